# Optimizing an MI355X kernel written in HIP

```python
import jax
import jax.numpy as jnp
from jax import lax
import numpy as np

D_MODEL = 2048
BATCH = 1
SEQ = 8192
DEPTH = 1

CHUNK = 64
RMS_EPS = 1e-6
GLA_HEADS = 4
GLA_DK = 256
GLA_DV = 512
GLA_GATE_RANK = 16
GLA_GATE_TAU = 16.0
GLA_QK = GLA_HEADS * GLA_DK
GLA_V = GLA_HEADS * GLA_DV
ATT_HEADS = 8
ATT_HD = 128
ATT_W = ATT_HEADS * ATT_HD
ATT_LEFT_CHUNKS = 8
ATT_BAND = ATT_LEFT_CHUNKS + 1
REL_CLIP = 128
N_EXPERTS = 32
TOP_K = 4
D_FF = 2048
SWIGLU_LIMIT = 7.0
SWIGLU_ALPHA = 1.702
MOE_BLOCK = 128
SPLITS = (GLA_QK, GLA_QK, GLA_V, GLA_V, GLA_GATE_RANK, ATT_W, ATT_W, ATT_W, D_MODEL, D_MODEL)
IN_COLS = 2 * GLA_QK + 2 * GLA_V + GLA_GATE_RANK + 3 * ATT_W + 2 * D_MODEL

kernel_name = 'hybrid_gla_chunkattn_moe_block'


def rms_norm(x, g):
    xf = x.astype(jnp.float32)
    y = xf * lax.rsqrt(jnp.mean(xf * xf, axis=-1, keepdims=True) + RMS_EPS)
    return (y * g.astype(jnp.float32)).astype(x.dtype)


def gla_mixer(q, k, v, r, gate_lr, w_gate_up, b_gate, out_g):
    B, S, _ = q.shape
    NC = S // CHUNK
    f32 = jnp.float32

    def to_chunks(t, d):
        return t.astype(f32).reshape(B, NC, CHUNK, GLA_HEADS, d).transpose(0, 1, 3, 2, 4)

    log_a = jax.nn.log_sigmoid((gate_lr @ w_gate_up + b_gate).astype(f32)) / GLA_GATE_TAU
    bcum = jnp.cumsum(to_chunks(log_a, GLA_DK), axis=3)
    b_last = bcum[:, :, :, -1:, :]
    qc = to_chunks(q, GLA_DK) * (GLA_DK ** -0.5)
    kc = to_chunks(k, GLA_DK)
    vc = to_chunks(v, GLA_DV)
    q_dec = qc * jnp.exp(bcum)
    k_inv = kc * jnp.exp(-bcum)
    k_end = kc * jnp.exp(b_last - bcum)
    causal = np.tril(np.ones((CHUNK, CHUNK), dtype=bool))
    a_intra = jnp.where(causal, jnp.einsum('bnhik,bnhjk->bnhij', q_dec, k_inv), 0.0)
    o_intra = jnp.einsum('bnhij,bnhjv->bnhiv', a_intra, vc)

    def step(state, inp):
        qd, ke, vv, dec = inp
        o_inter = jnp.einsum('bhik,bhkv->bhiv', qd, state)
        state = state * dec[..., None] + jnp.einsum('bhjk,bhjv->bhkv', ke, vv)
        return state, o_inter

    xs = (jnp.moveaxis(q_dec, 1, 0), jnp.moveaxis(k_end, 1, 0), jnp.moveaxis(vc, 1, 0),
          jnp.moveaxis(jnp.exp(b_last[:, :, :, 0, :]), 1, 0))
    s0 = jnp.zeros((B, GLA_HEADS, GLA_DK, GLA_DV), f32)
    _, o_inter = lax.scan(step, s0, xs)
    o = o_intra + jnp.moveaxis(o_inter, 0, 1)
    o = o.transpose(0, 1, 3, 2, 4).reshape(B, S, GLA_HEADS, GLA_DV)
    o = rms_norm(o, out_g).reshape(B, S, GLA_V)
    return (o * jax.nn.silu(r.astype(f32))).astype(q.dtype)


def chunk_attention(q, k, v, q_g, k_g, rel_bias):
    B, S, _ = q.shape
    NC = S // CHUNK
    q = rms_norm(q.reshape(B, S, ATT_HEADS, ATT_HD), q_g)
    k = rms_norm(k.reshape(B, S, ATT_HEADS, ATT_HD), k_g)
    v = v.reshape(B, S, ATT_HEADS, ATT_HD)
    qc = q.reshape(B, NC, CHUNK, ATT_HEADS, ATT_HD)

    def band(t):
        tp = jnp.pad(t.reshape(B, NC, CHUNK, ATT_HEADS, ATT_HD),
                     ((0, 0), (ATT_LEFT_CHUNKS, 0), (0, 0), (0, 0), (0, 0)))
        return jnp.stack([tp[:, w:w + NC] for w in range(ATT_BAND)], axis=2).reshape(
            B, NC, ATT_BAND * CHUNK, ATT_HEADS, ATT_HD)

    kb = band(k)
    vb = band(v)
    scores = jnp.einsum('bnihd,bnjhd->bnhij', qc, kb).astype(jnp.float32) * (ATT_HD ** -0.5)
    iq = np.arange(CHUNK)[:, None]
    jk = np.arange(ATT_BAND * CHUNK)[None, :] - ATT_LEFT_CHUNKS * CHUNK
    rel_idx = np.clip(iq - jk, -REL_CLIP, REL_CLIP) + REL_CLIP
    bias = rel_bias.astype(jnp.float32)[:, rel_idx]
    valid = (np.arange(NC)[:, None] - ATT_LEFT_CHUNKS
             + np.arange(ATT_BAND * CHUNK)[None, :] // CHUNK) >= 0
    scores = jnp.where(valid[None, :, None, None, :], scores + bias[None, None],
                       jnp.finfo(jnp.float32).min)
    p = jax.nn.softmax(scores, axis=-1).astype(v.dtype)
    o = jnp.einsum('bnhij,bnjhd->bnihd', p, vb)
    return o.reshape(B, S, ATT_W)


def moe_ffn(x, w_router, b_router, w_gate, b_gate, w_up, b_up, w_down, b_down):
    T, D = x.shape
    logits = (x @ w_router + b_router).astype(jnp.float32)
    top_val, top_idx = lax.top_k(logits, TOP_K)
    top_w = jax.nn.softmax(top_val, axis=-1)
    e_flat = top_idx.reshape(-1)
    tok_flat = jnp.repeat(jnp.arange(T, dtype=jnp.int32), TOP_K)
    w_flat = top_w.reshape(-1)
    order = jnp.argsort(e_flat)
    e_sorted = e_flat[order]
    counts = jnp.bincount(e_flat, length=N_EXPERTS)
    starts = jnp.cumsum(counts) - counts
    padded = (counts + MOE_BLOCK - 1) // MOE_BLOCK * MOE_BLOCK
    pends = jnp.cumsum(padded)
    pstarts = pends - padded
    dest = pstarts[e_sorted] + (jnp.arange(T * TOP_K) - starts[e_sorted])
    n_rows = -(-(T * TOP_K + N_EXPERTS * (MOE_BLOCK - 1)) // MOE_BLOCK) * MOE_BLOCK
    n_blocks = n_rows // MOE_BLOCK
    row_tok = jnp.full((n_rows,), T, jnp.int32).at[dest].set(tok_flat[order])
    row_w = jnp.zeros((n_rows,), jnp.float32).at[dest].set(w_flat[order])
    block_start = jnp.arange(n_blocks) * MOE_BLOCK
    block_e = jnp.minimum(jnp.searchsorted(pends, block_start, side='right'), N_EXPERTS - 1)
    x_pad = jnp.concatenate([x, jnp.zeros((1, D), x.dtype)], axis=0)

    def run_block(args):
        tok, wts, e = args
        xb = x_pad[tok]
        g = jnp.minimum(xb @ w_gate[e] + b_gate[e], SWIGLU_LIMIT)
        u = jnp.clip(xb @ w_up[e] + b_up[e], -SWIGLU_LIMIT, SWIGLU_LIMIT)
        hdn = (u + 1.0) * (g * jax.nn.sigmoid(SWIGLU_ALPHA * g))
        return ((hdn @ w_down[e] + b_down[e]) * wts[:, None]).astype(x.dtype)

    out = lax.map(run_block, (row_tok.reshape(n_blocks, MOE_BLOCK),
                              row_w.reshape(n_blocks, MOE_BLOCK), block_e))
    y = jnp.zeros((T + 1, D), x.dtype).at[row_tok].add(out.reshape(n_rows, D))
    return y[:T]


def setup_inputs(seed: int = 0) -> dict:
    key = jax.random.key(seed)
    ks = jax.random.split(key, 24)
    f32 = jnp.float32
    L = DEPTH

    def nrm(k, shape, scale):
        return jax.random.normal(k, shape, f32) * scale

    return {
        'x': nrm(ks[0], (BATCH, SEQ, D_MODEL), 1.0),
        'norm1_g': 1.0 + nrm(ks[1], (L, D_MODEL), 0.02),
        'w_in': nrm(ks[2], (L, D_MODEL, IN_COLS), D_MODEL ** -0.5),
        'w_gla_gate_up': nrm(ks[3], (L, GLA_GATE_RANK, GLA_QK), GLA_GATE_RANK ** -0.5),
        'b_gla_gate': nrm(ks[4], (L, GLA_QK), 0.1),
        'gla_norm_g': 1.0 + nrm(ks[5], (L, GLA_DV), 0.02),
        'q_norm_g': 1.0 + nrm(ks[6], (L, ATT_HD), 0.02),
        'k_norm_g': 1.0 + nrm(ks[7], (L, ATT_HD), 0.02),
        'rel_bias': nrm(ks[8], (L, ATT_HEADS, 2 * REL_CLIP + 1), 0.2),
        'b_branch_gate': nrm(ks[9], (L, 2, D_MODEL), 0.02),
        'w_branch_gla': nrm(ks[10], (L, GLA_V, D_MODEL), GLA_V ** -0.5),
        'w_branch_att': nrm(ks[11], (L, ATT_W, D_MODEL), ATT_W ** -0.5),
        'w_out': nrm(ks[12], (L, D_MODEL, D_MODEL), D_MODEL ** -0.5),
        'norm2_g': 1.0 + nrm(ks[13], (L, D_MODEL), 0.02),
        'w_router': nrm(ks[14], (L, D_MODEL, N_EXPERTS), D_MODEL ** -0.5),
        'b_router': nrm(ks[15], (L, N_EXPERTS), 0.01),
        'w_gate': nrm(ks[16], (L, N_EXPERTS, D_MODEL, D_FF), D_MODEL ** -0.5),
        'b_gate': nrm(ks[17], (L, N_EXPERTS, D_FF), 0.02),
        'w_up': nrm(ks[18], (L, N_EXPERTS, D_MODEL, D_FF), D_MODEL ** -0.5),
        'b_up': nrm(ks[19], (L, N_EXPERTS, D_FF), 0.02),
        'w_down': nrm(ks[20], (L, N_EXPERTS, D_FF, D_MODEL), D_FF ** -0.5),
        'b_down': nrm(ks[21], (L, N_EXPERTS, D_MODEL), 0.02),
    }


def reference(x, norm1_g, w_in, w_gla_gate_up, b_gla_gate, gla_norm_g, q_norm_g, k_norm_g,
              rel_bias, b_branch_gate, w_branch_gla, w_branch_att, w_out, norm2_g,
              w_router, b_router, w_gate, b_gate, w_up, b_up, w_down, b_down):
    B, S, D = x.shape
    split_points = [int(c) for c in np.cumsum(SPLITS)[:-1]]
    h = x
    for l in range(DEPTH):
        xn = rms_norm(h, norm1_g[l])
        proj = xn @ w_in[l]
        (g_q, g_k, g_v, g_r, g_lr, a_q, a_k, a_v,
         gate_gla, gate_att) = jnp.split(proj, split_points, axis=-1)
        y_gla = gla_mixer(g_q, g_k, g_v, g_r, g_lr, w_gla_gate_up[l], b_gla_gate[l],
                          gla_norm_g[l])
        y_att = chunk_attention(a_q, a_k, a_v, q_norm_g[l], k_norm_g[l], rel_bias[l])
        s_gla = jax.nn.sigmoid(gate_gla + b_branch_gate[l, 0])
        s_att = jax.nn.sigmoid(gate_att + b_branch_gate[l, 1])
        merged = s_gla * (y_gla @ w_branch_gla[l]) + s_att * (y_att @ w_branch_att[l])
        h = h + merged @ w_out[l]
        hn = rms_norm(h, norm2_g[l]).reshape(B * S, D)
        h = h + moe_ffn(hn, w_router[l], b_router[l], w_gate[l], b_gate[l], w_up[l],
                        b_up[l], w_down[l], b_down[l]).reshape(B, S, D)
    return h
```

```cpp
#include <hip/hip_runtime.h>
#include <stdint.h>
#include <cstdio>

constexpr int S = 8192, D = 2048;
constexpr int GLA_H = 4, GLA_DK = 256, GLA_DV = 512, GLA_RANK = 16, GLA_QK = 1024, GLA_V = 2048;
constexpr int ATT_H = 8, ATT_HD = 128, ATT_W = 1024, CHUNK = 64, NCH = S / CHUNK;
constexpr int NE = 32, TOPK = 4, DFF = 2048;
constexpr int IN_COLS = 13328;
constexpr int C_GQ = 0, C_GK = 1024, C_GV = 2048, C_GR = 4096, C_GLR = 6144, C_AQ = 6160, C_AK = 7184, C_AV = 8208, C_SG = 9232, C_SA = 11280;

__device__ __forceinline__ float wave_sum(float v) {
#pragma unroll
    for (int o = 1; o < 64; o <<= 1) v += __shfl_xor(v, o);
    return v;
}
__device__ __forceinline__ float sigmoidf_(float x) { return 1.f / (1.f + __expf(-x)); }
__device__ __forceinline__ float log_sigmoid(float z) { return fminf(z, 0.f) - log1pf(__expf(-fabsf(z))); }

__global__ void __launch_bounds__(256) k_rmsnorm(const float* __restrict__ x, const float* __restrict__ g, float* __restrict__ y, int rows, int n) {
    const int w = (blockIdx.x * blockDim.x + threadIdx.x) >> 6, lane = threadIdx.x & 63;
    if (w >= rows) return;
    const float* xr = x + (size_t)w * n; float s = 0.f;
    for (int i = lane; i < n; i += 64) { const float v = xr[i]; s += v * v; }
    s = wave_sum(s);
    const float r = rsqrtf(s / n + 1e-6f);
    float* yr = y + (size_t)w * n;
    for (int i = lane; i < n; i += 64) yr[i] = xr[i] * r * g[i];
}

struct GemmArgs {
    const float* A; const float* B; float* C; const float* bias;
    const int* arow;
    const int* Mz;
    const int* rowoff;
    int M, N, K, lda, ldb, ldc;
    long sB, sbias; int arow_stride, arow_shift, a_use_off, pad;
};
__global__ void __launch_bounds__(256) k_gemm(GemmArgs g) {
    __shared__ float As[16][65];
    __shared__ float Bs[16][64];
    const int z = blockIdx.z;
    const int Mg = g.Mz ? g.Mz[z] : g.M;
    const int m0 = blockIdx.y * 64, n0 = blockIdx.x * 64;
    if (m0 >= Mg) return;
    const int roff = g.rowoff ? g.rowoff[z] : 0;
    const float* B = g.B + (size_t)z * g.sB;
    const float* bias = g.bias ? g.bias + (size_t)z * g.sbias : nullptr;
    const int tid = threadIdx.x, tx = tid & 15, ty = tid >> 4;
    const int ar = tid >> 2, ak = (tid & 3) * 4;
    long arow_idx = -1;
    if (m0 + ar < Mg) {
        if (g.arow) arow_idx = (long)(g.arow[(size_t)z * g.arow_stride + m0 + ar] >> g.arow_shift);
        else arow_idx = (long)(m0 + ar) + (g.a_use_off ? roff : 0);
    }
    const int bk = tid >> 4, bn = (tid & 15) * 4;
    float acc[4][4];
#pragma unroll
    for (int i = 0; i < 4; ++i)
#pragma unroll
        for (int j = 0; j < 4; ++j) acc[i][j] = 0.f;
    for (int k0 = 0; k0 < g.K; k0 += 16) {
        float4 av = make_float4(0.f, 0.f, 0.f, 0.f);
        if (arow_idx >= 0) av = *(const float4*)(g.A + (size_t)arow_idx * g.lda + k0 + ak);
        As[ak + 0][ar] = av.x; As[ak + 1][ar] = av.y; As[ak + 2][ar] = av.z; As[ak + 3][ar] = av.w;
        float4 bv = make_float4(0.f, 0.f, 0.f, 0.f);
        if (n0 + bn < g.N) bv = *(const float4*)(B + (size_t)(k0 + bk) * g.ldb + n0 + bn);
        *(float4*)&Bs[bk][bn] = bv;
        __syncthreads();
#pragma unroll
        for (int kk = 0; kk < 16; ++kk) {
            float a[4], b[4];
#pragma unroll
            for (int i = 0; i < 4; ++i) a[i] = As[kk][ty * 4 + i];
#pragma unroll
            for (int j = 0; j < 4; ++j) b[j] = Bs[kk][tx * 4 + j];
#pragma unroll
            for (int i = 0; i < 4; ++i)
#pragma unroll
                for (int j = 0; j < 4; ++j) acc[i][j] = fmaf(a[i], b[j], acc[i][j]);
        }
        __syncthreads();
    }
#pragma unroll
    for (int i = 0; i < 4; ++i) {
        const int m = m0 + ty * 4 + i;
        if (m >= Mg) continue;
#pragma unroll
        for (int j = 0; j < 4; ++j) {
            const int n = n0 + tx * 4 + j;
            if (n < g.N) g.C[(size_t)(roff + m) * g.ldc + n] = acc[i][j] + (bias ? bias[n] : 0.f);
        }
    }
}

__global__ void __launch_bounds__(256) k_gla_scan(const float* __restrict__ proj, const float* __restrict__ wgu, const float* __restrict__ bg, float* __restrict__ o) {
    __shared__ float red[2][4][8];
    const int h = blockIdx.x >> 6, vg = blockIdx.x & 63, dk = threadIdx.x, lane = dk & 63, wv = dk >> 6;
    const int c = h * GLA_DK + dk;
    float w[16];
#pragma unroll
    for (int r = 0; r < 16; ++r) w[r] = wgu[r * GLA_QK + c];
    const float b = bg[c];
    float s[8];
#pragma unroll
    for (int j = 0; j < 8; ++j) s[j] = 0.f;
    float glr[16], vq, vk, vv[8];
    {
        const float* row = proj;
#pragma unroll
        for (int r = 0; r < 16; ++r) glr[r] = row[C_GLR + r];
        vq = row[C_GQ + c]; vk = row[C_GK + c];
#pragma unroll
        for (int j = 0; j < 8; ++j) vv[j] = row[C_GV + h * GLA_DV + vg * 8 + j];
    }
    for (int t = 0; t < S; ++t) {
        float nglr[16], nq, nk, nv[8];
        {
            const float* row = proj + (size_t)(t + 1 < S ? t + 1 : t) * IN_COLS;
#pragma unroll
            for (int r = 0; r < 16; ++r) nglr[r] = row[C_GLR + r];
            nq = row[C_GQ + c]; nk = row[C_GK + c];
#pragma unroll
            for (int j = 0; j < 8; ++j) nv[j] = row[C_GV + h * GLA_DV + vg * 8 + j];
        }
        float z = b;
#pragma unroll
        for (int r = 0; r < 16; ++r) z = fmaf(glr[r], w[r], z);
        const float a = __expf(log_sigmoid(z) * (1.f / 16.f));
        const float q = vq * 0.0625f, k = vk;
        float p[8];
#pragma unroll
        for (int j = 0; j < 8; ++j) { s[j] = fmaf(s[j], a, k * vv[j]); p[j] = q * s[j]; }
#pragma unroll
        for (int j = 0; j < 8; ++j) p[j] = wave_sum(p[j]);
        if (lane == 0) {
#pragma unroll
            for (int j = 0; j < 8; ++j) red[t & 1][wv][j] = p[j];
        }
        __syncthreads();
        if (dk < 8) o[(size_t)t * GLA_V + h * GLA_DV + vg * 8 + dk] = red[t & 1][0][dk] + red[t & 1][1][dk] + red[t & 1][2][dk] + red[t & 1][3][dk];
#pragma unroll
        for (int r = 0; r < 16; ++r) glr[r] = nglr[r];
        vq = nq; vk = nk;
#pragma unroll
        for (int j = 0; j < 8; ++j) vv[j] = nv[j];
    }
}
__global__ void __launch_bounds__(256) k_gla_out(const float* __restrict__ o, const float* __restrict__ proj, const float* __restrict__ g, float* __restrict__ y) {
    const int w = (blockIdx.x * blockDim.x + threadIdx.x) >> 6, lane = threadIdx.x & 63;
    const int t = w >> 2, h = w & 3;
    const float* orow = o + (size_t)t * GLA_V + h * GLA_DV; float v[8]; float s = 0.f;
#pragma unroll
    for (int i = 0; i < 8; ++i) { v[i] = orow[lane + 64 * i]; s += v[i] * v[i]; }
    s = wave_sum(s);
    const float r = rsqrtf(s / GLA_DV + 1e-6f);
#pragma unroll
    for (int i = 0; i < 8; ++i) { const int vv = lane + 64 * i; const float rr = proj[(size_t)t * IN_COLS + C_GR + h * GLA_DV + vv];
        y[(size_t)t * GLA_V + h * GLA_DV + vv] = v[i] * r * g[vv] * (rr * sigmoidf_(rr)); }
}

__global__ void __launch_bounds__(64) k_attn(const float* __restrict__ proj, const float* __restrict__ qg, const float* __restrict__ kg, const float* __restrict__ relb,
                                              float* __restrict__ sc, float* __restrict__ y) {
    __shared__ float kt[64][128];
    const int n = blockIdx.x >> 3, h = blockIdx.x & 7, i = threadIdx.x;
    float* scb = sc + (size_t)blockIdx.x * 576 * 64;
    float q[128];
    {
        const float* qr = proj + (size_t)(n * 64 + i) * IN_COLS + C_AQ + h * ATT_HD; float ss = 0.f;
#pragma unroll
        for (int d = 0; d < 128; d += 4) { const float4 v = *(const float4*)(qr + d); q[d] = v.x; q[d + 1] = v.y; q[d + 2] = v.z; q[d + 3] = v.w; ss += v.x * v.x + v.y * v.y + v.z * v.z + v.w * v.w; }
        const float r = rsqrtf(ss / 128.f + 1e-6f) * 0.08838834764831845f;
#pragma unroll
        for (int d = 0; d < 128; ++d) q[d] = q[d] * r * qg[d];
    }
    float mx = -3.0e38f;
    for (int w = 0; w < 9; ++w) {
        const int kc = n - 8 + w;
        if (kc < 0) continue;
        __syncthreads();
        {
            const float* kr = proj + (size_t)(kc * 64 + i) * IN_COLS + C_AK + h * ATT_HD; float ss = 0.f;
            for (int d = 0; d < 128; d += 4) { const float4 v = *(const float4*)(kr + d); ss += v.x * v.x + v.y * v.y + v.z * v.z + v.w * v.w; }
            const float r = rsqrtf(ss / 128.f + 1e-6f);
            for (int d = 0; d < 128; d += 4) { const float4 v = *(const float4*)(kr + d); kt[i][d] = v.x * r * kg[d]; kt[i][d + 1] = v.y * r * kg[d + 1]; kt[i][d + 2] = v.z * r * kg[d + 2]; kt[i][d + 3] = v.w * r * kg[d + 3]; }
        }
        __syncthreads();
        for (int j = 0; j < 64; ++j) {
            float s = 0.f;
#pragma unroll
            for (int d = 0; d < 128; d += 4) { const float4 kv = *(const float4*)&kt[j][d]; s = fmaf(q[d], kv.x, s); s = fmaf(q[d + 1], kv.y, s); s = fmaf(q[d + 2], kv.z, s); s = fmaf(q[d + 3], kv.w, s); }
            int rel = 64 * (8 - w) + i - j; rel = rel < -128 ? -128 : (rel > 128 ? 128 : rel);
            s += relb[h * 257 + rel + 128];
            scb[(w * 64 + j) * 64 + i] = s;
            mx = fmaxf(mx, s);
        }
    }
    float l = 0.f;
    float o[128];
#pragma unroll
    for (int d = 0; d < 128; ++d) o[d] = 0.f;
    for (int w = 0; w < 9; ++w) {
        const int kc = n - 8 + w;
        if (kc < 0) continue;
        __syncthreads();
        {
            const float* vr = proj + (size_t)(kc * 64 + i) * IN_COLS + C_AV + h * ATT_HD;
            for (int d = 0; d < 128; d += 4) { const float4 v = *(const float4*)(vr + d); *(float4*)&kt[i][d] = v; }
        }
        __syncthreads();
        for (int j = 0; j < 64; ++j) {
            const float p = __expf(scb[(w * 64 + j) * 64 + i] - mx);
            l += p;
#pragma unroll
            for (int d = 0; d < 128; d += 4) { const float4 vv = *(const float4*)&kt[j][d]; o[d] = fmaf(p, vv.x, o[d]); o[d + 1] = fmaf(p, vv.y, o[d + 1]); o[d + 2] = fmaf(p, vv.z, o[d + 2]); o[d + 3] = fmaf(p, vv.w, o[d + 3]); }
        }
    }
    const float inv = 1.f / l;
    float* yr = y + (size_t)(n * 64 + i) * ATT_W + h * ATT_HD;
#pragma unroll
    for (int d = 0; d < 128; d += 4) *(float4*)(yr + d) = make_float4(o[d] * inv, o[d + 1] * inv, o[d + 2] * inv, o[d + 3] * inv);
}

__global__ void __launch_bounds__(256) k_merge(const float* __restrict__ proj, const float* __restrict__ bb, const float* __restrict__ pg, const float* __restrict__ pa, float* __restrict__ m) {
    const size_t idx = (size_t)blockIdx.x * blockDim.x + threadIdx.x;
    const int t = idx / D, c = idx % D;
    const float sg = sigmoidf_(proj[(size_t)t * IN_COLS + C_SG + c] + bb[c]);
    const float sa = sigmoidf_(proj[(size_t)t * IN_COLS + C_SA + c] + bb[D + c]);
    m[idx] = sg * pg[idx] + sa * pa[idx];
}
__global__ void __launch_bounds__(256) k_add(const float* __restrict__ a, const float* __restrict__ b, float* __restrict__ c) {
    const size_t idx = (size_t)blockIdx.x * blockDim.x + threadIdx.x; c[idx] = a[idx] + b[idx];
}

__global__ void __launch_bounds__(256) k_route(const float* __restrict__ hn, const float* __restrict__ wr, const float* __restrict__ br,
                                               int* __restrict__ cnt, int* __restrict__ list, float* __restrict__ topw, int* __restrict__ tope, int* __restrict__ topslot) {
    const int t = (blockIdx.x * blockDim.x + threadIdx.x) >> 6, lane = threadIdx.x & 63;
    const int e = lane & 31, half = lane >> 5;
    const float* xr = hn + (size_t)t * D; float acc = 0.f;
    for (int k = half; k < D; k += 2) acc = fmaf(xr[k], wr[(size_t)k * NE + e], acc);
    acc += __shfl_xor(acc, 32);
    float logit = acc + br[e];
    float vals[4]; int idxs[4]; float cur = logit;
#pragma unroll
    for (int r = 0; r < 4; ++r) {
        float bv = cur; int bi = e;
#pragma unroll
        for (int o = 1; o < 32; o <<= 1) { const float ov = __shfl_xor(bv, o); const int oi = __shfl_xor(bi, o); if (ov > bv || (ov == bv && oi < bi)) { bv = ov; bi = oi; } }
        vals[r] = bv; idxs[r] = bi;
        if (e == bi) cur = -3.0e38f;
    }
    const float m = vals[0]; float ex[4], sum = 0.f;
#pragma unroll
    for (int r = 0; r < 4; ++r) { ex[r] = __expf(vals[r] - m); sum += ex[r]; }
#pragma unroll
    for (int r = 0; r < 4; ++r) {
        if (lane == r) {
            const int ee = idxs[r];
            const int slot = atomicAdd(&cnt[ee], 1);
            list[ee * S + slot] = t * 4 + r;
            topw[t * 4 + r] = ex[r] / sum; tope[t * 4 + r] = ee; topslot[t * 4 + r] = slot;
        }
    }
}
__global__ void k_offsets(const int* __restrict__ cnt, int* __restrict__ off) { if (threadIdx.x == 0) { int s = 0; for (int e = 0; e < NE; ++e) { off[e] = s; s += cnt[e]; } } }
__global__ void __launch_bounds__(256) k_swiglu(const float* __restrict__ gg, const float* __restrict__ uu, float* __restrict__ hd) {
    const size_t idx = (size_t)blockIdx.x * blockDim.x + threadIdx.x;
    const float g = fminf(gg[idx], 7.f), u = fminf(fmaxf(uu[idx], -7.f), 7.f);
    hd[idx] = (u + 1.f) * (g * sigmoidf_(1.702f * g));
}
__global__ void __launch_bounds__(256) k_combine(const float* __restrict__ h1, const float* __restrict__ Y, const float* __restrict__ topw, const int* __restrict__ tope, const int* __restrict__ topslot,
                                                 const int* __restrict__ off, float* __restrict__ out) {
    const size_t idx = (size_t)blockIdx.x * blockDim.x + threadIdx.x;
    const int t = idx / D, c = idx % D; float a = h1[idx];
#pragma unroll
    for (int r = 0; r < 4; ++r) { const int p = t * 4 + r; a += topw[p] * Y[(size_t)(off[tope[p]] + topslot[p]) * D + c]; }
    out[idx] = a;
}

static void gemm(hipStream_t st, const float* A, int lda, const float* B, int ldb, float* C, int ldc, int M, int N, int K) {
    GemmArgs g{}; g.A = A; g.B = B; g.C = C; g.M = M; g.N = N; g.K = K; g.lda = lda; g.ldb = ldb; g.ldc = ldc;
    hipLaunchKernelGGL(k_gemm, dim3((N + 63) / 64, (M + 63) / 64, 1), dim3(256), 0, st, g);
}

extern "C" void kernel_launch(void* const* d_in, const int* in_sizes, int n_in, void* d_out, int out_size, void* d_ws, size_t ws_size, hipStream_t stream) {
    const float* x = (const float*)d_in[0]; const float* norm1_g = (const float*)d_in[1]; const float* w_in = (const float*)d_in[2];
    const float* wgu = (const float*)d_in[3]; const float* bgg = (const float*)d_in[4]; const float* gla_g = (const float*)d_in[5];
    const float* qg = (const float*)d_in[6]; const float* kg = (const float*)d_in[7]; const float* relb = (const float*)d_in[8];
    const float* bbg = (const float*)d_in[9]; const float* w_bg = (const float*)d_in[10]; const float* w_ba = (const float*)d_in[11];
    const float* w_out = (const float*)d_in[12]; const float* norm2_g = (const float*)d_in[13]; const float* w_router = (const float*)d_in[14];
    const float* b_router = (const float*)d_in[15]; const float* w_gate = (const float*)d_in[16]; const float* b_gate = (const float*)d_in[17];
    const float* w_up = (const float*)d_in[18]; const float* b_up = (const float*)d_in[19]; const float* w_down = (const float*)d_in[20];
    const float* b_down = (const float*)d_in[21];
    float* out = (float*)d_out;
    char* ws = (char*)d_ws; size_t o_ = 0;
    auto take = [&](size_t bytes) { char* p = ws + o_; o_ += (bytes + 255) & ~(size_t)255; return p; };
    int* cnt = (int*)take(256); int* off = (int*)take(256);
    int* list = (int*)take((size_t)NE * S * 4); float* topw = (float*)take((size_t)S * 4 * 4); int* tope = (int*)take((size_t)S * 4 * 4); int* topslot = (int*)take((size_t)S * 4 * 4);
    float* xn = (float*)take((size_t)S * D * 4);
    float* proj = (float*)take((size_t)S * IN_COLS * 4);
    float* og = (float*)take((size_t)S * GLA_V * 4);
    float* yg = (float*)take((size_t)S * GLA_V * 4);
    float* sc = (float*)take((size_t)NCH * ATT_H * 576 * 64 * 4);
    float* ya = (float*)take((size_t)S * ATT_W * 4);
    float* pg = (float*)take((size_t)S * D * 4);
    float* pa = (float*)take((size_t)S * D * 4);
    float* mg = (float*)take((size_t)S * D * 4);
    float* h1 = (float*)take((size_t)S * D * 4);
    float* hn = (float*)take((size_t)S * D * 4);
    float* G = (float*)take((size_t)S * 4 * DFF * 4);
    float* U = (float*)take((size_t)S * 4 * DFF * 4);
    float* Hd = (float*)take((size_t)S * 4 * DFF * 4);
    float* Y = G;
    if (o_ > ws_size) { fprintf(stderr, "workspace too small: need %zu have %zu\n", o_, ws_size); return; }

    hipMemsetAsync(cnt, 0, 256, stream);
    hipLaunchKernelGGL(k_rmsnorm, dim3(S / 4), dim3(256), 0, stream, x, norm1_g, xn, S, D);
    gemm(stream, xn, D, w_in, IN_COLS, proj, IN_COLS, S, IN_COLS, D);
    hipLaunchKernelGGL(k_gla_scan, dim3(256), dim3(256), 0, stream, proj, wgu, bgg, og);
    hipLaunchKernelGGL(k_gla_out, dim3(S * GLA_H / 4), dim3(256), 0, stream, og, proj, gla_g, yg);
    hipLaunchKernelGGL(k_attn, dim3(NCH * ATT_H), dim3(64), 0, stream, proj, qg, kg, relb, sc, ya);
    gemm(stream, yg, GLA_V, w_bg, D, pg, D, S, D, GLA_V);
    gemm(stream, ya, ATT_W, w_ba, D, pa, D, S, D, ATT_W);
    hipLaunchKernelGGL(k_merge, dim3(S * D / 256), dim3(256), 0, stream, proj, bbg, pg, pa, mg);
    gemm(stream, mg, D, w_out, D, pa, D, S, D, D);
    hipLaunchKernelGGL(k_add, dim3(S * D / 256), dim3(256), 0, stream, x, pa, h1);
    hipLaunchKernelGGL(k_rmsnorm, dim3(S / 4), dim3(256), 0, stream, h1, norm2_g, hn, S, D);
    hipLaunchKernelGGL(k_route, dim3(S / 4), dim3(256), 0, stream, hn, w_router, b_router, cnt, list, topw, tope, topslot);
    hipLaunchKernelGGL(k_offsets, dim3(1), dim3(64), 0, stream, cnt, off);
    {
        GemmArgs g{}; g.A = hn; g.C = G; g.arow = list; g.Mz = cnt; g.rowoff = off; g.M = S; g.N = DFF; g.K = D; g.lda = D; g.ldb = DFF; g.ldc = DFF;
        g.sB = (long)D * DFF; g.sbias = DFF; g.arow_stride = S; g.arow_shift = 2;
        g.B = w_gate; g.bias = b_gate;
        hipLaunchKernelGGL(k_gemm, dim3(DFF / 64, S / 64, NE), dim3(256), 0, stream, g);
        g.B = w_up; g.bias = b_up; g.C = U;
        hipLaunchKernelGGL(k_gemm, dim3(DFF / 64, S / 64, NE), dim3(256), 0, stream, g);
    }
    hipLaunchKernelGGL(k_swiglu, dim3((size_t)S * 4 * DFF / 256), dim3(256), 0, stream, G, U, Hd);
    {
        GemmArgs g{}; g.A = Hd; g.C = Y; g.Mz = cnt; g.rowoff = off; g.a_use_off = 1; g.M = S; g.N = D; g.K = DFF; g.lda = DFF; g.ldb = D; g.ldc = D;
        g.sB = (long)DFF * D; g.sbias = D; g.B = w_down; g.bias = b_down;
        hipLaunchKernelGGL(k_gemm, dim3(D / 64, S / 64, NE), dim3(256), 0, stream, g);
    }
    hipLaunchKernelGGL(k_combine, dim3(S * D / 256), dim3(256), 0, stream, h1, Y, topw, tope, topslot, off, out);
}
```

```cpp
#include <hip/hip_runtime.h>
#include <stdint.h>
#include <cstdio>

constexpr int S = 8192, D = 2048;
constexpr int GLA_H = 4, GLA_DK = 256, GLA_DV = 512, GLA_QK = 1024, GLA_V = 2048;
constexpr int ATT_H = 8, ATT_HD = 128, ATT_W = 1024, NCH = S / 64;
constexpr int NE = 32, DFF = 2048;
constexpr int IN_COLS = 13328, C_GLR = 6144;
constexpr int NPROJ = 13312;
constexpr int MAXROWS = 32768 + NE * 256;

constexpr size_t MiB = 1u << 20;
constexpr size_t WS_CTL = 0, CTL_ZERO_BYTES = 1 * MiB;
constexpr size_t WS_TOPW = 1 * MiB, WS_TOPE = WS_TOPW + 128 * 1024, WS_TOPS = WS_TOPE + 128 * 1024, WS_RPAIR = WS_TOPS + 128 * 1024, WS_RW = WS_RPAIR + 256 * 1024;
constexpr size_t WS_GLR = 2 * MiB, WS_WR = 3 * MiB;
constexpr size_t WS_WIN = 8 * MiB, WS_WBG = 60 * MiB, WS_WBA = 68 * MiB, WS_WOUT = 72 * MiB, WS_GU = 80 * MiB, WS_DN = 592 * MiB;
constexpr size_t WS_XN = 848 * MiB, WS_GQ = 880 * MiB, WS_GK = 896 * MiB, WS_GV = 912 * MiB, WS_GR = 944 * MiB, WS_AQ = 976 * MiB, WS_AK = 992 * MiB, WS_AV = 1008 * MiB;
constexpr size_t WS_SG = 1024 * MiB, WS_SA = 1056 * MiB, WS_YG = 1088 * MiB, WS_YA = 1120 * MiB, WS_T = 1136 * MiB, WS_MG = 1168 * MiB, WS_HN = 1200 * MiB;
constexpr size_t WS_HNG = 1232 * MiB, WS_HD = 1392 * MiB, WS_PY = 1552 * MiB, WS_OG = 1681 * MiB, WS_SC = 1745 * MiB, WS_END = 1889 * MiB;
constexpr int CW_CNT = 64;
constexpr int CW_BAR = 4096;

typedef unsigned short bf16;
typedef short bf16x8 __attribute__((ext_vector_type(8)));
typedef float f32x4 __attribute__((ext_vector_type(4)));
typedef unsigned u32x4 __attribute__((ext_vector_type(4)));
typedef unsigned u32x2 __attribute__((ext_vector_type(2)));
#define LAS __attribute__((address_space(3)))
#define GAS __attribute__((address_space(1)))
__device__ __forceinline__ float bf2f(bf16 v) { return __uint_as_float((unsigned)v << 16); }
__device__ __forceinline__ unsigned f2bf(float f) { unsigned u = __float_as_uint(f); return (u + 0x7fffu + ((u >> 16) & 1u)) >> 16; }
__device__ __forceinline__ unsigned pk2(float lo, float hi) { return f2bf(lo) | (f2bf(hi) << 16); }
__device__ __forceinline__ unsigned cvt_pk_bf16(float lo, float hi) { unsigned r; asm volatile("v_cvt_pk_bf16_f32 %0, %1, %2" : "=v"(r) : "v"(lo), "v"(hi)); return r; }
__device__ __forceinline__ float wave_sum(float v) {
#pragma unroll
    for (int o = 1; o < 64; o <<= 1) v += __shfl_xor(v, o);
    return v;
}
__device__ __forceinline__ float sigmoidf_(float x) { return 1.f / (1.f + __expf(-x)); }
__device__ __forceinline__ float log_sigmoid(float z) { return fminf(z, 0.f) - log1pf(__expf(-fabsf(z))); }
#define LDS_WAIT() asm volatile("s_waitcnt lgkmcnt(0)" ::: "memory")
#define VM_WAIT() asm volatile("s_waitcnt vmcnt(0)" ::: "memory")

#define XB_TMO      128
#define XB_XCNT(j)  (256  + 64 * (j))
#define XB_XSUB(j)  (1280 + 64 * (j))
#define XB_XGEN(j)  (2304 + 64 * (j))
#define XB_TOP      3328
#define XB_TOPGEN   3392
#define XCD_BAR_WORDS 3456
#define XB_SPIN_CAP (1u << 18)
__device__ __forceinline__ unsigned xb_ld(unsigned* p)              { return __hip_atomic_load(p, __ATOMIC_RELAXED, __HIP_MEMORY_SCOPE_AGENT); }
__device__ __forceinline__ unsigned xb_add(unsigned* p, unsigned v) { return __hip_atomic_fetch_add(p, v, __ATOMIC_RELAXED, __HIP_MEMORY_SCOPE_AGENT); }
__device__ __forceinline__ unsigned xb_xcc_id() { return (unsigned)__builtin_amdgcn_s_getreg((3 << 11) | 20) & 0xFu; }
#define XB_SPIN(cond, bar) do { unsigned _sp = 0; while (cond) { __builtin_amdgcn_s_sleep(1); \
    if ((++_sp & 255u) == 0u) { if (xb_ld(&(bar)[XB_TMO])) break; if (_sp > XB_SPIN_CAP) { atomicAdd(&(bar)[XB_TMO], 1u); break; } } } } while (0)
struct XcdBarrier { unsigned* bar; unsigned x; volatile LAS unsigned* st; };
__device__ __forceinline__ XcdBarrier xcd_barrier_post(unsigned* bar, volatile LAS unsigned* st) {
    XcdBarrier b; b.bar = bar; b.x = xb_xcc_id(); b.st = st;
    if (threadIdx.x == 0) (void)xb_add(&bar[XB_XCNT(b.x)], 1u);
    return b;
}
__device__ __forceinline__ void xcd_barrier_complete(unsigned* bar, unsigned x, unsigned& nloc, unsigned& nx) {
    const unsigned G = gridDim.x * gridDim.y * gridDim.z;
    unsigned sum, cnt, mine, sp = 0u;
    for (;;) {
        sum = 0u; cnt = 0u; mine = 0u;
#pragma unroll
        for (unsigned j = 0; j < 16; ++j) { const unsigned c = xb_ld(&bar[XB_XCNT(j)]); sum += c; cnt += (c > 0u) ? 1u : 0u; mine = (j == x) ? c : mine; }
        if (sum == G) break;
        __builtin_amdgcn_s_sleep(1);
        if ((++sp & 255u) == 0u) { if (xb_ld(&bar[XB_TMO])) break; if (sp > XB_SPIN_CAP) { atomicAdd(&bar[XB_TMO], 1u); break; } }
    }
    nloc = mine > 0u ? mine : 1u; nx = cnt > 0u ? cnt : 1u;
}
__device__ __forceinline__ void xcd_barrier(const XcdBarrier& b) {
    asm volatile("s_waitcnt vmcnt(0)" ::: "memory");
    __syncthreads();
    if (threadIdx.x == 0) {
        unsigned* bar = b.bar;
        __builtin_amdgcn_s_waitcnt(0);
        unsigned nloc = b.st[0], nx = b.st[1];
        if (nloc == 0u) { xcd_barrier_complete(bar, b.x, nloc, nx); b.st[0] = nloc; b.st[1] = nx; }
        const unsigned old = xb_add(&bar[XB_XSUB(b.x)], 1u);
        const unsigned gen = old / nloc;
        if (old + 1u == (gen + 1u) * nloc) {
            __builtin_amdgcn_fence(__ATOMIC_RELEASE, "agent");
            asm volatile("s_waitcnt vmcnt(0)" ::: "memory");
            const unsigned og = xb_add(&bar[XB_TOP], 1u);
            const unsigned tg = og / nx;
            if (og + 1u == (tg + 1u) * nx) xb_add(&bar[XB_TOPGEN], 1u);
            else XB_SPIN(xb_ld(&bar[XB_TOPGEN]) == tg, bar);
            __builtin_amdgcn_fence(__ATOMIC_ACQUIRE, "agent");
            xb_add(&bar[XB_XGEN(b.x)], 1u);
            asm volatile("s_waitcnt vmcnt(0)" ::: "memory");
        } else {
            XB_SPIN(xb_ld(&bar[XB_XGEN(b.x)]) == gen, bar);
            __builtin_amdgcn_fence(__ATOMIC_ACQUIRE, "agent");
            asm volatile("s_waitcnt vmcnt(0)" ::: "memory");
        }
    }
    __syncthreads();
}

namespace pg8 {
constexpr int BM = 256, BK = 64, HALF = 128, HTB = HALF * BK * 2, STAGE_BYTES = 8 * HTB, NXCD = 8, WGM = 8;
__host__ __device__ __forceinline__ int lds_byte(int r, int c) { const int st = (r >> 4) * 2 + (c >> 5), rr = r & 15, cc = c & 31, ob = rr * 64 + cc * 2; return st * 1024 + (ob ^ (((ob >> 9) & 1) << 5)); }
__host__ __device__ __forceinline__ void stage_rc(int b, int& R, int& C) { const int st = b / 1024, sb = b % 1024, swz = sb ^ (((sb >> 9) & 1) << 5); R = (st >> 1) * 16 + swz / 64; C = (st & 1) * 32 + (swz % 64) / 2; }
__host__ __device__ __forceinline__ int perm32(int rho) { const int n = rho >> 4, i = rho & 15; return 8 * (i >> 2) + 4 * n + (i & 3); }
__device__ __forceinline__ int xcd_remap(int wgid, int nwg) { const int q = nwg / NXCD, r = nwg % NXCD, xcd = wgid % NXCD, off = wgid / NXCD; return (xcd < r ? xcd * (q + 1) : r * (q + 1) + (xcd - r) * q) + off; }

struct Unit { const char* A; const char* B; int pm, pn, e, nrow; };

struct DenseSched {
    const char* A; const char* Bt; int nM, nN, nwg, G, c; size_t tstep;
    __device__ __forceinline__ void init(const void* A_, const void* Bt_, int M, int N, int K, int G_, int c_) { A = (const char*)A_; Bt = (const char*)Bt_; nM = M / BM; nN = N / BM; nwg = nM * nN; G = G_; c = c_; tstep = (size_t)BM * K * 2; }
    __device__ __forceinline__ bool next(int i, Unit& u) const {
        const long L = (long)i * G + c; if (L >= nwg) return false;
        const int wgid = xcd_remap((int)L, nwg);
        const int nig = WGM * nN, gid = wgid / nig, fm = gid * WGM, gsz = (nM - fm) < WGM ? (nM - fm) : WGM;
        u.pm = fm + ((wgid % nig) % gsz); u.pn = (wgid % nig) / gsz; u.e = 0; u.nrow = BM;
        u.A = A + (size_t)u.pm * tstep; u.B = Bt + (size_t)u.pn * tstep; return true;
    }
};
struct MoeSched {
    const char* A; const char* Bt; const volatile LAS int* tstart; const volatile LAS int* cnt; int NT, nwg, G, c; size_t tstep;
    __device__ __forceinline__ void init(const void* A_, const void* Bt_, const volatile LAS int* ts, const volatile LAS int* cn, int NT_, int K, int G_, int c_) {
        A = (const char*)A_; Bt = (const char*)Bt_; tstart = ts; cnt = cn; NT = NT_; nwg = ts[NE] * NT_; G = G_; c = c_; tstep = (size_t)BM * K * 2; }
    __device__ __forceinline__ bool next(int i, Unit& u) const {
        const long L = (long)i * G + c; if (L >= nwg) return false;
        const int wgid = xcd_remap((int)L, nwg);
        int e = 0;
#pragma unroll 1
        for (int j = 1; j < NE; ++j) e = (wgid >= tstart[j] * NT) ? j : e;
        const int t0 = tstart[e], nte = tstart[e + 1] - t0, local = wgid - t0 * NT;
        const int pn = local / nte, mt = local - pn * nte;
        u.e = e; u.pn = pn; u.pm = t0 + mt; u.nrow = cnt[e] - mt * BM;
        u.A = A + (size_t)u.pm * tstep; u.B = Bt + (size_t)(e * NT + pn) * tstep; return true;
    }
};

template <class Epi, class Sched>
__device__ __forceinline__ void gemm_phase(LAS unsigned char* lds, const int K, const Sched& S, const Epi& E) {
    const int tid = threadIdx.x, wid = __builtin_amdgcn_readfirstlane(tid >> 6), lane = tid & 63, wr = wid >> 2, wc = wid & 3, fr = lane & 15, fq = lane >> 4;
    const int nt = K / BK;
    unsigned voffA[2], voffB[2];
#pragma unroll
    for (int i = 0; i < 2; ++i) { int R, C; stage_rc(tid * 16 + i * 8192, R, C); const int Rb = Epi::PERM ? ((R & ~31) + perm32(R & 31)) : R;
        voffA[i] = (unsigned)(R * K + C) * 2u; voffB[i] = (unsigned)(Rb * K + C) * 2u; }
    const size_t kstep = (size_t)(BK * 2);
    const size_t hstep = (size_t)HALF * K * 2;
    const unsigned ldsw = (unsigned)wid * 1024u;
    const int aoff = lds_byte(wr * 64 + fr, fq * 8), boff = lds_byte(wc * 32 + fr, fq * 8);
#define PG8_SA(b, h) (((b) * 2 + (h)) * HTB)
#define PG8_SB(b, h) ((4 + (b) * 2 + (h)) * HTB)
#define PG8_STAGE(bufoff, gbase, voff) do { _Pragma("unroll") for (int _i = 0; _i < 2; ++_i) \
        __builtin_amdgcn_global_load_lds((const unsigned*)((const char*)(gbase) + (voff)[_i]), (LAS unsigned*)(lds + (bufoff) + ldsw + _i * 8192), 16, 0, 0); } while (0)
#define PG8_LDA(dst, b, h) do { _Pragma("unroll") for (int m = 0; m < 4; ++m) _Pragma("unroll") for (int k = 0; k < 2; ++k) dst[m][k] = *(const LAS bf16x8*)(lds + PG8_SA(b, h) + aoff + m * 2048 + k * 1024); } while (0)
#define PG8_LDB(dst, b, h) do { _Pragma("unroll") for (int n = 0; n < 2; ++n) _Pragma("unroll") for (int k = 0; k < 2; ++k) dst[n][k] = *(const LAS bf16x8*)(lds + PG8_SB(b, h) + boff + n * 2048 + k * 1024); } while (0)
#define PG8_MMA(ai, bj, At, Bt) do { __builtin_amdgcn_s_setprio(1); _Pragma("unroll") for (int m = 0; m < 4; ++m) _Pragma("unroll") for (int n = 0; n < 2; ++n) _Pragma("unroll") for (int k = 0; k < 2; ++k) \
        acc[ai][bj][m][n] = __builtin_amdgcn_mfma_f32_16x16x32_bf16(Bt[n][k], At[m][k], acc[ai][bj][m][n], 0, 0, 0); __builtin_amdgcn_s_setprio(0); } while (0)
#define PG8_WAIT_V(n) asm volatile("s_waitcnt vmcnt(" #n ")" ::: "memory")
#define PG8_WAIT_L(n) asm volatile("s_waitcnt lgkmcnt(" #n ")" ::: "memory")
#define PG8_BAR __builtin_amdgcn_s_barrier()
#define PG8_SCHED __builtin_amdgcn_sched_barrier(0)
    Unit cur, nxt; int ui = 0;
    if (!S.next(0, cur)) return;
    f32x4 acc[2][2][4][2];
#pragma unroll
    for (int a = 0; a < 2; ++a)
#pragma unroll
        for (int b = 0; b < 2; ++b)
#pragma unroll
            for (int m = 0; m < 4; ++m)
#pragma unroll
                for (int n = 0; n < 2; ++n) acc[a][b][m][n] = (f32x4){0.f, 0.f, 0.f, 0.f};
    bf16x8 At[4][2], B0[2][2], B1[2][2];
    const char* cA = cur.A; const char* cB = cur.B;
    PG8_STAGE(PG8_SB(0, 0), cB, voffB); PG8_STAGE(PG8_SB(0, 1), cB + hstep, voffB); PG8_STAGE(PG8_SA(0, 0), cA, voffA); PG8_STAGE(PG8_SA(0, 1), cA + hstep, voffA);
    if (wr == 1) PG8_BAR;
    PG8_WAIT_V(2); PG8_BAR;
    PG8_STAGE(PG8_SB(1, 0), cB + kstep, voffB); PG8_STAGE(PG8_SA(1, 0), cA + kstep, voffA); PG8_STAGE(PG8_SB(1, 1), cB + hstep + kstep, voffB);
    PG8_WAIT_V(6); PG8_BAR;
    for (;;) {
        const bool has_next = S.next(ui + 1, nxt);
        const char* nA = has_next ? nxt.A : cA; const char* nB = has_next ? nxt.B : cB;
        for (int t = 0; t < nt; t += 2) {
            const bool last = (t == nt - 2);
            const char* a1 = cA + (size_t)(t + 1) * kstep;
            const char* a2 = last ? nA : cA + (size_t)(t + 2) * kstep; const char* b2 = last ? nB : cB + (size_t)(t + 2) * kstep;
            const char* a3 = a2 + kstep; const char* b3 = b2 + kstep;
            PG8_LDB(B0, 0, 0); PG8_LDB(B1, 0, 1); PG8_SCHED; PG8_LDA(At, 0, 0); PG8_STAGE(PG8_SA(1, 1), a1 + hstep, voffA);
            PG8_WAIT_V(8); PG8_WAIT_L(0); PG8_BAR; PG8_MMA(0, 0, At, B0); PG8_MMA(0, 1, At, B1); PG8_BAR; PG8_SCHED;
            PG8_LDA(At, 0, 1); PG8_STAGE(PG8_SB(0, 0), b2, voffB); PG8_STAGE(PG8_SB(0, 1), b2 + hstep, voffB); PG8_STAGE(PG8_SA(0, 0), a2, voffA);
            PG8_WAIT_V(8); PG8_WAIT_L(0); PG8_BAR; PG8_MMA(1, 0, At, B0); PG8_MMA(1, 1, At, B1); PG8_BAR; PG8_SCHED;
            PG8_LDB(B0, 1, 0); PG8_LDB(B1, 1, 1); PG8_SCHED; PG8_LDA(At, 1, 0); PG8_STAGE(PG8_SA(0, 1), a2 + hstep, voffA);
            PG8_WAIT_V(8); PG8_WAIT_L(0); PG8_BAR; PG8_MMA(0, 0, At, B0); PG8_MMA(0, 1, At, B1); PG8_BAR; PG8_SCHED;
            PG8_LDA(At, 1, 1); PG8_STAGE(PG8_SB(1, 0), b3, voffB); PG8_STAGE(PG8_SB(1, 1), b3 + hstep, voffB); PG8_STAGE(PG8_SA(1, 0), a3, voffA);
            PG8_WAIT_V(8); PG8_WAIT_L(0); PG8_BAR; PG8_MMA(1, 0, At, B0); PG8_MMA(1, 1, At, B1); PG8_BAR; PG8_SCHED;
        }
        if (wr == 0) PG8_BAR;
        E(acc, cur, wr, wc, fr, fq);
        if (!has_next) break;
#pragma unroll
        for (int a = 0; a < 2; ++a)
#pragma unroll
            for (int b = 0; b < 2; ++b)
#pragma unroll
                for (int m = 0; m < 4; ++m)
#pragma unroll
                    for (int n = 0; n < 2; ++n) acc[a][b][m][n] = (f32x4){0.f, 0.f, 0.f, 0.f};
        cur = nxt; cA = nA; cB = nB; ++ui;
        if (wr == 1) PG8_BAR;
    }
    PG8_WAIT_V(0);
    PG8_BAR;
#undef PG8_SA
#undef PG8_SB
#undef PG8_STAGE
#undef PG8_LDA
#undef PG8_LDB
#undef PG8_MMA
#undef PG8_WAIT_V
#undef PG8_WAIT_L
#undef PG8_BAR
#undef PG8_SCHED
}

struct EpiProj {
    static constexpr bool PERM = true;
    unsigned char* ws; const float* bbg;
    __device__ __forceinline__ void operator()(const f32x4 (&acc)[2][2][4][2], const Unit& u, int wr, int wc, int fr, int fq) const {
        const int pn = u.pn; size_t off; int ld, t0, act = 0;
        if (pn < 4) { off = WS_GQ; ld = 1024; t0 = 0; } else if (pn < 8) { off = WS_GK; ld = 1024; t0 = 4; } else if (pn < 16) { off = WS_GV; ld = 2048; t0 = 8; }
        else if (pn < 24) { off = WS_GR; ld = 2048; t0 = 16; act = 1; } else if (pn < 28) { off = WS_AQ; ld = 1024; t0 = 24; } else if (pn < 32) { off = WS_AK; ld = 1024; t0 = 28; }
        else if (pn < 36) { off = WS_AV; ld = 1024; t0 = 32; } else if (pn < 44) { off = WS_SG; ld = 2048; t0 = 36; act = 2; } else { off = WS_SA; ld = 2048; t0 = 44; act = 3; }
        bf16* base = (bf16*)(ws + off);
        const int colt = (pn - t0) * BM + wc * 32 + 8 * fq, row0 = u.pm * BM + wr * 64 + fr;
        f32x4 bv[2][2];
#pragma unroll
        for (int bj = 0; bj < 2; ++bj)
#pragma unroll
            for (int n = 0; n < 2; ++n) bv[bj][n] = act >= 2 ? *(const f32x4*)(bbg + (act - 2) * D + colt + bj * HALF + 4 * n) : (f32x4){0.f, 0.f, 0.f, 0.f};
#pragma unroll
        for (int ai = 0; ai < 2; ++ai)
#pragma unroll
            for (int m = 0; m < 4; ++m) { bf16* rowp = base + (size_t)(row0 + ai * HALF + m * 16) * ld + colt;
#pragma unroll
                for (int bj = 0; bj < 2; ++bj) { f32x4 v0 = acc[ai][bj][m][0] + bv[bj][0], v1 = acc[ai][bj][m][1] + bv[bj][1];
                    if (act == 1) {
#pragma unroll
                        for (int j = 0; j < 4; ++j) { v0[j] = v0[j] * sigmoidf_(v0[j]); v1[j] = v1[j] * sigmoidf_(v1[j]); } }
                    else if (act >= 2) {
#pragma unroll
                        for (int j = 0; j < 4; ++j) { v0[j] = sigmoidf_(v0[j]); v1[j] = sigmoidf_(v1[j]); } }
                    u32x4 w; w.x = cvt_pk_bf16(v0[0], v0[1]); w.y = cvt_pk_bf16(v0[2], v0[3]); w.z = cvt_pk_bf16(v1[0], v1[1]); w.w = cvt_pk_bf16(v1[2], v1[3]);
                    *(u32x4*)(rowp + bj * HALF) = w; } }
    }
};
template <int MODE> struct EpiBranch {
    static constexpr bool PERM = true;
    const bf16* gate; const bf16* tin; bf16* out;
    __device__ __forceinline__ void operator()(const f32x4 (&acc)[2][2][4][2], const Unit& u, int wr, int wc, int fr, int fq) const {
        const int colt = u.pn * BM + wc * 32 + 8 * fq, row0 = u.pm * BM + wr * 64 + fr;
#pragma unroll
        for (int ai = 0; ai < 2; ++ai)
#pragma unroll
            for (int m = 0; m < 4; ++m) { const size_t ro = (size_t)(row0 + ai * HALF + m * 16) * D + colt;
#pragma unroll
                for (int bj = 0; bj < 2; ++bj) {
                    const u32x4 gq = *(const u32x4*)(gate + ro + bj * HALF);
                    u32x4 tq = (u32x4){0u, 0u, 0u, 0u}; if (MODE == 1) tq = *(const u32x4*)(tin + ro + bj * HALF);
                    float r[8];
#pragma unroll
                    for (int j = 0; j < 4; ++j) { r[j] = acc[ai][bj][m][0][j]; r[4 + j] = acc[ai][bj][m][1][j]; }
#pragma unroll
                    for (int j = 0; j < 4; ++j) { const unsigned gw = gq[j], tw = tq[j];
                        r[2 * j] = r[2 * j] * __uint_as_float(gw << 16) + __uint_as_float(tw << 16);
                        r[2 * j + 1] = r[2 * j + 1] * __uint_as_float(gw & 0xffff0000u) + __uint_as_float(tw & 0xffff0000u); }
                    u32x4 w; w.x = cvt_pk_bf16(r[0], r[1]); w.y = cvt_pk_bf16(r[2], r[3]); w.z = cvt_pk_bf16(r[4], r[5]); w.w = cvt_pk_bf16(r[6], r[7]);
                    *(u32x4*)(out + ro + bj * HALF) = w; } }
    }
};
struct EpiResid {
    static constexpr bool PERM = false;
    const float* x; float* out;
    __device__ __forceinline__ void operator()(const f32x4 (&acc)[2][2][4][2], const Unit& u, int wr, int wc, int fr, int fq) const {
        const int col0 = u.pn * BM + wc * 32 + 4 * fq, row0 = u.pm * BM + wr * 64 + fr;
#pragma unroll
        for (int ai = 0; ai < 2; ++ai)
#pragma unroll
            for (int m = 0; m < 4; ++m) { const size_t ro = (size_t)(row0 + ai * HALF + m * 16) * D + col0;
#pragma unroll
                for (int bj = 0; bj < 2; ++bj)
#pragma unroll
                    for (int n = 0; n < 2; ++n) { const f32x4 xv = *(const f32x4*)(x + ro + bj * HALF + n * 16); *(f32x4*)(out + ro + bj * HALF + n * 16) = xv + acc[ai][bj][m][n]; } }
    }
};
struct EpiSwiglu {
    static constexpr bool PERM = true;
    const float* bgate; const float* bup; bf16* hd;
    __device__ __forceinline__ void operator()(const f32x4 (&acc)[2][2][4][2], const Unit& u, int wr, int wc, int fr, int fq) const {
        const int col = u.pn * HALF + wc * 32 + 8 * fq; const size_t row0 = (size_t)u.pm * BM + wr * 64 + fr;
        const float* bg = bgate + (size_t)u.e * DFF + col; const float* bu = bup + (size_t)u.e * DFF + col;
        const f32x4 g0 = *(const f32x4*)bg, g1 = *(const f32x4*)(bg + 4), u0 = *(const f32x4*)bu, u1 = *(const f32x4*)(bu + 4);
#pragma unroll
        for (int ai = 0; ai < 2; ++ai)
#pragma unroll
            for (int m = 0; m < 4; ++m) {
                float r[8];
#pragma unroll
                for (int j = 0; j < 4; ++j) {
                    const float ga = fminf(acc[ai][0][m][0][j] + g0[j], 7.f), ua = fminf(fmaxf(acc[ai][1][m][0][j] + u0[j], -7.f), 7.f);
                    const float gb = fminf(acc[ai][0][m][1][j] + g1[j], 7.f), ub = fminf(fmaxf(acc[ai][1][m][1][j] + u1[j], -7.f), 7.f);
                    r[j] = (ua + 1.f) * (ga * sigmoidf_(1.702f * ga)); r[4 + j] = (ub + 1.f) * (gb * sigmoidf_(1.702f * gb)); }
                u32x4 w; w.x = cvt_pk_bf16(r[0], r[1]); w.y = cvt_pk_bf16(r[2], r[3]); w.z = cvt_pk_bf16(r[4], r[5]); w.w = cvt_pk_bf16(r[6], r[7]);
                *(u32x4*)(hd + (row0 + ai * HALF + m * 16) * DFF + col) = w; }
    }
};
struct EpiDown {
    static constexpr bool PERM = true;
    const float* bdown; const int* rpair; const float* rw; bf16* py;
    __device__ __forceinline__ void operator()(const f32x4 (&acc)[2][2][4][2], const Unit& u, int wr, int wc, int fr, int fq) const {
        const int colt = u.pn * BM + wc * 32 + 8 * fq; const size_t srow0 = (size_t)u.pm * BM + wr * 64 + fr;
        f32x4 bv[2][2];
#pragma unroll
        for (int bj = 0; bj < 2; ++bj)
#pragma unroll
            for (int n = 0; n < 2; ++n) bv[bj][n] = *(const f32x4*)(bdown + (size_t)u.e * D + colt + bj * HALF + 4 * n);
#pragma unroll
        for (int ai = 0; ai < 2; ++ai)
#pragma unroll
            for (int m = 0; m < 4; ++m) { const size_t srow = srow0 + ai * HALF + m * 16; const int pair = rpair[srow]; const float wgt = rw[srow];
                bf16* rowp = py + (size_t)pair * D + colt;
#pragma unroll
                for (int bj = 0; bj < 2; ++bj) { const f32x4 v0 = (acc[ai][bj][m][0] + bv[bj][0]) * wgt, v1 = (acc[ai][bj][m][1] + bv[bj][1]) * wgt;
                    u32x4 w; w.x = cvt_pk_bf16(v0[0], v0[1]); w.y = cvt_pk_bf16(v0[2], v0[3]); w.z = cvt_pk_bf16(v1[0], v1[1]); w.w = cvt_pk_bf16(v1[2], v1[3]);
                    *(u32x4*)(rowp + bj * HALF) = w; } }
    }
};
}

constexpr int NWAVES = 8;
constexpr int RING_BYTES = 131072, MISC_OFF = RING_BYTES + 320, LDS_BYTES = 147456;
constexpr int TAB_OFF = MISC_OFF + 128;

struct Frame {
    LAS unsigned char* lds; volatile LAS unsigned* MISC; unsigned* ctl; unsigned char* ws;
    int tid, lane, wave, vcu, G;
};
struct Args { const float* in[22]; float* out; unsigned char* ws; int ph_lo, ph_hi, li, pad; };

__device__ __forceinline__ void p0_transpose_item(const float* W, int K, int ldn, bf16* WT, int d0, int s0, int k0, LAS float* scr, int lane) {
#pragma unroll 8
    for (int i = 0; i < 32; ++i) { const int kk = 2 * i + (lane >> 5); scr[kk * 33 + (lane & 31)] = W[(size_t)(k0 + kk) * ldn + s0 + (lane & 31)]; }
    LDS_WAIT(); asm volatile("" ::: "memory");
    const int c = lane & 7;
#pragma unroll
    for (int j = 0; j < 4; ++j) { const int n = (lane >> 3) + 8 * j; const LAS float* s = scr + (8 * c) * 33 + n;
        u32x4 o; o.x = pk2(s[0 * 33], s[1 * 33]); o.y = pk2(s[2 * 33], s[3 * 33]); o.z = pk2(s[4 * 33], s[5 * 33]); o.w = pk2(s[6 * 33], s[7 * 33]);
        *(GAS u32x4*)(WT + (size_t)(d0 + n) * K + k0 + 8 * c) = o; }
    LDS_WAIT(); asm volatile("" ::: "memory");
}

__device__ __forceinline__ void p0_prologue(Frame& F, const Args& a) {
    LAS float* scr = (LAS float*)(F.lds + F.wave * 16384);
    const int gw = F.vcu * NWAVES + F.wave, NGW = F.G * NWAVES, lane = F.lane;
    const float* w_in = a.in[2];
    constexpr int I_IN = 32 * (NPROJ / 32), I_BG = 32 * 64, I_BA = 16 * 64, I_OUT = 32 * 64, I_E = 32 * 64;
    constexpr int I_MOE = NE * I_E;
    constexpr int NITEMS = I_IN + I_BG + I_BA + I_OUT + 3 * I_MOE;
    for (int it = gw; it < NITEMS; it += NGW) {
        int r = it;
        if (r < I_IN) { const int nb = r % (NPROJ / 32), kb = r / (NPROJ / 32), d0 = nb * 32; p0_transpose_item(w_in, D, IN_COLS, (bf16*)(F.ws + WS_WIN), d0, d0 < C_GLR ? d0 : d0 + 16, kb * 64, scr, lane); continue; } r -= I_IN;
        if (r < I_BG) { const int nb = r % 64, kb = r / 64; p0_transpose_item(a.in[10], GLA_V, D, (bf16*)(F.ws + WS_WBG), nb * 32, nb * 32, kb * 64, scr, lane); continue; } r -= I_BG;
        if (r < I_BA) { const int nb = r % 64, kb = r / 64; p0_transpose_item(a.in[11], ATT_W, D, (bf16*)(F.ws + WS_WBA), nb * 32, nb * 32, kb * 64, scr, lane); continue; } r -= I_BA;
        if (r < I_OUT) { const int nb = r % 64, kb = r / 64; p0_transpose_item(a.in[12], D, D, (bf16*)(F.ws + WS_WOUT), nb * 32, nb * 32, kb * 64, scr, lane); continue; } r -= I_OUT;
        if (r < 2 * I_MOE) {
            const int which = r / I_MOE; r -= which * I_MOE; const int e = r / I_E; r -= e * I_E; const int nb = r % 64, kb = r / 64, n0 = nb * 32;
            const float* W = (which ? a.in[18] : a.in[16]) + (size_t)e * D * DFF;
            p0_transpose_item(W, D, DFF, (bf16*)(F.ws + WS_GU) + (size_t)e * 2 * DFF * D, (n0 >> 7) * 256 + (n0 & 127) + which * 128, n0, kb * 64, scr, lane); continue; }
        r -= 2 * I_MOE;
        { const int e = r / I_E; r -= e * I_E; const int nb = r % 64, kb = r / 64;
          p0_transpose_item(a.in[20] + (size_t)e * DFF * D, DFF, D, (bf16*)(F.ws + WS_DN) + (size_t)e * D * DFF, nb * 32, nb * 32, kb * 64, scr, lane); }
    }
    const float* x = a.in[0]; const float* g1 = a.in[1]; bf16* XN = (bf16*)(F.ws + WS_XN); float* GLR = (float*)(F.ws + WS_GLR);
    for (int m = gw; m < S; m += NGW) {
        const GAS f32x4* xr = (const GAS f32x4*)(x + (size_t)m * D) + lane;
        f32x4 v[8]; float s = 0.f;
#pragma unroll
        for (int j = 0; j < 8; ++j) { v[j] = xr[64 * j]; s += (v[j].x * v[j].x + v[j].y * v[j].y) + (v[j].z * v[j].z + v[j].w * v[j].w); }
        const float rstd = rsqrtf(wave_sum(s) * (1.f / D) + 1e-6f);
        GAS u32x2* o8 = (GAS u32x2*)(XN + (size_t)m * D) + lane;
        float gl[16];
#pragma unroll
        for (int r = 0; r < 16; ++r) gl[r] = 0.f;
#pragma unroll
        for (int j = 0; j < 8; ++j) { const f32x4 gg = *((const GAS f32x4*)g1 + lane + 64 * j); v[j] = v[j] * rstd * gg;
            u32x2 w; w.x = pk2(v[j].x, v[j].y); w.y = pk2(v[j].z, v[j].w); o8[64 * j] = w;
#pragma unroll
            for (int i = 0; i < 4; ++i) { const GAS f32x4* wp = (const GAS f32x4*)(w_in + (size_t)(256 * j + 4 * lane + i) * IN_COLS + C_GLR);
#pragma unroll
                for (int q = 0; q < 4; ++q) { const f32x4 wv = wp[q]; gl[4 * q] = fmaf(v[j][i], wv.x, gl[4 * q]); gl[4 * q + 1] = fmaf(v[j][i], wv.y, gl[4 * q + 1]); gl[4 * q + 2] = fmaf(v[j][i], wv.z, gl[4 * q + 2]); gl[4 * q + 3] = fmaf(v[j][i], wv.w, gl[4 * q + 3]); } } }
        float mine = 0.f;
#pragma unroll
        for (int r = 0; r < 16; ++r) { const float t = wave_sum(gl[r]); mine = (lane == r) ? t : mine; }
        if (lane < 16) GLR[(size_t)m * 16 + lane] = mine;
    }
    { const float* g2 = a.in[13]; const float* wr = a.in[14]; float* WR = (float*)(F.ws + WS_WR);
      for (int i = (F.vcu * NWAVES * 64) + F.tid; i < D * NE; i += F.G * NWAVES * 64) WR[i] = g2[i >> 5] * wr[i]; }
}

__device__ __forceinline__ void p6_router(Frame& F, const Args& a) {
    const int gw = F.vcu * NWAVES + F.wave, NGW = F.G * NWAVES, lane = F.lane;
    const float* h1 = a.out; const float* g2 = a.in[13]; const float* WR = (const float*)(F.ws + WS_WR); const float* br = a.in[15];
    bf16* HN = (bf16*)(F.ws + WS_HN); float* topw = (float*)(F.ws + WS_TOPW); int* tope = (int*)(F.ws + WS_TOPE); int* tops = (int*)(F.ws + WS_TOPS);
    unsigned* cnt = F.ctl + CW_CNT;
    const int e = lane & 31, half = lane >> 5;
    for (int t = gw; t < S; t += NGW) {
        const float* xr = h1 + (size_t)t * D;
        const GAS f32x4* x4 = (const GAS f32x4*)xr + lane; f32x4 v[8]; float s = 0.f;
#pragma unroll
        for (int j = 0; j < 8; ++j) { v[j] = x4[64 * j]; s += (v[j].x * v[j].x + v[j].y * v[j].y) + (v[j].z * v[j].z + v[j].w * v[j].w); }
        const float rstd = rsqrtf(wave_sum(s) * (1.f / D) + 1e-6f);
        GAS u32x2* o8 = (GAS u32x2*)(HN + (size_t)t * D) + lane;
#pragma unroll
        for (int j = 0; j < 8; ++j) { const f32x4 gg = *((const GAS f32x4*)g2 + lane + 64 * j); const f32x4 y = v[j] * rstd * gg; u32x2 w; w.x = pk2(y.x, y.y); w.y = pk2(y.z, y.w); o8[64 * j] = w; }
        float acc = 0.f;
#pragma unroll 8
        for (int k = half; k < D; k += 2) acc = fmaf(xr[k], WR[(size_t)k * NE + e], acc);
        acc += __shfl_xor(acc, 32);
        const float logit = acc * rstd + br[e];
        float vals[4]; int idxs[4]; float cur = logit;
#pragma unroll
        for (int r = 0; r < 4; ++r) {
            float bv = cur; int bi = e;
#pragma unroll
            for (int o = 1; o < 32; o <<= 1) { const float ov = __shfl_xor(bv, o); const int oi = __shfl_xor(bi, o); if (ov > bv || (ov == bv && oi < bi)) { bv = ov; bi = oi; } }
            vals[r] = bv; idxs[r] = bi;
            if (e == bi) cur = -3.0e38f;
        }
        float ex[4], sum = 0.f;
#pragma unroll
        for (int r = 0; r < 4; ++r) { ex[r] = __expf(vals[r] - vals[0]); sum += ex[r]; }
#pragma unroll
        for (int r = 0; r < 4; ++r) {
            if (lane == r) { const int ee = idxs[r]; const int slot = (int)atomicAdd(&cnt[ee], 1u);
                topw[t * 4 + r] = ex[r] / sum; tope[t * 4 + r] = ee; tops[t * 4 + r] = slot; }
        }
    }
}
__device__ __forceinline__ void moe_table(Frame& F) {
    volatile LAS int* ts = (volatile LAS int*)(F.lds + TAB_OFF); volatile LAS int* cn = (volatile LAS int*)(F.lds + TAB_OFF + 256);
    __syncthreads();
    if (F.tid == 0) { int s = 0; for (int e = 0; e < NE; ++e) { const int c = (int)__hip_atomic_load(F.ctl + CW_CNT + e, __ATOMIC_RELAXED, __HIP_MEMORY_SCOPE_AGENT); cn[e] = c; ts[e] = s; s += (c + 255) >> 8; } ts[NE] = s; }
    __syncthreads();
}
__device__ __forceinline__ void p7_gather(Frame& F) {
    const int gw = F.vcu * NWAVES + F.wave, NGW = F.G * NWAVES, lane = F.lane;
    volatile LAS int* ts = (volatile LAS int*)(F.lds + TAB_OFF);
    const bf16* HN = (const bf16*)(F.ws + WS_HN); bf16* HNG = (bf16*)(F.ws + WS_HNG);
    const float* topw = (const float*)(F.ws + WS_TOPW); const int* tope = (const int*)(F.ws + WS_TOPE); const int* tops = (const int*)(F.ws + WS_TOPS);
    int* rpair = (int*)(F.ws + WS_RPAIR); float* rw = (float*)(F.ws + WS_RW);
    { volatile LAS int* cn = (volatile LAS int*)(F.lds + TAB_OFF + 256);
      for (int e = gw; e < NE; e += NGW) { const int c = cn[e], base = ts[e] * 256, padn = ((c + 255) & ~255) - c;
          for (int r = lane; r < padn; r += 64) { rpair[base + c + r] = S * 4; rw[base + c + r] = 0.f; } } }
    for (int t = gw; t < S; t += NGW) {
        const GAS u32x4* src = (const GAS u32x4*)(HN + (size_t)t * D) + lane; u32x4 v[4];
#pragma unroll
        for (int j = 0; j < 4; ++j) v[j] = src[64 * j];
#pragma unroll
        for (int r = 0; r < 4; ++r) { const int p = t * 4 + r; const int dst = ts[tope[p]] * 256 + tops[p];
            GAS u32x4* d = (GAS u32x4*)(HNG + (size_t)dst * D) + lane;
#pragma unroll
            for (int j = 0; j < 4; ++j) d[64 * j] = v[j];
            if (lane == 0) { rpair[dst] = p; rw[dst] = topw[p]; } }
    }
}
__device__ __forceinline__ void p10_combine(Frame& F, const Args& a) {
    const int gw = F.vcu * NWAVES + F.wave, NGW = F.G * NWAVES, lane = F.lane;
    const bf16* PY = (const bf16*)(F.ws + WS_PY); float* out = a.out;
    for (int t = gw; t < S; t += NGW) {
#pragma unroll
        for (int j = 0; j < 4; ++j) {
            float r[8]; { const f32x4 h0 = *(const GAS f32x4*)(out + (size_t)t * D + 512 * j + 8 * lane), h1v = *(const GAS f32x4*)(out + (size_t)t * D + 512 * j + 8 * lane + 4);
                r[0] = h0.x; r[1] = h0.y; r[2] = h0.z; r[3] = h0.w; r[4] = h1v.x; r[5] = h1v.y; r[6] = h1v.z; r[7] = h1v.w; }
#pragma unroll
            for (int k = 0; k < 4; ++k) { const u32x4 p = *(const GAS u32x4*)(PY + (size_t)(t * 4 + k) * D + 512 * j + 8 * lane);
#pragma unroll
                for (int q = 0; q < 4; ++q) { r[2 * q] += __uint_as_float(p[q] << 16); r[2 * q + 1] += __uint_as_float(p[q] & 0xffff0000u); } }
            *(GAS f32x4*)(out + (size_t)t * D + 512 * j + 8 * lane) = (f32x4){r[0], r[1], r[2], r[3]};
            *(GAS f32x4*)(out + (size_t)t * D + 512 * j + 8 * lane + 4) = (f32x4){r[4], r[5], r[6], r[7]};
        }
    }
}

__global__ void __launch_bounds__(NWAVES * 64, 2) fwd(Args args) {
    extern __shared__ __attribute__((aligned(16))) unsigned char lds_raw[];
    Frame F;
    F.lds = (LAS unsigned char*)lds_raw; F.MISC = (volatile LAS unsigned*)(F.lds + MISC_OFF);
    F.tid = threadIdx.x; F.lane = F.tid & 63; F.wave = __builtin_amdgcn_readfirstlane(F.tid >> 6);
    F.G = gridDim.x; { const int bx = blockIdx.x; F.vcu = (F.G % 8 == 0) ? (bx % 8) * (F.G / 8) + bx / 8 : bx; }
    F.ws = args.ws; F.ctl = (unsigned*)(args.ws + WS_CTL);
    for (int u = F.tid; u < (LDS_BYTES - RING_BYTES) / 4; u += NWAVES * 64) ((LAS unsigned*)(F.lds + RING_BYTES))[u] = 0u;
    __syncthreads();
    XcdBarrier bar = xcd_barrier_post(F.ctl + CW_BAR + args.li * XCD_BAR_WORDS, F.MISC + 8);
    const int lo = args.ph_lo, hi = args.ph_hi;
#define IN(k) (lo <= (k) && (k) < hi)
#define SEAM(k) do { if (IN(k) && IN((k) + 1)) xcd_barrier(bar); } while (0)
    unsigned char* ws = args.ws;
    if (IN(0)) { p0_prologue(F, args); } SEAM(0);
    if (IN(1)) { pg8::DenseSched Sc; Sc.init(ws + WS_XN, ws + WS_WIN, S, NPROJ, D, F.G, (int)blockIdx.x); pg8::EpiProj E{ws, args.in[9]};
        pg8::gemm_phase<pg8::EpiProj, pg8::DenseSched>(F.lds, D, Sc, E); } SEAM(1);
    SEAM(2);
    if (IN(3)) { pg8::DenseSched Sc; Sc.init(ws + WS_YG, ws + WS_WBG, S, D, GLA_V, F.G, (int)blockIdx.x); pg8::EpiBranch<0> E{(const bf16*)(ws + WS_SG), nullptr, (bf16*)(ws + WS_T)};
        pg8::gemm_phase<pg8::EpiBranch<0>, pg8::DenseSched>(F.lds, GLA_V, Sc, E); } SEAM(3);
    if (IN(4)) { pg8::DenseSched Sc; Sc.init(ws + WS_YA, ws + WS_WBA, S, D, ATT_W, F.G, (int)blockIdx.x); pg8::EpiBranch<1> E{(const bf16*)(ws + WS_SA), (const bf16*)(ws + WS_T), (bf16*)(ws + WS_MG)};
        pg8::gemm_phase<pg8::EpiBranch<1>, pg8::DenseSched>(F.lds, ATT_W, Sc, E); } SEAM(4);
    if (IN(5)) { pg8::DenseSched Sc; Sc.init(ws + WS_MG, ws + WS_WOUT, S, D, D, F.G, (int)blockIdx.x); pg8::EpiResid E{args.in[0], args.out};
        pg8::gemm_phase<pg8::EpiResid, pg8::DenseSched>(F.lds, D, Sc, E); } SEAM(5);
    if (IN(6)) { p6_router(F, args); } SEAM(6);
    if (IN(7)) { moe_table(F); p7_gather(F); } SEAM(7);
    if (IN(8)) { moe_table(F); pg8::MoeSched Sc; Sc.init(ws + WS_HNG, ws + WS_GU, (volatile LAS int*)(F.lds + TAB_OFF), (volatile LAS int*)(F.lds + TAB_OFF + 256), 16, D, F.G, (int)blockIdx.x);
        pg8::EpiSwiglu E{args.in[17], args.in[19], (bf16*)(ws + WS_HD)};
        pg8::gemm_phase<pg8::EpiSwiglu, pg8::MoeSched>(F.lds, D, Sc, E); } SEAM(8);
    if (IN(9)) { moe_table(F); pg8::MoeSched Sc; Sc.init(ws + WS_HD, ws + WS_DN, (volatile LAS int*)(F.lds + TAB_OFF), (volatile LAS int*)(F.lds + TAB_OFF + 256), 8, DFF, F.G, (int)blockIdx.x);
        pg8::EpiDown E{args.in[21], (const int*)(ws + WS_RPAIR), (const float*)(ws + WS_RW), (bf16*)(ws + WS_PY)};
        pg8::gemm_phase<pg8::EpiDown, pg8::MoeSched>(F.lds, DFF, Sc, E); } SEAM(9);
    if (IN(10)) { p10_combine(F, args); }
#undef IN
#undef SEAM
}

__global__ void __launch_bounds__(256) k_gla_scan(const bf16* __restrict__ GQ, const bf16* __restrict__ GK, const bf16* __restrict__ GV, const float* __restrict__ GLR,
                                                  const float* __restrict__ wgu, const float* __restrict__ bg, float* __restrict__ o) {
    __shared__ float red[2][4][8];
    const int h = blockIdx.x >> 6, vg = blockIdx.x & 63, dk = threadIdx.x, lane = dk & 63, wv = dk >> 6;
    const int c = h * GLA_DK + dk;
    float w[16];
#pragma unroll
    for (int r = 0; r < 16; ++r) w[r] = wgu[r * GLA_QK + c];
    const float b = bg[c];
    float s[8];
#pragma unroll
    for (int j = 0; j < 8; ++j) s[j] = 0.f;
    float glr[16], vq, vk, vv[8];
#pragma unroll
    for (int r = 0; r < 16; ++r) glr[r] = GLR[r];
    vq = bf2f(GQ[c]); vk = bf2f(GK[c]);
#pragma unroll
    for (int j = 0; j < 8; ++j) vv[j] = bf2f(GV[h * GLA_DV + vg * 8 + j]);
    for (int t = 0; t < S; ++t) {
        float nglr[16], nq, nk, nv[8];
        { const size_t tn = (size_t)(t + 1 < S ? t + 1 : t);
#pragma unroll
          for (int r = 0; r < 16; ++r) nglr[r] = GLR[tn * 16 + r];
          nq = bf2f(GQ[tn * GLA_QK + c]); nk = bf2f(GK[tn * GLA_QK + c]);
#pragma unroll
          for (int j = 0; j < 8; ++j) nv[j] = bf2f(GV[tn * GLA_V + h * GLA_DV + vg * 8 + j]); }
        float z = b;
#pragma unroll
        for (int r = 0; r < 16; ++r) z = fmaf(glr[r], w[r], z);
        const float a = __expf(log_sigmoid(z) * (1.f / 16.f));
        const float q = vq * 0.0625f, k = vk;
        float p[8];
#pragma unroll
        for (int j = 0; j < 8; ++j) { s[j] = fmaf(s[j], a, k * vv[j]); p[j] = q * s[j]; }
#pragma unroll
        for (int j = 0; j < 8; ++j) p[j] = wave_sum(p[j]);
        if (lane == 0) {
#pragma unroll
            for (int j = 0; j < 8; ++j) red[t & 1][wv][j] = p[j];
        }
        __syncthreads();
        if (dk < 8) o[(size_t)t * GLA_V + h * GLA_DV + vg * 8 + dk] = red[t & 1][0][dk] + red[t & 1][1][dk] + red[t & 1][2][dk] + red[t & 1][3][dk];
#pragma unroll
        for (int r = 0; r < 16; ++r) glr[r] = nglr[r];
        vq = nq; vk = nk;
#pragma unroll
        for (int j = 0; j < 8; ++j) vv[j] = nv[j];
    }
}
__global__ void __launch_bounds__(256) k_gla_out(const float* __restrict__ o, const bf16* __restrict__ GR, const float* __restrict__ g, bf16* __restrict__ y) {
    const int w = (blockIdx.x * blockDim.x + threadIdx.x) >> 6, lane = threadIdx.x & 63;
    const int t = w >> 2, h = w & 3;
    const float* orow = o + (size_t)t * GLA_V + h * GLA_DV; float v[8]; float s = 0.f;
#pragma unroll
    for (int i = 0; i < 8; ++i) { v[i] = orow[lane + 64 * i]; s += v[i] * v[i]; }
    s = wave_sum(s);
    const float r = rsqrtf(s / GLA_DV + 1e-6f);
#pragma unroll
    for (int i = 0; i < 8; ++i) { const int vv = lane + 64 * i; const size_t idx = (size_t)t * GLA_V + h * GLA_DV + vv; y[idx] = (bf16)f2bf(v[i] * r * g[vv] * bf2f(GR[idx])); }
}
__global__ void __launch_bounds__(64) k_attn(const bf16* __restrict__ AQ, const bf16* __restrict__ AK, const bf16* __restrict__ AV, const float* __restrict__ qg, const float* __restrict__ kg,
                                              const float* __restrict__ relb, float* __restrict__ sc, bf16* __restrict__ y) {
    __shared__ float kt[64][128];
    const int n = blockIdx.x >> 3, h = blockIdx.x & 7, i = threadIdx.x;
    float* scb = sc + (size_t)blockIdx.x * 576 * 64;
    float q[128];
    {
        const bf16* qr = AQ + (size_t)(n * 64 + i) * ATT_W + h * ATT_HD; float ss = 0.f;
#pragma unroll
        for (int d = 0; d < 128; ++d) { q[d] = bf2f(qr[d]); ss += q[d] * q[d]; }
        const float r = rsqrtf(ss / 128.f + 1e-6f) * 0.08838834764831845f;
#pragma unroll
        for (int d = 0; d < 128; ++d) q[d] = q[d] * r * qg[d];
    }
    float mx = -3.0e38f;
    for (int w = 0; w < 9; ++w) {
        const int kc = n - 8 + w;
        if (kc < 0) continue;
        __syncthreads();
        {
            const bf16* kr = AK + (size_t)(kc * 64 + i) * ATT_W + h * ATT_HD; float ss = 0.f;
            for (int d = 0; d < 128; ++d) { const float v = bf2f(kr[d]); ss += v * v; }
            const float r = rsqrtf(ss / 128.f + 1e-6f);
            for (int d = 0; d < 128; ++d) kt[i][d] = bf2f(kr[d]) * r * kg[d];
        }
        __syncthreads();
        for (int j = 0; j < 64; ++j) {
            float s = 0.f;
#pragma unroll
            for (int d = 0; d < 128; d += 4) { const float4 kv = *(const float4*)&kt[j][d]; s = fmaf(q[d], kv.x, s); s = fmaf(q[d + 1], kv.y, s); s = fmaf(q[d + 2], kv.z, s); s = fmaf(q[d + 3], kv.w, s); }
            int rel = 64 * (8 - w) + i - j; rel = rel < -128 ? -128 : (rel > 128 ? 128 : rel);
            s += relb[h * 257 + rel + 128];
            scb[(w * 64 + j) * 64 + i] = s;
            mx = fmaxf(mx, s);
        }
    }
    float l = 0.f;
    float o[128];
#pragma unroll
    for (int d = 0; d < 128; ++d) o[d] = 0.f;
    for (int w = 0; w < 9; ++w) {
        const int kc = n - 8 + w;
        if (kc < 0) continue;
        __syncthreads();
        { const bf16* vr = AV + (size_t)(kc * 64 + i) * ATT_W + h * ATT_HD; for (int d = 0; d < 128; ++d) kt[i][d] = bf2f(vr[d]); }
        __syncthreads();
        for (int j = 0; j < 64; ++j) {
            const float p = __expf(scb[(w * 64 + j) * 64 + i] - mx);
            l += p;
#pragma unroll
            for (int d = 0; d < 128; d += 4) { const float4 vv = *(const float4*)&kt[j][d]; o[d] = fmaf(p, vv.x, o[d]); o[d + 1] = fmaf(p, vv.y, o[d + 1]); o[d + 2] = fmaf(p, vv.z, o[d + 2]); o[d + 3] = fmaf(p, vv.w, o[d + 3]); }
        }
    }
    const float inv = 1.f / l;
    bf16* yr = y + (size_t)(n * 64 + i) * ATT_W + h * ATT_HD;
#pragma unroll
    for (int d = 0; d < 128; d += 2) *(unsigned*)(yr + d) = pk2(o[d] * inv, o[d + 1] * inv);
}

extern "C" void kernel_launch(void* const* d_in, const int* in_sizes, int n_in, void* d_out, int out_size, void* d_ws, size_t ws_size, hipStream_t stream) {
    static int grid = 0;
    if (grid == 0) {
        if (n_in != 22 || out_size != S * D || ws_size < WS_END) { fprintf(stderr, "kernel_launch: unexpected problem (n_in %d out %d ws %zu)\n", n_in, out_size, ws_size); grid = -1; return; }
        int dev = 0, cus = 0, per_cu = 0;
        if (hipGetDevice(&dev) != hipSuccess || hipDeviceGetAttribute(&cus, hipDeviceAttributeMultiprocessorCount, dev) != hipSuccess) { grid = -1; return; }
        if (hipFuncSetAttribute((const void*)fwd, hipFuncAttributeMaxDynamicSharedMemorySize, LDS_BYTES) != hipSuccess) { fprintf(stderr, "kernel_launch: hipFuncSetAttribute failed\n"); grid = -1; return; }
        if (hipOccupancyMaxActiveBlocksPerMultiprocessor(&per_cu, (const void*)fwd, NWAVES * 64, LDS_BYTES) != hipSuccess || per_cu < 1) fprintf(stderr, "kernel_launch: occupancy query says %d\n", per_cu);
        (void)hipGetLastError();
        grid = cus;
    }
    if (grid < 0) return;
    (void)hipMemsetAsync((char*)d_ws + WS_CTL, 0, CTL_ZERO_BYTES, stream);
    Args a{};
    for (int i = 0; i < 22; ++i) a.in[i] = (const float*)d_in[i];
    a.out = (float*)d_out; a.ws = (unsigned char*)d_ws;
    unsigned char* ws = (unsigned char*)d_ws;
    a.ph_lo = 0; a.ph_hi = 2; a.li = 0;
    hipLaunchKernelGGL(fwd, dim3(grid), dim3(NWAVES * 64), LDS_BYTES, stream, a);
    hipLaunchKernelGGL(k_gla_scan, dim3(256), dim3(256), 0, stream, (const bf16*)(ws + WS_GQ), (const bf16*)(ws + WS_GK), (const bf16*)(ws + WS_GV), (const float*)(ws + WS_GLR),
                       (const float*)d_in[3], (const float*)d_in[4], (float*)(ws + WS_OG));
    hipLaunchKernelGGL(k_gla_out, dim3(S * GLA_H / 4), dim3(256), 0, stream, (const float*)(ws + WS_OG), (const bf16*)(ws + WS_GR), (const float*)d_in[5], (bf16*)(ws + WS_YG));
    hipLaunchKernelGGL(k_attn, dim3(NCH * ATT_H), dim3(64), 0, stream, (const bf16*)(ws + WS_AQ), (const bf16*)(ws + WS_AK), (const bf16*)(ws + WS_AV), (const float*)d_in[6], (const float*)d_in[7],
                       (const float*)d_in[8], (float*)(ws + WS_SC), (bf16*)(ws + WS_YA));
    a.ph_lo = 3; a.ph_hi = 11; a.li = 1;
    hipLaunchKernelGGL(fwd, dim3(grid), dim3(NWAVES * 64), LDS_BYTES, stream, a);
}
```

```cpp
#include <hip/hip_runtime.h>
#include <stdint.h>
#include <cstdio>

constexpr int S = 8192, D = 2048;
constexpr int GLA_H = 4, GLA_DK = 256, GLA_DV = 512, GLA_QK = 1024, GLA_V = 2048;
constexpr int ATT_H = 8, ATT_HD = 128, ATT_W = 1024, NCH = S / 64;
constexpr int NE = 32, DFF = 2048;
constexpr int IN_COLS = 13328, C_GLR = 6144;
constexpr int NPROJ = 13312;
constexpr int MAXROWS = 32768 + NE * 256;

constexpr size_t MiB = 1u << 20;
constexpr size_t WS_CTL = 0, CTL_ZERO_BYTES = 1 * MiB;
constexpr size_t WS_TOPW = 1 * MiB, WS_TOPE = WS_TOPW + 128 * 1024, WS_TOPS = WS_TOPE + 128 * 1024, WS_RPAIR = WS_TOPS + 128 * 1024, WS_RW = WS_RPAIR + 256 * 1024;
constexpr size_t WS_GLR = 2 * MiB, WS_WR = 3 * MiB;
constexpr size_t WS_WIN = 8 * MiB, WS_WBG = 60 * MiB, WS_WBA = 68 * MiB, WS_WOUT = 72 * MiB, WS_GU = 80 * MiB, WS_DN = 592 * MiB;
constexpr size_t WS_XN = 848 * MiB, WS_GQ = 880 * MiB, WS_GK = 896 * MiB, WS_GV = 912 * MiB, WS_GR = 944 * MiB, WS_AQ = 976 * MiB, WS_AK = 992 * MiB, WS_AV = 1008 * MiB;
constexpr size_t WS_SG = 1024 * MiB, WS_SA = 1056 * MiB, WS_YG = 1088 * MiB, WS_YA = 1120 * MiB, WS_T = 1136 * MiB, WS_MG = 1168 * MiB, WS_HN = 1200 * MiB;
constexpr size_t WS_HNG = 1232 * MiB, WS_HD = 1392 * MiB, WS_PY = 1552 * MiB, WS_OG = 1681 * MiB, WS_QH = 1745 * MiB, WS_KIMG = 1761 * MiB, WS_VIMG = 1777 * MiB, WS_END = 1793 * MiB;
constexpr int CW_CNT = 64;
constexpr int CW_BAR = 4096;

typedef unsigned short bf16;
typedef short bf16x8 __attribute__((ext_vector_type(8)));
typedef float f32x4 __attribute__((ext_vector_type(4)));
typedef unsigned u32x4 __attribute__((ext_vector_type(4)));
typedef unsigned u32x2 __attribute__((ext_vector_type(2)));
#define LAS __attribute__((address_space(3)))
#define GAS __attribute__((address_space(1)))
__device__ __forceinline__ float bf2f(bf16 v) { return __uint_as_float((unsigned)v << 16); }
__device__ __forceinline__ unsigned f2bf(float f) { unsigned u = __float_as_uint(f); return (u + 0x7fffu + ((u >> 16) & 1u)) >> 16; }
__device__ __forceinline__ unsigned pk2(float lo, float hi) { return f2bf(lo) | (f2bf(hi) << 16); }
__device__ __forceinline__ unsigned cvt_pk_bf16(float lo, float hi) { unsigned r; asm volatile("v_cvt_pk_bf16_f32 %0, %1, %2" : "=v"(r) : "v"(lo), "v"(hi)); return r; }
__device__ __forceinline__ float wave_sum(float v) {
#pragma unroll
    for (int o = 1; o < 64; o <<= 1) v += __shfl_xor(v, o);
    return v;
}
__device__ __forceinline__ float sigmoidf_(float x) { return 1.f / (1.f + __expf(-x)); }
__device__ __forceinline__ float log_sigmoid(float z) { return fminf(z, 0.f) - log1pf(__expf(-fabsf(z))); }
#define LDS_WAIT() asm volatile("s_waitcnt lgkmcnt(0)" ::: "memory")
#define VM_WAIT() asm volatile("s_waitcnt vmcnt(0)" ::: "memory")

#define XB_TMO      128
#define XB_XCNT(j)  (256  + 64 * (j))
#define XB_XSUB(j)  (1280 + 64 * (j))
#define XB_XGEN(j)  (2304 + 64 * (j))
#define XB_TOP      3328
#define XB_TOPGEN   3392
#define XCD_BAR_WORDS 3456
#define XB_SPIN_CAP (1u << 18)
__device__ __forceinline__ unsigned xb_ld(unsigned* p)              { return __hip_atomic_load(p, __ATOMIC_RELAXED, __HIP_MEMORY_SCOPE_AGENT); }
__device__ __forceinline__ unsigned xb_add(unsigned* p, unsigned v) { return __hip_atomic_fetch_add(p, v, __ATOMIC_RELAXED, __HIP_MEMORY_SCOPE_AGENT); }
__device__ __forceinline__ unsigned xb_xcc_id() { return (unsigned)__builtin_amdgcn_s_getreg((3 << 11) | 20) & 0xFu; }
#define XB_SPIN(cond, bar) do { unsigned _sp = 0; while (cond) { __builtin_amdgcn_s_sleep(1); \
    if ((++_sp & 255u) == 0u) { if (xb_ld(&(bar)[XB_TMO])) break; if (_sp > XB_SPIN_CAP) { atomicAdd(&(bar)[XB_TMO], 1u); break; } } } } while (0)
struct XcdBarrier { unsigned* bar; unsigned x; volatile LAS unsigned* st; };
__device__ __forceinline__ XcdBarrier xcd_barrier_post(unsigned* bar, volatile LAS unsigned* st) {
    XcdBarrier b; b.bar = bar; b.x = xb_xcc_id(); b.st = st;
    if (threadIdx.x == 0) (void)xb_add(&bar[XB_XCNT(b.x)], 1u);
    return b;
}
__device__ __forceinline__ void xcd_barrier_complete(unsigned* bar, unsigned x, unsigned& nloc, unsigned& nx) {
    const unsigned G = gridDim.x * gridDim.y * gridDim.z;
    unsigned sum, cnt, mine, sp = 0u;
    for (;;) {
        sum = 0u; cnt = 0u; mine = 0u;
#pragma unroll
        for (unsigned j = 0; j < 16; ++j) { const unsigned c = xb_ld(&bar[XB_XCNT(j)]); sum += c; cnt += (c > 0u) ? 1u : 0u; mine = (j == x) ? c : mine; }
        if (sum == G) break;
        __builtin_amdgcn_s_sleep(1);
        if ((++sp & 255u) == 0u) { if (xb_ld(&bar[XB_TMO])) break; if (sp > XB_SPIN_CAP) { atomicAdd(&bar[XB_TMO], 1u); break; } }
    }
    nloc = mine > 0u ? mine : 1u; nx = cnt > 0u ? cnt : 1u;
}
__device__ __forceinline__ void xcd_barrier(const XcdBarrier& b) {
    asm volatile("s_waitcnt vmcnt(0)" ::: "memory");
    __syncthreads();
    if (threadIdx.x == 0) {
        unsigned* bar = b.bar;
        __builtin_amdgcn_s_waitcnt(0);
        unsigned nloc = b.st[0], nx = b.st[1];
        if (nloc == 0u) { xcd_barrier_complete(bar, b.x, nloc, nx); b.st[0] = nloc; b.st[1] = nx; }
        const unsigned old = xb_add(&bar[XB_XSUB(b.x)], 1u);
        const unsigned gen = old / nloc;
        if (old + 1u == (gen + 1u) * nloc) {
            __builtin_amdgcn_fence(__ATOMIC_RELEASE, "agent");
            asm volatile("s_waitcnt vmcnt(0)" ::: "memory");
            const unsigned og = xb_add(&bar[XB_TOP], 1u);
            const unsigned tg = og / nx;
            if (og + 1u == (tg + 1u) * nx) xb_add(&bar[XB_TOPGEN], 1u);
            else XB_SPIN(xb_ld(&bar[XB_TOPGEN]) == tg, bar);
            __builtin_amdgcn_fence(__ATOMIC_ACQUIRE, "agent");
            xb_add(&bar[XB_XGEN(b.x)], 1u);
            asm volatile("s_waitcnt vmcnt(0)" ::: "memory");
        } else {
            XB_SPIN(xb_ld(&bar[XB_XGEN(b.x)]) == gen, bar);
            __builtin_amdgcn_fence(__ATOMIC_ACQUIRE, "agent");
            asm volatile("s_waitcnt vmcnt(0)" ::: "memory");
        }
    }
    __syncthreads();
}

namespace pg8 {
constexpr int BM = 256, BK = 64, HALF = 128, HTB = HALF * BK * 2, STAGE_BYTES = 8 * HTB, NXCD = 8, WGM = 8;
__host__ __device__ __forceinline__ int lds_byte(int r, int c) { const int st = (r >> 4) * 2 + (c >> 5), rr = r & 15, cc = c & 31, ob = rr * 64 + cc * 2; return st * 1024 + (ob ^ (((ob >> 9) & 1) << 5)); }
__host__ __device__ __forceinline__ void stage_rc(int b, int& R, int& C) { const int st = b / 1024, sb = b % 1024, swz = sb ^ (((sb >> 9) & 1) << 5); R = (st >> 1) * 16 + swz / 64; C = (st & 1) * 32 + (swz % 64) / 2; }
__host__ __device__ __forceinline__ int perm32(int rho) { const int n = rho >> 4, i = rho & 15; return 8 * (i >> 2) + 4 * n + (i & 3); }
__device__ __forceinline__ int xcd_remap(int wgid, int nwg) { const int q = nwg / NXCD, r = nwg % NXCD, xcd = wgid % NXCD, off = wgid / NXCD; return (xcd < r ? xcd * (q + 1) : r * (q + 1) + (xcd - r) * q) + off; }

struct Unit { const char* A; const char* B; int pm, pn, e, nrow; };

struct DenseSched {
    const char* A; const char* Bt; int nM, nN, nwg, G, c; size_t tstep;
    __device__ __forceinline__ void init(const void* A_, const void* Bt_, int M, int N, int K, int G_, int c_) { A = (const char*)A_; Bt = (const char*)Bt_; nM = M / BM; nN = N / BM; nwg = nM * nN; G = G_; c = c_; tstep = (size_t)BM * K * 2; }
    __device__ __forceinline__ bool next(int i, Unit& u) const {
        const long L = (long)i * G + c; if (L >= nwg) return false;
        const int wgid = xcd_remap((int)L, nwg);
        const int nig = WGM * nN, gid = wgid / nig, fm = gid * WGM, gsz = (nM - fm) < WGM ? (nM - fm) : WGM;
        u.pm = fm + ((wgid % nig) % gsz); u.pn = (wgid % nig) / gsz; u.e = 0; u.nrow = BM;
        u.A = A + (size_t)u.pm * tstep; u.B = Bt + (size_t)u.pn * tstep; return true;
    }
};
struct MoeSched {
    const char* A; const char* Bt; const volatile LAS int* tstart; const volatile LAS int* cnt; int NT, nwg, G, c; size_t tstep;
    __device__ __forceinline__ void init(const void* A_, const void* Bt_, const volatile LAS int* ts, const volatile LAS int* cn, int NT_, int K, int G_, int c_) {
        A = (const char*)A_; Bt = (const char*)Bt_; tstart = ts; cnt = cn; NT = NT_; nwg = ts[NE] * NT_; G = G_; c = c_; tstep = (size_t)BM * K * 2; }
    __device__ __forceinline__ bool next(int i, Unit& u) const {
        const long L = (long)i * G + c; if (L >= nwg) return false;
        const int wgid = xcd_remap((int)L, nwg);
        int e = 0;
#pragma unroll 1
        for (int j = 1; j < NE; ++j) e = (wgid >= tstart[j] * NT) ? j : e;
        const int t0 = tstart[e], nte = tstart[e + 1] - t0, local = wgid - t0 * NT;
        const int pn = local / nte, mt = local - pn * nte;
        u.e = e; u.pn = pn; u.pm = t0 + mt; u.nrow = cnt[e] - mt * BM;
        u.A = A + (size_t)u.pm * tstep; u.B = Bt + (size_t)(e * NT + pn) * tstep; return true;
    }
};

template <class Epi, class Sched>
__device__ __forceinline__ void gemm_phase(LAS unsigned char* lds, const int K, const Sched& S, const Epi& E) {
    const int tid = threadIdx.x, wid = __builtin_amdgcn_readfirstlane(tid >> 6), lane = tid & 63, wr = wid >> 2, wc = wid & 3, fr = lane & 15, fq = lane >> 4;
    const int nt = K / BK;
    unsigned voffA[2], voffB[2];
#pragma unroll
    for (int i = 0; i < 2; ++i) { int R, C; stage_rc(tid * 16 + i * 8192, R, C); const int Rb = Epi::PERM ? ((R & ~31) + perm32(R & 31)) : R;
        voffA[i] = (unsigned)(R * K + C) * 2u; voffB[i] = (unsigned)(Rb * K + C) * 2u; }
    const size_t kstep = (size_t)(BK * 2);
    const size_t hstep = (size_t)HALF * K * 2;
    const unsigned ldsw = (unsigned)wid * 1024u;
    const int aoff = lds_byte(wr * 64 + fr, fq * 8), boff = lds_byte(wc * 32 + fr, fq * 8);
#define PG8_SA(b, h) (((b) * 2 + (h)) * HTB)
#define PG8_SB(b, h) ((4 + (b) * 2 + (h)) * HTB)
#define PG8_STAGE(bufoff, gbase, voff) do { _Pragma("unroll") for (int _i = 0; _i < 2; ++_i) \
        __builtin_amdgcn_global_load_lds((const unsigned*)((const char*)(gbase) + (voff)[_i]), (LAS unsigned*)(lds + (bufoff) + ldsw + _i * 8192), 16, 0, 0); } while (0)
#define PG8_LDA(dst, b, h) do { _Pragma("unroll") for (int m = 0; m < 4; ++m) _Pragma("unroll") for (int k = 0; k < 2; ++k) dst[m][k] = *(const LAS bf16x8*)(lds + PG8_SA(b, h) + aoff + m * 2048 + k * 1024); } while (0)
#define PG8_LDB(dst, b, h) do { _Pragma("unroll") for (int n = 0; n < 2; ++n) _Pragma("unroll") for (int k = 0; k < 2; ++k) dst[n][k] = *(const LAS bf16x8*)(lds + PG8_SB(b, h) + boff + n * 2048 + k * 1024); } while (0)
#define PG8_MMA(ai, bj, At, Bt) do { __builtin_amdgcn_s_setprio(1); _Pragma("unroll") for (int m = 0; m < 4; ++m) _Pragma("unroll") for (int n = 0; n < 2; ++n) _Pragma("unroll") for (int k = 0; k < 2; ++k) \
        acc[ai][bj][m][n] = __builtin_amdgcn_mfma_f32_16x16x32_bf16(Bt[n][k], At[m][k], acc[ai][bj][m][n], 0, 0, 0); __builtin_amdgcn_s_setprio(0); } while (0)
#define PG8_WAIT_V(n) asm volatile("s_waitcnt vmcnt(" #n ")" ::: "memory")
#define PG8_WAIT_L(n) asm volatile("s_waitcnt lgkmcnt(" #n ")" ::: "memory")
#define PG8_BAR __builtin_amdgcn_s_barrier()
#define PG8_SCHED __builtin_amdgcn_sched_barrier(0)
    Unit cur, nxt; int ui = 0;
    if (!S.next(0, cur)) return;
    f32x4 acc[2][2][4][2];
#pragma unroll
    for (int a = 0; a < 2; ++a)
#pragma unroll
        for (int b = 0; b < 2; ++b)
#pragma unroll
            for (int m = 0; m < 4; ++m)
#pragma unroll
                for (int n = 0; n < 2; ++n) acc[a][b][m][n] = (f32x4){0.f, 0.f, 0.f, 0.f};
    bf16x8 At[4][2], B0[2][2], B1[2][2];
    const char* cA = cur.A; const char* cB = cur.B;
    PG8_STAGE(PG8_SB(0, 0), cB, voffB); PG8_STAGE(PG8_SB(0, 1), cB + hstep, voffB); PG8_STAGE(PG8_SA(0, 0), cA, voffA); PG8_STAGE(PG8_SA(0, 1), cA + hstep, voffA);
    if (wr == 1) PG8_BAR;
    PG8_WAIT_V(2); PG8_BAR;
    PG8_STAGE(PG8_SB(1, 0), cB + kstep, voffB); PG8_STAGE(PG8_SA(1, 0), cA + kstep, voffA); PG8_STAGE(PG8_SB(1, 1), cB + hstep + kstep, voffB);
    PG8_WAIT_V(6); PG8_BAR;
    for (;;) {
        const bool has_next = S.next(ui + 1, nxt);
        const char* nA = has_next ? nxt.A : cA; const char* nB = has_next ? nxt.B : cB;
        for (int t = 0; t < nt; t += 2) {
            const bool last = (t == nt - 2);
            const char* a1 = cA + (size_t)(t + 1) * kstep;
            const char* a2 = last ? nA : cA + (size_t)(t + 2) * kstep; const char* b2 = last ? nB : cB + (size_t)(t + 2) * kstep;
            const char* a3 = a2 + kstep; const char* b3 = b2 + kstep;
            PG8_LDB(B0, 0, 0); PG8_LDB(B1, 0, 1); PG8_SCHED; PG8_LDA(At, 0, 0); PG8_STAGE(PG8_SA(1, 1), a1 + hstep, voffA);
            PG8_WAIT_V(8); PG8_WAIT_L(0); PG8_BAR; PG8_MMA(0, 0, At, B0); PG8_MMA(0, 1, At, B1); PG8_BAR; PG8_SCHED;
            PG8_LDA(At, 0, 1); PG8_STAGE(PG8_SB(0, 0), b2, voffB); PG8_STAGE(PG8_SB(0, 1), b2 + hstep, voffB); PG8_STAGE(PG8_SA(0, 0), a2, voffA);
            PG8_WAIT_V(8); PG8_WAIT_L(0); PG8_BAR; PG8_MMA(1, 0, At, B0); PG8_MMA(1, 1, At, B1); PG8_BAR; PG8_SCHED;
            PG8_LDB(B0, 1, 0); PG8_LDB(B1, 1, 1); PG8_SCHED; PG8_LDA(At, 1, 0); PG8_STAGE(PG8_SA(0, 1), a2 + hstep, voffA);
            PG8_WAIT_V(8); PG8_WAIT_L(0); PG8_BAR; PG8_MMA(0, 0, At, B0); PG8_MMA(0, 1, At, B1); PG8_BAR; PG8_SCHED;
            PG8_LDA(At, 1, 1); PG8_STAGE(PG8_SB(1, 0), b3, voffB); PG8_STAGE(PG8_SB(1, 1), b3 + hstep, voffB); PG8_STAGE(PG8_SA(1, 0), a3, voffA);
            PG8_WAIT_V(8); PG8_WAIT_L(0); PG8_BAR; PG8_MMA(1, 0, At, B0); PG8_MMA(1, 1, At, B1); PG8_BAR; PG8_SCHED;
        }
        if (wr == 0) PG8_BAR;
        E(acc, cur, wr, wc, fr, fq);
        if (!has_next) break;
#pragma unroll
        for (int a = 0; a < 2; ++a)
#pragma unroll
            for (int b = 0; b < 2; ++b)
#pragma unroll
                for (int m = 0; m < 4; ++m)
#pragma unroll
                    for (int n = 0; n < 2; ++n) acc[a][b][m][n] = (f32x4){0.f, 0.f, 0.f, 0.f};
        cur = nxt; cA = nA; cB = nB; ++ui;
        if (wr == 1) PG8_BAR;
    }
    PG8_WAIT_V(0);
    PG8_BAR;
#undef PG8_SA
#undef PG8_SB
#undef PG8_STAGE
#undef PG8_LDA
#undef PG8_LDB
#undef PG8_MMA
#undef PG8_WAIT_V
#undef PG8_WAIT_L
#undef PG8_BAR
#undef PG8_SCHED
}

struct EpiProj {
    static constexpr bool PERM = true;
    unsigned char* ws; const float* bbg;
    __device__ __forceinline__ void operator()(const f32x4 (&acc)[2][2][4][2], const Unit& u, int wr, int wc, int fr, int fq) const {
        const int pn = u.pn; size_t off; int ld, t0, act = 0;
        if (pn < 4) { off = WS_GQ; ld = 1024; t0 = 0; } else if (pn < 8) { off = WS_GK; ld = 1024; t0 = 4; } else if (pn < 16) { off = WS_GV; ld = 2048; t0 = 8; }
        else if (pn < 24) { off = WS_GR; ld = 2048; t0 = 16; act = 1; } else if (pn < 28) { off = WS_AQ; ld = 1024; t0 = 24; } else if (pn < 32) { off = WS_AK; ld = 1024; t0 = 28; }
        else if (pn < 36) { off = WS_AV; ld = 1024; t0 = 32; } else if (pn < 44) { off = WS_SG; ld = 2048; t0 = 36; act = 2; } else { off = WS_SA; ld = 2048; t0 = 44; act = 3; }
        bf16* base = (bf16*)(ws + off);
        const int colt = (pn - t0) * BM + wc * 32 + 8 * fq, row0 = u.pm * BM + wr * 64 + fr;
        f32x4 bv[2][2];
#pragma unroll
        for (int bj = 0; bj < 2; ++bj)
#pragma unroll
            for (int n = 0; n < 2; ++n) bv[bj][n] = act >= 2 ? *(const f32x4*)(bbg + (act - 2) * D + colt + bj * HALF + 4 * n) : (f32x4){0.f, 0.f, 0.f, 0.f};
#pragma unroll
        for (int ai = 0; ai < 2; ++ai)
#pragma unroll
            for (int m = 0; m < 4; ++m) { bf16* rowp = base + (size_t)(row0 + ai * HALF + m * 16) * ld + colt;
#pragma unroll
                for (int bj = 0; bj < 2; ++bj) { f32x4 v0 = acc[ai][bj][m][0] + bv[bj][0], v1 = acc[ai][bj][m][1] + bv[bj][1];
                    if (act == 1) {
#pragma unroll
                        for (int j = 0; j < 4; ++j) { v0[j] = v0[j] * sigmoidf_(v0[j]); v1[j] = v1[j] * sigmoidf_(v1[j]); } }
                    else if (act >= 2) {
#pragma unroll
                        for (int j = 0; j < 4; ++j) { v0[j] = sigmoidf_(v0[j]); v1[j] = sigmoidf_(v1[j]); } }
                    u32x4 w; w.x = cvt_pk_bf16(v0[0], v0[1]); w.y = cvt_pk_bf16(v0[2], v0[3]); w.z = cvt_pk_bf16(v1[0], v1[1]); w.w = cvt_pk_bf16(v1[2], v1[3]);
                    *(u32x4*)(rowp + bj * HALF) = w; } }
    }
};
template <int MODE> struct EpiBranch {
    static constexpr bool PERM = true;
    const bf16* gate; const bf16* tin; bf16* out;
    __device__ __forceinline__ void operator()(const f32x4 (&acc)[2][2][4][2], const Unit& u, int wr, int wc, int fr, int fq) const {
        const int colt = u.pn * BM + wc * 32 + 8 * fq, row0 = u.pm * BM + wr * 64 + fr;
#pragma unroll
        for (int ai = 0; ai < 2; ++ai)
#pragma unroll
            for (int m = 0; m < 4; ++m) { const size_t ro = (size_t)(row0 + ai * HALF + m * 16) * D + colt;
#pragma unroll
                for (int bj = 0; bj < 2; ++bj) {
                    const u32x4 gq = *(const u32x4*)(gate + ro + bj * HALF);
                    u32x4 tq = (u32x4){0u, 0u, 0u, 0u}; if (MODE == 1) tq = *(const u32x4*)(tin + ro + bj * HALF);
                    float r[8];
#pragma unroll
                    for (int j = 0; j < 4; ++j) { r[j] = acc[ai][bj][m][0][j]; r[4 + j] = acc[ai][bj][m][1][j]; }
#pragma unroll
                    for (int j = 0; j < 4; ++j) { const unsigned gw = gq[j], tw = tq[j];
                        r[2 * j] = r[2 * j] * __uint_as_float(gw << 16) + __uint_as_float(tw << 16);
                        r[2 * j + 1] = r[2 * j + 1] * __uint_as_float(gw & 0xffff0000u) + __uint_as_float(tw & 0xffff0000u); }
                    u32x4 w; w.x = cvt_pk_bf16(r[0], r[1]); w.y = cvt_pk_bf16(r[2], r[3]); w.z = cvt_pk_bf16(r[4], r[5]); w.w = cvt_pk_bf16(r[6], r[7]);
                    *(u32x4*)(out + ro + bj * HALF) = w; } }
    }
};
struct EpiResid {
    static constexpr bool PERM = false;
    const float* x; float* out;
    __device__ __forceinline__ void operator()(const f32x4 (&acc)[2][2][4][2], const Unit& u, int wr, int wc, int fr, int fq) const {
        const int col0 = u.pn * BM + wc * 32 + 4 * fq, row0 = u.pm * BM + wr * 64 + fr;
#pragma unroll
        for (int ai = 0; ai < 2; ++ai)
#pragma unroll
            for (int m = 0; m < 4; ++m) { const size_t ro = (size_t)(row0 + ai * HALF + m * 16) * D + col0;
#pragma unroll
                for (int bj = 0; bj < 2; ++bj)
#pragma unroll
                    for (int n = 0; n < 2; ++n) { const f32x4 xv = *(const f32x4*)(x + ro + bj * HALF + n * 16); *(f32x4*)(out + ro + bj * HALF + n * 16) = xv + acc[ai][bj][m][n]; } }
    }
};
struct EpiSwiglu {
    static constexpr bool PERM = true;
    const float* bgate; const float* bup; bf16* hd;
    __device__ __forceinline__ void operator()(const f32x4 (&acc)[2][2][4][2], const Unit& u, int wr, int wc, int fr, int fq) const {
        const int col = u.pn * HALF + wc * 32 + 8 * fq; const size_t row0 = (size_t)u.pm * BM + wr * 64 + fr;
        const float* bg = bgate + (size_t)u.e * DFF + col; const float* bu = bup + (size_t)u.e * DFF + col;
        const f32x4 g0 = *(const f32x4*)bg, g1 = *(const f32x4*)(bg + 4), u0 = *(const f32x4*)bu, u1 = *(const f32x4*)(bu + 4);
#pragma unroll
        for (int ai = 0; ai < 2; ++ai)
#pragma unroll
            for (int m = 0; m < 4; ++m) {
                float r[8];
#pragma unroll
                for (int j = 0; j < 4; ++j) {
                    const float ga = fminf(acc[ai][0][m][0][j] + g0[j], 7.f), ua = fminf(fmaxf(acc[ai][1][m][0][j] + u0[j], -7.f), 7.f);
                    const float gb = fminf(acc[ai][0][m][1][j] + g1[j], 7.f), ub = fminf(fmaxf(acc[ai][1][m][1][j] + u1[j], -7.f), 7.f);
                    r[j] = (ua + 1.f) * (ga * sigmoidf_(1.702f * ga)); r[4 + j] = (ub + 1.f) * (gb * sigmoidf_(1.702f * gb)); }
                u32x4 w; w.x = cvt_pk_bf16(r[0], r[1]); w.y = cvt_pk_bf16(r[2], r[3]); w.z = cvt_pk_bf16(r[4], r[5]); w.w = cvt_pk_bf16(r[6], r[7]);
                *(u32x4*)(hd + (row0 + ai * HALF + m * 16) * DFF + col) = w; }
    }
};
struct EpiDown {
    static constexpr bool PERM = true;
    const float* bdown; const int* rpair; const float* rw; bf16* py;
    __device__ __forceinline__ void operator()(const f32x4 (&acc)[2][2][4][2], const Unit& u, int wr, int wc, int fr, int fq) const {
        const int colt = u.pn * BM + wc * 32 + 8 * fq; const size_t srow0 = (size_t)u.pm * BM + wr * 64 + fr;
        f32x4 bv[2][2];
#pragma unroll
        for (int bj = 0; bj < 2; ++bj)
#pragma unroll
            for (int n = 0; n < 2; ++n) bv[bj][n] = *(const f32x4*)(bdown + (size_t)u.e * D + colt + bj * HALF + 4 * n);
#pragma unroll
        for (int ai = 0; ai < 2; ++ai)
#pragma unroll
            for (int m = 0; m < 4; ++m) { const size_t srow = srow0 + ai * HALF + m * 16; const int pair = rpair[srow]; const float wgt = rw[srow];
                bf16* rowp = py + (size_t)pair * D + colt;
#pragma unroll
                for (int bj = 0; bj < 2; ++bj) { const f32x4 v0 = (acc[ai][bj][m][0] + bv[bj][0]) * wgt, v1 = (acc[ai][bj][m][1] + bv[bj][1]) * wgt;
                    u32x4 w; w.x = cvt_pk_bf16(v0[0], v0[1]); w.y = cvt_pk_bf16(v0[2], v0[3]); w.z = cvt_pk_bf16(v1[0], v1[1]); w.w = cvt_pk_bf16(v1[2], v1[3]);
                    *(u32x4*)(rowp + bj * HALF) = w; } }
    }
};
}

constexpr int NWAVES = 8;
constexpr int RING_BYTES = 131072, MISC_OFF = RING_BYTES + 320, LDS_BYTES = 147456;
constexpr int TAB_OFF = MISC_OFF + 128;

struct Frame {
    LAS unsigned char* lds; volatile LAS unsigned* MISC; unsigned* ctl; unsigned char* ws;
    int tid, lane, wave, vcu, G;
};
struct Args { const float* in[22]; float* out; unsigned char* ws; int ph_lo, ph_hi, li, pad; };

__device__ __forceinline__ void p0_transpose_item(const float* W, int K, int ldn, bf16* WT, int d0, int s0, int k0, LAS float* scr, int lane) {
#pragma unroll 8
    for (int i = 0; i < 32; ++i) { const int kk = 2 * i + (lane >> 5); scr[kk * 33 + (lane & 31)] = W[(size_t)(k0 + kk) * ldn + s0 + (lane & 31)]; }
    LDS_WAIT(); asm volatile("" ::: "memory");
    const int c = lane & 7;
#pragma unroll
    for (int j = 0; j < 4; ++j) { const int n = (lane >> 3) + 8 * j; const LAS float* s = scr + (8 * c) * 33 + n;
        u32x4 o; o.x = pk2(s[0 * 33], s[1 * 33]); o.y = pk2(s[2 * 33], s[3 * 33]); o.z = pk2(s[4 * 33], s[5 * 33]); o.w = pk2(s[6 * 33], s[7 * 33]);
        *(GAS u32x4*)(WT + (size_t)(d0 + n) * K + k0 + 8 * c) = o; }
    LDS_WAIT(); asm volatile("" ::: "memory");
}

__device__ __forceinline__ void p0_prologue(Frame& F, const Args& a) {
    LAS float* scr = (LAS float*)(F.lds + F.wave * 16384);
    const int gw = F.vcu * NWAVES + F.wave, NGW = F.G * NWAVES, lane = F.lane;
    const float* w_in = a.in[2];
    constexpr int I_IN = 32 * (NPROJ / 32), I_BG = 32 * 64, I_BA = 16 * 64, I_OUT = 32 * 64, I_E = 32 * 64;
    constexpr int I_MOE = NE * I_E;
    constexpr int NITEMS = I_IN + I_BG + I_BA + I_OUT + 3 * I_MOE;
    for (int it = gw; it < NITEMS; it += NGW) {
        int r = it;
        if (r < I_IN) { const int nb = r % (NPROJ / 32), kb = r / (NPROJ / 32), d0 = nb * 32; p0_transpose_item(w_in, D, IN_COLS, (bf16*)(F.ws + WS_WIN), d0, d0 < C_GLR ? d0 : d0 + 16, kb * 64, scr, lane); continue; } r -= I_IN;
        if (r < I_BG) { const int nb = r % 64, kb = r / 64; p0_transpose_item(a.in[10], GLA_V, D, (bf16*)(F.ws + WS_WBG), nb * 32, nb * 32, kb * 64, scr, lane); continue; } r -= I_BG;
        if (r < I_BA) { const int nb = r % 64, kb = r / 64; p0_transpose_item(a.in[11], ATT_W, D, (bf16*)(F.ws + WS_WBA), nb * 32, nb * 32, kb * 64, scr, lane); continue; } r -= I_BA;
        if (r < I_OUT) { const int nb = r % 64, kb = r / 64; p0_transpose_item(a.in[12], D, D, (bf16*)(F.ws + WS_WOUT), nb * 32, nb * 32, kb * 64, scr, lane); continue; } r -= I_OUT;
        if (r < 2 * I_MOE) {
            const int which = r / I_MOE; r -= which * I_MOE; const int e = r / I_E; r -= e * I_E; const int nb = r % 64, kb = r / 64, n0 = nb * 32;
            const float* W = (which ? a.in[18] : a.in[16]) + (size_t)e * D * DFF;
            p0_transpose_item(W, D, DFF, (bf16*)(F.ws + WS_GU) + (size_t)e * 2 * DFF * D, (n0 >> 7) * 256 + (n0 & 127) + which * 128, n0, kb * 64, scr, lane); continue; }
        r -= 2 * I_MOE;
        { const int e = r / I_E; r -= e * I_E; const int nb = r % 64, kb = r / 64;
          p0_transpose_item(a.in[20] + (size_t)e * DFF * D, DFF, D, (bf16*)(F.ws + WS_DN) + (size_t)e * D * DFF, nb * 32, nb * 32, kb * 64, scr, lane); }
    }
    const float* x = a.in[0]; const float* g1 = a.in[1]; bf16* XN = (bf16*)(F.ws + WS_XN); float* GLR = (float*)(F.ws + WS_GLR);
    for (int m = gw; m < S; m += NGW) {
        const GAS f32x4* xr = (const GAS f32x4*)(x + (size_t)m * D) + lane;
        f32x4 v[8]; float s = 0.f;
#pragma unroll
        for (int j = 0; j < 8; ++j) { v[j] = xr[64 * j]; s += (v[j].x * v[j].x + v[j].y * v[j].y) + (v[j].z * v[j].z + v[j].w * v[j].w); }
        const float rstd = rsqrtf(wave_sum(s) * (1.f / D) + 1e-6f);
        GAS u32x2* o8 = (GAS u32x2*)(XN + (size_t)m * D) + lane;
        float gl[16];
#pragma unroll
        for (int r = 0; r < 16; ++r) gl[r] = 0.f;
#pragma unroll
        for (int j = 0; j < 8; ++j) { const f32x4 gg = *((const GAS f32x4*)g1 + lane + 64 * j); v[j] = v[j] * rstd * gg;
            u32x2 w; w.x = pk2(v[j].x, v[j].y); w.y = pk2(v[j].z, v[j].w); o8[64 * j] = w;
#pragma unroll
            for (int i = 0; i < 4; ++i) { const GAS f32x4* wp = (const GAS f32x4*)(w_in + (size_t)(256 * j + 4 * lane + i) * IN_COLS + C_GLR);
#pragma unroll
                for (int q = 0; q < 4; ++q) { const f32x4 wv = wp[q]; gl[4 * q] = fmaf(v[j][i], wv.x, gl[4 * q]); gl[4 * q + 1] = fmaf(v[j][i], wv.y, gl[4 * q + 1]); gl[4 * q + 2] = fmaf(v[j][i], wv.z, gl[4 * q + 2]); gl[4 * q + 3] = fmaf(v[j][i], wv.w, gl[4 * q + 3]); } } }
        float mine = 0.f;
#pragma unroll
        for (int r = 0; r < 16; ++r) { const float t = wave_sum(gl[r]); mine = (lane == r) ? t : mine; }
        if (lane < 16) GLR[(size_t)m * 16 + lane] = mine;
    }
    { const float* g2 = a.in[13]; const float* wr = a.in[14]; float* WR = (float*)(F.ws + WS_WR);
      for (int i = (F.vcu * NWAVES * 64) + F.tid; i < D * NE; i += F.G * NWAVES * 64) WR[i] = g2[i >> 5] * wr[i]; }
}

__device__ __forceinline__ void p6_router(Frame& F, const Args& a) {
    const int gw = F.vcu * NWAVES + F.wave, NGW = F.G * NWAVES, lane = F.lane;
    const float* h1 = a.out; const float* g2 = a.in[13]; const float* WR = (const float*)(F.ws + WS_WR); const float* br = a.in[15];
    bf16* HN = (bf16*)(F.ws + WS_HN); float* topw = (float*)(F.ws + WS_TOPW); int* tope = (int*)(F.ws + WS_TOPE); int* tops = (int*)(F.ws + WS_TOPS);
    unsigned* cnt = F.ctl + CW_CNT;
    const int e = lane & 31, half = lane >> 5;
    for (int t = gw; t < S; t += NGW) {
        const float* xr = h1 + (size_t)t * D;
        const GAS f32x4* x4 = (const GAS f32x4*)xr + lane; f32x4 v[8]; float s = 0.f;
#pragma unroll
        for (int j = 0; j < 8; ++j) { v[j] = x4[64 * j]; s += (v[j].x * v[j].x + v[j].y * v[j].y) + (v[j].z * v[j].z + v[j].w * v[j].w); }
        const float rstd = rsqrtf(wave_sum(s) * (1.f / D) + 1e-6f);
        GAS u32x2* o8 = (GAS u32x2*)(HN + (size_t)t * D) + lane;
#pragma unroll
        for (int j = 0; j < 8; ++j) { const f32x4 gg = *((const GAS f32x4*)g2 + lane + 64 * j); const f32x4 y = v[j] * rstd * gg; u32x2 w; w.x = pk2(y.x, y.y); w.y = pk2(y.z, y.w); o8[64 * j] = w; }
        float acc = 0.f;
#pragma unroll 8
        for (int k = half; k < D; k += 2) acc = fmaf(xr[k], WR[(size_t)k * NE + e], acc);
        acc += __shfl_xor(acc, 32);
        const float logit = acc * rstd + br[e];
        float vals[4]; int idxs[4]; float cur = logit;
#pragma unroll
        for (int r = 0; r < 4; ++r) {
            float bv = cur; int bi = e;
#pragma unroll
            for (int o = 1; o < 32; o <<= 1) { const float ov = __shfl_xor(bv, o); const int oi = __shfl_xor(bi, o); if (ov > bv || (ov == bv && oi < bi)) { bv = ov; bi = oi; } }
            vals[r] = bv; idxs[r] = bi;
            if (e == bi) cur = -3.0e38f;
        }
        float ex[4], sum = 0.f;
#pragma unroll
        for (int r = 0; r < 4; ++r) { ex[r] = __expf(vals[r] - vals[0]); sum += ex[r]; }
#pragma unroll
        for (int r = 0; r < 4; ++r) {
            if (lane == r) { const int ee = idxs[r]; const int slot = (int)atomicAdd(&cnt[ee], 1u);
                topw[t * 4 + r] = ex[r] / sum; tope[t * 4 + r] = ee; tops[t * 4 + r] = slot; }
        }
    }
}
__device__ __forceinline__ void moe_table(Frame& F) {
    volatile LAS int* ts = (volatile LAS int*)(F.lds + TAB_OFF); volatile LAS int* cn = (volatile LAS int*)(F.lds + TAB_OFF + 256);
    __syncthreads();
    if (F.tid == 0) { int s = 0; for (int e = 0; e < NE; ++e) { const int c = (int)__hip_atomic_load(F.ctl + CW_CNT + e, __ATOMIC_RELAXED, __HIP_MEMORY_SCOPE_AGENT); cn[e] = c; ts[e] = s; s += (c + 255) >> 8; } ts[NE] = s; }
    __syncthreads();
}
__device__ __forceinline__ void p7_gather(Frame& F) {
    const int gw = F.vcu * NWAVES + F.wave, NGW = F.G * NWAVES, lane = F.lane;
    volatile LAS int* ts = (volatile LAS int*)(F.lds + TAB_OFF);
    const bf16* HN = (const bf16*)(F.ws + WS_HN); bf16* HNG = (bf16*)(F.ws + WS_HNG);
    const float* topw = (const float*)(F.ws + WS_TOPW); const int* tope = (const int*)(F.ws + WS_TOPE); const int* tops = (const int*)(F.ws + WS_TOPS);
    int* rpair = (int*)(F.ws + WS_RPAIR); float* rw = (float*)(F.ws + WS_RW);
    { volatile LAS int* cn = (volatile LAS int*)(F.lds + TAB_OFF + 256);
      for (int e = gw; e < NE; e += NGW) { const int c = cn[e], base = ts[e] * 256, padn = ((c + 255) & ~255) - c;
          for (int r = lane; r < padn; r += 64) { rpair[base + c + r] = S * 4; rw[base + c + r] = 0.f; } } }
    for (int t = gw; t < S; t += NGW) {
        const GAS u32x4* src = (const GAS u32x4*)(HN + (size_t)t * D) + lane; u32x4 v[4];
#pragma unroll
        for (int j = 0; j < 4; ++j) v[j] = src[64 * j];
#pragma unroll
        for (int r = 0; r < 4; ++r) { const int p = t * 4 + r; const int dst = ts[tope[p]] * 256 + tops[p];
            GAS u32x4* d = (GAS u32x4*)(HNG + (size_t)dst * D) + lane;
#pragma unroll
            for (int j = 0; j < 4; ++j) d[64 * j] = v[j];
            if (lane == 0) { rpair[dst] = p; rw[dst] = topw[p]; } }
    }
}
__device__ __forceinline__ void p10_combine(Frame& F, const Args& a) {
    const int gw = F.vcu * NWAVES + F.wave, NGW = F.G * NWAVES, lane = F.lane;
    const bf16* PY = (const bf16*)(F.ws + WS_PY); float* out = a.out;
    for (int t = gw; t < S; t += NGW) {
#pragma unroll
        for (int j = 0; j < 4; ++j) {
            float r[8]; { const f32x4 h0 = *(const GAS f32x4*)(out + (size_t)t * D + 512 * j + 8 * lane), h1v = *(const GAS f32x4*)(out + (size_t)t * D + 512 * j + 8 * lane + 4);
                r[0] = h0.x; r[1] = h0.y; r[2] = h0.z; r[3] = h0.w; r[4] = h1v.x; r[5] = h1v.y; r[6] = h1v.z; r[7] = h1v.w; }
#pragma unroll
            for (int k = 0; k < 4; ++k) { const u32x4 p = *(const GAS u32x4*)(PY + (size_t)(t * 4 + k) * D + 512 * j + 8 * lane);
#pragma unroll
                for (int q = 0; q < 4; ++q) { r[2 * q] += __uint_as_float(p[q] << 16); r[2 * q + 1] += __uint_as_float(p[q] & 0xffff0000u); } }
            *(GAS f32x4*)(out + (size_t)t * D + 512 * j + 8 * lane) = (f32x4){r[0], r[1], r[2], r[3]};
            *(GAS f32x4*)(out + (size_t)t * D + 512 * j + 8 * lane + 4) = (f32x4){r[4], r[5], r[6], r[7]};
        }
    }
}


constexpr float ATT_QSCALE = 0.08838834764831845f * 1.4426950408889634f;
__device__ __forceinline__ void attn_prep_unit(Frame& F, const Args& a, int n, int h) {
    const int wave = F.wave, lane = F.lane, tid = F.tid;
    LAS bf16* kst = (LAS bf16*)(F.lds);
    LAS bf16* vst = (LAS bf16*)(F.lds + 16384);
    const bf16* AQ = (const bf16*)(F.ws + WS_AQ); const bf16* AK = (const bf16*)(F.ws + WS_AK); const bf16* AV = (const bf16*)(F.ws + WS_AV);
    bf16* QH = (bf16*)(F.ws + WS_QH);
    const float* qg = a.in[6]; const float* kg = a.in[7];
    const float gq0 = qg[2 * lane], gq1 = qg[2 * lane + 1], gk0 = kg[2 * lane], gk1 = kg[2 * lane + 1];
#pragma unroll
    for (int i = 0; i < 8; ++i) {
        const int row = n * 64 + wave * 8 + i; const size_t off = (size_t)row * ATT_W + h * ATT_HD + 2 * lane;
        const unsigned qv = *(const unsigned*)(AQ + off), kv = *(const unsigned*)(AK + off), vv = *(const unsigned*)(AV + off);
        const float q0 = __uint_as_float(qv << 16), q1 = __uint_as_float(qv & 0xffff0000u), k0 = __uint_as_float(kv << 16), k1 = __uint_as_float(kv & 0xffff0000u);
        const float rq = rsqrtf(wave_sum(q0 * q0 + q1 * q1) * (1.f / 128.f) + 1e-6f) * ATT_QSCALE, rk = rsqrtf(wave_sum(k0 * k0 + k1 * k1) * (1.f / 128.f) + 1e-6f);
        *(unsigned*)(QH + off) = pk2(q0 * rq * gq0, q1 * rq * gq1);
        *(LAS unsigned*)(kst + (wave * 8 + i) * 128 + 2 * lane) = pk2(k0 * rk * gk0, k1 * rk * gk1);
        *(LAS unsigned*)(vst + (wave * 8 + i) * 128 + 2 * lane) = vv;
    }
    __syncthreads();
    bf16* KI = (bf16*)(F.ws + WS_KIMG) + (size_t)(n * ATT_H + h) * 8192; bf16* VI = (bf16*)(F.ws + WS_VIMG) + (size_t)(n * ATT_H + h) * 8192;
#pragma unroll
    for (int i = 0; i < 2; ++i) {
        const int g = tid + 512 * i;
        { const int c16 = g >> 6, key = g & 63; const u32x4 v = *(const LAS u32x4*)(kst + key * 128 + c16 * 8); *(u32x4*)(KI + (size_t)g * 8) = v; }
        { const int kg8 = g >> 7, d = g & 127; unsigned short e[8];
#pragma unroll
          for (int j = 0; j < 8; ++j) e[j] = vst[(kg8 * 8 + j) * 128 + d];
          u32x4 v; v.x = e[0] | ((unsigned)e[1] << 16); v.y = e[2] | ((unsigned)e[3] << 16); v.z = e[4] | ((unsigned)e[5] << 16); v.w = e[6] | ((unsigned)e[7] << 16);
          *(u32x4*)(VI + (size_t)g * 8) = v; }
    }
    __syncthreads();
}

typedef float f32x16 __attribute__((ext_vector_type(16)));
__device__ __forceinline__ int crow(int r, int hi) { return (r & 3) + 8 * (r >> 2) + 4 * hi; }
__device__ __forceinline__ void attn_unit(Frame& F, const Args& a, int n4, int h) {
    const int w = F.wave, lane = F.lane, r32 = lane & 31, hi = lane >> 5, tid = F.tid;
    const int p = w >> 1, half = w & 1, c = 4 * n4 + p, qrow0 = c * 64 + 32 * half;
    LAS unsigned char* lds = F.lds;
    LAS float* btab = (LAS float*)(lds + 65536); LAS float* xch = (LAS float*)(lds + 67584 + 256 * w); LAS bf16* ost = (LAS bf16*)(lds + 8192 * w);
    const float* relb = a.in[8] + h * 257;
    if (tid < 257) btab[tid] = relb[tid] * 1.4426950408889634f;
    const bf16* QH = (const bf16*)(F.ws + WS_QH);
    bf16x8 qf[8];
#pragma unroll
    for (int d0 = 0; d0 < 8; ++d0) qf[d0] = *(const bf16x8*)(QH + (size_t)(qrow0 + r32) * ATT_W + h * ATT_HD + d0 * 16 + hi * 8);
    const char* KIMG = (const char*)(F.ws + WS_KIMG); const char* VIMG = (const char*)(F.ws + WS_VIMG);
    f32x16 o[4];
#pragma unroll
    for (int dt = 0; dt < 4; ++dt)
#pragma unroll
        for (int r = 0; r < 16; ++r) o[dt][r] = 0.f;
    float m = -1.0e30f, l = 0.f;
    const int s0 = (4 * n4 - 8 < 0) ? (8 - 4 * n4) : 0;
#define ATT_STAGE(s_) do { const int kc_ = 4 * n4 - 8 + (s_); const size_t gb_ = (size_t)(kc_ * ATT_H + h) * 16384; const unsigned lb_ = ((s_) & 1) * 32768; \
        _Pragma("unroll") for (int i_ = 0; i_ < 2; ++i_) { const int pc_ = w + 8 * i_; \
            __builtin_amdgcn_global_load_lds((const unsigned*)(KIMG + gb_ + pc_ * 1024 + lane * 16), (LAS unsigned*)(lds + lb_ + pc_ * 1024), 16, 0, 0); \
            __builtin_amdgcn_global_load_lds((const unsigned*)(VIMG + gb_ + pc_ * 1024 + lane * 16), (LAS unsigned*)(lds + lb_ + 16384 + pc_ * 1024), 16, 0, 0); } } while (0)
    ATT_STAGE(s0);
    for (int s = s0; s < 12; ++s) {
        asm volatile("s_waitcnt vmcnt(0) lgkmcnt(0)" ::: "memory");
        __builtin_amdgcn_s_barrier();
        if (s + 1 < 12) ATT_STAGE(s + 1);
        if (s >= p && s <= p + 8) {
            const LAS unsigned char* kb = lds + (s & 1) * 32768; const LAS unsigned char* vb = kb + 16384;
            f32x16 p0, p1;
#pragma unroll
            for (int r = 0; r < 16; ++r) { p0[r] = 0.f; p1[r] = 0.f; }
#pragma unroll
            for (int d0 = 0; d0 < 8; ++d0) {
                const bf16x8 k0 = *(const LAS bf16x8*)(kb + (2 * d0 + hi) * 1024 + r32 * 16), k1 = *(const LAS bf16x8*)(kb + (2 * d0 + hi) * 1024 + (r32 + 32) * 16);
                p0 = __builtin_amdgcn_mfma_f32_32x32x16_bf16(k0, qf[d0], p0, 0, 0, 0);
                p1 = __builtin_amdgcn_mfma_f32_32x32x16_bf16(k1, qf[d0], p1, 0, 0, 0);
                if (d0 & 1) __builtin_amdgcn_sched_barrier(0);
            }
            const int wrel = p + 8 - s;
            if (wrel >= 3) { const float bc = btab[256];
#pragma unroll
                for (int r = 0; r < 16; ++r) { p0[r] += bc; p1[r] += bc; } }
            else { const int base = 64 * wrel + 32 * half + r32 + 128;
#pragma unroll
                for (int r = 0; r < 16; ++r) { int i0 = base - crow(r, hi), i1 = i0 - 32; i0 = i0 > 256 ? 256 : i0; i1 = i1 > 256 ? 256 : i1; i1 = i1 < 0 ? 0 : i1; i0 = i0 < 0 ? 0 : i0; p0[r] += btab[i0]; p1[r] += btab[i1]; } }
            float mx = p0[0];
#pragma unroll
            for (int r = 1; r < 16; ++r) mx = fmaxf(mx, p0[r]);
#pragma unroll
            for (int r = 0; r < 16; ++r) mx = fmaxf(mx, p1[r]);
            mx = fmaxf(mx, __shfl_xor(mx, 32));
            const float mn = fmaxf(m, mx), alpha = __builtin_amdgcn_exp2f(m - mn);
            float ps = 0.f;
#pragma unroll
            for (int r = 0; r < 16; ++r) { p0[r] = __builtin_amdgcn_exp2f(p0[r] - mn); p1[r] = __builtin_amdgcn_exp2f(p1[r] - mn); ps += p0[r] + p1[r]; }
            l = l * alpha + ps;
            if (__any(mn > m)) {
                if (hi == 0) xch[r32] = alpha;
                asm volatile("s_waitcnt lgkmcnt(0)" ::: "memory");
#pragma unroll
                for (int g = 0; g < 4; ++g) { const f32x4 av = *(const LAS f32x4*)(xch + 8 * g + 4 * hi);
#pragma unroll
                    for (int dt = 0; dt < 4; ++dt) { o[dt][4 * g] *= av[0]; o[dt][4 * g + 1] *= av[1]; o[dt][4 * g + 2] *= av[2]; o[dt][4 * g + 3] *= av[3]; } }
            }
            m = mn;
            bf16x8 pa[4];
#pragma unroll
            for (int ks = 0; ks < 4; ++ks) { const f32x16& src = (ks < 2) ? p0 : p1; const int b = (ks & 1) * 8; u32x4 t;
                t.x = cvt_pk_bf16(src[b], src[b + 1]); t.y = cvt_pk_bf16(src[b + 2], src[b + 3]); t.z = cvt_pk_bf16(src[b + 4], src[b + 5]); t.w = cvt_pk_bf16(src[b + 6], src[b + 7]);
                pa[ks] = __builtin_bit_cast(bf16x8, t); }
#pragma unroll
            for (int dt = 0; dt < 4; ++dt)
#pragma unroll
                for (int ks = 0; ks < 4; ++ks) {
                    const LAS unsigned char* vp = vb + (2 * ks) * 2048 + (32 * dt + r32) * 16 + 8 * hi;
                    const u32x2 lo = *(const LAS u32x2*)vp, hh = *(const LAS u32x2*)(vp + 2048);
                    const u32x4 bq = (u32x4){lo.x, lo.y, hh.x, hh.y};
                    o[dt] = __builtin_amdgcn_mfma_f32_32x32x16_bf16(pa[ks], __builtin_bit_cast(bf16x8, bq), o[dt], 0, 0, 0);
                    if (ks == 3) __builtin_amdgcn_sched_barrier(0);
                }
        }
    }
#undef ATT_STAGE
    asm volatile("s_waitcnt lgkmcnt(0)" ::: "memory");
    __builtin_amdgcn_s_barrier();
    l += __shfl_xor(l, 32);
    if (hi == 0) xch[32 + r32] = 1.f / l;
    asm volatile("s_waitcnt lgkmcnt(0)" ::: "memory");
#pragma unroll
    for (int g = 0; g < 4; ++g) { const f32x4 iv = *(const LAS f32x4*)(xch + 32 + 8 * g + 4 * hi);
#pragma unroll
        for (int dt = 0; dt < 4; ++dt)
#pragma unroll
            for (int j = 0; j < 4; ++j) ost[(8 * g + 4 * hi + j) * 128 + 32 * dt + r32] = (bf16)f2bf(o[dt][4 * g + j] * iv[j]); }
    asm volatile("s_waitcnt lgkmcnt(0)" ::: "memory");
    bf16* YA = (bf16*)(F.ws + WS_YA);
#pragma unroll
    for (int i = 0; i < 8; ++i) { const int g = i * 64 + lane, row = g >> 4, c16 = g & 15; const u32x4 v = *(const LAS u32x4*)(ost + row * 128 + c16 * 8);
        *(u32x4*)(YA + (size_t)(qrow0 + row) * ATT_W + h * ATT_HD + c16 * 8) = v; }
    asm volatile("s_waitcnt vmcnt(0) lgkmcnt(0)" ::: "memory");
    __builtin_amdgcn_s_barrier();
}

__global__ void __launch_bounds__(NWAVES * 64, 2) fwd(Args args) {
    extern __shared__ __attribute__((aligned(16))) unsigned char lds_raw[];
    Frame F;
    F.lds = (LAS unsigned char*)lds_raw; F.MISC = (volatile LAS unsigned*)(F.lds + MISC_OFF);
    F.tid = threadIdx.x; F.lane = F.tid & 63; F.wave = __builtin_amdgcn_readfirstlane(F.tid >> 6);
    F.G = gridDim.x; { const int bx = blockIdx.x; F.vcu = (F.G % 8 == 0) ? (bx % 8) * (F.G / 8) + bx / 8 : bx; }
    F.ws = args.ws; F.ctl = (unsigned*)(args.ws + WS_CTL);
    for (int u = F.tid; u < (LDS_BYTES - RING_BYTES) / 4; u += NWAVES * 64) ((LAS unsigned*)(F.lds + RING_BYTES))[u] = 0u;
    __syncthreads();
    XcdBarrier bar = xcd_barrier_post(F.ctl + CW_BAR + args.li * XCD_BAR_WORDS, F.MISC + 8);
    const int lo = args.ph_lo, hi = args.ph_hi;
#define IN(k) (lo <= (k) && (k) < hi)
#define SEAM(k) do { if (IN(k) && IN((k) + 1)) xcd_barrier(bar); } while (0)
    unsigned char* ws = args.ws;
    if (IN(0)) { p0_prologue(F, args); } SEAM(0);
    if (IN(1)) { pg8::DenseSched Sc; Sc.init(ws + WS_XN, ws + WS_WIN, S, NPROJ, D, F.G, (int)blockIdx.x); pg8::EpiProj E{ws, args.in[9]};
        pg8::gemm_phase<pg8::EpiProj, pg8::DenseSched>(F.lds, D, Sc, E); } SEAM(1);
    if (IN(2)) { for (int u = F.vcu; u < NCH * ATT_H; u += F.G) attn_prep_unit(F, args, u >> 3, u & 7); } SEAM(2);
    if (IN(3)) { for (int u = F.vcu; u < (NCH / 4) * ATT_H; u += F.G) attn_unit(F, args, u >> 3, u & 7); } SEAM(3);
    SEAM(4); SEAM(5); SEAM(6);
    if (IN(7)) { pg8::DenseSched Sc; Sc.init(ws + WS_YG, ws + WS_WBG, S, D, GLA_V, F.G, (int)blockIdx.x); pg8::EpiBranch<0> E{(const bf16*)(ws + WS_SG), nullptr, (bf16*)(ws + WS_T)};
        pg8::gemm_phase<pg8::EpiBranch<0>, pg8::DenseSched>(F.lds, GLA_V, Sc, E); } SEAM(7);
    if (IN(8)) { pg8::DenseSched Sc; Sc.init(ws + WS_YA, ws + WS_WBA, S, D, ATT_W, F.G, (int)blockIdx.x); pg8::EpiBranch<1> E{(const bf16*)(ws + WS_SA), (const bf16*)(ws + WS_T), (bf16*)(ws + WS_MG)};
        pg8::gemm_phase<pg8::EpiBranch<1>, pg8::DenseSched>(F.lds, ATT_W, Sc, E); } SEAM(8);
    if (IN(9)) { pg8::DenseSched Sc; Sc.init(ws + WS_MG, ws + WS_WOUT, S, D, D, F.G, (int)blockIdx.x); pg8::EpiResid E{args.in[0], args.out};
        pg8::gemm_phase<pg8::EpiResid, pg8::DenseSched>(F.lds, D, Sc, E); } SEAM(9);
    if (IN(10)) { p6_router(F, args); } SEAM(10);
    if (IN(11)) { moe_table(F); p7_gather(F); } SEAM(11);
    if (IN(12)) { moe_table(F); pg8::MoeSched Sc; Sc.init(ws + WS_HNG, ws + WS_GU, (volatile LAS int*)(F.lds + TAB_OFF), (volatile LAS int*)(F.lds + TAB_OFF + 256), 16, D, F.G, (int)blockIdx.x);
        pg8::EpiSwiglu E{args.in[17], args.in[19], (bf16*)(ws + WS_HD)};
        pg8::gemm_phase<pg8::EpiSwiglu, pg8::MoeSched>(F.lds, D, Sc, E); } SEAM(12);
    if (IN(13)) { moe_table(F); pg8::MoeSched Sc; Sc.init(ws + WS_HD, ws + WS_DN, (volatile LAS int*)(F.lds + TAB_OFF), (volatile LAS int*)(F.lds + TAB_OFF + 256), 8, DFF, F.G, (int)blockIdx.x);
        pg8::EpiDown E{args.in[21], (const int*)(ws + WS_RPAIR), (const float*)(ws + WS_RW), (bf16*)(ws + WS_PY)};
        pg8::gemm_phase<pg8::EpiDown, pg8::MoeSched>(F.lds, DFF, Sc, E); } SEAM(13);
    if (IN(14)) { p10_combine(F, args); }
#undef IN
#undef SEAM
}

__global__ void __launch_bounds__(256) k_gla_scan(const bf16* __restrict__ GQ, const bf16* __restrict__ GK, const bf16* __restrict__ GV, const float* __restrict__ GLR,
                                                  const float* __restrict__ wgu, const float* __restrict__ bg, float* __restrict__ o) {
    __shared__ float red[2][4][8];
    const int h = blockIdx.x >> 6, vg = blockIdx.x & 63, dk = threadIdx.x, lane = dk & 63, wv = dk >> 6;
    const int c = h * GLA_DK + dk;
    float w[16];
#pragma unroll
    for (int r = 0; r < 16; ++r) w[r] = wgu[r * GLA_QK + c];
    const float b = bg[c];
    float s[8];
#pragma unroll
    for (int j = 0; j < 8; ++j) s[j] = 0.f;
    float glr[16], vq, vk, vv[8];
#pragma unroll
    for (int r = 0; r < 16; ++r) glr[r] = GLR[r];
    vq = bf2f(GQ[c]); vk = bf2f(GK[c]);
#pragma unroll
    for (int j = 0; j < 8; ++j) vv[j] = bf2f(GV[h * GLA_DV + vg * 8 + j]);
    for (int t = 0; t < S; ++t) {
        float nglr[16], nq, nk, nv[8];
        { const size_t tn = (size_t)(t + 1 < S ? t + 1 : t);
#pragma unroll
          for (int r = 0; r < 16; ++r) nglr[r] = GLR[tn * 16 + r];
          nq = bf2f(GQ[tn * GLA_QK + c]); nk = bf2f(GK[tn * GLA_QK + c]);
#pragma unroll
          for (int j = 0; j < 8; ++j) nv[j] = bf2f(GV[tn * GLA_V + h * GLA_DV + vg * 8 + j]); }
        float z = b;
#pragma unroll
        for (int r = 0; r < 16; ++r) z = fmaf(glr[r], w[r], z);
        const float a = __expf(log_sigmoid(z) * (1.f / 16.f));
        const float q = vq * 0.0625f, k = vk;
        float p[8];
#pragma unroll
        for (int j = 0; j < 8; ++j) { s[j] = fmaf(s[j], a, k * vv[j]); p[j] = q * s[j]; }
#pragma unroll
        for (int j = 0; j < 8; ++j) p[j] = wave_sum(p[j]);
        if (lane == 0) {
#pragma unroll
            for (int j = 0; j < 8; ++j) red[t & 1][wv][j] = p[j];
        }
        __syncthreads();
        if (dk < 8) o[(size_t)t * GLA_V + h * GLA_DV + vg * 8 + dk] = red[t & 1][0][dk] + red[t & 1][1][dk] + red[t & 1][2][dk] + red[t & 1][3][dk];
#pragma unroll
        for (int r = 0; r < 16; ++r) glr[r] = nglr[r];
        vq = nq; vk = nk;
#pragma unroll
        for (int j = 0; j < 8; ++j) vv[j] = nv[j];
    }
}
__global__ void __launch_bounds__(256) k_gla_out(const float* __restrict__ o, const bf16* __restrict__ GR, const float* __restrict__ g, bf16* __restrict__ y) {
    const int w = (blockIdx.x * blockDim.x + threadIdx.x) >> 6, lane = threadIdx.x & 63;
    const int t = w >> 2, h = w & 3;
    const float* orow = o + (size_t)t * GLA_V + h * GLA_DV; float v[8]; float s = 0.f;
#pragma unroll
    for (int i = 0; i < 8; ++i) { v[i] = orow[lane + 64 * i]; s += v[i] * v[i]; }
    s = wave_sum(s);
    const float r = rsqrtf(s / GLA_DV + 1e-6f);
#pragma unroll
    for (int i = 0; i < 8; ++i) { const int vv = lane + 64 * i; const size_t idx = (size_t)t * GLA_V + h * GLA_DV + vv; y[idx] = (bf16)f2bf(v[i] * r * g[vv] * bf2f(GR[idx])); }
}
extern "C" void kernel_launch(void* const* d_in, const int* in_sizes, int n_in, void* d_out, int out_size, void* d_ws, size_t ws_size, hipStream_t stream) {
    static int grid = 0;
    if (grid == 0) {
        if (n_in != 22 || out_size != S * D || ws_size < WS_END) { fprintf(stderr, "kernel_launch: unexpected problem (n_in %d out %d ws %zu)\n", n_in, out_size, ws_size); grid = -1; return; }
        int dev = 0, cus = 0, per_cu = 0;
        if (hipGetDevice(&dev) != hipSuccess || hipDeviceGetAttribute(&cus, hipDeviceAttributeMultiprocessorCount, dev) != hipSuccess) { grid = -1; return; }
        if (hipFuncSetAttribute((const void*)fwd, hipFuncAttributeMaxDynamicSharedMemorySize, LDS_BYTES) != hipSuccess) { fprintf(stderr, "kernel_launch: hipFuncSetAttribute failed\n"); grid = -1; return; }
        if (hipOccupancyMaxActiveBlocksPerMultiprocessor(&per_cu, (const void*)fwd, NWAVES * 64, LDS_BYTES) != hipSuccess || per_cu < 1) fprintf(stderr, "kernel_launch: occupancy query says %d\n", per_cu);
        (void)hipGetLastError();
        grid = cus;
    }
    if (grid < 0) return;
    (void)hipMemsetAsync((char*)d_ws + WS_CTL, 0, CTL_ZERO_BYTES, stream);
    Args a{};
    for (int i = 0; i < 22; ++i) a.in[i] = (const float*)d_in[i];
    a.out = (float*)d_out; a.ws = (unsigned char*)d_ws;
    unsigned char* ws = (unsigned char*)d_ws;
    a.ph_lo = 0; a.ph_hi = 2; a.li = 0;
    hipLaunchKernelGGL(fwd, dim3(grid), dim3(NWAVES * 64), LDS_BYTES, stream, a);
    hipLaunchKernelGGL(k_gla_scan, dim3(256), dim3(256), 0, stream, (const bf16*)(ws + WS_GQ), (const bf16*)(ws + WS_GK), (const bf16*)(ws + WS_GV), (const float*)(ws + WS_GLR),
                       (const float*)d_in[3], (const float*)d_in[4], (float*)(ws + WS_OG));
    hipLaunchKernelGGL(k_gla_out, dim3(S * GLA_H / 4), dim3(256), 0, stream, (const float*)(ws + WS_OG), (const bf16*)(ws + WS_GR), (const float*)d_in[5], (bf16*)(ws + WS_YG));
    a.ph_lo = 2; a.ph_hi = 15; a.li = 1;
    hipLaunchKernelGGL(fwd, dim3(grid), dim3(NWAVES * 64), LDS_BYTES, stream, a);
}
```

```cpp
#include <hip/hip_runtime.h>
#include <stdint.h>
#include <cstdio>

constexpr int S = 8192, D = 2048;
constexpr int GLA_H = 4, GLA_DK = 256, GLA_DV = 512, GLA_QK = 1024, GLA_V = 2048;
constexpr int ATT_H = 8, ATT_HD = 128, ATT_W = 1024, NCH = S / 64;
constexpr int NE = 32, DFF = 2048;
constexpr int IN_COLS = 13328, C_GLR = 6144;
constexpr int NPROJ = 13312;
constexpr int MAXROWS = 32768 + NE * 256;

constexpr size_t MiB = 1u << 20;
constexpr size_t WS_CTL = 0, CTL_ZERO_BYTES = 1 * MiB;
constexpr size_t WS_TOPW = 1 * MiB, WS_TOPE = WS_TOPW + 128 * 1024, WS_TOPS = WS_TOPE + 128 * 1024, WS_RPAIR = WS_TOPS + 128 * 1024, WS_RW = WS_RPAIR + 256 * 1024;
constexpr size_t WS_GLR = 2 * MiB, WS_WR = 3 * MiB;
constexpr size_t WS_WIN = 8 * MiB, WS_WBG = 60 * MiB, WS_WBA = 68 * MiB, WS_WOUT = 72 * MiB, WS_GU = 80 * MiB, WS_DN = 592 * MiB;
constexpr size_t WS_XN = 848 * MiB, WS_GQ = 880 * MiB, WS_GK = 896 * MiB, WS_GV = 912 * MiB, WS_GR = 944 * MiB, WS_AQ = 976 * MiB, WS_AK = 992 * MiB, WS_AV = 1008 * MiB;
constexpr size_t WS_SG = 1024 * MiB, WS_SA = 1056 * MiB, WS_YG = 1088 * MiB, WS_YA = 1120 * MiB, WS_T = 1136 * MiB, WS_MG = 1168 * MiB, WS_HN = 1200 * MiB;
constexpr size_t WS_HNG = 1232 * MiB, WS_HD = 1392 * MiB, WS_PY = 1552 * MiB, WS_QH = 1681 * MiB, WS_KIMG = 1697 * MiB, WS_VIMG = 1713 * MiB;
constexpr size_t WS_ACAT = 1729 * MiB, WS_BCAT = 1761 * MiB, WS_KI = 1825 * MiB, WS_KET = 1841 * MiB, WS_UT = 1857 * MiB, WS_DEC = 1889 * MiB, WS_OB = 1890 * MiB, WS_END = 1922 * MiB;
constexpr int CW_CNT = 64;
constexpr int CW_BAR = 4096;

typedef unsigned short bf16;
typedef short bf16x8 __attribute__((ext_vector_type(8)));
typedef float f32x4 __attribute__((ext_vector_type(4)));
typedef unsigned u32x4 __attribute__((ext_vector_type(4)));
typedef unsigned u32x2 __attribute__((ext_vector_type(2)));
#define LAS __attribute__((address_space(3)))
#define GAS __attribute__((address_space(1)))
__device__ __forceinline__ float bf2f(bf16 v) { return __uint_as_float((unsigned)v << 16); }
__device__ __forceinline__ unsigned f2bf(float f) { unsigned u = __float_as_uint(f); return (u + 0x7fffu + ((u >> 16) & 1u)) >> 16; }
__device__ __forceinline__ unsigned pk2(float lo, float hi) { return f2bf(lo) | (f2bf(hi) << 16); }
__device__ __forceinline__ unsigned cvt_pk_bf16(float lo, float hi) { unsigned r; asm volatile("v_cvt_pk_bf16_f32 %0, %1, %2" : "=v"(r) : "v"(lo), "v"(hi)); return r; }
__device__ __forceinline__ float wave_sum(float v) {
#pragma unroll
    for (int o = 1; o < 64; o <<= 1) v += __shfl_xor(v, o);
    return v;
}
__device__ __forceinline__ float sigmoidf_(float x) { return 1.f / (1.f + __expf(-x)); }
__device__ __forceinline__ float log_sigmoid(float z) { return fminf(z, 0.f) - log1pf(__expf(-fabsf(z))); }
#define LDS_WAIT() asm volatile("s_waitcnt lgkmcnt(0)" ::: "memory")
#define VM_WAIT() asm volatile("s_waitcnt vmcnt(0)" ::: "memory")

#define XB_TMO      128
#define XB_XCNT(j)  (256  + 64 * (j))
#define XB_XSUB(j)  (1280 + 64 * (j))
#define XB_XGEN(j)  (2304 + 64 * (j))
#define XB_TOP      3328
#define XB_TOPGEN   3392
#define XCD_BAR_WORDS 3456
#define XB_SPIN_CAP (1u << 18)
__device__ __forceinline__ unsigned xb_ld(unsigned* p)              { return __hip_atomic_load(p, __ATOMIC_RELAXED, __HIP_MEMORY_SCOPE_AGENT); }
__device__ __forceinline__ unsigned xb_add(unsigned* p, unsigned v) { return __hip_atomic_fetch_add(p, v, __ATOMIC_RELAXED, __HIP_MEMORY_SCOPE_AGENT); }
__device__ __forceinline__ unsigned xb_xcc_id() { return (unsigned)__builtin_amdgcn_s_getreg((3 << 11) | 20) & 0xFu; }
#define XB_SPIN(cond, bar) do { unsigned _sp = 0; while (cond) { __builtin_amdgcn_s_sleep(1); \
    if ((++_sp & 255u) == 0u) { if (xb_ld(&(bar)[XB_TMO])) break; if (_sp > XB_SPIN_CAP) { atomicAdd(&(bar)[XB_TMO], 1u); break; } } } } while (0)
struct XcdBarrier { unsigned* bar; unsigned x; volatile LAS unsigned* st; };
__device__ __forceinline__ XcdBarrier xcd_barrier_post(unsigned* bar, volatile LAS unsigned* st) {
    XcdBarrier b; b.bar = bar; b.x = xb_xcc_id(); b.st = st;
    if (threadIdx.x == 0) (void)xb_add(&bar[XB_XCNT(b.x)], 1u);
    return b;
}
__device__ __forceinline__ void xcd_barrier_complete(unsigned* bar, unsigned x, unsigned& nloc, unsigned& nx) {
    const unsigned G = gridDim.x * gridDim.y * gridDim.z;
    unsigned sum, cnt, mine, sp = 0u;
    for (;;) {
        sum = 0u; cnt = 0u; mine = 0u;
#pragma unroll
        for (unsigned j = 0; j < 16; ++j) { const unsigned c = xb_ld(&bar[XB_XCNT(j)]); sum += c; cnt += (c > 0u) ? 1u : 0u; mine = (j == x) ? c : mine; }
        if (sum == G) break;
        __builtin_amdgcn_s_sleep(1);
        if ((++sp & 255u) == 0u) { if (xb_ld(&bar[XB_TMO])) break; if (sp > XB_SPIN_CAP) { atomicAdd(&bar[XB_TMO], 1u); break; } }
    }
    nloc = mine > 0u ? mine : 1u; nx = cnt > 0u ? cnt : 1u;
}
__device__ __forceinline__ void xcd_barrier(const XcdBarrier& b) {
    asm volatile("s_waitcnt vmcnt(0)" ::: "memory");
    __syncthreads();
    if (threadIdx.x == 0) {
        unsigned* bar = b.bar;
        __builtin_amdgcn_s_waitcnt(0);
        unsigned nloc = b.st[0], nx = b.st[1];
        if (nloc == 0u) { xcd_barrier_complete(bar, b.x, nloc, nx); b.st[0] = nloc; b.st[1] = nx; }
        const unsigned old = xb_add(&bar[XB_XSUB(b.x)], 1u);
        const unsigned gen = old / nloc;
        if (old + 1u == (gen + 1u) * nloc) {
            __builtin_amdgcn_fence(__ATOMIC_RELEASE, "agent");
            asm volatile("s_waitcnt vmcnt(0)" ::: "memory");
            const unsigned og = xb_add(&bar[XB_TOP], 1u);
            const unsigned tg = og / nx;
            if (og + 1u == (tg + 1u) * nx) xb_add(&bar[XB_TOPGEN], 1u);
            else XB_SPIN(xb_ld(&bar[XB_TOPGEN]) == tg, bar);
            __builtin_amdgcn_fence(__ATOMIC_ACQUIRE, "agent");
            xb_add(&bar[XB_XGEN(b.x)], 1u);
            asm volatile("s_waitcnt vmcnt(0)" ::: "memory");
        } else {
            XB_SPIN(xb_ld(&bar[XB_XGEN(b.x)]) == gen, bar);
            __builtin_amdgcn_fence(__ATOMIC_ACQUIRE, "agent");
            asm volatile("s_waitcnt vmcnt(0)" ::: "memory");
        }
    }
    __syncthreads();
}

namespace pg8 {
constexpr int BM = 256, BK = 64, HALF = 128, HTB = HALF * BK * 2, STAGE_BYTES = 8 * HTB, NXCD = 8, WGM = 8;
__host__ __device__ __forceinline__ int lds_byte(int r, int c) { const int st = (r >> 4) * 2 + (c >> 5), rr = r & 15, cc = c & 31, ob = rr * 64 + cc * 2; return st * 1024 + (ob ^ (((ob >> 9) & 1) << 5)); }
__host__ __device__ __forceinline__ void stage_rc(int b, int& R, int& C) { const int st = b / 1024, sb = b % 1024, swz = sb ^ (((sb >> 9) & 1) << 5); R = (st >> 1) * 16 + swz / 64; C = (st & 1) * 32 + (swz % 64) / 2; }
__host__ __device__ __forceinline__ int perm32(int rho) { const int n = rho >> 4, i = rho & 15; return 8 * (i >> 2) + 4 * n + (i & 3); }
__device__ __forceinline__ int xcd_remap(int wgid, int nwg) { const int q = nwg / NXCD, r = nwg % NXCD, xcd = wgid % NXCD, off = wgid / NXCD; return (xcd < r ? xcd * (q + 1) : r * (q + 1) + (xcd - r) * q) + off; }

struct Unit { const char* A; const char* B; int pm, pn, e, nrow; };

struct DenseSched {
    const char* A; const char* Bt; int nM, nN, nwg, G, c; size_t tstep;
    __device__ __forceinline__ void init(const void* A_, const void* Bt_, int M, int N, int K, int G_, int c_) { A = (const char*)A_; Bt = (const char*)Bt_; nM = M / BM; nN = N / BM; nwg = nM * nN; G = G_; c = c_; tstep = (size_t)BM * K * 2; }
    __device__ __forceinline__ bool next(int i, Unit& u) const {
        const long L = (long)i * G + c; if (L >= nwg) return false;
        const int wgid = xcd_remap((int)L, nwg);
        const int nig = WGM * nN, gid = wgid / nig, fm = gid * WGM, gsz = (nM - fm) < WGM ? (nM - fm) : WGM;
        u.pm = fm + ((wgid % nig) % gsz); u.pn = (wgid % nig) / gsz; u.e = 0; u.nrow = BM;
        u.A = A + (size_t)u.pm * tstep; u.B = Bt + (size_t)u.pn * tstep; return true;
    }
};
struct MoeSched {
    const char* A; const char* Bt; const volatile LAS int* tstart; const volatile LAS int* cnt; int NT, nwg, G, c; size_t tstep;
    __device__ __forceinline__ void init(const void* A_, const void* Bt_, const volatile LAS int* ts, const volatile LAS int* cn, int NT_, int K, int G_, int c_) {
        A = (const char*)A_; Bt = (const char*)Bt_; tstart = ts; cnt = cn; NT = NT_; nwg = ts[NE] * NT_; G = G_; c = c_; tstep = (size_t)BM * K * 2; }
    __device__ __forceinline__ bool next(int i, Unit& u) const {
        const long L = (long)i * G + c; if (L >= nwg) return false;
        const int wgid = xcd_remap((int)L, nwg);
        int e = 0;
#pragma unroll 1
        for (int j = 1; j < NE; ++j) e = (wgid >= tstart[j] * NT) ? j : e;
        const int t0 = tstart[e], nte = tstart[e + 1] - t0, local = wgid - t0 * NT;
        const int pn = local / nte, mt = local - pn * nte;
        u.e = e; u.pn = pn; u.pm = t0 + mt; u.nrow = cnt[e] - mt * BM;
        u.A = A + (size_t)u.pm * tstep; u.B = Bt + (size_t)(e * NT + pn) * tstep; return true;
    }
};

template <class Epi, class Sched>
__device__ __forceinline__ void gemm_phase(LAS unsigned char* lds, const int K, const int lda, const int ldb, const Sched& S, const Epi& E) {
    const int tid = threadIdx.x, wid = __builtin_amdgcn_readfirstlane(tid >> 6), lane = tid & 63, wr = wid >> 2, wc = wid & 3, fr = lane & 15, fq = lane >> 4;
    int nt = K / BK; asm volatile("" : "+s"(nt));
    unsigned voffA[2], voffB[2];
#pragma unroll
    for (int i = 0; i < 2; ++i) { int R, C; stage_rc(tid * 16 + i * 8192, R, C); const int Rb = Epi::PERM ? ((R & ~31) + perm32(R & 31)) : R;
        voffA[i] = (unsigned)(R * lda + C) * 2u; voffB[i] = (unsigned)(Rb * ldb + C) * 2u; }
    const size_t kstep = (size_t)(BK * 2);
    const size_t hstepA = (size_t)HALF * lda * 2, hstepB = (size_t)HALF * ldb * 2;
    const unsigned ldsw = (unsigned)wid * 1024u;
    const int aoff = lds_byte(wr * 64 + fr, fq * 8), boff = lds_byte(wc * 32 + fr, fq * 8);
#define PG8_SA(b, h) (((b) * 2 + (h)) * HTB)
#define PG8_SB(b, h) ((4 + (b) * 2 + (h)) * HTB)
#define PG8_STAGE(bufoff, gbase, voff) do { _Pragma("unroll") for (int _i = 0; _i < 2; ++_i) \
        __builtin_amdgcn_global_load_lds((const unsigned*)((const char*)(gbase) + (voff)[_i]), (LAS unsigned*)(lds + (bufoff) + ldsw + _i * 8192), 16, 0, 0); } while (0)
#define PG8_LDA(dst, b, h) do { _Pragma("unroll") for (int m = 0; m < 4; ++m) _Pragma("unroll") for (int k = 0; k < 2; ++k) dst[m][k] = *(const LAS bf16x8*)(lds + PG8_SA(b, h) + aoff + m * 2048 + k * 1024); } while (0)
#define PG8_LDB(dst, b, h) do { _Pragma("unroll") for (int n = 0; n < 2; ++n) _Pragma("unroll") for (int k = 0; k < 2; ++k) dst[n][k] = *(const LAS bf16x8*)(lds + PG8_SB(b, h) + boff + n * 2048 + k * 1024); } while (0)
#define PG8_MMA(ai, bj, At, Bt) do { __builtin_amdgcn_s_setprio(1); _Pragma("unroll") for (int m = 0; m < 4; ++m) _Pragma("unroll") for (int n = 0; n < 2; ++n) _Pragma("unroll") for (int k = 0; k < 2; ++k) \
        acc[ai][bj][m][n] = __builtin_amdgcn_mfma_f32_16x16x32_bf16(Bt[n][k], At[m][k], acc[ai][bj][m][n], 0, 0, 0); __builtin_amdgcn_s_setprio(0); } while (0)
#define PG8_WAIT_V(n) asm volatile("s_waitcnt vmcnt(" #n ")" ::: "memory")
#define PG8_WAIT_L(n) asm volatile("s_waitcnt lgkmcnt(" #n ")" ::: "memory")
#define PG8_BAR __builtin_amdgcn_s_barrier()
#define PG8_SCHED __builtin_amdgcn_sched_barrier(0)
    Unit cur, nxt; int ui = 0;
    if (!S.next(0, cur)) return;
    f32x4 acc[2][2][4][2];
#pragma unroll
    for (int a = 0; a < 2; ++a)
#pragma unroll
        for (int b = 0; b < 2; ++b)
#pragma unroll
            for (int m = 0; m < 4; ++m)
#pragma unroll
                for (int n = 0; n < 2; ++n) acc[a][b][m][n] = (f32x4){0.f, 0.f, 0.f, 0.f};
    bf16x8 At[4][2], B0[2][2], B1[2][2];
    const char* cA = cur.A; const char* cB = cur.B;
    PG8_STAGE(PG8_SB(0, 0), cB, voffB); PG8_STAGE(PG8_SB(0, 1), cB + hstepB, voffB); PG8_STAGE(PG8_SA(0, 0), cA, voffA); PG8_STAGE(PG8_SA(0, 1), cA + hstepA, voffA);
    if (wr == 1) PG8_BAR;
    PG8_WAIT_V(2); PG8_BAR;
    PG8_STAGE(PG8_SB(1, 0), cB + kstep, voffB); PG8_STAGE(PG8_SA(1, 0), cA + kstep, voffA); PG8_STAGE(PG8_SB(1, 1), cB + hstepB + kstep, voffB);
    PG8_WAIT_V(6); PG8_BAR;
    for (;;) {
        const bool has_next = S.next(ui + 1, nxt);
        const char* nA = has_next ? nxt.A : cA; const char* nB = has_next ? nxt.B : cB;
#pragma unroll 1
        for (int t = 0; t < nt; t += 2) {
            const bool last = (t == nt - 2);
            const char* a1 = cA + (size_t)(t + 1) * kstep;
            const char* a2 = last ? nA : cA + (size_t)(t + 2) * kstep; const char* b2 = last ? nB : cB + (size_t)(t + 2) * kstep;
            const char* a3 = a2 + kstep; const char* b3 = b2 + kstep;
            PG8_LDB(B0, 0, 0); PG8_LDB(B1, 0, 1); PG8_SCHED; PG8_LDA(At, 0, 0); PG8_STAGE(PG8_SA(1, 1), a1 + hstepA, voffA);
            PG8_WAIT_V(8); PG8_WAIT_L(0); PG8_BAR; PG8_MMA(0, 0, At, B0); PG8_MMA(0, 1, At, B1); PG8_BAR; PG8_SCHED;
            PG8_LDA(At, 0, 1); PG8_STAGE(PG8_SB(0, 0), b2, voffB); PG8_STAGE(PG8_SB(0, 1), b2 + hstepB, voffB); PG8_STAGE(PG8_SA(0, 0), a2, voffA);
            PG8_WAIT_V(8); PG8_WAIT_L(0); PG8_BAR; PG8_MMA(1, 0, At, B0); PG8_MMA(1, 1, At, B1); PG8_BAR; PG8_SCHED;
            PG8_LDB(B0, 1, 0); PG8_LDB(B1, 1, 1); PG8_SCHED; PG8_LDA(At, 1, 0); PG8_STAGE(PG8_SA(0, 1), a2 + hstepA, voffA);
            PG8_WAIT_V(8); PG8_WAIT_L(0); PG8_BAR; PG8_MMA(0, 0, At, B0); PG8_MMA(0, 1, At, B1); PG8_BAR; PG8_SCHED;
            PG8_LDA(At, 1, 1); PG8_STAGE(PG8_SB(1, 0), b3, voffB); PG8_STAGE(PG8_SB(1, 1), b3 + hstepB, voffB); PG8_STAGE(PG8_SA(1, 0), a3, voffA);
            PG8_WAIT_V(8); PG8_WAIT_L(0); PG8_BAR; PG8_MMA(1, 0, At, B0); PG8_MMA(1, 1, At, B1); PG8_BAR; PG8_SCHED;
        }
        if (wr == 0) PG8_BAR;
        E(acc, cur, wr, wc, fr, fq);
        if (!has_next) break;
#pragma unroll
        for (int a = 0; a < 2; ++a)
#pragma unroll
            for (int b = 0; b < 2; ++b)
#pragma unroll
                for (int m = 0; m < 4; ++m)
#pragma unroll
                    for (int n = 0; n < 2; ++n) acc[a][b][m][n] = (f32x4){0.f, 0.f, 0.f, 0.f};
        cur = nxt; cA = nA; cB = nB; ++ui;
        if (wr == 1) PG8_BAR;
    }
    PG8_WAIT_V(0);
    PG8_BAR;
#undef PG8_SA
#undef PG8_SB
#undef PG8_STAGE
#undef PG8_LDA
#undef PG8_LDB
#undef PG8_MMA
#undef PG8_WAIT_V
#undef PG8_WAIT_L
#undef PG8_BAR
#undef PG8_SCHED
}

struct EpiProj {
    static constexpr bool PERM = true;
    unsigned char* ws; const float* bbg;
    __device__ __forceinline__ void operator()(const f32x4 (&acc)[2][2][4][2], const Unit& u, int wr, int wc, int fr, int fq) const {
        const int pn = u.pn; size_t off; int ld, t0, act = 0;
        if (pn < 4) { off = WS_GQ; ld = 1024; t0 = 0; } else if (pn < 8) { off = WS_GK; ld = 1024; t0 = 4; } else if (pn < 16) { off = WS_GV; ld = 2048; t0 = 8; }
        else if (pn < 24) { off = WS_GR; ld = 2048; t0 = 16; act = 1; } else if (pn < 28) { off = WS_AQ; ld = 1024; t0 = 24; } else if (pn < 32) { off = WS_AK; ld = 1024; t0 = 28; }
        else if (pn < 36) { off = WS_AV; ld = 1024; t0 = 32; } else if (pn < 44) { off = WS_SG; ld = 2048; t0 = 36; act = 2; } else { off = WS_SA; ld = 2048; t0 = 44; act = 3; }
        bf16* base = (bf16*)(ws + off);
        const int colt = (pn - t0) * BM + wc * 32 + 8 * fq, row0 = u.pm * BM + wr * 64 + fr;
        f32x4 bv[2][2];
#pragma unroll
        for (int bj = 0; bj < 2; ++bj)
#pragma unroll
            for (int n = 0; n < 2; ++n) bv[bj][n] = act >= 2 ? *(const f32x4*)(bbg + (act - 2) * D + colt + bj * HALF + 4 * n) : (f32x4){0.f, 0.f, 0.f, 0.f};
#pragma unroll
        for (int ai = 0; ai < 2; ++ai)
#pragma unroll
            for (int m = 0; m < 4; ++m) { bf16* rowp = base + (size_t)(row0 + ai * HALF + m * 16) * ld + colt;
#pragma unroll
                for (int bj = 0; bj < 2; ++bj) { f32x4 v0 = acc[ai][bj][m][0] + bv[bj][0], v1 = acc[ai][bj][m][1] + bv[bj][1];
                    if (act == 1) {
#pragma unroll
                        for (int j = 0; j < 4; ++j) { v0[j] = v0[j] * sigmoidf_(v0[j]); v1[j] = v1[j] * sigmoidf_(v1[j]); } }
                    else if (act >= 2) {
#pragma unroll
                        for (int j = 0; j < 4; ++j) { v0[j] = sigmoidf_(v0[j]); v1[j] = sigmoidf_(v1[j]); } }
                    u32x4 w; w.x = cvt_pk_bf16(v0[0], v0[1]); w.y = cvt_pk_bf16(v0[2], v0[3]); w.z = cvt_pk_bf16(v1[0], v1[1]); w.w = cvt_pk_bf16(v1[2], v1[3]);
                    *(u32x4*)(rowp + bj * HALF) = w; } }
    }
};
template <int MODE> struct EpiBranch {
    static constexpr bool PERM = true;
    const bf16* gate; const bf16* tin; bf16* out;
    __device__ __forceinline__ void operator()(const f32x4 (&acc)[2][2][4][2], const Unit& u, int wr, int wc, int fr, int fq) const {
        const int colt = u.pn * BM + wc * 32 + 8 * fq, row0 = u.pm * BM + wr * 64 + fr;
#pragma unroll
        for (int ai = 0; ai < 2; ++ai)
#pragma unroll
            for (int m = 0; m < 4; ++m) { const size_t ro = (size_t)(row0 + ai * HALF + m * 16) * D + colt;
#pragma unroll
                for (int bj = 0; bj < 2; ++bj) {
                    const u32x4 gq = *(const u32x4*)(gate + ro + bj * HALF);
                    u32x4 tq = (u32x4){0u, 0u, 0u, 0u}; if (MODE == 1) tq = *(const u32x4*)(tin + ro + bj * HALF);
                    float r[8];
#pragma unroll
                    for (int j = 0; j < 4; ++j) { r[j] = acc[ai][bj][m][0][j]; r[4 + j] = acc[ai][bj][m][1][j]; }
#pragma unroll
                    for (int j = 0; j < 4; ++j) { const unsigned gw = gq[j], tw = tq[j];
                        r[2 * j] = r[2 * j] * __uint_as_float(gw << 16) + __uint_as_float(tw << 16);
                        r[2 * j + 1] = r[2 * j + 1] * __uint_as_float(gw & 0xffff0000u) + __uint_as_float(tw & 0xffff0000u); }
                    u32x4 w; w.x = cvt_pk_bf16(r[0], r[1]); w.y = cvt_pk_bf16(r[2], r[3]); w.z = cvt_pk_bf16(r[4], r[5]); w.w = cvt_pk_bf16(r[6], r[7]);
                    *(u32x4*)(out + ro + bj * HALF) = w; } }
    }
};
struct EpiResid {
    static constexpr bool PERM = false;
    const float* x; float* out;
    __device__ __forceinline__ void operator()(const f32x4 (&acc)[2][2][4][2], const Unit& u, int wr, int wc, int fr, int fq) const {
        const int col0 = u.pn * BM + wc * 32 + 4 * fq, row0 = u.pm * BM + wr * 64 + fr;
#pragma unroll
        for (int ai = 0; ai < 2; ++ai)
#pragma unroll
            for (int m = 0; m < 4; ++m) { const size_t ro = (size_t)(row0 + ai * HALF + m * 16) * D + col0;
#pragma unroll
                for (int bj = 0; bj < 2; ++bj)
#pragma unroll
                    for (int n = 0; n < 2; ++n) { const f32x4 xv = *(const f32x4*)(x + ro + bj * HALF + n * 16); *(f32x4*)(out + ro + bj * HALF + n * 16) = xv + acc[ai][bj][m][n]; } }
    }
};
struct EpiSwiglu {
    static constexpr bool PERM = true;
    const float* bgate; const float* bup; bf16* hd;
    __device__ __forceinline__ void operator()(const f32x4 (&acc)[2][2][4][2], const Unit& u, int wr, int wc, int fr, int fq) const {
        const int col = u.pn * HALF + wc * 32 + 8 * fq; const size_t row0 = (size_t)u.pm * BM + wr * 64 + fr;
        const float* bg = bgate + (size_t)u.e * DFF + col; const float* bu = bup + (size_t)u.e * DFF + col;
        const f32x4 g0 = *(const f32x4*)bg, g1 = *(const f32x4*)(bg + 4), u0 = *(const f32x4*)bu, u1 = *(const f32x4*)(bu + 4);
#pragma unroll
        for (int ai = 0; ai < 2; ++ai)
#pragma unroll
            for (int m = 0; m < 4; ++m) {
                float r[8];
#pragma unroll
                for (int j = 0; j < 4; ++j) {
                    const float ga = fminf(acc[ai][0][m][0][j] + g0[j], 7.f), ua = fminf(fmaxf(acc[ai][1][m][0][j] + u0[j], -7.f), 7.f);
                    const float gb = fminf(acc[ai][0][m][1][j] + g1[j], 7.f), ub = fminf(fmaxf(acc[ai][1][m][1][j] + u1[j], -7.f), 7.f);
                    r[j] = (ua + 1.f) * (ga * sigmoidf_(1.702f * ga)); r[4 + j] = (ub + 1.f) * (gb * sigmoidf_(1.702f * gb)); }
                u32x4 w; w.x = cvt_pk_bf16(r[0], r[1]); w.y = cvt_pk_bf16(r[2], r[3]); w.z = cvt_pk_bf16(r[4], r[5]); w.w = cvt_pk_bf16(r[6], r[7]);
                *(u32x4*)(hd + (row0 + ai * HALF + m * 16) * DFF + col) = w; }
    }
};
struct EpiDown {
    static constexpr bool PERM = true;
    const float* bdown; const int* rpair; const float* rw; bf16* py;
    __device__ __forceinline__ void operator()(const f32x4 (&acc)[2][2][4][2], const Unit& u, int wr, int wc, int fr, int fq) const {
        const int colt = u.pn * BM + wc * 32 + 8 * fq; const size_t srow0 = (size_t)u.pm * BM + wr * 64 + fr;
        f32x4 bv[2][2];
#pragma unroll
        for (int bj = 0; bj < 2; ++bj)
#pragma unroll
            for (int n = 0; n < 2; ++n) bv[bj][n] = *(const f32x4*)(bdown + (size_t)u.e * D + colt + bj * HALF + 4 * n);
#pragma unroll
        for (int ai = 0; ai < 2; ++ai)
#pragma unroll
            for (int m = 0; m < 4; ++m) { const size_t srow = srow0 + ai * HALF + m * 16; const int pair = rpair[srow]; const float wgt = rw[srow];
                bf16* rowp = py + (size_t)pair * D + colt;
#pragma unroll
                for (int bj = 0; bj < 2; ++bj) { const f32x4 v0 = (acc[ai][bj][m][0] + bv[bj][0]) * wgt, v1 = (acc[ai][bj][m][1] + bv[bj][1]) * wgt;
                    u32x4 w; w.x = cvt_pk_bf16(v0[0], v0[1]); w.y = cvt_pk_bf16(v0[2], v0[3]); w.z = cvt_pk_bf16(v1[0], v1[1]); w.w = cvt_pk_bf16(v1[2], v1[3]);
                    *(u32x4*)(rowp + bj * HALF) = w; } }
    }
};

struct GlaSched {
    int mode, G, c; unsigned char* ws;
    __device__ __forceinline__ bool next(int i, Unit& u) const {
        const int L = i * G + c; const int nu = mode == 0 ? 128 : 256; if (L >= nu) return false;
        const int nh = mode == 0 ? L : (L >> 1), hv = mode == 0 ? 0 : (L & 1);
        u.pm = nh; u.pn = hv; u.e = 0; u.nrow = BM;
        if (mode == 0) { u.A = (const char*)(ws + WS_ACAT) + (size_t)nh * 256 * 512 * 2 + 512; u.B = (const char*)(ws + WS_KI) + (size_t)nh * 256 * 256 * 2; }
        else if (mode == 1) { u.A = (const char*)(ws + WS_BCAT) + (size_t)nh * 512 * 512 * 2 + (size_t)hv * 256 * 512 * 2; u.B = (const char*)(ws + WS_KET) + (size_t)nh * 256 * 256 * 2; }
        else { u.A = (const char*)(ws + WS_ACAT) + (size_t)nh * 256 * 512 * 2; u.B = (const char*)(ws + WS_BCAT) + (size_t)nh * 512 * 512 * 2 + (size_t)hv * 256 * 512 * 2; }
        return true;
    }
};
template <int MODE> struct EpiGla {
    static constexpr bool PERM = true;
    unsigned char* ws;
    __device__ __forceinline__ void operator()(const f32x4 (&acc)[2][2][4][2], const Unit& u, int wr, int wc, int fr, int fq) const {
        const int nh = u.pm, hv = u.pn; const int c8 = wc * 32 + 8 * fq, r0 = wr * 64 + fr;
        bf16* base; int ld;
        if (MODE == 0) { base = (bf16*)(ws + WS_ACAT) + (size_t)nh * 256 * 512; ld = 512; }
        else if (MODE == 1) { base = (bf16*)(ws + WS_UT) + (size_t)nh * 512 * 256 + (size_t)hv * 256 * 256; ld = 256; }
        else { base = (bf16*)(ws + WS_OB) + (size_t)(nh >> 2) * 256 * GLA_V + (nh & 3) * GLA_DV + hv * 256; ld = GLA_V; }
#pragma unroll
        for (int ai = 0; ai < 2; ++ai)
#pragma unroll
            for (int m = 0; m < 4; ++m) { const int row = r0 + ai * HALF + m * 16;
#pragma unroll
                for (int bj = 0; bj < 2; ++bj) { f32x4 v0 = acc[ai][bj][m][0], v1 = acc[ai][bj][m][1]; const int col = bj * HALF + c8;
                    if (MODE == 0) {
#pragma unroll
                        for (int j = 0; j < 4; ++j) { v0[j] = (col + j <= row) ? v0[j] : 0.f; v1[j] = (col + 4 + j <= row) ? v1[j] : 0.f; } }
                    u32x4 w; w.x = cvt_pk_bf16(v0[0], v0[1]); w.y = cvt_pk_bf16(v0[2], v0[3]); w.z = cvt_pk_bf16(v1[0], v1[1]); w.w = cvt_pk_bf16(v1[2], v1[3]);
                    *(u32x4*)(base + (size_t)row * ld + col) = w; } }
    }
};
}

constexpr int NWAVES = 8;
constexpr int RING_BYTES = 131072, MISC_OFF = RING_BYTES + 320, LDS_BYTES = 147456;
constexpr int TAB_OFF = MISC_OFF + 128;

struct Frame {
    LAS unsigned char* lds; volatile LAS unsigned* MISC; unsigned* ctl; unsigned char* ws;
    int tid, lane, wave, vcu, G;
};
struct Args { const float* in[22]; float* out; unsigned char* ws; int ph_lo, ph_hi, li, pad; };

__device__ __forceinline__ void p0_transpose_item(const float* W, int K, int ldn, bf16* WT, int d0, int s0, int k0, LAS float* scr, int lane) {
#pragma unroll 8
    for (int i = 0; i < 32; ++i) { const int kk = 2 * i + (lane >> 5); scr[kk * 33 + (lane & 31)] = W[(size_t)(k0 + kk) * ldn + s0 + (lane & 31)]; }
    LDS_WAIT(); asm volatile("" ::: "memory");
    const int c = lane & 7;
#pragma unroll
    for (int j = 0; j < 4; ++j) { const int n = (lane >> 3) + 8 * j; const LAS float* s = scr + (8 * c) * 33 + n;
        u32x4 o; o.x = pk2(s[0 * 33], s[1 * 33]); o.y = pk2(s[2 * 33], s[3 * 33]); o.z = pk2(s[4 * 33], s[5 * 33]); o.w = pk2(s[6 * 33], s[7 * 33]);
        *(GAS u32x4*)(WT + (size_t)(d0 + n) * K + k0 + 8 * c) = o; }
    LDS_WAIT(); asm volatile("" ::: "memory");
}

__device__ __forceinline__ void p0_prologue(Frame& F, const Args& a) {
    LAS float* scr = (LAS float*)(F.lds + F.wave * 16384);
    const int gw = F.vcu * NWAVES + F.wave, NGW = F.G * NWAVES, lane = F.lane;
    const float* w_in = a.in[2];
    constexpr int I_IN = 32 * (NPROJ / 32), I_BG = 32 * 64, I_BA = 16 * 64, I_OUT = 32 * 64, I_E = 32 * 64;
    constexpr int I_MOE = NE * I_E;
    constexpr int NITEMS = I_IN + I_BG + I_BA + I_OUT + 3 * I_MOE;
    for (int it = gw; it < NITEMS; it += NGW) {
        int r = it;
        if (r < I_IN) { const int nb = r % (NPROJ / 32), kb = r / (NPROJ / 32), d0 = nb * 32; p0_transpose_item(w_in, D, IN_COLS, (bf16*)(F.ws + WS_WIN), d0, d0 < C_GLR ? d0 : d0 + 16, kb * 64, scr, lane); continue; } r -= I_IN;
        if (r < I_BG) { const int nb = r % 64, kb = r / 64; p0_transpose_item(a.in[10], GLA_V, D, (bf16*)(F.ws + WS_WBG), nb * 32, nb * 32, kb * 64, scr, lane); continue; } r -= I_BG;
        if (r < I_BA) { const int nb = r % 64, kb = r / 64; p0_transpose_item(a.in[11], ATT_W, D, (bf16*)(F.ws + WS_WBA), nb * 32, nb * 32, kb * 64, scr, lane); continue; } r -= I_BA;
        if (r < I_OUT) { const int nb = r % 64, kb = r / 64; p0_transpose_item(a.in[12], D, D, (bf16*)(F.ws + WS_WOUT), nb * 32, nb * 32, kb * 64, scr, lane); continue; } r -= I_OUT;
        if (r < 2 * I_MOE) {
            const int which = r / I_MOE; r -= which * I_MOE; const int e = r / I_E; r -= e * I_E; const int nb = r % 64, kb = r / 64, n0 = nb * 32;
            const float* W = (which ? a.in[18] : a.in[16]) + (size_t)e * D * DFF;
            p0_transpose_item(W, D, DFF, (bf16*)(F.ws + WS_GU) + (size_t)e * 2 * DFF * D, (n0 >> 7) * 256 + (n0 & 127) + which * 128, n0, kb * 64, scr, lane); continue; }
        r -= 2 * I_MOE;
        { const int e = r / I_E; r -= e * I_E; const int nb = r % 64, kb = r / 64;
          p0_transpose_item(a.in[20] + (size_t)e * DFF * D, DFF, D, (bf16*)(F.ws + WS_DN) + (size_t)e * D * DFF, nb * 32, nb * 32, kb * 64, scr, lane); }
    }
    const float* x = a.in[0]; const float* g1 = a.in[1]; bf16* XN = (bf16*)(F.ws + WS_XN); float* GLR = (float*)(F.ws + WS_GLR);
    for (int m = gw; m < S; m += NGW) {
        const GAS f32x4* xr = (const GAS f32x4*)(x + (size_t)m * D) + lane;
        f32x4 v[8]; float s = 0.f;
#pragma unroll
        for (int j = 0; j < 8; ++j) { v[j] = xr[64 * j]; s += (v[j].x * v[j].x + v[j].y * v[j].y) + (v[j].z * v[j].z + v[j].w * v[j].w); }
        const float rstd = rsqrtf(wave_sum(s) * (1.f / D) + 1e-6f);
        GAS u32x2* o8 = (GAS u32x2*)(XN + (size_t)m * D) + lane;
        float gl[16];
#pragma unroll
        for (int r = 0; r < 16; ++r) gl[r] = 0.f;
#pragma unroll
        for (int j = 0; j < 8; ++j) { const f32x4 gg = *((const GAS f32x4*)g1 + lane + 64 * j); v[j] = v[j] * rstd * gg;
            u32x2 w; w.x = pk2(v[j].x, v[j].y); w.y = pk2(v[j].z, v[j].w); o8[64 * j] = w;
#pragma unroll
            for (int i = 0; i < 4; ++i) { const GAS f32x4* wp = (const GAS f32x4*)(w_in + (size_t)(256 * j + 4 * lane + i) * IN_COLS + C_GLR);
#pragma unroll
                for (int q = 0; q < 4; ++q) { const f32x4 wv = wp[q]; gl[4 * q] = fmaf(v[j][i], wv.x, gl[4 * q]); gl[4 * q + 1] = fmaf(v[j][i], wv.y, gl[4 * q + 1]); gl[4 * q + 2] = fmaf(v[j][i], wv.z, gl[4 * q + 2]); gl[4 * q + 3] = fmaf(v[j][i], wv.w, gl[4 * q + 3]); } } }
        float mine = 0.f;
#pragma unroll
        for (int r = 0; r < 16; ++r) { const float t = wave_sum(gl[r]); mine = (lane == r) ? t : mine; }
        if (lane < 16) GLR[(size_t)m * 16 + lane] = mine;
    }
    { const float* g2 = a.in[13]; const float* wr = a.in[14]; float* WR = (float*)(F.ws + WS_WR);
      for (int i = (F.vcu * NWAVES * 64) + F.tid; i < D * NE; i += F.G * NWAVES * 64) WR[i] = g2[i >> 5] * wr[i]; }
}

__device__ __forceinline__ void p6_router(Frame& F, const Args& a) {
    const int gw = F.vcu * NWAVES + F.wave, NGW = F.G * NWAVES, lane = F.lane;
    const float* h1 = a.out; const float* g2 = a.in[13]; const float* WR = (const float*)(F.ws + WS_WR); const float* br = a.in[15];
    bf16* HN = (bf16*)(F.ws + WS_HN); float* topw = (float*)(F.ws + WS_TOPW); int* tope = (int*)(F.ws + WS_TOPE); int* tops = (int*)(F.ws + WS_TOPS);
    unsigned* cnt = F.ctl + CW_CNT;
    const int e = lane & 31, half = lane >> 5;
    for (int t = gw; t < S; t += NGW) {
        const float* xr = h1 + (size_t)t * D;
        const GAS f32x4* x4 = (const GAS f32x4*)xr + lane; f32x4 v[8]; float s = 0.f;
#pragma unroll
        for (int j = 0; j < 8; ++j) { v[j] = x4[64 * j]; s += (v[j].x * v[j].x + v[j].y * v[j].y) + (v[j].z * v[j].z + v[j].w * v[j].w); }
        const float rstd = rsqrtf(wave_sum(s) * (1.f / D) + 1e-6f);
        GAS u32x2* o8 = (GAS u32x2*)(HN + (size_t)t * D) + lane;
#pragma unroll
        for (int j = 0; j < 8; ++j) { const f32x4 gg = *((const GAS f32x4*)g2 + lane + 64 * j); const f32x4 y = v[j] * rstd * gg; u32x2 w; w.x = pk2(y.x, y.y); w.y = pk2(y.z, y.w); o8[64 * j] = w; }
        float acc = 0.f;
#pragma unroll 8
        for (int k = half; k < D; k += 2) acc = fmaf(xr[k], WR[(size_t)k * NE + e], acc);
        acc += __shfl_xor(acc, 32);
        const float logit = acc * rstd + br[e];
        float vals[4]; int idxs[4]; float cur = logit;
#pragma unroll
        for (int r = 0; r < 4; ++r) {
            float bv = cur; int bi = e;
#pragma unroll
            for (int o = 1; o < 32; o <<= 1) { const float ov = __shfl_xor(bv, o); const int oi = __shfl_xor(bi, o); if (ov > bv || (ov == bv && oi < bi)) { bv = ov; bi = oi; } }
            vals[r] = bv; idxs[r] = bi;
            if (e == bi) cur = -3.0e38f;
        }
        float ex[4], sum = 0.f;
#pragma unroll
        for (int r = 0; r < 4; ++r) { ex[r] = __expf(vals[r] - vals[0]); sum += ex[r]; }
#pragma unroll
        for (int r = 0; r < 4; ++r) {
            if (lane == r) { const int ee = idxs[r]; const int slot = (int)atomicAdd(&cnt[ee], 1u);
                topw[t * 4 + r] = ex[r] / sum; tope[t * 4 + r] = ee; tops[t * 4 + r] = slot; }
        }
    }
}
__device__ __forceinline__ void moe_table(Frame& F) {
    volatile LAS int* ts = (volatile LAS int*)(F.lds + TAB_OFF); volatile LAS int* cn = (volatile LAS int*)(F.lds + TAB_OFF + 256);
    __syncthreads();
    if (F.tid == 0) { int s = 0; for (int e = 0; e < NE; ++e) { const int c = (int)__hip_atomic_load(F.ctl + CW_CNT + e, __ATOMIC_RELAXED, __HIP_MEMORY_SCOPE_AGENT); cn[e] = c; ts[e] = s; s += (c + 255) >> 8; } ts[NE] = s; }
    __syncthreads();
}
__device__ __forceinline__ void p7_gather(Frame& F) {
    const int gw = F.vcu * NWAVES + F.wave, NGW = F.G * NWAVES, lane = F.lane;
    volatile LAS int* ts = (volatile LAS int*)(F.lds + TAB_OFF);
    const bf16* HN = (const bf16*)(F.ws + WS_HN); bf16* HNG = (bf16*)(F.ws + WS_HNG);
    const float* topw = (const float*)(F.ws + WS_TOPW); const int* tope = (const int*)(F.ws + WS_TOPE); const int* tops = (const int*)(F.ws + WS_TOPS);
    int* rpair = (int*)(F.ws + WS_RPAIR); float* rw = (float*)(F.ws + WS_RW);
    { volatile LAS int* cn = (volatile LAS int*)(F.lds + TAB_OFF + 256);
      for (int e = gw; e < NE; e += NGW) { const int c = cn[e], base = ts[e] * 256, padn = ((c + 255) & ~255) - c;
          for (int r = lane; r < padn; r += 64) { rpair[base + c + r] = S * 4; rw[base + c + r] = 0.f; } } }
    for (int t = gw; t < S; t += NGW) {
        const GAS u32x4* src = (const GAS u32x4*)(HN + (size_t)t * D) + lane; u32x4 v[4];
#pragma unroll
        for (int j = 0; j < 4; ++j) v[j] = src[64 * j];
#pragma unroll
        for (int r = 0; r < 4; ++r) { const int p = t * 4 + r; const int dst = ts[tope[p]] * 256 + tops[p];
            GAS u32x4* d = (GAS u32x4*)(HNG + (size_t)dst * D) + lane;
#pragma unroll
            for (int j = 0; j < 4; ++j) d[64 * j] = v[j];
            if (lane == 0) { rpair[dst] = p; rw[dst] = topw[p]; } }
    }
}
__device__ __forceinline__ void p10_combine(Frame& F, const Args& a) {
    const int gw = F.vcu * NWAVES + F.wave, NGW = F.G * NWAVES, lane = F.lane;
    const bf16* PY = (const bf16*)(F.ws + WS_PY); float* out = a.out;
    for (int t = gw; t < S; t += NGW) {
#pragma unroll
        for (int j = 0; j < 4; ++j) {
            float r[8]; { const f32x4 h0 = *(const GAS f32x4*)(out + (size_t)t * D + 512 * j + 8 * lane), h1v = *(const GAS f32x4*)(out + (size_t)t * D + 512 * j + 8 * lane + 4);
                r[0] = h0.x; r[1] = h0.y; r[2] = h0.z; r[3] = h0.w; r[4] = h1v.x; r[5] = h1v.y; r[6] = h1v.z; r[7] = h1v.w; }
#pragma unroll
            for (int k = 0; k < 4; ++k) { const u32x4 p = *(const GAS u32x4*)(PY + (size_t)(t * 4 + k) * D + 512 * j + 8 * lane);
#pragma unroll
                for (int q = 0; q < 4; ++q) { r[2 * q] += __uint_as_float(p[q] << 16); r[2 * q + 1] += __uint_as_float(p[q] & 0xffff0000u); } }
            *(GAS f32x4*)(out + (size_t)t * D + 512 * j + 8 * lane) = (f32x4){r[0], r[1], r[2], r[3]};
            *(GAS f32x4*)(out + (size_t)t * D + 512 * j + 8 * lane + 4) = (f32x4){r[4], r[5], r[6], r[7]};
        }
    }
}


constexpr float ATT_QSCALE = 0.08838834764831845f * 1.4426950408889634f;
__device__ __forceinline__ void attn_prep_unit(Frame& F, const Args& a, int n, int h) {
    const int wave = F.wave, lane = F.lane, tid = F.tid;
    LAS bf16* kst = (LAS bf16*)(F.lds);
    LAS bf16* vst = (LAS bf16*)(F.lds + 16384);
    const bf16* AQ = (const bf16*)(F.ws + WS_AQ); const bf16* AK = (const bf16*)(F.ws + WS_AK); const bf16* AV = (const bf16*)(F.ws + WS_AV);
    bf16* QH = (bf16*)(F.ws + WS_QH);
    const float* qg = a.in[6]; const float* kg = a.in[7];
    const float gq0 = qg[2 * lane], gq1 = qg[2 * lane + 1], gk0 = kg[2 * lane], gk1 = kg[2 * lane + 1];
#pragma unroll
    for (int i = 0; i < 8; ++i) {
        const int row = n * 64 + wave * 8 + i; const size_t off = (size_t)row * ATT_W + h * ATT_HD + 2 * lane;
        const unsigned qv = *(const unsigned*)(AQ + off), kv = *(const unsigned*)(AK + off), vv = *(const unsigned*)(AV + off);
        const float q0 = __uint_as_float(qv << 16), q1 = __uint_as_float(qv & 0xffff0000u), k0 = __uint_as_float(kv << 16), k1 = __uint_as_float(kv & 0xffff0000u);
        const float rq = rsqrtf(wave_sum(q0 * q0 + q1 * q1) * (1.f / 128.f) + 1e-6f) * ATT_QSCALE, rk = rsqrtf(wave_sum(k0 * k0 + k1 * k1) * (1.f / 128.f) + 1e-6f);
        *(unsigned*)(QH + off) = pk2(q0 * rq * gq0, q1 * rq * gq1);
        *(LAS unsigned*)(kst + (wave * 8 + i) * 128 + 2 * lane) = pk2(k0 * rk * gk0, k1 * rk * gk1);
        *(LAS unsigned*)(vst + (wave * 8 + i) * 128 + 2 * lane) = vv;
    }
    __syncthreads();
    bf16* KI = (bf16*)(F.ws + WS_KIMG) + (size_t)(n * ATT_H + h) * 8192; bf16* VI = (bf16*)(F.ws + WS_VIMG) + (size_t)(n * ATT_H + h) * 8192;
#pragma unroll
    for (int i = 0; i < 2; ++i) {
        const int g = tid + 512 * i;
        { const int c16 = g >> 6, key = g & 63; const u32x4 v = *(const LAS u32x4*)(kst + key * 128 + c16 * 8); *(u32x4*)(KI + (size_t)g * 8) = v; }
        { const int kg8 = g >> 7, d = g & 127; unsigned short e[8];
#pragma unroll
          for (int j = 0; j < 8; ++j) e[j] = vst[(kg8 * 8 + j) * 128 + d];
          u32x4 v; v.x = e[0] | ((unsigned)e[1] << 16); v.y = e[2] | ((unsigned)e[3] << 16); v.z = e[4] | ((unsigned)e[5] << 16); v.w = e[6] | ((unsigned)e[7] << 16);
          *(u32x4*)(VI + (size_t)g * 8) = v; }
    }
    __syncthreads();
}

typedef float f32x16 __attribute__((ext_vector_type(16)));
__device__ __forceinline__ int crow(int r, int hi) { return (r & 3) + 8 * (r >> 2) + 4 * hi; }
__device__ __forceinline__ void attn_unit(Frame& F, const Args& a, int n4, int h) {
    const int w = F.wave, lane = F.lane, r32 = lane & 31, hi = lane >> 5, tid = F.tid;
    const int p = w >> 1, half = w & 1, c = 4 * n4 + p, qrow0 = c * 64 + 32 * half;
    LAS unsigned char* lds = F.lds;
    LAS float* btab = (LAS float*)(lds + 65536); LAS float* xch = (LAS float*)(lds + 67584 + 256 * w); LAS bf16* ost = (LAS bf16*)(lds + 8192 * w);
    const float* relb = a.in[8] + h * 257;
    if (tid < 257) btab[tid] = relb[tid] * 1.4426950408889634f;
    const bf16* QH = (const bf16*)(F.ws + WS_QH);
    bf16x8 qf[8];
#pragma unroll
    for (int d0 = 0; d0 < 8; ++d0) qf[d0] = *(const bf16x8*)(QH + (size_t)(qrow0 + r32) * ATT_W + h * ATT_HD + d0 * 16 + hi * 8);
    const char* KIMG = (const char*)(F.ws + WS_KIMG); const char* VIMG = (const char*)(F.ws + WS_VIMG);
    f32x16 o[4];
#pragma unroll
    for (int dt = 0; dt < 4; ++dt)
#pragma unroll
        for (int r = 0; r < 16; ++r) o[dt][r] = 0.f;
    float m = -1.0e30f, l = 0.f;
    const int s0 = (4 * n4 - 8 < 0) ? (8 - 4 * n4) : 0;
#define ATT_STAGE(s_) do { const int kc_ = 4 * n4 - 8 + (s_); const size_t gb_ = (size_t)(kc_ * ATT_H + h) * 16384; const unsigned lb_ = ((s_) & 1) * 32768; \
        _Pragma("unroll") for (int i_ = 0; i_ < 2; ++i_) { const int pc_ = w + 8 * i_; \
            __builtin_amdgcn_global_load_lds((const unsigned*)(KIMG + gb_ + pc_ * 1024 + lane * 16), (LAS unsigned*)(lds + lb_ + pc_ * 1024), 16, 0, 0); \
            __builtin_amdgcn_global_load_lds((const unsigned*)(VIMG + gb_ + pc_ * 1024 + lane * 16), (LAS unsigned*)(lds + lb_ + 16384 + pc_ * 1024), 16, 0, 0); } } while (0)
    ATT_STAGE(s0);
    for (int s = s0; s < 12; ++s) {
        asm volatile("s_waitcnt vmcnt(0) lgkmcnt(0)" ::: "memory");
        __builtin_amdgcn_s_barrier();
        if (s + 1 < 12) ATT_STAGE(s + 1);
        if (s >= p && s <= p + 8) {
            const LAS unsigned char* kb = lds + (s & 1) * 32768; const LAS unsigned char* vb = kb + 16384;
            f32x16 p0, p1;
#pragma unroll
            for (int r = 0; r < 16; ++r) { p0[r] = 0.f; p1[r] = 0.f; }
#pragma unroll
            for (int d0 = 0; d0 < 8; ++d0) {
                const bf16x8 k0 = *(const LAS bf16x8*)(kb + (2 * d0 + hi) * 1024 + r32 * 16), k1 = *(const LAS bf16x8*)(kb + (2 * d0 + hi) * 1024 + (r32 + 32) * 16);
                p0 = __builtin_amdgcn_mfma_f32_32x32x16_bf16(k0, qf[d0], p0, 0, 0, 0);
                p1 = __builtin_amdgcn_mfma_f32_32x32x16_bf16(k1, qf[d0], p1, 0, 0, 0);
                if (d0 & 1) __builtin_amdgcn_sched_barrier(0);
            }
            const int wrel = p + 8 - s;
            if (wrel >= 3) { const float bc = btab[256];
#pragma unroll
                for (int r = 0; r < 16; ++r) { p0[r] += bc; p1[r] += bc; } }
            else { const int base = 64 * wrel + 32 * half + r32 + 128;
#pragma unroll
                for (int r = 0; r < 16; ++r) { int i0 = base - crow(r, hi), i1 = i0 - 32; i0 = i0 > 256 ? 256 : i0; i1 = i1 > 256 ? 256 : i1; i1 = i1 < 0 ? 0 : i1; i0 = i0 < 0 ? 0 : i0; p0[r] += btab[i0]; p1[r] += btab[i1]; } }
            float mx = p0[0];
#pragma unroll
            for (int r = 1; r < 16; ++r) mx = fmaxf(mx, p0[r]);
#pragma unroll
            for (int r = 0; r < 16; ++r) mx = fmaxf(mx, p1[r]);
            mx = fmaxf(mx, __shfl_xor(mx, 32));
            const float mn = fmaxf(m, mx), alpha = __builtin_amdgcn_exp2f(m - mn);
            float ps = 0.f;
#pragma unroll
            for (int r = 0; r < 16; ++r) { p0[r] = __builtin_amdgcn_exp2f(p0[r] - mn); p1[r] = __builtin_amdgcn_exp2f(p1[r] - mn); ps += p0[r] + p1[r]; }
            l = l * alpha + ps;
            if (__any(mn > m)) {
                if (hi == 0) xch[r32] = alpha;
                asm volatile("s_waitcnt lgkmcnt(0)" ::: "memory");
#pragma unroll
                for (int g = 0; g < 4; ++g) { const f32x4 av = *(const LAS f32x4*)(xch + 8 * g + 4 * hi);
#pragma unroll
                    for (int dt = 0; dt < 4; ++dt) { o[dt][4 * g] *= av[0]; o[dt][4 * g + 1] *= av[1]; o[dt][4 * g + 2] *= av[2]; o[dt][4 * g + 3] *= av[3]; } }
            }
            m = mn;
            bf16x8 pa[4];
#pragma unroll
            for (int ks = 0; ks < 4; ++ks) { const f32x16& src = (ks < 2) ? p0 : p1; const int b = (ks & 1) * 8; u32x4 t;
                t.x = cvt_pk_bf16(src[b], src[b + 1]); t.y = cvt_pk_bf16(src[b + 2], src[b + 3]); t.z = cvt_pk_bf16(src[b + 4], src[b + 5]); t.w = cvt_pk_bf16(src[b + 6], src[b + 7]);
                pa[ks] = __builtin_bit_cast(bf16x8, t); }
#pragma unroll
            for (int dt = 0; dt < 4; ++dt)
#pragma unroll
                for (int ks = 0; ks < 4; ++ks) {
                    const LAS unsigned char* vp = vb + (2 * ks) * 2048 + (32 * dt + r32) * 16 + 8 * hi;
                    const u32x2 lo = *(const LAS u32x2*)vp, hh = *(const LAS u32x2*)(vp + 2048);
                    const u32x4 bq = (u32x4){lo.x, lo.y, hh.x, hh.y};
                    o[dt] = __builtin_amdgcn_mfma_f32_32x32x16_bf16(pa[ks], __builtin_bit_cast(bf16x8, bq), o[dt], 0, 0, 0);
                    if (ks == 3) __builtin_amdgcn_sched_barrier(0);
                }
        }
    }
#undef ATT_STAGE
    asm volatile("s_waitcnt lgkmcnt(0)" ::: "memory");
    __builtin_amdgcn_s_barrier();
    l += __shfl_xor(l, 32);
    if (hi == 0) xch[32 + r32] = 1.f / l;
    asm volatile("s_waitcnt lgkmcnt(0)" ::: "memory");
#pragma unroll
    for (int g = 0; g < 4; ++g) { const f32x4 iv = *(const LAS f32x4*)(xch + 32 + 8 * g + 4 * hi);
#pragma unroll
        for (int dt = 0; dt < 4; ++dt)
#pragma unroll
            for (int j = 0; j < 4; ++j) ost[(8 * g + 4 * hi + j) * 128 + 32 * dt + r32] = (bf16)f2bf(o[dt][4 * g + j] * iv[j]); }
    asm volatile("s_waitcnt lgkmcnt(0)" ::: "memory");
    bf16* YA = (bf16*)(F.ws + WS_YA);
#pragma unroll
    for (int i = 0; i < 8; ++i) { const int g = i * 64 + lane, row = g >> 4, c16 = g & 15; const u32x4 v = *(const LAS u32x4*)(ost + row * 128 + c16 * 8);
        *(u32x4*)(YA + (size_t)(qrow0 + row) * ATT_W + h * ATT_HD + c16 * 8) = v; }
    asm volatile("s_waitcnt vmcnt(0) lgkmcnt(0)" ::: "memory");
    __builtin_amdgcn_s_barrier();
}


__device__ __forceinline__ void gla_prep_unit(Frame& F, const Args& a, int n, int cg) {
    const int tid = F.tid, cq = tid & 15, seg = tid >> 4;
    const int h = cg >> 2, dk0 = (cg & 3) * 64 + 4 * cq, col0 = h * GLA_DK + dk0, nh = n * GLA_H + h;
    const float* wgu = a.in[3]; const float* bgt = a.in[4]; const float* GLR = (const float*)(F.ws + WS_GLR);
    const bf16* GQ = (const bf16*)(F.ws + WS_GQ); const bf16* GK = (const bf16*)(F.ws + WS_GK);
    LAS float* tot = (LAS float*)F.lds;
    f32x4 w[16];
#pragma unroll
    for (int r = 0; r < 16; ++r) w[r] = *(const f32x4*)(wgu + r * GLA_QK + col0);
    const f32x4 bgv = *(const f32x4*)(bgt + col0);
    f32x4 cs[8]; f32x4 run = (f32x4){0.f, 0.f, 0.f, 0.f};
    const int t0 = n * 256 + seg * 8;
#pragma unroll
    for (int i = 0; i < 8; ++i) {
        const f32x4* gp = (const f32x4*)(GLR + (size_t)(t0 + i) * 16); f32x4 z = bgv;
#pragma unroll
        for (int q = 0; q < 4; ++q) { const f32x4 gv = gp[q]; z += w[4 * q] * gv.x; z += w[4 * q + 1] * gv.y; z += w[4 * q + 2] * gv.z; z += w[4 * q + 3] * gv.w; }
#pragma unroll
        for (int j = 0; j < 4; ++j) run[j] += log_sigmoid(z[j]) * (1.f / 16.f);
        cs[i] = run;
    }
    *(LAS f32x4*)(tot + seg * 64 + 4 * cq) = run;
    __syncthreads();
    f32x4 off = (f32x4){0.f, 0.f, 0.f, 0.f}, total = (f32x4){0.f, 0.f, 0.f, 0.f};
    for (int sg = 0; sg < 32; ++sg) { const f32x4 tv = *(const LAS f32x4*)(tot + sg * 64 + 4 * cq); total += tv; if (sg < seg) off += tv; }
    unsigned kew[4][4];
    bf16* ACAT = (bf16*)(F.ws + WS_ACAT); bf16* KI = (bf16*)(F.ws + WS_KI); bf16* KET = (bf16*)(F.ws + WS_KET);
    float kprev[4];
#pragma unroll
    for (int i = 0; i < 8; ++i) {
        const size_t trow = (size_t)(t0 + i);
        const u32x2 qv = *(const u32x2*)(GQ + trow * GLA_QK + col0), kv = *(const u32x2*)(GK + trow * GLA_QK + col0);
        float q[4] = {__uint_as_float(qv.x << 16), __uint_as_float(qv.x & 0xffff0000u), __uint_as_float(qv.y << 16), __uint_as_float(qv.y & 0xffff0000u)};
        float k[4] = {__uint_as_float(kv.x << 16), __uint_as_float(kv.x & 0xffff0000u), __uint_as_float(kv.y << 16), __uint_as_float(kv.y & 0xffff0000u)};
        float qd[4], ki[4], ke[4];
#pragma unroll
        for (int j = 0; j < 4; ++j) { const float bc = cs[i][j] + off[j]; qd[j] = q[j] * 0.0625f * __expf(bc); ki[j] = k[j] * __expf(-bc); ke[j] = k[j] * __expf(total[j] - bc); }
        const size_t lrow = (size_t)nh * 256 + seg * 8 + i;
        u32x2 o; o.x = pk2(qd[0], qd[1]); o.y = pk2(qd[2], qd[3]); *(u32x2*)(ACAT + lrow * 512 + 256 + dk0) = o;
        o.x = pk2(ki[0], ki[1]); o.y = pk2(ki[2], ki[3]); *(u32x2*)(KI + lrow * 256 + dk0) = o;
        if (i & 1) {
#pragma unroll
            for (int j = 0; j < 4; ++j) kew[j][i >> 1] = pk2(kprev[j], ke[j]); }
        else {
#pragma unroll
            for (int j = 0; j < 4; ++j) kprev[j] = ke[j]; }
    }
#pragma unroll
    for (int j = 0; j < 4; ++j) *(u32x4*)(KET + ((size_t)nh * 256 + dk0 + j) * 256 + seg * 8) = (u32x4){kew[j][0], kew[j][1], kew[j][2], kew[j][3]};
    if (seg == 0) *(f32x4*)((float*)(F.ws + WS_DEC) + n * GLA_QK + col0) = (f32x4){__expf(total[0]), __expf(total[1]), __expf(total[2]), __expf(total[3])};
    __syncthreads();
}
__device__ __forceinline__ void gla_vt_unit(Frame& F, int n, int h, int g8) {
    const int tid = F.tid; const int nh = n * GLA_H + h;
    LAS bf16* tile = (LAS bf16*)F.lds;
    const bf16* GV = (const bf16*)(F.ws + WS_GV); bf16* BCAT = (bf16*)(F.ws + WS_BCAT);
#pragma unroll
    for (int ps = 0; ps < 4; ++ps) { const int row = (tid >> 3) + 64 * ps, ch = tid & 7;
        const u32x4 v = *(const u32x4*)(GV + (size_t)(n * 256 + row) * GLA_V + h * GLA_DV + g8 * 64 + ch * 8);
        *(LAS u32x2*)(tile + row * 72 + ch * 8) = (u32x2){v.x, v.y}; *(LAS u32x2*)(tile + row * 72 + ch * 8 + 4) = (u32x2){v.z, v.w}; }
    __syncthreads();
#pragma unroll
    for (int i = 0; i < 4; ++i) { const int g = tid + 512 * i, c = g & 63, tg = g >> 6; unsigned short e[8];
#pragma unroll
        for (int j = 0; j < 8; ++j) e[j] = tile[(tg * 8 + j) * 72 + c];
        u32x4 v; v.x = e[0] | ((unsigned)e[1] << 16); v.y = e[2] | ((unsigned)e[3] << 16); v.z = e[4] | ((unsigned)e[5] << 16); v.w = e[6] | ((unsigned)e[7] << 16);
        *(u32x4*)(BCAT + ((size_t)nh * 512 + g8 * 64 + c) * 512 + tg * 8) = v; }
    __syncthreads();
}
__device__ __forceinline__ void gla_scan(Frame& F) {
    const bf16* UT = (const bf16*)(F.ws + WS_UT); bf16* BCAT = (bf16*)(F.ws + WS_BCAT); const float* DEC = (const float*)(F.ws + WS_DEC);
    for (int idx = F.vcu * (NWAVES * 64) + F.tid; idx < GLA_H * GLA_DV * 64; idx += F.G * NWAVES * 64) {
        const int dk4 = (idx & 63) * 4, dv = (idx >> 6) & 511, h = idx >> 15;
        float s[4] = {0.f, 0.f, 0.f, 0.f};
#pragma unroll 8
        for (int n = 0; n < 32; ++n) {
            const size_t nh = (size_t)n * GLA_H + h;
            u32x2 o; o.x = pk2(s[0], s[1]); o.y = pk2(s[2], s[3]); *(u32x2*)(BCAT + (nh * 512 + dv) * 512 + 256 + dk4) = o;
            const u32x2 uv = *(const u32x2*)(UT + (nh * 512 + dv) * 256 + dk4); const f32x4 dc = *(const f32x4*)(DEC + n * GLA_QK + h * GLA_DK + dk4);
            s[0] = s[0] * dc.x + __uint_as_float(uv.x << 16); s[1] = s[1] * dc.y + __uint_as_float(uv.x & 0xffff0000u);
            s[2] = s[2] * dc.z + __uint_as_float(uv.y << 16); s[3] = s[3] * dc.w + __uint_as_float(uv.y & 0xffff0000u);
        }
    }
}
__device__ __forceinline__ void gla_norm(Frame& F, const Args& a) {
    const int gw = F.vcu * NWAVES + F.wave, NGW = F.G * NWAVES, lane = F.lane;
    const bf16* OB = (const bf16*)(F.ws + WS_OB); const bf16* GR = (const bf16*)(F.ws + WS_GR); bf16* YG = (bf16*)(F.ws + WS_YG); const float* g = a.in[5];
    const f32x4 g0 = *(const f32x4*)(g + 8 * lane), g1 = *(const f32x4*)(g + 8 * lane + 4);
    for (int wi = gw; wi < S * GLA_H; wi += NGW) {
        const size_t off = (size_t)(wi >> 2) * GLA_V + (wi & 3) * GLA_DV + 8 * lane;
        const u32x4 ov = *(const u32x4*)(OB + off), rv = *(const u32x4*)(GR + off);
        float o[8], r[8]; float ss = 0.f;
#pragma unroll
        for (int j = 0; j < 4; ++j) { o[2 * j] = __uint_as_float(ov[j] << 16); o[2 * j + 1] = __uint_as_float(ov[j] & 0xffff0000u); r[2 * j] = __uint_as_float(rv[j] << 16); r[2 * j + 1] = __uint_as_float(rv[j] & 0xffff0000u); }
#pragma unroll
        for (int j = 0; j < 8; ++j) ss += o[j] * o[j];
        const float rstd = rsqrtf(wave_sum(ss) * (1.f / GLA_DV) + 1e-6f);
        u32x4 w; w.x = pk2(o[0] * rstd * g0.x * r[0], o[1] * rstd * g0.y * r[1]); w.y = pk2(o[2] * rstd * g0.z * r[2], o[3] * rstd * g0.w * r[3]);
        w.z = pk2(o[4] * rstd * g1.x * r[4], o[5] * rstd * g1.y * r[5]); w.w = pk2(o[6] * rstd * g1.z * r[6], o[7] * rstd * g1.w * r[7]);
        *(u32x4*)(YG + off) = w;
    }
}

__global__ void __launch_bounds__(NWAVES * 64, 2) fwd(Args args) {
    extern __shared__ __attribute__((aligned(16))) unsigned char lds_raw[];
    Frame F;
    F.lds = (LAS unsigned char*)lds_raw; F.MISC = (volatile LAS unsigned*)(F.lds + MISC_OFF);
    F.tid = threadIdx.x; F.lane = F.tid & 63; F.wave = __builtin_amdgcn_readfirstlane(F.tid >> 6);
    F.G = gridDim.x; { const int bx = blockIdx.x; F.vcu = (F.G % 8 == 0) ? (bx % 8) * (F.G / 8) + bx / 8 : bx; }
    F.ws = args.ws; F.ctl = (unsigned*)(args.ws + WS_CTL);
    for (int u = F.tid; u < (LDS_BYTES - RING_BYTES) / 4; u += NWAVES * 64) ((LAS unsigned*)(F.lds + RING_BYTES))[u] = 0u;
    __syncthreads();
    XcdBarrier bar = xcd_barrier_post(F.ctl + CW_BAR + args.li * XCD_BAR_WORDS, F.MISC + 8);
    const int lo = args.ph_lo, hi = args.ph_hi;
#define IN(k) (lo <= (k) && (k) < hi)
#define SEAM(k) do { if (IN(k) && IN((k) + 1)) xcd_barrier(bar); } while (0)
    unsigned char* ws = args.ws;
    if (IN(0)) { p0_prologue(F, args); } SEAM(0);
    if (IN(1)) { pg8::DenseSched Sc; Sc.init(ws + WS_XN, ws + WS_WIN, S, NPROJ, D, F.G, (int)blockIdx.x); pg8::EpiProj E{ws, args.in[9]};
        pg8::gemm_phase<pg8::EpiProj, pg8::DenseSched>(F.lds, D, D, D, Sc, E); } SEAM(1);
    if (IN(2)) { for (int u = F.vcu; u < NCH * ATT_H; u += F.G) attn_prep_unit(F, args, u >> 3, u & 7);
        for (int u = F.vcu; u < 32 * 16; u += F.G) gla_prep_unit(F, args, u >> 4, u & 15);
        for (int u = F.vcu; u < 32 * GLA_H * 8; u += F.G) gla_vt_unit(F, u >> 5, (u >> 3) & 3, u & 7); } SEAM(2);
    if (IN(3)) { for (int u = F.vcu; u < (NCH / 4) * ATT_H; u += F.G) attn_unit(F, args, u >> 3, u & 7);
        { pg8::GlaSched Sc{0, F.G, F.G - 1 - (int)blockIdx.x, ws}; pg8::EpiGla<0> E{ws}; pg8::gemm_phase<pg8::EpiGla<0>, pg8::GlaSched>(F.lds, 256, 512, 256, Sc, E); }
        { pg8::GlaSched Sc{1, F.G, (int)blockIdx.x, ws}; pg8::EpiGla<1> E{ws}; pg8::gemm_phase<pg8::EpiGla<1>, pg8::GlaSched>(F.lds, 256, 512, 256, Sc, E); } } SEAM(3);
    if (IN(4)) { gla_scan(F); } SEAM(4);
    if (IN(5)) { pg8::GlaSched Sc{2, F.G, (int)blockIdx.x, ws}; pg8::EpiGla<2> E{ws}; pg8::gemm_phase<pg8::EpiGla<2>, pg8::GlaSched>(F.lds, 512, 512, 512, Sc, E); } SEAM(5);
    if (IN(6)) { gla_norm(F, args); } SEAM(6);
    if (IN(7)) { pg8::DenseSched Sc; Sc.init(ws + WS_YG, ws + WS_WBG, S, D, GLA_V, F.G, (int)blockIdx.x); pg8::EpiBranch<0> E{(const bf16*)(ws + WS_SG), nullptr, (bf16*)(ws + WS_T)};
        pg8::gemm_phase<pg8::EpiBranch<0>, pg8::DenseSched>(F.lds, GLA_V, GLA_V, GLA_V, Sc, E); } SEAM(7);
    if (IN(8)) { pg8::DenseSched Sc; Sc.init(ws + WS_YA, ws + WS_WBA, S, D, ATT_W, F.G, (int)blockIdx.x); pg8::EpiBranch<1> E{(const bf16*)(ws + WS_SA), (const bf16*)(ws + WS_T), (bf16*)(ws + WS_MG)};
        pg8::gemm_phase<pg8::EpiBranch<1>, pg8::DenseSched>(F.lds, ATT_W, ATT_W, ATT_W, Sc, E); } SEAM(8);
    if (IN(9)) { pg8::DenseSched Sc; Sc.init(ws + WS_MG, ws + WS_WOUT, S, D, D, F.G, (int)blockIdx.x); pg8::EpiResid E{args.in[0], args.out};
        pg8::gemm_phase<pg8::EpiResid, pg8::DenseSched>(F.lds, D, D, D, Sc, E); } SEAM(9);
    if (IN(10)) { p6_router(F, args); } SEAM(10);
    if (IN(11)) { moe_table(F); p7_gather(F); } SEAM(11);
    if (IN(12)) { moe_table(F); pg8::MoeSched Sc; Sc.init(ws + WS_HNG, ws + WS_GU, (volatile LAS int*)(F.lds + TAB_OFF), (volatile LAS int*)(F.lds + TAB_OFF + 256), 16, D, F.G, (int)blockIdx.x);
        pg8::EpiSwiglu E{args.in[17], args.in[19], (bf16*)(ws + WS_HD)};
        pg8::gemm_phase<pg8::EpiSwiglu, pg8::MoeSched>(F.lds, D, D, D, Sc, E); } SEAM(12);
    if (IN(13)) { moe_table(F); pg8::MoeSched Sc; Sc.init(ws + WS_HD, ws + WS_DN, (volatile LAS int*)(F.lds + TAB_OFF), (volatile LAS int*)(F.lds + TAB_OFF + 256), 8, DFF, F.G, (int)blockIdx.x);
        pg8::EpiDown E{args.in[21], (const int*)(ws + WS_RPAIR), (const float*)(ws + WS_RW), (bf16*)(ws + WS_PY)};
        pg8::gemm_phase<pg8::EpiDown, pg8::MoeSched>(F.lds, DFF, DFF, DFF, Sc, E); } SEAM(13);
    if (IN(14)) { p10_combine(F, args); }
#undef IN
#undef SEAM
}

extern "C" void kernel_launch(void* const* d_in, const int* in_sizes, int n_in, void* d_out, int out_size, void* d_ws, size_t ws_size, hipStream_t stream) {
    static int grid = 0;
    if (grid == 0) {
        if (n_in != 22 || out_size != S * D || ws_size < WS_END) { fprintf(stderr, "kernel_launch: unexpected problem (n_in %d out %d ws %zu)\n", n_in, out_size, ws_size); grid = -1; return; }
        int dev = 0, cus = 0, per_cu = 0;
        if (hipGetDevice(&dev) != hipSuccess || hipDeviceGetAttribute(&cus, hipDeviceAttributeMultiprocessorCount, dev) != hipSuccess) { grid = -1; return; }
        if (hipFuncSetAttribute((const void*)fwd, hipFuncAttributeMaxDynamicSharedMemorySize, LDS_BYTES) != hipSuccess) { fprintf(stderr, "kernel_launch: hipFuncSetAttribute failed\n"); grid = -1; return; }
        if (hipOccupancyMaxActiveBlocksPerMultiprocessor(&per_cu, (const void*)fwd, NWAVES * 64, LDS_BYTES) != hipSuccess || per_cu < 1) fprintf(stderr, "kernel_launch: occupancy query says %d\n", per_cu);
        (void)hipGetLastError();
        grid = cus;
    }
    if (grid < 0) return;
    (void)hipMemsetAsync((char*)d_ws + WS_CTL, 0, CTL_ZERO_BYTES, stream);
    Args a{};
    for (int i = 0; i < 22; ++i) a.in[i] = (const float*)d_in[i];
    a.out = (float*)d_out; a.ws = (unsigned char*)d_ws;
    a.ph_lo = 0; a.ph_hi = 15; a.li = 0;
    hipLaunchKernelGGL(fwd, dim3(grid), dim3(NWAVES * 64), LDS_BYTES, stream, a);
}
```

```cpp
#include <hip/hip_runtime.h>
#include <stdint.h>
#include <cstdio>

constexpr int S = 8192, D = 2048;
constexpr int GLA_H = 4, GLA_DK = 256, GLA_DV = 512, GLA_QK = 1024, GLA_V = 2048;
constexpr int ATT_H = 8, ATT_HD = 128, ATT_W = 1024, NCH = S / 64;
constexpr int NE = 32, DFF = 2048;
constexpr int IN_COLS = 13328, C_GLR = 6144;
constexpr int NPROJ = 13312;
constexpr int MAXROWS = 32768 + NE * 256;

constexpr size_t MiB = 1u << 20;
constexpr size_t WS_CTL = 0, CTL_ZERO_BYTES = 1 * MiB;
constexpr size_t WS_TOPW = 1 * MiB, WS_TOPE = WS_TOPW + 128 * 1024, WS_TOPS = WS_TOPE + 128 * 1024, WS_RPAIR = WS_TOPS + 128 * 1024, WS_RW = WS_RPAIR + 256 * 1024;
constexpr size_t WS_GLR = 2 * MiB, WS_WR = 3 * MiB;
constexpr size_t WS_WIN = 8 * MiB, WS_WBG = 60 * MiB, WS_WBA = 68 * MiB, WS_WOUT = 72 * MiB, WS_GU = 80 * MiB, WS_DN = 592 * MiB;
constexpr size_t WS_XN = 848 * MiB, WS_GQ = 880 * MiB, WS_GK = 896 * MiB, WS_GV = 912 * MiB, WS_GR = 944 * MiB, WS_AQ = 976 * MiB, WS_AK = 992 * MiB, WS_AV = 1008 * MiB;
constexpr size_t WS_SG = 1024 * MiB, WS_SA = 1056 * MiB, WS_YG = 1088 * MiB, WS_YA = 1120 * MiB, WS_T = 1136 * MiB, WS_MG = 1168 * MiB, WS_HN = 1200 * MiB;
constexpr size_t WS_HNG = 1232 * MiB, WS_HD = 1392 * MiB, WS_PY = 1552 * MiB, WS_QH = 1681 * MiB, WS_KIMG = 1697 * MiB, WS_VIMG = 1713 * MiB;
constexpr size_t WS_ACAT = 1729 * MiB, WS_BCAT = 1761 * MiB, WS_KI = 1825 * MiB, WS_KET = 1841 * MiB, WS_UT = 1857 * MiB, WS_DEC = 1889 * MiB, WS_OB = 1890 * MiB, WS_END = 1922 * MiB;
constexpr int CW_CNT = 64;
constexpr int CW_BAR = 4096;

typedef unsigned short bf16;
typedef short bf16x8 __attribute__((ext_vector_type(8)));
typedef float f32x4 __attribute__((ext_vector_type(4)));
typedef float f32x16 __attribute__((ext_vector_type(16)));
typedef unsigned u32x4 __attribute__((ext_vector_type(4)));
typedef unsigned u32x2 __attribute__((ext_vector_type(2)));
#define LAS __attribute__((address_space(3)))
#define GAS __attribute__((address_space(1)))
__device__ __forceinline__ float bf2f(bf16 v) { return __uint_as_float((unsigned)v << 16); }
__device__ __forceinline__ unsigned f2bf(float f) { unsigned u = __float_as_uint(f); return (u + 0x7fffu + ((u >> 16) & 1u)) >> 16; }
__device__ __forceinline__ unsigned pk2(float lo, float hi) { return f2bf(lo) | (f2bf(hi) << 16); }
__device__ __forceinline__ unsigned cvt_pk_bf16(float lo, float hi) { unsigned r; asm volatile("v_cvt_pk_bf16_f32 %0, %1, %2" : "=v"(r) : "v"(lo), "v"(hi)); return r; }
__device__ __forceinline__ float wave_sum(float v) {
#pragma unroll
    for (int o = 1; o < 64; o <<= 1) v += __shfl_xor(v, o);
    return v;
}
__device__ __forceinline__ float sigmoidf_(float x) { return 1.f / (1.f + __expf(-x)); }
__device__ __forceinline__ float log_sigmoid(float z) { return fminf(z, 0.f) - log1pf(__expf(-fabsf(z))); }
#define LDS_WAIT() asm volatile("s_waitcnt lgkmcnt(0)" ::: "memory")
#define VM_WAIT() asm volatile("s_waitcnt vmcnt(0)" ::: "memory")

#define XB_TMO      128
#define XB_XCNT(j)  (256  + 64 * (j))
#define XB_XSUB(j)  (1280 + 64 * (j))
#define XB_XGEN(j)  (2304 + 64 * (j))
#define XB_TOP      3328
#define XB_TOPGEN   3392
#define XCD_BAR_WORDS 3456
#define XB_SPIN_CAP (1u << 18)
__device__ __forceinline__ unsigned xb_ld(unsigned* p)              { return __hip_atomic_load(p, __ATOMIC_RELAXED, __HIP_MEMORY_SCOPE_AGENT); }
__device__ __forceinline__ unsigned xb_add(unsigned* p, unsigned v) { return __hip_atomic_fetch_add(p, v, __ATOMIC_RELAXED, __HIP_MEMORY_SCOPE_AGENT); }
__device__ __forceinline__ unsigned xb_xcc_id() { return (unsigned)__builtin_amdgcn_s_getreg((3 << 11) | 20) & 0xFu; }
#define XB_SPIN(cond, bar) do { unsigned _sp = 0; while (cond) { __builtin_amdgcn_s_sleep(1); \
    if ((++_sp & 255u) == 0u) { if (xb_ld(&(bar)[XB_TMO])) break; if (_sp > XB_SPIN_CAP) { atomicAdd(&(bar)[XB_TMO], 1u); break; } } } } while (0)
struct XcdBarrier { unsigned* bar; unsigned x; volatile LAS unsigned* st; };
__device__ __forceinline__ XcdBarrier xcd_barrier_post(unsigned* bar, volatile LAS unsigned* st) {
    XcdBarrier b; b.bar = bar; b.x = xb_xcc_id(); b.st = st;
    if (threadIdx.x == 0) (void)xb_add(&bar[XB_XCNT(b.x)], 1u);
    return b;
}
__device__ __forceinline__ void xcd_barrier_complete(unsigned* bar, unsigned x, unsigned& nloc, unsigned& nx) {
    const unsigned G = gridDim.x * gridDim.y * gridDim.z;
    unsigned sum, cnt, mine, sp = 0u;
    for (;;) {
        sum = 0u; cnt = 0u; mine = 0u;
#pragma unroll
        for (unsigned j = 0; j < 16; ++j) { const unsigned c = xb_ld(&bar[XB_XCNT(j)]); sum += c; cnt += (c > 0u) ? 1u : 0u; mine = (j == x) ? c : mine; }
        if (sum == G) break;
        __builtin_amdgcn_s_sleep(1);
        if ((++sp & 255u) == 0u) { if (xb_ld(&bar[XB_TMO])) break; if (sp > XB_SPIN_CAP) { atomicAdd(&bar[XB_TMO], 1u); break; } }
    }
    nloc = mine > 0u ? mine : 1u; nx = cnt > 0u ? cnt : 1u;
}
__device__ __forceinline__ void xcd_barrier(const XcdBarrier& b) {
    asm volatile("s_waitcnt vmcnt(0)" ::: "memory");
    __syncthreads();
    if (threadIdx.x == 0) {
        unsigned* bar = b.bar;
        __builtin_amdgcn_s_waitcnt(0);
        unsigned nloc = b.st[0], nx = b.st[1];
        if (nloc == 0u) { xcd_barrier_complete(bar, b.x, nloc, nx); b.st[0] = nloc; b.st[1] = nx; }
        const unsigned old = xb_add(&bar[XB_XSUB(b.x)], 1u);
        const unsigned gen = old / nloc;
        if (old + 1u == (gen + 1u) * nloc) {
            __builtin_amdgcn_fence(__ATOMIC_RELEASE, "agent");
            asm volatile("s_waitcnt vmcnt(0)" ::: "memory");
            const unsigned og = xb_add(&bar[XB_TOP], 1u);
            const unsigned tg = og / nx;
            if (og + 1u == (tg + 1u) * nx) xb_add(&bar[XB_TOPGEN], 1u);
            else XB_SPIN(xb_ld(&bar[XB_TOPGEN]) == tg, bar);
            __builtin_amdgcn_fence(__ATOMIC_ACQUIRE, "agent");
            xb_add(&bar[XB_XGEN(b.x)], 1u);
            asm volatile("s_waitcnt vmcnt(0)" ::: "memory");
        } else {
            XB_SPIN(xb_ld(&bar[XB_XGEN(b.x)]) == gen, bar);
            __builtin_amdgcn_fence(__ATOMIC_ACQUIRE, "agent");
            asm volatile("s_waitcnt vmcnt(0)" ::: "memory");
        }
    }
    __syncthreads();
}

namespace pg8 {
constexpr int BM = 256, BK = 64, HALF = 128, HTB = HALF * BK * 2, STAGE_BYTES = 8 * HTB, NXCD = 8, WGM = 8;
__host__ __device__ __forceinline__ int lds_byte(int r, int c) { const int st = (r >> 4) * 2 + (c >> 5), rr = r & 15, cc = c & 31, ob = rr * 64 + cc * 2; return st * 1024 + (ob ^ (((ob >> 9) & 1) << 5)); }
__host__ __device__ __forceinline__ void stage_rc(int b, int& R, int& C) { const int st = b / 1024, sb = b % 1024, swz = sb ^ (((sb >> 9) & 1) << 5); R = (st >> 1) * 16 + swz / 64; C = (st & 1) * 32 + (swz % 64) / 2; }
__host__ __device__ __forceinline__ int perm32(int rho) { const int n = rho >> 4, i = rho & 15; return 8 * (i >> 2) + 4 * n + (i & 3); }
__device__ __forceinline__ int xcd_remap(int wgid, int nwg) { const int q = nwg / NXCD, r = nwg % NXCD, xcd = wgid % NXCD, off = wgid / NXCD; return (xcd < r ? xcd * (q + 1) : r * (q + 1) + (xcd - r) * q) + off; }

struct Unit { const char* A; const char* B; int pm, pn, e, nrow; };

struct DenseSched {
    const char* A; const char* Bt; int nM, nN, nwg, G, c; size_t tstep;
    __device__ __forceinline__ void init(const void* A_, const void* Bt_, int M, int N, int K, int G_, int c_) { A = (const char*)A_; Bt = (const char*)Bt_; nM = M / BM; nN = N / BM; nwg = nM * nN; G = G_; c = c_; tstep = (size_t)BM * K * 2; }
    __device__ __forceinline__ bool next(int i, Unit& u) const {
        const long L = (long)i * G + c; if (L >= nwg) return false;
        const int wgid = xcd_remap((int)L, nwg);
        const int nig = WGM * nN, gid = wgid / nig, fm = gid * WGM, gsz = (nM - fm) < WGM ? (nM - fm) : WGM;
        u.pm = fm + ((wgid % nig) % gsz); u.pn = (wgid % nig) / gsz; u.e = 0; u.nrow = BM;
        u.A = A + (size_t)u.pm * tstep; u.B = Bt + (size_t)u.pn * tstep; return true;
    }
};
struct MoeSched {
    const char* A; const char* Bt; const volatile LAS int* tstart; const volatile LAS int* cnt; int NT, nwg, G, c; size_t tstep;
    __device__ __forceinline__ void init(const void* A_, const void* Bt_, const volatile LAS int* ts, const volatile LAS int* cn, int NT_, int K, int G_, int c_) {
        A = (const char*)A_; Bt = (const char*)Bt_; tstart = ts; cnt = cn; NT = NT_; nwg = ts[NE] * NT_; G = G_; c = c_; tstep = (size_t)BM * K * 2; }
    __device__ __forceinline__ bool next(int i, Unit& u) const {
        const long L = (long)i * G + c; if (L >= nwg) return false;
        const int wgid = xcd_remap((int)L, nwg);
        int e = 0;
#pragma unroll 1
        for (int j = 1; j < NE; ++j) e = (wgid >= tstart[j] * NT) ? j : e;
        const int t0 = tstart[e], nte = tstart[e + 1] - t0, local = wgid - t0 * NT;
        const int pn = local / nte, mt = local - pn * nte;
        u.e = e; u.pn = pn; u.pm = t0 + mt; u.nrow = cnt[e] - mt * BM;
        u.A = A + (size_t)u.pm * tstep; u.B = Bt + (size_t)(e * NT + pn) * tstep; return true;
    }
};

template <class Epi, class Sched, bool BGRAN = false>
__device__ __forceinline__ void gemm_phase(LAS unsigned char* lds, const int K, const int lda, const int ldb, const Sched& S, const Epi& E) {
    const int tid = threadIdx.x, wid = __builtin_amdgcn_readfirstlane(tid >> 6), lane = tid & 63, wr = wid >> 2, wc = wid & 3, fr = lane & 15, fq = lane >> 4;
    int nt = K / BK; asm volatile("" : "+s"(nt));
    unsigned voffA[2], voffB[2];
#pragma unroll
    for (int i = 0; i < 2; ++i) { int R, C; stage_rc(tid * 16 + i * 8192, R, C); const int Rb = Epi::PERM ? ((R & ~31) + perm32(R & 31)) : R;
        voffA[i] = (unsigned)(R * lda + C) * 2u; voffB[i] = BGRAN ? (unsigned)((C >> 3) * ldb + Rb) * 16u : (unsigned)(Rb * ldb + C) * 2u; }
    const size_t kstep = (size_t)(BK * 2), kstepB = BGRAN ? (size_t)ldb * 128 : (size_t)(BK * 2);
    const size_t hstepA = (size_t)HALF * lda * 2, hstepB = BGRAN ? (size_t)2048 : (size_t)HALF * ldb * 2;
    const unsigned ldsw = (unsigned)wid * 1024u;
    const int aoff = lds_byte(wr * 64 + fr, fq * 8), boff = lds_byte(wc * 32 + fr, fq * 8);
#define PG8_SA(b, h) (((b) * 2 + (h)) * HTB)
#define PG8_SB(b, h) ((4 + (b) * 2 + (h)) * HTB)
#define PG8_STAGE(bufoff, gbase, voff) do { _Pragma("unroll") for (int _i = 0; _i < 2; ++_i) \
        __builtin_amdgcn_global_load_lds((const unsigned*)((const char*)(gbase) + (voff)[_i]), (LAS unsigned*)(lds + (bufoff) + ldsw + _i * 8192), 16, 0, 0); } while (0)
#define PG8_LDA(dst, b, h) do { _Pragma("unroll") for (int m = 0; m < 4; ++m) _Pragma("unroll") for (int k = 0; k < 2; ++k) dst[m][k] = *(const LAS bf16x8*)(lds + PG8_SA(b, h) + aoff + m * 2048 + k * 1024); } while (0)
#define PG8_LDB(dst, b, h) do { _Pragma("unroll") for (int n = 0; n < 2; ++n) _Pragma("unroll") for (int k = 0; k < 2; ++k) dst[n][k] = *(const LAS bf16x8*)(lds + PG8_SB(b, h) + boff + n * 2048 + k * 1024); } while (0)
#define PG8_MMA(ai, bj, At, Bt) do { __builtin_amdgcn_s_setprio(1); _Pragma("unroll") for (int m = 0; m < 4; ++m) _Pragma("unroll") for (int n = 0; n < 2; ++n) _Pragma("unroll") for (int k = 0; k < 2; ++k) \
        acc[ai][bj][m][n] = __builtin_amdgcn_mfma_f32_16x16x32_bf16(Bt[n][k], At[m][k], acc[ai][bj][m][n], 0, 0, 0); __builtin_amdgcn_s_setprio(0); } while (0)
#define PG8_WAIT_V(n) asm volatile("s_waitcnt vmcnt(" #n ")" ::: "memory")
#define PG8_WAIT_L(n) asm volatile("s_waitcnt lgkmcnt(" #n ")" ::: "memory")
#define PG8_BAR __builtin_amdgcn_s_barrier()
#define PG8_SCHED __builtin_amdgcn_sched_barrier(0)
    Unit cur, nxt; int ui = 0;
    if (!S.next(0, cur)) return;
    f32x4 acc[2][2][4][2];
#pragma unroll
    for (int a = 0; a < 2; ++a)
#pragma unroll
        for (int b = 0; b < 2; ++b)
#pragma unroll
            for (int m = 0; m < 4; ++m)
#pragma unroll
                for (int n = 0; n < 2; ++n) acc[a][b][m][n] = (f32x4){0.f, 0.f, 0.f, 0.f};
    bf16x8 At[4][2], B0[2][2], B1[2][2];
    const char* cA = cur.A; const char* cB = cur.B;
    PG8_STAGE(PG8_SB(0, 0), cB, voffB); PG8_STAGE(PG8_SB(0, 1), cB + hstepB, voffB); PG8_STAGE(PG8_SA(0, 0), cA, voffA); PG8_STAGE(PG8_SA(0, 1), cA + hstepA, voffA);
    if (wr == 1) PG8_BAR;
    PG8_WAIT_V(2); PG8_BAR;
    PG8_STAGE(PG8_SB(1, 0), cB + kstepB, voffB); PG8_STAGE(PG8_SA(1, 0), cA + kstep, voffA); PG8_STAGE(PG8_SB(1, 1), cB + hstepB + kstepB, voffB);
    PG8_WAIT_V(6); PG8_BAR;
    for (;;) {
        const bool has_next = S.next(ui + 1, nxt);
        const char* nA = has_next ? nxt.A : cA; const char* nB = has_next ? nxt.B : cB;
#pragma unroll 1
        for (int t = 0; t < nt; t += 2) {
            const bool last = (t == nt - 2);
            const char* a1 = cA + (size_t)(t + 1) * kstep;
            const char* a2 = last ? nA : cA + (size_t)(t + 2) * kstep; const char* b2 = last ? nB : cB + (size_t)(t + 2) * kstepB;
            const char* a3 = a2 + kstep; const char* b3 = b2 + kstepB;
            PG8_LDB(B0, 0, 0); PG8_LDB(B1, 0, 1); PG8_SCHED; PG8_LDA(At, 0, 0); PG8_STAGE(PG8_SA(1, 1), a1 + hstepA, voffA);
            PG8_WAIT_V(8); PG8_WAIT_L(0); PG8_BAR; PG8_MMA(0, 0, At, B0); PG8_MMA(0, 1, At, B1); PG8_BAR; PG8_SCHED;
            PG8_LDA(At, 0, 1); PG8_STAGE(PG8_SB(0, 0), b2, voffB); PG8_STAGE(PG8_SB(0, 1), b2 + hstepB, voffB); PG8_STAGE(PG8_SA(0, 0), a2, voffA);
            PG8_WAIT_V(8); PG8_WAIT_L(0); PG8_BAR; PG8_MMA(1, 0, At, B0); PG8_MMA(1, 1, At, B1); PG8_BAR; PG8_SCHED;
            PG8_LDB(B0, 1, 0); PG8_LDB(B1, 1, 1); PG8_SCHED; PG8_LDA(At, 1, 0); PG8_STAGE(PG8_SA(0, 1), a2 + hstepA, voffA);
            PG8_WAIT_V(8); PG8_WAIT_L(0); PG8_BAR; PG8_MMA(0, 0, At, B0); PG8_MMA(0, 1, At, B1); PG8_BAR; PG8_SCHED;
            PG8_LDA(At, 1, 1); PG8_STAGE(PG8_SB(1, 0), b3, voffB); PG8_STAGE(PG8_SB(1, 1), b3 + hstepB, voffB); PG8_STAGE(PG8_SA(1, 0), a3, voffA);
            PG8_WAIT_V(8); PG8_WAIT_L(0); PG8_BAR; PG8_MMA(1, 0, At, B0); PG8_MMA(1, 1, At, B1); PG8_BAR; PG8_SCHED;
        }
        if (wr == 0) PG8_BAR;
        E(acc, cur, wr, wc, fr, fq);
        if (!has_next) break;
#pragma unroll
        for (int a = 0; a < 2; ++a)
#pragma unroll
            for (int b = 0; b < 2; ++b)
#pragma unroll
                for (int m = 0; m < 4; ++m)
#pragma unroll
                    for (int n = 0; n < 2; ++n) acc[a][b][m][n] = (f32x4){0.f, 0.f, 0.f, 0.f};
        cur = nxt; cA = nA; cB = nB; ++ui;
        if (wr == 1) PG8_BAR;
    }
    PG8_WAIT_V(0);
    PG8_BAR;
#undef PG8_SA
#undef PG8_SB
#undef PG8_STAGE
#undef PG8_LDA
#undef PG8_LDB
#undef PG8_MMA
#undef PG8_WAIT_V
#undef PG8_WAIT_L
#undef PG8_BAR
#undef PG8_SCHED
}

struct EpiProj {
    static constexpr bool PERM = true;
    unsigned char* ws; const float* bbg;
    __device__ __forceinline__ void operator()(const f32x4 (&acc)[2][2][4][2], const Unit& u, int wr, int wc, int fr, int fq) const {
        const int pn = u.pn; size_t off; int ld, t0, act = 0;
        if (pn < 4) { off = WS_GQ; ld = 1024; t0 = 0; } else if (pn < 8) { off = WS_GK; ld = 1024; t0 = 4; } else if (pn < 16) { off = WS_GV; ld = 2048; t0 = 8; }
        else if (pn < 24) { off = WS_GR; ld = 2048; t0 = 16; act = 1; } else if (pn < 28) { off = WS_AQ; ld = 1024; t0 = 24; } else if (pn < 32) { off = WS_AK; ld = 1024; t0 = 28; }
        else if (pn < 36) { off = WS_AV; ld = 1024; t0 = 32; } else if (pn < 44) { off = WS_SG; ld = 2048; t0 = 36; act = 2; } else { off = WS_SA; ld = 2048; t0 = 44; act = 3; }
        bf16* base = (bf16*)(ws + off);
        const int colt = (pn - t0) * BM + wc * 32 + 8 * fq, row0 = u.pm * BM + wr * 64 + fr;
        f32x4 bv[2][2];
#pragma unroll
        for (int bj = 0; bj < 2; ++bj)
#pragma unroll
            for (int n = 0; n < 2; ++n) bv[bj][n] = act >= 2 ? *(const f32x4*)(bbg + (act - 2) * D + colt + bj * HALF + 4 * n) : (f32x4){0.f, 0.f, 0.f, 0.f};
#pragma unroll
        for (int ai = 0; ai < 2; ++ai)
#pragma unroll
            for (int m = 0; m < 4; ++m) { bf16* rowp = base + (size_t)(row0 + ai * HALF + m * 16) * ld + colt;
#pragma unroll
                for (int bj = 0; bj < 2; ++bj) { f32x4 v0 = acc[ai][bj][m][0] + bv[bj][0], v1 = acc[ai][bj][m][1] + bv[bj][1];
                    if (act == 1) {
#pragma unroll
                        for (int j = 0; j < 4; ++j) { v0[j] = v0[j] * sigmoidf_(v0[j]); v1[j] = v1[j] * sigmoidf_(v1[j]); } }
                    else if (act >= 2) {
#pragma unroll
                        for (int j = 0; j < 4; ++j) { v0[j] = sigmoidf_(v0[j]); v1[j] = sigmoidf_(v1[j]); } }
                    u32x4 w; w.x = cvt_pk_bf16(v0[0], v0[1]); w.y = cvt_pk_bf16(v0[2], v0[3]); w.z = cvt_pk_bf16(v1[0], v1[1]); w.w = cvt_pk_bf16(v1[2], v1[3]);
                    *(u32x4*)(rowp + bj * HALF) = w; } }
    }
};
template <int MODE> struct EpiBranch {
    static constexpr bool PERM = true;
    const bf16* gate; const bf16* tin; bf16* out;
    __device__ __forceinline__ void operator()(const f32x4 (&acc)[2][2][4][2], const Unit& u, int wr, int wc, int fr, int fq) const {
        const int colt = u.pn * BM + wc * 32 + 8 * fq, row0 = u.pm * BM + wr * 64 + fr;
#pragma unroll
        for (int ai = 0; ai < 2; ++ai)
#pragma unroll
            for (int m = 0; m < 4; ++m) { const size_t ro = (size_t)(row0 + ai * HALF + m * 16) * D + colt;
#pragma unroll
                for (int bj = 0; bj < 2; ++bj) {
                    const u32x4 gq = *(const u32x4*)(gate + ro + bj * HALF);
                    u32x4 tq = (u32x4){0u, 0u, 0u, 0u}; if (MODE == 1) tq = *(const u32x4*)(tin + ro + bj * HALF);
                    float r[8];
#pragma unroll
                    for (int j = 0; j < 4; ++j) { r[j] = acc[ai][bj][m][0][j]; r[4 + j] = acc[ai][bj][m][1][j]; }
#pragma unroll
                    for (int j = 0; j < 4; ++j) { const unsigned gw = gq[j], tw = tq[j];
                        r[2 * j] = r[2 * j] * __uint_as_float(gw << 16) + __uint_as_float(tw << 16);
                        r[2 * j + 1] = r[2 * j + 1] * __uint_as_float(gw & 0xffff0000u) + __uint_as_float(tw & 0xffff0000u); }
                    u32x4 w; w.x = cvt_pk_bf16(r[0], r[1]); w.y = cvt_pk_bf16(r[2], r[3]); w.z = cvt_pk_bf16(r[4], r[5]); w.w = cvt_pk_bf16(r[6], r[7]);
                    *(u32x4*)(out + ro + bj * HALF) = w; } }
    }
};
struct EpiResid {
    static constexpr bool PERM = false;
    const float* x; float* out;
    __device__ __forceinline__ void operator()(const f32x4 (&acc)[2][2][4][2], const Unit& u, int wr, int wc, int fr, int fq) const {
        const int col0 = u.pn * BM + wc * 32 + 4 * fq, row0 = u.pm * BM + wr * 64 + fr;
#pragma unroll
        for (int ai = 0; ai < 2; ++ai)
#pragma unroll
            for (int m = 0; m < 4; ++m) { const size_t ro = (size_t)(row0 + ai * HALF + m * 16) * D + col0;
#pragma unroll
                for (int bj = 0; bj < 2; ++bj)
#pragma unroll
                    for (int n = 0; n < 2; ++n) { const f32x4 xv = *(const f32x4*)(x + ro + bj * HALF + n * 16); *(f32x4*)(out + ro + bj * HALF + n * 16) = xv + acc[ai][bj][m][n]; } }
    }
};
struct EpiSwiglu {
    static constexpr bool PERM = true;
    const float* bgate; const float* bup; bf16* hd;
    __device__ __forceinline__ void operator()(const f32x4 (&acc)[2][2][4][2], const Unit& u, int wr, int wc, int fr, int fq) const {
        const int col = u.pn * HALF + wc * 32 + 8 * fq; const size_t row0 = (size_t)u.pm * BM + wr * 64 + fr;
        const float* bg = bgate + (size_t)u.e * DFF + col; const float* bu = bup + (size_t)u.e * DFF + col;
        const f32x4 g0 = *(const f32x4*)bg, g1 = *(const f32x4*)(bg + 4), u0 = *(const f32x4*)bu, u1 = *(const f32x4*)(bu + 4);
#pragma unroll
        for (int ai = 0; ai < 2; ++ai)
#pragma unroll
            for (int m = 0; m < 4; ++m) {
                float r[8];
#pragma unroll
                for (int j = 0; j < 4; ++j) {
                    const float ga = fminf(acc[ai][0][m][0][j] + g0[j], 7.f), ua = fminf(fmaxf(acc[ai][1][m][0][j] + u0[j], -7.f), 7.f);
                    const float gb = fminf(acc[ai][0][m][1][j] + g1[j], 7.f), ub = fminf(fmaxf(acc[ai][1][m][1][j] + u1[j], -7.f), 7.f);
                    r[j] = (ua + 1.f) * (ga * sigmoidf_(1.702f * ga)); r[4 + j] = (ub + 1.f) * (gb * sigmoidf_(1.702f * gb)); }
                u32x4 w; w.x = cvt_pk_bf16(r[0], r[1]); w.y = cvt_pk_bf16(r[2], r[3]); w.z = cvt_pk_bf16(r[4], r[5]); w.w = cvt_pk_bf16(r[6], r[7]);
                *(u32x4*)(hd + (row0 + ai * HALF + m * 16) * DFF + col) = w; }
    }
};
struct EpiDown {
    static constexpr bool PERM = true;
    const float* bdown; const int* rpair; const float* rw; bf16* py;
    __device__ __forceinline__ void operator()(const f32x4 (&acc)[2][2][4][2], const Unit& u, int wr, int wc, int fr, int fq) const {
        const int colt = u.pn * BM + wc * 32 + 8 * fq; const size_t srow0 = (size_t)u.pm * BM + wr * 64 + fr;
        f32x4 bv[2][2];
#pragma unroll
        for (int bj = 0; bj < 2; ++bj)
#pragma unroll
            for (int n = 0; n < 2; ++n) bv[bj][n] = *(const f32x4*)(bdown + (size_t)u.e * D + colt + bj * HALF + 4 * n);
#pragma unroll
        for (int ai = 0; ai < 2; ++ai)
#pragma unroll
            for (int m = 0; m < 4; ++m) { const size_t srow = srow0 + ai * HALF + m * 16; const int pair = rpair[srow]; const float wgt = rw[srow];
                bf16* rowp = py + (size_t)pair * D + colt;
#pragma unroll
                for (int bj = 0; bj < 2; ++bj) { const f32x4 v0 = (acc[ai][bj][m][0] + bv[bj][0]) * wgt, v1 = (acc[ai][bj][m][1] + bv[bj][1]) * wgt;
                    u32x4 w; w.x = cvt_pk_bf16(v0[0], v0[1]); w.y = cvt_pk_bf16(v0[2], v0[3]); w.z = cvt_pk_bf16(v1[0], v1[1]); w.w = cvt_pk_bf16(v1[2], v1[3]);
                    *(u32x4*)(rowp + bj * HALF) = w; } }
    }
};

struct GlaSched {
    int mode, G, c; unsigned char* ws;
    __device__ __forceinline__ bool next(int i, Unit& u) const {
        const int L = i * G + c; const int nu = mode == 0 ? 128 : 256; if (L >= nu) return false;
        const int nh = mode == 0 ? L : (L >> 1), hv = mode == 0 ? 0 : (L & 1);
        u.pm = nh; u.pn = hv; u.e = 0; u.nrow = BM;
        if (mode == 0) { u.A = (const char*)(ws + WS_ACAT) + (size_t)nh * 256 * 512 * 2 + 512; u.B = (const char*)(ws + WS_KI) + (size_t)nh * 256 * 256 * 2; }
        else if (mode == 1) { u.A = (const char*)(ws + WS_BCAT) + (size_t)nh * 512 * 512 * 2 + (size_t)hv * 256 * 512 * 2; u.B = (const char*)(ws + WS_KET) + (size_t)nh * 256 * 256 * 2; }
        else { u.A = (const char*)(ws + WS_ACAT) + (size_t)nh * 256 * 512 * 2; u.B = (const char*)(ws + WS_BCAT) + (size_t)nh * 512 * 512 * 2 + (size_t)hv * 256 * 512 * 2; }
        return true;
    }
};
template <int MODE> struct EpiGla {
    static constexpr bool PERM = true;
    unsigned char* ws;
    __device__ __forceinline__ void operator()(const f32x4 (&acc)[2][2][4][2], const Unit& u, int wr, int wc, int fr, int fq) const {
        const int nh = u.pm, hv = u.pn; const int c8 = wc * 32 + 8 * fq, r0 = wr * 64 + fr;
        bf16* base; int ld;
        if (MODE == 0) { base = (bf16*)(ws + WS_ACAT) + (size_t)nh * 256 * 512; ld = 512; }
        else if (MODE == 1) { base = (bf16*)(ws + WS_UT) + (size_t)nh * 512 * 256 + (size_t)hv * 256 * 256; ld = 256; }
        else { base = (bf16*)(ws + WS_OB) + (size_t)(nh >> 2) * 256 * GLA_V + (nh & 3) * GLA_DV + hv * 256; ld = GLA_V; }
#pragma unroll
        for (int ai = 0; ai < 2; ++ai)
#pragma unroll
            for (int m = 0; m < 4; ++m) { const int row = r0 + ai * HALF + m * 16;
#pragma unroll
                for (int bj = 0; bj < 2; ++bj) { f32x4 v0 = acc[ai][bj][m][0], v1 = acc[ai][bj][m][1]; const int col = bj * HALF + c8;
                    if (MODE == 0) {
#pragma unroll
                        for (int j = 0; j < 4; ++j) { v0[j] = (col + j <= row) ? v0[j] : 0.f; v1[j] = (col + 4 + j <= row) ? v1[j] : 0.f; } }
                    u32x4 w; w.x = cvt_pk_bf16(v0[0], v0[1]); w.y = cvt_pk_bf16(v0[2], v0[3]); w.z = cvt_pk_bf16(v1[0], v1[1]); w.w = cvt_pk_bf16(v1[2], v1[3]);
                    *(u32x4*)(base + (size_t)row * ld + col) = w; } }
    }
};
}

constexpr int NWAVES = 8;
constexpr int RING_BYTES = 131072, MISC_OFF = RING_BYTES + 320, LDS_BYTES = 147456;
constexpr int TAB_OFF = MISC_OFF + 128;

struct Frame {
    LAS unsigned char* lds; volatile LAS unsigned* MISC; unsigned* ctl; unsigned char* ws;
    int tid, lane, wave, vcu, G;
};
struct Args { const float* in[22]; float* out; unsigned char* ws; int ph_lo, ph_hi, li, pad; };

__device__ __forceinline__ void p0_transpose_item(const float* W, int K, int ldn, bf16* WT, int d0, int s0, int k0, LAS float* scr, int lane) {
#pragma unroll 8
    for (int i = 0; i < 32; ++i) { const int kk = 2 * i + (lane >> 5); scr[kk * 33 + (lane & 31)] = W[(size_t)(k0 + kk) * ldn + s0 + (lane & 31)]; }
    LDS_WAIT(); asm volatile("" ::: "memory");
    const int c = lane & 7;
#pragma unroll
    for (int j = 0; j < 4; ++j) { const int n = (lane >> 3) + 8 * j; const LAS float* s = scr + (8 * c) * 33 + n;
        u32x4 o; o.x = pk2(s[0 * 33], s[1 * 33]); o.y = pk2(s[2 * 33], s[3 * 33]); o.z = pk2(s[4 * 33], s[5 * 33]); o.w = pk2(s[6 * 33], s[7 * 33]);
        *(GAS u32x4*)(WT + (size_t)(d0 + n) * K + k0 + 8 * c) = o; }
    LDS_WAIT(); asm volatile("" ::: "memory");
}

__device__ __forceinline__ void p0_prologue(Frame& F, const Args& a) {
    LAS float* scr = (LAS float*)(F.lds + F.wave * 16384);
    const int gw = F.vcu * NWAVES + F.wave, NGW = F.G * NWAVES, lane = F.lane;
    const float* w_in = a.in[2];
    constexpr int I_IN = 32 * (NPROJ / 32), I_BG = 32 * 64, I_BA = 16 * 64, I_OUT = 32 * 64, I_E = 32 * 64;
    constexpr int I_MOE = NE * I_E;
    constexpr int NITEMS = I_IN + I_BG + I_BA + I_OUT + 3 * I_MOE;
    for (int it = gw; it < NITEMS; it += NGW) {
        int r = it;
        if (r < I_IN) { const int nb = r % (NPROJ / 32), kb = r / (NPROJ / 32), d0 = nb * 32; p0_transpose_item(w_in, D, IN_COLS, (bf16*)(F.ws + WS_WIN), d0, d0 < C_GLR ? d0 : d0 + 16, kb * 64, scr, lane); continue; } r -= I_IN;
        if (r < I_BG) { const int nb = r % 64, kb = r / 64; p0_transpose_item(a.in[10], GLA_V, D, (bf16*)(F.ws + WS_WBG), nb * 32, nb * 32, kb * 64, scr, lane); continue; } r -= I_BG;
        if (r < I_BA) { const int nb = r % 64, kb = r / 64; p0_transpose_item(a.in[11], ATT_W, D, (bf16*)(F.ws + WS_WBA), nb * 32, nb * 32, kb * 64, scr, lane); continue; } r -= I_BA;
        if (r < I_OUT) { const int nb = r % 64, kb = r / 64; p0_transpose_item(a.in[12], D, D, (bf16*)(F.ws + WS_WOUT), nb * 32, nb * 32, kb * 64, scr, lane); continue; } r -= I_OUT;
        if (r < 2 * I_MOE) {
            const int which = r / I_MOE; r -= which * I_MOE; const int e = r / I_E; r -= e * I_E; const int nb = r % 64, kb = r / 64, n0 = nb * 32;
            const float* W = (which ? a.in[18] : a.in[16]) + (size_t)e * D * DFF;
            p0_transpose_item(W, D, DFF, (bf16*)(F.ws + WS_GU) + (size_t)e * 2 * DFF * D, (n0 >> 7) * 256 + (n0 & 127) + which * 128, n0, kb * 64, scr, lane); continue; }
        r -= 2 * I_MOE;
        { const int e = r / I_E; r -= e * I_E; const int nb = r % 64, kb = r / 64;
          p0_transpose_item(a.in[20] + (size_t)e * DFF * D, DFF, D, (bf16*)(F.ws + WS_DN) + (size_t)e * D * DFF, nb * 32, nb * 32, kb * 64, scr, lane); }
    }
    const float* x = a.in[0]; const float* g1 = a.in[1]; bf16* XN = (bf16*)(F.ws + WS_XN); float* GLR = (float*)(F.ws + WS_GLR);
    for (int m = gw; m < S; m += NGW) {
        const GAS f32x4* xr = (const GAS f32x4*)(x + (size_t)m * D) + lane;
        f32x4 v[8]; float s = 0.f;
#pragma unroll
        for (int j = 0; j < 8; ++j) { v[j] = xr[64 * j]; s += (v[j].x * v[j].x + v[j].y * v[j].y) + (v[j].z * v[j].z + v[j].w * v[j].w); }
        const float rstd = rsqrtf(wave_sum(s) * (1.f / D) + 1e-6f);
        GAS u32x2* o8 = (GAS u32x2*)(XN + (size_t)m * D) + lane;
        float gl[16];
#pragma unroll
        for (int r = 0; r < 16; ++r) gl[r] = 0.f;
#pragma unroll
        for (int j = 0; j < 8; ++j) { const f32x4 gg = *((const GAS f32x4*)g1 + lane + 64 * j); v[j] = v[j] * rstd * gg;
            u32x2 w; w.x = pk2(v[j].x, v[j].y); w.y = pk2(v[j].z, v[j].w); o8[64 * j] = w;
#pragma unroll
            for (int i = 0; i < 4; ++i) { const GAS f32x4* wp = (const GAS f32x4*)(w_in + (size_t)(256 * j + 4 * lane + i) * IN_COLS + C_GLR);
#pragma unroll
                for (int q = 0; q < 4; ++q) { const f32x4 wv = wp[q]; gl[4 * q] = fmaf(v[j][i], wv.x, gl[4 * q]); gl[4 * q + 1] = fmaf(v[j][i], wv.y, gl[4 * q + 1]); gl[4 * q + 2] = fmaf(v[j][i], wv.z, gl[4 * q + 2]); gl[4 * q + 3] = fmaf(v[j][i], wv.w, gl[4 * q + 3]); } } }
        float mine = 0.f;
#pragma unroll
        for (int r = 0; r < 16; ++r) { const float t = wave_sum(gl[r]); mine = (lane == r) ? t : mine; }
        if (lane < 16) GLR[(size_t)m * 16 + lane] = mine;
    }
    { const float* g2 = a.in[13]; const float* wr = a.in[14]; float* WR = (float*)(F.ws + WS_WR);
      for (int i = (F.vcu * NWAVES * 64) + F.tid; i < D * NE; i += F.G * NWAVES * 64) WR[i] = g2[i >> 5] * wr[i]; }
}

__device__ __forceinline__ void router_unit(Frame& F, const Args& a, int tile) {
    const int w = F.wave, lane = F.lane, tid = F.tid, i = lane & 31, kk = lane >> 5, t0 = tile * 32;
    const float* h1 = a.out; const float* g2 = a.in[13]; const float* WR = (const float*)(F.ws + WS_WR); const float* br = a.in[15];
    LAS float* part = (LAS float*)F.lds;
    LAS float* ssq = part + 8192;
    LAS float* lg = ssq + 256;
    LAS float* rs = lg + 32 * 33;
    f32x16 acc;
#pragma unroll
    for (int r = 0; r < 16; ++r) acc[r] = 0.f;
    float ss = 0.f;
    const float* arow = h1 + (size_t)(t0 + i) * D + 256 * w + 128 * kk;
    const float* bcol = WR + (size_t)(256 * w + 128 * kk) * NE + i;
#pragma unroll 1
    for (int c = 0; c < 4; ++c) {
        f32x4 av[8];
#pragma unroll
        for (int q = 0; q < 8; ++q) av[q] = *(const GAS f32x4*)(arow + 32 * c + 4 * q);
#pragma unroll
        for (int q = 0; q < 8; ++q)
#pragma unroll
            for (int j = 0; j < 4; ++j) { const float b = bcol[(size_t)(32 * c + 4 * q + j) * NE]; acc = __builtin_amdgcn_mfma_f32_32x32x2f32(av[q][j], b, acc, 0, 0, 0); ss = fmaf(av[q][j], av[q][j], ss); }
    }
    ss += __shfl_xor(ss, 32);
    if (kk == 0) ssq[w * 32 + i] = ss;
#pragma unroll
    for (int r = 0; r < 16; ++r) part[(w * 32 + (r & 3) + 8 * (r >> 2) + 4 * kk) * 32 + i] = acc[r];
    __syncthreads();
#pragma unroll
    for (int rep = 0; rep < 2; ++rep) { const int idx = tid + 512 * rep, tok = idx >> 5, e = idx & 31; float sum = 0.f, st = 0.f;
#pragma unroll
        for (int ww = 0; ww < 8; ++ww) { sum += part[(ww * 32 + tok) * 32 + e]; st += ssq[ww * 32 + tok]; }
        const float rstd = rsqrtf(st * (1.f / D) + 1e-6f);
        lg[tok * 33 + e] = sum * rstd + br[e]; if (e == 0) rs[tok] = rstd; }
    __syncthreads();
    bf16* HN = (bf16*)(F.ws + WS_HN); float* topw = (float*)(F.ws + WS_TOPW); int* tope = (int*)(F.ws + WS_TOPE); int* tops = (int*)(F.ws + WS_TOPS);
    unsigned* cnt = F.ctl + CW_CNT;
#pragma unroll 1
    for (int q = 0; q < 4; ++q) {
        const int tok = 4 * w + q, t = t0 + tok, e = lane & 31;
        const float rstd = rs[tok];
        {
            const GAS f32x4* x4 = (const GAS f32x4*)(h1 + (size_t)t * D) + lane; GAS u32x2* o8 = (GAS u32x2*)(HN + (size_t)t * D) + lane;
#pragma unroll
            for (int j = 0; j < 8; ++j) { const f32x4 gg = *((const GAS f32x4*)g2 + lane + 64 * j); const f32x4 y = x4[64 * j] * rstd * gg; u32x2 wv; wv.x = pk2(y.x, y.y); wv.y = pk2(y.z, y.w); o8[64 * j] = wv; }
        }
        float vals[4]; int idxs[4]; float cur = lg[tok * 33 + e];
#pragma unroll
        for (int r = 0; r < 4; ++r) {
            float bv = cur; int bi = e;
#pragma unroll
            for (int o = 1; o < 32; o <<= 1) { const float ov = __shfl_xor(bv, o); const int oi = __shfl_xor(bi, o); if (ov > bv || (ov == bv && oi < bi)) { bv = ov; bi = oi; } }
            vals[r] = bv; idxs[r] = bi;
            if (e == bi) cur = -3.0e38f;
        }
        float ex[4], sum = 0.f;
#pragma unroll
        for (int r = 0; r < 4; ++r) { ex[r] = __expf(vals[r] - vals[0]); sum += ex[r]; }
#pragma unroll
        for (int r = 0; r < 4; ++r) {
            if (lane == r) { const int ee = idxs[r]; const int slot = (int)atomicAdd(&cnt[ee], 1u);
                topw[t * 4 + r] = ex[r] / sum; tope[t * 4 + r] = ee; tops[t * 4 + r] = slot; }
        }
    }
    __syncthreads();
}
__device__ __forceinline__ void moe_table(Frame& F) {
    volatile LAS int* ts = (volatile LAS int*)(F.lds + TAB_OFF); volatile LAS int* cn = (volatile LAS int*)(F.lds + TAB_OFF + 256);
    __syncthreads();
    if (F.tid == 0) { int s = 0; for (int e = 0; e < NE; ++e) { const int c = (int)__hip_atomic_load(F.ctl + CW_CNT + e, __ATOMIC_RELAXED, __HIP_MEMORY_SCOPE_AGENT); cn[e] = c; ts[e] = s; s += (c + 255) >> 8; } ts[NE] = s; }
    __syncthreads();
}
__device__ __forceinline__ void p7_gather(Frame& F) {
    const int gw = F.vcu * NWAVES + F.wave, NGW = F.G * NWAVES, lane = F.lane;
    volatile LAS int* ts = (volatile LAS int*)(F.lds + TAB_OFF);
    const bf16* HN = (const bf16*)(F.ws + WS_HN); bf16* HNG = (bf16*)(F.ws + WS_HNG);
    const float* topw = (const float*)(F.ws + WS_TOPW); const int* tope = (const int*)(F.ws + WS_TOPE); const int* tops = (const int*)(F.ws + WS_TOPS);
    int* rpair = (int*)(F.ws + WS_RPAIR); float* rw = (float*)(F.ws + WS_RW);
    { volatile LAS int* cn = (volatile LAS int*)(F.lds + TAB_OFF + 256);
      for (int e = gw; e < NE; e += NGW) { const int c = cn[e], base = ts[e] * 256, padn = ((c + 255) & ~255) - c;
          for (int r = lane; r < padn; r += 64) { rpair[base + c + r] = S * 4; rw[base + c + r] = 0.f; } } }
    for (int t = gw; t < S; t += NGW) {
        const GAS u32x4* src = (const GAS u32x4*)(HN + (size_t)t * D) + lane; u32x4 v[4];
#pragma unroll
        for (int j = 0; j < 4; ++j) v[j] = src[64 * j];
#pragma unroll
        for (int r = 0; r < 4; ++r) { const int p = t * 4 + r; const int dst = ts[tope[p]] * 256 + tops[p];
            GAS u32x4* d = (GAS u32x4*)(HNG + (size_t)dst * D) + lane;
#pragma unroll
            for (int j = 0; j < 4; ++j) d[64 * j] = v[j];
            if (lane == 0) { rpair[dst] = p; rw[dst] = topw[p]; } }
    }
}
__device__ __forceinline__ void p10_combine(Frame& F, const Args& a) {
    const int gw = F.vcu * NWAVES + F.wave, NGW = F.G * NWAVES, lane = F.lane;
    const bf16* PY = (const bf16*)(F.ws + WS_PY); float* out = a.out;
    for (int t = gw; t < S; t += NGW) {
#pragma unroll
        for (int j = 0; j < 4; ++j) {
            float r[8]; { const f32x4 h0 = *(const GAS f32x4*)(out + (size_t)t * D + 512 * j + 8 * lane), h1v = *(const GAS f32x4*)(out + (size_t)t * D + 512 * j + 8 * lane + 4);
                r[0] = h0.x; r[1] = h0.y; r[2] = h0.z; r[3] = h0.w; r[4] = h1v.x; r[5] = h1v.y; r[6] = h1v.z; r[7] = h1v.w; }
#pragma unroll
            for (int k = 0; k < 4; ++k) { const u32x4 p = *(const GAS u32x4*)(PY + (size_t)(t * 4 + k) * D + 512 * j + 8 * lane);
#pragma unroll
                for (int q = 0; q < 4; ++q) { r[2 * q] += __uint_as_float(p[q] << 16); r[2 * q + 1] += __uint_as_float(p[q] & 0xffff0000u); } }
            *(GAS f32x4*)(out + (size_t)t * D + 512 * j + 8 * lane) = (f32x4){r[0], r[1], r[2], r[3]};
            *(GAS f32x4*)(out + (size_t)t * D + 512 * j + 8 * lane + 4) = (f32x4){r[4], r[5], r[6], r[7]};
        }
    }
}


constexpr float ATT_QSCALE = 0.08838834764831845f * 1.4426950408889634f;
__device__ __forceinline__ void attn_prep_unit(Frame& F, const Args& a, int n, int h) {
    const int wave = F.wave, lane = F.lane, tid = F.tid;
    LAS bf16* kst = (LAS bf16*)(F.lds);
    LAS bf16* vst = (LAS bf16*)(F.lds + 16384);
    const bf16* AQ = (const bf16*)(F.ws + WS_AQ); const bf16* AK = (const bf16*)(F.ws + WS_AK); const bf16* AV = (const bf16*)(F.ws + WS_AV);
    bf16* QH = (bf16*)(F.ws + WS_QH);
    const float* qg = a.in[6]; const float* kg = a.in[7];
    const float gq0 = qg[2 * lane], gq1 = qg[2 * lane + 1], gk0 = kg[2 * lane], gk1 = kg[2 * lane + 1];
#pragma unroll
    for (int i = 0; i < 8; ++i) {
        const int row = n * 64 + wave * 8 + i; const size_t off = (size_t)row * ATT_W + h * ATT_HD + 2 * lane;
        const unsigned qv = *(const unsigned*)(AQ + off), kv = *(const unsigned*)(AK + off), vv = *(const unsigned*)(AV + off);
        const float q0 = __uint_as_float(qv << 16), q1 = __uint_as_float(qv & 0xffff0000u), k0 = __uint_as_float(kv << 16), k1 = __uint_as_float(kv & 0xffff0000u);
        const float rq = rsqrtf(wave_sum(q0 * q0 + q1 * q1) * (1.f / 128.f) + 1e-6f) * ATT_QSCALE, rk = rsqrtf(wave_sum(k0 * k0 + k1 * k1) * (1.f / 128.f) + 1e-6f);
        *(unsigned*)(QH + off) = pk2(q0 * rq * gq0, q1 * rq * gq1);
        *(LAS unsigned*)(kst + (wave * 8 + i) * 128 + 2 * lane) = pk2(k0 * rk * gk0, k1 * rk * gk1);
        *(LAS unsigned*)(vst + (wave * 8 + i) * 128 + 2 * lane) = vv;
    }
    __syncthreads();
    bf16* KI = (bf16*)(F.ws + WS_KIMG) + (size_t)(n * ATT_H + h) * 8192; bf16* VI = (bf16*)(F.ws + WS_VIMG) + (size_t)(n * ATT_H + h) * 8192;
#pragma unroll
    for (int i = 0; i < 2; ++i) {
        const int g = tid + 512 * i;
        { const int c16 = g >> 6, key = g & 63; const u32x4 v = *(const LAS u32x4*)(kst + key * 128 + c16 * 8); *(u32x4*)(KI + (size_t)g * 8) = v; }
        { const int kg8 = g >> 7, d = g & 127; unsigned short e[8];
#pragma unroll
          for (int j = 0; j < 8; ++j) e[j] = vst[(kg8 * 8 + j) * 128 + d];
          u32x4 v; v.x = e[0] | ((unsigned)e[1] << 16); v.y = e[2] | ((unsigned)e[3] << 16); v.z = e[4] | ((unsigned)e[5] << 16); v.w = e[6] | ((unsigned)e[7] << 16);
          *(u32x4*)(VI + (size_t)g * 8) = v; }
    }
    __syncthreads();
}

__device__ __forceinline__ int crow(int r, int hi) { return (r & 3) + 8 * (r >> 2) + 4 * hi; }
__device__ __forceinline__ void attn_unit(Frame& F, const Args& a, int n4, int h) {
    const int w = F.wave, lane = F.lane, r32 = lane & 31, hi = lane >> 5, tid = F.tid;
    const int p = w >> 1, half = w & 1, c = 4 * n4 + p, qrow0 = c * 64 + 32 * half;
    LAS unsigned char* lds = F.lds;
    LAS float* btab = (LAS float*)(lds + 65536); LAS float* xch = (LAS float*)(lds + 67584 + 256 * w); LAS bf16* ost = (LAS bf16*)(lds + 8192 * w);
    const float* relb = a.in[8] + h * 257;
    if (tid < 257) btab[tid] = relb[tid] * 1.4426950408889634f;
    const bf16* QH = (const bf16*)(F.ws + WS_QH);
    bf16x8 qf[8];
#pragma unroll
    for (int d0 = 0; d0 < 8; ++d0) qf[d0] = *(const bf16x8*)(QH + (size_t)(qrow0 + r32) * ATT_W + h * ATT_HD + d0 * 16 + hi * 8);
    const char* KIMG = (const char*)(F.ws + WS_KIMG); const char* VIMG = (const char*)(F.ws + WS_VIMG);
    f32x16 o[4];
#pragma unroll
    for (int dt = 0; dt < 4; ++dt)
#pragma unroll
        for (int r = 0; r < 16; ++r) o[dt][r] = 0.f;
    float m = -1.0e30f, l = 0.f;
    const int s0 = (4 * n4 - 8 < 0) ? (8 - 4 * n4) : 0;
#define ATT_STAGE(s_) do { const int kc_ = 4 * n4 - 8 + (s_); const size_t gb_ = (size_t)(kc_ * ATT_H + h) * 16384; const unsigned lb_ = ((s_) & 1) * 32768; \
        _Pragma("unroll") for (int i_ = 0; i_ < 2; ++i_) { const int pc_ = w + 8 * i_; \
            __builtin_amdgcn_global_load_lds((const unsigned*)(KIMG + gb_ + pc_ * 1024 + lane * 16), (LAS unsigned*)(lds + lb_ + pc_ * 1024), 16, 0, 0); \
            __builtin_amdgcn_global_load_lds((const unsigned*)(VIMG + gb_ + pc_ * 1024 + lane * 16), (LAS unsigned*)(lds + lb_ + 16384 + pc_ * 1024), 16, 0, 0); } } while (0)
    ATT_STAGE(s0);
    for (int s = s0; s < 12; ++s) {
        asm volatile("s_waitcnt vmcnt(0) lgkmcnt(0)" ::: "memory");
        __builtin_amdgcn_s_barrier();
        if (s + 1 < 12) ATT_STAGE(s + 1);
        if (s >= p && s <= p + 8) {
            const LAS unsigned char* kb = lds + (s & 1) * 32768; const LAS unsigned char* vb = kb + 16384;
            f32x16 p0, p1;
#pragma unroll
            for (int r = 0; r < 16; ++r) { p0[r] = 0.f; p1[r] = 0.f; }
#pragma unroll
            for (int d0 = 0; d0 < 8; ++d0) {
                const bf16x8 k0 = *(const LAS bf16x8*)(kb + (2 * d0 + hi) * 1024 + r32 * 16), k1 = *(const LAS bf16x8*)(kb + (2 * d0 + hi) * 1024 + (r32 + 32) * 16);
                p0 = __builtin_amdgcn_mfma_f32_32x32x16_bf16(k0, qf[d0], p0, 0, 0, 0);
                p1 = __builtin_amdgcn_mfma_f32_32x32x16_bf16(k1, qf[d0], p1, 0, 0, 0);
                if (d0 & 1) __builtin_amdgcn_sched_barrier(0);
            }
            const int wrel = p + 8 - s;
            if (wrel >= 3) { const float bc = btab[256];
#pragma unroll
                for (int r = 0; r < 16; ++r) { p0[r] += bc; p1[r] += bc; } }
            else { const int base = 64 * wrel + 32 * half + r32 + 128;
#pragma unroll
                for (int r = 0; r < 16; ++r) { int i0 = base - crow(r, hi), i1 = i0 - 32; i0 = i0 > 256 ? 256 : i0; i1 = i1 > 256 ? 256 : i1; i1 = i1 < 0 ? 0 : i1; i0 = i0 < 0 ? 0 : i0; p0[r] += btab[i0]; p1[r] += btab[i1]; } }
            float mx = p0[0];
#pragma unroll
            for (int r = 1; r < 16; ++r) mx = fmaxf(mx, p0[r]);
#pragma unroll
            for (int r = 0; r < 16; ++r) mx = fmaxf(mx, p1[r]);
            mx = fmaxf(mx, __shfl_xor(mx, 32));
            const float mn = fmaxf(m, mx), alpha = __builtin_amdgcn_exp2f(m - mn);
            float ps = 0.f;
#pragma unroll
            for (int r = 0; r < 16; ++r) { p0[r] = __builtin_amdgcn_exp2f(p0[r] - mn); p1[r] = __builtin_amdgcn_exp2f(p1[r] - mn); ps += p0[r] + p1[r]; }
            l = l * alpha + ps;
            if (__any(mn > m)) {
                if (hi == 0) xch[r32] = alpha;
                asm volatile("s_waitcnt lgkmcnt(0)" ::: "memory");
#pragma unroll
                for (int g = 0; g < 4; ++g) { const f32x4 av = *(const LAS f32x4*)(xch + 8 * g + 4 * hi);
#pragma unroll
                    for (int dt = 0; dt < 4; ++dt) { o[dt][4 * g] *= av[0]; o[dt][4 * g + 1] *= av[1]; o[dt][4 * g + 2] *= av[2]; o[dt][4 * g + 3] *= av[3]; } }
            }
            m = mn;
            bf16x8 pa[4];
#pragma unroll
            for (int ks = 0; ks < 4; ++ks) { const f32x16& src = (ks < 2) ? p0 : p1; const int b = (ks & 1) * 8; u32x4 t;
                t.x = cvt_pk_bf16(src[b], src[b + 1]); t.y = cvt_pk_bf16(src[b + 2], src[b + 3]); t.z = cvt_pk_bf16(src[b + 4], src[b + 5]); t.w = cvt_pk_bf16(src[b + 6], src[b + 7]);
                pa[ks] = __builtin_bit_cast(bf16x8, t); }
#pragma unroll
            for (int dt = 0; dt < 4; ++dt)
#pragma unroll
                for (int ks = 0; ks < 4; ++ks) {
                    const LAS unsigned char* vp = vb + (2 * ks) * 2048 + (32 * dt + r32) * 16 + 8 * hi;
                    const u32x2 lo = *(const LAS u32x2*)vp, hh = *(const LAS u32x2*)(vp + 2048);
                    const u32x4 bq = (u32x4){lo.x, lo.y, hh.x, hh.y};
                    o[dt] = __builtin_amdgcn_mfma_f32_32x32x16_bf16(pa[ks], __builtin_bit_cast(bf16x8, bq), o[dt], 0, 0, 0);
                    if (ks == 3) __builtin_amdgcn_sched_barrier(0);
                }
        }
    }
#undef ATT_STAGE
    asm volatile("s_waitcnt lgkmcnt(0)" ::: "memory");
    __builtin_amdgcn_s_barrier();
    l += __shfl_xor(l, 32);
    if (hi == 0) xch[32 + r32] = 1.f / l;
    asm volatile("s_waitcnt lgkmcnt(0)" ::: "memory");
#pragma unroll
    for (int g = 0; g < 4; ++g) { const f32x4 iv = *(const LAS f32x4*)(xch + 32 + 8 * g + 4 * hi);
#pragma unroll
        for (int dt = 0; dt < 4; ++dt)
#pragma unroll
            for (int j = 0; j < 4; ++j) ost[(8 * g + 4 * hi + j) * 128 + 32 * dt + r32] = (bf16)f2bf(o[dt][4 * g + j] * iv[j]); }
    asm volatile("s_waitcnt lgkmcnt(0)" ::: "memory");
    bf16* YA = (bf16*)(F.ws + WS_YA);
#pragma unroll
    for (int i = 0; i < 8; ++i) { const int g = i * 64 + lane, row = g >> 4, c16 = g & 15; const u32x4 v = *(const LAS u32x4*)(ost + row * 128 + c16 * 8);
        *(u32x4*)(YA + (size_t)(qrow0 + row) * ATT_W + h * ATT_HD + c16 * 8) = v; }
    asm volatile("s_waitcnt vmcnt(0) lgkmcnt(0)" ::: "memory");
    __builtin_amdgcn_s_barrier();
}


__device__ __forceinline__ void gla_prep_unit(Frame& F, const Args& a, int n, int cg) {
    const int tid = F.tid, cq = tid & 15, seg = tid >> 4;
    const int h = cg >> 2, dk0 = (cg & 3) * 64 + 4 * cq, col0 = h * GLA_DK + dk0, nh = n * GLA_H + h;
    const float* wgu = a.in[3]; const float* bgt = a.in[4]; const float* GLR = (const float*)(F.ws + WS_GLR);
    const bf16* GQ = (const bf16*)(F.ws + WS_GQ); const bf16* GK = (const bf16*)(F.ws + WS_GK);
    LAS float* tot = (LAS float*)F.lds;
    f32x4 w[16];
#pragma unroll
    for (int r = 0; r < 16; ++r) w[r] = *(const f32x4*)(wgu + r * GLA_QK + col0);
    const f32x4 bgv = *(const f32x4*)(bgt + col0);
    f32x4 cs[8]; f32x4 run = (f32x4){0.f, 0.f, 0.f, 0.f};
    const int t0 = n * 256 + seg * 8;
#pragma unroll
    for (int i = 0; i < 8; ++i) {
        const f32x4* gp = (const f32x4*)(GLR + (size_t)(t0 + i) * 16); f32x4 z = bgv;
#pragma unroll
        for (int q = 0; q < 4; ++q) { const f32x4 gv = gp[q]; z += w[4 * q] * gv.x; z += w[4 * q + 1] * gv.y; z += w[4 * q + 2] * gv.z; z += w[4 * q + 3] * gv.w; }
#pragma unroll
        for (int j = 0; j < 4; ++j) run[j] += log_sigmoid(z[j]) * (1.f / 16.f);
        cs[i] = run;
    }
    *(LAS f32x4*)(tot + seg * 64 + 4 * cq) = run;
    __syncthreads();
    f32x4 off = (f32x4){0.f, 0.f, 0.f, 0.f}, total = (f32x4){0.f, 0.f, 0.f, 0.f};
    for (int sg = 0; sg < 32; ++sg) { const f32x4 tv = *(const LAS f32x4*)(tot + sg * 64 + 4 * cq); total += tv; if (sg < seg) off += tv; }
    unsigned kew[4][4];
    bf16* ACAT = (bf16*)(F.ws + WS_ACAT); bf16* KI = (bf16*)(F.ws + WS_KI); bf16* KET = (bf16*)(F.ws + WS_KET);
    float kprev[4];
#pragma unroll
    for (int i = 0; i < 8; ++i) {
        const size_t trow = (size_t)(t0 + i);
        const u32x2 qv = *(const u32x2*)(GQ + trow * GLA_QK + col0), kv = *(const u32x2*)(GK + trow * GLA_QK + col0);
        float q[4] = {__uint_as_float(qv.x << 16), __uint_as_float(qv.x & 0xffff0000u), __uint_as_float(qv.y << 16), __uint_as_float(qv.y & 0xffff0000u)};
        float k[4] = {__uint_as_float(kv.x << 16), __uint_as_float(kv.x & 0xffff0000u), __uint_as_float(kv.y << 16), __uint_as_float(kv.y & 0xffff0000u)};
        float qd[4], ki[4], ke[4];
#pragma unroll
        for (int j = 0; j < 4; ++j) { const float bc = cs[i][j] + off[j]; qd[j] = q[j] * 0.0625f * __expf(bc); ki[j] = k[j] * __expf(-bc); ke[j] = k[j] * __expf(total[j] - bc); }
        const size_t lrow = (size_t)nh * 256 + seg * 8 + i;
        u32x2 o; o.x = pk2(qd[0], qd[1]); o.y = pk2(qd[2], qd[3]); *(u32x2*)(ACAT + lrow * 512 + 256 + dk0) = o;
        o.x = pk2(ki[0], ki[1]); o.y = pk2(ki[2], ki[3]); *(u32x2*)(KI + lrow * 256 + dk0) = o;
        if (i & 1) {
#pragma unroll
            for (int j = 0; j < 4; ++j) kew[j][i >> 1] = pk2(kprev[j], ke[j]); }
        else {
#pragma unroll
            for (int j = 0; j < 4; ++j) kprev[j] = ke[j]; }
    }
#pragma unroll
    for (int j = 0; j < 4; ++j) *(u32x4*)(KET + ((size_t)nh * 256 + dk0 + j) * 256 + seg * 8) = (u32x4){kew[j][0], kew[j][1], kew[j][2], kew[j][3]};
    if (seg == 0) *(f32x4*)((float*)(F.ws + WS_DEC) + n * GLA_QK + col0) = (f32x4){__expf(total[0]), __expf(total[1]), __expf(total[2]), __expf(total[3])};
    __syncthreads();
}
__device__ __forceinline__ void gla_vt_unit(Frame& F, int n, int h, int g8) {
    const int tid = F.tid; const int nh = n * GLA_H + h;
    LAS bf16* tile = (LAS bf16*)F.lds;
    const bf16* GV = (const bf16*)(F.ws + WS_GV); bf16* BCAT = (bf16*)(F.ws + WS_BCAT);
#pragma unroll
    for (int ps = 0; ps < 4; ++ps) { const int row = (tid >> 3) + 64 * ps, ch = tid & 7;
        const u32x4 v = *(const u32x4*)(GV + (size_t)(n * 256 + row) * GLA_V + h * GLA_DV + g8 * 64 + ch * 8);
        *(LAS u32x2*)(tile + row * 72 + ch * 8) = (u32x2){v.x, v.y}; *(LAS u32x2*)(tile + row * 72 + ch * 8 + 4) = (u32x2){v.z, v.w}; }
    __syncthreads();
#pragma unroll
    for (int i = 0; i < 4; ++i) { const int g = tid + 512 * i, c = g & 63, tg = g >> 6; unsigned short e[8];
#pragma unroll
        for (int j = 0; j < 8; ++j) e[j] = tile[(tg * 8 + j) * 72 + c];
        u32x4 v; v.x = e[0] | ((unsigned)e[1] << 16); v.y = e[2] | ((unsigned)e[3] << 16); v.z = e[4] | ((unsigned)e[5] << 16); v.w = e[6] | ((unsigned)e[7] << 16);
        *(u32x4*)(BCAT + ((size_t)nh * 512 + g8 * 64 + c) * 512 + tg * 8) = v; }
    __syncthreads();
}
__device__ __forceinline__ void gla_scan(Frame& F) {
    const bf16* UT = (const bf16*)(F.ws + WS_UT); bf16* BCAT = (bf16*)(F.ws + WS_BCAT); const float* DEC = (const float*)(F.ws + WS_DEC);
    for (int idx = F.vcu * (NWAVES * 64) + F.tid; idx < GLA_H * GLA_DV * 64; idx += F.G * NWAVES * 64) {
        const int dk4 = (idx & 63) * 4, dv = (idx >> 6) & 511, h = idx >> 15;
        float s[4] = {0.f, 0.f, 0.f, 0.f};
#pragma unroll 8
        for (int n = 0; n < 32; ++n) {
            const size_t nh = (size_t)n * GLA_H + h;
            u32x2 o; o.x = pk2(s[0], s[1]); o.y = pk2(s[2], s[3]); *(u32x2*)(BCAT + (nh * 512 + dv) * 512 + 256 + dk4) = o;
            const u32x2 uv = *(const u32x2*)(UT + (nh * 512 + dv) * 256 + dk4); const f32x4 dc = *(const f32x4*)(DEC + n * GLA_QK + h * GLA_DK + dk4);
            s[0] = s[0] * dc.x + __uint_as_float(uv.x << 16); s[1] = s[1] * dc.y + __uint_as_float(uv.x & 0xffff0000u);
            s[2] = s[2] * dc.z + __uint_as_float(uv.y << 16); s[3] = s[3] * dc.w + __uint_as_float(uv.y & 0xffff0000u);
        }
    }
}
__device__ __forceinline__ void gla_norm(Frame& F, const Args& a) {
    const int gw = F.vcu * NWAVES + F.wave, NGW = F.G * NWAVES, lane = F.lane;
    const bf16* OB = (const bf16*)(F.ws + WS_OB); const bf16* GR = (const bf16*)(F.ws + WS_GR); bf16* YG = (bf16*)(F.ws + WS_YG); const float* g = a.in[5];
    const f32x4 g0 = *(const f32x4*)(g + 8 * lane), g1 = *(const f32x4*)(g + 8 * lane + 4);
    for (int wi = gw; wi < S * GLA_H; wi += NGW) {
        const size_t off = (size_t)(wi >> 2) * GLA_V + (wi & 3) * GLA_DV + 8 * lane;
        const u32x4 ov = *(const u32x4*)(OB + off), rv = *(const u32x4*)(GR + off);
        float o[8], r[8]; float ss = 0.f;
#pragma unroll
        for (int j = 0; j < 4; ++j) { o[2 * j] = __uint_as_float(ov[j] << 16); o[2 * j + 1] = __uint_as_float(ov[j] & 0xffff0000u); r[2 * j] = __uint_as_float(rv[j] << 16); r[2 * j + 1] = __uint_as_float(rv[j] & 0xffff0000u); }
#pragma unroll
        for (int j = 0; j < 8; ++j) ss += o[j] * o[j];
        const float rstd = rsqrtf(wave_sum(ss) * (1.f / GLA_DV) + 1e-6f);
        u32x4 w; w.x = pk2(o[0] * rstd * g0.x * r[0], o[1] * rstd * g0.y * r[1]); w.y = pk2(o[2] * rstd * g0.z * r[2], o[3] * rstd * g0.w * r[3]);
        w.z = pk2(o[4] * rstd * g1.x * r[4], o[5] * rstd * g1.y * r[5]); w.w = pk2(o[6] * rstd * g1.z * r[6], o[7] * rstd * g1.w * r[7]);
        *(u32x4*)(YG + off) = w;
    }
}

__global__ void __launch_bounds__(NWAVES * 64, 2) fwd(Args args) {
    extern __shared__ __attribute__((aligned(16))) unsigned char lds_raw[];
    Frame F;
    F.lds = (LAS unsigned char*)lds_raw; F.MISC = (volatile LAS unsigned*)(F.lds + MISC_OFF);
    F.tid = threadIdx.x; F.lane = F.tid & 63; F.wave = __builtin_amdgcn_readfirstlane(F.tid >> 6);
    F.G = gridDim.x; { const int bx = blockIdx.x; F.vcu = (F.G % 8 == 0) ? (bx % 8) * (F.G / 8) + bx / 8 : bx; }
    F.ws = args.ws; F.ctl = (unsigned*)(args.ws + WS_CTL);
    for (int u = F.tid; u < (LDS_BYTES - RING_BYTES) / 4; u += NWAVES * 64) ((LAS unsigned*)(F.lds + RING_BYTES))[u] = 0u;
    __syncthreads();
    XcdBarrier bar = xcd_barrier_post(F.ctl + CW_BAR + args.li * XCD_BAR_WORDS, F.MISC + 8);
    const int lo = args.ph_lo, hi = args.ph_hi;
#define IN(k) (lo <= (k) && (k) < hi)
#define SEAM(k) do { if (IN(k) && IN((k) + 1)) xcd_barrier(bar); } while (0)
    unsigned char* ws = args.ws;
#ifndef DUP_MASK
#define DUP_MASK 0
#endif
#define DUP(k) ((DUP_MASK >> (k)) & 1)
#define PHASE(k, ...) do { if (IN(k)) { __VA_ARGS__ if (DUP(k)) { xcd_barrier(bar); __VA_ARGS__ } } SEAM(k); } while (0)
    PHASE(0, { p0_prologue(F, args); });
    PHASE(1, { pg8::DenseSched Sc; Sc.init(ws + WS_XN, ws + WS_WIN, S, NPROJ, D, F.G, (int)blockIdx.x); pg8::EpiProj E{ws, args.in[9]};
        pg8::gemm_phase<pg8::EpiProj, pg8::DenseSched>(F.lds, D, D, D, Sc, E); });
    PHASE(2, { for (int u = F.vcu; u < NCH * ATT_H; u += F.G) attn_prep_unit(F, args, u >> 3, u & 7);
        for (int u = F.vcu; u < 32 * 16; u += F.G) gla_prep_unit(F, args, u >> 4, u & 15);
        for (int u = F.vcu; u < 32 * GLA_H * 8; u += F.G) gla_vt_unit(F, u >> 5, (u >> 3) & 3, u & 7); });
    PHASE(3, { for (int u = F.vcu; u < (NCH / 4) * ATT_H; u += F.G) attn_unit(F, args, u >> 3, u & 7);
        { pg8::GlaSched Sc{0, F.G, F.G - 1 - (int)blockIdx.x, ws}; pg8::EpiGla<0> E{ws}; pg8::gemm_phase<pg8::EpiGla<0>, pg8::GlaSched>(F.lds, 256, 512, 256, Sc, E); }
        { pg8::GlaSched Sc{1, F.G, (int)blockIdx.x, ws}; pg8::EpiGla<1> E{ws}; pg8::gemm_phase<pg8::EpiGla<1>, pg8::GlaSched>(F.lds, 256, 512, 256, Sc, E); } });
    PHASE(4, { gla_scan(F); });
    PHASE(5, { pg8::GlaSched Sc{2, F.G, (int)blockIdx.x, ws}; pg8::EpiGla<2> E{ws}; pg8::gemm_phase<pg8::EpiGla<2>, pg8::GlaSched>(F.lds, 512, 512, 512, Sc, E); });
    PHASE(6, { gla_norm(F, args); });
    PHASE(7, { pg8::DenseSched Sc; Sc.init(ws + WS_YG, ws + WS_WBG, S, D, GLA_V, F.G, (int)blockIdx.x); pg8::EpiBranch<0> E{(const bf16*)(ws + WS_SG), nullptr, (bf16*)(ws + WS_T)};
        pg8::gemm_phase<pg8::EpiBranch<0>, pg8::DenseSched>(F.lds, GLA_V, GLA_V, GLA_V, Sc, E); });
    PHASE(8, { pg8::DenseSched Sc; Sc.init(ws + WS_YA, ws + WS_WBA, S, D, ATT_W, F.G, (int)blockIdx.x); pg8::EpiBranch<1> E{(const bf16*)(ws + WS_SA), (const bf16*)(ws + WS_T), (bf16*)(ws + WS_MG)};
        pg8::gemm_phase<pg8::EpiBranch<1>, pg8::DenseSched>(F.lds, ATT_W, ATT_W, ATT_W, Sc, E); });
    PHASE(9, { pg8::DenseSched Sc; Sc.init(ws + WS_MG, ws + WS_WOUT, S, D, D, F.G, (int)blockIdx.x); pg8::EpiResid E{args.in[0], args.out};
        pg8::gemm_phase<pg8::EpiResid, pg8::DenseSched>(F.lds, D, D, D, Sc, E); });
    PHASE(10, { for (int u = F.vcu; u < S / 32; u += F.G) router_unit(F, args, u); });
    PHASE(11, { moe_table(F); p7_gather(F); });
    PHASE(12, { moe_table(F); pg8::MoeSched Sc; Sc.init(ws + WS_HNG, ws + WS_GU, (volatile LAS int*)(F.lds + TAB_OFF), (volatile LAS int*)(F.lds + TAB_OFF + 256), 16, D, F.G, (int)blockIdx.x);
        pg8::EpiSwiglu E{args.in[17], args.in[19], (bf16*)(ws + WS_HD)};
        pg8::gemm_phase<pg8::EpiSwiglu, pg8::MoeSched>(F.lds, D, D, D, Sc, E); });
    PHASE(13, { moe_table(F); pg8::MoeSched Sc; Sc.init(ws + WS_HD, ws + WS_DN, (volatile LAS int*)(F.lds + TAB_OFF), (volatile LAS int*)(F.lds + TAB_OFF + 256), 8, DFF, F.G, (int)blockIdx.x);
        pg8::EpiDown E{args.in[21], (const int*)(ws + WS_RPAIR), (const float*)(ws + WS_RW), (bf16*)(ws + WS_PY)};
        pg8::gemm_phase<pg8::EpiDown, pg8::MoeSched>(F.lds, DFF, DFF, DFF, Sc, E); });
    PHASE(14, { p10_combine(F, args); });
#undef PHASE
#undef IN
#undef SEAM
}

extern "C" void kernel_launch(void* const* d_in, const int* in_sizes, int n_in, void* d_out, int out_size, void* d_ws, size_t ws_size, hipStream_t stream) {
    static int grid = 0;
    if (grid == 0) {
        if (n_in != 22 || out_size != S * D || ws_size < WS_END) { fprintf(stderr, "kernel_launch: unexpected problem (n_in %d out %d ws %zu)\n", n_in, out_size, ws_size); grid = -1; return; }
        int dev = 0, cus = 0, per_cu = 0;
        if (hipGetDevice(&dev) != hipSuccess || hipDeviceGetAttribute(&cus, hipDeviceAttributeMultiprocessorCount, dev) != hipSuccess) { grid = -1; return; }
        if (hipFuncSetAttribute((const void*)fwd, hipFuncAttributeMaxDynamicSharedMemorySize, LDS_BYTES) != hipSuccess) { fprintf(stderr, "kernel_launch: hipFuncSetAttribute failed\n"); grid = -1; return; }
        if (hipOccupancyMaxActiveBlocksPerMultiprocessor(&per_cu, (const void*)fwd, NWAVES * 64, LDS_BYTES) != hipSuccess || per_cu < 1) fprintf(stderr, "kernel_launch: occupancy query says %d\n", per_cu);
        (void)hipGetLastError();
        grid = cus;
    }
    if (grid < 0) return;
    (void)hipMemsetAsync((char*)d_ws + WS_CTL, 0, CTL_ZERO_BYTES, stream);
    Args a{};
    for (int i = 0; i < 22; ++i) a.in[i] = (const float*)d_in[i];
    a.out = (float*)d_out; a.ws = (unsigned char*)d_ws;
    a.ph_lo = 0; a.ph_hi = 15; a.li = 0;
    hipLaunchKernelGGL(fwd, dim3(grid), dim3(NWAVES * 64), LDS_BYTES, stream, a);
}
```

```cpp
#include <hip/hip_runtime.h>
#include <stdint.h>
#include <cstdio>

constexpr int S = 8192, D = 2048;
constexpr int GLA_H = 4, GLA_DK = 256, GLA_DV = 512, GLA_QK = 1024, GLA_V = 2048;
constexpr int ATT_H = 8, ATT_HD = 128, ATT_W = 1024, NCH = S / 64;
constexpr int NE = 32, DFF = 2048;
constexpr int IN_COLS = 13328, C_GLR = 6144;
constexpr int NPROJ = 13312;
constexpr int MAXROWS = 32768 + NE * 256;

constexpr size_t MiB = 1u << 20;
constexpr size_t WS_CTL = 0, CTL_ZERO_BYTES = 1 * MiB;
constexpr size_t WS_TOPW = 1 * MiB, WS_TOPE = WS_TOPW + 128 * 1024, WS_TOPS = WS_TOPE + 128 * 1024, WS_RPAIR = WS_TOPS + 128 * 1024, WS_RW = WS_RPAIR + 256 * 1024;
constexpr size_t WS_GLR = 2 * MiB, WS_WR = 3 * MiB;
constexpr size_t WS_WIN = 8 * MiB, WS_WBG = 60 * MiB, WS_WBA = 68 * MiB, WS_WOUT = 72 * MiB, WS_GU = 80 * MiB, WS_DN = 592 * MiB;
constexpr size_t WS_XN = 848 * MiB, WS_GQ = 880 * MiB, WS_GK = 896 * MiB, WS_GV = 912 * MiB, WS_GR = 944 * MiB, WS_AQ = 976 * MiB, WS_AK = 992 * MiB, WS_AV = 1008 * MiB;
constexpr size_t WS_SG = 1024 * MiB, WS_SA = 1056 * MiB, WS_YG = 1088 * MiB, WS_YA = 1120 * MiB, WS_T = 1136 * MiB, WS_MG = 1168 * MiB, WS_HN = 1200 * MiB;
constexpr size_t WS_HNG = 1232 * MiB, WS_HD = 1392 * MiB, WS_PY = 1552 * MiB, WS_QH = 1681 * MiB, WS_KIMG = 1697 * MiB, WS_VIMG = 1713 * MiB;
constexpr size_t WS_ACAT = 1729 * MiB, WS_BCAT = 1761 * MiB, WS_KI = 1825 * MiB, WS_KET = 1841 * MiB, WS_UT = 1857 * MiB, WS_DEC = 1889 * MiB, WS_OB = 1890 * MiB, WS_END = 1922 * MiB;
constexpr int CW_CNT = 64;
constexpr int CW_BAR = 4096;

typedef unsigned short bf16;
typedef short bf16x8 __attribute__((ext_vector_type(8)));
typedef float f32x4 __attribute__((ext_vector_type(4)));
typedef float f32x16 __attribute__((ext_vector_type(16)));
typedef unsigned u32x4 __attribute__((ext_vector_type(4)));
typedef unsigned u32x2 __attribute__((ext_vector_type(2)));
#define LAS __attribute__((address_space(3)))
#define GAS __attribute__((address_space(1)))
__device__ __forceinline__ float bf2f(bf16 v) { return __uint_as_float((unsigned)v << 16); }
__device__ __forceinline__ unsigned f2bf(float f) { unsigned u = __float_as_uint(f); return (u + 0x7fffu + ((u >> 16) & 1u)) >> 16; }
__device__ __forceinline__ unsigned pk2(float lo, float hi) { return f2bf(lo) | (f2bf(hi) << 16); }
__device__ __forceinline__ unsigned cvt_pk_bf16(float lo, float hi) { unsigned r; asm volatile("v_cvt_pk_bf16_f32 %0, %1, %2" : "=v"(r) : "v"(lo), "v"(hi)); return r; }
__device__ __forceinline__ float wave_sum(float v) {
#pragma unroll
    for (int o = 1; o < 64; o <<= 1) v += __shfl_xor(v, o);
    return v;
}
__device__ __forceinline__ float sigmoidf_(float x) { return 1.f / (1.f + __expf(-x)); }
__device__ __forceinline__ float log_sigmoid(float z) { return fminf(z, 0.f) - log1pf(__expf(-fabsf(z))); }
#define LDS_WAIT() asm volatile("s_waitcnt lgkmcnt(0)" ::: "memory")
#define VM_WAIT() asm volatile("s_waitcnt vmcnt(0)" ::: "memory")

#define XB_TMO      128
#define XB_XCNT(j)  (256  + 64 * (j))
#define XB_XSUB(j)  (1280 + 64 * (j))
#define XB_XGEN(j)  (2304 + 64 * (j))
#define XB_TOP      3328
#define XB_TOPGEN   3392
#define XCD_BAR_WORDS 3456
#define XB_SPIN_CAP (1u << 18)
__device__ __forceinline__ unsigned xb_ld(unsigned* p)              { return __hip_atomic_load(p, __ATOMIC_RELAXED, __HIP_MEMORY_SCOPE_AGENT); }
__device__ __forceinline__ unsigned xb_add(unsigned* p, unsigned v) { return __hip_atomic_fetch_add(p, v, __ATOMIC_RELAXED, __HIP_MEMORY_SCOPE_AGENT); }
__device__ __forceinline__ unsigned xb_xcc_id() { return (unsigned)__builtin_amdgcn_s_getreg((3 << 11) | 20) & 0xFu; }
#define XB_SPIN(cond, bar) do { unsigned _sp = 0; while (cond) { __builtin_amdgcn_s_sleep(1); \
    if ((++_sp & 255u) == 0u) { if (xb_ld(&(bar)[XB_TMO])) break; if (_sp > XB_SPIN_CAP) { atomicAdd(&(bar)[XB_TMO], 1u); break; } } } } while (0)
struct XcdBarrier { unsigned* bar; unsigned x; volatile LAS unsigned* st; };
__device__ __forceinline__ XcdBarrier xcd_barrier_post(unsigned* bar, volatile LAS unsigned* st) {
    XcdBarrier b; b.bar = bar; b.x = xb_xcc_id(); b.st = st;
    if (threadIdx.x == 0) (void)xb_add(&bar[XB_XCNT(b.x)], 1u);
    return b;
}
__device__ __forceinline__ void xcd_barrier_complete(unsigned* bar, unsigned x, unsigned& nloc, unsigned& nx) {
    const unsigned G = gridDim.x * gridDim.y * gridDim.z;
    unsigned sum, cnt, mine, sp = 0u;
    for (;;) {
        sum = 0u; cnt = 0u; mine = 0u;
#pragma unroll
        for (unsigned j = 0; j < 16; ++j) { const unsigned c = xb_ld(&bar[XB_XCNT(j)]); sum += c; cnt += (c > 0u) ? 1u : 0u; mine = (j == x) ? c : mine; }
        if (sum == G) break;
        __builtin_amdgcn_s_sleep(1);
        if ((++sp & 255u) == 0u) { if (xb_ld(&bar[XB_TMO])) break; if (sp > XB_SPIN_CAP) { atomicAdd(&bar[XB_TMO], 1u); break; } }
    }
    nloc = mine > 0u ? mine : 1u; nx = cnt > 0u ? cnt : 1u;
}
__device__ __forceinline__ void xcd_barrier(const XcdBarrier& b) {
    asm volatile("s_waitcnt vmcnt(0)" ::: "memory");
    __syncthreads();
    if (threadIdx.x == 0) {
        unsigned* bar = b.bar;
        __builtin_amdgcn_s_waitcnt(0);
        unsigned nloc = b.st[0], nx = b.st[1];
        if (nloc == 0u) { xcd_barrier_complete(bar, b.x, nloc, nx); b.st[0] = nloc; b.st[1] = nx; }
        const unsigned old = xb_add(&bar[XB_XSUB(b.x)], 1u);
        const unsigned gen = old / nloc;
        if (old + 1u == (gen + 1u) * nloc) {
            __builtin_amdgcn_fence(__ATOMIC_RELEASE, "agent");
            asm volatile("s_waitcnt vmcnt(0)" ::: "memory");
            const unsigned og = xb_add(&bar[XB_TOP], 1u);
            const unsigned tg = og / nx;
            if (og + 1u == (tg + 1u) * nx) xb_add(&bar[XB_TOPGEN], 1u);
            else XB_SPIN(xb_ld(&bar[XB_TOPGEN]) == tg, bar);
            __builtin_amdgcn_fence(__ATOMIC_ACQUIRE, "agent");
            xb_add(&bar[XB_XGEN(b.x)], 1u);
            asm volatile("s_waitcnt vmcnt(0)" ::: "memory");
        } else {
            XB_SPIN(xb_ld(&bar[XB_XGEN(b.x)]) == gen, bar);
            __builtin_amdgcn_fence(__ATOMIC_ACQUIRE, "agent");
            asm volatile("s_waitcnt vmcnt(0)" ::: "memory");
        }
    }
    __syncthreads();
}

namespace pg8 {
constexpr int BM = 256, BK = 64, HALF = 128, HTB = HALF * BK * 2, STAGE_BYTES = 8 * HTB, NXCD = 8, WGM = 8;
__host__ __device__ __forceinline__ int lds_byte(int r, int c) { const int st = (r >> 4) * 2 + (c >> 5), rr = r & 15, cc = c & 31, ob = rr * 64 + cc * 2; return st * 1024 + (ob ^ (((ob >> 9) & 1) << 5)); }
__host__ __device__ __forceinline__ void stage_rc(int b, int& R, int& C) { const int st = b / 1024, sb = b % 1024, swz = sb ^ (((sb >> 9) & 1) << 5); R = (st >> 1) * 16 + swz / 64; C = (st & 1) * 32 + (swz % 64) / 2; }
__host__ __device__ __forceinline__ int perm32(int rho) { const int n = rho >> 4, i = rho & 15; return 8 * (i >> 2) + 4 * n + (i & 3); }
__device__ __forceinline__ int xcd_remap(int wgid, int nwg) { const int q = nwg / NXCD, r = nwg % NXCD, xcd = wgid % NXCD, off = wgid / NXCD; return (xcd < r ? xcd * (q + 1) : r * (q + 1) + (xcd - r) * q) + off; }

struct Unit { const char* A; const char* B; int pm, pn, e, nrow; };

struct DenseSched {
    const char* A; const char* Bt; int nM, nN, nwg, G, c; size_t tstep;
    __device__ __forceinline__ void init(const void* A_, const void* Bt_, int M, int N, int K, int G_, int c_) { A = (const char*)A_; Bt = (const char*)Bt_; nM = M / BM; nN = N / BM; nwg = nM * nN; G = G_; c = c_; tstep = (size_t)BM * K * 2; }
    __device__ __forceinline__ bool next(int i, Unit& u) const {
        const long L = (long)i * G + c; if (L >= nwg) return false;
        const int wgid = xcd_remap((int)L, nwg);
        const int nig = WGM * nN, gid = wgid / nig, fm = gid * WGM, gsz = (nM - fm) < WGM ? (nM - fm) : WGM;
        u.pm = fm + ((wgid % nig) % gsz); u.pn = (wgid % nig) / gsz; u.e = 0; u.nrow = BM;
        u.A = A + (size_t)u.pm * tstep; u.B = Bt + (size_t)u.pn * tstep; return true;
    }
};
struct MoeSched {
    const char* A; const char* Bt; const volatile LAS int* tstart; const volatile LAS int* cnt; int NT, nwg, G, c; size_t tstep;
    __device__ __forceinline__ void init(const void* A_, const void* Bt_, const volatile LAS int* ts, const volatile LAS int* cn, int NT_, int K, int G_, int c_) {
        A = (const char*)A_; Bt = (const char*)Bt_; tstart = ts; cnt = cn; NT = NT_; nwg = ts[NE] * NT_; G = G_; c = c_; tstep = (size_t)BM * K * 2; }
    __device__ __forceinline__ bool next(int i, Unit& u) const {
        const long L = (long)i * G + c; if (L >= nwg) return false;
        const int wgid = xcd_remap((int)L, nwg);
        int e = 0;
#pragma unroll 1
        for (int j = 1; j < NE; ++j) e = (wgid >= tstart[j] * NT) ? j : e;
        const int t0 = tstart[e], nte = tstart[e + 1] - t0, local = wgid - t0 * NT;
        const int pn = local / nte, mt = local - pn * nte;
        u.e = e; u.pn = pn; u.pm = t0 + mt; u.nrow = cnt[e] - mt * BM;
        u.A = A + (size_t)u.pm * tstep; u.B = Bt + (size_t)(e * NT + pn) * tstep; return true;
    }
};

template <class Epi, class Sched, bool BGRAN = false>
__device__ __forceinline__ void gemm_phase(LAS unsigned char* lds, const int K, const int lda, const int ldb, const Sched& S, const Epi& E) {
    const int tid = threadIdx.x, wid = __builtin_amdgcn_readfirstlane(tid >> 6), lane = tid & 63, wr = wid >> 2, wc = wid & 3, fr = lane & 15, fq = lane >> 4;
    int nt = K / BK; asm volatile("" : "+s"(nt));
    unsigned voffA[2], voffB[2];
#pragma unroll
    for (int i = 0; i < 2; ++i) { int R, C; stage_rc(tid * 16 + i * 8192, R, C); const int Rb = Epi::PERM ? ((R & ~31) + perm32(R & 31)) : R;
        voffA[i] = (unsigned)(R * lda + C) * 2u; voffB[i] = BGRAN ? (unsigned)((C >> 3) * ldb + Rb) * 16u : (unsigned)(Rb * ldb + C) * 2u; }
    const size_t kstep = (size_t)(BK * 2), kstepB = BGRAN ? (size_t)ldb * 128 : (size_t)(BK * 2);
    const size_t hstepA = (size_t)HALF * lda * 2, hstepB = BGRAN ? (size_t)2048 : (size_t)HALF * ldb * 2;
    const unsigned ldsw = (unsigned)wid * 1024u;
    const int aoff = lds_byte(wr * 64 + fr, fq * 8), boff = lds_byte(wc * 32 + fr, fq * 8);
#define PG8_SA(b, h) (((b) * 2 + (h)) * HTB)
#define PG8_SB(b, h) ((4 + (b) * 2 + (h)) * HTB)
#define PG8_STAGE(bufoff, gbase, voff) do { _Pragma("unroll") for (int _i = 0; _i < 2; ++_i) \
        __builtin_amdgcn_global_load_lds((const unsigned*)((const char*)(gbase) + (voff)[_i]), (LAS unsigned*)(lds + (bufoff) + ldsw + _i * 8192), 16, 0, 0); } while (0)
#define PG8_LDA(dst, b, h) do { _Pragma("unroll") for (int m = 0; m < 4; ++m) _Pragma("unroll") for (int k = 0; k < 2; ++k) dst[m][k] = *(const LAS bf16x8*)(lds + PG8_SA(b, h) + aoff + m * 2048 + k * 1024); } while (0)
#define PG8_LDB(dst, b, h) do { _Pragma("unroll") for (int n = 0; n < 2; ++n) _Pragma("unroll") for (int k = 0; k < 2; ++k) dst[n][k] = *(const LAS bf16x8*)(lds + PG8_SB(b, h) + boff + n * 2048 + k * 1024); } while (0)
#define PG8_MMA(ai, bj, At, Bt) do { __builtin_amdgcn_s_setprio(1); _Pragma("unroll") for (int m = 0; m < 4; ++m) _Pragma("unroll") for (int n = 0; n < 2; ++n) _Pragma("unroll") for (int k = 0; k < 2; ++k) \
        acc[ai][bj][m][n] = __builtin_amdgcn_mfma_f32_16x16x32_bf16(Bt[n][k], At[m][k], acc[ai][bj][m][n], 0, 0, 0); __builtin_amdgcn_s_setprio(0); } while (0)
#define PG8_WAIT_V(n) asm volatile("s_waitcnt vmcnt(" #n ")" ::: "memory")
#define PG8_WAIT_L(n) asm volatile("s_waitcnt lgkmcnt(" #n ")" ::: "memory")
#define PG8_BAR __builtin_amdgcn_s_barrier()
#define PG8_SCHED __builtin_amdgcn_sched_barrier(0)
    Unit cur, nxt; int ui = 0;
    if (!S.next(0, cur)) return;
    f32x4 acc[2][2][4][2];
#pragma unroll
    for (int a = 0; a < 2; ++a)
#pragma unroll
        for (int b = 0; b < 2; ++b)
#pragma unroll
            for (int m = 0; m < 4; ++m)
#pragma unroll
                for (int n = 0; n < 2; ++n) acc[a][b][m][n] = (f32x4){0.f, 0.f, 0.f, 0.f};
    bf16x8 At[4][2], B0[2][2], B1[2][2];
    const char* cA = cur.A; const char* cB = cur.B;
    PG8_STAGE(PG8_SB(0, 0), cB, voffB); PG8_STAGE(PG8_SB(0, 1), cB + hstepB, voffB); PG8_STAGE(PG8_SA(0, 0), cA, voffA); PG8_STAGE(PG8_SA(0, 1), cA + hstepA, voffA);
    if (wr == 1) PG8_BAR;
    PG8_WAIT_V(2); PG8_BAR;
    PG8_STAGE(PG8_SB(1, 0), cB + kstepB, voffB); PG8_STAGE(PG8_SA(1, 0), cA + kstep, voffA); PG8_STAGE(PG8_SB(1, 1), cB + hstepB + kstepB, voffB);
    PG8_WAIT_V(6); PG8_BAR;
    for (;;) {
        const bool has_next = S.next(ui + 1, nxt);
        const char* nA = has_next ? nxt.A : cA; const char* nB = has_next ? nxt.B : cB;
#pragma unroll 1
        for (int t = 0; t < nt; t += 2) {
            const bool last = (t == nt - 2);
            const char* a1 = cA + (size_t)(t + 1) * kstep;
            const char* a2 = last ? nA : cA + (size_t)(t + 2) * kstep; const char* b2 = last ? nB : cB + (size_t)(t + 2) * kstepB;
            const char* a3 = a2 + kstep; const char* b3 = b2 + kstepB;
            PG8_LDB(B0, 0, 0); PG8_LDB(B1, 0, 1); PG8_SCHED; PG8_LDA(At, 0, 0); PG8_STAGE(PG8_SA(1, 1), a1 + hstepA, voffA);
            PG8_WAIT_V(8); PG8_WAIT_L(0); PG8_BAR; PG8_MMA(0, 0, At, B0); PG8_MMA(0, 1, At, B1); PG8_BAR; PG8_SCHED;
            PG8_LDA(At, 0, 1); PG8_STAGE(PG8_SB(0, 0), b2, voffB); PG8_STAGE(PG8_SB(0, 1), b2 + hstepB, voffB); PG8_STAGE(PG8_SA(0, 0), a2, voffA);
            PG8_WAIT_V(8); PG8_WAIT_L(0); PG8_BAR; PG8_MMA(1, 0, At, B0); PG8_MMA(1, 1, At, B1); PG8_BAR; PG8_SCHED;
            PG8_LDB(B0, 1, 0); PG8_LDB(B1, 1, 1); PG8_SCHED; PG8_LDA(At, 1, 0); PG8_STAGE(PG8_SA(0, 1), a2 + hstepA, voffA);
            PG8_WAIT_V(8); PG8_WAIT_L(0); PG8_BAR; PG8_MMA(0, 0, At, B0); PG8_MMA(0, 1, At, B1); PG8_BAR; PG8_SCHED;
            PG8_LDA(At, 1, 1); PG8_STAGE(PG8_SB(1, 0), b3, voffB); PG8_STAGE(PG8_SB(1, 1), b3 + hstepB, voffB); PG8_STAGE(PG8_SA(1, 0), a3, voffA);
            PG8_WAIT_V(8); PG8_WAIT_L(0); PG8_BAR; PG8_MMA(1, 0, At, B0); PG8_MMA(1, 1, At, B1); PG8_BAR; PG8_SCHED;
        }
        if (wr == 0) PG8_BAR;
        E(acc, cur, wr, wc, fr, fq);
        if (!has_next) break;
#pragma unroll
        for (int a = 0; a < 2; ++a)
#pragma unroll
            for (int b = 0; b < 2; ++b)
#pragma unroll
                for (int m = 0; m < 4; ++m)
#pragma unroll
                    for (int n = 0; n < 2; ++n) acc[a][b][m][n] = (f32x4){0.f, 0.f, 0.f, 0.f};
        cur = nxt; cA = nA; cB = nB; ++ui;
        if (wr == 1) PG8_BAR;
    }
    PG8_WAIT_V(0);
    PG8_BAR;
#undef PG8_SA
#undef PG8_SB
#undef PG8_STAGE
#undef PG8_LDA
#undef PG8_LDB
#undef PG8_MMA
#undef PG8_WAIT_V
#undef PG8_WAIT_L
#undef PG8_BAR
#undef PG8_SCHED
}

struct EpiProj {
    static constexpr bool PERM = true;
    unsigned char* ws; const float* bbg;
    __device__ __forceinline__ void operator()(const f32x4 (&acc)[2][2][4][2], const Unit& u, int wr, int wc, int fr, int fq) const {
        const int pn = u.pn; size_t off; int ld, t0, act = 0;
        if (pn < 4) { off = WS_GQ; ld = 1024; t0 = 0; } else if (pn < 8) { off = WS_GK; ld = 1024; t0 = 4; } else if (pn < 16) { off = WS_GV; ld = 2048; t0 = 8; }
        else if (pn < 24) { off = WS_GR; ld = 2048; t0 = 16; act = 1; } else if (pn < 28) { off = WS_AQ; ld = 1024; t0 = 24; } else if (pn < 32) { off = WS_AK; ld = 1024; t0 = 28; }
        else if (pn < 36) { off = WS_AV; ld = 1024; t0 = 32; } else if (pn < 44) { off = WS_SG; ld = 2048; t0 = 36; act = 2; } else { off = WS_SA; ld = 2048; t0 = 44; act = 3; }
        bf16* base = (bf16*)(ws + off);
        const int colt = (pn - t0) * BM + wc * 32 + 8 * fq, row0 = u.pm * BM + wr * 64 + fr;
        f32x4 bv[2][2];
#pragma unroll
        for (int bj = 0; bj < 2; ++bj)
#pragma unroll
            for (int n = 0; n < 2; ++n) bv[bj][n] = act >= 2 ? *(const f32x4*)(bbg + (act - 2) * D + colt + bj * HALF + 4 * n) : (f32x4){0.f, 0.f, 0.f, 0.f};
#pragma unroll
        for (int ai = 0; ai < 2; ++ai)
#pragma unroll
            for (int m = 0; m < 4; ++m) { bf16* rowp = base + (size_t)(row0 + ai * HALF + m * 16) * ld + colt;
#pragma unroll
                for (int bj = 0; bj < 2; ++bj) { f32x4 v0 = acc[ai][bj][m][0] + bv[bj][0], v1 = acc[ai][bj][m][1] + bv[bj][1];
                    if (act == 1) {
#pragma unroll
                        for (int j = 0; j < 4; ++j) { v0[j] = v0[j] * sigmoidf_(v0[j]); v1[j] = v1[j] * sigmoidf_(v1[j]); } }
                    else if (act >= 2) {
#pragma unroll
                        for (int j = 0; j < 4; ++j) { v0[j] = sigmoidf_(v0[j]); v1[j] = sigmoidf_(v1[j]); } }
                    u32x4 w; w.x = cvt_pk_bf16(v0[0], v0[1]); w.y = cvt_pk_bf16(v0[2], v0[3]); w.z = cvt_pk_bf16(v1[0], v1[1]); w.w = cvt_pk_bf16(v1[2], v1[3]);
                    *(u32x4*)(rowp + bj * HALF) = w; } }
    }
};
template <int MODE> struct EpiBranch {
    static constexpr bool PERM = true;
    const bf16* gate; const bf16* tin; bf16* out;
    __device__ __forceinline__ void operator()(const f32x4 (&acc)[2][2][4][2], const Unit& u, int wr, int wc, int fr, int fq) const {
        const int colt = u.pn * BM + wc * 32 + 8 * fq, row0 = u.pm * BM + wr * 64 + fr;
#pragma unroll
        for (int ai = 0; ai < 2; ++ai)
#pragma unroll
            for (int m = 0; m < 4; ++m) { const size_t ro = (size_t)(row0 + ai * HALF + m * 16) * D + colt;
#pragma unroll
                for (int bj = 0; bj < 2; ++bj) {
                    const u32x4 gq = *(const u32x4*)(gate + ro + bj * HALF);
                    u32x4 tq = (u32x4){0u, 0u, 0u, 0u}; if (MODE == 1) tq = *(const u32x4*)(tin + ro + bj * HALF);
                    float r[8];
#pragma unroll
                    for (int j = 0; j < 4; ++j) { r[j] = acc[ai][bj][m][0][j]; r[4 + j] = acc[ai][bj][m][1][j]; }
#pragma unroll
                    for (int j = 0; j < 4; ++j) { const unsigned gw = gq[j], tw = tq[j];
                        r[2 * j] = r[2 * j] * __uint_as_float(gw << 16) + __uint_as_float(tw << 16);
                        r[2 * j + 1] = r[2 * j + 1] * __uint_as_float(gw & 0xffff0000u) + __uint_as_float(tw & 0xffff0000u); }
                    u32x4 w; w.x = cvt_pk_bf16(r[0], r[1]); w.y = cvt_pk_bf16(r[2], r[3]); w.z = cvt_pk_bf16(r[4], r[5]); w.w = cvt_pk_bf16(r[6], r[7]);
                    *(u32x4*)(out + ro + bj * HALF) = w; } }
    }
};
struct EpiResid {
    static constexpr bool PERM = false;
    const float* x; float* out;
    __device__ __forceinline__ void operator()(const f32x4 (&acc)[2][2][4][2], const Unit& u, int wr, int wc, int fr, int fq) const {
        const int col0 = u.pn * BM + wc * 32 + 4 * fq, row0 = u.pm * BM + wr * 64 + fr;
#pragma unroll
        for (int ai = 0; ai < 2; ++ai)
#pragma unroll
            for (int m = 0; m < 4; ++m) { const size_t ro = (size_t)(row0 + ai * HALF + m * 16) * D + col0;
#pragma unroll
                for (int bj = 0; bj < 2; ++bj)
#pragma unroll
                    for (int n = 0; n < 2; ++n) { const f32x4 xv = *(const f32x4*)(x + ro + bj * HALF + n * 16); *(f32x4*)(out + ro + bj * HALF + n * 16) = xv + acc[ai][bj][m][n]; } }
    }
};
struct EpiSwiglu {
    static constexpr bool PERM = true;
    const float* bgate; const float* bup; bf16* hd;
    __device__ __forceinline__ void operator()(const f32x4 (&acc)[2][2][4][2], const Unit& u, int wr, int wc, int fr, int fq) const {
        const int col = u.pn * HALF + wc * 32 + 8 * fq; const size_t row0 = (size_t)u.pm * BM + wr * 64 + fr;
        const float* bg = bgate + (size_t)u.e * DFF + col; const float* bu = bup + (size_t)u.e * DFF + col;
        const f32x4 g0 = *(const f32x4*)bg, g1 = *(const f32x4*)(bg + 4), u0 = *(const f32x4*)bu, u1 = *(const f32x4*)(bu + 4);
#pragma unroll
        for (int ai = 0; ai < 2; ++ai)
#pragma unroll
            for (int m = 0; m < 4; ++m) {
                float r[8];
#pragma unroll
                for (int j = 0; j < 4; ++j) {
                    const float ga = fminf(acc[ai][0][m][0][j] + g0[j], 7.f), ua = fminf(fmaxf(acc[ai][1][m][0][j] + u0[j], -7.f), 7.f);
                    const float gb = fminf(acc[ai][0][m][1][j] + g1[j], 7.f), ub = fminf(fmaxf(acc[ai][1][m][1][j] + u1[j], -7.f), 7.f);
                    r[j] = (ua + 1.f) * (ga * sigmoidf_(1.702f * ga)); r[4 + j] = (ub + 1.f) * (gb * sigmoidf_(1.702f * gb)); }
                u32x4 w; w.x = cvt_pk_bf16(r[0], r[1]); w.y = cvt_pk_bf16(r[2], r[3]); w.z = cvt_pk_bf16(r[4], r[5]); w.w = cvt_pk_bf16(r[6], r[7]);
                *(u32x4*)(hd + (row0 + ai * HALF + m * 16) * DFF + col) = w; }
    }
};
struct EpiDown {
    static constexpr bool PERM = true;
    const float* bdown; const int* rpair; const float* rw; bf16* py;
    __device__ __forceinline__ void operator()(const f32x4 (&acc)[2][2][4][2], const Unit& u, int wr, int wc, int fr, int fq) const {
        const int colt = u.pn * BM + wc * 32 + 8 * fq; const size_t srow0 = (size_t)u.pm * BM + wr * 64 + fr;
        f32x4 bv[2][2];
#pragma unroll
        for (int bj = 0; bj < 2; ++bj)
#pragma unroll
            for (int n = 0; n < 2; ++n) bv[bj][n] = *(const f32x4*)(bdown + (size_t)u.e * D + colt + bj * HALF + 4 * n);
#pragma unroll
        for (int ai = 0; ai < 2; ++ai)
#pragma unroll
            for (int m = 0; m < 4; ++m) { const size_t srow = srow0 + ai * HALF + m * 16; const int pair = rpair[srow]; const float wgt = rw[srow];
                bf16* rowp = py + (size_t)pair * D + colt;
#pragma unroll
                for (int bj = 0; bj < 2; ++bj) { const f32x4 v0 = (acc[ai][bj][m][0] + bv[bj][0]) * wgt, v1 = (acc[ai][bj][m][1] + bv[bj][1]) * wgt;
                    u32x4 w; w.x = cvt_pk_bf16(v0[0], v0[1]); w.y = cvt_pk_bf16(v0[2], v0[3]); w.z = cvt_pk_bf16(v1[0], v1[1]); w.w = cvt_pk_bf16(v1[2], v1[3]);
                    *(u32x4*)(rowp + bj * HALF) = w; } }
    }
};

struct GlaSched {
    int mode, G, c; unsigned char* ws;
    __device__ __forceinline__ bool next(int i, Unit& u) const {
        const int L = i * G + c; const int nu = mode == 0 ? 128 : 256; if (L >= nu) return false;
        const int nh = mode == 0 ? L : (L >> 1), hv = mode == 0 ? 0 : (L & 1);
        u.pm = nh; u.pn = hv; u.e = 0; u.nrow = BM;
        if (mode == 0) { u.A = (const char*)(ws + WS_ACAT) + (size_t)nh * 256 * 512 * 2 + 512; u.B = (const char*)(ws + WS_KI) + (size_t)nh * 256 * 256 * 2; }
        else if (mode == 1) { u.A = (const char*)(ws + WS_BCAT) + (size_t)nh * 512 * 512 * 2 + (size_t)hv * 256 * 512 * 2; u.B = (const char*)(ws + WS_KET) + (size_t)nh * 256 * 256 * 2; }
        else { u.A = (const char*)(ws + WS_ACAT) + (size_t)nh * 256 * 512 * 2; u.B = (const char*)(ws + WS_BCAT) + (size_t)nh * 512 * 512 * 2 + (size_t)hv * 256 * 512 * 2; }
        return true;
    }
};
template <int MODE> struct EpiGla {
    static constexpr bool PERM = true;
    unsigned char* ws;
    __device__ __forceinline__ void operator()(const f32x4 (&acc)[2][2][4][2], const Unit& u, int wr, int wc, int fr, int fq) const {
        const int nh = u.pm, hv = u.pn; const int c8 = wc * 32 + 8 * fq, r0 = wr * 64 + fr;
        bf16* base; int ld;
        if (MODE == 0) { base = (bf16*)(ws + WS_ACAT) + (size_t)nh * 256 * 512; ld = 512; }
        else if (MODE == 1) { base = (bf16*)(ws + WS_UT) + (size_t)nh * 512 * 256 + (size_t)hv * 256 * 256; ld = 256; }
        else { base = (bf16*)(ws + WS_OB) + (size_t)(nh >> 2) * 256 * GLA_V + (nh & 3) * GLA_DV + hv * 256; ld = GLA_V; }
#pragma unroll
        for (int ai = 0; ai < 2; ++ai)
#pragma unroll
            for (int m = 0; m < 4; ++m) { const int row = r0 + ai * HALF + m * 16;
#pragma unroll
                for (int bj = 0; bj < 2; ++bj) { f32x4 v0 = acc[ai][bj][m][0], v1 = acc[ai][bj][m][1]; const int col = bj * HALF + c8;
                    if (MODE == 0) {
#pragma unroll
                        for (int j = 0; j < 4; ++j) { v0[j] = (col + j <= row) ? v0[j] : 0.f; v1[j] = (col + 4 + j <= row) ? v1[j] : 0.f; } }
                    u32x4 w; w.x = cvt_pk_bf16(v0[0], v0[1]); w.y = cvt_pk_bf16(v0[2], v0[3]); w.z = cvt_pk_bf16(v1[0], v1[1]); w.w = cvt_pk_bf16(v1[2], v1[3]);
                    *(u32x4*)(base + (size_t)row * ld + col) = w; } }
    }
};
}

constexpr int NWAVES = 8;
constexpr int RING_BYTES = 131072, MISC_OFF = RING_BYTES + 320, LDS_BYTES = 147456;
constexpr int TAB_OFF = MISC_OFF + 128;

struct Frame {
    LAS unsigned char* lds; volatile LAS unsigned* MISC; unsigned* ctl; unsigned char* ws;
    int tid, lane, wave, vcu, G;
};
struct Args { const float* in[22]; float* out; unsigned char* ws; int ph_lo, ph_hi, li, pad; };

__device__ __forceinline__ void p0_transpose_item(const float* W, int K, int ldn, bf16* WT, int d0, int s0, int k0, LAS float* scr, int lane) {
#pragma unroll 8
    for (int i = 0; i < 32; ++i) { const int kk = 2 * i + (lane >> 5); scr[kk * 33 + (lane & 31)] = __builtin_nontemporal_load(W + (size_t)(k0 + kk) * ldn + s0 + (lane & 31)); }
    LDS_WAIT(); asm volatile("" ::: "memory");
    const int c = lane & 7;
#pragma unroll
    for (int j = 0; j < 4; ++j) { const int n = (lane >> 3) + 8 * j; const LAS float* s = scr + (8 * c) * 33 + n;
        u32x4 o; o.x = pk2(s[0 * 33], s[1 * 33]); o.y = pk2(s[2 * 33], s[3 * 33]); o.z = pk2(s[4 * 33], s[5 * 33]); o.w = pk2(s[6 * 33], s[7 * 33]);
        __builtin_nontemporal_store(o, (GAS u32x4*)(WT + (size_t)(d0 + n) * K + k0 + 8 * c)); }
    LDS_WAIT(); asm volatile("" ::: "memory");
}

__device__ __forceinline__ void p0_prologue(Frame& F, const Args& a) {
    LAS float* scr = (LAS float*)(F.lds + F.wave * 16384);
    const int gw = F.vcu * NWAVES + F.wave, NGW = F.G * NWAVES, lane = F.lane;
    const float* w_in = a.in[2];
    constexpr int I_IN = 32 * (NPROJ / 32), I_BG = 32 * 64, I_BA = 16 * 64, I_OUT = 32 * 64, I_E = 32 * 64;
    constexpr int I_MOE = NE * I_E;
    constexpr int NITEMS = I_IN + I_BG + I_BA + I_OUT + 3 * I_MOE;
    for (int it = gw; it < NITEMS; it += NGW) {
        int r = it;
        if (r < I_IN) { const int nb = r % (NPROJ / 32), kb = r / (NPROJ / 32), d0 = nb * 32; p0_transpose_item(w_in, D, IN_COLS, (bf16*)(F.ws + WS_WIN), d0, d0 < C_GLR ? d0 : d0 + 16, kb * 64, scr, lane); continue; } r -= I_IN;
        if (r < I_BG) { const int nb = r % 64, kb = r / 64; p0_transpose_item(a.in[10], GLA_V, D, (bf16*)(F.ws + WS_WBG), nb * 32, nb * 32, kb * 64, scr, lane); continue; } r -= I_BG;
        if (r < I_BA) { const int nb = r % 64, kb = r / 64; p0_transpose_item(a.in[11], ATT_W, D, (bf16*)(F.ws + WS_WBA), nb * 32, nb * 32, kb * 64, scr, lane); continue; } r -= I_BA;
        if (r < I_OUT) { const int nb = r % 64, kb = r / 64; p0_transpose_item(a.in[12], D, D, (bf16*)(F.ws + WS_WOUT), nb * 32, nb * 32, kb * 64, scr, lane); continue; } r -= I_OUT;
        if (r < 2 * I_MOE) {
            const int which = r / I_MOE; r -= which * I_MOE; const int e = r / I_E; r -= e * I_E; const int nb = r % 64, kb = r / 64, n0 = nb * 32;
            const float* W = (which ? a.in[18] : a.in[16]) + (size_t)e * D * DFF;
            p0_transpose_item(W, D, DFF, (bf16*)(F.ws + WS_GU) + (size_t)e * 2 * DFF * D, (n0 >> 7) * 256 + (n0 & 127) + which * 128, n0, kb * 64, scr, lane); continue; }
        r -= 2 * I_MOE;
        { const int e = r / I_E; r -= e * I_E; const int nb = r % 64, kb = r / 64;
          p0_transpose_item(a.in[20] + (size_t)e * DFF * D, DFF, D, (bf16*)(F.ws + WS_DN) + (size_t)e * D * DFF, nb * 32, nb * 32, kb * 64, scr, lane); }
    }
    const float* x = a.in[0]; const float* g1 = a.in[1]; bf16* XN = (bf16*)(F.ws + WS_XN); float* GLR = (float*)(F.ws + WS_GLR);
    for (int m = gw; m < S; m += NGW) {
        const GAS f32x4* xr = (const GAS f32x4*)(x + (size_t)m * D) + lane;
        f32x4 v[8]; float s = 0.f;
#pragma unroll
        for (int j = 0; j < 8; ++j) { v[j] = xr[64 * j]; s += (v[j].x * v[j].x + v[j].y * v[j].y) + (v[j].z * v[j].z + v[j].w * v[j].w); }
        const float rstd = rsqrtf(wave_sum(s) * (1.f / D) + 1e-6f);
        GAS u32x2* o8 = (GAS u32x2*)(XN + (size_t)m * D) + lane;
        float gl[16];
#pragma unroll
        for (int r = 0; r < 16; ++r) gl[r] = 0.f;
#pragma unroll
        for (int j = 0; j < 8; ++j) { const f32x4 gg = *((const GAS f32x4*)g1 + lane + 64 * j); v[j] = v[j] * rstd * gg;
            u32x2 w; w.x = pk2(v[j].x, v[j].y); w.y = pk2(v[j].z, v[j].w); o8[64 * j] = w;
#pragma unroll
            for (int i = 0; i < 4; ++i) { const GAS f32x4* wp = (const GAS f32x4*)(w_in + (size_t)(256 * j + 4 * lane + i) * IN_COLS + C_GLR);
#pragma unroll
                for (int q = 0; q < 4; ++q) { const f32x4 wv = wp[q]; gl[4 * q] = fmaf(v[j][i], wv.x, gl[4 * q]); gl[4 * q + 1] = fmaf(v[j][i], wv.y, gl[4 * q + 1]); gl[4 * q + 2] = fmaf(v[j][i], wv.z, gl[4 * q + 2]); gl[4 * q + 3] = fmaf(v[j][i], wv.w, gl[4 * q + 3]); } } }
        float mine = 0.f;
#pragma unroll
        for (int r = 0; r < 16; ++r) { const float t = wave_sum(gl[r]); mine = (lane == r) ? t : mine; }
        if (lane < 16) GLR[(size_t)m * 16 + lane] = mine;
    }
    { const float* g2 = a.in[13]; const float* wr = a.in[14]; float* WR = (float*)(F.ws + WS_WR);
      for (int i = (F.vcu * NWAVES * 64) + F.tid; i < D * NE; i += F.G * NWAVES * 64) WR[i] = g2[i >> 5] * wr[i]; }
}

__device__ __forceinline__ void router_unit(Frame& F, const Args& a, int tile) {
    const int w = F.wave, lane = F.lane, tid = F.tid, i = lane & 31, kk = lane >> 5, t0 = tile * 32;
    const float* h1 = a.out; const float* g2 = a.in[13]; const float* WR = (const float*)(F.ws + WS_WR); const float* br = a.in[15];
    LAS float* part = (LAS float*)F.lds;
    LAS float* ssq = part + 8192;
    LAS float* lg = ssq + 256;
    LAS float* rs = lg + 32 * 33;
    f32x16 acc;
#pragma unroll
    for (int r = 0; r < 16; ++r) acc[r] = 0.f;
    float ss = 0.f;
    const float* arow = h1 + (size_t)(t0 + i) * D + 256 * w + 128 * kk;
    const float* bcol = WR + (size_t)(256 * w + 128 * kk) * NE + i;
#pragma unroll 1
    for (int c = 0; c < 4; ++c) {
        f32x4 av[8];
#pragma unroll
        for (int q = 0; q < 8; ++q) av[q] = *(const GAS f32x4*)(arow + 32 * c + 4 * q);
#pragma unroll
        for (int q = 0; q < 8; ++q)
#pragma unroll
            for (int j = 0; j < 4; ++j) { const float b = bcol[(size_t)(32 * c + 4 * q + j) * NE]; acc = __builtin_amdgcn_mfma_f32_32x32x2f32(av[q][j], b, acc, 0, 0, 0); ss = fmaf(av[q][j], av[q][j], ss); }
    }
    ss += __shfl_xor(ss, 32);
    if (kk == 0) ssq[w * 32 + i] = ss;
#pragma unroll
    for (int r = 0; r < 16; ++r) part[(w * 32 + (r & 3) + 8 * (r >> 2) + 4 * kk) * 32 + i] = acc[r];
    __syncthreads();
#pragma unroll
    for (int rep = 0; rep < 2; ++rep) { const int idx = tid + 512 * rep, tok = idx >> 5, e = idx & 31; float sum = 0.f, st = 0.f;
#pragma unroll
        for (int ww = 0; ww < 8; ++ww) { sum += part[(ww * 32 + tok) * 32 + e]; st += ssq[ww * 32 + tok]; }
        const float rstd = rsqrtf(st * (1.f / D) + 1e-6f);
        lg[tok * 33 + e] = sum * rstd + br[e]; if (e == 0) rs[tok] = rstd; }
    __syncthreads();
    bf16* HN = (bf16*)(F.ws + WS_HN); float* topw = (float*)(F.ws + WS_TOPW); int* tope = (int*)(F.ws + WS_TOPE); int* tops = (int*)(F.ws + WS_TOPS);
    unsigned* cnt = F.ctl + CW_CNT;
#pragma unroll 1
    for (int q = 0; q < 4; ++q) {
        const int tok = 4 * w + q, t = t0 + tok, e = lane & 31;
        const float rstd = rs[tok];
        {
            const GAS f32x4* x4 = (const GAS f32x4*)(h1 + (size_t)t * D) + lane; GAS u32x2* o8 = (GAS u32x2*)(HN + (size_t)t * D) + lane;
#pragma unroll
            for (int j = 0; j < 8; ++j) { const f32x4 gg = *((const GAS f32x4*)g2 + lane + 64 * j); const f32x4 y = x4[64 * j] * rstd * gg; u32x2 wv; wv.x = pk2(y.x, y.y); wv.y = pk2(y.z, y.w); o8[64 * j] = wv; }
        }
        float vals[4]; int idxs[4]; float cur = lg[tok * 33 + e];
#pragma unroll
        for (int r = 0; r < 4; ++r) {
            float bv = cur; int bi = e;
#pragma unroll
            for (int o = 1; o < 32; o <<= 1) { const float ov = __shfl_xor(bv, o); const int oi = __shfl_xor(bi, o); if (ov > bv || (ov == bv && oi < bi)) { bv = ov; bi = oi; } }
            vals[r] = bv; idxs[r] = bi;
            if (e == bi) cur = -3.0e38f;
        }
        float ex[4], sum = 0.f;
#pragma unroll
        for (int r = 0; r < 4; ++r) { ex[r] = __expf(vals[r] - vals[0]); sum += ex[r]; }
#pragma unroll
        for (int r = 0; r < 4; ++r) {
            if (lane == r) { const int ee = idxs[r]; const int slot = (int)atomicAdd(&cnt[ee], 1u);
                topw[t * 4 + r] = ex[r] / sum; tope[t * 4 + r] = ee; tops[t * 4 + r] = slot; }
        }
    }
    __syncthreads();
}
__device__ __forceinline__ void moe_table(Frame& F) {
    volatile LAS int* ts = (volatile LAS int*)(F.lds + TAB_OFF); volatile LAS int* cn = (volatile LAS int*)(F.lds + TAB_OFF + 256);
    __syncthreads();
    if (F.tid == 0) { int s = 0; for (int e = 0; e < NE; ++e) { const int c = (int)__hip_atomic_load(F.ctl + CW_CNT + e, __ATOMIC_RELAXED, __HIP_MEMORY_SCOPE_AGENT); cn[e] = c; ts[e] = s; s += (c + 255) >> 8; } ts[NE] = s; }
    __syncthreads();
}
__device__ __forceinline__ void p7_gather(Frame& F) {
    const int gw = F.vcu * NWAVES + F.wave, NGW = F.G * NWAVES, lane = F.lane;
    volatile LAS int* ts = (volatile LAS int*)(F.lds + TAB_OFF);
    const bf16* HN = (const bf16*)(F.ws + WS_HN); bf16* HNG = (bf16*)(F.ws + WS_HNG);
    const float* topw = (const float*)(F.ws + WS_TOPW); const int* tope = (const int*)(F.ws + WS_TOPE); const int* tops = (const int*)(F.ws + WS_TOPS);
    int* rpair = (int*)(F.ws + WS_RPAIR); float* rw = (float*)(F.ws + WS_RW);
    { volatile LAS int* cn = (volatile LAS int*)(F.lds + TAB_OFF + 256);
      for (int e = gw; e < NE; e += NGW) { const int c = cn[e], base = ts[e] * 256, padn = ((c + 255) & ~255) - c;
          for (int r = lane; r < padn; r += 64) { rpair[base + c + r] = S * 4; rw[base + c + r] = 0.f; } } }
    for (int t = gw; t < S; t += NGW) {
        const GAS u32x4* src = (const GAS u32x4*)(HN + (size_t)t * D) + lane; u32x4 v[4];
#pragma unroll
        for (int j = 0; j < 4; ++j) v[j] = src[64 * j];
#pragma unroll
        for (int r = 0; r < 4; ++r) { const int p = t * 4 + r; const int dst = ts[tope[p]] * 256 + tops[p];
            GAS u32x4* d = (GAS u32x4*)(HNG + (size_t)dst * D) + lane;
#pragma unroll
            for (int j = 0; j < 4; ++j) d[64 * j] = v[j];
            if (lane == 0) { rpair[dst] = p; rw[dst] = topw[p]; } }
    }
}
__device__ __forceinline__ void p10_combine(Frame& F, const Args& a) {
    const int gw = F.vcu * NWAVES + F.wave, NGW = F.G * NWAVES, lane = F.lane;
    const bf16* PY = (const bf16*)(F.ws + WS_PY); float* out = a.out;
    for (int t = gw; t < S; t += NGW) {
#pragma unroll
        for (int j = 0; j < 4; ++j) {
            float r[8]; { const f32x4 h0 = *(const GAS f32x4*)(out + (size_t)t * D + 512 * j + 8 * lane), h1v = *(const GAS f32x4*)(out + (size_t)t * D + 512 * j + 8 * lane + 4);
                r[0] = h0.x; r[1] = h0.y; r[2] = h0.z; r[3] = h0.w; r[4] = h1v.x; r[5] = h1v.y; r[6] = h1v.z; r[7] = h1v.w; }
#pragma unroll
            for (int k = 0; k < 4; ++k) { const u32x4 p = *(const GAS u32x4*)(PY + (size_t)(t * 4 + k) * D + 512 * j + 8 * lane);
#pragma unroll
                for (int q = 0; q < 4; ++q) { r[2 * q] += __uint_as_float(p[q] << 16); r[2 * q + 1] += __uint_as_float(p[q] & 0xffff0000u); } }
            *(GAS f32x4*)(out + (size_t)t * D + 512 * j + 8 * lane) = (f32x4){r[0], r[1], r[2], r[3]};
            *(GAS f32x4*)(out + (size_t)t * D + 512 * j + 8 * lane + 4) = (f32x4){r[4], r[5], r[6], r[7]};
        }
    }
}


constexpr float ATT_QSCALE = 0.08838834764831845f * 1.4426950408889634f;
__device__ __forceinline__ void attn_prep_unit(Frame& F, const Args& a, int n, int h) {
    const int wave = F.wave, lane = F.lane, tid = F.tid;
    LAS bf16* kst = (LAS bf16*)(F.lds);
    LAS bf16* vst = (LAS bf16*)(F.lds + 16384);
    const bf16* AQ = (const bf16*)(F.ws + WS_AQ); const bf16* AK = (const bf16*)(F.ws + WS_AK); const bf16* AV = (const bf16*)(F.ws + WS_AV);
    bf16* QH = (bf16*)(F.ws + WS_QH);
    const float* qg = a.in[6]; const float* kg = a.in[7];
    const float gq0 = qg[2 * lane], gq1 = qg[2 * lane + 1], gk0 = kg[2 * lane], gk1 = kg[2 * lane + 1];
#pragma unroll
    for (int i = 0; i < 8; ++i) {
        const int row = n * 64 + wave * 8 + i; const size_t off = (size_t)row * ATT_W + h * ATT_HD + 2 * lane;
        const unsigned qv = *(const unsigned*)(AQ + off), kv = *(const unsigned*)(AK + off), vv = *(const unsigned*)(AV + off);
        const float q0 = __uint_as_float(qv << 16), q1 = __uint_as_float(qv & 0xffff0000u), k0 = __uint_as_float(kv << 16), k1 = __uint_as_float(kv & 0xffff0000u);
        const float rq = rsqrtf(wave_sum(q0 * q0 + q1 * q1) * (1.f / 128.f) + 1e-6f) * ATT_QSCALE, rk = rsqrtf(wave_sum(k0 * k0 + k1 * k1) * (1.f / 128.f) + 1e-6f);
        *(unsigned*)(QH + off) = pk2(q0 * rq * gq0, q1 * rq * gq1);
        *(LAS unsigned*)(kst + (wave * 8 + i) * 128 + 2 * lane) = pk2(k0 * rk * gk0, k1 * rk * gk1);
        *(LAS unsigned*)(vst + (wave * 8 + i) * 128 + 2 * lane) = vv;
    }
    __syncthreads();
    bf16* KI = (bf16*)(F.ws + WS_KIMG) + (size_t)(n * ATT_H + h) * 8192; bf16* VI = (bf16*)(F.ws + WS_VIMG) + (size_t)(n * ATT_H + h) * 8192;
#pragma unroll
    for (int i = 0; i < 2; ++i) {
        const int g = tid + 512 * i;
        { const int c16 = g >> 6, key = g & 63; const u32x4 v = *(const LAS u32x4*)(kst + key * 128 + c16 * 8); *(u32x4*)(KI + (size_t)g * 8) = v; }
        { const int kg8 = g >> 7, d = g & 127; unsigned short e[8];
#pragma unroll
          for (int j = 0; j < 8; ++j) e[j] = vst[(kg8 * 8 + j) * 128 + d];
          u32x4 v; v.x = e[0] | ((unsigned)e[1] << 16); v.y = e[2] | ((unsigned)e[3] << 16); v.z = e[4] | ((unsigned)e[5] << 16); v.w = e[6] | ((unsigned)e[7] << 16);
          *(u32x4*)(VI + (size_t)g * 8) = v; }
    }
    __syncthreads();
}

__device__ __forceinline__ int crow(int r, int hi) { return (r & 3) + 8 * (r >> 2) + 4 * hi; }
__device__ __forceinline__ void attn_unit(Frame& F, const Args& a, int n4, int h) {
    const int w = F.wave, lane = F.lane, r32 = lane & 31, hi = lane >> 5, tid = F.tid;
    const int p = w >> 1, half = w & 1, c = 4 * n4 + p, qrow0 = c * 64 + 32 * half;
    LAS unsigned char* lds = F.lds;
    LAS float* btab = (LAS float*)(lds + 65536); LAS float* xch = (LAS float*)(lds + 67584 + 256 * w); LAS bf16* ost = (LAS bf16*)(lds + 8192 * w);
    const float* relb = a.in[8] + h * 257;
    if (tid < 257) btab[tid] = relb[tid] * 1.4426950408889634f;
    const bf16* QH = (const bf16*)(F.ws + WS_QH);
    bf16x8 qf[8];
#pragma unroll
    for (int d0 = 0; d0 < 8; ++d0) qf[d0] = *(const bf16x8*)(QH + (size_t)(qrow0 + r32) * ATT_W + h * ATT_HD + d0 * 16 + hi * 8);
    const char* KIMG = (const char*)(F.ws + WS_KIMG); const char* VIMG = (const char*)(F.ws + WS_VIMG);
    f32x16 o[4];
#pragma unroll
    for (int dt = 0; dt < 4; ++dt)
#pragma unroll
        for (int r = 0; r < 16; ++r) o[dt][r] = 0.f;
    float m = -1.0e30f, l = 0.f;
    const int s0 = (4 * n4 - 8 < 0) ? (8 - 4 * n4) : 0;
#define ATT_STAGE(s_) do { const int kc_ = 4 * n4 - 8 + (s_); const size_t gb_ = (size_t)(kc_ * ATT_H + h) * 16384; const unsigned lb_ = ((s_) & 1) * 32768; \
        _Pragma("unroll") for (int i_ = 0; i_ < 2; ++i_) { const int pc_ = w + 8 * i_; \
            __builtin_amdgcn_global_load_lds((const unsigned*)(KIMG + gb_ + pc_ * 1024 + lane * 16), (LAS unsigned*)(lds + lb_ + pc_ * 1024), 16, 0, 0); \
            __builtin_amdgcn_global_load_lds((const unsigned*)(VIMG + gb_ + pc_ * 1024 + lane * 16), (LAS unsigned*)(lds + lb_ + 16384 + pc_ * 1024), 16, 0, 0); } } while (0)
    ATT_STAGE(s0);
    for (int s = s0; s < 12; ++s) {
        asm volatile("s_waitcnt vmcnt(0) lgkmcnt(0)" ::: "memory");
        __builtin_amdgcn_s_barrier();
        if (s + 1 < 12) ATT_STAGE(s + 1);
        if (s >= p && s <= p + 8) {
            const LAS unsigned char* kb = lds + (s & 1) * 32768; const LAS unsigned char* vb = kb + 16384;
            f32x16 p0, p1;
#pragma unroll
            for (int r = 0; r < 16; ++r) { p0[r] = 0.f; p1[r] = 0.f; }
#pragma unroll
            for (int d0 = 0; d0 < 8; ++d0) {
                const bf16x8 k0 = *(const LAS bf16x8*)(kb + (2 * d0 + hi) * 1024 + r32 * 16), k1 = *(const LAS bf16x8*)(kb + (2 * d0 + hi) * 1024 + (r32 + 32) * 16);
                p0 = __builtin_amdgcn_mfma_f32_32x32x16_bf16(k0, qf[d0], p0, 0, 0, 0);
                p1 = __builtin_amdgcn_mfma_f32_32x32x16_bf16(k1, qf[d0], p1, 0, 0, 0);
                if (d0 & 1) __builtin_amdgcn_sched_barrier(0);
            }
            const int wrel = p + 8 - s;
            if (wrel >= 3) { const float bc = btab[256];
#pragma unroll
                for (int r = 0; r < 16; ++r) { p0[r] += bc; p1[r] += bc; } }
            else { const int base = 64 * wrel + 32 * half + r32 + 128;
#pragma unroll
                for (int r = 0; r < 16; ++r) { int i0 = base - crow(r, hi), i1 = i0 - 32; i0 = i0 > 256 ? 256 : i0; i1 = i1 > 256 ? 256 : i1; i1 = i1 < 0 ? 0 : i1; i0 = i0 < 0 ? 0 : i0; p0[r] += btab[i0]; p1[r] += btab[i1]; } }
            float mx = p0[0];
#pragma unroll
            for (int r = 1; r < 16; ++r) mx = fmaxf(mx, p0[r]);
#pragma unroll
            for (int r = 0; r < 16; ++r) mx = fmaxf(mx, p1[r]);
            mx = fmaxf(mx, __shfl_xor(mx, 32));
            const float mn = fmaxf(m, mx), alpha = __builtin_amdgcn_exp2f(m - mn);
            float ps = 0.f;
#pragma unroll
            for (int r = 0; r < 16; ++r) { p0[r] = __builtin_amdgcn_exp2f(p0[r] - mn); p1[r] = __builtin_amdgcn_exp2f(p1[r] - mn); ps += p0[r] + p1[r]; }
            l = l * alpha + ps;
            if (__any(mn > m)) {
                if (hi == 0) xch[r32] = alpha;
                asm volatile("s_waitcnt lgkmcnt(0)" ::: "memory");
#pragma unroll
                for (int g = 0; g < 4; ++g) { const f32x4 av = *(const LAS f32x4*)(xch + 8 * g + 4 * hi);
#pragma unroll
                    for (int dt = 0; dt < 4; ++dt) { o[dt][4 * g] *= av[0]; o[dt][4 * g + 1] *= av[1]; o[dt][4 * g + 2] *= av[2]; o[dt][4 * g + 3] *= av[3]; } }
            }
            m = mn;
            bf16x8 pa[4];
#pragma unroll
            for (int ks = 0; ks < 4; ++ks) { const f32x16& src = (ks < 2) ? p0 : p1; const int b = (ks & 1) * 8; u32x4 t;
                t.x = cvt_pk_bf16(src[b], src[b + 1]); t.y = cvt_pk_bf16(src[b + 2], src[b + 3]); t.z = cvt_pk_bf16(src[b + 4], src[b + 5]); t.w = cvt_pk_bf16(src[b + 6], src[b + 7]);
                pa[ks] = __builtin_bit_cast(bf16x8, t); }
#pragma unroll
            for (int dt = 0; dt < 4; ++dt)
#pragma unroll
                for (int ks = 0; ks < 4; ++ks) {
                    const LAS unsigned char* vp = vb + (2 * ks) * 2048 + (32 * dt + r32) * 16 + 8 * hi;
                    const u32x2 lo = *(const LAS u32x2*)vp, hh = *(const LAS u32x2*)(vp + 2048);
                    const u32x4 bq = (u32x4){lo.x, lo.y, hh.x, hh.y};
                    o[dt] = __builtin_amdgcn_mfma_f32_32x32x16_bf16(pa[ks], __builtin_bit_cast(bf16x8, bq), o[dt], 0, 0, 0);
                    if (ks == 3) __builtin_amdgcn_sched_barrier(0);
                }
        }
    }
#undef ATT_STAGE
    asm volatile("s_waitcnt lgkmcnt(0)" ::: "memory");
    __builtin_amdgcn_s_barrier();
    l += __shfl_xor(l, 32);
    if (hi == 0) xch[32 + r32] = 1.f / l;
    asm volatile("s_waitcnt lgkmcnt(0)" ::: "memory");
#pragma unroll
    for (int g = 0; g < 4; ++g) { const f32x4 iv = *(const LAS f32x4*)(xch + 32 + 8 * g + 4 * hi);
#pragma unroll
        for (int dt = 0; dt < 4; ++dt)
#pragma unroll
            for (int j = 0; j < 4; ++j) ost[(8 * g + 4 * hi + j) * 128 + 32 * dt + r32] = (bf16)f2bf(o[dt][4 * g + j] * iv[j]); }
    asm volatile("s_waitcnt lgkmcnt(0)" ::: "memory");
    bf16* YA = (bf16*)(F.ws + WS_YA);
#pragma unroll
    for (int i = 0; i < 8; ++i) { const int g = i * 64 + lane, row = g >> 4, c16 = g & 15; const u32x4 v = *(const LAS u32x4*)(ost + row * 128 + c16 * 8);
        *(u32x4*)(YA + (size_t)(qrow0 + row) * ATT_W + h * ATT_HD + c16 * 8) = v; }
    asm volatile("s_waitcnt vmcnt(0) lgkmcnt(0)" ::: "memory");
    __builtin_amdgcn_s_barrier();
}


__device__ __forceinline__ void gla_prep_unit(Frame& F, const Args& a, int n, int cg) {
    const int tid = F.tid, cq = tid & 15, seg = tid >> 4;
    const int h = cg >> 2, dk0 = (cg & 3) * 64 + 4 * cq, col0 = h * GLA_DK + dk0, nh = n * GLA_H + h;
    const float* wgu = a.in[3]; const float* bgt = a.in[4]; const float* GLR = (const float*)(F.ws + WS_GLR);
    const bf16* GQ = (const bf16*)(F.ws + WS_GQ); const bf16* GK = (const bf16*)(F.ws + WS_GK);
    LAS float* tot = (LAS float*)F.lds;
    f32x4 w[16];
#pragma unroll
    for (int r = 0; r < 16; ++r) w[r] = *(const f32x4*)(wgu + r * GLA_QK + col0);
    const f32x4 bgv = *(const f32x4*)(bgt + col0);
    f32x4 cs[8]; f32x4 run = (f32x4){0.f, 0.f, 0.f, 0.f};
    const int t0 = n * 256 + seg * 8;
#pragma unroll
    for (int i = 0; i < 8; ++i) {
        const f32x4* gp = (const f32x4*)(GLR + (size_t)(t0 + i) * 16); f32x4 z = bgv;
#pragma unroll
        for (int q = 0; q < 4; ++q) { const f32x4 gv = gp[q]; z += w[4 * q] * gv.x; z += w[4 * q + 1] * gv.y; z += w[4 * q + 2] * gv.z; z += w[4 * q + 3] * gv.w; }
#pragma unroll
        for (int j = 0; j < 4; ++j) run[j] += log_sigmoid(z[j]) * (1.f / 16.f);
        cs[i] = run;
    }
    *(LAS f32x4*)(tot + seg * 64 + 4 * cq) = run;
    __syncthreads();
    f32x4 off = (f32x4){0.f, 0.f, 0.f, 0.f}, total = (f32x4){0.f, 0.f, 0.f, 0.f};
    for (int sg = 0; sg < 32; ++sg) { const f32x4 tv = *(const LAS f32x4*)(tot + sg * 64 + 4 * cq); total += tv; if (sg < seg) off += tv; }
    unsigned kew[4][4];
    bf16* ACAT = (bf16*)(F.ws + WS_ACAT); bf16* KI = (bf16*)(F.ws + WS_KI); bf16* KET = (bf16*)(F.ws + WS_KET);
    float kprev[4];
#pragma unroll
    for (int i = 0; i < 8; ++i) {
        const size_t trow = (size_t)(t0 + i);
        const u32x2 qv = *(const u32x2*)(GQ + trow * GLA_QK + col0), kv = *(const u32x2*)(GK + trow * GLA_QK + col0);
        float q[4] = {__uint_as_float(qv.x << 16), __uint_as_float(qv.x & 0xffff0000u), __uint_as_float(qv.y << 16), __uint_as_float(qv.y & 0xffff0000u)};
        float k[4] = {__uint_as_float(kv.x << 16), __uint_as_float(kv.x & 0xffff0000u), __uint_as_float(kv.y << 16), __uint_as_float(kv.y & 0xffff0000u)};
        float qd[4], ki[4], ke[4];
#pragma unroll
        for (int j = 0; j < 4; ++j) { const float bc = cs[i][j] + off[j]; qd[j] = q[j] * 0.0625f * __expf(bc); ki[j] = k[j] * __expf(-bc); ke[j] = k[j] * __expf(total[j] - bc); }
        const size_t lrow = (size_t)nh * 256 + seg * 8 + i;
        u32x2 o; o.x = pk2(qd[0], qd[1]); o.y = pk2(qd[2], qd[3]); *(u32x2*)(ACAT + lrow * 512 + 256 + dk0) = o;
        o.x = pk2(ki[0], ki[1]); o.y = pk2(ki[2], ki[3]); *(u32x2*)(KI + lrow * 256 + dk0) = o;
        if (i & 1) {
#pragma unroll
            for (int j = 0; j < 4; ++j) kew[j][i >> 1] = pk2(kprev[j], ke[j]); }
        else {
#pragma unroll
            for (int j = 0; j < 4; ++j) kprev[j] = ke[j]; }
    }
#pragma unroll
    for (int j = 0; j < 4; ++j) *(u32x4*)(KET + ((size_t)nh * 256 + dk0 + j) * 256 + seg * 8) = (u32x4){kew[j][0], kew[j][1], kew[j][2], kew[j][3]};
    if (seg == 0) *(f32x4*)((float*)(F.ws + WS_DEC) + n * GLA_QK + col0) = (f32x4){__expf(total[0]), __expf(total[1]), __expf(total[2]), __expf(total[3])};
    __syncthreads();
}
__device__ __forceinline__ void gla_vt_unit(Frame& F, int n, int h, int g8) {
    const int tid = F.tid; const int nh = n * GLA_H + h;
    LAS bf16* tile = (LAS bf16*)F.lds;
    const bf16* GV = (const bf16*)(F.ws + WS_GV); bf16* BCAT = (bf16*)(F.ws + WS_BCAT);
#pragma unroll
    for (int ps = 0; ps < 4; ++ps) { const int row = (tid >> 3) + 64 * ps, ch = tid & 7;
        const u32x4 v = *(const u32x4*)(GV + (size_t)(n * 256 + row) * GLA_V + h * GLA_DV + g8 * 64 + ch * 8);
        *(LAS u32x2*)(tile + row * 72 + ch * 8) = (u32x2){v.x, v.y}; *(LAS u32x2*)(tile + row * 72 + ch * 8 + 4) = (u32x2){v.z, v.w}; }
    __syncthreads();
#pragma unroll
    for (int i = 0; i < 4; ++i) { const int g = tid + 512 * i, c = g & 63, tg = g >> 6; unsigned short e[8];
#pragma unroll
        for (int j = 0; j < 8; ++j) e[j] = tile[(tg * 8 + j) * 72 + c];
        u32x4 v; v.x = e[0] | ((unsigned)e[1] << 16); v.y = e[2] | ((unsigned)e[3] << 16); v.z = e[4] | ((unsigned)e[5] << 16); v.w = e[6] | ((unsigned)e[7] << 16);
        *(u32x4*)(BCAT + ((size_t)nh * 512 + g8 * 64 + c) * 512 + tg * 8) = v; }
    __syncthreads();
}
__device__ __forceinline__ void gla_scan(Frame& F) {
    const bf16* UT = (const bf16*)(F.ws + WS_UT); bf16* BCAT = (bf16*)(F.ws + WS_BCAT); const float* DEC = (const float*)(F.ws + WS_DEC);
    for (int idx = F.vcu * (NWAVES * 64) + F.tid; idx < GLA_H * GLA_DV * 64; idx += F.G * NWAVES * 64) {
        const int dk4 = (idx & 63) * 4, dv = (idx >> 6) & 511, h = idx >> 15;
        float s[4] = {0.f, 0.f, 0.f, 0.f};
#pragma unroll 8
        for (int n = 0; n < 32; ++n) {
            const size_t nh = (size_t)n * GLA_H + h;
            u32x2 o; o.x = pk2(s[0], s[1]); o.y = pk2(s[2], s[3]); *(u32x2*)(BCAT + (nh * 512 + dv) * 512 + 256 + dk4) = o;
            const u32x2 uv = *(const u32x2*)(UT + (nh * 512 + dv) * 256 + dk4); const f32x4 dc = *(const f32x4*)(DEC + n * GLA_QK + h * GLA_DK + dk4);
            s[0] = s[0] * dc.x + __uint_as_float(uv.x << 16); s[1] = s[1] * dc.y + __uint_as_float(uv.x & 0xffff0000u);
            s[2] = s[2] * dc.z + __uint_as_float(uv.y << 16); s[3] = s[3] * dc.w + __uint_as_float(uv.y & 0xffff0000u);
        }
    }
}
__device__ __forceinline__ void gla_norm(Frame& F, const Args& a) {
    const int gw = F.vcu * NWAVES + F.wave, NGW = F.G * NWAVES, lane = F.lane;
    const bf16* OB = (const bf16*)(F.ws + WS_OB); const bf16* GR = (const bf16*)(F.ws + WS_GR); bf16* YG = (bf16*)(F.ws + WS_YG); const float* g = a.in[5];
    const f32x4 g0 = *(const f32x4*)(g + 8 * lane), g1 = *(const f32x4*)(g + 8 * lane + 4);
    for (int wi = gw; wi < S * GLA_H; wi += NGW) {
        const size_t off = (size_t)(wi >> 2) * GLA_V + (wi & 3) * GLA_DV + 8 * lane;
        const u32x4 ov = *(const u32x4*)(OB + off), rv = *(const u32x4*)(GR + off);
        float o[8], r[8]; float ss = 0.f;
#pragma unroll
        for (int j = 0; j < 4; ++j) { o[2 * j] = __uint_as_float(ov[j] << 16); o[2 * j + 1] = __uint_as_float(ov[j] & 0xffff0000u); r[2 * j] = __uint_as_float(rv[j] << 16); r[2 * j + 1] = __uint_as_float(rv[j] & 0xffff0000u); }
#pragma unroll
        for (int j = 0; j < 8; ++j) ss += o[j] * o[j];
        const float rstd = rsqrtf(wave_sum(ss) * (1.f / GLA_DV) + 1e-6f);
        u32x4 w; w.x = pk2(o[0] * rstd * g0.x * r[0], o[1] * rstd * g0.y * r[1]); w.y = pk2(o[2] * rstd * g0.z * r[2], o[3] * rstd * g0.w * r[3]);
        w.z = pk2(o[4] * rstd * g1.x * r[4], o[5] * rstd * g1.y * r[5]); w.w = pk2(o[6] * rstd * g1.z * r[6], o[7] * rstd * g1.w * r[7]);
        *(u32x4*)(YG + off) = w;
    }
}

__global__ void __launch_bounds__(NWAVES * 64, 2) fwd(Args args) {
    extern __shared__ __attribute__((aligned(16))) unsigned char lds_raw[];
    Frame F;
    F.lds = (LAS unsigned char*)lds_raw; F.MISC = (volatile LAS unsigned*)(F.lds + MISC_OFF);
    F.tid = threadIdx.x; F.lane = F.tid & 63; F.wave = __builtin_amdgcn_readfirstlane(F.tid >> 6);
    F.G = gridDim.x; { const int bx = blockIdx.x; F.vcu = (F.G % 8 == 0) ? (bx % 8) * (F.G / 8) + bx / 8 : bx; }
    F.ws = args.ws; F.ctl = (unsigned*)(args.ws + WS_CTL);
    for (int u = F.tid; u < (LDS_BYTES - RING_BYTES) / 4; u += NWAVES * 64) ((LAS unsigned*)(F.lds + RING_BYTES))[u] = 0u;
    __syncthreads();
    XcdBarrier bar = xcd_barrier_post(F.ctl + CW_BAR + args.li * XCD_BAR_WORDS, F.MISC + 8);
    const int lo = args.ph_lo, hi = args.ph_hi;
#define IN(k) (lo <= (k) && (k) < hi)
#define SEAM(k) do { if (IN(k) && IN((k) + 1)) xcd_barrier(bar); } while (0)
    unsigned char* ws = args.ws;
#ifndef DUP_MASK
#define DUP_MASK 0
#endif
#define DUP(k) ((DUP_MASK >> (k)) & 1)
#define PHASE(k, ...) do { if (IN(k)) { __VA_ARGS__ if (DUP(k)) { xcd_barrier(bar); __VA_ARGS__ } } SEAM(k); } while (0)
    PHASE(0, { p0_prologue(F, args); });
    PHASE(1, { pg8::DenseSched Sc; Sc.init(ws + WS_XN, ws + WS_WIN, S, NPROJ, D, F.G, (int)blockIdx.x); pg8::EpiProj E{ws, args.in[9]};
        pg8::gemm_phase<pg8::EpiProj, pg8::DenseSched>(F.lds, D, D, D, Sc, E); });
    PHASE(2, { for (int u = F.vcu; u < NCH * ATT_H; u += F.G) attn_prep_unit(F, args, u >> 3, u & 7);
        for (int u = F.vcu; u < 32 * 16; u += F.G) gla_prep_unit(F, args, u >> 4, u & 15);
        for (int u = F.vcu; u < 32 * GLA_H * 8; u += F.G) gla_vt_unit(F, u >> 5, (u >> 3) & 3, u & 7); });
    PHASE(3, { for (int u = F.vcu; u < (NCH / 4) * ATT_H; u += F.G) attn_unit(F, args, u >> 3, u & 7);
        { pg8::GlaSched Sc{0, F.G, F.G - 1 - (int)blockIdx.x, ws}; pg8::EpiGla<0> E{ws}; pg8::gemm_phase<pg8::EpiGla<0>, pg8::GlaSched>(F.lds, 256, 512, 256, Sc, E); }
        { pg8::GlaSched Sc{1, F.G, (int)blockIdx.x, ws}; pg8::EpiGla<1> E{ws}; pg8::gemm_phase<pg8::EpiGla<1>, pg8::GlaSched>(F.lds, 256, 512, 256, Sc, E); } });
    PHASE(4, { gla_scan(F); });
    PHASE(5, { pg8::GlaSched Sc{2, F.G, (int)blockIdx.x, ws}; pg8::EpiGla<2> E{ws}; pg8::gemm_phase<pg8::EpiGla<2>, pg8::GlaSched>(F.lds, 512, 512, 512, Sc, E); });
    PHASE(6, { gla_norm(F, args); });
    PHASE(7, { pg8::DenseSched Sc; Sc.init(ws + WS_YG, ws + WS_WBG, S, D, GLA_V, F.G, (int)blockIdx.x); pg8::EpiBranch<0> E{(const bf16*)(ws + WS_SG), nullptr, (bf16*)(ws + WS_T)};
        pg8::gemm_phase<pg8::EpiBranch<0>, pg8::DenseSched>(F.lds, GLA_V, GLA_V, GLA_V, Sc, E); });
    PHASE(8, { pg8::DenseSched Sc; Sc.init(ws + WS_YA, ws + WS_WBA, S, D, ATT_W, F.G, (int)blockIdx.x); pg8::EpiBranch<1> E{(const bf16*)(ws + WS_SA), (const bf16*)(ws + WS_T), (bf16*)(ws + WS_MG)};
        pg8::gemm_phase<pg8::EpiBranch<1>, pg8::DenseSched>(F.lds, ATT_W, ATT_W, ATT_W, Sc, E); });
    PHASE(9, { pg8::DenseSched Sc; Sc.init(ws + WS_MG, ws + WS_WOUT, S, D, D, F.G, (int)blockIdx.x); pg8::EpiResid E{args.in[0], args.out};
        pg8::gemm_phase<pg8::EpiResid, pg8::DenseSched>(F.lds, D, D, D, Sc, E); });
    PHASE(10, { for (int u = F.vcu; u < S / 32; u += F.G) router_unit(F, args, u); });
    PHASE(11, { moe_table(F); p7_gather(F); });
    PHASE(12, { moe_table(F); pg8::MoeSched Sc; Sc.init(ws + WS_HNG, ws + WS_GU, (volatile LAS int*)(F.lds + TAB_OFF), (volatile LAS int*)(F.lds + TAB_OFF + 256), 16, D, F.G, (int)blockIdx.x);
        pg8::EpiSwiglu E{args.in[17], args.in[19], (bf16*)(ws + WS_HD)};
        pg8::gemm_phase<pg8::EpiSwiglu, pg8::MoeSched>(F.lds, D, D, D, Sc, E); });
    PHASE(13, { moe_table(F); pg8::MoeSched Sc; Sc.init(ws + WS_HD, ws + WS_DN, (volatile LAS int*)(F.lds + TAB_OFF), (volatile LAS int*)(F.lds + TAB_OFF + 256), 8, DFF, F.G, (int)blockIdx.x);
        pg8::EpiDown E{args.in[21], (const int*)(ws + WS_RPAIR), (const float*)(ws + WS_RW), (bf16*)(ws + WS_PY)};
        pg8::gemm_phase<pg8::EpiDown, pg8::MoeSched>(F.lds, DFF, DFF, DFF, Sc, E); });
    PHASE(14, { p10_combine(F, args); });
#undef PHASE
#undef IN
#undef SEAM
}

extern "C" void kernel_launch(void* const* d_in, const int* in_sizes, int n_in, void* d_out, int out_size, void* d_ws, size_t ws_size, hipStream_t stream) {
    static int grid = 0;
    if (grid == 0) {
        if (n_in != 22 || out_size != S * D || ws_size < WS_END) { fprintf(stderr, "kernel_launch: unexpected problem (n_in %d out %d ws %zu)\n", n_in, out_size, ws_size); grid = -1; return; }
        int dev = 0, cus = 0, per_cu = 0;
        if (hipGetDevice(&dev) != hipSuccess || hipDeviceGetAttribute(&cus, hipDeviceAttributeMultiprocessorCount, dev) != hipSuccess) { grid = -1; return; }
        if (hipFuncSetAttribute((const void*)fwd, hipFuncAttributeMaxDynamicSharedMemorySize, LDS_BYTES) != hipSuccess) { fprintf(stderr, "kernel_launch: hipFuncSetAttribute failed\n"); grid = -1; return; }
        if (hipOccupancyMaxActiveBlocksPerMultiprocessor(&per_cu, (const void*)fwd, NWAVES * 64, LDS_BYTES) != hipSuccess || per_cu < 1) fprintf(stderr, "kernel_launch: occupancy query says %d\n", per_cu);
        (void)hipGetLastError();
        grid = cus;
    }
    if (grid < 0) return;
    (void)hipMemsetAsync((char*)d_ws + WS_CTL, 0, CTL_ZERO_BYTES, stream);
    Args a{};
    for (int i = 0; i < 22; ++i) a.in[i] = (const float*)d_in[i];
    a.out = (float*)d_out; a.ws = (unsigned char*)d_ws;
    a.ph_lo = 0; a.ph_hi = 15; a.li = 0;
    hipLaunchKernelGGL(fwd, dim3(grid), dim3(NWAVES * 64), LDS_BYTES, stream, a);
}
```

```cpp
#include <hip/hip_runtime.h>
#include <stdint.h>
#include <cstdio>

constexpr int S = 8192, D = 2048;
constexpr int GLA_H = 4, GLA_DK = 256, GLA_DV = 512, GLA_QK = 1024, GLA_V = 2048;
constexpr int ATT_H = 8, ATT_HD = 128, ATT_W = 1024, NCH = S / 64;
constexpr int NE = 32, DFF = 2048;
constexpr int IN_COLS = 13328, C_GLR = 6144;
constexpr int NPROJ = 13312;
constexpr int MAXROWS = 32768 + NE * 256;

constexpr size_t MiB = 1u << 20;
constexpr size_t WS_CTL = 0, CTL_ZERO_BYTES = 1 * MiB;
constexpr size_t WS_TOPW = 1 * MiB, WS_TOPE = WS_TOPW + 128 * 1024, WS_TOPS = WS_TOPE + 128 * 1024, WS_RPAIR = WS_TOPS + 128 * 1024, WS_RW = WS_RPAIR + 256 * 1024;
constexpr size_t WS_GLR = 2 * MiB, WS_WR = 3 * MiB;
constexpr size_t WS_WIN = 8 * MiB, WS_WBG = 60 * MiB, WS_WBA = 68 * MiB, WS_WOUT = 72 * MiB, WS_GU = 80 * MiB, WS_DN = 592 * MiB;
constexpr size_t WS_XN = 848 * MiB, WS_GQ = 880 * MiB, WS_GK = 896 * MiB, WS_GV = 912 * MiB, WS_GR = 944 * MiB, WS_AQ = 976 * MiB, WS_AK = 992 * MiB, WS_AV = 1008 * MiB;
constexpr size_t WS_SG = 1024 * MiB, WS_SA = 1056 * MiB, WS_YG = 1088 * MiB, WS_YA = 1120 * MiB, WS_T = 1136 * MiB, WS_MG = 1168 * MiB, WS_HN = 1200 * MiB;
constexpr size_t WS_HNG = 1232 * MiB, WS_HD = 1392 * MiB, WS_PY = 1552 * MiB, WS_QH = 1681 * MiB, WS_KIMG = 1697 * MiB, WS_VIMG = 1713 * MiB;
constexpr size_t WS_ACAT = 1729 * MiB, WS_BCAT = 1761 * MiB, WS_KI = 1825 * MiB, WS_KET = 1841 * MiB, WS_UT = 1857 * MiB, WS_DEC = 1889 * MiB, WS_OB = 1890 * MiB, WS_END = 1922 * MiB;
constexpr int CW_CNT = 64;
constexpr int CW_BAR = 4096;

typedef unsigned short bf16;
typedef short bf16x8 __attribute__((ext_vector_type(8)));
typedef float f32x4 __attribute__((ext_vector_type(4)));
typedef float f32x16 __attribute__((ext_vector_type(16)));
typedef unsigned u32x4 __attribute__((ext_vector_type(4)));
typedef unsigned u32x2 __attribute__((ext_vector_type(2)));
#define LAS __attribute__((address_space(3)))
#define GAS __attribute__((address_space(1)))
__device__ __forceinline__ float bf2f(bf16 v) { return __uint_as_float((unsigned)v << 16); }
__device__ __forceinline__ unsigned f2bf(float f) { unsigned u = __float_as_uint(f); return (u + 0x7fffu + ((u >> 16) & 1u)) >> 16; }
__device__ __forceinline__ unsigned pk2(float lo, float hi) { return f2bf(lo) | (f2bf(hi) << 16); }
__device__ __forceinline__ unsigned cvt_pk_bf16(float lo, float hi) { unsigned r; asm volatile("v_cvt_pk_bf16_f32 %0, %1, %2" : "=v"(r) : "v"(lo), "v"(hi)); return r; }
__device__ __forceinline__ float wave_sum(float v) {
#pragma unroll
    for (int o = 1; o < 64; o <<= 1) v += __shfl_xor(v, o);
    return v;
}
__device__ __forceinline__ float sigmoidf_(float x) { return 1.f / (1.f + __expf(-x)); }
__device__ __forceinline__ float log_sigmoid(float z) { return fminf(z, 0.f) - log1pf(__expf(-fabsf(z))); }
#define LDS_WAIT() asm volatile("s_waitcnt lgkmcnt(0)" ::: "memory")
#define VM_WAIT() asm volatile("s_waitcnt vmcnt(0)" ::: "memory")

#define XB_TMO      128
#define XB_XCNT(j)  (256  + 64 * (j))
#define XB_XSUB(j)  (1280 + 64 * (j))
#define XB_XGEN(j)  (2304 + 64 * (j))
#define XB_TOP      3328
#define XB_TOPGEN   3392
#define XCD_BAR_WORDS 3456
#define XB_SPIN_CAP (1u << 18)
__device__ __forceinline__ unsigned xb_ld(unsigned* p)              { return __hip_atomic_load(p, __ATOMIC_RELAXED, __HIP_MEMORY_SCOPE_AGENT); }
__device__ __forceinline__ unsigned xb_add(unsigned* p, unsigned v) { return __hip_atomic_fetch_add(p, v, __ATOMIC_RELAXED, __HIP_MEMORY_SCOPE_AGENT); }
__device__ __forceinline__ unsigned xb_xcc_id() { return (unsigned)__builtin_amdgcn_s_getreg((3 << 11) | 20) & 0xFu; }
#define XB_SPIN(cond, bar) do { unsigned _sp = 0; while (cond) { __builtin_amdgcn_s_sleep(1); \
    if ((++_sp & 255u) == 0u) { if (xb_ld(&(bar)[XB_TMO])) break; if (_sp > XB_SPIN_CAP) { atomicAdd(&(bar)[XB_TMO], 1u); break; } } } } while (0)
struct XcdBarrier { unsigned* bar; unsigned x; volatile LAS unsigned* st; };
__device__ __forceinline__ XcdBarrier xcd_barrier_post(unsigned* bar, volatile LAS unsigned* st) {
    XcdBarrier b; b.bar = bar; b.x = xb_xcc_id(); b.st = st;
    if (threadIdx.x == 0) (void)xb_add(&bar[XB_XCNT(b.x)], 1u);
    return b;
}
__device__ __forceinline__ void xcd_barrier_complete(unsigned* bar, unsigned x, unsigned& nloc, unsigned& nx) {
    const unsigned G = gridDim.x * gridDim.y * gridDim.z;
    unsigned sum, cnt, mine, sp = 0u;
    for (;;) {
        sum = 0u; cnt = 0u; mine = 0u;
#pragma unroll
        for (unsigned j = 0; j < 16; ++j) { const unsigned c = xb_ld(&bar[XB_XCNT(j)]); sum += c; cnt += (c > 0u) ? 1u : 0u; mine = (j == x) ? c : mine; }
        if (sum == G) break;
        __builtin_amdgcn_s_sleep(1);
        if ((++sp & 255u) == 0u) { if (xb_ld(&bar[XB_TMO])) break; if (sp > XB_SPIN_CAP) { atomicAdd(&bar[XB_TMO], 1u); break; } }
    }
    nloc = mine > 0u ? mine : 1u; nx = cnt > 0u ? cnt : 1u;
}
__device__ __forceinline__ void xcd_barrier(const XcdBarrier& b) {
    asm volatile("s_waitcnt vmcnt(0)" ::: "memory");
    __syncthreads();
    if (threadIdx.x == 0) {
        unsigned* bar = b.bar;
        __builtin_amdgcn_s_waitcnt(0);
        unsigned nloc = b.st[0], nx = b.st[1];
        if (nloc == 0u) { xcd_barrier_complete(bar, b.x, nloc, nx); b.st[0] = nloc; b.st[1] = nx; }
        const unsigned old = xb_add(&bar[XB_XSUB(b.x)], 1u);
        const unsigned gen = old / nloc;
        if (old + 1u == (gen + 1u) * nloc) {
            __builtin_amdgcn_fence(__ATOMIC_RELEASE, "agent");
            asm volatile("s_waitcnt vmcnt(0)" ::: "memory");
            const unsigned og = xb_add(&bar[XB_TOP], 1u);
            const unsigned tg = og / nx;
            if (og + 1u == (tg + 1u) * nx) xb_add(&bar[XB_TOPGEN], 1u);
            else XB_SPIN(xb_ld(&bar[XB_TOPGEN]) == tg, bar);
            __builtin_amdgcn_fence(__ATOMIC_ACQUIRE, "agent");
            xb_add(&bar[XB_XGEN(b.x)], 1u);
            asm volatile("s_waitcnt vmcnt(0)" ::: "memory");
        } else {
            XB_SPIN(xb_ld(&bar[XB_XGEN(b.x)]) == gen, bar);
            __builtin_amdgcn_fence(__ATOMIC_ACQUIRE, "agent");
            asm volatile("s_waitcnt vmcnt(0)" ::: "memory");
        }
    }
    __syncthreads();
}

namespace pg8 {
constexpr int BM = 256, BK = 64, HALF = 128, HTB = HALF * BK * 2, STAGE_BYTES = 8 * HTB, NXCD = 8, WGM = 8;
__host__ __device__ __forceinline__ int lds_byte(int r, int c) { const int st = (r >> 4) * 2 + (c >> 5), rr = r & 15, cc = c & 31, ob = rr * 64 + cc * 2; return st * 1024 + (ob ^ (((ob >> 9) & 1) << 5)); }
__host__ __device__ __forceinline__ void stage_rc(int b, int& R, int& C) { const int st = b / 1024, sb = b % 1024, swz = sb ^ (((sb >> 9) & 1) << 5); R = (st >> 1) * 16 + swz / 64; C = (st & 1) * 32 + (swz % 64) / 2; }
__host__ __device__ __forceinline__ int perm32(int rho) { const int n = rho >> 4, i = rho & 15; return 8 * (i >> 2) + 4 * n + (i & 3); }
__device__ __forceinline__ int xcd_remap(int wgid, int nwg) { const int q = nwg / NXCD, r = nwg % NXCD, xcd = wgid % NXCD, off = wgid / NXCD; return (xcd < r ? xcd * (q + 1) : r * (q + 1) + (xcd - r) * q) + off; }

struct Unit { const char* A; const char* B; int pm, pn, e, nrow; };

struct DenseSched {
    const char* A; const char* Bt; int nM, nN, nwg, G, c; size_t tstep;
    __device__ __forceinline__ void init(const void* A_, const void* Bt_, int M, int N, int K, int G_, int c_) { A = (const char*)A_; Bt = (const char*)Bt_; nM = M / BM; nN = N / BM; nwg = nM * nN; G = G_; c = c_; tstep = (size_t)BM * K * 2; }
    __device__ __forceinline__ bool next(int i, Unit& u) const {
        const long L = (long)i * G + c; if (L >= nwg) return false;
        const int wgid = xcd_remap((int)L, nwg);
        const int nig = WGM * nN, gid = wgid / nig, fm = gid * WGM, gsz = (nM - fm) < WGM ? (nM - fm) : WGM;
        u.pm = fm + ((wgid % nig) % gsz); u.pn = (wgid % nig) / gsz; u.e = 0; u.nrow = BM;
        u.A = A + (size_t)u.pm * tstep; u.B = Bt + (size_t)u.pn * tstep; return true;
    }
};
struct MoeSched {
    const char* A; const char* Bt; const volatile LAS int* tstart; const volatile LAS int* cnt; int NT, nwg, G, c; size_t tstep;
    __device__ __forceinline__ void init(const void* A_, const void* Bt_, const volatile LAS int* ts, const volatile LAS int* cn, int NT_, int K, int G_, int c_) {
        A = (const char*)A_; Bt = (const char*)Bt_; tstart = ts; cnt = cn; NT = NT_; nwg = ts[NE] * NT_; G = G_; c = c_; tstep = (size_t)BM * K * 2; }
    __device__ __forceinline__ bool next(int i, Unit& u) const {
        const long L = (long)i * G + c; if (L >= nwg) return false;
        const int wgid = xcd_remap((int)L, nwg);
        int e = 0;
#pragma unroll 1
        for (int j = 1; j < NE; ++j) e = (wgid >= tstart[j] * NT) ? j : e;
        const int t0 = tstart[e], nte = tstart[e + 1] - t0, local = wgid - t0 * NT;
        const int pn = local / nte, mt = local - pn * nte;
        u.e = e; u.pn = pn; u.pm = t0 + mt; u.nrow = cnt[e] - mt * BM;
        u.A = A + (size_t)u.pm * tstep; u.B = Bt + (size_t)(e * NT + pn) * tstep; return true;
    }
};

template <class Epi, class Sched, bool BGRAN = false>
__device__ __forceinline__ void gemm_phase(LAS unsigned char* lds, const int K, const int lda, const int ldb, const Sched& S, const Epi& E) {
    const int tid = threadIdx.x, wid = __builtin_amdgcn_readfirstlane(tid >> 6), lane = tid & 63, wr = wid >> 2, wc = wid & 3, fr = lane & 15, fq = lane >> 4;
    int nt = K / BK; asm volatile("" : "+s"(nt));
    unsigned voffA[2], voffB[2];
#pragma unroll
    for (int i = 0; i < 2; ++i) { int R, C; stage_rc(tid * 16 + i * 8192, R, C); const int Rb = Epi::PERM ? ((R & ~31) + perm32(R & 31)) : R;
        voffA[i] = (unsigned)(R * lda + C) * 2u; voffB[i] = BGRAN ? (unsigned)((C >> 3) * ldb + Rb) * 16u : (unsigned)(Rb * ldb + C) * 2u; }
    const size_t kstep = (size_t)(BK * 2), kstepB = BGRAN ? (size_t)ldb * 128 : (size_t)(BK * 2);
    const size_t hstepA = (size_t)HALF * lda * 2, hstepB = BGRAN ? (size_t)2048 : (size_t)HALF * ldb * 2;
    const unsigned ldsw = (unsigned)wid * 1024u;
    const int aoff = lds_byte(wr * 64 + fr, fq * 8), boff = lds_byte(wc * 32 + fr, fq * 8);
#define PG8_SA(b, h) (((b) * 2 + (h)) * HTB)
#define PG8_SB(b, h) ((4 + (b) * 2 + (h)) * HTB)
#define PG8_STAGE(bufoff, gbase, voff) do { _Pragma("unroll") for (int _i = 0; _i < 2; ++_i) \
        __builtin_amdgcn_global_load_lds((const unsigned*)((const char*)(gbase) + (voff)[_i]), (LAS unsigned*)(lds + (bufoff) + ldsw + _i * 8192), 16, 0, 0); } while (0)
#define PG8_LDA(dst, b, h) do { _Pragma("unroll") for (int m = 0; m < 4; ++m) _Pragma("unroll") for (int k = 0; k < 2; ++k) dst[m][k] = *(const LAS bf16x8*)(lds + PG8_SA(b, h) + aoff + m * 2048 + k * 1024); } while (0)
#define PG8_LDB(dst, b, h) do { _Pragma("unroll") for (int n = 0; n < 2; ++n) _Pragma("unroll") for (int k = 0; k < 2; ++k) dst[n][k] = *(const LAS bf16x8*)(lds + PG8_SB(b, h) + boff + n * 2048 + k * 1024); } while (0)
#define PG8_MMA(ai, bj, At, Bt) do { __builtin_amdgcn_s_setprio(1); _Pragma("unroll") for (int m = 0; m < 4; ++m) _Pragma("unroll") for (int n = 0; n < 2; ++n) _Pragma("unroll") for (int k = 0; k < 2; ++k) \
        acc[ai][bj][m][n] = __builtin_amdgcn_mfma_f32_16x16x32_bf16(Bt[n][k], At[m][k], acc[ai][bj][m][n], 0, 0, 0); __builtin_amdgcn_s_setprio(0); } while (0)
#define PG8_WAIT_V(n) asm volatile("s_waitcnt vmcnt(" #n ")" ::: "memory")
#define PG8_WAIT_L(n) asm volatile("s_waitcnt lgkmcnt(" #n ")" ::: "memory")
#define PG8_BAR __builtin_amdgcn_s_barrier()
#define PG8_SCHED __builtin_amdgcn_sched_barrier(0)
    Unit cur, nxt; int ui = 0;
    if (!S.next(0, cur)) return;
    f32x4 acc[2][2][4][2];
#pragma unroll
    for (int a = 0; a < 2; ++a)
#pragma unroll
        for (int b = 0; b < 2; ++b)
#pragma unroll
            for (int m = 0; m < 4; ++m)
#pragma unroll
                for (int n = 0; n < 2; ++n) acc[a][b][m][n] = (f32x4){0.f, 0.f, 0.f, 0.f};
    bf16x8 At[4][2], B0[2][2], B1[2][2];
    const char* cA = cur.A; const char* cB = cur.B;
    PG8_STAGE(PG8_SB(0, 0), cB, voffB); PG8_STAGE(PG8_SB(0, 1), cB + hstepB, voffB); PG8_STAGE(PG8_SA(0, 0), cA, voffA); PG8_STAGE(PG8_SA(0, 1), cA + hstepA, voffA);
    if (wr == 1) PG8_BAR;
    PG8_WAIT_V(2); PG8_BAR;
    PG8_STAGE(PG8_SB(1, 0), cB + kstepB, voffB); PG8_STAGE(PG8_SA(1, 0), cA + kstep, voffA); PG8_STAGE(PG8_SB(1, 1), cB + hstepB + kstepB, voffB);
    PG8_WAIT_V(6); PG8_BAR;
    for (;;) {
        const bool has_next = S.next(ui + 1, nxt);
        const char* nA = has_next ? nxt.A : cA; const char* nB = has_next ? nxt.B : cB;
#pragma unroll 1
        for (int t = 0; t < nt; t += 2) {
            const bool last = (t == nt - 2);
            const char* a1 = cA + (size_t)(t + 1) * kstep;
            const char* a2 = last ? nA : cA + (size_t)(t + 2) * kstep; const char* b2 = last ? nB : cB + (size_t)(t + 2) * kstepB;
            const char* a3 = a2 + kstep; const char* b3 = b2 + kstepB;
            PG8_LDB(B0, 0, 0); PG8_LDB(B1, 0, 1); PG8_SCHED; PG8_LDA(At, 0, 0); PG8_STAGE(PG8_SA(1, 1), a1 + hstepA, voffA);
            PG8_WAIT_V(8); PG8_WAIT_L(0); PG8_BAR; PG8_MMA(0, 0, At, B0); PG8_MMA(0, 1, At, B1); PG8_BAR; PG8_SCHED;
            PG8_LDA(At, 0, 1); PG8_STAGE(PG8_SB(0, 0), b2, voffB); PG8_STAGE(PG8_SB(0, 1), b2 + hstepB, voffB); PG8_STAGE(PG8_SA(0, 0), a2, voffA);
            PG8_WAIT_V(8); PG8_WAIT_L(0); PG8_BAR; PG8_MMA(1, 0, At, B0); PG8_MMA(1, 1, At, B1); PG8_BAR; PG8_SCHED;
            PG8_LDB(B0, 1, 0); PG8_LDB(B1, 1, 1); PG8_SCHED; PG8_LDA(At, 1, 0); PG8_STAGE(PG8_SA(0, 1), a2 + hstepA, voffA);
            PG8_WAIT_V(8); PG8_WAIT_L(0); PG8_BAR; PG8_MMA(0, 0, At, B0); PG8_MMA(0, 1, At, B1); PG8_BAR; PG8_SCHED;
            PG8_LDA(At, 1, 1); PG8_STAGE(PG8_SB(1, 0), b3, voffB); PG8_STAGE(PG8_SB(1, 1), b3 + hstepB, voffB); PG8_STAGE(PG8_SA(1, 0), a3, voffA);
            PG8_WAIT_V(8); PG8_WAIT_L(0); PG8_BAR; PG8_MMA(1, 0, At, B0); PG8_MMA(1, 1, At, B1); PG8_BAR; PG8_SCHED;
        }
        if (wr == 0) PG8_BAR;
        E(acc, cur, wr, wc, fr, fq);
        if (!has_next) break;
#pragma unroll
        for (int a = 0; a < 2; ++a)
#pragma unroll
            for (int b = 0; b < 2; ++b)
#pragma unroll
                for (int m = 0; m < 4; ++m)
#pragma unroll
                    for (int n = 0; n < 2; ++n) acc[a][b][m][n] = (f32x4){0.f, 0.f, 0.f, 0.f};
        cur = nxt; cA = nA; cB = nB; ++ui;
        if (wr == 1) PG8_BAR;
    }
    PG8_WAIT_V(0);
    PG8_BAR;
#undef PG8_SA
#undef PG8_SB
#undef PG8_STAGE
#undef PG8_LDA
#undef PG8_LDB
#undef PG8_MMA
#undef PG8_WAIT_V
#undef PG8_WAIT_L
#undef PG8_BAR
#undef PG8_SCHED
}

struct EpiProj {
    static constexpr bool PERM = true;
    unsigned char* ws; const float* bbg;
    __device__ __forceinline__ void operator()(const f32x4 (&acc)[2][2][4][2], const Unit& u, int wr, int wc, int fr, int fq) const {
        const int pn = u.pn; size_t off; int ld, t0, act = 0;
        if (pn < 4) { off = WS_GQ; ld = 1024; t0 = 0; } else if (pn < 8) { off = WS_GK; ld = 1024; t0 = 4; } else if (pn < 16) { off = WS_GV; ld = 2048; t0 = 8; }
        else if (pn < 24) { off = WS_GR; ld = 2048; t0 = 16; act = 1; } else if (pn < 28) { off = WS_AQ; ld = 1024; t0 = 24; } else if (pn < 32) { off = WS_AK; ld = 1024; t0 = 28; }
        else if (pn < 36) { off = WS_AV; ld = 1024; t0 = 32; } else if (pn < 44) { off = WS_SG; ld = 2048; t0 = 36; act = 2; } else { off = WS_SA; ld = 2048; t0 = 44; act = 3; }
        bf16* base = (bf16*)(ws + off);
        const int colt = (pn - t0) * BM + wc * 32 + 8 * fq, row0 = u.pm * BM + wr * 64 + fr;
        f32x4 bv[2][2];
#pragma unroll
        for (int bj = 0; bj < 2; ++bj)
#pragma unroll
            for (int n = 0; n < 2; ++n) bv[bj][n] = act >= 2 ? *(const f32x4*)(bbg + (act - 2) * D + colt + bj * HALF + 4 * n) : (f32x4){0.f, 0.f, 0.f, 0.f};
#pragma unroll
        for (int ai = 0; ai < 2; ++ai)
#pragma unroll
            for (int m = 0; m < 4; ++m) { bf16* rowp = base + (size_t)(row0 + ai * HALF + m * 16) * ld + colt;
#pragma unroll
                for (int bj = 0; bj < 2; ++bj) { f32x4 v0 = acc[ai][bj][m][0] + bv[bj][0], v1 = acc[ai][bj][m][1] + bv[bj][1];
                    if (act == 1) {
#pragma unroll
                        for (int j = 0; j < 4; ++j) { v0[j] = v0[j] * sigmoidf_(v0[j]); v1[j] = v1[j] * sigmoidf_(v1[j]); } }
                    else if (act >= 2) {
#pragma unroll
                        for (int j = 0; j < 4; ++j) { v0[j] = sigmoidf_(v0[j]); v1[j] = sigmoidf_(v1[j]); } }
                    u32x4 w; w.x = cvt_pk_bf16(v0[0], v0[1]); w.y = cvt_pk_bf16(v0[2], v0[3]); w.z = cvt_pk_bf16(v1[0], v1[1]); w.w = cvt_pk_bf16(v1[2], v1[3]);
                    *(u32x4*)(rowp + bj * HALF) = w; } }
    }
};
template <int MODE> struct EpiBranch {
    static constexpr bool PERM = true;
    const bf16* gate; const bf16* tin; bf16* out;
    __device__ __forceinline__ void operator()(const f32x4 (&acc)[2][2][4][2], const Unit& u, int wr, int wc, int fr, int fq) const {
        const int colt = u.pn * BM + wc * 32 + 8 * fq, row0 = u.pm * BM + wr * 64 + fr;
#pragma unroll
        for (int ai = 0; ai < 2; ++ai)
#pragma unroll
            for (int m = 0; m < 4; ++m) { const size_t ro = (size_t)(row0 + ai * HALF + m * 16) * D + colt;
#pragma unroll
                for (int bj = 0; bj < 2; ++bj) {
                    const u32x4 gq = *(const u32x4*)(gate + ro + bj * HALF);
                    u32x4 tq = (u32x4){0u, 0u, 0u, 0u}; if (MODE == 1) tq = *(const u32x4*)(tin + ro + bj * HALF);
                    float r[8];
#pragma unroll
                    for (int j = 0; j < 4; ++j) { r[j] = acc[ai][bj][m][0][j]; r[4 + j] = acc[ai][bj][m][1][j]; }
#pragma unroll
                    for (int j = 0; j < 4; ++j) { const unsigned gw = gq[j], tw = tq[j];
                        r[2 * j] = r[2 * j] * __uint_as_float(gw << 16) + __uint_as_float(tw << 16);
                        r[2 * j + 1] = r[2 * j + 1] * __uint_as_float(gw & 0xffff0000u) + __uint_as_float(tw & 0xffff0000u); }
                    u32x4 w; w.x = cvt_pk_bf16(r[0], r[1]); w.y = cvt_pk_bf16(r[2], r[3]); w.z = cvt_pk_bf16(r[4], r[5]); w.w = cvt_pk_bf16(r[6], r[7]);
                    *(u32x4*)(out + ro + bj * HALF) = w; } }
    }
};
struct EpiResid {
    static constexpr bool PERM = false;
    const float* x; float* out;
    __device__ __forceinline__ void operator()(const f32x4 (&acc)[2][2][4][2], const Unit& u, int wr, int wc, int fr, int fq) const {
        const int col0 = u.pn * BM + wc * 32 + 4 * fq, row0 = u.pm * BM + wr * 64 + fr;
#pragma unroll
        for (int ai = 0; ai < 2; ++ai)
#pragma unroll
            for (int m = 0; m < 4; ++m) { const size_t ro = (size_t)(row0 + ai * HALF + m * 16) * D + col0;
#pragma unroll
                for (int bj = 0; bj < 2; ++bj)
#pragma unroll
                    for (int n = 0; n < 2; ++n) { const f32x4 xv = *(const f32x4*)(x + ro + bj * HALF + n * 16); *(f32x4*)(out + ro + bj * HALF + n * 16) = xv + acc[ai][bj][m][n]; } }
    }
};
struct EpiSwiglu {
    static constexpr bool PERM = true;
    const float* bgate; const float* bup; bf16* hd;
    __device__ __forceinline__ void operator()(const f32x4 (&acc)[2][2][4][2], const Unit& u, int wr, int wc, int fr, int fq) const {
        const int col = u.pn * HALF + wc * 32 + 8 * fq; const size_t row0 = (size_t)u.pm * BM + wr * 64 + fr;
        const float* bg = bgate + (size_t)u.e * DFF + col; const float* bu = bup + (size_t)u.e * DFF + col;
        const f32x4 g0 = *(const f32x4*)bg, g1 = *(const f32x4*)(bg + 4), u0 = *(const f32x4*)bu, u1 = *(const f32x4*)(bu + 4);
#pragma unroll
        for (int ai = 0; ai < 2; ++ai)
#pragma unroll
            for (int m = 0; m < 4; ++m) {
                float r[8];
#pragma unroll
                for (int j = 0; j < 4; ++j) {
                    const float ga = fminf(acc[ai][0][m][0][j] + g0[j], 7.f), ua = fminf(fmaxf(acc[ai][1][m][0][j] + u0[j], -7.f), 7.f);
                    const float gb = fminf(acc[ai][0][m][1][j] + g1[j], 7.f), ub = fminf(fmaxf(acc[ai][1][m][1][j] + u1[j], -7.f), 7.f);
                    r[j] = (ua + 1.f) * (ga * sigmoidf_(1.702f * ga)); r[4 + j] = (ub + 1.f) * (gb * sigmoidf_(1.702f * gb)); }
                u32x4 w; w.x = cvt_pk_bf16(r[0], r[1]); w.y = cvt_pk_bf16(r[2], r[3]); w.z = cvt_pk_bf16(r[4], r[5]); w.w = cvt_pk_bf16(r[6], r[7]);
                *(u32x4*)(hd + (row0 + ai * HALF + m * 16) * DFF + col) = w; }
    }
};
struct EpiDown {
    static constexpr bool PERM = true;
    const float* bdown; const int* rpair; const float* rw; bf16* py;
    __device__ __forceinline__ void operator()(const f32x4 (&acc)[2][2][4][2], const Unit& u, int wr, int wc, int fr, int fq) const {
        const int colt = u.pn * BM + wc * 32 + 8 * fq; const size_t srow0 = (size_t)u.pm * BM + wr * 64 + fr;
        f32x4 bv[2][2];
#pragma unroll
        for (int bj = 0; bj < 2; ++bj)
#pragma unroll
            for (int n = 0; n < 2; ++n) bv[bj][n] = *(const f32x4*)(bdown + (size_t)u.e * D + colt + bj * HALF + 4 * n);
#pragma unroll
        for (int ai = 0; ai < 2; ++ai)
#pragma unroll
            for (int m = 0; m < 4; ++m) { const size_t srow = srow0 + ai * HALF + m * 16; const int pair = rpair[srow]; const float wgt = rw[srow];
                bf16* rowp = py + (size_t)pair * D + colt;
#pragma unroll
                for (int bj = 0; bj < 2; ++bj) { const f32x4 v0 = (acc[ai][bj][m][0] + bv[bj][0]) * wgt, v1 = (acc[ai][bj][m][1] + bv[bj][1]) * wgt;
                    u32x4 w; w.x = cvt_pk_bf16(v0[0], v0[1]); w.y = cvt_pk_bf16(v0[2], v0[3]); w.z = cvt_pk_bf16(v1[0], v1[1]); w.w = cvt_pk_bf16(v1[2], v1[3]);
                    *(u32x4*)(rowp + bj * HALF) = w; } }
    }
};

struct GlaSched {
    int mode, G, c; unsigned char* ws;
    __device__ __forceinline__ bool next(int i, Unit& u) const {
        const int L = i * G + c; const int nu = mode == 0 ? 128 : 256; if (L >= nu) return false;
        const int nh = mode == 0 ? L : (L >> 1), hv = mode == 0 ? 0 : (L & 1);
        u.pm = nh; u.pn = hv; u.e = 0; u.nrow = BM;
        if (mode == 0) { u.A = (const char*)(ws + WS_ACAT) + (size_t)nh * 256 * 512 * 2 + 512; u.B = (const char*)(ws + WS_KI) + (size_t)nh * 256 * 256 * 2; }
        else if (mode == 1) { u.A = (const char*)(ws + WS_BCAT) + (size_t)nh * 512 * 512 * 2 + (size_t)hv * 256 * 512 * 2; u.B = (const char*)(ws + WS_KET) + (size_t)nh * 256 * 256 * 2; }
        else { u.A = (const char*)(ws + WS_ACAT) + (size_t)nh * 256 * 512 * 2; u.B = (const char*)(ws + WS_BCAT) + (size_t)nh * 512 * 512 * 2 + (size_t)hv * 256 * 512 * 2; }
        return true;
    }
};
template <int MODE> struct EpiGla {
    static constexpr bool PERM = true;
    unsigned char* ws;
    __device__ __forceinline__ void operator()(const f32x4 (&acc)[2][2][4][2], const Unit& u, int wr, int wc, int fr, int fq) const {
        const int nh = u.pm, hv = u.pn; const int c8 = wc * 32 + 8 * fq, r0 = wr * 64 + fr;
        bf16* base; int ld;
        if (MODE == 0) { base = (bf16*)(ws + WS_ACAT) + (size_t)nh * 256 * 512; ld = 512; }
        else if (MODE == 1) { base = (bf16*)(ws + WS_UT) + (size_t)nh * 512 * 256 + (size_t)hv * 256 * 256; ld = 256; }
        else { base = (bf16*)(ws + WS_OB) + (size_t)(nh >> 2) * 256 * GLA_V + (nh & 3) * GLA_DV + hv * 256; ld = GLA_V; }
#pragma unroll
        for (int ai = 0; ai < 2; ++ai)
#pragma unroll
            for (int m = 0; m < 4; ++m) { const int row = r0 + ai * HALF + m * 16;
#pragma unroll
                for (int bj = 0; bj < 2; ++bj) { f32x4 v0 = acc[ai][bj][m][0], v1 = acc[ai][bj][m][1]; const int col = bj * HALF + c8;
                    if (MODE == 0) {
#pragma unroll
                        for (int j = 0; j < 4; ++j) { v0[j] = (col + j <= row) ? v0[j] : 0.f; v1[j] = (col + 4 + j <= row) ? v1[j] : 0.f; } }
                    u32x4 w; w.x = cvt_pk_bf16(v0[0], v0[1]); w.y = cvt_pk_bf16(v0[2], v0[3]); w.z = cvt_pk_bf16(v1[0], v1[1]); w.w = cvt_pk_bf16(v1[2], v1[3]);
                    *(u32x4*)(base + (size_t)row * ld + col) = w; } }
    }
};
}

constexpr int NWAVES = 8;
#ifndef GEMM_CUS
#define GEMM_CUS 152
#endif
constexpr int RING_BYTES = 131072, MISC_OFF = RING_BYTES + 320, LDS_BYTES = 147456;
constexpr int TAB_OFF = MISC_OFF + 128;

struct Frame {
    LAS unsigned char* lds; volatile LAS unsigned* MISC; unsigned* ctl; unsigned char* ws;
    int tid, lane, wave, vcu, G;
};
struct Args { const float* in[22]; float* out; unsigned char* ws; int ph_lo, ph_hi, li, pad; };

struct P0Item { const float* src; bf16* dst; int ldn, K; };
constexpr int P0_I_IN = 32 * (NPROJ / 32), P0_I_BG = 32 * 64, P0_I_BA = 16 * 64, P0_I_OUT = 32 * 64, P0_I_E = 32 * 64;
constexpr int P0_I_SMALL = P0_I_IN + P0_I_BG + P0_I_BA + P0_I_OUT, P0_NITEMS = P0_I_SMALL + 3 * NE * P0_I_E;
__device__ __forceinline__ P0Item p0_decode(Frame& F, const Args& a, int r) {
    constexpr int I_IN = P0_I_IN, I_BG = P0_I_BG, I_BA = P0_I_BA, I_OUT = P0_I_OUT, I_E = P0_I_E, I_MOE = NE * I_E;
    P0Item it;
    if (r < I_IN) { const int nb = r % (NPROJ / 32), kb = r / (NPROJ / 32), d0 = nb * 32, s0 = d0 < C_GLR ? d0 : d0 + 16;
        it.src = a.in[2] + (size_t)kb * 64 * IN_COLS + s0; it.ldn = IN_COLS; it.dst = (bf16*)(F.ws + WS_WIN) + (size_t)d0 * D + kb * 64; it.K = D; return it; } r -= I_IN;
    if (r < I_BG) { const int nb = r % 64, kb = r / 64; it.src = a.in[10] + (size_t)kb * 64 * D + nb * 32; it.ldn = D; it.dst = (bf16*)(F.ws + WS_WBG) + (size_t)nb * 32 * GLA_V + kb * 64; it.K = GLA_V; return it; } r -= I_BG;
    if (r < I_BA) { const int nb = r % 64, kb = r / 64; it.src = a.in[11] + (size_t)kb * 64 * D + nb * 32; it.ldn = D; it.dst = (bf16*)(F.ws + WS_WBA) + (size_t)nb * 32 * ATT_W + kb * 64; it.K = ATT_W; return it; } r -= I_BA;
    if (r < I_OUT) { const int nb = r % 64, kb = r / 64; it.src = a.in[12] + (size_t)kb * 64 * D + nb * 32; it.ldn = D; it.dst = (bf16*)(F.ws + WS_WOUT) + (size_t)nb * 32 * D + kb * 64; it.K = D; return it; } r -= I_OUT;
    if (r < 2 * I_MOE) {
        const int which = r / I_MOE; r -= which * I_MOE; const int e = r / I_E; r -= e * I_E; const int nb = r % 64, kb = r / 64, n0 = nb * 32;
        it.src = (which ? a.in[18] : a.in[16]) + (size_t)e * D * DFF + (size_t)kb * 64 * DFF + n0; it.ldn = DFF;
        it.dst = (bf16*)(F.ws + WS_GU) + (size_t)e * 2 * DFF * D + (size_t)((n0 >> 7) * 256 + (n0 & 127) + which * 128) * D + kb * 64; it.K = D; return it; }
    r -= 2 * I_MOE;
    { const int e = r / I_E; r -= e * I_E; const int nb = r % 64, kb = r / 64;
      it.src = a.in[20] + (size_t)e * DFF * D + (size_t)kb * 64 * D + nb * 32; it.ldn = D; it.dst = (bf16*)(F.ws + WS_DN) + (size_t)e * D * DFF + (size_t)nb * 32 * DFF + kb * 64; it.K = DFF; return it; }
}
__device__ __forceinline__ void p0_load(const P0Item& it, int lane, f32x4 (&v)[8]) {
    const float* p = it.src + (size_t)(lane >> 3) * it.ldn + 4 * (lane & 7);
#pragma unroll
    for (int i = 0; i < 8; ++i) v[i] = __builtin_nontemporal_load((const GAS f32x4*)(p + (size_t)(8 * i) * it.ldn));
}
__device__ __forceinline__ void p0_convert(Frame& F, const Args& a, int it_lo, int it_hi, int gw, int NGW) {
    LAS float* scr = (LAS float*)(F.lds + F.wave * 16384);
    const int lane = F.lane;
    int itx = it_lo + gw;
    if (itx >= it_hi) return;
    P0Item cur = p0_decode(F, a, itx);
    f32x4 v[8]; p0_load(cur, lane, v);
    for (;;) {
        const int nx = itx + NGW; const bool more = nx < it_hi;
        P0Item nxt = cur; f32x4 vn[8];
        if (more) { nxt = p0_decode(F, a, nx); p0_load(nxt, lane, vn); }
#pragma unroll
        for (int i = 0; i < 8; ++i) { LAS float* q = scr + (8 * i + (lane >> 3)) * 33 + 4 * (lane & 7); q[0] = v[i].x; q[1] = v[i].y; q[2] = v[i].z; q[3] = v[i].w; }
        LDS_WAIT(); asm volatile("" ::: "memory");
        const int c = lane & 7;
#pragma unroll
        for (int j = 0; j < 4; ++j) { const int n = (lane >> 3) + 8 * j; const LAS float* sp = scr + (8 * c) * 33 + n;
            u32x4 o; o.x = pk2(sp[0 * 33], sp[1 * 33]); o.y = pk2(sp[2 * 33], sp[3 * 33]); o.z = pk2(sp[4 * 33], sp[5 * 33]); o.w = pk2(sp[6 * 33], sp[7 * 33]);
            __builtin_nontemporal_store(o, (GAS u32x4*)(cur.dst + (size_t)n * cur.K + 8 * c)); }
        LDS_WAIT(); asm volatile("" ::: "memory");
        if (!more) break;
        itx = nx; cur = nxt;
#pragma unroll
        for (int i = 0; i < 8; ++i) v[i] = vn[i];
    }
}
__device__ __forceinline__ void p0_rows(Frame& F, const Args& a) {
    const int gw = F.vcu * NWAVES + F.wave, NGW = F.G * NWAVES, lane = F.lane;
    const float* w_in = a.in[2];
    const float* x = a.in[0]; const float* g1 = a.in[1]; bf16* XN = (bf16*)(F.ws + WS_XN); float* GLR = (float*)(F.ws + WS_GLR);
    for (int m = gw; m < S; m += NGW) {
        const GAS f32x4* xr = (const GAS f32x4*)(x + (size_t)m * D) + lane;
        f32x4 v[8]; float s = 0.f;
#pragma unroll
        for (int j = 0; j < 8; ++j) { v[j] = xr[64 * j]; s += (v[j].x * v[j].x + v[j].y * v[j].y) + (v[j].z * v[j].z + v[j].w * v[j].w); }
        const float rstd = rsqrtf(wave_sum(s) * (1.f / D) + 1e-6f);
        GAS u32x2* o8 = (GAS u32x2*)(XN + (size_t)m * D) + lane;
        float gl[16];
#pragma unroll
        for (int r = 0; r < 16; ++r) gl[r] = 0.f;
#pragma unroll
        for (int j = 0; j < 8; ++j) { const f32x4 gg = *((const GAS f32x4*)g1 + lane + 64 * j); v[j] = v[j] * rstd * gg;
            u32x2 w; w.x = pk2(v[j].x, v[j].y); w.y = pk2(v[j].z, v[j].w); o8[64 * j] = w;
#pragma unroll
            for (int i = 0; i < 4; ++i) { const GAS f32x4* wp = (const GAS f32x4*)(w_in + (size_t)(256 * j + 4 * lane + i) * IN_COLS + C_GLR);
#pragma unroll
                for (int q = 0; q < 4; ++q) { const f32x4 wv = wp[q]; gl[4 * q] = fmaf(v[j][i], wv.x, gl[4 * q]); gl[4 * q + 1] = fmaf(v[j][i], wv.y, gl[4 * q + 1]); gl[4 * q + 2] = fmaf(v[j][i], wv.z, gl[4 * q + 2]); gl[4 * q + 3] = fmaf(v[j][i], wv.w, gl[4 * q + 3]); } } }
        float mine = 0.f;
#pragma unroll
        for (int r = 0; r < 16; ++r) { const float t = wave_sum(gl[r]); mine = (lane == r) ? t : mine; }
        if (lane < 16) GLR[(size_t)m * 16 + lane] = mine;
    }
    { const float* g2 = a.in[13]; const float* wr = a.in[14]; float* WR = (float*)(F.ws + WS_WR);
      for (int i = (F.vcu * NWAVES * 64) + F.tid; i < D * NE; i += F.G * NWAVES * 64) WR[i] = g2[i >> 5] * wr[i]; }
}

__device__ __forceinline__ void router_unit(Frame& F, const Args& a, int tile) {
    const int w = F.wave, lane = F.lane, tid = F.tid, i = lane & 31, kk = lane >> 5, t0 = tile * 32;
    const float* h1 = a.out; const float* g2 = a.in[13]; const float* WR = (const float*)(F.ws + WS_WR); const float* br = a.in[15];
    LAS float* part = (LAS float*)F.lds;
    LAS float* ssq = part + 8192;
    LAS float* lg = ssq + 256;
    LAS float* rs = lg + 32 * 33;
    f32x16 acc;
#pragma unroll
    for (int r = 0; r < 16; ++r) acc[r] = 0.f;
    float ss = 0.f;
    const float* arow = h1 + (size_t)(t0 + i) * D + 256 * w + 128 * kk;
    const float* bcol = WR + (size_t)(256 * w + 128 * kk) * NE + i;
#pragma unroll 1
    for (int c = 0; c < 4; ++c) {
        f32x4 av[8];
#pragma unroll
        for (int q = 0; q < 8; ++q) av[q] = *(const GAS f32x4*)(arow + 32 * c + 4 * q);
#pragma unroll
        for (int q = 0; q < 8; ++q)
#pragma unroll
            for (int j = 0; j < 4; ++j) { const float b = bcol[(size_t)(32 * c + 4 * q + j) * NE]; acc = __builtin_amdgcn_mfma_f32_32x32x2f32(av[q][j], b, acc, 0, 0, 0); ss = fmaf(av[q][j], av[q][j], ss); }
    }
    ss += __shfl_xor(ss, 32);
    if (kk == 0) ssq[w * 32 + i] = ss;
#pragma unroll
    for (int r = 0; r < 16; ++r) part[(w * 32 + (r & 3) + 8 * (r >> 2) + 4 * kk) * 32 + i] = acc[r];
    __syncthreads();
#pragma unroll
    for (int rep = 0; rep < 2; ++rep) { const int idx = tid + 512 * rep, tok = idx >> 5, e = idx & 31; float sum = 0.f, st = 0.f;
#pragma unroll
        for (int ww = 0; ww < 8; ++ww) { sum += part[(ww * 32 + tok) * 32 + e]; st += ssq[ww * 32 + tok]; }
        const float rstd = rsqrtf(st * (1.f / D) + 1e-6f);
        lg[tok * 33 + e] = sum * rstd + br[e]; if (e == 0) rs[tok] = rstd; }
    __syncthreads();
    bf16* HN = (bf16*)(F.ws + WS_HN); float* topw = (float*)(F.ws + WS_TOPW); int* tope = (int*)(F.ws + WS_TOPE); int* tops = (int*)(F.ws + WS_TOPS);
    unsigned* cnt = F.ctl + CW_CNT;
#pragma unroll 1
    for (int q = 0; q < 4; ++q) {
        const int tok = 4 * w + q, t = t0 + tok, e = lane & 31;
        const float rstd = rs[tok];
        {
            const GAS f32x4* x4 = (const GAS f32x4*)(h1 + (size_t)t * D) + lane; GAS u32x2* o8 = (GAS u32x2*)(HN + (size_t)t * D) + lane;
#pragma unroll
            for (int j = 0; j < 8; ++j) { const f32x4 gg = *((const GAS f32x4*)g2 + lane + 64 * j); const f32x4 y = x4[64 * j] * rstd * gg; u32x2 wv; wv.x = pk2(y.x, y.y); wv.y = pk2(y.z, y.w); o8[64 * j] = wv; }
        }
        float vals[4]; int idxs[4]; float cur = lg[tok * 33 + e];
#pragma unroll
        for (int r = 0; r < 4; ++r) {
            float bv = cur; int bi = e;
#pragma unroll
            for (int o = 1; o < 32; o <<= 1) { const float ov = __shfl_xor(bv, o); const int oi = __shfl_xor(bi, o); if (ov > bv || (ov == bv && oi < bi)) { bv = ov; bi = oi; } }
            vals[r] = bv; idxs[r] = bi;
            if (e == bi) cur = -3.0e38f;
        }
        float ex[4], sum = 0.f;
#pragma unroll
        for (int r = 0; r < 4; ++r) { ex[r] = __expf(vals[r] - vals[0]); sum += ex[r]; }
#pragma unroll
        for (int r = 0; r < 4; ++r) {
            if (lane == r) { const int ee = idxs[r]; const int slot = (int)atomicAdd(&cnt[ee], 1u);
                topw[t * 4 + r] = ex[r] / sum; tope[t * 4 + r] = ee; tops[t * 4 + r] = slot; }
        }
    }
    __syncthreads();
}
__device__ __forceinline__ void moe_table(Frame& F) {
    volatile LAS int* ts = (volatile LAS int*)(F.lds + TAB_OFF); volatile LAS int* cn = (volatile LAS int*)(F.lds + TAB_OFF + 256);
    __syncthreads();
    if (F.tid == 0) { int s = 0; for (int e = 0; e < NE; ++e) { const int c = (int)__hip_atomic_load(F.ctl + CW_CNT + e, __ATOMIC_RELAXED, __HIP_MEMORY_SCOPE_AGENT); cn[e] = c; ts[e] = s; s += (c + 255) >> 8; } ts[NE] = s; }
    __syncthreads();
}
__device__ __forceinline__ void p7_gather(Frame& F) {
    const int gw = F.vcu * NWAVES + F.wave, NGW = F.G * NWAVES, lane = F.lane;
    volatile LAS int* ts = (volatile LAS int*)(F.lds + TAB_OFF);
    const bf16* HN = (const bf16*)(F.ws + WS_HN); bf16* HNG = (bf16*)(F.ws + WS_HNG);
    const float* topw = (const float*)(F.ws + WS_TOPW); const int* tope = (const int*)(F.ws + WS_TOPE); const int* tops = (const int*)(F.ws + WS_TOPS);
    int* rpair = (int*)(F.ws + WS_RPAIR); float* rw = (float*)(F.ws + WS_RW);
    { volatile LAS int* cn = (volatile LAS int*)(F.lds + TAB_OFF + 256);
      for (int e = gw; e < NE; e += NGW) { const int c = cn[e], base = ts[e] * 256, padn = ((c + 255) & ~255) - c;
          for (int r = lane; r < padn; r += 64) { rpair[base + c + r] = S * 4; rw[base + c + r] = 0.f; } } }
    for (int t = gw; t < S; t += NGW) {
        const GAS u32x4* src = (const GAS u32x4*)(HN + (size_t)t * D) + lane; u32x4 v[4];
#pragma unroll
        for (int j = 0; j < 4; ++j) v[j] = src[64 * j];
#pragma unroll
        for (int r = 0; r < 4; ++r) { const int p = t * 4 + r; const int dst = ts[tope[p]] * 256 + tops[p];
            GAS u32x4* d = (GAS u32x4*)(HNG + (size_t)dst * D) + lane;
#pragma unroll
            for (int j = 0; j < 4; ++j) d[64 * j] = v[j];
            if (lane == 0) { rpair[dst] = p; rw[dst] = topw[p]; } }
    }
}
__device__ __forceinline__ void p10_combine(Frame& F, const Args& a) {
    const int gw = F.vcu * NWAVES + F.wave, NGW = F.G * NWAVES, lane = F.lane;
    const bf16* PY = (const bf16*)(F.ws + WS_PY); float* out = a.out;
    for (int t = gw; t < S; t += NGW) {
#pragma unroll
        for (int j = 0; j < 4; ++j) {
            float r[8]; { const f32x4 h0 = *(const GAS f32x4*)(out + (size_t)t * D + 512 * j + 8 * lane), h1v = *(const GAS f32x4*)(out + (size_t)t * D + 512 * j + 8 * lane + 4);
                r[0] = h0.x; r[1] = h0.y; r[2] = h0.z; r[3] = h0.w; r[4] = h1v.x; r[5] = h1v.y; r[6] = h1v.z; r[7] = h1v.w; }
#pragma unroll
            for (int k = 0; k < 4; ++k) { const u32x4 p = *(const GAS u32x4*)(PY + (size_t)(t * 4 + k) * D + 512 * j + 8 * lane);
#pragma unroll
                for (int q = 0; q < 4; ++q) { r[2 * q] += __uint_as_float(p[q] << 16); r[2 * q + 1] += __uint_as_float(p[q] & 0xffff0000u); } }
            *(GAS f32x4*)(out + (size_t)t * D + 512 * j + 8 * lane) = (f32x4){r[0], r[1], r[2], r[3]};
            *(GAS f32x4*)(out + (size_t)t * D + 512 * j + 8 * lane + 4) = (f32x4){r[4], r[5], r[6], r[7]};
        }
    }
}


constexpr float ATT_QSCALE = 0.08838834764831845f * 1.4426950408889634f;
__device__ __forceinline__ void attn_prep_unit(Frame& F, const Args& a, int n, int h) {
    const int wave = F.wave, lane = F.lane, tid = F.tid;
    LAS bf16* kst = (LAS bf16*)(F.lds);
    LAS bf16* vst = (LAS bf16*)(F.lds + 16384);
    const bf16* AQ = (const bf16*)(F.ws + WS_AQ); const bf16* AK = (const bf16*)(F.ws + WS_AK); const bf16* AV = (const bf16*)(F.ws + WS_AV);
    bf16* QH = (bf16*)(F.ws + WS_QH);
    const float* qg = a.in[6]; const float* kg = a.in[7];
    const float gq0 = qg[2 * lane], gq1 = qg[2 * lane + 1], gk0 = kg[2 * lane], gk1 = kg[2 * lane + 1];
#pragma unroll
    for (int i = 0; i < 8; ++i) {
        const int row = n * 64 + wave * 8 + i; const size_t off = (size_t)row * ATT_W + h * ATT_HD + 2 * lane;
        const unsigned qv = *(const unsigned*)(AQ + off), kv = *(const unsigned*)(AK + off), vv = *(const unsigned*)(AV + off);
        const float q0 = __uint_as_float(qv << 16), q1 = __uint_as_float(qv & 0xffff0000u), k0 = __uint_as_float(kv << 16), k1 = __uint_as_float(kv & 0xffff0000u);
        const float rq = rsqrtf(wave_sum(q0 * q0 + q1 * q1) * (1.f / 128.f) + 1e-6f) * ATT_QSCALE, rk = rsqrtf(wave_sum(k0 * k0 + k1 * k1) * (1.f / 128.f) + 1e-6f);
        *(unsigned*)(QH + off) = pk2(q0 * rq * gq0, q1 * rq * gq1);
        *(LAS unsigned*)(kst + (wave * 8 + i) * 128 + 2 * lane) = pk2(k0 * rk * gk0, k1 * rk * gk1);
        *(LAS unsigned*)(vst + (wave * 8 + i) * 128 + 2 * lane) = vv;
    }
    __syncthreads();
    bf16* KI = (bf16*)(F.ws + WS_KIMG) + (size_t)(n * ATT_H + h) * 8192; bf16* VI = (bf16*)(F.ws + WS_VIMG) + (size_t)(n * ATT_H + h) * 8192;
#pragma unroll
    for (int i = 0; i < 2; ++i) {
        const int g = tid + 512 * i;
        { const int c16 = g >> 6, key = g & 63; const u32x4 v = *(const LAS u32x4*)(kst + key * 128 + c16 * 8); *(u32x4*)(KI + (size_t)g * 8) = v; }
        { const int kg8 = g >> 7, d = g & 127; unsigned short e[8];
#pragma unroll
          for (int j = 0; j < 8; ++j) e[j] = vst[(kg8 * 8 + j) * 128 + d];
          u32x4 v; v.x = e[0] | ((unsigned)e[1] << 16); v.y = e[2] | ((unsigned)e[3] << 16); v.z = e[4] | ((unsigned)e[5] << 16); v.w = e[6] | ((unsigned)e[7] << 16);
          *(u32x4*)(VI + (size_t)g * 8) = v; }
    }
    __syncthreads();
}

__device__ __forceinline__ int crow(int r, int hi) { return (r & 3) + 8 * (r >> 2) + 4 * hi; }
__device__ __forceinline__ void attn_unit(Frame& F, const Args& a, int n4, int h) {
    const int w = F.wave, lane = F.lane, r32 = lane & 31, hi = lane >> 5, tid = F.tid;
    const int p = w >> 1, half = w & 1, c = 4 * n4 + p, qrow0 = c * 64 + 32 * half;
    LAS unsigned char* lds = F.lds;
    LAS float* btab = (LAS float*)(lds + 65536); LAS float* xch = (LAS float*)(lds + 67584 + 256 * w); LAS bf16* ost = (LAS bf16*)(lds + 8192 * w);
    const float* relb = a.in[8] + h * 257;
    if (tid < 257) btab[tid] = relb[tid] * 1.4426950408889634f;
    const bf16* QH = (const bf16*)(F.ws + WS_QH);
    bf16x8 qf[8];
#pragma unroll
    for (int d0 = 0; d0 < 8; ++d0) qf[d0] = *(const bf16x8*)(QH + (size_t)(qrow0 + r32) * ATT_W + h * ATT_HD + d0 * 16 + hi * 8);
    const char* KIMG = (const char*)(F.ws + WS_KIMG); const char* VIMG = (const char*)(F.ws + WS_VIMG);
    f32x16 o[4];
#pragma unroll
    for (int dt = 0; dt < 4; ++dt)
#pragma unroll
        for (int r = 0; r < 16; ++r) o[dt][r] = 0.f;
    float m = -1.0e30f, l = 0.f;
    const int s0 = (4 * n4 - 8 < 0) ? (8 - 4 * n4) : 0;
#define ATT_STAGE(s_) do { const int kc_ = 4 * n4 - 8 + (s_); const size_t gb_ = (size_t)(kc_ * ATT_H + h) * 16384; const unsigned lb_ = ((s_) & 1) * 32768; \
        _Pragma("unroll") for (int i_ = 0; i_ < 2; ++i_) { const int pc_ = w + 8 * i_; \
            __builtin_amdgcn_global_load_lds((const unsigned*)(KIMG + gb_ + pc_ * 1024 + lane * 16), (LAS unsigned*)(lds + lb_ + pc_ * 1024), 16, 0, 0); \
            __builtin_amdgcn_global_load_lds((const unsigned*)(VIMG + gb_ + pc_ * 1024 + lane * 16), (LAS unsigned*)(lds + lb_ + 16384 + pc_ * 1024), 16, 0, 0); } } while (0)
    ATT_STAGE(s0);
    for (int s = s0; s < 12; ++s) {
        asm volatile("s_waitcnt vmcnt(0) lgkmcnt(0)" ::: "memory");
        __builtin_amdgcn_s_barrier();
        if (s + 1 < 12) ATT_STAGE(s + 1);
        if (s >= p && s <= p + 8) {
            const LAS unsigned char* kb = lds + (s & 1) * 32768; const LAS unsigned char* vb = kb + 16384;
            f32x16 p0, p1;
#pragma unroll
            for (int r = 0; r < 16; ++r) { p0[r] = 0.f; p1[r] = 0.f; }
#pragma unroll
            for (int d0 = 0; d0 < 8; ++d0) {
                const bf16x8 k0 = *(const LAS bf16x8*)(kb + (2 * d0 + hi) * 1024 + r32 * 16), k1 = *(const LAS bf16x8*)(kb + (2 * d0 + hi) * 1024 + (r32 + 32) * 16);
                p0 = __builtin_amdgcn_mfma_f32_32x32x16_bf16(k0, qf[d0], p0, 0, 0, 0);
                p1 = __builtin_amdgcn_mfma_f32_32x32x16_bf16(k1, qf[d0], p1, 0, 0, 0);
                if (d0 & 1) __builtin_amdgcn_sched_barrier(0);
            }
            const int wrel = p + 8 - s;
            if (wrel >= 3) { const float bc = btab[256];
#pragma unroll
                for (int r = 0; r < 16; ++r) { p0[r] += bc; p1[r] += bc; } }
            else { const int base = 64 * wrel + 32 * half + r32 + 128;
#pragma unroll
                for (int r = 0; r < 16; ++r) { int i0 = base - crow(r, hi), i1 = i0 - 32; i0 = i0 > 256 ? 256 : i0; i1 = i1 > 256 ? 256 : i1; i1 = i1 < 0 ? 0 : i1; i0 = i0 < 0 ? 0 : i0; p0[r] += btab[i0]; p1[r] += btab[i1]; } }
            float mx = p0[0];
#pragma unroll
            for (int r = 1; r < 16; ++r) mx = fmaxf(mx, p0[r]);
#pragma unroll
            for (int r = 0; r < 16; ++r) mx = fmaxf(mx, p1[r]);
            mx = fmaxf(mx, __shfl_xor(mx, 32));
            const float mn = fmaxf(m, mx), alpha = __builtin_amdgcn_exp2f(m - mn);
            float ps = 0.f;
#pragma unroll
            for (int r = 0; r < 16; ++r) { p0[r] = __builtin_amdgcn_exp2f(p0[r] - mn); p1[r] = __builtin_amdgcn_exp2f(p1[r] - mn); ps += p0[r] + p1[r]; }
            l = l * alpha + ps;
            if (__any(mn > m)) {
                if (hi == 0) xch[r32] = alpha;
                asm volatile("s_waitcnt lgkmcnt(0)" ::: "memory");
#pragma unroll
                for (int g = 0; g < 4; ++g) { const f32x4 av = *(const LAS f32x4*)(xch + 8 * g + 4 * hi);
#pragma unroll
                    for (int dt = 0; dt < 4; ++dt) { o[dt][4 * g] *= av[0]; o[dt][4 * g + 1] *= av[1]; o[dt][4 * g + 2] *= av[2]; o[dt][4 * g + 3] *= av[3]; } }
            }
            m = mn;
            bf16x8 pa[4];
#pragma unroll
            for (int ks = 0; ks < 4; ++ks) { const f32x16& src = (ks < 2) ? p0 : p1; const int b = (ks & 1) * 8; u32x4 t;
                t.x = cvt_pk_bf16(src[b], src[b + 1]); t.y = cvt_pk_bf16(src[b + 2], src[b + 3]); t.z = cvt_pk_bf16(src[b + 4], src[b + 5]); t.w = cvt_pk_bf16(src[b + 6], src[b + 7]);
                pa[ks] = __builtin_bit_cast(bf16x8, t); }
#pragma unroll
            for (int dt = 0; dt < 4; ++dt)
#pragma unroll
                for (int ks = 0; ks < 4; ++ks) {
                    const LAS unsigned char* vp = vb + (2 * ks) * 2048 + (32 * dt + r32) * 16 + 8 * hi;
                    const u32x2 lo = *(const LAS u32x2*)vp, hh = *(const LAS u32x2*)(vp + 2048);
                    const u32x4 bq = (u32x4){lo.x, lo.y, hh.x, hh.y};
                    o[dt] = __builtin_amdgcn_mfma_f32_32x32x16_bf16(pa[ks], __builtin_bit_cast(bf16x8, bq), o[dt], 0, 0, 0);
                    if (ks == 3) __builtin_amdgcn_sched_barrier(0);
                }
        }
    }
#undef ATT_STAGE
    asm volatile("s_waitcnt lgkmcnt(0)" ::: "memory");
    __builtin_amdgcn_s_barrier();
    l += __shfl_xor(l, 32);
    if (hi == 0) xch[32 + r32] = 1.f / l;
    asm volatile("s_waitcnt lgkmcnt(0)" ::: "memory");
#pragma unroll
    for (int g = 0; g < 4; ++g) { const f32x4 iv = *(const LAS f32x4*)(xch + 32 + 8 * g + 4 * hi);
#pragma unroll
        for (int dt = 0; dt < 4; ++dt)
#pragma unroll
            for (int j = 0; j < 4; ++j) ost[(8 * g + 4 * hi + j) * 128 + 32 * dt + r32] = (bf16)f2bf(o[dt][4 * g + j] * iv[j]); }
    asm volatile("s_waitcnt lgkmcnt(0)" ::: "memory");
    bf16* YA = (bf16*)(F.ws + WS_YA);
#pragma unroll
    for (int i = 0; i < 8; ++i) { const int g = i * 64 + lane, row = g >> 4, c16 = g & 15; const u32x4 v = *(const LAS u32x4*)(ost + row * 128 + c16 * 8);
        *(u32x4*)(YA + (size_t)(qrow0 + row) * ATT_W + h * ATT_HD + c16 * 8) = v; }
    asm volatile("s_waitcnt vmcnt(0) lgkmcnt(0)" ::: "memory");
    __builtin_amdgcn_s_barrier();
}


__device__ __forceinline__ void gla_prep_unit(Frame& F, const Args& a, int n, int cg) {
    const int tid = F.tid, cq = tid & 15, seg = tid >> 4;
    const int h = cg >> 2, dk0 = (cg & 3) * 64 + 4 * cq, col0 = h * GLA_DK + dk0, nh = n * GLA_H + h;
    const float* wgu = a.in[3]; const float* bgt = a.in[4]; const float* GLR = (const float*)(F.ws + WS_GLR);
    const bf16* GQ = (const bf16*)(F.ws + WS_GQ); const bf16* GK = (const bf16*)(F.ws + WS_GK);
    LAS float* tot = (LAS float*)F.lds;
    f32x4 w[16];
#pragma unroll
    for (int r = 0; r < 16; ++r) w[r] = *(const f32x4*)(wgu + r * GLA_QK + col0);
    const f32x4 bgv = *(const f32x4*)(bgt + col0);
    f32x4 cs[8]; f32x4 run = (f32x4){0.f, 0.f, 0.f, 0.f};
    const int t0 = n * 256 + seg * 8;
#pragma unroll
    for (int i = 0; i < 8; ++i) {
        const f32x4* gp = (const f32x4*)(GLR + (size_t)(t0 + i) * 16); f32x4 z = bgv;
#pragma unroll
        for (int q = 0; q < 4; ++q) { const f32x4 gv = gp[q]; z += w[4 * q] * gv.x; z += w[4 * q + 1] * gv.y; z += w[4 * q + 2] * gv.z; z += w[4 * q + 3] * gv.w; }
#pragma unroll
        for (int j = 0; j < 4; ++j) run[j] += log_sigmoid(z[j]) * (1.f / 16.f);
        cs[i] = run;
    }
    *(LAS f32x4*)(tot + seg * 64 + 4 * cq) = run;
    __syncthreads();
    f32x4 off = (f32x4){0.f, 0.f, 0.f, 0.f}, total = (f32x4){0.f, 0.f, 0.f, 0.f};
    for (int sg = 0; sg < 32; ++sg) { const f32x4 tv = *(const LAS f32x4*)(tot + sg * 64 + 4 * cq); total += tv; if (sg < seg) off += tv; }
    unsigned kew[4][4];
    bf16* ACAT = (bf16*)(F.ws + WS_ACAT); bf16* KI = (bf16*)(F.ws + WS_KI); bf16* KET = (bf16*)(F.ws + WS_KET);
    float kprev[4];
#pragma unroll
    for (int i = 0; i < 8; ++i) {
        const size_t trow = (size_t)(t0 + i);
        const u32x2 qv = *(const u32x2*)(GQ + trow * GLA_QK + col0), kv = *(const u32x2*)(GK + trow * GLA_QK + col0);
        float q[4] = {__uint_as_float(qv.x << 16), __uint_as_float(qv.x & 0xffff0000u), __uint_as_float(qv.y << 16), __uint_as_float(qv.y & 0xffff0000u)};
        float k[4] = {__uint_as_float(kv.x << 16), __uint_as_float(kv.x & 0xffff0000u), __uint_as_float(kv.y << 16), __uint_as_float(kv.y & 0xffff0000u)};
        float qd[4], ki[4], ke[4];
#pragma unroll
        for (int j = 0; j < 4; ++j) { const float bc = cs[i][j] + off[j]; qd[j] = q[j] * 0.0625f * __expf(bc); ki[j] = k[j] * __expf(-bc); ke[j] = k[j] * __expf(total[j] - bc); }
        const size_t lrow = (size_t)nh * 256 + seg * 8 + i;
        u32x2 o; o.x = pk2(qd[0], qd[1]); o.y = pk2(qd[2], qd[3]); *(u32x2*)(ACAT + lrow * 512 + 256 + dk0) = o;
        o.x = pk2(ki[0], ki[1]); o.y = pk2(ki[2], ki[3]); *(u32x2*)(KI + lrow * 256 + dk0) = o;
        if (i & 1) {
#pragma unroll
            for (int j = 0; j < 4; ++j) kew[j][i >> 1] = pk2(kprev[j], ke[j]); }
        else {
#pragma unroll
            for (int j = 0; j < 4; ++j) kprev[j] = ke[j]; }
    }
#pragma unroll
    for (int j = 0; j < 4; ++j) *(u32x4*)(KET + ((size_t)nh * 256 + dk0 + j) * 256 + seg * 8) = (u32x4){kew[j][0], kew[j][1], kew[j][2], kew[j][3]};
    if (seg == 0) *(f32x4*)((float*)(F.ws + WS_DEC) + n * GLA_QK + col0) = (f32x4){__expf(total[0]), __expf(total[1]), __expf(total[2]), __expf(total[3])};
    __syncthreads();
}
__device__ __forceinline__ void gla_vt_unit(Frame& F, int n, int h, int g8) {
    const int tid = F.tid; const int nh = n * GLA_H + h;
    LAS bf16* tile = (LAS bf16*)F.lds;
    const bf16* GV = (const bf16*)(F.ws + WS_GV); bf16* BCAT = (bf16*)(F.ws + WS_BCAT);
#pragma unroll
    for (int ps = 0; ps < 4; ++ps) { const int row = (tid >> 3) + 64 * ps, ch = tid & 7;
        const u32x4 v = *(const u32x4*)(GV + (size_t)(n * 256 + row) * GLA_V + h * GLA_DV + g8 * 64 + ch * 8);
        *(LAS u32x2*)(tile + row * 72 + ch * 8) = (u32x2){v.x, v.y}; *(LAS u32x2*)(tile + row * 72 + ch * 8 + 4) = (u32x2){v.z, v.w}; }
    __syncthreads();
#pragma unroll
    for (int i = 0; i < 4; ++i) { const int g = tid + 512 * i, c = g & 63, tg = g >> 6; unsigned short e[8];
#pragma unroll
        for (int j = 0; j < 8; ++j) e[j] = tile[(tg * 8 + j) * 72 + c];
        u32x4 v; v.x = e[0] | ((unsigned)e[1] << 16); v.y = e[2] | ((unsigned)e[3] << 16); v.z = e[4] | ((unsigned)e[5] << 16); v.w = e[6] | ((unsigned)e[7] << 16);
        *(u32x4*)(BCAT + ((size_t)nh * 512 + g8 * 64 + c) * 512 + tg * 8) = v; }
    __syncthreads();
}
__device__ __forceinline__ void gla_scan(Frame& F) {
    const bf16* UT = (const bf16*)(F.ws + WS_UT); bf16* BCAT = (bf16*)(F.ws + WS_BCAT); const float* DEC = (const float*)(F.ws + WS_DEC);
    for (int idx = F.vcu * (NWAVES * 64) + F.tid; idx < GLA_H * GLA_DV * 64; idx += F.G * NWAVES * 64) {
        const int dk4 = (idx & 63) * 4, dv = (idx >> 6) & 511, h = idx >> 15;
        float s[4] = {0.f, 0.f, 0.f, 0.f};
#pragma unroll 8
        for (int n = 0; n < 32; ++n) {
            const size_t nh = (size_t)n * GLA_H + h;
            u32x2 o; o.x = pk2(s[0], s[1]); o.y = pk2(s[2], s[3]); *(u32x2*)(BCAT + (nh * 512 + dv) * 512 + 256 + dk4) = o;
            const u32x2 uv = *(const u32x2*)(UT + (nh * 512 + dv) * 256 + dk4); const f32x4 dc = *(const f32x4*)(DEC + n * GLA_QK + h * GLA_DK + dk4);
            s[0] = s[0] * dc.x + __uint_as_float(uv.x << 16); s[1] = s[1] * dc.y + __uint_as_float(uv.x & 0xffff0000u);
            s[2] = s[2] * dc.z + __uint_as_float(uv.y << 16); s[3] = s[3] * dc.w + __uint_as_float(uv.y & 0xffff0000u);
        }
    }
}
__device__ __forceinline__ void gla_norm(Frame& F, const Args& a) {
    const int gw = F.vcu * NWAVES + F.wave, NGW = F.G * NWAVES, lane = F.lane;
    const bf16* OB = (const bf16*)(F.ws + WS_OB); const bf16* GR = (const bf16*)(F.ws + WS_GR); bf16* YG = (bf16*)(F.ws + WS_YG); const float* g = a.in[5];
    const f32x4 g0 = *(const f32x4*)(g + 8 * lane), g1 = *(const f32x4*)(g + 8 * lane + 4);
    for (int wi = gw; wi < S * GLA_H; wi += NGW) {
        const size_t off = (size_t)(wi >> 2) * GLA_V + (wi & 3) * GLA_DV + 8 * lane;
        const u32x4 ov = *(const u32x4*)(OB + off), rv = *(const u32x4*)(GR + off);
        float o[8], r[8]; float ss = 0.f;
#pragma unroll
        for (int j = 0; j < 4; ++j) { o[2 * j] = __uint_as_float(ov[j] << 16); o[2 * j + 1] = __uint_as_float(ov[j] & 0xffff0000u); r[2 * j] = __uint_as_float(rv[j] << 16); r[2 * j + 1] = __uint_as_float(rv[j] & 0xffff0000u); }
#pragma unroll
        for (int j = 0; j < 8; ++j) ss += o[j] * o[j];
        const float rstd = rsqrtf(wave_sum(ss) * (1.f / GLA_DV) + 1e-6f);
        u32x4 w; w.x = pk2(o[0] * rstd * g0.x * r[0], o[1] * rstd * g0.y * r[1]); w.y = pk2(o[2] * rstd * g0.z * r[2], o[3] * rstd * g0.w * r[3]);
        w.z = pk2(o[4] * rstd * g1.x * r[4], o[5] * rstd * g1.y * r[5]); w.w = pk2(o[6] * rstd * g1.z * r[6], o[7] * rstd * g1.w * r[7]);
        *(u32x4*)(YG + off) = w;
    }
}

__global__ void __launch_bounds__(NWAVES * 64, 2) fwd(Args args) {
    extern __shared__ __attribute__((aligned(16))) unsigned char lds_raw[];
    Frame F;
    F.lds = (LAS unsigned char*)lds_raw; F.MISC = (volatile LAS unsigned*)(F.lds + MISC_OFF);
    F.tid = threadIdx.x; F.lane = F.tid & 63; F.wave = __builtin_amdgcn_readfirstlane(F.tid >> 6);
    F.G = gridDim.x; { const int bx = blockIdx.x; F.vcu = (F.G % 8 == 0) ? (bx % 8) * (F.G / 8) + bx / 8 : bx; }
    F.ws = args.ws; F.ctl = (unsigned*)(args.ws + WS_CTL);
    for (int u = F.tid; u < (LDS_BYTES - RING_BYTES) / 4; u += NWAVES * 64) ((LAS unsigned*)(F.lds + RING_BYTES))[u] = 0u;
    __syncthreads();
    XcdBarrier bar = xcd_barrier_post(F.ctl + CW_BAR + args.li * XCD_BAR_WORDS, F.MISC + 8);
    const int lo = args.ph_lo, hi = args.ph_hi;
#define IN(k) (lo <= (k) && (k) < hi)
#define SEAM(k) do { if (IN(k) && IN((k) + 1)) xcd_barrier(bar); } while (0)
    unsigned char* ws = args.ws;
#ifndef DUP_MASK
#define DUP_MASK 0
#endif
#define DUP(k) ((DUP_MASK >> (k)) & 1)
#define PHASE(k, ...) do { if (IN(k)) { __VA_ARGS__ if (DUP(k)) { xcd_barrier(bar); __VA_ARGS__ } } SEAM(k); } while (0)
    const int gcus = (F.G == 256) ? GEMM_CUS : F.G;
    PHASE(0, { p0_convert(F, args, 0, gcus < F.G ? P0_I_SMALL : P0_NITEMS, F.vcu * NWAVES + F.wave, F.G * NWAVES); p0_rows(F, args); });
    PHASE(1, { if ((int)blockIdx.x < gcus) { pg8::DenseSched Sc; Sc.init(ws + WS_XN, ws + WS_WIN, S, NPROJ, D, gcus, (int)blockIdx.x); pg8::EpiProj E{ws, args.in[9]};
            pg8::gemm_phase<pg8::EpiProj, pg8::DenseSched>(F.lds, D, D, D, Sc, E); }
        else p0_convert(F, args, P0_I_SMALL, P0_NITEMS, ((int)blockIdx.x - gcus) * NWAVES + F.wave, (F.G - gcus) * NWAVES); });
    PHASE(2, { for (int u = F.vcu; u < NCH * ATT_H; u += F.G) attn_prep_unit(F, args, u >> 3, u & 7);
        for (int u = F.vcu; u < 32 * 16; u += F.G) gla_prep_unit(F, args, u >> 4, u & 15);
        for (int u = F.vcu; u < 32 * GLA_H * 8; u += F.G) gla_vt_unit(F, u >> 5, (u >> 3) & 3, u & 7); });
    PHASE(3, { for (int u = F.vcu; u < (NCH / 4) * ATT_H; u += F.G) attn_unit(F, args, u >> 3, u & 7);
        { pg8::GlaSched Sc{0, F.G, F.G - 1 - (int)blockIdx.x, ws}; pg8::EpiGla<0> E{ws}; pg8::gemm_phase<pg8::EpiGla<0>, pg8::GlaSched>(F.lds, 256, 512, 256, Sc, E); }
        { pg8::GlaSched Sc{1, F.G, (int)blockIdx.x, ws}; pg8::EpiGla<1> E{ws}; pg8::gemm_phase<pg8::EpiGla<1>, pg8::GlaSched>(F.lds, 256, 512, 256, Sc, E); } });
    PHASE(4, { gla_scan(F); });
    PHASE(5, { pg8::GlaSched Sc{2, F.G, (int)blockIdx.x, ws}; pg8::EpiGla<2> E{ws}; pg8::gemm_phase<pg8::EpiGla<2>, pg8::GlaSched>(F.lds, 512, 512, 512, Sc, E); });
    PHASE(6, { gla_norm(F, args); });
    PHASE(7, { pg8::DenseSched Sc; Sc.init(ws + WS_YG, ws + WS_WBG, S, D, GLA_V, F.G, (int)blockIdx.x); pg8::EpiBranch<0> E{(const bf16*)(ws + WS_SG), nullptr, (bf16*)(ws + WS_T)};
        pg8::gemm_phase<pg8::EpiBranch<0>, pg8::DenseSched>(F.lds, GLA_V, GLA_V, GLA_V, Sc, E); });
    PHASE(8, { pg8::DenseSched Sc; Sc.init(ws + WS_YA, ws + WS_WBA, S, D, ATT_W, F.G, (int)blockIdx.x); pg8::EpiBranch<1> E{(const bf16*)(ws + WS_SA), (const bf16*)(ws + WS_T), (bf16*)(ws + WS_MG)};
        pg8::gemm_phase<pg8::EpiBranch<1>, pg8::DenseSched>(F.lds, ATT_W, ATT_W, ATT_W, Sc, E); });
    PHASE(9, { pg8::DenseSched Sc; Sc.init(ws + WS_MG, ws + WS_WOUT, S, D, D, F.G, (int)blockIdx.x); pg8::EpiResid E{args.in[0], args.out};
        pg8::gemm_phase<pg8::EpiResid, pg8::DenseSched>(F.lds, D, D, D, Sc, E); });
    PHASE(10, { for (int u = F.vcu; u < S / 32; u += F.G) router_unit(F, args, u); });
    PHASE(11, { moe_table(F); p7_gather(F); });
    PHASE(12, { moe_table(F); pg8::MoeSched Sc; Sc.init(ws + WS_HNG, ws + WS_GU, (volatile LAS int*)(F.lds + TAB_OFF), (volatile LAS int*)(F.lds + TAB_OFF + 256), 16, D, F.G, (int)blockIdx.x);
        pg8::EpiSwiglu E{args.in[17], args.in[19], (bf16*)(ws + WS_HD)};
        pg8::gemm_phase<pg8::EpiSwiglu, pg8::MoeSched>(F.lds, D, D, D, Sc, E); });
    PHASE(13, { moe_table(F); pg8::MoeSched Sc; Sc.init(ws + WS_HD, ws + WS_DN, (volatile LAS int*)(F.lds + TAB_OFF), (volatile LAS int*)(F.lds + TAB_OFF + 256), 8, DFF, F.G, (int)blockIdx.x);
        pg8::EpiDown E{args.in[21], (const int*)(ws + WS_RPAIR), (const float*)(ws + WS_RW), (bf16*)(ws + WS_PY)};
        pg8::gemm_phase<pg8::EpiDown, pg8::MoeSched>(F.lds, DFF, DFF, DFF, Sc, E); });
    PHASE(14, { p10_combine(F, args); });
#undef PHASE
#undef IN
#undef SEAM
}

extern "C" void kernel_launch(void* const* d_in, const int* in_sizes, int n_in, void* d_out, int out_size, void* d_ws, size_t ws_size, hipStream_t stream) {
    static int grid = 0;
    if (grid == 0) {
        if (n_in != 22 || out_size != S * D || ws_size < WS_END) { fprintf(stderr, "kernel_launch: unexpected problem (n_in %d out %d ws %zu)\n", n_in, out_size, ws_size); grid = -1; return; }
        int dev = 0, cus = 0, per_cu = 0;
        if (hipGetDevice(&dev) != hipSuccess || hipDeviceGetAttribute(&cus, hipDeviceAttributeMultiprocessorCount, dev) != hipSuccess) { grid = -1; return; }
        if (hipFuncSetAttribute((const void*)fwd, hipFuncAttributeMaxDynamicSharedMemorySize, LDS_BYTES) != hipSuccess) { fprintf(stderr, "kernel_launch: hipFuncSetAttribute failed\n"); grid = -1; return; }
        if (hipOccupancyMaxActiveBlocksPerMultiprocessor(&per_cu, (const void*)fwd, NWAVES * 64, LDS_BYTES) != hipSuccess || per_cu < 1) fprintf(stderr, "kernel_launch: occupancy query says %d\n", per_cu);
        (void)hipGetLastError();
        grid = cus;
    }
    if (grid < 0) return;
    (void)hipMemsetAsync((char*)d_ws + WS_CTL, 0, CTL_ZERO_BYTES, stream);
    Args a{};
    for (int i = 0; i < 22; ++i) a.in[i] = (const float*)d_in[i];
    a.out = (float*)d_out; a.ws = (unsigned char*)d_ws;
    a.ph_lo = 0; a.ph_hi = 15; a.li = 0;
    hipLaunchKernelGGL(fwd, dim3(grid), dim3(NWAVES * 64), LDS_BYTES, stream, a);
}
```

```cpp
#include <hip/hip_runtime.h>
#include <stdint.h>
#include <cstdio>

constexpr int S = 8192, D = 2048;
constexpr int GLA_H = 4, GLA_DK = 256, GLA_DV = 512, GLA_QK = 1024, GLA_V = 2048;
constexpr int ATT_H = 8, ATT_HD = 128, ATT_W = 1024, NCH = S / 64;
constexpr int NE = 32, DFF = 2048;
constexpr int IN_COLS = 13328, C_GLR = 6144;
constexpr int NPROJ = 13312;
constexpr int MAXROWS = 32768 + NE * 256;

constexpr size_t MiB = 1u << 20;
constexpr size_t WS_CTL = 0, CTL_ZERO_BYTES = 1 * MiB;
constexpr size_t WS_TOPW = 1 * MiB, WS_TOPE = WS_TOPW + 128 * 1024, WS_TOPS = WS_TOPE + 128 * 1024, WS_RPAIR = WS_TOPS + 128 * 1024, WS_RW = WS_RPAIR + 256 * 1024;
constexpr size_t WS_GLR = 2 * MiB, WS_WR = 3 * MiB;
constexpr size_t WS_WIN = 8 * MiB, WS_WBG = 60 * MiB, WS_WBA = 68 * MiB, WS_WOUT = 72 * MiB, WS_GU = 80 * MiB, WS_DN = 592 * MiB;
constexpr size_t WS_XN = 848 * MiB, WS_GQ = 880 * MiB, WS_GK = 896 * MiB, WS_GV = 912 * MiB, WS_GR = 944 * MiB, WS_AQ = 976 * MiB, WS_AK = 992 * MiB, WS_AV = 1008 * MiB;
constexpr size_t WS_SG = 1024 * MiB, WS_SA = 1056 * MiB, WS_YG = 1088 * MiB, WS_YA = 1120 * MiB, WS_T = 1136 * MiB, WS_MG = 1168 * MiB, WS_HN = 1200 * MiB;
constexpr size_t WS_HNG = 1232 * MiB, WS_HD = 1392 * MiB, WS_PY = 1552 * MiB, WS_QH = 1681 * MiB, WS_KIMG = 1697 * MiB, WS_VIMG = 1713 * MiB;
constexpr size_t WS_ACAT = 1729 * MiB, WS_BCAT = 1761 * MiB, WS_KI = 1825 * MiB, WS_KET = 1841 * MiB, WS_UT = 1857 * MiB, WS_DEC = 1889 * MiB, WS_OB = 1890 * MiB, WS_H1 = 1922 * MiB, WS_END = 1986 * MiB;
constexpr int CW_CNT = 256;
constexpr int CW_BAR = 4096;

typedef unsigned short bf16;
typedef short bf16x8 __attribute__((ext_vector_type(8)));
typedef float f32x4 __attribute__((ext_vector_type(4)));
typedef float f32x16 __attribute__((ext_vector_type(16)));
typedef unsigned u32x4 __attribute__((ext_vector_type(4)));
typedef unsigned u32x2 __attribute__((ext_vector_type(2)));
#define LAS __attribute__((address_space(3)))
#define GAS __attribute__((address_space(1)))
__device__ __forceinline__ float bf2f(bf16 v) { return __uint_as_float((unsigned)v << 16); }
__device__ __forceinline__ unsigned f2bf(float f) { unsigned u = __float_as_uint(f); return (u + 0x7fffu + ((u >> 16) & 1u)) >> 16; }
__device__ __forceinline__ unsigned pk2(float lo, float hi) { return f2bf(lo) | (f2bf(hi) << 16); }
__device__ __forceinline__ unsigned cvt_pk_bf16(float lo, float hi) { unsigned r; asm volatile("v_cvt_pk_bf16_f32 %0, %1, %2" : "=v"(r) : "v"(lo), "v"(hi)); return r; }
__device__ __forceinline__ float wave_sum(float v) {
#pragma unroll
    for (int o = 1; o < 64; o <<= 1) v += __shfl_xor(v, o);
    return v;
}
__device__ __forceinline__ float sigmoidf_(float x) { return 1.f / (1.f + __expf(-x)); }
__device__ __forceinline__ float log_sigmoid(float z) { return fminf(z, 0.f) - log1pf(__expf(-fabsf(z))); }
#define LDS_WAIT() asm volatile("s_waitcnt lgkmcnt(0)" ::: "memory")
#define VM_WAIT() asm volatile("s_waitcnt vmcnt(0)" ::: "memory")

#define XB_TMO      128
#define XB_XCNT(j)  (256  + 64 * (j))
#define XB_XSUB(j)  (1280 + 64 * (j))
#define XB_XGEN(j)  (2304 + 64 * (j))
#define XB_TOP      3328
#define XB_TOPGEN   3392
#define XCD_BAR_WORDS 3456
#define XB_SPIN_CAP (1u << 18)
__device__ __forceinline__ unsigned xb_ld(unsigned* p)              { return __hip_atomic_load(p, __ATOMIC_RELAXED, __HIP_MEMORY_SCOPE_AGENT); }
__device__ __forceinline__ unsigned xb_add(unsigned* p, unsigned v) { return __hip_atomic_fetch_add(p, v, __ATOMIC_RELAXED, __HIP_MEMORY_SCOPE_AGENT); }
__device__ __forceinline__ unsigned xb_xcc_id() { return (unsigned)__builtin_amdgcn_s_getreg((3 << 11) | 20) & 0xFu; }
#define XB_SPIN(cond, bar) do { unsigned _sp = 0; while (cond) { __builtin_amdgcn_s_sleep(1); \
    if ((++_sp & 255u) == 0u) { if (xb_ld(&(bar)[XB_TMO])) break; if (_sp > XB_SPIN_CAP) { atomicAdd(&(bar)[XB_TMO], 1u); break; } } } } while (0)
struct XcdBarrier { unsigned* bar; unsigned x; volatile LAS unsigned* st; };
__device__ __forceinline__ XcdBarrier xcd_barrier_post(unsigned* bar, volatile LAS unsigned* st) {
    XcdBarrier b; b.bar = bar; b.x = xb_xcc_id(); b.st = st;
    if (threadIdx.x == 0) (void)xb_add(&bar[XB_XCNT(b.x)], 1u);
    return b;
}
__device__ __forceinline__ void xcd_barrier_complete(unsigned* bar, unsigned x, unsigned& nloc, unsigned& nx) {
    const unsigned G = gridDim.x * gridDim.y * gridDim.z;
    unsigned sum, cnt, mine, sp = 0u;
    for (;;) {
        sum = 0u; cnt = 0u; mine = 0u;
#pragma unroll
        for (unsigned j = 0; j < 16; ++j) { const unsigned c = xb_ld(&bar[XB_XCNT(j)]); sum += c; cnt += (c > 0u) ? 1u : 0u; mine = (j == x) ? c : mine; }
        if (sum == G) break;
        __builtin_amdgcn_s_sleep(1);
        if ((++sp & 255u) == 0u) { if (xb_ld(&bar[XB_TMO])) break; if (sp > XB_SPIN_CAP) { atomicAdd(&bar[XB_TMO], 1u); break; } }
    }
    nloc = mine > 0u ? mine : 1u; nx = cnt > 0u ? cnt : 1u;
}
__device__ __forceinline__ void xcd_barrier(const XcdBarrier& b) {
    asm volatile("s_waitcnt vmcnt(0)" ::: "memory");
    __syncthreads();
    if (threadIdx.x == 0) {
        unsigned* bar = b.bar;
        __builtin_amdgcn_s_waitcnt(0);
        unsigned nloc = b.st[0], nx = b.st[1];
        if (nloc == 0u) { xcd_barrier_complete(bar, b.x, nloc, nx); b.st[0] = nloc; b.st[1] = nx; }
        const unsigned old = xb_add(&bar[XB_XSUB(b.x)], 1u);
        const unsigned gen = old / nloc;
        if (old + 1u == (gen + 1u) * nloc) {
            __builtin_amdgcn_fence(__ATOMIC_RELEASE, "agent");
            asm volatile("s_waitcnt vmcnt(0)" ::: "memory");
            const unsigned og = xb_add(&bar[XB_TOP], 1u);
            const unsigned tg = og / nx;
            if (og + 1u == (tg + 1u) * nx) xb_add(&bar[XB_TOPGEN], 1u);
            else XB_SPIN(xb_ld(&bar[XB_TOPGEN]) == tg, bar);
            __builtin_amdgcn_fence(__ATOMIC_ACQUIRE, "agent");
            xb_add(&bar[XB_XGEN(b.x)], 1u);
            asm volatile("s_waitcnt vmcnt(0)" ::: "memory");
        } else {
            XB_SPIN(xb_ld(&bar[XB_XGEN(b.x)]) == gen, bar);
            __builtin_amdgcn_fence(__ATOMIC_ACQUIRE, "agent");
            asm volatile("s_waitcnt vmcnt(0)" ::: "memory");
        }
    }
    __syncthreads();
}

namespace pg8 {
constexpr int BM = 256, BK = 64, HALF = 128, HTB = HALF * BK * 2, STAGE_BYTES = 8 * HTB, NXCD = 8, WGM = 8;
__host__ __device__ __forceinline__ int lds_byte(int r, int c) { const int st = (r >> 4) * 2 + (c >> 5), rr = r & 15, cc = c & 31, ob = rr * 64 + cc * 2; return st * 1024 + (ob ^ (((ob >> 9) & 1) << 5)); }
__host__ __device__ __forceinline__ void stage_rc(int b, int& R, int& C) { const int st = b / 1024, sb = b % 1024, swz = sb ^ (((sb >> 9) & 1) << 5); R = (st >> 1) * 16 + swz / 64; C = (st & 1) * 32 + (swz % 64) / 2; }
__host__ __device__ __forceinline__ int perm32(int rho) { const int n = rho >> 4, i = rho & 15; return 8 * (i >> 2) + 4 * n + (i & 3); }
__device__ __forceinline__ int xcd_remap(int wgid, int nwg) { const int q = nwg / NXCD, r = nwg % NXCD, xcd = wgid % NXCD, off = wgid / NXCD; return (xcd < r ? xcd * (q + 1) : r * (q + 1) + (xcd - r) * q) + off; }

struct Unit { const char* A; const char* B; int pm, pn, e, nrow; };

struct DenseSched {
    const char* A; const char* Bt; int nM, nN, nwg, G, c; size_t tstep;
    __device__ __forceinline__ void init(const void* A_, const void* Bt_, int M, int N, int K, int G_, int c_) { A = (const char*)A_; Bt = (const char*)Bt_; nM = M / BM; nN = N / BM; nwg = nM * nN; G = G_; c = c_; tstep = (size_t)BM * K * 2; }
    __device__ __forceinline__ bool next(int i, Unit& u) const {
        const long L = (long)i * G + c; if (L >= nwg) return false;
        const int wgid = xcd_remap((int)L, nwg);
        const int nig = WGM * nN, gid = wgid / nig, fm = gid * WGM, gsz = (nM - fm) < WGM ? (nM - fm) : WGM;
        u.pm = fm + ((wgid % nig) % gsz); u.pn = (wgid % nig) / gsz; u.e = 0; u.nrow = BM;
        u.A = A + (size_t)u.pm * tstep; u.B = Bt + (size_t)u.pn * tstep; return true;
    }
};
struct MoeSched {
    const char* A; const char* Bt; const volatile LAS int* tstart; const volatile LAS int* cnt; int NT, nwg, G, c; size_t tstep;
    __device__ __forceinline__ void init(const void* A_, const void* Bt_, const volatile LAS int* ts, const volatile LAS int* cn, int NT_, int K, int G_, int c_) {
        A = (const char*)A_; Bt = (const char*)Bt_; tstart = ts; cnt = cn; NT = NT_; nwg = ts[NE] * NT_; G = G_; c = c_; tstep = (size_t)BM * K * 2; }
    __device__ __forceinline__ bool next(int i, Unit& u) const {
        const long L = (long)i * G + c; if (L >= nwg) return false;
        const int wgid = xcd_remap((int)L, nwg);
        int e = 0;
#pragma unroll 1
        for (int j = 1; j < NE; ++j) e = (wgid >= tstart[j] * NT) ? j : e;
        const int t0 = tstart[e], nte = tstart[e + 1] - t0, local = wgid - t0 * NT;
        const int pn = local / nte, mt = local - pn * nte;
        u.e = e; u.pn = pn; u.pm = t0 + mt; u.nrow = cnt[e] - mt * BM;
        u.A = A + (size_t)u.pm * tstep; u.B = Bt + (size_t)(e * NT + pn) * tstep; return true;
    }
};

template <class Epi, class Sched, bool BGRAN = false>
__device__ __forceinline__ void gemm_phase(LAS unsigned char* lds, const int K, const int lda, const int ldb, const Sched& S, const Epi& E) {
    const int tid = threadIdx.x, wid = __builtin_amdgcn_readfirstlane(tid >> 6), lane = tid & 63, wr = wid >> 2, wc = wid & 3, fr = lane & 15, fq = lane >> 4;
    int nt = K / BK; asm volatile("" : "+s"(nt));
    unsigned voffA[2], voffB[2];
#pragma unroll
    for (int i = 0; i < 2; ++i) { int R, C; stage_rc(tid * 16 + i * 8192, R, C); const int Rb = Epi::PERM ? ((R & ~31) + perm32(R & 31)) : R;
        voffA[i] = (unsigned)(R * lda + C) * 2u; voffB[i] = BGRAN ? (unsigned)((C >> 3) * ldb + Rb) * 16u : (unsigned)(Rb * ldb + C) * 2u; }
    const size_t kstep = (size_t)(BK * 2), kstepB = BGRAN ? (size_t)ldb * 128 : (size_t)(BK * 2);
    const size_t hstepA = (size_t)HALF * lda * 2, hstepB = BGRAN ? (size_t)2048 : (size_t)HALF * ldb * 2;
    const unsigned ldsw = (unsigned)wid * 1024u;
    const int aoff = lds_byte(wr * 64 + fr, fq * 8), boff = lds_byte(wc * 32 + fr, fq * 8);
#define PG8_SA(b, h) (((b) * 2 + (h)) * HTB)
#define PG8_SB(b, h) ((4 + (b) * 2 + (h)) * HTB)
#define PG8_STAGE(bufoff, gbase, voff) do { _Pragma("unroll") for (int _i = 0; _i < 2; ++_i) \
        __builtin_amdgcn_global_load_lds((const unsigned*)((const char*)(gbase) + (voff)[_i]), (LAS unsigned*)(lds + (bufoff) + ldsw + _i * 8192), 16, 0, 0); } while (0)
#define PG8_LDA(dst, b, h) do { _Pragma("unroll") for (int m = 0; m < 4; ++m) _Pragma("unroll") for (int k = 0; k < 2; ++k) dst[m][k] = *(const LAS bf16x8*)(lds + PG8_SA(b, h) + aoff + m * 2048 + k * 1024); } while (0)
#define PG8_LDB(dst, b, h) do { _Pragma("unroll") for (int n = 0; n < 2; ++n) _Pragma("unroll") for (int k = 0; k < 2; ++k) dst[n][k] = *(const LAS bf16x8*)(lds + PG8_SB(b, h) + boff + n * 2048 + k * 1024); } while (0)
#define PG8_MMA(ai, bj, At, Bt) do { __builtin_amdgcn_s_setprio(1); _Pragma("unroll") for (int m = 0; m < 4; ++m) _Pragma("unroll") for (int n = 0; n < 2; ++n) _Pragma("unroll") for (int k = 0; k < 2; ++k) \
        acc[ai][bj][m][n] = __builtin_amdgcn_mfma_f32_16x16x32_bf16(Bt[n][k], At[m][k], acc[ai][bj][m][n], 0, 0, 0); __builtin_amdgcn_s_setprio(0); } while (0)
#define PG8_WAIT_V(n) asm volatile("s_waitcnt vmcnt(" #n ")" ::: "memory")
#define PG8_WAIT_L(n) asm volatile("s_waitcnt lgkmcnt(" #n ")" ::: "memory")
#define PG8_BAR __builtin_amdgcn_s_barrier()
#define PG8_SCHED __builtin_amdgcn_sched_barrier(0)
    Unit cur, nxt; int ui = 0;
    if (!S.next(0, cur)) return;
    f32x4 acc[2][2][4][2];
#pragma unroll
    for (int a = 0; a < 2; ++a)
#pragma unroll
        for (int b = 0; b < 2; ++b)
#pragma unroll
            for (int m = 0; m < 4; ++m)
#pragma unroll
                for (int n = 0; n < 2; ++n) acc[a][b][m][n] = (f32x4){0.f, 0.f, 0.f, 0.f};
    bf16x8 At[4][2], B0[2][2], B1[2][2];
    const char* cA = cur.A; const char* cB = cur.B;
    PG8_STAGE(PG8_SB(0, 0), cB, voffB); PG8_STAGE(PG8_SB(0, 1), cB + hstepB, voffB); PG8_STAGE(PG8_SA(0, 0), cA, voffA); PG8_STAGE(PG8_SA(0, 1), cA + hstepA, voffA);
    if (wr == 1) PG8_BAR;
    PG8_WAIT_V(2); PG8_BAR;
    PG8_STAGE(PG8_SB(1, 0), cB + kstepB, voffB); PG8_STAGE(PG8_SA(1, 0), cA + kstep, voffA); PG8_STAGE(PG8_SB(1, 1), cB + hstepB + kstepB, voffB);
    PG8_WAIT_V(6); PG8_BAR;
    for (;;) {
        const bool has_next = S.next(ui + 1, nxt);
        const char* nA = has_next ? nxt.A : cA; const char* nB = has_next ? nxt.B : cB;
#pragma unroll 1
        for (int t = 0; t < nt; t += 2) {
            const bool last = (t == nt - 2);
            const char* a1 = cA + (size_t)(t + 1) * kstep;
            const char* a2 = last ? nA : cA + (size_t)(t + 2) * kstep; const char* b2 = last ? nB : cB + (size_t)(t + 2) * kstepB;
            const char* a3 = a2 + kstep; const char* b3 = b2 + kstepB;
            PG8_LDB(B0, 0, 0); PG8_LDB(B1, 0, 1); PG8_SCHED; PG8_LDA(At, 0, 0); PG8_STAGE(PG8_SA(1, 1), a1 + hstepA, voffA);
            PG8_WAIT_V(8); PG8_WAIT_L(0); PG8_BAR; PG8_MMA(0, 0, At, B0); PG8_MMA(0, 1, At, B1); PG8_BAR; PG8_SCHED;
            PG8_LDA(At, 0, 1); PG8_STAGE(PG8_SB(0, 0), b2, voffB); PG8_STAGE(PG8_SB(0, 1), b2 + hstepB, voffB); PG8_STAGE(PG8_SA(0, 0), a2, voffA);
            PG8_WAIT_V(8); PG8_WAIT_L(0); PG8_BAR; PG8_MMA(1, 0, At, B0); PG8_MMA(1, 1, At, B1); PG8_BAR; PG8_SCHED;
            PG8_LDB(B0, 1, 0); PG8_LDB(B1, 1, 1); PG8_SCHED; PG8_LDA(At, 1, 0); PG8_STAGE(PG8_SA(0, 1), a2 + hstepA, voffA);
            PG8_WAIT_V(8); PG8_WAIT_L(0); PG8_BAR; PG8_MMA(0, 0, At, B0); PG8_MMA(0, 1, At, B1); PG8_BAR; PG8_SCHED;
            PG8_LDA(At, 1, 1); PG8_STAGE(PG8_SB(1, 0), b3, voffB); PG8_STAGE(PG8_SB(1, 1), b3 + hstepB, voffB); PG8_STAGE(PG8_SA(1, 0), a3, voffA);
            PG8_WAIT_V(8); PG8_WAIT_L(0); PG8_BAR; PG8_MMA(1, 0, At, B0); PG8_MMA(1, 1, At, B1); PG8_BAR; PG8_SCHED;
        }
        if (wr == 0) PG8_BAR;
        E(acc, cur, wr, wc, fr, fq);
        if (!has_next) break;
#pragma unroll
        for (int a = 0; a < 2; ++a)
#pragma unroll
            for (int b = 0; b < 2; ++b)
#pragma unroll
                for (int m = 0; m < 4; ++m)
#pragma unroll
                    for (int n = 0; n < 2; ++n) acc[a][b][m][n] = (f32x4){0.f, 0.f, 0.f, 0.f};
        cur = nxt; cA = nA; cB = nB; ++ui;
        if (wr == 1) PG8_BAR;
    }
    PG8_WAIT_V(0);
    PG8_BAR;
#undef PG8_SA
#undef PG8_SB
#undef PG8_STAGE
#undef PG8_LDA
#undef PG8_LDB
#undef PG8_MMA
#undef PG8_WAIT_V
#undef PG8_WAIT_L
#undef PG8_BAR
#undef PG8_SCHED
}

struct EpiProj {
    static constexpr bool PERM = true;
    unsigned char* ws; const float* bbg;
    __device__ __forceinline__ void operator()(const f32x4 (&acc)[2][2][4][2], const Unit& u, int wr, int wc, int fr, int fq) const {
        const int pn = u.pn; size_t off; int ld, t0, act = 0;
        if (pn < 4) { off = WS_GQ; ld = 1024; t0 = 0; } else if (pn < 8) { off = WS_GK; ld = 1024; t0 = 4; } else if (pn < 16) { off = WS_GV; ld = 2048; t0 = 8; }
        else if (pn < 24) { off = WS_GR; ld = 2048; t0 = 16; act = 1; } else if (pn < 28) { off = WS_AQ; ld = 1024; t0 = 24; } else if (pn < 32) { off = WS_AK; ld = 1024; t0 = 28; }
        else if (pn < 36) { off = WS_AV; ld = 1024; t0 = 32; } else if (pn < 44) { off = WS_SG; ld = 2048; t0 = 36; act = 2; } else { off = WS_SA; ld = 2048; t0 = 44; act = 3; }
        bf16* base = (bf16*)(ws + off);
        const int colt = (pn - t0) * BM + wc * 32 + 8 * fq, row0 = u.pm * BM + wr * 64 + fr;
        f32x4 bv[2][2];
#pragma unroll
        for (int bj = 0; bj < 2; ++bj)
#pragma unroll
            for (int n = 0; n < 2; ++n) bv[bj][n] = act >= 2 ? *(const f32x4*)(bbg + (act - 2) * D + colt + bj * HALF + 4 * n) : (f32x4){0.f, 0.f, 0.f, 0.f};
#pragma unroll
        for (int ai = 0; ai < 2; ++ai)
#pragma unroll
            for (int m = 0; m < 4; ++m) { bf16* rowp = base + (size_t)(row0 + ai * HALF + m * 16) * ld + colt;
#pragma unroll
                for (int bj = 0; bj < 2; ++bj) { f32x4 v0 = acc[ai][bj][m][0] + bv[bj][0], v1 = acc[ai][bj][m][1] + bv[bj][1];
                    if (act == 1) {
#pragma unroll
                        for (int j = 0; j < 4; ++j) { v0[j] = v0[j] * sigmoidf_(v0[j]); v1[j] = v1[j] * sigmoidf_(v1[j]); } }
                    else if (act >= 2) {
#pragma unroll
                        for (int j = 0; j < 4; ++j) { v0[j] = sigmoidf_(v0[j]); v1[j] = sigmoidf_(v1[j]); } }
                    u32x4 w; w.x = cvt_pk_bf16(v0[0], v0[1]); w.y = cvt_pk_bf16(v0[2], v0[3]); w.z = cvt_pk_bf16(v1[0], v1[1]); w.w = cvt_pk_bf16(v1[2], v1[3]);
                    *(u32x4*)(rowp + bj * HALF) = w; } }
    }
};
template <int MODE> struct EpiBranch {
    static constexpr bool PERM = true;
    const bf16* gate; const bf16* tin; bf16* out;
    __device__ __forceinline__ void operator()(const f32x4 (&acc)[2][2][4][2], const Unit& u, int wr, int wc, int fr, int fq) const {
        const int colt = u.pn * BM + wc * 32 + 8 * fq, row0 = u.pm * BM + wr * 64 + fr;
#pragma unroll
        for (int ai = 0; ai < 2; ++ai)
#pragma unroll
            for (int m = 0; m < 4; ++m) { const size_t ro = (size_t)(row0 + ai * HALF + m * 16) * D + colt;
#pragma unroll
                for (int bj = 0; bj < 2; ++bj) {
                    const u32x4 gq = *(const u32x4*)(gate + ro + bj * HALF);
                    u32x4 tq = (u32x4){0u, 0u, 0u, 0u}; if (MODE == 1) tq = *(const u32x4*)(tin + ro + bj * HALF);
                    float r[8];
#pragma unroll
                    for (int j = 0; j < 4; ++j) { r[j] = acc[ai][bj][m][0][j]; r[4 + j] = acc[ai][bj][m][1][j]; }
#pragma unroll
                    for (int j = 0; j < 4; ++j) { const unsigned gw = gq[j], tw = tq[j];
                        r[2 * j] = r[2 * j] * __uint_as_float(gw << 16) + __uint_as_float(tw << 16);
                        r[2 * j + 1] = r[2 * j + 1] * __uint_as_float(gw & 0xffff0000u) + __uint_as_float(tw & 0xffff0000u); }
                    u32x4 w; w.x = cvt_pk_bf16(r[0], r[1]); w.y = cvt_pk_bf16(r[2], r[3]); w.z = cvt_pk_bf16(r[4], r[5]); w.w = cvt_pk_bf16(r[6], r[7]);
                    *(u32x4*)(out + ro + bj * HALF) = w; } }
    }
};
struct EpiResid {
    static constexpr bool PERM = false;
    const float* x; float* out;
    __device__ __forceinline__ void operator()(const f32x4 (&acc)[2][2][4][2], const Unit& u, int wr, int wc, int fr, int fq) const {
        const int col0 = u.pn * BM + wc * 32 + 4 * fq, row0 = u.pm * BM + wr * 64 + fr;
#pragma unroll
        for (int ai = 0; ai < 2; ++ai)
#pragma unroll
            for (int m = 0; m < 4; ++m) { const size_t ro = (size_t)(row0 + ai * HALF + m * 16) * D + col0;
#pragma unroll
                for (int bj = 0; bj < 2; ++bj)
#pragma unroll
                    for (int n = 0; n < 2; ++n) { const f32x4 xv = *(const f32x4*)(x + ro + bj * HALF + n * 16); *(f32x4*)(out + ro + bj * HALF + n * 16) = xv + acc[ai][bj][m][n]; } }
    }
};
struct EpiSwiglu {
    static constexpr bool PERM = true;
    const float* bgate; const float* bup; bf16* hd;
    __device__ __forceinline__ void operator()(const f32x4 (&acc)[2][2][4][2], const Unit& u, int wr, int wc, int fr, int fq) const {
        const int col = u.pn * HALF + wc * 32 + 8 * fq; const size_t row0 = (size_t)u.pm * BM + wr * 64 + fr;
        const float* bg = bgate + (size_t)u.e * DFF + col; const float* bu = bup + (size_t)u.e * DFF + col;
        const f32x4 g0 = *(const f32x4*)bg, g1 = *(const f32x4*)(bg + 4), u0 = *(const f32x4*)bu, u1 = *(const f32x4*)(bu + 4);
#pragma unroll
        for (int ai = 0; ai < 2; ++ai)
#pragma unroll
            for (int m = 0; m < 4; ++m) {
                float r[8];
#pragma unroll
                for (int j = 0; j < 4; ++j) {
                    const float ga = fminf(acc[ai][0][m][0][j] + g0[j], 7.f), ua = fminf(fmaxf(acc[ai][1][m][0][j] + u0[j], -7.f), 7.f);
                    const float gb = fminf(acc[ai][0][m][1][j] + g1[j], 7.f), ub = fminf(fmaxf(acc[ai][1][m][1][j] + u1[j], -7.f), 7.f);
                    r[j] = (ua + 1.f) * (ga * sigmoidf_(1.702f * ga)); r[4 + j] = (ub + 1.f) * (gb * sigmoidf_(1.702f * gb)); }
                u32x4 w; w.x = cvt_pk_bf16(r[0], r[1]); w.y = cvt_pk_bf16(r[2], r[3]); w.z = cvt_pk_bf16(r[4], r[5]); w.w = cvt_pk_bf16(r[6], r[7]);
                *(u32x4*)(hd + (row0 + ai * HALF + m * 16) * DFF + col) = w; }
    }
};
struct EpiDown {
    static constexpr bool PERM = true;
    const float* bdown; const int* rpair; const float* rw; bf16* py;
    __device__ __forceinline__ void operator()(const f32x4 (&acc)[2][2][4][2], const Unit& u, int wr, int wc, int fr, int fq) const {
        const int colt = u.pn * BM + wc * 32 + 8 * fq; const size_t srow0 = (size_t)u.pm * BM + wr * 64 + fr;
        f32x4 bv[2][2];
#pragma unroll
        for (int bj = 0; bj < 2; ++bj)
#pragma unroll
            for (int n = 0; n < 2; ++n) bv[bj][n] = *(const f32x4*)(bdown + (size_t)u.e * D + colt + bj * HALF + 4 * n);
#pragma unroll
        for (int ai = 0; ai < 2; ++ai)
#pragma unroll
            for (int m = 0; m < 4; ++m) { const size_t srow = srow0 + ai * HALF + m * 16; const int pair = rpair[srow]; const float wgt = rw[srow];
                bf16* rowp = py + (size_t)pair * D + colt;
#pragma unroll
                for (int bj = 0; bj < 2; ++bj) { const f32x4 v0 = (acc[ai][bj][m][0] + bv[bj][0]) * wgt, v1 = (acc[ai][bj][m][1] + bv[bj][1]) * wgt;
                    u32x4 w; w.x = cvt_pk_bf16(v0[0], v0[1]); w.y = cvt_pk_bf16(v0[2], v0[3]); w.z = cvt_pk_bf16(v1[0], v1[1]); w.w = cvt_pk_bf16(v1[2], v1[3]);
                    *(u32x4*)(rowp + bj * HALF) = w; } }
    }
};

struct GlaSched {
    int mode, G, c; unsigned char* ws;
    __device__ __forceinline__ bool next(int i, Unit& u) const {
        const int L = i * G + c; const int nu = mode == 0 ? 128 : 256; if (L >= nu) return false;
        const int nh = mode == 0 ? L : (L >> 1), hv = mode == 0 ? 0 : (L & 1);
        u.pm = nh; u.pn = hv; u.e = 0; u.nrow = BM;
        if (mode == 0) { u.A = (const char*)(ws + WS_ACAT) + (size_t)nh * 256 * 512 * 2 + 512; u.B = (const char*)(ws + WS_KI) + (size_t)nh * 256 * 256 * 2; }
        else if (mode == 1) { u.A = (const char*)(ws + WS_BCAT) + (size_t)nh * 512 * 512 * 2 + (size_t)hv * 256 * 512 * 2; u.B = (const char*)(ws + WS_KET) + (size_t)nh * 256 * 256 * 2; }
        else { u.A = (const char*)(ws + WS_ACAT) + (size_t)nh * 256 * 512 * 2; u.B = (const char*)(ws + WS_BCAT) + (size_t)nh * 512 * 512 * 2 + (size_t)hv * 256 * 512 * 2; }
        return true;
    }
};
template <int MODE> struct EpiGla {
    static constexpr bool PERM = true;
    unsigned char* ws;
    __device__ __forceinline__ void operator()(const f32x4 (&acc)[2][2][4][2], const Unit& u, int wr, int wc, int fr, int fq) const {
        const int nh = u.pm, hv = u.pn; const int c8 = wc * 32 + 8 * fq, r0 = wr * 64 + fr;
        bf16* base; int ld;
        if (MODE == 0) { base = (bf16*)(ws + WS_ACAT) + (size_t)nh * 256 * 512; ld = 512; }
        else if (MODE == 1) { base = (bf16*)(ws + WS_UT) + (size_t)nh * 512 * 256 + (size_t)hv * 256 * 256; ld = 256; }
        else { base = (bf16*)(ws + WS_OB) + (size_t)(nh >> 2) * 256 * GLA_V + (nh & 3) * GLA_DV + hv * 256; ld = GLA_V; }
#pragma unroll
        for (int ai = 0; ai < 2; ++ai)
#pragma unroll
            for (int m = 0; m < 4; ++m) { const int row = r0 + ai * HALF + m * 16;
#pragma unroll
                for (int bj = 0; bj < 2; ++bj) { f32x4 v0 = acc[ai][bj][m][0], v1 = acc[ai][bj][m][1]; const int col = bj * HALF + c8;
                    if (MODE == 0) {
#pragma unroll
                        for (int j = 0; j < 4; ++j) { v0[j] = (col + j <= row) ? v0[j] : 0.f; v1[j] = (col + 4 + j <= row) ? v1[j] : 0.f; } }
                    u32x4 w; w.x = cvt_pk_bf16(v0[0], v0[1]); w.y = cvt_pk_bf16(v0[2], v0[3]); w.z = cvt_pk_bf16(v1[0], v1[1]); w.w = cvt_pk_bf16(v1[2], v1[3]);
                    *(u32x4*)(base + (size_t)row * ld + col) = w; } }
    }
};
}

constexpr int NWAVES = 8;
#ifndef GEMM_CUS
#define GEMM_CUS 152
#endif
constexpr int RING_BYTES = 131072, CTLZ_OFF = 139264, MISC_OFF = CTLZ_OFF + 320, LDS_BYTES = 147456;
constexpr int TAB_OFF = MISC_OFF + 128;

struct Frame {
    LAS unsigned char* lds; volatile LAS unsigned* MISC; unsigned* ctl; unsigned char* ws;
    int tid, lane, wave, vcu, G;
};
struct Args { const float* in[22]; float* out; unsigned char* ws; int ph_lo, ph_hi, li, pad; };

struct P0Item { const float* src; bf16* dst; int ldn, K; };
constexpr int P0_I_IN = 32 * (NPROJ / 32), P0_I_BG = 32 * 64, P0_I_BA = 16 * 64, P0_I_OUT = 32 * 64, P0_I_E = 32 * 64;
constexpr int P0_I_SMALL = P0_I_IN + P0_I_BG + P0_I_BA + P0_I_OUT, P0_NITEMS = P0_I_SMALL + 3 * NE * P0_I_E;
__device__ __forceinline__ P0Item p0_decode(Frame& F, const Args& a, int r) {
    constexpr int I_IN = P0_I_IN, I_BG = P0_I_BG, I_BA = P0_I_BA, I_OUT = P0_I_OUT, I_E = P0_I_E, I_MOE = NE * I_E;
    P0Item it;
    if (r < I_IN) { const int nb = r % (NPROJ / 32), kb = r / (NPROJ / 32), d0 = nb * 32, s0 = d0 < C_GLR ? d0 : d0 + 16;
        it.src = a.in[2] + (size_t)kb * 64 * IN_COLS + s0; it.ldn = IN_COLS; it.dst = (bf16*)(F.ws + WS_WIN) + (size_t)d0 * D + kb * 64; it.K = D; return it; } r -= I_IN;
    if (r < I_BG) { const int nb = r % 64, kb = r / 64; it.src = a.in[10] + (size_t)kb * 64 * D + nb * 32; it.ldn = D; it.dst = (bf16*)(F.ws + WS_WBG) + (size_t)nb * 32 * GLA_V + kb * 64; it.K = GLA_V; return it; } r -= I_BG;
    if (r < I_BA) { const int nb = r % 64, kb = r / 64; it.src = a.in[11] + (size_t)kb * 64 * D + nb * 32; it.ldn = D; it.dst = (bf16*)(F.ws + WS_WBA) + (size_t)nb * 32 * ATT_W + kb * 64; it.K = ATT_W; return it; } r -= I_BA;
    if (r < I_OUT) { const int nb = r % 64, kb = r / 64; it.src = a.in[12] + (size_t)kb * 64 * D + nb * 32; it.ldn = D; it.dst = (bf16*)(F.ws + WS_WOUT) + (size_t)nb * 32 * D + kb * 64; it.K = D; return it; } r -= I_OUT;
    if (r < 2 * I_MOE) {
        const int which = r / I_MOE; r -= which * I_MOE; const int e = r / I_E; r -= e * I_E; const int nb = r % 64, kb = r / 64, n0 = nb * 32;
        it.src = (which ? a.in[18] : a.in[16]) + (size_t)e * D * DFF + (size_t)kb * 64 * DFF + n0; it.ldn = DFF;
        it.dst = (bf16*)(F.ws + WS_GU) + (size_t)e * 2 * DFF * D + (size_t)((n0 >> 7) * 256 + (n0 & 127) + which * 128) * D + kb * 64; it.K = D; return it; }
    r -= 2 * I_MOE;
    { const int e = r / I_E; r -= e * I_E; const int nb = r % 64, kb = r / 64;
      it.src = a.in[20] + (size_t)e * DFF * D + (size_t)kb * 64 * D + nb * 32; it.ldn = D; it.dst = (bf16*)(F.ws + WS_DN) + (size_t)e * D * DFF + (size_t)nb * 32 * DFF + kb * 64; it.K = DFF; return it; }
}
__device__ __forceinline__ void p0_load(const P0Item& it, int lane, f32x4 (&v)[8]) {
    const float* p = it.src + (size_t)(lane >> 3) * it.ldn + 4 * (lane & 7);
#pragma unroll
    for (int i = 0; i < 8; ++i) v[i] = __builtin_nontemporal_load((const GAS f32x4*)(p + (size_t)(8 * i) * it.ldn));
}
__device__ __forceinline__ void p0_convert(Frame& F, const Args& a, int it_lo, int it_hi, int gw, int NGW) {
    LAS float* scr = (LAS float*)(F.lds + F.wave * 16384);
    const int lane = F.lane;
    int itx = it_lo + gw;
    if (itx >= it_hi) return;
    P0Item cur = p0_decode(F, a, itx);
    f32x4 v[8]; p0_load(cur, lane, v);
    for (;;) {
        const int nx = itx + NGW; const bool more = nx < it_hi;
        P0Item nxt = cur; f32x4 vn[8];
        if (more) { nxt = p0_decode(F, a, nx); p0_load(nxt, lane, vn); }
#pragma unroll
        for (int i = 0; i < 8; ++i) { LAS float* q = scr + (8 * i + (lane >> 3)) * 33 + 4 * (lane & 7); q[0] = v[i].x; q[1] = v[i].y; q[2] = v[i].z; q[3] = v[i].w; }
        LDS_WAIT(); asm volatile("" ::: "memory");
        const int c = lane & 7;
#pragma unroll
        for (int j = 0; j < 4; ++j) { const int n = (lane >> 3) + 8 * j; const LAS float* sp = scr + (8 * c) * 33 + n;
            u32x4 o; o.x = pk2(sp[0 * 33], sp[1 * 33]); o.y = pk2(sp[2 * 33], sp[3 * 33]); o.z = pk2(sp[4 * 33], sp[5 * 33]); o.w = pk2(sp[6 * 33], sp[7 * 33]);
            __builtin_nontemporal_store(o, (GAS u32x4*)(cur.dst + (size_t)n * cur.K + 8 * c)); }
        LDS_WAIT(); asm volatile("" ::: "memory");
        if (!more) break;
        itx = nx; cur = nxt;
#pragma unroll
        for (int i = 0; i < 8; ++i) v[i] = vn[i];
    }
}
__device__ __forceinline__ void p0_rows(Frame& F, const Args& a) {
    { const float* g2 = a.in[13]; const float* wr = a.in[14]; float* WR = (float*)(F.ws + WS_WR);
      for (int i = (F.vcu * NWAVES * 64) + F.tid; i < D * NE; i += F.G * NWAVES * 64) WR[i] = g2[i >> 5] * wr[i]; }
}

template <int MODE> __device__ __forceinline__ void normproj_unit(Frame& F, const Args& a, int tile) {
    const int w = F.wave, lane = F.lane, tid = F.tid, i = lane & 31, kk = lane >> 5, t0 = tile * 32;
    const float* X = MODE == 0 ? a.in[0] : (const float*)(F.ws + WS_H1); const float* g = MODE == 0 ? a.in[1] : a.in[13];
    const float* WR = (const float*)(F.ws + WS_WR); const float* br = a.in[15]; const float* w_in = a.in[2];
    LAS float* part = (LAS float*)F.lds;
    LAS float* ssq = part + 8192;
    LAS float* lg = ssq + 256;
    LAS float* rs = lg + 32 * 33;
    LAS unsigned* lcnt = (LAS unsigned*)(rs + 32); LAS unsigned* lbase = lcnt + 32; LAS unsigned* prec = lbase + 32;
    if (MODE == 1 && tid < NE) lcnt[tid] = 0u;
    f32x16 acc;
#pragma unroll
    for (int r = 0; r < 16; ++r) acc[r] = 0.f;
    float ss = 0.f;
    const int kbase = 256 * w + 128 * kk;
    const float* arow = X + (size_t)(t0 + i) * D + kbase;
    const float* bcol = MODE == 0 ? (w_in + (size_t)kbase * IN_COLS + C_GLR + (i & 15)) : (WR + (size_t)kbase * NE + i);
    const size_t bstr = MODE == 0 ? IN_COLS : NE;
#pragma unroll 1
    for (int c = 0; c < 4; ++c) {
        f32x4 av[8];
#pragma unroll
        for (int q = 0; q < 8; ++q) av[q] = *(const GAS f32x4*)(arow + 32 * c + 4 * q);
#pragma unroll
        for (int q = 0; q < 8; ++q)
#pragma unroll
            for (int j = 0; j < 4; ++j) { const int kq = 32 * c + 4 * q + j; float b = bcol[(size_t)kq * bstr];
                if (MODE == 0) b = (i < 16) ? b * g[kbase + kq] : 0.f;
                acc = __builtin_amdgcn_mfma_f32_32x32x2f32(av[q][j], b, acc, 0, 0, 0); ss = fmaf(av[q][j], av[q][j], ss); }
    }
    ss += __shfl_xor(ss, 32);
    if (kk == 0) ssq[w * 32 + i] = ss;
#pragma unroll
    for (int r = 0; r < 16; ++r) part[(w * 32 + (r & 3) + 8 * (r >> 2) + 4 * kk) * 32 + i] = acc[r];
    __syncthreads();
#pragma unroll
    for (int rep = 0; rep < 2; ++rep) { const int idx = tid + 512 * rep, tok = idx >> 5, e = idx & 31; float sum = 0.f, st = 0.f;
#pragma unroll
        for (int ww = 0; ww < 8; ++ww) { sum += part[(ww * 32 + tok) * 32 + e]; st += ssq[ww * 32 + tok]; }
        const float rstd = rsqrtf(st * (1.f / D) + 1e-6f);
        if (MODE == 0) { if (e < 16) ((float*)(F.ws + WS_GLR))[(size_t)(t0 + tok) * 16 + e] = sum * rstd; }
        else lg[tok * 33 + e] = sum * rstd + br[e];
        if (e == 0) rs[tok] = rstd; }
    __syncthreads();
    bf16* HN = (bf16*)(F.ws + (MODE == 0 ? WS_XN : WS_HN)); float* topw = (float*)(F.ws + WS_TOPW); int* tope = (int*)(F.ws + WS_TOPE); int* tops = (int*)(F.ws + WS_TOPS);
    unsigned* cnt = F.ctl + CW_CNT;
#pragma unroll 1
    for (int q = 0; q < 4; ++q) {
        const int tok = 4 * w + q, t = t0 + tok, e = lane & 31;
        const float rstd = rs[tok];
        {
            const GAS f32x4* x4 = (const GAS f32x4*)(X + (size_t)t * D) + lane; GAS u32x2* o8 = (GAS u32x2*)(HN + (size_t)t * D) + lane;
#pragma unroll
            for (int j = 0; j < 8; ++j) { const f32x4 gg = *((const GAS f32x4*)g + lane + 64 * j); const f32x4 y = x4[64 * j] * rstd * gg; u32x2 wv; wv.x = pk2(y.x, y.y); wv.y = pk2(y.z, y.w); o8[64 * j] = wv; }
        }
        if (MODE == 1) {
        float vals[4]; int idxs[4]; float cur = lg[tok * 33 + e];
#pragma unroll
        for (int r = 0; r < 4; ++r) {
            float bv = cur; int bi = e;
#pragma unroll
            for (int o = 1; o < 32; o <<= 1) { const float ov = __shfl_xor(bv, o); const int oi = __shfl_xor(bi, o); if (ov > bv || (ov == bv && oi < bi)) { bv = ov; bi = oi; } }
            vals[r] = bv; idxs[r] = bi;
            if (e == bi) cur = -3.0e38f;
        }
        float ex[4], sum = 0.f;
#pragma unroll
        for (int r = 0; r < 4; ++r) { ex[r] = __expf(vals[r] - vals[0]); sum += ex[r]; }
#pragma unroll
        for (int r = 0; r < 4; ++r) {
            if (lane == r) { const int ee = idxs[r]; const unsigned lr = __hip_atomic_fetch_add(&lcnt[ee], 1u, __ATOMIC_RELAXED, __HIP_MEMORY_SCOPE_WORKGROUP);
                topw[t * 4 + r] = ex[r] / sum; tope[t * 4 + r] = ee; prec[tok * 4 + r] = (ee << 16) | lr; }
        }
        }
    }
    if (MODE == 1) {
        __syncthreads();
        if (tid < NE) { const unsigned c = lcnt[tid]; lbase[tid] = c ? atomicAdd(&cnt[64 * tid], c) : 0u; }
        __syncthreads();
        if (tid < 128) { const unsigned pr = prec[tid]; tops[(t0 * 4) + tid] = (int)(lbase[pr >> 16] + (pr & 0xffffu)); }
        __syncthreads();
        if (tid < NE) lcnt[tid] = 0u;
    }
    __syncthreads();
}
__device__ __forceinline__ void moe_table(Frame& F) {
    volatile LAS int* ts = (volatile LAS int*)(F.lds + TAB_OFF); volatile LAS int* cn = (volatile LAS int*)(F.lds + TAB_OFF + 256);
    __syncthreads();
    if (F.tid == 0) { int s = 0; for (int e = 0; e < NE; ++e) { const int c = (int)__hip_atomic_load(F.ctl + CW_CNT + 64 * e, __ATOMIC_RELAXED, __HIP_MEMORY_SCOPE_AGENT); cn[e] = c; ts[e] = s; s += (c + 255) >> 8; } ts[NE] = s; }
    __syncthreads();
}
__device__ __forceinline__ void p7_gather(Frame& F) {
    const int gw = F.vcu * NWAVES + F.wave, NGW = F.G * NWAVES, lane = F.lane;
    volatile LAS int* ts = (volatile LAS int*)(F.lds + TAB_OFF);
    const bf16* HN = (const bf16*)(F.ws + WS_HN); bf16* HNG = (bf16*)(F.ws + WS_HNG);
    const float* topw = (const float*)(F.ws + WS_TOPW); const int* tope = (const int*)(F.ws + WS_TOPE); const int* tops = (const int*)(F.ws + WS_TOPS);
    int* rpair = (int*)(F.ws + WS_RPAIR); float* rw = (float*)(F.ws + WS_RW);
    { volatile LAS int* cn = (volatile LAS int*)(F.lds + TAB_OFF + 256);
      for (int e = gw; e < NE; e += NGW) { const int c = cn[e], base = ts[e] * 256, padn = ((c + 255) & ~255) - c;
          for (int r = lane; r < padn; r += 64) { rpair[base + c + r] = S * 4; rw[base + c + r] = 0.f; } } }
    for (int t = gw; t < S; t += NGW) {
        const GAS u32x4* src = (const GAS u32x4*)(HN + (size_t)t * D) + lane; u32x4 v[4];
#pragma unroll
        for (int j = 0; j < 4; ++j) v[j] = src[64 * j];
#pragma unroll
        for (int r = 0; r < 4; ++r) { const int p = t * 4 + r; const int dst = ts[tope[p]] * 256 + tops[p];
            GAS u32x4* d = (GAS u32x4*)(HNG + (size_t)dst * D) + lane;
#pragma unroll
            for (int j = 0; j < 4; ++j) d[64 * j] = v[j];
            if (lane == 0) { rpair[dst] = p; rw[dst] = topw[p]; } }
    }
}
__device__ __forceinline__ void p10_combine(Frame& F, const Args& a) {
    const int gw = F.vcu * NWAVES + F.wave, NGW = F.G * NWAVES, lane = F.lane;
    const bf16* PY = (const bf16*)(F.ws + WS_PY); float* out = a.out; const float* H1 = (const float*)(F.ws + WS_H1);
    for (int t = gw; t < S; t += NGW) {
#pragma unroll
        for (int j = 0; j < 4; ++j) {
            float r[8]; { const f32x4 h0 = *(const GAS f32x4*)(H1 + (size_t)t * D + 512 * j + 8 * lane), h1v = *(const GAS f32x4*)(H1 + (size_t)t * D + 512 * j + 8 * lane + 4);
                r[0] = h0.x; r[1] = h0.y; r[2] = h0.z; r[3] = h0.w; r[4] = h1v.x; r[5] = h1v.y; r[6] = h1v.z; r[7] = h1v.w; }
#pragma unroll
            for (int k = 0; k < 4; ++k) { const u32x4 p = *(const GAS u32x4*)(PY + (size_t)(t * 4 + k) * D + 512 * j + 8 * lane);
#pragma unroll
                for (int q = 0; q < 4; ++q) { r[2 * q] += __uint_as_float(p[q] << 16); r[2 * q + 1] += __uint_as_float(p[q] & 0xffff0000u); } }
            *(GAS f32x4*)(out + (size_t)t * D + 512 * j + 8 * lane) = (f32x4){r[0], r[1], r[2], r[3]};
            *(GAS f32x4*)(out + (size_t)t * D + 512 * j + 8 * lane + 4) = (f32x4){r[4], r[5], r[6], r[7]};
        }
    }
}


constexpr float ATT_QSCALE = 0.08838834764831845f * 1.4426950408889634f;
__device__ __forceinline__ void attn_prep_unit(Frame& F, const Args& a, int n, int h) {
    const int wave = F.wave, lane = F.lane, tid = F.tid;
    LAS bf16* kst = (LAS bf16*)(F.lds);
    LAS bf16* vst = (LAS bf16*)(F.lds + 16384);
    const bf16* AQ = (const bf16*)(F.ws + WS_AQ); const bf16* AK = (const bf16*)(F.ws + WS_AK); const bf16* AV = (const bf16*)(F.ws + WS_AV);
    bf16* QH = (bf16*)(F.ws + WS_QH);
    const float* qg = a.in[6]; const float* kg = a.in[7];
    const float gq0 = qg[2 * lane], gq1 = qg[2 * lane + 1], gk0 = kg[2 * lane], gk1 = kg[2 * lane + 1];
#pragma unroll
    for (int i = 0; i < 8; ++i) {
        const int row = n * 64 + wave * 8 + i; const size_t off = (size_t)row * ATT_W + h * ATT_HD + 2 * lane;
        const unsigned qv = *(const unsigned*)(AQ + off), kv = *(const unsigned*)(AK + off), vv = *(const unsigned*)(AV + off);
        const float q0 = __uint_as_float(qv << 16), q1 = __uint_as_float(qv & 0xffff0000u), k0 = __uint_as_float(kv << 16), k1 = __uint_as_float(kv & 0xffff0000u);
        const float rq = rsqrtf(wave_sum(q0 * q0 + q1 * q1) * (1.f / 128.f) + 1e-6f) * ATT_QSCALE, rk = rsqrtf(wave_sum(k0 * k0 + k1 * k1) * (1.f / 128.f) + 1e-6f);
        *(unsigned*)(QH + off) = pk2(q0 * rq * gq0, q1 * rq * gq1);
        *(LAS unsigned*)(kst + (wave * 8 + i) * 128 + 2 * lane) = pk2(k0 * rk * gk0, k1 * rk * gk1);
        *(LAS unsigned*)(vst + (wave * 8 + i) * 128 + 2 * lane) = vv;
    }
    __syncthreads();
    bf16* KI = (bf16*)(F.ws + WS_KIMG) + (size_t)(n * ATT_H + h) * 8192; bf16* VI = (bf16*)(F.ws + WS_VIMG) + (size_t)(n * ATT_H + h) * 8192;
#pragma unroll
    for (int i = 0; i < 2; ++i) {
        const int g = tid + 512 * i;
        { const int c16 = g >> 6, key = g & 63; const u32x4 v = *(const LAS u32x4*)(kst + key * 128 + c16 * 8); *(u32x4*)(KI + (size_t)g * 8) = v; }
        { const int kg8 = g >> 7, d = g & 127; unsigned short e[8];
#pragma unroll
          for (int j = 0; j < 8; ++j) e[j] = vst[(kg8 * 8 + j) * 128 + d];
          u32x4 v; v.x = e[0] | ((unsigned)e[1] << 16); v.y = e[2] | ((unsigned)e[3] << 16); v.z = e[4] | ((unsigned)e[5] << 16); v.w = e[6] | ((unsigned)e[7] << 16);
          *(u32x4*)(VI + (size_t)g * 8) = v; }
    }
    __syncthreads();
}

__device__ __forceinline__ int crow(int r, int hi) { return (r & 3) + 8 * (r >> 2) + 4 * hi; }
__device__ __forceinline__ void attn_unit(Frame& F, const Args& a, int n4, int h) {
    const int w = F.wave, lane = F.lane, r32 = lane & 31, hi = lane >> 5, tid = F.tid;
    const int p = w >> 1, half = w & 1, c = 4 * n4 + p, qrow0 = c * 64 + 32 * half;
    LAS unsigned char* lds = F.lds;
    LAS float* btab = (LAS float*)(lds + 65536); LAS float* xch = (LAS float*)(lds + 67584 + 256 * w); LAS bf16* ost = (LAS bf16*)(lds + 8192 * w);
    const float* relb = a.in[8] + h * 257;
    if (tid < 257) btab[tid] = relb[tid] * 1.4426950408889634f;
    const bf16* QH = (const bf16*)(F.ws + WS_QH);
    LAS unsigned char* qimg = lds + 69632 + 8192 * w;
#pragma unroll
    for (int d0 = 0; d0 < 8; ++d0) { const bf16x8 qv = *(const bf16x8*)(QH + (size_t)(qrow0 + r32) * ATT_W + h * ATT_HD + d0 * 16 + hi * 8);
        *(LAS bf16x8*)(qimg + ((2 * d0 + hi) * 32 + r32) * 16) = qv; }
    const char* KIMG = (const char*)(F.ws + WS_KIMG); const char* VIMG = (const char*)(F.ws + WS_VIMG);
    f32x16 o[4];
#pragma unroll
    for (int dt = 0; dt < 4; ++dt)
#pragma unroll
        for (int r = 0; r < 16; ++r) o[dt][r] = 0.f;
    float m = -1.0e30f, l = 0.f;
    const int s0 = (4 * n4 - 8 < 0) ? (8 - 4 * n4) : 0;
#define ATT_STAGE(s_) do { const int kc_ = 4 * n4 - 8 + (s_); const size_t gb_ = (size_t)(kc_ * ATT_H + h) * 16384; const unsigned lb_ = ((s_) & 1) * 32768; \
        _Pragma("unroll") for (int i_ = 0; i_ < 2; ++i_) { const int pc_ = w + 8 * i_; \
            __builtin_amdgcn_global_load_lds((const unsigned*)(KIMG + gb_ + pc_ * 1024 + lane * 16), (LAS unsigned*)(lds + lb_ + pc_ * 1024), 16, 0, 0); \
            __builtin_amdgcn_global_load_lds((const unsigned*)(VIMG + gb_ + pc_ * 1024 + lane * 16), (LAS unsigned*)(lds + lb_ + 16384 + pc_ * 1024), 16, 0, 0); } } while (0)
    ATT_STAGE(s0);
    for (int s = s0; s < 12; ++s) {
        asm volatile("s_waitcnt vmcnt(0) lgkmcnt(0)" ::: "memory");
        __builtin_amdgcn_s_barrier();
        if (s + 1 < 12) ATT_STAGE(s + 1);
        if (s >= p && s <= p + 8) {
            const LAS unsigned char* kb = lds + (s & 1) * 32768; const LAS unsigned char* vb = kb + 16384;
            f32x16 p0, p1;
#pragma unroll
            for (int r = 0; r < 16; ++r) { p0[r] = 0.f; p1[r] = 0.f; }
#pragma unroll
            for (int d0 = 0; d0 < 8; ++d0) {
                const bf16x8 k0 = *(const LAS bf16x8*)(kb + (2 * d0 + hi) * 1024 + r32 * 16), k1 = *(const LAS bf16x8*)(kb + (2 * d0 + hi) * 1024 + (r32 + 32) * 16);
                const bf16x8 qv = *(const LAS bf16x8*)(qimg + ((2 * d0 + hi) * 32 + r32) * 16);
                p0 = __builtin_amdgcn_mfma_f32_32x32x16_bf16(k0, qv, p0, 0, 0, 0);
                p1 = __builtin_amdgcn_mfma_f32_32x32x16_bf16(k1, qv, p1, 0, 0, 0);
                if (d0 & 1) __builtin_amdgcn_sched_barrier(0);
            }
            const int wrel = p + 8 - s;
            if (wrel >= 3) { const float bc = btab[256];
#pragma unroll
                for (int r = 0; r < 16; ++r) { p0[r] += bc; p1[r] += bc; } }
            else { const int base = 64 * wrel + 32 * half + r32 + 128;
#pragma unroll
                for (int r = 0; r < 16; ++r) { int i0 = base - crow(r, hi), i1 = i0 - 32; i0 = i0 > 256 ? 256 : i0; i1 = i1 > 256 ? 256 : i1; i1 = i1 < 0 ? 0 : i1; i0 = i0 < 0 ? 0 : i0; p0[r] += btab[i0]; p1[r] += btab[i1]; } }
            float mx = p0[0];
#pragma unroll
            for (int r = 1; r < 16; ++r) mx = fmaxf(mx, p0[r]);
#pragma unroll
            for (int r = 0; r < 16; ++r) mx = fmaxf(mx, p1[r]);
            mx = fmaxf(mx, __shfl_xor(mx, 32));
            const float mn = fmaxf(m, mx), alpha = __builtin_amdgcn_exp2f(m - mn);
            float ps = 0.f;
#pragma unroll
            for (int r = 0; r < 16; ++r) { p0[r] = __builtin_amdgcn_exp2f(p0[r] - mn); p1[r] = __builtin_amdgcn_exp2f(p1[r] - mn); ps += p0[r] + p1[r]; }
            l = l * alpha + ps;
            if (__any(mn > m)) {
                if (hi == 0) xch[r32] = alpha;
                asm volatile("s_waitcnt lgkmcnt(0)" ::: "memory");
#pragma unroll
                for (int g = 0; g < 4; ++g) { const f32x4 av = *(const LAS f32x4*)(xch + 8 * g + 4 * hi);
#pragma unroll
                    for (int dt = 0; dt < 4; ++dt) { o[dt][4 * g] *= av[0]; o[dt][4 * g + 1] *= av[1]; o[dt][4 * g + 2] *= av[2]; o[dt][4 * g + 3] *= av[3]; } }
            }
            m = mn;
            bf16x8 pa[4];
#pragma unroll
            for (int ks = 0; ks < 4; ++ks) { const f32x16& src = (ks < 2) ? p0 : p1; const int b = (ks & 1) * 8; u32x4 t;
                t.x = cvt_pk_bf16(src[b], src[b + 1]); t.y = cvt_pk_bf16(src[b + 2], src[b + 3]); t.z = cvt_pk_bf16(src[b + 4], src[b + 5]); t.w = cvt_pk_bf16(src[b + 6], src[b + 7]);
                pa[ks] = __builtin_bit_cast(bf16x8, t); }
#pragma unroll
            for (int dt = 0; dt < 4; ++dt)
#pragma unroll
                for (int ks = 0; ks < 4; ++ks) {
                    const LAS unsigned char* vp = vb + (2 * ks) * 2048 + (32 * dt + r32) * 16 + 8 * hi;
                    const u32x2 lo = *(const LAS u32x2*)vp, hh = *(const LAS u32x2*)(vp + 2048);
                    const u32x4 bq = (u32x4){lo.x, lo.y, hh.x, hh.y};
                    o[dt] = __builtin_amdgcn_mfma_f32_32x32x16_bf16(pa[ks], __builtin_bit_cast(bf16x8, bq), o[dt], 0, 0, 0);
                    if (ks == 3) __builtin_amdgcn_sched_barrier(0);
                }
        }
    }
#undef ATT_STAGE
    asm volatile("s_waitcnt lgkmcnt(0)" ::: "memory");
    __builtin_amdgcn_s_barrier();
    l += __shfl_xor(l, 32);
    if (hi == 0) xch[32 + r32] = 1.f / l;
    asm volatile("s_waitcnt lgkmcnt(0)" ::: "memory");
#pragma unroll
    for (int g = 0; g < 4; ++g) { const f32x4 iv = *(const LAS f32x4*)(xch + 32 + 8 * g + 4 * hi);
#pragma unroll
        for (int dt = 0; dt < 4; ++dt)
#pragma unroll
            for (int j = 0; j < 4; ++j) ost[(8 * g + 4 * hi + j) * 128 + 32 * dt + r32] = (bf16)f2bf(o[dt][4 * g + j] * iv[j]); }
    asm volatile("s_waitcnt lgkmcnt(0)" ::: "memory");
    bf16* YA = (bf16*)(F.ws + WS_YA);
#pragma unroll
    for (int i = 0; i < 8; ++i) { const int g = i * 64 + lane, row = g >> 4, c16 = g & 15; const u32x4 v = *(const LAS u32x4*)(ost + row * 128 + c16 * 8);
        *(u32x4*)(YA + (size_t)(qrow0 + row) * ATT_W + h * ATT_HD + c16 * 8) = v; }
    asm volatile("s_waitcnt vmcnt(0) lgkmcnt(0)" ::: "memory");
    __builtin_amdgcn_s_barrier();
}


__device__ __forceinline__ void gla_prep_unit(Frame& F, const Args& a, int n, int cg) {
    const int tid = F.tid, cq = tid & 15, seg = tid >> 4;
    const int h = cg >> 2, dk0 = (cg & 3) * 64 + 4 * cq, col0 = h * GLA_DK + dk0, nh = n * GLA_H + h;
    const float* wgu = a.in[3]; const float* bgt = a.in[4]; const float* GLR = (const float*)(F.ws + WS_GLR);
    const bf16* GQ = (const bf16*)(F.ws + WS_GQ); const bf16* GK = (const bf16*)(F.ws + WS_GK);
    LAS float* tot = (LAS float*)F.lds;
    LAS float* wl = tot + 2048;
    if (seg < 16) *(LAS f32x4*)(wl + seg * 64 + 4 * cq) = *(const f32x4*)(wgu + seg * GLA_QK + col0);
    __syncthreads();
    const f32x4 bgv = *(const f32x4*)(bgt + col0);
    f32x4 cs[8]; f32x4 run = (f32x4){0.f, 0.f, 0.f, 0.f};
    const int t0 = n * 256 + seg * 8;
#pragma unroll
    for (int i = 0; i < 8; ++i) {
        const f32x4* gp = (const f32x4*)(GLR + (size_t)(t0 + i) * 16); f32x4 z = bgv;
#pragma unroll
        for (int q = 0; q < 4; ++q) { const f32x4 gv = gp[q]; const LAS f32x4* wp = (const LAS f32x4*)(wl + 4 * q * 64 + 4 * cq);
            z += wp[0] * gv.x; z += wp[16] * gv.y; z += wp[32] * gv.z; z += wp[48] * gv.w; }
#pragma unroll
        for (int j = 0; j < 4; ++j) run[j] += log_sigmoid(z[j]) * (1.f / 16.f);
        cs[i] = run;
    }
    *(LAS f32x4*)(tot + seg * 64 + 4 * cq) = run;
    __syncthreads();
    f32x4 off = (f32x4){0.f, 0.f, 0.f, 0.f}, total = (f32x4){0.f, 0.f, 0.f, 0.f};
    for (int sg = 0; sg < 32; ++sg) { const f32x4 tv = *(const LAS f32x4*)(tot + sg * 64 + 4 * cq); total += tv; if (sg < seg) off += tv; }
    unsigned kew[4][4];
    bf16* ACAT = (bf16*)(F.ws + WS_ACAT); bf16* KI = (bf16*)(F.ws + WS_KI); bf16* KET = (bf16*)(F.ws + WS_KET);
    float kprev[4];
#pragma unroll
    for (int i = 0; i < 8; ++i) {
        const size_t trow = (size_t)(t0 + i);
        const u32x2 qv = *(const u32x2*)(GQ + trow * GLA_QK + col0), kv = *(const u32x2*)(GK + trow * GLA_QK + col0);
        float q[4] = {__uint_as_float(qv.x << 16), __uint_as_float(qv.x & 0xffff0000u), __uint_as_float(qv.y << 16), __uint_as_float(qv.y & 0xffff0000u)};
        float k[4] = {__uint_as_float(kv.x << 16), __uint_as_float(kv.x & 0xffff0000u), __uint_as_float(kv.y << 16), __uint_as_float(kv.y & 0xffff0000u)};
        float qd[4], ki[4], ke[4];
#pragma unroll
        for (int j = 0; j < 4; ++j) { const float bc = cs[i][j] + off[j]; qd[j] = q[j] * 0.0625f * __expf(bc); ki[j] = k[j] * __expf(-bc); ke[j] = k[j] * __expf(total[j] - bc); }
        const size_t lrow = (size_t)nh * 256 + seg * 8 + i;
        u32x2 o; o.x = pk2(qd[0], qd[1]); o.y = pk2(qd[2], qd[3]); *(u32x2*)(ACAT + lrow * 512 + 256 + dk0) = o;
        o.x = pk2(ki[0], ki[1]); o.y = pk2(ki[2], ki[3]); *(u32x2*)(KI + lrow * 256 + dk0) = o;
        if (i & 1) {
#pragma unroll
            for (int j = 0; j < 4; ++j) kew[j][i >> 1] = pk2(kprev[j], ke[j]); }
        else {
#pragma unroll
            for (int j = 0; j < 4; ++j) kprev[j] = ke[j]; }
    }
#pragma unroll
    for (int j = 0; j < 4; ++j) *(u32x4*)(KET + ((size_t)nh * 256 + dk0 + j) * 256 + seg * 8) = (u32x4){kew[j][0], kew[j][1], kew[j][2], kew[j][3]};
    if (seg == 0) *(f32x4*)((float*)(F.ws + WS_DEC) + n * GLA_QK + col0) = (f32x4){__expf(total[0]), __expf(total[1]), __expf(total[2]), __expf(total[3])};
    __syncthreads();
}
__device__ __forceinline__ void gla_vt_unit(Frame& F, int n, int h, int g8) {
    const int tid = F.tid; const int nh = n * GLA_H + h;
    LAS bf16* tile = (LAS bf16*)F.lds;
    const bf16* GV = (const bf16*)(F.ws + WS_GV); bf16* BCAT = (bf16*)(F.ws + WS_BCAT);
#pragma unroll
    for (int ps = 0; ps < 4; ++ps) { const int row = (tid >> 3) + 64 * ps, ch = tid & 7;
        const u32x4 v = *(const u32x4*)(GV + (size_t)(n * 256 + row) * GLA_V + h * GLA_DV + g8 * 64 + ch * 8);
        *(LAS u32x2*)(tile + row * 72 + ch * 8) = (u32x2){v.x, v.y}; *(LAS u32x2*)(tile + row * 72 + ch * 8 + 4) = (u32x2){v.z, v.w}; }
    __syncthreads();
#pragma unroll
    for (int i = 0; i < 4; ++i) { const int g = tid + 512 * i, c = g & 63, tg = g >> 6; unsigned short e[8];
#pragma unroll
        for (int j = 0; j < 8; ++j) e[j] = tile[(tg * 8 + j) * 72 + c];
        u32x4 v; v.x = e[0] | ((unsigned)e[1] << 16); v.y = e[2] | ((unsigned)e[3] << 16); v.z = e[4] | ((unsigned)e[5] << 16); v.w = e[6] | ((unsigned)e[7] << 16);
        *(u32x4*)(BCAT + ((size_t)nh * 512 + g8 * 64 + c) * 512 + tg * 8) = v; }
    __syncthreads();
}
__device__ __forceinline__ void gla_scan(Frame& F) {
    const bf16* UT = (const bf16*)(F.ws + WS_UT); bf16* BCAT = (bf16*)(F.ws + WS_BCAT); const float* DEC = (const float*)(F.ws + WS_DEC);
    for (int idx = F.vcu * (NWAVES * 64) + F.tid; idx < GLA_H * GLA_DV * 64; idx += F.G * NWAVES * 64) {
        const int dk4 = (idx & 63) * 4, dv = (idx >> 6) & 511, h = idx >> 15;
        float s[4] = {0.f, 0.f, 0.f, 0.f};
#pragma unroll 8
        for (int n = 0; n < 32; ++n) {
            const size_t nh = (size_t)n * GLA_H + h;
            u32x2 o; o.x = pk2(s[0], s[1]); o.y = pk2(s[2], s[3]); *(u32x2*)(BCAT + (nh * 512 + dv) * 512 + 256 + dk4) = o;
            const u32x2 uv = *(const u32x2*)(UT + (nh * 512 + dv) * 256 + dk4); const f32x4 dc = *(const f32x4*)(DEC + n * GLA_QK + h * GLA_DK + dk4);
            s[0] = s[0] * dc.x + __uint_as_float(uv.x << 16); s[1] = s[1] * dc.y + __uint_as_float(uv.x & 0xffff0000u);
            s[2] = s[2] * dc.z + __uint_as_float(uv.y << 16); s[3] = s[3] * dc.w + __uint_as_float(uv.y & 0xffff0000u);
        }
    }
}
__device__ __forceinline__ void gla_norm(Frame& F, const Args& a) {
    const int gw = F.vcu * NWAVES + F.wave, NGW = F.G * NWAVES, lane = F.lane;
    const bf16* OB = (const bf16*)(F.ws + WS_OB); const bf16* GR = (const bf16*)(F.ws + WS_GR); bf16* YG = (bf16*)(F.ws + WS_YG); const float* g = a.in[5];
    const f32x4 g0 = *(const f32x4*)(g + 8 * lane), g1 = *(const f32x4*)(g + 8 * lane + 4);
    for (int wi = gw; wi < S * GLA_H; wi += NGW) {
        const size_t off = (size_t)(wi >> 2) * GLA_V + (wi & 3) * GLA_DV + 8 * lane;
        const u32x4 ov = *(const u32x4*)(OB + off), rv = *(const u32x4*)(GR + off);
        float o[8], r[8]; float ss = 0.f;
#pragma unroll
        for (int j = 0; j < 4; ++j) { o[2 * j] = __uint_as_float(ov[j] << 16); o[2 * j + 1] = __uint_as_float(ov[j] & 0xffff0000u); r[2 * j] = __uint_as_float(rv[j] << 16); r[2 * j + 1] = __uint_as_float(rv[j] & 0xffff0000u); }
#pragma unroll
        for (int j = 0; j < 8; ++j) ss += o[j] * o[j];
        const float rstd = rsqrtf(wave_sum(ss) * (1.f / GLA_DV) + 1e-6f);
        u32x4 w; w.x = pk2(o[0] * rstd * g0.x * r[0], o[1] * rstd * g0.y * r[1]); w.y = pk2(o[2] * rstd * g0.z * r[2], o[3] * rstd * g0.w * r[3]);
        w.z = pk2(o[4] * rstd * g1.x * r[4], o[5] * rstd * g1.y * r[5]); w.w = pk2(o[6] * rstd * g1.z * r[6], o[7] * rstd * g1.w * r[7]);
        *(u32x4*)(YG + off) = w;
    }
}

__global__ void __launch_bounds__(NWAVES * 64, 2) fwd(Args args) {
    extern __shared__ __attribute__((aligned(16))) unsigned char lds_raw[];
    Frame F;
    F.lds = (LAS unsigned char*)lds_raw; F.MISC = (volatile LAS unsigned*)(F.lds + MISC_OFF);
    F.tid = threadIdx.x; F.lane = F.tid & 63; F.wave = __builtin_amdgcn_readfirstlane(F.tid >> 6);
    F.G = gridDim.x; { const int bx = blockIdx.x; F.vcu = (F.G % 8 == 0) ? (bx % 8) * (F.G / 8) + bx / 8 : bx; }
    F.ws = args.ws; F.ctl = (unsigned*)(args.ws + WS_CTL);
    for (int u = F.tid; u < (LDS_BYTES - CTLZ_OFF) / 4; u += NWAVES * 64) ((LAS unsigned*)(F.lds + CTLZ_OFF))[u] = 0u;
    __syncthreads();
    XcdBarrier bar = xcd_barrier_post(F.ctl + CW_BAR + args.li * XCD_BAR_WORDS, F.MISC + 8);
    const int lo = args.ph_lo, hi = args.ph_hi;
#define IN(k) (lo <= (k) && (k) < hi)
#define SEAM(k) do { if (IN(k) && IN((k) + 1)) xcd_barrier(bar); } while (0)
    unsigned char* ws = args.ws;
#ifndef DUP_MASK
#define DUP_MASK 0
#endif
#define DUP(k) ((DUP_MASK >> (k)) & 1)
#define PHASE(k, ...) do { if (IN(k)) { __VA_ARGS__ if (DUP(k)) { xcd_barrier(bar); __VA_ARGS__ } } SEAM(k); } while (0)
    const int gcus = (F.G == 256) ? GEMM_CUS : F.G;
    PHASE(0, { p0_convert(F, args, 0, gcus < F.G ? P0_I_SMALL : P0_NITEMS, F.vcu * NWAVES + F.wave, F.G * NWAVES); p0_rows(F, args);
        for (int u = F.vcu; u < S / 32; u += F.G) normproj_unit<0>(F, args, u); });
    PHASE(1, { if ((int)blockIdx.x < gcus) { pg8::DenseSched Sc; Sc.init(ws + WS_XN, ws + WS_WIN, S, NPROJ, D, gcus, (int)blockIdx.x); pg8::EpiProj E{ws, args.in[9]};
            pg8::gemm_phase<pg8::EpiProj, pg8::DenseSched>(F.lds, D, D, D, Sc, E); }
        else p0_convert(F, args, P0_I_SMALL, P0_NITEMS, ((int)blockIdx.x - gcus) * NWAVES + F.wave, (F.G - gcus) * NWAVES); });
    PHASE(2, { for (int rp = 0; rp < 1 + DUP(16); ++rp) for (int u = F.vcu; u < NCH * ATT_H; u += F.G) attn_prep_unit(F, args, u >> 3, u & 7);
        for (int rp = 0; rp < 1 + DUP(17); ++rp) for (int u = F.vcu; u < 32 * 16; u += F.G) gla_prep_unit(F, args, u >> 4, u & 15);
        for (int rp = 0; rp < 1 + DUP(18); ++rp) for (int u = F.vcu; u < 32 * GLA_H * 8; u += F.G) gla_vt_unit(F, u >> 5, (u >> 3) & 3, u & 7); });
    PHASE(3, { for (int u = F.vcu; u < (NCH / 4) * ATT_H; u += F.G) attn_unit(F, args, u >> 3, u & 7);
        { pg8::GlaSched Sc{0, F.G, F.G - 1 - (int)blockIdx.x, ws}; pg8::EpiGla<0> E{ws}; pg8::gemm_phase<pg8::EpiGla<0>, pg8::GlaSched>(F.lds, 256, 512, 256, Sc, E); }
        { pg8::GlaSched Sc{1, F.G, (int)blockIdx.x, ws}; pg8::EpiGla<1> E{ws}; pg8::gemm_phase<pg8::EpiGla<1>, pg8::GlaSched>(F.lds, 256, 512, 256, Sc, E); } });
    PHASE(4, { gla_scan(F); });
    PHASE(5, { pg8::GlaSched Sc{2, F.G, (int)blockIdx.x, ws}; pg8::EpiGla<2> E{ws}; pg8::gemm_phase<pg8::EpiGla<2>, pg8::GlaSched>(F.lds, 512, 512, 512, Sc, E); });
    PHASE(6, { gla_norm(F, args); });
    PHASE(7, { pg8::DenseSched Sc; Sc.init(ws + WS_YG, ws + WS_WBG, S, D, GLA_V, F.G, (int)blockIdx.x); pg8::EpiBranch<0> E{(const bf16*)(ws + WS_SG), nullptr, (bf16*)(ws + WS_T)};
        pg8::gemm_phase<pg8::EpiBranch<0>, pg8::DenseSched>(F.lds, GLA_V, GLA_V, GLA_V, Sc, E); });
    PHASE(8, { pg8::DenseSched Sc; Sc.init(ws + WS_YA, ws + WS_WBA, S, D, ATT_W, F.G, (int)blockIdx.x); pg8::EpiBranch<1> E{(const bf16*)(ws + WS_SA), (const bf16*)(ws + WS_T), (bf16*)(ws + WS_MG)};
        pg8::gemm_phase<pg8::EpiBranch<1>, pg8::DenseSched>(F.lds, ATT_W, ATT_W, ATT_W, Sc, E); });
    PHASE(9, { pg8::DenseSched Sc; Sc.init(ws + WS_MG, ws + WS_WOUT, S, D, D, F.G, (int)blockIdx.x); pg8::EpiResid E{args.in[0], (float*)(ws + WS_H1)};
        pg8::gemm_phase<pg8::EpiResid, pg8::DenseSched>(F.lds, D, D, D, Sc, E); });
    PHASE(10, { for (int u = F.vcu; u < S / 32; u += F.G) normproj_unit<1>(F, args, u); });
    PHASE(11, { moe_table(F); p7_gather(F); });
    PHASE(12, { moe_table(F); pg8::MoeSched Sc; Sc.init(ws + WS_HNG, ws + WS_GU, (volatile LAS int*)(F.lds + TAB_OFF), (volatile LAS int*)(F.lds + TAB_OFF + 256), 16, D, F.G, (int)blockIdx.x);
        pg8::EpiSwiglu E{args.in[17], args.in[19], (bf16*)(ws + WS_HD)};
        pg8::gemm_phase<pg8::EpiSwiglu, pg8::MoeSched>(F.lds, D, D, D, Sc, E); });
    PHASE(13, { moe_table(F); pg8::MoeSched Sc; Sc.init(ws + WS_HD, ws + WS_DN, (volatile LAS int*)(F.lds + TAB_OFF), (volatile LAS int*)(F.lds + TAB_OFF + 256), 8, DFF, F.G, (int)blockIdx.x);
        pg8::EpiDown E{args.in[21], (const int*)(ws + WS_RPAIR), (const float*)(ws + WS_RW), (bf16*)(ws + WS_PY)};
        pg8::gemm_phase<pg8::EpiDown, pg8::MoeSched>(F.lds, DFF, DFF, DFF, Sc, E); });
    PHASE(14, { p10_combine(F, args); });
#undef PHASE
#undef IN
#undef SEAM
}

extern "C" void kernel_launch(void* const* d_in, const int* in_sizes, int n_in, void* d_out, int out_size, void* d_ws, size_t ws_size, hipStream_t stream) {
    static int grid = 0;
    if (grid == 0) {
        if (n_in != 22 || out_size != S * D || ws_size < WS_END) { fprintf(stderr, "kernel_launch: unexpected problem (n_in %d out %d ws %zu)\n", n_in, out_size, ws_size); grid = -1; return; }
        int dev = 0, cus = 0, per_cu = 0;
        if (hipGetDevice(&dev) != hipSuccess || hipDeviceGetAttribute(&cus, hipDeviceAttributeMultiprocessorCount, dev) != hipSuccess) { grid = -1; return; }
        if (hipFuncSetAttribute((const void*)fwd, hipFuncAttributeMaxDynamicSharedMemorySize, LDS_BYTES) != hipSuccess) { fprintf(stderr, "kernel_launch: hipFuncSetAttribute failed\n"); grid = -1; return; }
        if (hipOccupancyMaxActiveBlocksPerMultiprocessor(&per_cu, (const void*)fwd, NWAVES * 64, LDS_BYTES) != hipSuccess || per_cu < 1) fprintf(stderr, "kernel_launch: occupancy query says %d\n", per_cu);
        (void)hipGetLastError();
        grid = cus;
    }
    if (grid < 0) return;
    (void)hipMemsetAsync((char*)d_ws + WS_CTL, 0, CTL_ZERO_BYTES, stream);
    Args a{};
    for (int i = 0; i < 22; ++i) a.in[i] = (const float*)d_in[i];
    a.out = (float*)d_out; a.ws = (unsigned char*)d_ws;
    a.ph_lo = 0; a.ph_hi = 15; a.li = 0;
    hipLaunchKernelGGL(fwd, dim3(grid), dim3(NWAVES * 64), LDS_BYTES, stream, a);
}
```

```cpp
#include <hip/hip_runtime.h>
#include <stdint.h>
#include <cstdio>

constexpr int S = 8192, D = 2048;
constexpr int GLA_H = 4, GLA_DK = 256, GLA_DV = 512, GLA_QK = 1024, GLA_V = 2048;
constexpr int ATT_H = 8, ATT_HD = 128, ATT_W = 1024, NCH = S / 64;
constexpr int NE = 32, DFF = 2048;
constexpr int IN_COLS = 13328, C_GLR = 6144;
constexpr int NPROJ = 13312;
constexpr int MAXROWS = 32768 + NE * 256;

constexpr size_t MiB = 1u << 20;
constexpr size_t WS_CTL = 0, CTL_ZERO_BYTES = 1 * MiB;
constexpr size_t WS_TOPW = 1 * MiB, WS_TOPE = WS_TOPW + 128 * 1024, WS_TOPS = WS_TOPE + 128 * 1024, WS_RPAIR = WS_TOPS + 128 * 1024, WS_RW = WS_RPAIR + 256 * 1024;
constexpr size_t WS_GLR = 2 * MiB, WS_WR = 3 * MiB;
constexpr size_t WS_WIN = 8 * MiB, WS_WBG = 60 * MiB, WS_WBA = 68 * MiB, WS_WOUT = 72 * MiB, WS_GU = 80 * MiB, WS_DN = 592 * MiB;
constexpr size_t WS_XN = 848 * MiB, WS_GQ = 880 * MiB, WS_GK = 896 * MiB, WS_GV = 912 * MiB, WS_GR = 944 * MiB, WS_AQ = 976 * MiB, WS_AK = 992 * MiB, WS_AV = 1008 * MiB;
constexpr size_t WS_SG = 1024 * MiB, WS_SA = 1056 * MiB, WS_YG = 1088 * MiB, WS_YA = 1120 * MiB, WS_T = 1136 * MiB, WS_MG = 1168 * MiB, WS_HN = 1200 * MiB;
constexpr size_t WS_HNG = 1232 * MiB, WS_HD = 1392 * MiB, WS_PY = 1552 * MiB, WS_QH = 1681 * MiB, WS_KIMG = 1697 * MiB, WS_VIMG = 1713 * MiB;
constexpr size_t WS_ACAT = 1729 * MiB, WS_BCAT = 1761 * MiB, WS_KI = 1825 * MiB, WS_KET = 1841 * MiB, WS_UT = 1857 * MiB, WS_DEC = 1889 * MiB, WS_OB = 1890 * MiB, WS_H1 = 1922 * MiB, WS_END = 1986 * MiB;
constexpr int CW_CNT = 256;
constexpr int CW_BAR = 4096;

typedef unsigned short bf16;
typedef short bf16x8 __attribute__((ext_vector_type(8)));
typedef float f32x4 __attribute__((ext_vector_type(4)));
typedef float f32x16 __attribute__((ext_vector_type(16)));
typedef unsigned u32x4 __attribute__((ext_vector_type(4)));
typedef unsigned u32x2 __attribute__((ext_vector_type(2)));
typedef int v8i __attribute__((ext_vector_type(8)));
#define LAS __attribute__((address_space(3)))
#define GAS __attribute__((address_space(1)))
__device__ __forceinline__ float bf2f(bf16 v) { return __uint_as_float((unsigned)v << 16); }
__device__ __forceinline__ unsigned f2bf(float f) { unsigned u = __float_as_uint(f); return (u + 0x7fffu + ((u >> 16) & 1u)) >> 16; }
__device__ __forceinline__ unsigned pk2(float lo, float hi) { return f2bf(lo) | (f2bf(hi) << 16); }
__device__ __forceinline__ unsigned cvt_pk_bf16(float lo, float hi) { unsigned r; asm volatile("v_cvt_pk_bf16_f32 %0, %1, %2" : "=v"(r) : "v"(lo), "v"(hi)); return r; }
__device__ __forceinline__ float wave_sum(float v) {
#pragma unroll
    for (int o = 1; o < 64; o <<= 1) v += __shfl_xor(v, o);
    return v;
}
__device__ __forceinline__ float sigmoidf_(float x) { return 1.f / (1.f + __expf(-x)); }
__device__ __forceinline__ float log_sigmoid(float z) { return fminf(z, 0.f) - log1pf(__expf(-fabsf(z))); }
#define LDS_WAIT() asm volatile("s_waitcnt lgkmcnt(0)" ::: "memory")
#define VM_WAIT() asm volatile("s_waitcnt vmcnt(0)" ::: "memory")

#define XB_TMO      128
#define XB_XCNT(j)  (256  + 64 * (j))
#define XB_XSUB(j)  (1280 + 64 * (j))
#define XB_XGEN(j)  (2304 + 64 * (j))
#define XB_TOP      3328
#define XB_TOPGEN   3392
#define XCD_BAR_WORDS 3456
#define XB_SPIN_CAP (1u << 18)
__device__ __forceinline__ unsigned xb_ld(unsigned* p)              { return __hip_atomic_load(p, __ATOMIC_RELAXED, __HIP_MEMORY_SCOPE_AGENT); }
__device__ __forceinline__ unsigned xb_add(unsigned* p, unsigned v) { return __hip_atomic_fetch_add(p, v, __ATOMIC_RELAXED, __HIP_MEMORY_SCOPE_AGENT); }
__device__ __forceinline__ unsigned xb_xcc_id() { return (unsigned)__builtin_amdgcn_s_getreg((3 << 11) | 20) & 0xFu; }
#define XB_SPIN(cond, bar) do { unsigned _sp = 0; while (cond) { __builtin_amdgcn_s_sleep(1); \
    if ((++_sp & 255u) == 0u) { if (xb_ld(&(bar)[XB_TMO])) break; if (_sp > XB_SPIN_CAP) { atomicAdd(&(bar)[XB_TMO], 1u); break; } } } } while (0)
struct XcdBarrier { unsigned* bar; unsigned x; volatile LAS unsigned* st; };
__device__ __forceinline__ XcdBarrier xcd_barrier_post(unsigned* bar, volatile LAS unsigned* st) {
    XcdBarrier b; b.bar = bar; b.x = xb_xcc_id(); b.st = st;
    if (threadIdx.x == 0) (void)xb_add(&bar[XB_XCNT(b.x)], 1u);
    return b;
}
__device__ __forceinline__ void xcd_barrier_complete(unsigned* bar, unsigned x, unsigned& nloc, unsigned& nx) {
    const unsigned G = gridDim.x * gridDim.y * gridDim.z;
    unsigned sum, cnt, mine, sp = 0u;
    for (;;) {
        sum = 0u; cnt = 0u; mine = 0u;
#pragma unroll
        for (unsigned j = 0; j < 16; ++j) { const unsigned c = xb_ld(&bar[XB_XCNT(j)]); sum += c; cnt += (c > 0u) ? 1u : 0u; mine = (j == x) ? c : mine; }
        if (sum == G) break;
        __builtin_amdgcn_s_sleep(1);
        if ((++sp & 255u) == 0u) { if (xb_ld(&bar[XB_TMO])) break; if (sp > XB_SPIN_CAP) { atomicAdd(&bar[XB_TMO], 1u); break; } }
    }
    nloc = mine > 0u ? mine : 1u; nx = cnt > 0u ? cnt : 1u;
}
__device__ __forceinline__ void xcd_barrier(const XcdBarrier& b) {
    asm volatile("s_waitcnt vmcnt(0)" ::: "memory");
    __syncthreads();
    if (threadIdx.x == 0) {
        unsigned* bar = b.bar;
        __builtin_amdgcn_s_waitcnt(0);
        unsigned nloc = b.st[0], nx = b.st[1];
        if (nloc == 0u) { xcd_barrier_complete(bar, b.x, nloc, nx); b.st[0] = nloc; b.st[1] = nx; }
        const unsigned old = xb_add(&bar[XB_XSUB(b.x)], 1u);
        const unsigned gen = old / nloc;
        if (old + 1u == (gen + 1u) * nloc) {
            __builtin_amdgcn_fence(__ATOMIC_RELEASE, "agent");
            asm volatile("s_waitcnt vmcnt(0)" ::: "memory");
            const unsigned og = xb_add(&bar[XB_TOP], 1u);
            const unsigned tg = og / nx;
            if (og + 1u == (tg + 1u) * nx) xb_add(&bar[XB_TOPGEN], 1u);
            else XB_SPIN(xb_ld(&bar[XB_TOPGEN]) == tg, bar);
            __builtin_amdgcn_fence(__ATOMIC_ACQUIRE, "agent");
            xb_add(&bar[XB_XGEN(b.x)], 1u);
            asm volatile("s_waitcnt vmcnt(0)" ::: "memory");
        } else {
            XB_SPIN(xb_ld(&bar[XB_XGEN(b.x)]) == gen, bar);
            __builtin_amdgcn_fence(__ATOMIC_ACQUIRE, "agent");
            asm volatile("s_waitcnt vmcnt(0)" ::: "memory");
        }
    }
    __syncthreads();
}

namespace pg8 {
constexpr int BM = 256, BK = 64, HALF = 128, HTB = HALF * BK * 2, STAGE_BYTES = 8 * HTB, NXCD = 8, WGM = 8;
__host__ __device__ __forceinline__ int lds_byte(int r, int c) { const int st = (r >> 4) * 2 + (c >> 5), rr = r & 15, cc = c & 31, ob = rr * 64 + cc * 2; return st * 1024 + (ob ^ (((ob >> 9) & 1) << 5)); }
__host__ __device__ __forceinline__ void stage_rc(int b, int& R, int& C) { const int st = b / 1024, sb = b % 1024, swz = sb ^ (((sb >> 9) & 1) << 5); R = (st >> 1) * 16 + swz / 64; C = (st & 1) * 32 + (swz % 64) / 2; }
__host__ __device__ __forceinline__ int perm32(int rho) { const int n = rho >> 4, i = rho & 15; return 8 * (i >> 2) + 4 * n + (i & 3); }
__device__ __forceinline__ int xcd_remap(int wgid, int nwg) { const int q = nwg / NXCD, r = nwg % NXCD, xcd = wgid % NXCD, off = wgid / NXCD; return (xcd < r ? xcd * (q + 1) : r * (q + 1) + (xcd - r) * q) + off; }

struct Unit { const char* A; const char* B; int pm, pn, e, nrow; };

struct DenseSched {
    const char* A; const char* Bt; int nM, nN, nwg, G, c; size_t tstep;
    __device__ __forceinline__ void init(const void* A_, const void* Bt_, int M, int N, int K, int G_, int c_) { A = (const char*)A_; Bt = (const char*)Bt_; nM = M / BM; nN = N / BM; nwg = nM * nN; G = G_; c = c_; tstep = (size_t)BM * K * 2; }
    __device__ __forceinline__ bool next(int i, Unit& u) const {
        const long L = (long)i * G + c; if (L >= nwg) return false;
        const int wgid = xcd_remap((int)L, nwg);
        const int nig = WGM * nN, gid = wgid / nig, fm = gid * WGM, gsz = (nM - fm) < WGM ? (nM - fm) : WGM;
        u.pm = fm + ((wgid % nig) % gsz); u.pn = (wgid % nig) / gsz; u.e = 0; u.nrow = BM;
        u.A = A + (size_t)u.pm * tstep; u.B = Bt + (size_t)u.pn * tstep; return true;
    }
};
struct MoeSched {
    const char* A; const char* Bt; const volatile LAS int* tstart; const volatile LAS int* cnt; int NT, nwg, G, c; size_t tstep;
    __device__ __forceinline__ void init(const void* A_, const void* Bt_, const volatile LAS int* ts, const volatile LAS int* cn, int NT_, int Kbytes, int G_, int c_) {
        A = (const char*)A_; Bt = (const char*)Bt_; tstart = ts; cnt = cn; NT = NT_; nwg = ts[NE] * NT_; G = G_; c = c_; tstep = (size_t)BM * Kbytes; }
    __device__ __forceinline__ bool next(int i, Unit& u) const {
        const long L = (long)i * G + c; if (L >= nwg) return false;
        const int wgid = xcd_remap((int)L, nwg);
        int e = 0;
#pragma unroll 1
        for (int j = 1; j < NE; ++j) e = (wgid >= tstart[j] * NT) ? j : e;
        const int t0 = tstart[e], nte = tstart[e + 1] - t0, local = wgid - t0 * NT;
        const int pn = local / nte, mt = local - pn * nte;
        u.e = e; u.pn = pn; u.pm = t0 + mt; u.nrow = cnt[e] - mt * BM;
        u.A = A + (size_t)u.pm * tstep; u.B = Bt + (size_t)(e * NT + pn) * tstep; return true;
    }
};

template <class Epi, class Sched, bool BGRAN = false>
__device__ __forceinline__ void gemm_phase(LAS unsigned char* lds, const int K, const int lda, const int ldb, const Sched& S, const Epi& E) {
    const int tid = threadIdx.x, wid = __builtin_amdgcn_readfirstlane(tid >> 6), lane = tid & 63, wr = wid >> 2, wc = wid & 3, fr = lane & 15, fq = lane >> 4;
    int nt = K / BK; asm volatile("" : "+s"(nt));
    unsigned voffA[2], voffB[2];
#pragma unroll
    for (int i = 0; i < 2; ++i) { int R, C; stage_rc(tid * 16 + i * 8192, R, C); const int Rb = Epi::PERM ? ((R & ~31) + perm32(R & 31)) : R;
        voffA[i] = (unsigned)(R * lda + C) * 2u; voffB[i] = BGRAN ? (unsigned)((C >> 3) * ldb + Rb) * 16u : (unsigned)(Rb * ldb + C) * 2u; }
    const size_t kstep = (size_t)(BK * 2), kstepB = BGRAN ? (size_t)ldb * 128 : (size_t)(BK * 2);
    const size_t hstepA = (size_t)HALF * lda * 2, hstepB = BGRAN ? (size_t)2048 : (size_t)HALF * ldb * 2;
    const unsigned ldsw = (unsigned)wid * 1024u;
    const int aoff = lds_byte(wr * 64 + fr, fq * 8), boff = lds_byte(wc * 32 + fr, fq * 8);
#define PG8_SA(b, h) (((b) * 2 + (h)) * HTB)
#define PG8_SB(b, h) ((4 + (b) * 2 + (h)) * HTB)
#define PG8_STAGE(bufoff, gbase, voff) do { _Pragma("unroll") for (int _i = 0; _i < 2; ++_i) \
        __builtin_amdgcn_global_load_lds((const unsigned*)((const char*)(gbase) + (voff)[_i]), (LAS unsigned*)(lds + (bufoff) + ldsw + _i * 8192), 16, 0, 0); } while (0)
#define PG8_LDA(dst, b, h) do { _Pragma("unroll") for (int m = 0; m < 4; ++m) _Pragma("unroll") for (int k = 0; k < 2; ++k) dst[m][k] = *(const LAS bf16x8*)(lds + PG8_SA(b, h) + aoff + m * 2048 + k * 1024); } while (0)
#define PG8_LDB(dst, b, h) do { _Pragma("unroll") for (int n = 0; n < 2; ++n) _Pragma("unroll") for (int k = 0; k < 2; ++k) dst[n][k] = *(const LAS bf16x8*)(lds + PG8_SB(b, h) + boff + n * 2048 + k * 1024); } while (0)
#define PG8_MMA(ai, bj, At, Bt) do { __builtin_amdgcn_s_setprio(1); _Pragma("unroll") for (int m = 0; m < 4; ++m) _Pragma("unroll") for (int n = 0; n < 2; ++n) _Pragma("unroll") for (int k = 0; k < 2; ++k) \
        acc[ai][bj][m][n] = __builtin_amdgcn_mfma_f32_16x16x32_bf16(Bt[n][k], At[m][k], acc[ai][bj][m][n], 0, 0, 0); __builtin_amdgcn_s_setprio(0); } while (0)
#define PG8_WAIT_V(n) asm volatile("s_waitcnt vmcnt(" #n ")" ::: "memory")
#define PG8_WAIT_L(n) asm volatile("s_waitcnt lgkmcnt(" #n ")" ::: "memory")
#define PG8_BAR __builtin_amdgcn_s_barrier()
#define PG8_SCHED __builtin_amdgcn_sched_barrier(0)
    Unit cur, nxt; int ui = 0;
    if (!S.next(0, cur)) return;
    f32x4 acc[2][2][4][2];
#pragma unroll
    for (int a = 0; a < 2; ++a)
#pragma unroll
        for (int b = 0; b < 2; ++b)
#pragma unroll
            for (int m = 0; m < 4; ++m)
#pragma unroll
                for (int n = 0; n < 2; ++n) acc[a][b][m][n] = (f32x4){0.f, 0.f, 0.f, 0.f};
    bf16x8 At[4][2], B0[2][2], B1[2][2];
    const char* cA = cur.A; const char* cB = cur.B;
    PG8_STAGE(PG8_SB(0, 0), cB, voffB); PG8_STAGE(PG8_SB(0, 1), cB + hstepB, voffB); PG8_STAGE(PG8_SA(0, 0), cA, voffA); PG8_STAGE(PG8_SA(0, 1), cA + hstepA, voffA);
    if (wr == 1) PG8_BAR;
    PG8_WAIT_V(2); PG8_BAR;
    PG8_STAGE(PG8_SB(1, 0), cB + kstepB, voffB); PG8_STAGE(PG8_SA(1, 0), cA + kstep, voffA); PG8_STAGE(PG8_SB(1, 1), cB + hstepB + kstepB, voffB);
    PG8_WAIT_V(6); PG8_BAR;
    for (;;) {
        const bool has_next = S.next(ui + 1, nxt);
        const char* nA = has_next ? nxt.A : cA; const char* nB = has_next ? nxt.B : cB;
#pragma unroll 1
        for (int t = 0; t < nt; t += 2) {
            const bool last = (t == nt - 2);
            const char* a1 = cA + (size_t)(t + 1) * kstep;
            const char* a2 = last ? nA : cA + (size_t)(t + 2) * kstep; const char* b2 = last ? nB : cB + (size_t)(t + 2) * kstepB;
            const char* a3 = a2 + kstep; const char* b3 = b2 + kstepB;
            PG8_LDB(B0, 0, 0); PG8_LDB(B1, 0, 1); PG8_SCHED; PG8_LDA(At, 0, 0); PG8_STAGE(PG8_SA(1, 1), a1 + hstepA, voffA);
            PG8_WAIT_V(8); PG8_WAIT_L(0); PG8_BAR; PG8_MMA(0, 0, At, B0); PG8_MMA(0, 1, At, B1); PG8_BAR; PG8_SCHED;
            PG8_LDA(At, 0, 1); PG8_STAGE(PG8_SB(0, 0), b2, voffB); PG8_STAGE(PG8_SB(0, 1), b2 + hstepB, voffB); PG8_STAGE(PG8_SA(0, 0), a2, voffA);
            PG8_WAIT_V(8); PG8_WAIT_L(0); PG8_BAR; PG8_MMA(1, 0, At, B0); PG8_MMA(1, 1, At, B1); PG8_BAR; PG8_SCHED;
            PG8_LDB(B0, 1, 0); PG8_LDB(B1, 1, 1); PG8_SCHED; PG8_LDA(At, 1, 0); PG8_STAGE(PG8_SA(0, 1), a2 + hstepA, voffA);
            PG8_WAIT_V(8); PG8_WAIT_L(0); PG8_BAR; PG8_MMA(0, 0, At, B0); PG8_MMA(0, 1, At, B1); PG8_BAR; PG8_SCHED;
            PG8_LDA(At, 1, 1); PG8_STAGE(PG8_SB(1, 0), b3, voffB); PG8_STAGE(PG8_SB(1, 1), b3 + hstepB, voffB); PG8_STAGE(PG8_SA(1, 0), a3, voffA);
            PG8_WAIT_V(8); PG8_WAIT_L(0); PG8_BAR; PG8_MMA(1, 0, At, B0); PG8_MMA(1, 1, At, B1); PG8_BAR; PG8_SCHED;
        }
        if (wr == 0) PG8_BAR;
        { int fr_ = fr, fq_ = fq; asm volatile("" : "+v"(fr_), "+v"(fq_));
          E(acc, cur, wr, wc, fr_, fq_); }
        if (!has_next) break;
#pragma unroll
        for (int a = 0; a < 2; ++a)
#pragma unroll
            for (int b = 0; b < 2; ++b)
#pragma unroll
                for (int m = 0; m < 4; ++m)
#pragma unroll
                    for (int n = 0; n < 2; ++n) acc[a][b][m][n] = (f32x4){0.f, 0.f, 0.f, 0.f};
        cur = nxt; cA = nA; cB = nB; ++ui;
        if (wr == 1) PG8_BAR;
    }
    PG8_WAIT_V(0);
    PG8_BAR;
#undef PG8_SA
#undef PG8_SB
#undef PG8_STAGE
#undef PG8_LDA
#undef PG8_LDB
#undef PG8_MMA
#undef PG8_WAIT_V
#undef PG8_WAIT_L
#undef PG8_BAR
#undef PG8_SCHED
}

template <class Epi, class Sched>
__device__ __forceinline__ void gemm_phase8(LAS unsigned char* lds, const int K, const int lda, const int ldb, const Sched& S, const Epi& E) {
    const int tid = threadIdx.x, wid = __builtin_amdgcn_readfirstlane(tid >> 6), lane = tid & 63, wr = wid >> 2, wc = wid & 3, fr = lane & 15, fq = lane >> 4;
    int nt = K / 128; asm volatile("" : "+s"(nt));
    unsigned voffA[2], voffB[2];
#pragma unroll
    for (int i = 0; i < 2; ++i) { int R, C; stage_rc(tid * 16 + i * 8192, R, C); const int Rb = Epi::PERM ? ((R & ~31) + perm32(R & 31)) : R;
        voffA[i] = (unsigned)(R * lda + C * 2); voffB[i] = (unsigned)(Rb * ldb + C * 2); }
    const size_t kstep = 128, kstepB = 128;
    const size_t hstepA = (size_t)HALF * lda, hstepB = (size_t)HALF * ldb;
    const unsigned ldsw = (unsigned)wid * 1024u;
    const int aoff = lds_byte(wr * 64 + fr, fq * 16), boff = lds_byte(wc * 32 + fr, fq * 16);
#define PG8_SA(b, h) (((b) * 2 + (h)) * HTB)
#define PG8_SB(b, h) ((4 + (b) * 2 + (h)) * HTB)
#define PG8_STAGE(bufoff, gbase, voff) do { _Pragma("unroll") for (int _i = 0; _i < 2; ++_i) \
        __builtin_amdgcn_global_load_lds((const unsigned*)((const char*)(gbase) + (voff)[_i]), (LAS unsigned*)(lds + (bufoff) + ldsw + _i * 8192), 16, 0, 0); } while (0)
#define PG8_LDA(dst, b, h) do { _Pragma("unroll") for (int m = 0; m < 4; ++m) { dst[m][0] = *(const LAS u32x4*)(lds + PG8_SA(b, h) + aoff + m * 2048); dst[m][1] = *(const LAS u32x4*)(lds + PG8_SA(b, h) + aoff + m * 2048 + 16); } } while (0)
#define PG8_LDB(dst, b, h) do { _Pragma("unroll") for (int n = 0; n < 2; ++n) { dst[n][0] = *(const LAS u32x4*)(lds + PG8_SB(b, h) + boff + n * 2048); dst[n][1] = *(const LAS u32x4*)(lds + PG8_SB(b, h) + boff + n * 2048 + 16); } } while (0)
#define PG8_MMA(ai, bj, At, Bt) do { __builtin_amdgcn_s_setprio(1); _Pragma("unroll") for (int m = 0; m < 4; ++m) _Pragma("unroll") for (int n = 0; n < 2; ++n) { \
        const v8i b_ = __builtin_bit_cast(v8i, __builtin_shufflevector(Bt[n][0], Bt[n][1], 0, 1, 2, 3, 4, 5, 6, 7)), a_ = __builtin_bit_cast(v8i, __builtin_shufflevector(At[m][0], At[m][1], 0, 1, 2, 3, 4, 5, 6, 7)); \
        asm volatile("s_nop 1\n\tv_mfma_scale_f32_16x16x128_f8f6f4 %0, %1, %2, %0, %3, %4 op_sel_hi:[0,0,0]" : "+v"(acc[ai][bj][m][n]) : "v"(b_), "v"(a_), "v"(scw), "v"(scx)); } \
        __builtin_amdgcn_s_setprio(0); } while (0)
#define PG8_WAIT_V(n) asm volatile("s_waitcnt vmcnt(" #n ")" ::: "memory")
#define PG8_WAIT_L(n) asm volatile("s_waitcnt lgkmcnt(" #n ")" ::: "memory")
#define PG8_BAR __builtin_amdgcn_s_barrier()
#define PG8_SCHED __builtin_amdgcn_sched_barrier(0)
    Unit cur, nxt; int ui = 0;
    if (!S.next(0, cur)) return;
    f32x4 acc[2][2][4][2];
#pragma unroll
    for (int a = 0; a < 2; ++a)
#pragma unroll
        for (int b = 0; b < 2; ++b)
#pragma unroll
            for (int m = 0; m < 4; ++m)
#pragma unroll
                for (int n = 0; n < 2; ++n) acc[a][b][m][n] = (f32x4){0.f, 0.f, 0.f, 0.f};
    u32x4 At[4][2], B0[2][2], B1[2][2];
    int scw = 0x7a7a7a7a, scx = 0x7f7f7f7f; asm volatile("" : "+v"(scw), "+v"(scx));
    const char* cA = cur.A; const char* cB = cur.B;
    PG8_STAGE(PG8_SB(0, 0), cB, voffB); PG8_STAGE(PG8_SB(0, 1), cB + hstepB, voffB); PG8_STAGE(PG8_SA(0, 0), cA, voffA); PG8_STAGE(PG8_SA(0, 1), cA + hstepA, voffA);
    if (wr == 1) PG8_BAR;
    PG8_WAIT_V(2); PG8_BAR;
    PG8_STAGE(PG8_SB(1, 0), cB + kstepB, voffB); PG8_STAGE(PG8_SA(1, 0), cA + kstep, voffA); PG8_STAGE(PG8_SB(1, 1), cB + hstepB + kstepB, voffB);
    PG8_WAIT_V(6); PG8_BAR;
    for (;;) {
        const bool has_next = S.next(ui + 1, nxt);
        const char* nA = has_next ? nxt.A : cA; const char* nB = has_next ? nxt.B : cB;
#pragma unroll 1
        for (int t = 0; t < nt; t += 2) {
            const bool last = (t == nt - 2);
            const char* a1 = cA + (size_t)(t + 1) * kstep;
            const char* a2 = last ? nA : cA + (size_t)(t + 2) * kstep; const char* b2 = last ? nB : cB + (size_t)(t + 2) * kstepB;
            const char* a3 = a2 + kstep; const char* b3 = b2 + kstepB;
            PG8_LDB(B0, 0, 0); PG8_LDB(B1, 0, 1); PG8_SCHED; PG8_LDA(At, 0, 0); PG8_STAGE(PG8_SA(1, 1), a1 + hstepA, voffA);
            PG8_WAIT_V(8); PG8_WAIT_L(0); PG8_BAR; PG8_MMA(0, 0, At, B0); PG8_MMA(0, 1, At, B1); PG8_BAR; PG8_SCHED;
            PG8_LDA(At, 0, 1); PG8_STAGE(PG8_SB(0, 0), b2, voffB); PG8_STAGE(PG8_SB(0, 1), b2 + hstepB, voffB); PG8_STAGE(PG8_SA(0, 0), a2, voffA);
            PG8_WAIT_V(8); PG8_WAIT_L(0); PG8_BAR; PG8_MMA(1, 0, At, B0); PG8_MMA(1, 1, At, B1); PG8_BAR; PG8_SCHED;
            PG8_LDB(B0, 1, 0); PG8_LDB(B1, 1, 1); PG8_SCHED; PG8_LDA(At, 1, 0); PG8_STAGE(PG8_SA(0, 1), a2 + hstepA, voffA);
            PG8_WAIT_V(8); PG8_WAIT_L(0); PG8_BAR; PG8_MMA(0, 0, At, B0); PG8_MMA(0, 1, At, B1); PG8_BAR; PG8_SCHED;
            PG8_LDA(At, 1, 1); PG8_STAGE(PG8_SB(1, 0), b3, voffB); PG8_STAGE(PG8_SB(1, 1), b3 + hstepB, voffB); PG8_STAGE(PG8_SA(1, 0), a3, voffA);
            PG8_WAIT_V(8); PG8_WAIT_L(0); PG8_BAR; PG8_MMA(1, 0, At, B0); PG8_MMA(1, 1, At, B1); PG8_BAR; PG8_SCHED;
        }
        if (wr == 0) PG8_BAR;
        asm volatile("s_nop 15\n\ts_nop 7" ::: "memory");
        { int fr_ = fr, fq_ = fq; asm volatile("" : "+v"(fr_), "+v"(fq_));
          E(acc, cur, wr, wc, fr_, fq_); }
        if (!has_next) break;
#pragma unroll
        for (int a = 0; a < 2; ++a)
#pragma unroll
            for (int b = 0; b < 2; ++b)
#pragma unroll
                for (int m = 0; m < 4; ++m)
#pragma unroll
                    for (int n = 0; n < 2; ++n) acc[a][b][m][n] = (f32x4){0.f, 0.f, 0.f, 0.f};
        cur = nxt; cA = nA; cB = nB; ++ui;
        if (wr == 1) PG8_BAR;
    }
    PG8_WAIT_V(0);
    PG8_BAR;
#undef PG8_SA
#undef PG8_SB
#undef PG8_STAGE
#undef PG8_LDA
#undef PG8_LDB
#undef PG8_MMA
#undef PG8_WAIT_V
#undef PG8_WAIT_L
#undef PG8_BAR
#undef PG8_SCHED
}

struct EpiProj {
    static constexpr bool PERM = true;
    unsigned char* ws; const float* bbg;
    __device__ __forceinline__ void operator()(const f32x4 (&acc)[2][2][4][2], const Unit& u, int wr, int wc, int fr, int fq) const {
        const int pn = u.pn; size_t off; int ld, t0, act = 0;
        if (pn < 4) { off = WS_GQ; ld = 1024; t0 = 0; } else if (pn < 8) { off = WS_GK; ld = 1024; t0 = 4; } else if (pn < 16) { off = WS_GV; ld = 2048; t0 = 8; }
        else if (pn < 24) { off = WS_GR; ld = 2048; t0 = 16; act = 1; } else if (pn < 28) { off = WS_AQ; ld = 1024; t0 = 24; } else if (pn < 32) { off = WS_AK; ld = 1024; t0 = 28; }
        else if (pn < 36) { off = WS_AV; ld = 1024; t0 = 32; } else if (pn < 44) { off = WS_SG; ld = 2048; t0 = 36; act = 2; } else { off = WS_SA; ld = 2048; t0 = 44; act = 3; }
        bf16* base = (bf16*)(ws + off);
        const int colt = (pn - t0) * BM + wc * 32 + 8 * fq, row0 = u.pm * BM + wr * 64 + fr;
        f32x4 bv[2][2];
#pragma unroll
        for (int bj = 0; bj < 2; ++bj)
#pragma unroll
            for (int n = 0; n < 2; ++n) bv[bj][n] = act >= 2 ? *(const f32x4*)(bbg + (act - 2) * D + colt + bj * HALF + 4 * n) : (f32x4){0.f, 0.f, 0.f, 0.f};
#pragma unroll
        for (int ai = 0; ai < 2; ++ai)
#pragma unroll
            for (int m = 0; m < 4; ++m) { bf16* rowp = base + (size_t)(row0 + ai * HALF + m * 16) * ld + colt;
#pragma unroll
                for (int bj = 0; bj < 2; ++bj) { f32x4 v0 = acc[ai][bj][m][0] + bv[bj][0], v1 = acc[ai][bj][m][1] + bv[bj][1];
                    if (act == 1) {
#pragma unroll
                        for (int j = 0; j < 4; ++j) { v0[j] = v0[j] * sigmoidf_(v0[j]); v1[j] = v1[j] * sigmoidf_(v1[j]); } }
                    else if (act >= 2) {
#pragma unroll
                        for (int j = 0; j < 4; ++j) { v0[j] = sigmoidf_(v0[j]); v1[j] = sigmoidf_(v1[j]); } }
                    u32x4 w; w.x = cvt_pk_bf16(v0[0], v0[1]); w.y = cvt_pk_bf16(v0[2], v0[3]); w.z = cvt_pk_bf16(v1[0], v1[1]); w.w = cvt_pk_bf16(v1[2], v1[3]);
                    *(u32x4*)(rowp + bj * HALF) = w; } }
    }
};
template <int MODE> struct EpiBranch {
    static constexpr bool PERM = true;
    const bf16* gate; const bf16* tin; bf16* out;
    __device__ __forceinline__ void operator()(const f32x4 (&acc)[2][2][4][2], const Unit& u, int wr, int wc, int fr, int fq) const {
        const int colt = u.pn * BM + wc * 32 + 8 * fq, row0 = u.pm * BM + wr * 64 + fr;
#pragma unroll
        for (int ai = 0; ai < 2; ++ai)
#pragma unroll
            for (int m = 0; m < 4; ++m) { const size_t ro = (size_t)(row0 + ai * HALF + m * 16) * D + colt;
#pragma unroll
                for (int bj = 0; bj < 2; ++bj) {
                    const u32x4 gq = *(const u32x4*)(gate + ro + bj * HALF);
                    u32x4 tq = (u32x4){0u, 0u, 0u, 0u}; if (MODE == 1) tq = *(const u32x4*)(tin + ro + bj * HALF);
                    float r[8];
#pragma unroll
                    for (int j = 0; j < 4; ++j) { r[j] = acc[ai][bj][m][0][j]; r[4 + j] = acc[ai][bj][m][1][j]; }
#pragma unroll
                    for (int j = 0; j < 4; ++j) { const unsigned gw = gq[j], tw = tq[j];
                        r[2 * j] = r[2 * j] * __uint_as_float(gw << 16) + __uint_as_float(tw << 16);
                        r[2 * j + 1] = r[2 * j + 1] * __uint_as_float(gw & 0xffff0000u) + __uint_as_float(tw & 0xffff0000u); }
                    u32x4 w; w.x = cvt_pk_bf16(r[0], r[1]); w.y = cvt_pk_bf16(r[2], r[3]); w.z = cvt_pk_bf16(r[4], r[5]); w.w = cvt_pk_bf16(r[6], r[7]);
                    *(u32x4*)(out + ro + bj * HALF) = w; } }
    }
};
struct EpiResid {
    static constexpr bool PERM = false;
    const float* x; float* out;
    __device__ __forceinline__ void operator()(const f32x4 (&acc)[2][2][4][2], const Unit& u, int wr, int wc, int fr, int fq) const {
        const int col0 = u.pn * BM + wc * 32 + 4 * fq, row0 = u.pm * BM + wr * 64 + fr;
#pragma unroll
        for (int ai = 0; ai < 2; ++ai)
#pragma unroll
            for (int m = 0; m < 4; ++m) { const size_t ro = (size_t)(row0 + ai * HALF + m * 16) * D + col0;
#pragma unroll
                for (int bj = 0; bj < 2; ++bj)
#pragma unroll
                    for (int n = 0; n < 2; ++n) { const f32x4 xv = *(const f32x4*)(x + ro + bj * HALF + n * 16); *(f32x4*)(out + ro + bj * HALF + n * 16) = xv + acc[ai][bj][m][n]; } }
    }
};
struct EpiSwiglu {
    static constexpr bool PERM = true;
    const float* bgate; const float* bup; unsigned char* hd;
    __device__ __forceinline__ void operator()(const f32x4 (&acc)[2][2][4][2], const Unit& u, int wr, int wc, int fr, int fq) const {
        const int col = u.pn * HALF + wc * 32 + 8 * fq; const size_t row0 = (size_t)u.pm * BM + wr * 64 + fr;
        const float* bg = bgate + (size_t)u.e * DFF + col; const float* bu = bup + (size_t)u.e * DFF + col;
        const f32x4 g0 = *(const f32x4*)bg, g1 = *(const f32x4*)(bg + 4), u0 = *(const f32x4*)bu, u1 = *(const f32x4*)(bu + 4);
#pragma unroll
        for (int ai = 0; ai < 2; ++ai)
#pragma unroll
            for (int m = 0; m < 4; ++m) {
                float r[8];
#pragma unroll
                for (int j = 0; j < 4; ++j) {
                    const float ga = fminf(acc[ai][0][m][0][j] + g0[j], 7.f), ua = fminf(fmaxf(acc[ai][1][m][0][j] + u0[j], -7.f), 7.f);
                    const float gb = fminf(acc[ai][0][m][1][j] + g1[j], 7.f), ub = fminf(fmaxf(acc[ai][1][m][1][j] + u1[j], -7.f), 7.f);
                    r[j] = (ua + 1.f) * (ga * sigmoidf_(1.702f * ga)); r[4 + j] = (ub + 1.f) * (gb * sigmoidf_(1.702f * gb)); }
                int w0 = 0, w1 = 0;
                w0 = __builtin_amdgcn_cvt_pk_fp8_f32(r[0], r[1], w0, false); w0 = __builtin_amdgcn_cvt_pk_fp8_f32(r[2], r[3], w0, true);
                w1 = __builtin_amdgcn_cvt_pk_fp8_f32(r[4], r[5], w1, false); w1 = __builtin_amdgcn_cvt_pk_fp8_f32(r[6], r[7], w1, true);
                *(u32x2*)(hd + (row0 + ai * HALF + m * 16) * DFF + col) = (u32x2){(unsigned)w0, (unsigned)w1}; }
    }
};
struct EpiDown {
    static constexpr bool PERM = true;
    const float* bdown; const int* rpair; const float* rw; bf16* py;
    __device__ __forceinline__ void operator()(const f32x4 (&acc)[2][2][4][2], const Unit& u, int wr, int wc, int fr, int fq) const {
        const int colt = u.pn * BM + wc * 32 + 8 * fq; const size_t srow0 = (size_t)u.pm * BM + wr * 64 + fr;
        f32x4 bv[2][2];
#pragma unroll
        for (int bj = 0; bj < 2; ++bj)
#pragma unroll
            for (int n = 0; n < 2; ++n) bv[bj][n] = *(const f32x4*)(bdown + (size_t)u.e * D + colt + bj * HALF + 4 * n);
#pragma unroll
        for (int ai = 0; ai < 2; ++ai)
#pragma unroll
            for (int m = 0; m < 4; ++m) { const size_t srow = srow0 + ai * HALF + m * 16; const int pair = rpair[srow]; const float wgt = rw[srow];
                bf16* rowp = py + (size_t)pair * D + colt;
#pragma unroll
                for (int bj = 0; bj < 2; ++bj) { const f32x4 v0 = (acc[ai][bj][m][0] + bv[bj][0]) * wgt, v1 = (acc[ai][bj][m][1] + bv[bj][1]) * wgt;
                    u32x4 w; w.x = cvt_pk_bf16(v0[0], v0[1]); w.y = cvt_pk_bf16(v0[2], v0[3]); w.z = cvt_pk_bf16(v1[0], v1[1]); w.w = cvt_pk_bf16(v1[2], v1[3]);
                    *(u32x4*)(rowp + bj * HALF) = w; } }
    }
};

struct GlaSched {
    int mode, G, c; unsigned char* ws;
    __device__ __forceinline__ bool next(int i, Unit& u) const {
        const int L = i * G + c; const int nu = mode == 0 ? 128 : 256; if (L >= nu) return false;
        const int nh = mode == 0 ? L : (L >> 1), hv = mode == 0 ? 0 : (L & 1);
        u.pm = nh; u.pn = hv; u.e = 0; u.nrow = BM;
        if (mode == 0) { u.A = (const char*)(ws + WS_ACAT) + (size_t)nh * 256 * 512 * 2 + 512; u.B = (const char*)(ws + WS_KI) + (size_t)nh * 256 * 256 * 2; }
        else if (mode == 1) { u.A = (const char*)(ws + WS_BCAT) + (size_t)nh * 512 * 512 * 2 + (size_t)hv * 256 * 512 * 2; u.B = (const char*)(ws + WS_KET) + (size_t)nh * 256 * 256 * 2; }
        else { u.A = (const char*)(ws + WS_ACAT) + (size_t)nh * 256 * 512 * 2; u.B = (const char*)(ws + WS_BCAT) + (size_t)nh * 512 * 512 * 2 + (size_t)hv * 256 * 512 * 2; }
        return true;
    }
};
template <int MODE> struct EpiGla {
    static constexpr bool PERM = true;
    unsigned char* ws;
    __device__ __forceinline__ void operator()(const f32x4 (&acc)[2][2][4][2], const Unit& u, int wr, int wc, int fr, int fq) const {
        const int nh = u.pm, hv = u.pn; const int c8 = wc * 32 + 8 * fq, r0 = wr * 64 + fr;
        bf16* base; int ld;
        if (MODE == 0) { base = (bf16*)(ws + WS_ACAT) + (size_t)nh * 256 * 512; ld = 512; }
        else if (MODE == 1) { base = (bf16*)(ws + WS_UT) + (size_t)nh * 512 * 256 + (size_t)hv * 256 * 256; ld = 256; }
        else { base = (bf16*)(ws + WS_OB) + (size_t)(nh >> 2) * 256 * GLA_V + (nh & 3) * GLA_DV + hv * 256; ld = GLA_V; }
#pragma unroll
        for (int ai = 0; ai < 2; ++ai)
#pragma unroll
            for (int m = 0; m < 4; ++m) { const int row = r0 + ai * HALF + m * 16;
#pragma unroll
                for (int bj = 0; bj < 2; ++bj) { f32x4 v0 = acc[ai][bj][m][0], v1 = acc[ai][bj][m][1]; const int col = bj * HALF + c8;
                    if (MODE == 0) {
#pragma unroll
                        for (int j = 0; j < 4; ++j) { v0[j] = (col + j <= row) ? v0[j] : 0.f; v1[j] = (col + 4 + j <= row) ? v1[j] : 0.f; } }
                    u32x4 w; w.x = cvt_pk_bf16(v0[0], v0[1]); w.y = cvt_pk_bf16(v0[2], v0[3]); w.z = cvt_pk_bf16(v1[0], v1[1]); w.w = cvt_pk_bf16(v1[2], v1[3]);
                    *(u32x4*)(base + (size_t)row * ld + col) = w; } }
    }
};
}

constexpr int NWAVES = 8;
#ifndef GEMM_CUS
#define GEMM_CUS 152
#endif
constexpr int RING_BYTES = 131072, CTLZ_OFF = 139264, MISC_OFF = CTLZ_OFF + 320, LDS_BYTES = 147456;
constexpr int TAB_OFF = MISC_OFF + 128;

struct Frame {
    LAS unsigned char* lds; volatile LAS unsigned* MISC; unsigned* ctl; unsigned char* ws;
    int tid, lane, wave, vcu, G;
};
struct Args { const float* in[22]; float* out; unsigned char* ws; int ph_lo, ph_hi, li, pad; };

struct P0Item { const float* src; bf16* dst; int ldn, K; };
constexpr int P0_I_IN = 32 * (NPROJ / 32), P0_I_BG = 32 * 64, P0_I_BA = 16 * 64, P0_I_OUT = 32 * 64, P0_I_E = 32 * 64;
constexpr int P0_I_SMALL = P0_I_IN + P0_I_BG + P0_I_BA + P0_I_OUT, P0_NITEMS = P0_I_SMALL;
__device__ __forceinline__ P0Item p0_decode(Frame& F, const Args& a, int r) {
    constexpr int I_IN = P0_I_IN, I_BG = P0_I_BG, I_BA = P0_I_BA;
    P0Item it;
    if (r < I_IN) { const int nb = r % (NPROJ / 32), kb = r / (NPROJ / 32), d0 = nb * 32, s0 = d0 < C_GLR ? d0 : d0 + 16;
        it.src = a.in[2] + (size_t)kb * 64 * IN_COLS + s0; it.ldn = IN_COLS; it.dst = (bf16*)(F.ws + WS_WIN) + (size_t)d0 * D + kb * 64; it.K = D; return it; } r -= I_IN;
    if (r < I_BG) { const int nb = r % 64, kb = r / 64; it.src = a.in[10] + (size_t)kb * 64 * D + nb * 32; it.ldn = D; it.dst = (bf16*)(F.ws + WS_WBG) + (size_t)nb * 32 * GLA_V + kb * 64; it.K = GLA_V; return it; } r -= I_BG;
    if (r < I_BA) { const int nb = r % 64, kb = r / 64; it.src = a.in[11] + (size_t)kb * 64 * D + nb * 32; it.ldn = D; it.dst = (bf16*)(F.ws + WS_WBA) + (size_t)nb * 32 * ATT_W + kb * 64; it.K = ATT_W; return it; } r -= I_BA;
    { const int nb = r % 64, kb = r / 64; it.src = a.in[12] + (size_t)kb * 64 * D + nb * 32; it.ldn = D; it.dst = (bf16*)(F.ws + WS_WOUT) + (size_t)nb * 32 * D + kb * 64; it.K = D; }
    return it;
}
__device__ __forceinline__ void p0_load(const P0Item& it, int lane, f32x4 (&v)[8]) {
    const float* p = it.src + (size_t)(lane >> 3) * it.ldn + 4 * (lane & 7);
#pragma unroll
    for (int i = 0; i < 8; ++i) v[i] = __builtin_nontemporal_load((const GAS f32x4*)(p + (size_t)(8 * i) * it.ldn));
}
__device__ __forceinline__ void p0_convert(Frame& F, const Args& a, int it_lo, int it_hi, int gw, int NGW) {
    LAS float* scr = (LAS float*)(F.lds + F.wave * 16384);
    const int lane = F.lane;
    int itx = it_lo + gw;
    if (itx >= it_hi) return;
    P0Item cur = p0_decode(F, a, itx);
    f32x4 v[8]; p0_load(cur, lane, v);
    for (;;) {
        const int nx = itx + NGW; const bool more = nx < it_hi;
        P0Item nxt = cur; f32x4 vn[8];
        if (more) { nxt = p0_decode(F, a, nx); p0_load(nxt, lane, vn); }
#pragma unroll
        for (int i = 0; i < 8; ++i) { LAS float* q = scr + (8 * i + (lane >> 3)) * 33 + 4 * (lane & 7); q[0] = v[i].x; q[1] = v[i].y; q[2] = v[i].z; q[3] = v[i].w; }
        LDS_WAIT(); asm volatile("" ::: "memory");
        const int c = lane & 7;
#pragma unroll
        for (int j = 0; j < 4; ++j) { const int n = (lane >> 3) + 8 * j; const LAS float* sp = scr + (8 * c) * 33 + n;
            u32x4 o; o.x = pk2(sp[0 * 33], sp[1 * 33]); o.y = pk2(sp[2 * 33], sp[3 * 33]); o.z = pk2(sp[4 * 33], sp[5 * 33]); o.w = pk2(sp[6 * 33], sp[7 * 33]);
            __builtin_nontemporal_store(o, (GAS u32x4*)(cur.dst + (size_t)n * cur.K + 8 * c)); }
        LDS_WAIT(); asm volatile("" ::: "memory");
        if (!more) break;
        itx = nx; cur = nxt;
#pragma unroll
        for (int i = 0; i < 8; ++i) v[i] = vn[i];
    }
}
constexpr int P8_NITEMS = 3 * NE * 16 * 64;
__device__ __forceinline__ void p0_convert8(Frame& F, const Args& a, int gw, int NGW) {
    LAS unsigned char* tile = F.lds + F.wave * 16384;
    const int lane = F.lane, kq = lane >> 3, n4 = lane & 7;
    for (int it = gw; it < P8_NITEMS; it += NGW) {
        const int which = it / (NE * 1024), e = (it >> 10) & 31, kb = (it >> 6) & 15, nb = it & 63, k0 = kb * 128, n0 = nb * 32;
        const float* src; unsigned char* dst; int ldn;
        if (which < 2) { src = (which ? a.in[18] : a.in[16]) + (size_t)e * D * DFF + (size_t)k0 * DFF + n0; ldn = DFF;
            dst = F.ws + WS_GU + (size_t)e * 2 * DFF * D + (size_t)((n0 >> 7) * 256 + (n0 & 127) + which * 128) * D + k0; }
        else { src = a.in[20] + (size_t)e * DFF * D + (size_t)k0 * D + n0; ldn = D; dst = F.ws + WS_DN + (size_t)e * D * DFF + (size_t)n0 * DFF + k0; }
        const float* p = src + (size_t)(4 * kq) * ldn + 4 * n4;
        f32x4 v[4][4];
#pragma unroll
        for (int ps = 0; ps < 4; ++ps)
#pragma unroll
            for (int i = 0; i < 4; ++i) v[ps][i] = __builtin_nontemporal_load((const GAS f32x4*)(p + (size_t)(32 * ps + i) * ldn));
#pragma unroll
        for (int ps = 0; ps < 4; ++ps)
#pragma unroll
            for (int c = 0; c < 4; ++c) { int w = 0;
                w = __builtin_amdgcn_cvt_pk_fp8_f32(v[ps][0][c] * 32.f, v[ps][1][c] * 32.f, w, false); w = __builtin_amdgcn_cvt_pk_fp8_f32(v[ps][2][c] * 32.f, v[ps][3][c] * 32.f, w, true);
                *(LAS int*)(tile + (4 * n4 + c) * 144 + 32 * ps + 4 * kq) = w; }
        LDS_WAIT(); asm volatile("" ::: "memory");
#pragma unroll
        for (int j = 0; j < 4; ++j) { const int n = (lane >> 3) + 8 * j, c16 = lane & 7; const u32x4 g = *(const LAS u32x4*)(tile + n * 144 + 16 * c16);
            __builtin_nontemporal_store(g, (GAS u32x4*)(dst + (size_t)n * 2048 + 16 * c16)); }
        LDS_WAIT(); asm volatile("" ::: "memory");
    }
}
__device__ __forceinline__ void p0_rows(Frame& F, const Args& a) {
    { const float* g2 = a.in[13]; const float* wr = a.in[14]; float* WR = (float*)(F.ws + WS_WR);
      for (int i = (F.vcu * NWAVES * 64) + F.tid; i < D * NE; i += F.G * NWAVES * 64) WR[i] = g2[i >> 5] * wr[i]; }
}

template <int MODE> __device__ __forceinline__ void normproj_unit(Frame& F, const Args& a, int tile) {
    const int w = F.wave, lane = F.lane, tid = F.tid, i = lane & 31, kk = lane >> 5, t0 = tile * 32;
    const float* X = MODE == 0 ? a.in[0] : (const float*)(F.ws + WS_H1); const float* g = MODE == 0 ? a.in[1] : a.in[13];
    const float* WR = (const float*)(F.ws + WS_WR); const float* br = a.in[15]; const float* w_in = a.in[2];
    LAS float* part = (LAS float*)F.lds;
    LAS float* ssq = part + 8192;
    LAS float* lg = ssq + 256;
    LAS float* rs = lg + 32 * 33;
    LAS unsigned* lcnt = (LAS unsigned*)(rs + 32); LAS unsigned* lbase = lcnt + 32; LAS unsigned* prec = lbase + 32;
    if (MODE == 1 && tid < NE) lcnt[tid] = 0u;
    f32x16 acc;
#pragma unroll
    for (int r = 0; r < 16; ++r) acc[r] = 0.f;
    float ss = 0.f;
    const int kbase = 256 * w + 128 * kk;
    const float* arow = X + (size_t)(t0 + i) * D + kbase;
    const float* bcol = MODE == 0 ? (w_in + (size_t)kbase * IN_COLS + C_GLR + (i & 15)) : (WR + (size_t)kbase * NE + i);
    const size_t bstr = MODE == 0 ? IN_COLS : NE;
#pragma unroll 1
    for (int c = 0; c < 4; ++c) {
        f32x4 av[8];
#pragma unroll
        for (int q = 0; q < 8; ++q) av[q] = *(const GAS f32x4*)(arow + 32 * c + 4 * q);
#pragma unroll
        for (int q = 0; q < 8; ++q)
#pragma unroll
            for (int j = 0; j < 4; ++j) { const int kq = 32 * c + 4 * q + j; float b = bcol[(size_t)kq * bstr];
                if (MODE == 0) b = (i < 16) ? b * g[kbase + kq] : 0.f;
                acc = __builtin_amdgcn_mfma_f32_32x32x2f32(av[q][j], b, acc, 0, 0, 0); ss = fmaf(av[q][j], av[q][j], ss); }
    }
    ss += __shfl_xor(ss, 32);
    if (kk == 0) ssq[w * 32 + i] = ss;
#pragma unroll
    for (int r = 0; r < 16; ++r) part[(w * 32 + (r & 3) + 8 * (r >> 2) + 4 * kk) * 32 + i] = acc[r];
    __syncthreads();
#pragma unroll
    for (int rep = 0; rep < 2; ++rep) { const int idx = tid + 512 * rep, tok = idx >> 5, e = idx & 31; float sum = 0.f, st = 0.f;
#pragma unroll
        for (int ww = 0; ww < 8; ++ww) { sum += part[(ww * 32 + tok) * 32 + e]; st += ssq[ww * 32 + tok]; }
        const float rstd = rsqrtf(st * (1.f / D) + 1e-6f);
        if (MODE == 0) { if (e < 16) ((float*)(F.ws + WS_GLR))[(size_t)(t0 + tok) * 16 + e] = sum * rstd; }
        else lg[tok * 33 + e] = sum * rstd + br[e];
        if (e == 0) rs[tok] = rstd; }
    __syncthreads();
    bf16* HN = (bf16*)(F.ws + (MODE == 0 ? WS_XN : WS_HN)); float* topw = (float*)(F.ws + WS_TOPW); int* tope = (int*)(F.ws + WS_TOPE); int* tops = (int*)(F.ws + WS_TOPS);
    unsigned* cnt = F.ctl + CW_CNT;
#pragma unroll 1
    for (int q = 0; q < 4; ++q) {
        const int tok = 4 * w + q, t = t0 + tok, e = lane & 31;
        const float rstd = rs[tok];
        {
            const GAS f32x4* x4 = (const GAS f32x4*)(X + (size_t)t * D) + lane; GAS u32x2* o8 = (GAS u32x2*)(HN + (size_t)t * D) + lane;
#pragma unroll
            for (int j = 0; j < 8; ++j) { const f32x4 gg = *((const GAS f32x4*)g + lane + 64 * j); const f32x4 y = x4[64 * j] * rstd * gg;
                if (MODE == 0) { u32x2 wv; wv.x = pk2(y.x, y.y); wv.y = pk2(y.z, y.w); o8[64 * j] = wv; }
                else { int w8 = 0; w8 = __builtin_amdgcn_cvt_pk_fp8_f32(y.x, y.y, w8, false); w8 = __builtin_amdgcn_cvt_pk_fp8_f32(y.z, y.w, w8, true); ((GAS int*)((unsigned char*)HN + (size_t)t * D))[lane + 64 * j] = w8; } }
        }
        if (MODE == 1) {
        float vals[4]; int idxs[4]; float cur = lg[tok * 33 + e];
#pragma unroll
        for (int r = 0; r < 4; ++r) {
            float bv = cur; int bi = e;
#pragma unroll
            for (int o = 1; o < 32; o <<= 1) { const float ov = __shfl_xor(bv, o); const int oi = __shfl_xor(bi, o); if (ov > bv || (ov == bv && oi < bi)) { bv = ov; bi = oi; } }
            vals[r] = bv; idxs[r] = bi;
            if (e == bi) cur = -3.0e38f;
        }
        float ex[4], sum = 0.f;
#pragma unroll
        for (int r = 0; r < 4; ++r) { ex[r] = __expf(vals[r] - vals[0]); sum += ex[r]; }
#pragma unroll
        for (int r = 0; r < 4; ++r) {
            if (lane == r) { const int ee = idxs[r]; const unsigned lr = __hip_atomic_fetch_add(&lcnt[ee], 1u, __ATOMIC_RELAXED, __HIP_MEMORY_SCOPE_WORKGROUP);
                topw[t * 4 + r] = ex[r] / sum; tope[t * 4 + r] = ee; prec[tok * 4 + r] = (ee << 16) | lr; }
        }
        }
    }
    if (MODE == 1) {
        __syncthreads();
        if (tid < NE) { const unsigned c = lcnt[tid]; lbase[tid] = c ? atomicAdd(&cnt[64 * tid], c) : 0u; }
        __syncthreads();
        if (tid < 128) { const unsigned pr = prec[tid]; tops[(t0 * 4) + tid] = (int)(lbase[pr >> 16] + (pr & 0xffffu)); }
        __syncthreads();
        if (tid < NE) lcnt[tid] = 0u;
    }
    __syncthreads();
}
__device__ __forceinline__ void moe_table(Frame& F) {
    volatile LAS int* ts = (volatile LAS int*)(F.lds + TAB_OFF); volatile LAS int* cn = (volatile LAS int*)(F.lds + TAB_OFF + 256);
    __syncthreads();
    if (F.tid == 0) { int s = 0; for (int e = 0; e < NE; ++e) { const int c = (int)__hip_atomic_load(F.ctl + CW_CNT + 64 * e, __ATOMIC_RELAXED, __HIP_MEMORY_SCOPE_AGENT); cn[e] = c; ts[e] = s; s += (c + 255) >> 8; } ts[NE] = s; }
    __syncthreads();
}
__device__ __forceinline__ void p7_gather(Frame& F) {
    const int gw = F.vcu * NWAVES + F.wave, NGW = F.G * NWAVES, lane = F.lane;
    volatile LAS int* ts = (volatile LAS int*)(F.lds + TAB_OFF);
    const bf16* HN = (const bf16*)(F.ws + WS_HN); bf16* HNG = (bf16*)(F.ws + WS_HNG);
    const float* topw = (const float*)(F.ws + WS_TOPW); const int* tope = (const int*)(F.ws + WS_TOPE); const int* tops = (const int*)(F.ws + WS_TOPS);
    int* rpair = (int*)(F.ws + WS_RPAIR); float* rw = (float*)(F.ws + WS_RW);
    { volatile LAS int* cn = (volatile LAS int*)(F.lds + TAB_OFF + 256);
      for (int e = gw; e < NE; e += NGW) { const int c = cn[e], base = ts[e] * 256, padn = ((c + 255) & ~255) - c;
          for (int r = lane; r < padn; r += 64) { rpair[base + c + r] = S * 4; rw[base + c + r] = 0.f; } } }
    for (int t = gw; t < S; t += NGW) {
        const GAS u32x4* src = (const GAS u32x4*)((const unsigned char*)HN + (size_t)t * D) + lane; u32x4 v[2];
#pragma unroll
        for (int j = 0; j < 2; ++j) v[j] = src[64 * j];
#pragma unroll
        for (int r = 0; r < 4; ++r) { const int p = t * 4 + r; const int dst = ts[tope[p]] * 256 + tops[p];
            GAS u32x4* d = (GAS u32x4*)((unsigned char*)HNG + (size_t)dst * D) + lane;
#pragma unroll
            for (int j = 0; j < 2; ++j) d[64 * j] = v[j];
            if (lane == 0) { rpair[dst] = p; rw[dst] = topw[p]; } }
    }
}
__device__ __forceinline__ void p10_combine(Frame& F, const Args& a) {
    const int gw = F.vcu * NWAVES + F.wave, NGW = F.G * NWAVES, lane = F.lane;
    const bf16* PY = (const bf16*)(F.ws + WS_PY); float* out = a.out; const float* H1 = (const float*)(F.ws + WS_H1);
    for (int t = gw; t < S; t += NGW) {
#pragma unroll
        for (int j = 0; j < 4; ++j) {
            float r[8]; { const f32x4 h0 = *(const GAS f32x4*)(H1 + (size_t)t * D + 512 * j + 8 * lane), h1v = *(const GAS f32x4*)(H1 + (size_t)t * D + 512 * j + 8 * lane + 4);
                r[0] = h0.x; r[1] = h0.y; r[2] = h0.z; r[3] = h0.w; r[4] = h1v.x; r[5] = h1v.y; r[6] = h1v.z; r[7] = h1v.w; }
#pragma unroll
            for (int k = 0; k < 4; ++k) { const u32x4 p = *(const GAS u32x4*)(PY + (size_t)(t * 4 + k) * D + 512 * j + 8 * lane);
#pragma unroll
                for (int q = 0; q < 4; ++q) { r[2 * q] += __uint_as_float(p[q] << 16); r[2 * q + 1] += __uint_as_float(p[q] & 0xffff0000u); } }
            *(GAS f32x4*)(out + (size_t)t * D + 512 * j + 8 * lane) = (f32x4){r[0], r[1], r[2], r[3]};
            *(GAS f32x4*)(out + (size_t)t * D + 512 * j + 8 * lane + 4) = (f32x4){r[4], r[5], r[6], r[7]};
        }
    }
}


constexpr float ATT_QSCALE = 0.08838834764831845f * 1.4426950408889634f;
__device__ __forceinline__ void attn_prep_unit(Frame& F, const Args& a, int n, int h) {
    const int wave = F.wave, lane = F.lane, tid = F.tid;
    LAS bf16* kst = (LAS bf16*)(F.lds);
    LAS bf16* vst = (LAS bf16*)(F.lds + 16384);
    const bf16* AQ = (const bf16*)(F.ws + WS_AQ); const bf16* AK = (const bf16*)(F.ws + WS_AK); const bf16* AV = (const bf16*)(F.ws + WS_AV);
    bf16* QH = (bf16*)(F.ws + WS_QH);
    const float* qg = a.in[6]; const float* kg = a.in[7];
    const float gq0 = qg[2 * lane], gq1 = qg[2 * lane + 1], gk0 = kg[2 * lane], gk1 = kg[2 * lane + 1];
#pragma unroll
    for (int i = 0; i < 8; ++i) {
        const int row = n * 64 + wave * 8 + i; const size_t off = (size_t)row * ATT_W + h * ATT_HD + 2 * lane;
        const unsigned qv = *(const unsigned*)(AQ + off), kv = *(const unsigned*)(AK + off), vv = *(const unsigned*)(AV + off);
        const float q0 = __uint_as_float(qv << 16), q1 = __uint_as_float(qv & 0xffff0000u), k0 = __uint_as_float(kv << 16), k1 = __uint_as_float(kv & 0xffff0000u);
        const float rq = rsqrtf(wave_sum(q0 * q0 + q1 * q1) * (1.f / 128.f) + 1e-6f) * ATT_QSCALE, rk = rsqrtf(wave_sum(k0 * k0 + k1 * k1) * (1.f / 128.f) + 1e-6f);
        *(unsigned*)(QH + off) = pk2(q0 * rq * gq0, q1 * rq * gq1);
        *(LAS unsigned*)(kst + (wave * 8 + i) * 128 + 2 * lane) = pk2(k0 * rk * gk0, k1 * rk * gk1);
        *(LAS unsigned*)(vst + (wave * 8 + i) * 128 + 2 * lane) = vv;
    }
    __syncthreads();
    bf16* KI = (bf16*)(F.ws + WS_KIMG) + (size_t)(n * ATT_H + h) * 8192; bf16* VI = (bf16*)(F.ws + WS_VIMG) + (size_t)(n * ATT_H + h) * 8192;
#pragma unroll
    for (int i = 0; i < 2; ++i) {
        const int g = tid + 512 * i;
        { const int c16 = g >> 6, key = g & 63; const u32x4 v = *(const LAS u32x4*)(kst + key * 128 + c16 * 8); *(u32x4*)(KI + (size_t)g * 8) = v; }
        { const int kg8 = g >> 7, d = g & 127; unsigned short e[8];
#pragma unroll
          for (int j = 0; j < 8; ++j) e[j] = vst[(kg8 * 8 + j) * 128 + d];
          u32x4 v; v.x = e[0] | ((unsigned)e[1] << 16); v.y = e[2] | ((unsigned)e[3] << 16); v.z = e[4] | ((unsigned)e[5] << 16); v.w = e[6] | ((unsigned)e[7] << 16);
          *(u32x4*)(VI + (size_t)g * 8) = v; }
    }
    __syncthreads();
}

__device__ __forceinline__ int crow(int r, int hi) { return (r & 3) + 8 * (r >> 2) + 4 * hi; }
__device__ __forceinline__ void attn_unit(Frame& F, const Args& a, int n4, int h) {
    const int w = F.wave, lane = F.lane, r32 = lane & 31, hi = lane >> 5, tid = F.tid;
    const int p = w >> 1, half = w & 1, c = 4 * n4 + p, qrow0 = c * 64 + 32 * half;
    LAS unsigned char* lds = F.lds;
    LAS float* btab = (LAS float*)(lds + 65536); LAS float* xch = (LAS float*)(lds + 67584 + 256 * w); LAS bf16* ost = (LAS bf16*)(lds + 8192 * w);
    const float* relb = a.in[8] + h * 257;
    if (tid < 257) btab[tid] = relb[tid] * 1.4426950408889634f;
    const bf16* QH = (const bf16*)(F.ws + WS_QH);
    LAS unsigned char* qimg = lds + 69632 + 8192 * w;
#pragma unroll
    for (int d0 = 0; d0 < 8; ++d0) { const bf16x8 qv = *(const bf16x8*)(QH + (size_t)(qrow0 + r32) * ATT_W + h * ATT_HD + d0 * 16 + hi * 8);
        *(LAS bf16x8*)(qimg + ((2 * d0 + hi) * 32 + r32) * 16) = qv; }
    const char* KIMG = (const char*)(F.ws + WS_KIMG); const char* VIMG = (const char*)(F.ws + WS_VIMG);
    f32x16 o[4];
#pragma unroll
    for (int dt = 0; dt < 4; ++dt)
#pragma unroll
        for (int r = 0; r < 16; ++r) o[dt][r] = 0.f;
    float m = -1.0e30f, l = 0.f;
    const int s0 = (4 * n4 - 8 < 0) ? (8 - 4 * n4) : 0;
#define ATT_STAGE(s_) do { const int kc_ = 4 * n4 - 8 + (s_); const size_t gb_ = (size_t)(kc_ * ATT_H + h) * 16384; const unsigned lb_ = ((s_) & 1) * 32768; \
        _Pragma("unroll") for (int i_ = 0; i_ < 2; ++i_) { const int pc_ = w + 8 * i_; \
            __builtin_amdgcn_global_load_lds((const unsigned*)(KIMG + gb_ + pc_ * 1024 + lane * 16), (LAS unsigned*)(lds + lb_ + pc_ * 1024), 16, 0, 0); \
            __builtin_amdgcn_global_load_lds((const unsigned*)(VIMG + gb_ + pc_ * 1024 + lane * 16), (LAS unsigned*)(lds + lb_ + 16384 + pc_ * 1024), 16, 0, 0); } } while (0)
    ATT_STAGE(s0);
    for (int s = s0; s < 12; ++s) {
        asm volatile("s_waitcnt vmcnt(0) lgkmcnt(0)" ::: "memory");
        __builtin_amdgcn_s_barrier();
        if (s + 1 < 12) ATT_STAGE(s + 1);
        if (s >= p && s <= p + 8) {
            const LAS unsigned char* kb = lds + (s & 1) * 32768; const LAS unsigned char* vb = kb + 16384;
            f32x16 p0, p1;
#pragma unroll
            for (int r = 0; r < 16; ++r) { p0[r] = 0.f; p1[r] = 0.f; }
#pragma unroll
            for (int d0 = 0; d0 < 8; ++d0) {
                const bf16x8 k0 = *(const LAS bf16x8*)(kb + (2 * d0 + hi) * 1024 + r32 * 16), k1 = *(const LAS bf16x8*)(kb + (2 * d0 + hi) * 1024 + (r32 + 32) * 16);
                const bf16x8 qv = *(const LAS bf16x8*)(qimg + ((2 * d0 + hi) * 32 + r32) * 16);
                p0 = __builtin_amdgcn_mfma_f32_32x32x16_bf16(k0, qv, p0, 0, 0, 0);
                p1 = __builtin_amdgcn_mfma_f32_32x32x16_bf16(k1, qv, p1, 0, 0, 0);
                if (d0 & 1) __builtin_amdgcn_sched_barrier(0);
            }
            const int wrel = p + 8 - s;
            if (wrel >= 3) { const float bc = btab[256];
#pragma unroll
                for (int r = 0; r < 16; ++r) { p0[r] += bc; p1[r] += bc; } }
            else { const int base = 64 * wrel + 32 * half + r32 + 128;
#pragma unroll
                for (int r = 0; r < 16; ++r) { int i0 = base - crow(r, hi), i1 = i0 - 32; i0 = i0 > 256 ? 256 : i0; i1 = i1 > 256 ? 256 : i1; i1 = i1 < 0 ? 0 : i1; i0 = i0 < 0 ? 0 : i0; p0[r] += btab[i0]; p1[r] += btab[i1]; } }
            float mx = p0[0];
#pragma unroll
            for (int r = 1; r < 16; ++r) mx = fmaxf(mx, p0[r]);
#pragma unroll
            for (int r = 0; r < 16; ++r) mx = fmaxf(mx, p1[r]);
            mx = fmaxf(mx, __shfl_xor(mx, 32));
            const float mn = fmaxf(m, mx), alpha = __builtin_amdgcn_exp2f(m - mn);
            float ps = 0.f;
#pragma unroll
            for (int r = 0; r < 16; ++r) { p0[r] = __builtin_amdgcn_exp2f(p0[r] - mn); p1[r] = __builtin_amdgcn_exp2f(p1[r] - mn); ps += p0[r] + p1[r]; }
            l = l * alpha + ps;
            if (__any(mn > m)) {
                if (hi == 0) xch[r32] = alpha;
                asm volatile("s_waitcnt lgkmcnt(0)" ::: "memory");
#pragma unroll
                for (int g = 0; g < 4; ++g) { const f32x4 av = *(const LAS f32x4*)(xch + 8 * g + 4 * hi);
#pragma unroll
                    for (int dt = 0; dt < 4; ++dt) { o[dt][4 * g] *= av[0]; o[dt][4 * g + 1] *= av[1]; o[dt][4 * g + 2] *= av[2]; o[dt][4 * g + 3] *= av[3]; } }
            }
            m = mn;
            bf16x8 pa[4];
#pragma unroll
            for (int ks = 0; ks < 4; ++ks) { const f32x16& src = (ks < 2) ? p0 : p1; const int b = (ks & 1) * 8; u32x4 t;
                t.x = cvt_pk_bf16(src[b], src[b + 1]); t.y = cvt_pk_bf16(src[b + 2], src[b + 3]); t.z = cvt_pk_bf16(src[b + 4], src[b + 5]); t.w = cvt_pk_bf16(src[b + 6], src[b + 7]);
                pa[ks] = __builtin_bit_cast(bf16x8, t); }
#pragma unroll
            for (int dt = 0; dt < 4; ++dt)
#pragma unroll
                for (int ks = 0; ks < 4; ++ks) {
                    const LAS unsigned char* vp = vb + (2 * ks) * 2048 + (32 * dt + r32) * 16 + 8 * hi;
                    const u32x2 lo = *(const LAS u32x2*)vp, hh = *(const LAS u32x2*)(vp + 2048);
                    const u32x4 bq = (u32x4){lo.x, lo.y, hh.x, hh.y};
                    o[dt] = __builtin_amdgcn_mfma_f32_32x32x16_bf16(pa[ks], __builtin_bit_cast(bf16x8, bq), o[dt], 0, 0, 0);
                    if (ks == 3) __builtin_amdgcn_sched_barrier(0);
                }
        }
    }
#undef ATT_STAGE
    asm volatile("s_waitcnt lgkmcnt(0)" ::: "memory");
    __builtin_amdgcn_s_barrier();
    l += __shfl_xor(l, 32);
    if (hi == 0) xch[32 + r32] = 1.f / l;
    asm volatile("s_waitcnt lgkmcnt(0)" ::: "memory");
#pragma unroll
    for (int g = 0; g < 4; ++g) { const f32x4 iv = *(const LAS f32x4*)(xch + 32 + 8 * g + 4 * hi);
#pragma unroll
        for (int dt = 0; dt < 4; ++dt)
#pragma unroll
            for (int j = 0; j < 4; ++j) ost[(8 * g + 4 * hi + j) * 128 + 32 * dt + r32] = (bf16)f2bf(o[dt][4 * g + j] * iv[j]); }
    asm volatile("s_waitcnt lgkmcnt(0)" ::: "memory");
    bf16* YA = (bf16*)(F.ws + WS_YA);
#pragma unroll
    for (int i = 0; i < 8; ++i) { const int g = i * 64 + lane, row = g >> 4, c16 = g & 15; const u32x4 v = *(const LAS u32x4*)(ost + row * 128 + c16 * 8);
        *(u32x4*)(YA + (size_t)(qrow0 + row) * ATT_W + h * ATT_HD + c16 * 8) = v; }
    asm volatile("s_waitcnt vmcnt(0) lgkmcnt(0)" ::: "memory");
    __builtin_amdgcn_s_barrier();
}


__device__ __forceinline__ void gla_prep_unit(Frame& F, const Args& a, int n, int cg) {
    const int tid = F.tid, cq = tid & 15, seg = tid >> 4;
    const int h = cg >> 2, dk0 = (cg & 3) * 64 + 4 * cq, col0 = h * GLA_DK + dk0, nh = n * GLA_H + h;
    const float* wgu = a.in[3]; const float* bgt = a.in[4]; const float* GLR = (const float*)(F.ws + WS_GLR);
    const bf16* GQ = (const bf16*)(F.ws + WS_GQ); const bf16* GK = (const bf16*)(F.ws + WS_GK);
    LAS float* tot = (LAS float*)F.lds;
    LAS float* wl = tot + 2048;
    if (seg < 16) *(LAS f32x4*)(wl + seg * 64 + 4 * cq) = *(const f32x4*)(wgu + seg * GLA_QK + col0);
    __syncthreads();
    const f32x4 bgv = *(const f32x4*)(bgt + col0);
    f32x4 cs[8]; f32x4 run = (f32x4){0.f, 0.f, 0.f, 0.f};
    const int t0 = n * 256 + seg * 8;
#pragma unroll
    for (int i = 0; i < 8; ++i) {
        const f32x4* gp = (const f32x4*)(GLR + (size_t)(t0 + i) * 16); f32x4 z = bgv;
#pragma unroll
        for (int q = 0; q < 4; ++q) { const f32x4 gv = gp[q]; const LAS f32x4* wp = (const LAS f32x4*)(wl + 4 * q * 64 + 4 * cq);
            z += wp[0] * gv.x; z += wp[16] * gv.y; z += wp[32] * gv.z; z += wp[48] * gv.w; }
#pragma unroll
        for (int j = 0; j < 4; ++j) run[j] += log_sigmoid(z[j]) * (1.f / 16.f);
        cs[i] = run;
    }
    *(LAS f32x4*)(tot + seg * 64 + 4 * cq) = run;
    __syncthreads();
    f32x4 off = (f32x4){0.f, 0.f, 0.f, 0.f}, total = (f32x4){0.f, 0.f, 0.f, 0.f};
    for (int sg = 0; sg < 32; ++sg) { const f32x4 tv = *(const LAS f32x4*)(tot + sg * 64 + 4 * cq); total += tv; if (sg < seg) off += tv; }
    unsigned kew[4][4];
    bf16* ACAT = (bf16*)(F.ws + WS_ACAT); bf16* KI = (bf16*)(F.ws + WS_KI); bf16* KET = (bf16*)(F.ws + WS_KET);
    float kprev[4];
#pragma unroll
    for (int i = 0; i < 8; ++i) {
        const size_t trow = (size_t)(t0 + i);
        const u32x2 qv = *(const u32x2*)(GQ + trow * GLA_QK + col0), kv = *(const u32x2*)(GK + trow * GLA_QK + col0);
        float q[4] = {__uint_as_float(qv.x << 16), __uint_as_float(qv.x & 0xffff0000u), __uint_as_float(qv.y << 16), __uint_as_float(qv.y & 0xffff0000u)};
        float k[4] = {__uint_as_float(kv.x << 16), __uint_as_float(kv.x & 0xffff0000u), __uint_as_float(kv.y << 16), __uint_as_float(kv.y & 0xffff0000u)};
        float qd[4], ki[4], ke[4];
#pragma unroll
        for (int j = 0; j < 4; ++j) { const float bc = cs[i][j] + off[j]; qd[j] = q[j] * 0.0625f * __expf(bc); ki[j] = k[j] * __expf(-bc); ke[j] = k[j] * __expf(total[j] - bc); }
        const size_t lrow = (size_t)nh * 256 + seg * 8 + i;
        u32x2 o; o.x = pk2(qd[0], qd[1]); o.y = pk2(qd[2], qd[3]); *(u32x2*)(ACAT + lrow * 512 + 256 + dk0) = o;
        o.x = pk2(ki[0], ki[1]); o.y = pk2(ki[2], ki[3]); *(u32x2*)(KI + lrow * 256 + dk0) = o;
        if (i & 1) {
#pragma unroll
            for (int j = 0; j < 4; ++j) kew[j][i >> 1] = pk2(kprev[j], ke[j]); }
        else {
#pragma unroll
            for (int j = 0; j < 4; ++j) kprev[j] = ke[j]; }
    }
#pragma unroll
    for (int j = 0; j < 4; ++j) *(u32x4*)(KET + ((size_t)nh * 256 + dk0 + j) * 256 + seg * 8) = (u32x4){kew[j][0], kew[j][1], kew[j][2], kew[j][3]};
    if (seg == 0) *(f32x4*)((float*)(F.ws + WS_DEC) + n * GLA_QK + col0) = (f32x4){__expf(total[0]), __expf(total[1]), __expf(total[2]), __expf(total[3])};
    __syncthreads();
}
__device__ __forceinline__ void gla_vt_unit(Frame& F, int n, int h, int g8) {
    const int tid = F.tid; const int nh = n * GLA_H + h;
    LAS bf16* tile = (LAS bf16*)F.lds;
    const bf16* GV = (const bf16*)(F.ws + WS_GV); bf16* BCAT = (bf16*)(F.ws + WS_BCAT);
#pragma unroll
    for (int ps = 0; ps < 4; ++ps) { const int row = (tid >> 3) + 64 * ps, ch = tid & 7;
        const u32x4 v = *(const u32x4*)(GV + (size_t)(n * 256 + row) * GLA_V + h * GLA_DV + g8 * 64 + ch * 8);
        *(LAS u32x2*)(tile + row * 72 + ch * 8) = (u32x2){v.x, v.y}; *(LAS u32x2*)(tile + row * 72 + ch * 8 + 4) = (u32x2){v.z, v.w}; }
    __syncthreads();
#pragma unroll
    for (int i = 0; i < 4; ++i) { const int g = tid + 512 * i, c = g & 63, tg = g >> 6; unsigned short e[8];
#pragma unroll
        for (int j = 0; j < 8; ++j) e[j] = tile[(tg * 8 + j) * 72 + c];
        u32x4 v; v.x = e[0] | ((unsigned)e[1] << 16); v.y = e[2] | ((unsigned)e[3] << 16); v.z = e[4] | ((unsigned)e[5] << 16); v.w = e[6] | ((unsigned)e[7] << 16);
        *(u32x4*)(BCAT + ((size_t)nh * 512 + g8 * 64 + c) * 512 + tg * 8) = v; }
    __syncthreads();
}
__device__ __forceinline__ void gla_scan(Frame& F) {
    const bf16* UT = (const bf16*)(F.ws + WS_UT); bf16* BCAT = (bf16*)(F.ws + WS_BCAT); const float* DEC = (const float*)(F.ws + WS_DEC);
    for (int idx = F.vcu * (NWAVES * 64) + F.tid; idx < GLA_H * GLA_DV * 64; idx += F.G * NWAVES * 64) {
        const int dk4 = (idx & 63) * 4, dv = (idx >> 6) & 511, h = idx >> 15;
        float s[4] = {0.f, 0.f, 0.f, 0.f};
#pragma unroll 8
        for (int n = 0; n < 32; ++n) {
            const size_t nh = (size_t)n * GLA_H + h;
            u32x2 o; o.x = pk2(s[0], s[1]); o.y = pk2(s[2], s[3]); *(u32x2*)(BCAT + (nh * 512 + dv) * 512 + 256 + dk4) = o;
            const u32x2 uv = *(const u32x2*)(UT + (nh * 512 + dv) * 256 + dk4); const f32x4 dc = *(const f32x4*)(DEC + n * GLA_QK + h * GLA_DK + dk4);
            s[0] = s[0] * dc.x + __uint_as_float(uv.x << 16); s[1] = s[1] * dc.y + __uint_as_float(uv.x & 0xffff0000u);
            s[2] = s[2] * dc.z + __uint_as_float(uv.y << 16); s[3] = s[3] * dc.w + __uint_as_float(uv.y & 0xffff0000u);
        }
    }
}
__device__ __forceinline__ void gla_norm(Frame& F, const Args& a) {
    const int gw = F.vcu * NWAVES + F.wave, NGW = F.G * NWAVES, lane = F.lane;
    const bf16* OB = (const bf16*)(F.ws + WS_OB); const bf16* GR = (const bf16*)(F.ws + WS_GR); bf16* YG = (bf16*)(F.ws + WS_YG); const float* g = a.in[5];
    const f32x4 g0 = *(const f32x4*)(g + 8 * lane), g1 = *(const f32x4*)(g + 8 * lane + 4);
    for (int wi = gw; wi < S * GLA_H; wi += NGW) {
        const size_t off = (size_t)(wi >> 2) * GLA_V + (wi & 3) * GLA_DV + 8 * lane;
        const u32x4 ov = *(const u32x4*)(OB + off), rv = *(const u32x4*)(GR + off);
        float o[8], r[8]; float ss = 0.f;
#pragma unroll
        for (int j = 0; j < 4; ++j) { o[2 * j] = __uint_as_float(ov[j] << 16); o[2 * j + 1] = __uint_as_float(ov[j] & 0xffff0000u); r[2 * j] = __uint_as_float(rv[j] << 16); r[2 * j + 1] = __uint_as_float(rv[j] & 0xffff0000u); }
#pragma unroll
        for (int j = 0; j < 8; ++j) ss += o[j] * o[j];
        const float rstd = rsqrtf(wave_sum(ss) * (1.f / GLA_DV) + 1e-6f);
        u32x4 w; w.x = pk2(o[0] * rstd * g0.x * r[0], o[1] * rstd * g0.y * r[1]); w.y = pk2(o[2] * rstd * g0.z * r[2], o[3] * rstd * g0.w * r[3]);
        w.z = pk2(o[4] * rstd * g1.x * r[4], o[5] * rstd * g1.y * r[5]); w.w = pk2(o[6] * rstd * g1.z * r[6], o[7] * rstd * g1.w * r[7]);
        *(u32x4*)(YG + off) = w;
    }
}

__global__ void __launch_bounds__(NWAVES * 64, 2) fwd(Args args) {
    extern __shared__ __attribute__((aligned(16))) unsigned char lds_raw[];
    Frame F;
    F.lds = (LAS unsigned char*)lds_raw; F.MISC = (volatile LAS unsigned*)(F.lds + MISC_OFF);
    F.tid = threadIdx.x; F.lane = F.tid & 63; F.wave = __builtin_amdgcn_readfirstlane(F.tid >> 6);
    F.G = gridDim.x; { const int bx = blockIdx.x; F.vcu = (F.G % 8 == 0) ? (bx % 8) * (F.G / 8) + bx / 8 : bx; }
    F.ws = args.ws; F.ctl = (unsigned*)(args.ws + WS_CTL);
    for (int u = F.tid; u < (LDS_BYTES - CTLZ_OFF) / 4; u += NWAVES * 64) ((LAS unsigned*)(F.lds + CTLZ_OFF))[u] = 0u;
    __syncthreads();
    XcdBarrier bar = xcd_barrier_post(F.ctl + CW_BAR + args.li * XCD_BAR_WORDS, F.MISC + 8);
    const int lo = args.ph_lo, hi = args.ph_hi;
#define IN(k) (lo <= (k) && (k) < hi)
#define SEAM(k) do { if (IN(k) && IN((k) + 1)) xcd_barrier(bar); } while (0)
    unsigned char* ws = args.ws;
#ifndef DUP_MASK
#define DUP_MASK 0
#endif
#define DUP(k) ((DUP_MASK >> (k)) & 1)
#define PHASE(k, ...) do { if (IN(k)) { __VA_ARGS__ if (DUP(k)) { xcd_barrier(bar); __VA_ARGS__ } } SEAM(k); } while (0)
    const int gcus = (F.G == 256) ? GEMM_CUS : F.G;
    PHASE(0, { p0_convert(F, args, 0, P0_NITEMS, F.vcu * NWAVES + F.wave, F.G * NWAVES); if (gcus == F.G) p0_convert8(F, args, F.vcu * NWAVES + F.wave, F.G * NWAVES); p0_rows(F, args);
        for (int u = F.vcu; u < S / 32; u += F.G) normproj_unit<0>(F, args, u); });
    PHASE(1, { if ((int)blockIdx.x < gcus) { pg8::DenseSched Sc; Sc.init(ws + WS_XN, ws + WS_WIN, S, NPROJ, D, gcus, (int)blockIdx.x); pg8::EpiProj E{ws, args.in[9]};
            pg8::gemm_phase<pg8::EpiProj, pg8::DenseSched>(F.lds, D, D, D, Sc, E); }
        else p0_convert8(F, args, ((int)blockIdx.x - gcus) * NWAVES + F.wave, (F.G - gcus) * NWAVES); });
    PHASE(2, { for (int rp = 0; rp < 1 + DUP(16); ++rp) for (int u = F.vcu; u < NCH * ATT_H; u += F.G) attn_prep_unit(F, args, u >> 3, u & 7);
        for (int rp = 0; rp < 1 + DUP(17); ++rp) for (int u = F.vcu; u < 32 * 16; u += F.G) gla_prep_unit(F, args, u >> 4, u & 15);
        for (int rp = 0; rp < 1 + DUP(18); ++rp) for (int u = F.vcu; u < 32 * GLA_H * 8; u += F.G) gla_vt_unit(F, u >> 5, (u >> 3) & 3, u & 7); });
    PHASE(3, { for (int u = F.vcu; u < (NCH / 4) * ATT_H; u += F.G) attn_unit(F, args, u >> 3, u & 7);
        { pg8::GlaSched Sc{0, F.G, F.G - 1 - (int)blockIdx.x, ws}; pg8::EpiGla<0> E{ws}; pg8::gemm_phase<pg8::EpiGla<0>, pg8::GlaSched>(F.lds, 256, 512, 256, Sc, E); }
        { pg8::GlaSched Sc{1, F.G, (int)blockIdx.x, ws}; pg8::EpiGla<1> E{ws}; pg8::gemm_phase<pg8::EpiGla<1>, pg8::GlaSched>(F.lds, 256, 512, 256, Sc, E); } });
    PHASE(4, { gla_scan(F); });
    PHASE(5, { pg8::GlaSched Sc{2, F.G, (int)blockIdx.x, ws}; pg8::EpiGla<2> E{ws}; pg8::gemm_phase<pg8::EpiGla<2>, pg8::GlaSched>(F.lds, 512, 512, 512, Sc, E); });
    PHASE(6, { gla_norm(F, args); });
    PHASE(7, { pg8::DenseSched Sc; Sc.init(ws + WS_YG, ws + WS_WBG, S, D, GLA_V, F.G, (int)blockIdx.x); pg8::EpiBranch<0> E{(const bf16*)(ws + WS_SG), nullptr, (bf16*)(ws + WS_T)};
        pg8::gemm_phase<pg8::EpiBranch<0>, pg8::DenseSched>(F.lds, GLA_V, GLA_V, GLA_V, Sc, E); });
    PHASE(8, { pg8::DenseSched Sc; Sc.init(ws + WS_YA, ws + WS_WBA, S, D, ATT_W, F.G, (int)blockIdx.x); pg8::EpiBranch<1> E{(const bf16*)(ws + WS_SA), (const bf16*)(ws + WS_T), (bf16*)(ws + WS_MG)};
        pg8::gemm_phase<pg8::EpiBranch<1>, pg8::DenseSched>(F.lds, ATT_W, ATT_W, ATT_W, Sc, E); });
    PHASE(9, { pg8::DenseSched Sc; Sc.init(ws + WS_MG, ws + WS_WOUT, S, D, D, F.G, (int)blockIdx.x); pg8::EpiResid E{args.in[0], (float*)(ws + WS_H1)};
        pg8::gemm_phase<pg8::EpiResid, pg8::DenseSched>(F.lds, D, D, D, Sc, E); });
    PHASE(10, { for (int u = F.vcu; u < S / 32; u += F.G) normproj_unit<1>(F, args, u); });
    PHASE(11, { moe_table(F); p7_gather(F); });
    PHASE(12, { moe_table(F); pg8::MoeSched Sc; Sc.init(ws + WS_HNG, ws + WS_GU, (volatile LAS int*)(F.lds + TAB_OFF), (volatile LAS int*)(F.lds + TAB_OFF + 256), 16, D, F.G, (int)blockIdx.x);
        pg8::EpiSwiglu E{args.in[17], args.in[19], ws + WS_HD};
        pg8::gemm_phase8<pg8::EpiSwiglu, pg8::MoeSched>(F.lds, D, D, D, Sc, E); });
    PHASE(13, { moe_table(F); pg8::MoeSched Sc; Sc.init(ws + WS_HD, ws + WS_DN, (volatile LAS int*)(F.lds + TAB_OFF), (volatile LAS int*)(F.lds + TAB_OFF + 256), 8, DFF, F.G, (int)blockIdx.x);
        pg8::EpiDown E{args.in[21], (const int*)(ws + WS_RPAIR), (const float*)(ws + WS_RW), (bf16*)(ws + WS_PY)};
        pg8::gemm_phase8<pg8::EpiDown, pg8::MoeSched>(F.lds, DFF, DFF, DFF, Sc, E); });
    PHASE(14, { p10_combine(F, args); });
#undef PHASE
#undef IN
#undef SEAM
}

extern "C" void kernel_launch(void* const* d_in, const int* in_sizes, int n_in, void* d_out, int out_size, void* d_ws, size_t ws_size, hipStream_t stream) {
    static int grid = 0;
    if (grid == 0) {
        if (n_in != 22 || out_size != S * D || ws_size < WS_END) { fprintf(stderr, "kernel_launch: unexpected problem (n_in %d out %d ws %zu)\n", n_in, out_size, ws_size); grid = -1; return; }
        int dev = 0, cus = 0, per_cu = 0;
        if (hipGetDevice(&dev) != hipSuccess || hipDeviceGetAttribute(&cus, hipDeviceAttributeMultiprocessorCount, dev) != hipSuccess) { grid = -1; return; }
        if (hipFuncSetAttribute((const void*)fwd, hipFuncAttributeMaxDynamicSharedMemorySize, LDS_BYTES) != hipSuccess) { fprintf(stderr, "kernel_launch: hipFuncSetAttribute failed\n"); grid = -1; return; }
        if (hipOccupancyMaxActiveBlocksPerMultiprocessor(&per_cu, (const void*)fwd, NWAVES * 64, LDS_BYTES) != hipSuccess || per_cu < 1) fprintf(stderr, "kernel_launch: occupancy query says %d\n", per_cu);
        (void)hipGetLastError();
        grid = cus;
    }
    if (grid < 0) return;
    (void)hipMemsetAsync((char*)d_ws + WS_CTL, 0, CTL_ZERO_BYTES, stream);
    Args a{};
    for (int i = 0; i < 22; ++i) a.in[i] = (const float*)d_in[i];
    a.out = (float*)d_out; a.ws = (unsigned char*)d_ws;
    a.ph_lo = 0; a.ph_hi = 15; a.li = 0;
    hipLaunchKernelGGL(fwd, dim3(grid), dim3(NWAVES * 64), LDS_BYTES, stream, a);
}
```

```cpp
#include <hip/hip_runtime.h>
#include <stdint.h>
#include <cstdio>

constexpr int S = 8192, D = 2048;
constexpr int GLA_H = 4, GLA_DK = 256, GLA_DV = 512, GLA_QK = 1024, GLA_V = 2048;
constexpr int ATT_H = 8, ATT_HD = 128, ATT_W = 1024, NCH = S / 64;
constexpr int NE = 32, DFF = 2048;
constexpr int IN_COLS = 13328, C_GLR = 6144;
constexpr int NPROJ = 13312;
constexpr int MAXROWS = 32768 + NE * 256;

constexpr size_t MiB = 1u << 20;
constexpr size_t WS_CTL = 0, CTL_ZERO_BYTES = 1 * MiB;
constexpr size_t WS_TOPW = 1 * MiB, WS_TOPE = WS_TOPW + 128 * 1024, WS_TOPS = WS_TOPE + 128 * 1024, WS_RPAIR = WS_TOPS + 128 * 1024, WS_RW = WS_RPAIR + 256 * 1024;
constexpr size_t WS_GLR = 2 * MiB, WS_WR = 3 * MiB;
constexpr size_t WS_WIN = 8 * MiB, WS_WBG = 60 * MiB, WS_WBA = 68 * MiB, WS_WOUT = 72 * MiB, WS_GU = 80 * MiB, WS_DN = 592 * MiB;
constexpr size_t WS_XN = 848 * MiB, WS_GQ = 880 * MiB, WS_GK = 896 * MiB, WS_GV = 912 * MiB, WS_GR = 944 * MiB, WS_AQ = 976 * MiB, WS_AK = 992 * MiB, WS_AV = 1008 * MiB;
constexpr size_t WS_SG = 1024 * MiB, WS_SA = 1056 * MiB, WS_YG = 1088 * MiB, WS_YA = 1120 * MiB, WS_T = 1136 * MiB, WS_MG = 1168 * MiB, WS_HN = 1200 * MiB;
constexpr size_t WS_HNG = 1232 * MiB, WS_HD = 1392 * MiB, WS_PY = 1552 * MiB, WS_QH = 1681 * MiB, WS_KIMG = 1697 * MiB, WS_VIMG = 1713 * MiB;
constexpr size_t WS_ACAT = 1729 * MiB, WS_BCAT = 1761 * MiB, WS_KI = 1825 * MiB, WS_KET = 1841 * MiB, WS_UT = 1857 * MiB, WS_DEC = 1889 * MiB, WS_OB = 1890 * MiB, WS_H1 = 1922 * MiB, WS_END = 1986 * MiB;
constexpr int CW_CNT = 256;
constexpr int CW_BAR = 4096;

typedef unsigned short bf16;
typedef short bf16x8 __attribute__((ext_vector_type(8)));
typedef float f32x4 __attribute__((ext_vector_type(4)));
typedef float f32x16 __attribute__((ext_vector_type(16)));
typedef unsigned u32x4 __attribute__((ext_vector_type(4)));
typedef unsigned u32x2 __attribute__((ext_vector_type(2)));
typedef int v8i __attribute__((ext_vector_type(8)));
#define LAS __attribute__((address_space(3)))
#define GAS __attribute__((address_space(1)))
__device__ __forceinline__ float bf2f(bf16 v) { return __uint_as_float((unsigned)v << 16); }
__device__ __forceinline__ unsigned f2bf(float f) { unsigned u = __float_as_uint(f); return (u + 0x7fffu + ((u >> 16) & 1u)) >> 16; }
__device__ __forceinline__ unsigned pk2(float lo, float hi) { return f2bf(lo) | (f2bf(hi) << 16); }
__device__ __forceinline__ unsigned cvt_pk_bf16(float lo, float hi) { unsigned r; asm volatile("v_cvt_pk_bf16_f32 %0, %1, %2" : "=v"(r) : "v"(lo), "v"(hi)); return r; }
__device__ __forceinline__ float wave_sum(float v) {
#pragma unroll
    for (int o = 1; o < 64; o <<= 1) v += __shfl_xor(v, o);
    return v;
}
__device__ __forceinline__ float sigmoidf_(float x) { return 1.f / (1.f + __expf(-x)); }
__device__ __forceinline__ float log_sigmoid(float z) { return fminf(z, 0.f) - log1pf(__expf(-fabsf(z))); }
#define LDS_WAIT() asm volatile("s_waitcnt lgkmcnt(0)" ::: "memory")
#define VM_WAIT() asm volatile("s_waitcnt vmcnt(0)" ::: "memory")

#define XB_TMO      128
#define XB_XCNT(j)  (256  + 64 * (j))
#define XB_XSUB(j)  (1280 + 64 * (j))
#define XB_XGEN(j)  (2304 + 64 * (j))
#define XB_TOP      3328
#define XB_TOPGEN   3392
#define XCD_BAR_WORDS 3456
#define XB_SPIN_CAP (1u << 18)
__device__ __forceinline__ unsigned xb_ld(unsigned* p)              { return __hip_atomic_load(p, __ATOMIC_RELAXED, __HIP_MEMORY_SCOPE_AGENT); }
__device__ __forceinline__ unsigned xb_add(unsigned* p, unsigned v) { return __hip_atomic_fetch_add(p, v, __ATOMIC_RELAXED, __HIP_MEMORY_SCOPE_AGENT); }
__device__ __forceinline__ unsigned xb_xcc_id() { return (unsigned)__builtin_amdgcn_s_getreg((3 << 11) | 20) & 0xFu; }
#define XB_SPIN(cond, bar) do { unsigned _sp = 0; while (cond) { __builtin_amdgcn_s_sleep(1); \
    if ((++_sp & 255u) == 0u) { if (xb_ld(&(bar)[XB_TMO])) break; if (_sp > XB_SPIN_CAP) { atomicAdd(&(bar)[XB_TMO], 1u); break; } } } } while (0)
struct XcdBarrier { unsigned* bar; unsigned x; volatile LAS unsigned* st; };
__device__ __forceinline__ XcdBarrier xcd_barrier_post(unsigned* bar, volatile LAS unsigned* st) {
    XcdBarrier b; b.bar = bar; b.x = xb_xcc_id(); b.st = st;
    if (threadIdx.x == 0) (void)xb_add(&bar[XB_XCNT(b.x)], 1u);
    return b;
}
__device__ __forceinline__ void xcd_barrier_complete(unsigned* bar, unsigned x, unsigned& nloc, unsigned& nx) {
    const unsigned G = gridDim.x * gridDim.y * gridDim.z;
    unsigned sum, cnt, mine, sp = 0u;
    for (;;) {
        sum = 0u; cnt = 0u; mine = 0u;
#pragma unroll
        for (unsigned j = 0; j < 16; ++j) { const unsigned c = xb_ld(&bar[XB_XCNT(j)]); sum += c; cnt += (c > 0u) ? 1u : 0u; mine = (j == x) ? c : mine; }
        if (sum == G) break;
        __builtin_amdgcn_s_sleep(1);
        if ((++sp & 255u) == 0u) { if (xb_ld(&bar[XB_TMO])) break; if (sp > XB_SPIN_CAP) { atomicAdd(&bar[XB_TMO], 1u); break; } }
    }
    nloc = mine > 0u ? mine : 1u; nx = cnt > 0u ? cnt : 1u;
}
__device__ __forceinline__ void xcd_barrier(const XcdBarrier& b) {
    asm volatile("s_waitcnt vmcnt(0)" ::: "memory");
    __syncthreads();
    if (threadIdx.x == 0) {
        unsigned* bar = b.bar;
        __builtin_amdgcn_s_waitcnt(0);
        unsigned nloc = b.st[0], nx = b.st[1];
        if (nloc == 0u) { xcd_barrier_complete(bar, b.x, nloc, nx); b.st[0] = nloc; b.st[1] = nx; }
        const unsigned old = xb_add(&bar[XB_XSUB(b.x)], 1u);
        const unsigned gen = old / nloc;
        if (old + 1u == (gen + 1u) * nloc) {
            __builtin_amdgcn_fence(__ATOMIC_RELEASE, "agent");
            asm volatile("s_waitcnt vmcnt(0)" ::: "memory");
            const unsigned og = xb_add(&bar[XB_TOP], 1u);
            const unsigned tg = og / nx;
            if (og + 1u == (tg + 1u) * nx) xb_add(&bar[XB_TOPGEN], 1u);
            else XB_SPIN(xb_ld(&bar[XB_TOPGEN]) == tg, bar);
            __builtin_amdgcn_fence(__ATOMIC_ACQUIRE, "agent");
            xb_add(&bar[XB_XGEN(b.x)], 1u);
            asm volatile("s_waitcnt vmcnt(0)" ::: "memory");
        } else {
            XB_SPIN(xb_ld(&bar[XB_XGEN(b.x)]) == gen, bar);
            __builtin_amdgcn_fence(__ATOMIC_ACQUIRE, "agent");
            asm volatile("s_waitcnt vmcnt(0)" ::: "memory");
        }
    }
    __syncthreads();
}

namespace pg8 {
constexpr int BM = 256, BK = 64, HALF = 128, HTB = HALF * BK * 2, STAGE_BYTES = 8 * HTB, NXCD = 8, WGM = 8;
__host__ __device__ __forceinline__ int lds_byte(int r, int c) { const int st = (r >> 4) * 2 + (c >> 5), rr = r & 15, cc = c & 31, ob = rr * 64 + cc * 2; return st * 1024 + (ob ^ (((ob >> 9) & 1) << 5)); }
__host__ __device__ __forceinline__ void stage_rc(int b, int& R, int& C) { const int st = b / 1024, sb = b % 1024, swz = sb ^ (((sb >> 9) & 1) << 5); R = (st >> 1) * 16 + swz / 64; C = (st & 1) * 32 + (swz % 64) / 2; }
__host__ __device__ __forceinline__ int perm32(int rho) { const int n = rho >> 4, i = rho & 15; return 8 * (i >> 2) + 4 * n + (i & 3); }
__device__ __forceinline__ int xcd_remap(int wgid, int nwg) { const int q = nwg / NXCD, r = nwg % NXCD, xcd = wgid % NXCD, off = wgid / NXCD; return (xcd < r ? xcd * (q + 1) : r * (q + 1) + (xcd - r) * q) + off; }

struct Unit { const char* A; const char* B; int pm, pn, e, nrow; };

struct DenseSched {
    const char* A; const char* Bt; int nM, nN, nwg, G, c; size_t tstep;
    __device__ __forceinline__ void init(const void* A_, const void* Bt_, int M, int N, int K, int G_, int c_) { A = (const char*)A_; Bt = (const char*)Bt_; nM = M / BM; nN = N / BM; nwg = nM * nN; G = G_; c = c_; tstep = (size_t)BM * K * 2; }
    __device__ __forceinline__ bool next(int i, Unit& u) const {
        const long L = (long)i * G + c; if (L >= nwg) return false;
        const int wgid = xcd_remap((int)L, nwg);
        const int nig = WGM * nN, gid = wgid / nig, fm = gid * WGM, gsz = (nM - fm) < WGM ? (nM - fm) : WGM;
        u.pm = fm + ((wgid % nig) % gsz); u.pn = (wgid % nig) / gsz; u.e = 0; u.nrow = BM;
        u.A = A + (size_t)u.pm * tstep; u.B = Bt + (size_t)u.pn * tstep; return true;
    }
};
struct MoeSched {
    const char* A; const char* Bt; const volatile LAS int* tstart; const volatile LAS int* cnt; int NT, nwg, G, c; size_t tstep;
    __device__ __forceinline__ void init(const void* A_, const void* Bt_, const volatile LAS int* ts, const volatile LAS int* cn, int NT_, int Kbytes, int G_, int c_) {
        A = (const char*)A_; Bt = (const char*)Bt_; tstart = ts; cnt = cn; NT = NT_; nwg = ts[NE] * NT_; G = G_; c = c_; tstep = (size_t)BM * Kbytes; }
    __device__ __forceinline__ bool next(int i, Unit& u) const {
        const long L = (long)i * G + c; if (L >= nwg) return false;
        const int wgid = xcd_remap((int)L, nwg);
        int e = 0;
#pragma unroll 1
        for (int j = 1; j < NE; ++j) e = (wgid >= tstart[j] * NT) ? j : e;
        const int t0 = tstart[e], nte = tstart[e + 1] - t0, local = wgid - t0 * NT;
        const int pn = local / nte, mt = local - pn * nte;
        u.e = e; u.pn = pn; u.pm = t0 + mt; u.nrow = cnt[e] - mt * BM;
        u.A = A + (size_t)u.pm * tstep; u.B = Bt + (size_t)(e * NT + pn) * tstep; return true;
    }
};

template <class Epi, class Sched, bool BGRAN = false>
__device__ __forceinline__ void gemm_phase(LAS unsigned char* lds, const int K, const int lda, const int ldb, const Sched& S, const Epi& E) {
    const int tid = threadIdx.x, wid = __builtin_amdgcn_readfirstlane(tid >> 6), lane = tid & 63, wr = wid >> 2, wc = wid & 3, fr = lane & 15, fq = lane >> 4;
    int nt = K / BK; asm volatile("" : "+s"(nt));
    unsigned voffA[2], voffB[2];
#pragma unroll
    for (int i = 0; i < 2; ++i) { int R, C; stage_rc(tid * 16 + i * 8192, R, C); const int Rb = Epi::PERM ? ((R & ~31) + perm32(R & 31)) : R;
        voffA[i] = (unsigned)(R * lda + C) * 2u; voffB[i] = BGRAN ? (unsigned)((C >> 3) * ldb + Rb) * 16u : (unsigned)(Rb * ldb + C) * 2u; }
    const size_t kstep = (size_t)(BK * 2), kstepB = BGRAN ? (size_t)ldb * 128 : (size_t)(BK * 2);
    const size_t hstepA = (size_t)HALF * lda * 2, hstepB = BGRAN ? (size_t)2048 : (size_t)HALF * ldb * 2;
    const unsigned ldsw = (unsigned)wid * 1024u;
    const int aoff = lds_byte(wr * 64 + fr, fq * 8), boff = lds_byte(wc * 32 + fr, fq * 8);
#define PG8_SA(b, h) (((b) * 2 + (h)) * HTB)
#define PG8_SB(b, h) ((4 + (b) * 2 + (h)) * HTB)
#define PG8_STAGE(bufoff, gbase, voff) do { _Pragma("unroll") for (int _i = 0; _i < 2; ++_i) \
        __builtin_amdgcn_global_load_lds((const unsigned*)((const char*)(gbase) + (voff)[_i]), (LAS unsigned*)(lds + (bufoff) + ldsw + _i * 8192), 16, 0, 0); } while (0)
#define PG8_LDA(dst, b, h) do { _Pragma("unroll") for (int m = 0; m < 4; ++m) _Pragma("unroll") for (int k = 0; k < 2; ++k) dst[m][k] = *(const LAS bf16x8*)(lds + PG8_SA(b, h) + aoff + m * 2048 + k * 1024); } while (0)
#define PG8_LDB(dst, b, h) do { _Pragma("unroll") for (int n = 0; n < 2; ++n) _Pragma("unroll") for (int k = 0; k < 2; ++k) dst[n][k] = *(const LAS bf16x8*)(lds + PG8_SB(b, h) + boff + n * 2048 + k * 1024); } while (0)
#define PG8_MMA(ai, bj, At, Bt) do { __builtin_amdgcn_s_setprio(1); _Pragma("unroll") for (int m = 0; m < 4; ++m) _Pragma("unroll") for (int n = 0; n < 2; ++n) _Pragma("unroll") for (int k = 0; k < 2; ++k) \
        acc[ai][bj][m][n] = __builtin_amdgcn_mfma_f32_16x16x32_bf16(Bt[n][k], At[m][k], acc[ai][bj][m][n], 0, 0, 0); __builtin_amdgcn_s_setprio(0); } while (0)
#define PG8_WAIT_V(n) asm volatile("s_waitcnt vmcnt(" #n ")" ::: "memory")
#define PG8_WAIT_L(n) asm volatile("s_waitcnt lgkmcnt(" #n ")" ::: "memory")
#define PG8_BAR __builtin_amdgcn_s_barrier()
#define PG8_SCHED __builtin_amdgcn_sched_barrier(0)
    Unit cur, nxt; int ui = 0;
    if (!S.next(0, cur)) return;
    f32x4 acc[2][2][4][2];
#pragma unroll
    for (int a = 0; a < 2; ++a)
#pragma unroll
        for (int b = 0; b < 2; ++b)
#pragma unroll
            for (int m = 0; m < 4; ++m)
#pragma unroll
                for (int n = 0; n < 2; ++n) acc[a][b][m][n] = (f32x4){0.f, 0.f, 0.f, 0.f};
    bf16x8 At[4][2], B0[2][2], B1[2][2];
    const char* cA = cur.A; const char* cB = cur.B;
    PG8_STAGE(PG8_SB(0, 0), cB, voffB); PG8_STAGE(PG8_SB(0, 1), cB + hstepB, voffB); PG8_STAGE(PG8_SA(0, 0), cA, voffA); PG8_STAGE(PG8_SA(0, 1), cA + hstepA, voffA);
    if (wr == 1) PG8_BAR;
    PG8_WAIT_V(2); PG8_BAR;
    PG8_STAGE(PG8_SB(1, 0), cB + kstepB, voffB); PG8_STAGE(PG8_SA(1, 0), cA + kstep, voffA); PG8_STAGE(PG8_SB(1, 1), cB + hstepB + kstepB, voffB);
    PG8_WAIT_V(6); PG8_BAR;
    for (;;) {
        const bool has_next = S.next(ui + 1, nxt);
        const char* nA = has_next ? nxt.A : cA; const char* nB = has_next ? nxt.B : cB;
#pragma unroll 1
        for (int t = 0; t < nt; t += 2) {
            const bool last = (t == nt - 2);
            const char* a1 = cA + (size_t)(t + 1) * kstep;
            const char* a2 = last ? nA : cA + (size_t)(t + 2) * kstep; const char* b2 = last ? nB : cB + (size_t)(t + 2) * kstepB;
            const char* a3 = a2 + kstep; const char* b3 = b2 + kstepB;
            PG8_LDB(B0, 0, 0); PG8_LDB(B1, 0, 1); PG8_SCHED; PG8_LDA(At, 0, 0); PG8_STAGE(PG8_SA(1, 1), a1 + hstepA, voffA);
            PG8_WAIT_V(8); PG8_WAIT_L(0); PG8_BAR; PG8_MMA(0, 0, At, B0); PG8_MMA(0, 1, At, B1); PG8_BAR; PG8_SCHED;
            PG8_LDA(At, 0, 1); PG8_STAGE(PG8_SB(0, 0), b2, voffB); PG8_STAGE(PG8_SB(0, 1), b2 + hstepB, voffB); PG8_STAGE(PG8_SA(0, 0), a2, voffA);
            PG8_WAIT_V(8); PG8_WAIT_L(0); PG8_BAR; PG8_MMA(1, 0, At, B0); PG8_MMA(1, 1, At, B1); PG8_BAR; PG8_SCHED;
            PG8_LDB(B0, 1, 0); PG8_LDB(B1, 1, 1); PG8_SCHED; PG8_LDA(At, 1, 0); PG8_STAGE(PG8_SA(0, 1), a2 + hstepA, voffA);
            PG8_WAIT_V(8); PG8_WAIT_L(0); PG8_BAR; PG8_MMA(0, 0, At, B0); PG8_MMA(0, 1, At, B1); PG8_BAR; PG8_SCHED;
            PG8_LDA(At, 1, 1); PG8_STAGE(PG8_SB(1, 0), b3, voffB); PG8_STAGE(PG8_SB(1, 1), b3 + hstepB, voffB); PG8_STAGE(PG8_SA(1, 0), a3, voffA);
            PG8_WAIT_V(8); PG8_WAIT_L(0); PG8_BAR; PG8_MMA(1, 0, At, B0); PG8_MMA(1, 1, At, B1); PG8_BAR; PG8_SCHED;
        }
        if (wr == 0) PG8_BAR;
        { int fr_ = fr, fq_ = fq; asm volatile("" : "+v"(fr_), "+v"(fq_));
          E(acc, cur, wr, wc, fr_, fq_); }
        if (!has_next) break;
#pragma unroll
        for (int a = 0; a < 2; ++a)
#pragma unroll
            for (int b = 0; b < 2; ++b)
#pragma unroll
                for (int m = 0; m < 4; ++m)
#pragma unroll
                    for (int n = 0; n < 2; ++n) acc[a][b][m][n] = (f32x4){0.f, 0.f, 0.f, 0.f};
        cur = nxt; cA = nA; cB = nB; ++ui;
        if (wr == 1) PG8_BAR;
    }
    PG8_WAIT_V(0);
    PG8_BAR;
#undef PG8_SA
#undef PG8_SB
#undef PG8_STAGE
#undef PG8_LDA
#undef PG8_LDB
#undef PG8_MMA
#undef PG8_WAIT_V
#undef PG8_WAIT_L
#undef PG8_BAR
#undef PG8_SCHED
}

template <class Epi, class Sched>
__device__ __forceinline__ void gemm_phase8(LAS unsigned char* lds, const int K, const int lda, const int ldb, const Sched& S, const Epi& E) {
    const int tid = threadIdx.x, wid = __builtin_amdgcn_readfirstlane(tid >> 6), lane = tid & 63, wr = wid >> 2, wc = wid & 3, fr = lane & 15, fq = lane >> 4;
    int nt = K / 128; asm volatile("" : "+s"(nt));
    unsigned voffA[2], voffB[2];
#pragma unroll
    for (int i = 0; i < 2; ++i) { int R, C; stage_rc(tid * 16 + i * 8192, R, C); const int Rb = Epi::PERM ? ((R & ~31) + perm32(R & 31)) : R;
        voffA[i] = (unsigned)(R * lda + C * 2); voffB[i] = (unsigned)(Rb * ldb + C * 2); }
    const size_t kstep = 128, kstepB = 128;
    const size_t hstepA = (size_t)HALF * lda, hstepB = (size_t)HALF * ldb;
    const unsigned ldsw = (unsigned)wid * 1024u;
    const int aoff = lds_byte(wr * 64 + fr, fq * 8), boff = lds_byte(wc * 32 + fr, fq * 8);
#define PG8_SA(b, h) (((b) * 2 + (h)) * HTB)
#define PG8_SB(b, h) ((4 + (b) * 2 + (h)) * HTB)
#define PG8_STAGE(bufoff, gbase, voff) do { _Pragma("unroll") for (int _i = 0; _i < 2; ++_i) \
        __builtin_amdgcn_global_load_lds((const unsigned*)((const char*)(gbase) + (voff)[_i]), (LAS unsigned*)(lds + (bufoff) + ldsw + _i * 8192), 16, 0, 0); } while (0)
#define PG8_LDA(dst, b, h) do { _Pragma("unroll") for (int m = 0; m < 4; ++m) { dst[m][0] = *(const LAS u32x4*)(lds + PG8_SA(b, h) + aoff + m * 2048); dst[m][1] = *(const LAS u32x4*)(lds + PG8_SA(b, h) + aoff + m * 2048 + 1024); } } while (0)
#define PG8_LDB(dst, b, h) do { _Pragma("unroll") for (int n = 0; n < 2; ++n) { dst[n][0] = *(const LAS u32x4*)(lds + PG8_SB(b, h) + boff + n * 2048); dst[n][1] = *(const LAS u32x4*)(lds + PG8_SB(b, h) + boff + n * 2048 + 1024); } } while (0)
#define PG8_MMA(ai, bj, At, Bt) do { __builtin_amdgcn_s_setprio(1); _Pragma("unroll") for (int m = 0; m < 4; ++m) _Pragma("unroll") for (int n = 0; n < 2; ++n) { \
        const v8i b_ = __builtin_bit_cast(v8i, __builtin_shufflevector(Bt[n][0], Bt[n][1], 0, 1, 2, 3, 4, 5, 6, 7)), a_ = __builtin_bit_cast(v8i, __builtin_shufflevector(At[m][0], At[m][1], 0, 1, 2, 3, 4, 5, 6, 7)); \
        asm volatile("s_nop 1\n\tv_mfma_scale_f32_16x16x128_f8f6f4 %0, %1, %2, %0, %3, %4 op_sel_hi:[0,0,0]" : "+v"(acc[ai][bj][m][n]) : "v"(b_), "v"(a_), "v"(scw), "v"(scx)); } \
        __builtin_amdgcn_s_setprio(0); } while (0)
#define PG8_WAIT_V(n) asm volatile("s_waitcnt vmcnt(" #n ")" ::: "memory")
#define PG8_WAIT_L(n) asm volatile("s_waitcnt lgkmcnt(" #n ")" ::: "memory")
#define PG8_BAR __builtin_amdgcn_s_barrier()
#define PG8_SCHED __builtin_amdgcn_sched_barrier(0)
    Unit cur, nxt; int ui = 0;
    if (!S.next(0, cur)) return;
    f32x4 acc[2][2][4][2];
#pragma unroll
    for (int a = 0; a < 2; ++a)
#pragma unroll
        for (int b = 0; b < 2; ++b)
#pragma unroll
            for (int m = 0; m < 4; ++m)
#pragma unroll
                for (int n = 0; n < 2; ++n) acc[a][b][m][n] = (f32x4){0.f, 0.f, 0.f, 0.f};
    u32x4 At[4][2], B0[2][2], B1[2][2];
    int scw = 0x7a7a7a7a, scx = 0x7f7f7f7f; asm volatile("" : "+v"(scw), "+v"(scx));
    const char* cA = cur.A; const char* cB = cur.B;
    PG8_STAGE(PG8_SB(0, 0), cB, voffB); PG8_STAGE(PG8_SB(0, 1), cB + hstepB, voffB); PG8_STAGE(PG8_SA(0, 0), cA, voffA); PG8_STAGE(PG8_SA(0, 1), cA + hstepA, voffA);
    if (wr == 1) PG8_BAR;
    PG8_WAIT_V(2); PG8_BAR;
    PG8_STAGE(PG8_SB(1, 0), cB + kstepB, voffB); PG8_STAGE(PG8_SA(1, 0), cA + kstep, voffA); PG8_STAGE(PG8_SB(1, 1), cB + hstepB + kstepB, voffB);
    PG8_WAIT_V(6); PG8_BAR;
    for (;;) {
        const bool has_next = S.next(ui + 1, nxt);
        const char* nA = has_next ? nxt.A : cA; const char* nB = has_next ? nxt.B : cB;
#pragma unroll 1
        for (int t = 0; t < nt; t += 2) {
            const bool last = (t == nt - 2);
            const char* a1 = cA + (size_t)(t + 1) * kstep;
            const char* a2 = last ? nA : cA + (size_t)(t + 2) * kstep; const char* b2 = last ? nB : cB + (size_t)(t + 2) * kstepB;
            const char* a3 = a2 + kstep; const char* b3 = b2 + kstepB;
            PG8_LDB(B0, 0, 0); PG8_LDB(B1, 0, 1); PG8_SCHED; PG8_LDA(At, 0, 0); PG8_STAGE(PG8_SA(1, 1), a1 + hstepA, voffA);
            PG8_WAIT_V(8); PG8_WAIT_L(0); PG8_BAR; PG8_MMA(0, 0, At, B0); PG8_MMA(0, 1, At, B1); PG8_BAR; PG8_SCHED;
            PG8_LDA(At, 0, 1); PG8_STAGE(PG8_SB(0, 0), b2, voffB); PG8_STAGE(PG8_SB(0, 1), b2 + hstepB, voffB); PG8_STAGE(PG8_SA(0, 0), a2, voffA);
            PG8_WAIT_V(8); PG8_WAIT_L(0); PG8_BAR; PG8_MMA(1, 0, At, B0); PG8_MMA(1, 1, At, B1); PG8_BAR; PG8_SCHED;
            PG8_LDB(B0, 1, 0); PG8_LDB(B1, 1, 1); PG8_SCHED; PG8_LDA(At, 1, 0); PG8_STAGE(PG8_SA(0, 1), a2 + hstepA, voffA);
            PG8_WAIT_V(8); PG8_WAIT_L(0); PG8_BAR; PG8_MMA(0, 0, At, B0); PG8_MMA(0, 1, At, B1); PG8_BAR; PG8_SCHED;
            PG8_LDA(At, 1, 1); PG8_STAGE(PG8_SB(1, 0), b3, voffB); PG8_STAGE(PG8_SB(1, 1), b3 + hstepB, voffB); PG8_STAGE(PG8_SA(1, 0), a3, voffA);
            PG8_WAIT_V(8); PG8_WAIT_L(0); PG8_BAR; PG8_MMA(1, 0, At, B0); PG8_MMA(1, 1, At, B1); PG8_BAR; PG8_SCHED;
        }
        if (wr == 0) PG8_BAR;
        asm volatile("s_nop 15\n\ts_nop 7" ::: "memory");
        { int fr_ = fr, fq_ = fq; asm volatile("" : "+v"(fr_), "+v"(fq_));
          E(acc, cur, wr, wc, fr_, fq_); }
        if (!has_next) break;
#pragma unroll
        for (int a = 0; a < 2; ++a)
#pragma unroll
            for (int b = 0; b < 2; ++b)
#pragma unroll
                for (int m = 0; m < 4; ++m)
#pragma unroll
                    for (int n = 0; n < 2; ++n) acc[a][b][m][n] = (f32x4){0.f, 0.f, 0.f, 0.f};
        cur = nxt; cA = nA; cB = nB; ++ui;
        if (wr == 1) PG8_BAR;
    }
    PG8_WAIT_V(0);
    PG8_BAR;
#undef PG8_SA
#undef PG8_SB
#undef PG8_STAGE
#undef PG8_LDA
#undef PG8_LDB
#undef PG8_MMA
#undef PG8_WAIT_V
#undef PG8_WAIT_L
#undef PG8_BAR
#undef PG8_SCHED
}

struct EpiProj {
    static constexpr bool PERM = true;
    unsigned char* ws; const float* bbg;
    __device__ __forceinline__ void operator()(const f32x4 (&acc)[2][2][4][2], const Unit& u, int wr, int wc, int fr, int fq) const {
        const int pn = u.pn; size_t off; int ld, t0, act = 0;
        if (pn < 4) { off = WS_GQ; ld = 1024; t0 = 0; } else if (pn < 8) { off = WS_GK; ld = 1024; t0 = 4; } else if (pn < 16) { off = WS_GV; ld = 2048; t0 = 8; }
        else if (pn < 24) { off = WS_GR; ld = 2048; t0 = 16; act = 1; } else if (pn < 28) { off = WS_AQ; ld = 1024; t0 = 24; } else if (pn < 32) { off = WS_AK; ld = 1024; t0 = 28; }
        else if (pn < 36) { off = WS_AV; ld = 1024; t0 = 32; } else if (pn < 44) { off = WS_SG; ld = 2048; t0 = 36; act = 2; } else { off = WS_SA; ld = 2048; t0 = 44; act = 3; }
        bf16* base = (bf16*)(ws + off);
        const int colt = (pn - t0) * BM + wc * 32 + 8 * fq, row0 = u.pm * BM + wr * 64 + fr;
        f32x4 bv[2][2];
#pragma unroll
        for (int bj = 0; bj < 2; ++bj)
#pragma unroll
            for (int n = 0; n < 2; ++n) bv[bj][n] = act >= 2 ? *(const f32x4*)(bbg + (act - 2) * D + colt + bj * HALF + 4 * n) : (f32x4){0.f, 0.f, 0.f, 0.f};
#pragma unroll
        for (int ai = 0; ai < 2; ++ai)
#pragma unroll
            for (int m = 0; m < 4; ++m) { bf16* rowp = base + (size_t)(row0 + ai * HALF + m * 16) * ld + colt;
#pragma unroll
                for (int bj = 0; bj < 2; ++bj) { f32x4 v0 = acc[ai][bj][m][0] + bv[bj][0], v1 = acc[ai][bj][m][1] + bv[bj][1];
                    if (act == 1) {
#pragma unroll
                        for (int j = 0; j < 4; ++j) { v0[j] = v0[j] * sigmoidf_(v0[j]); v1[j] = v1[j] * sigmoidf_(v1[j]); } }
                    else if (act >= 2) {
#pragma unroll
                        for (int j = 0; j < 4; ++j) { v0[j] = sigmoidf_(v0[j]); v1[j] = sigmoidf_(v1[j]); } }
                    u32x4 w; w.x = cvt_pk_bf16(v0[0], v0[1]); w.y = cvt_pk_bf16(v0[2], v0[3]); w.z = cvt_pk_bf16(v1[0], v1[1]); w.w = cvt_pk_bf16(v1[2], v1[3]);
                    *(u32x4*)(rowp + bj * HALF) = w; } }
    }
};
template <int MODE> struct EpiBranch {
    static constexpr bool PERM = true;
    const bf16* gate; const bf16* tin; bf16* out;
    __device__ __forceinline__ void operator()(const f32x4 (&acc)[2][2][4][2], const Unit& u, int wr, int wc, int fr, int fq) const {
        const int colt = u.pn * BM + wc * 32 + 8 * fq, row0 = u.pm * BM + wr * 64 + fr;
#pragma unroll
        for (int ai = 0; ai < 2; ++ai)
#pragma unroll
            for (int m = 0; m < 4; ++m) { const size_t ro = (size_t)(row0 + ai * HALF + m * 16) * D + colt;
#pragma unroll
                for (int bj = 0; bj < 2; ++bj) {
                    const u32x4 gq = *(const u32x4*)(gate + ro + bj * HALF);
                    u32x4 tq = (u32x4){0u, 0u, 0u, 0u}; if (MODE == 1) tq = *(const u32x4*)(tin + ro + bj * HALF);
                    float r[8];
#pragma unroll
                    for (int j = 0; j < 4; ++j) { r[j] = acc[ai][bj][m][0][j]; r[4 + j] = acc[ai][bj][m][1][j]; }
#pragma unroll
                    for (int j = 0; j < 4; ++j) { const unsigned gw = gq[j], tw = tq[j];
                        r[2 * j] = r[2 * j] * __uint_as_float(gw << 16) + __uint_as_float(tw << 16);
                        r[2 * j + 1] = r[2 * j + 1] * __uint_as_float(gw & 0xffff0000u) + __uint_as_float(tw & 0xffff0000u); }
                    u32x4 w; w.x = cvt_pk_bf16(r[0], r[1]); w.y = cvt_pk_bf16(r[2], r[3]); w.z = cvt_pk_bf16(r[4], r[5]); w.w = cvt_pk_bf16(r[6], r[7]);
                    *(u32x4*)(out + ro + bj * HALF) = w; } }
    }
};
struct EpiResid {
    static constexpr bool PERM = false;
    const float* x; float* out;
    __device__ __forceinline__ void operator()(const f32x4 (&acc)[2][2][4][2], const Unit& u, int wr, int wc, int fr, int fq) const {
        const int col0 = u.pn * BM + wc * 32 + 4 * fq, row0 = u.pm * BM + wr * 64 + fr;
#pragma unroll
        for (int ai = 0; ai < 2; ++ai)
#pragma unroll
            for (int m = 0; m < 4; ++m) { const size_t ro = (size_t)(row0 + ai * HALF + m * 16) * D + col0;
#pragma unroll
                for (int bj = 0; bj < 2; ++bj)
#pragma unroll
                    for (int n = 0; n < 2; ++n) { const f32x4 xv = *(const f32x4*)(x + ro + bj * HALF + n * 16); *(f32x4*)(out + ro + bj * HALF + n * 16) = xv + acc[ai][bj][m][n]; } }
    }
};
struct EpiSwiglu {
    static constexpr bool PERM = true;
    const float* bgate; const float* bup; unsigned char* hd;
    __device__ __forceinline__ void operator()(const f32x4 (&acc)[2][2][4][2], const Unit& u, int wr, int wc, int fr, int fq) const {
        const int col = u.pn * HALF + wc * 32 + 8 * fq; const size_t row0 = (size_t)u.pm * BM + wr * 64 + fr;
        const float* bg = bgate + (size_t)u.e * DFF + col; const float* bu = bup + (size_t)u.e * DFF + col;
        const f32x4 g0 = *(const f32x4*)bg, g1 = *(const f32x4*)(bg + 4), u0 = *(const f32x4*)bu, u1 = *(const f32x4*)(bu + 4);
#pragma unroll
        for (int ai = 0; ai < 2; ++ai)
#pragma unroll
            for (int m = 0; m < 4; ++m) {
                float r[8];
#pragma unroll
                for (int j = 0; j < 4; ++j) {
                    const float ga = fminf(acc[ai][0][m][0][j] + g0[j], 7.f), ua = fminf(fmaxf(acc[ai][1][m][0][j] + u0[j], -7.f), 7.f);
                    const float gb = fminf(acc[ai][0][m][1][j] + g1[j], 7.f), ub = fminf(fmaxf(acc[ai][1][m][1][j] + u1[j], -7.f), 7.f);
                    r[j] = (ua + 1.f) * (ga * sigmoidf_(1.702f * ga)); r[4 + j] = (ub + 1.f) * (gb * sigmoidf_(1.702f * gb)); }
                int w0 = 0, w1 = 0;
                w0 = __builtin_amdgcn_cvt_pk_fp8_f32(r[0], r[1], w0, false); w0 = __builtin_amdgcn_cvt_pk_fp8_f32(r[2], r[3], w0, true);
                w1 = __builtin_amdgcn_cvt_pk_fp8_f32(r[4], r[5], w1, false); w1 = __builtin_amdgcn_cvt_pk_fp8_f32(r[6], r[7], w1, true);
                *(u32x2*)(hd + (row0 + ai * HALF + m * 16) * DFF + col) = (u32x2){(unsigned)w0, (unsigned)w1}; }
    }
};
struct EpiDown {
    static constexpr bool PERM = true;
    const float* bdown; const int* rpair; const float* rw; bf16* py;
    __device__ __forceinline__ void operator()(const f32x4 (&acc)[2][2][4][2], const Unit& u, int wr, int wc, int fr, int fq) const {
        const int colt = u.pn * BM + wc * 32 + 8 * fq; const size_t srow0 = (size_t)u.pm * BM + wr * 64 + fr;
        f32x4 bv[2][2];
#pragma unroll
        for (int bj = 0; bj < 2; ++bj)
#pragma unroll
            for (int n = 0; n < 2; ++n) bv[bj][n] = *(const f32x4*)(bdown + (size_t)u.e * D + colt + bj * HALF + 4 * n);
#pragma unroll
        for (int ai = 0; ai < 2; ++ai)
#pragma unroll
            for (int m = 0; m < 4; ++m) { const size_t srow = srow0 + ai * HALF + m * 16; const int pair = rpair[srow]; const float wgt = rw[srow];
                bf16* rowp = py + (size_t)pair * D + colt;
#pragma unroll
                for (int bj = 0; bj < 2; ++bj) { const f32x4 v0 = (acc[ai][bj][m][0] + bv[bj][0]) * wgt, v1 = (acc[ai][bj][m][1] + bv[bj][1]) * wgt;
                    u32x4 w; w.x = cvt_pk_bf16(v0[0], v0[1]); w.y = cvt_pk_bf16(v0[2], v0[3]); w.z = cvt_pk_bf16(v1[0], v1[1]); w.w = cvt_pk_bf16(v1[2], v1[3]);
                    *(u32x4*)(rowp + bj * HALF) = w; } }
    }
};

struct GlaSched {
    int mode, G, c; unsigned char* ws;
    __device__ __forceinline__ bool next(int i, Unit& u) const {
        const int L = i * G + c; const int nu = mode == 0 ? 128 : 256; if (L >= nu) return false;
        const int nh = mode == 0 ? L : (L >> 1), hv = mode == 0 ? 0 : (L & 1);
        u.pm = nh; u.pn = hv; u.e = 0; u.nrow = BM;
        if (mode == 0) { u.A = (const char*)(ws + WS_ACAT) + (size_t)nh * 256 * 512 * 2 + 512; u.B = (const char*)(ws + WS_KI) + (size_t)nh * 256 * 256 * 2; }
        else if (mode == 1) { u.A = (const char*)(ws + WS_BCAT) + (size_t)nh * 512 * 512 * 2 + (size_t)hv * 256 * 512 * 2; u.B = (const char*)(ws + WS_KET) + (size_t)nh * 256 * 256 * 2; }
        else { u.A = (const char*)(ws + WS_ACAT) + (size_t)nh * 256 * 512 * 2; u.B = (const char*)(ws + WS_BCAT) + (size_t)nh * 512 * 512 * 2 + (size_t)hv * 256 * 512 * 2; }
        return true;
    }
};
template <int MODE> struct EpiGla {
    static constexpr bool PERM = true;
    unsigned char* ws;
    __device__ __forceinline__ void operator()(const f32x4 (&acc)[2][2][4][2], const Unit& u, int wr, int wc, int fr, int fq) const {
        const int nh = u.pm, hv = u.pn; const int c8 = wc * 32 + 8 * fq, r0 = wr * 64 + fr;
        bf16* base; int ld;
        if (MODE == 0) { base = (bf16*)(ws + WS_ACAT) + (size_t)nh * 256 * 512; ld = 512; }
        else if (MODE == 1) { base = (bf16*)(ws + WS_UT) + (size_t)nh * 512 * 256 + (size_t)hv * 256 * 256; ld = 256; }
        else { base = (bf16*)(ws + WS_OB) + (size_t)(nh >> 2) * 256 * GLA_V + (nh & 3) * GLA_DV + hv * 256; ld = GLA_V; }
#pragma unroll
        for (int ai = 0; ai < 2; ++ai)
#pragma unroll
            for (int m = 0; m < 4; ++m) { const int row = r0 + ai * HALF + m * 16;
#pragma unroll
                for (int bj = 0; bj < 2; ++bj) { f32x4 v0 = acc[ai][bj][m][0], v1 = acc[ai][bj][m][1]; const int col = bj * HALF + c8;
                    if (MODE == 0) {
#pragma unroll
                        for (int j = 0; j < 4; ++j) { v0[j] = (col + j <= row) ? v0[j] : 0.f; v1[j] = (col + 4 + j <= row) ? v1[j] : 0.f; } }
                    u32x4 w; w.x = cvt_pk_bf16(v0[0], v0[1]); w.y = cvt_pk_bf16(v0[2], v0[3]); w.z = cvt_pk_bf16(v1[0], v1[1]); w.w = cvt_pk_bf16(v1[2], v1[3]);
                    *(u32x4*)(base + (size_t)row * ld + col) = w; } }
    }
};
}

constexpr int NWAVES = 8;
#ifndef GEMM_CUS
#define GEMM_CUS 152
#endif
constexpr int RING_BYTES = 131072, CTLZ_OFF = 139264, MISC_OFF = CTLZ_OFF + 320, LDS_BYTES = 147456;
constexpr int TAB_OFF = MISC_OFF + 128;

struct Frame {
    LAS unsigned char* lds; volatile LAS unsigned* MISC; unsigned* ctl; unsigned char* ws;
    int tid, lane, wave, vcu, G;
};
struct Args { const float* in[22]; float* out; unsigned char* ws; int ph_lo, ph_hi, li, pad; };

struct P0Item { const float* src; bf16* dst; int ldn, K; };
constexpr int P0_I_IN = 32 * (NPROJ / 32), P0_I_BG = 32 * 64, P0_I_BA = 16 * 64, P0_I_OUT = 32 * 64, P0_I_E = 32 * 64;
constexpr int P0_I_SMALL = P0_I_IN + P0_I_BG + P0_I_BA + P0_I_OUT, P0_NITEMS = P0_I_SMALL;
__device__ __forceinline__ P0Item p0_decode(Frame& F, const Args& a, int r) {
    constexpr int I_IN = P0_I_IN, I_BG = P0_I_BG, I_BA = P0_I_BA;
    P0Item it;
    if (r < I_IN) { const int nb = r % (NPROJ / 32), kb = r / (NPROJ / 32), d0 = nb * 32, s0 = d0 < C_GLR ? d0 : d0 + 16;
        it.src = a.in[2] + (size_t)kb * 64 * IN_COLS + s0; it.ldn = IN_COLS; it.dst = (bf16*)(F.ws + WS_WIN) + (size_t)d0 * D + kb * 64; it.K = D; return it; } r -= I_IN;
    if (r < I_BG) { const int nb = r % 64, kb = r / 64; it.src = a.in[10] + (size_t)kb * 64 * D + nb * 32; it.ldn = D; it.dst = (bf16*)(F.ws + WS_WBG) + (size_t)nb * 32 * GLA_V + kb * 64; it.K = GLA_V; return it; } r -= I_BG;
    if (r < I_BA) { const int nb = r % 64, kb = r / 64; it.src = a.in[11] + (size_t)kb * 64 * D + nb * 32; it.ldn = D; it.dst = (bf16*)(F.ws + WS_WBA) + (size_t)nb * 32 * ATT_W + kb * 64; it.K = ATT_W; return it; } r -= I_BA;
    { const int nb = r % 64, kb = r / 64; it.src = a.in[12] + (size_t)kb * 64 * D + nb * 32; it.ldn = D; it.dst = (bf16*)(F.ws + WS_WOUT) + (size_t)nb * 32 * D + kb * 64; it.K = D; }
    return it;
}
__device__ __forceinline__ void p0_load(const P0Item& it, int lane, f32x4 (&v)[8]) {
    const float* p = it.src + (size_t)(lane >> 3) * it.ldn + 4 * (lane & 7);
#pragma unroll
    for (int i = 0; i < 8; ++i) v[i] = __builtin_nontemporal_load((const GAS f32x4*)(p + (size_t)(8 * i) * it.ldn));
}
__device__ __forceinline__ void p0_convert(Frame& F, const Args& a, int it_lo, int it_hi, int gw, int NGW) {
    LAS float* scr = (LAS float*)(F.lds + F.wave * 16384);
    const int lane = F.lane;
    int itx = it_lo + gw;
    if (itx >= it_hi) return;
    P0Item cur = p0_decode(F, a, itx);
    f32x4 v[8]; p0_load(cur, lane, v);
    for (;;) {
        const int nx = itx + NGW; const bool more = nx < it_hi;
        P0Item nxt = cur; f32x4 vn[8];
        if (more) { nxt = p0_decode(F, a, nx); p0_load(nxt, lane, vn); }
#pragma unroll
        for (int i = 0; i < 8; ++i) { LAS float* q = scr + (8 * i + (lane >> 3)) * 33 + 4 * (lane & 7); q[0] = v[i].x; q[1] = v[i].y; q[2] = v[i].z; q[3] = v[i].w; }
        LDS_WAIT(); asm volatile("" ::: "memory");
        const int c = lane & 7;
#pragma unroll
        for (int j = 0; j < 4; ++j) { const int n = (lane >> 3) + 8 * j; const LAS float* sp = scr + (8 * c) * 33 + n;
            u32x4 o; o.x = pk2(sp[0 * 33], sp[1 * 33]); o.y = pk2(sp[2 * 33], sp[3 * 33]); o.z = pk2(sp[4 * 33], sp[5 * 33]); o.w = pk2(sp[6 * 33], sp[7 * 33]);
            __builtin_nontemporal_store(o, (GAS u32x4*)(cur.dst + (size_t)n * cur.K + 8 * c)); }
        LDS_WAIT(); asm volatile("" ::: "memory");
        if (!more) break;
        itx = nx; cur = nxt;
#pragma unroll
        for (int i = 0; i < 8; ++i) v[i] = vn[i];
    }
}
constexpr int P8_NITEMS = 3 * NE * 16 * 64;
__device__ __forceinline__ void p0_convert8(Frame& F, const Args& a, int gw, int NGW) {
    LAS unsigned char* tile = F.lds + F.wave * 16384;
    const int lane = F.lane, kq = lane >> 3, n4 = lane & 7;
    for (int it = gw; it < P8_NITEMS; it += NGW) {
        const int which = it / (NE * 1024), e = (it >> 10) & 31, kb = (it >> 6) & 15, nb = it & 63, k0 = kb * 128, n0 = nb * 32;
        const float* src; unsigned char* dst; int ldn;
        if (which < 2) { src = (which ? a.in[18] : a.in[16]) + (size_t)e * D * DFF + (size_t)k0 * DFF + n0; ldn = DFF;
            dst = F.ws + WS_GU + (size_t)e * 2 * DFF * D + (size_t)((n0 >> 7) * 256 + (n0 & 127) + which * 128) * D + k0; }
        else { src = a.in[20] + (size_t)e * DFF * D + (size_t)k0 * D + n0; ldn = D; dst = F.ws + WS_DN + (size_t)e * D * DFF + (size_t)n0 * DFF + k0; }
        const float* p = src + (size_t)(4 * kq) * ldn + 4 * n4;
        f32x4 v[4][4];
#pragma unroll
        for (int ps = 0; ps < 4; ++ps)
#pragma unroll
            for (int i = 0; i < 4; ++i) v[ps][i] = __builtin_nontemporal_load((const GAS f32x4*)(p + (size_t)(32 * ps + i) * ldn));
#pragma unroll
        for (int ps = 0; ps < 4; ++ps)
#pragma unroll
            for (int c = 0; c < 4; ++c) { int w = 0;
                w = __builtin_amdgcn_cvt_pk_fp8_f32(v[ps][0][c] * 32.f, v[ps][1][c] * 32.f, w, false); w = __builtin_amdgcn_cvt_pk_fp8_f32(v[ps][2][c] * 32.f, v[ps][3][c] * 32.f, w, true);
                *(LAS int*)(tile + (4 * n4 + c) * 144 + 32 * ps + 4 * kq) = w; }
        LDS_WAIT(); asm volatile("" ::: "memory");
#pragma unroll
        for (int j = 0; j < 4; ++j) { const int n = (lane >> 3) + 8 * j, c16 = lane & 7; const u32x4 g = *(const LAS u32x4*)(tile + n * 144 + 16 * c16);
            __builtin_nontemporal_store(g, (GAS u32x4*)(dst + (size_t)n * 2048 + 16 * c16)); }
        LDS_WAIT(); asm volatile("" ::: "memory");
    }
}
__device__ __forceinline__ void p0_rows(Frame& F, const Args& a) {
    { const float* g2 = a.in[13]; const float* wr = a.in[14]; float* WR = (float*)(F.ws + WS_WR);
      for (int i = (F.vcu * NWAVES * 64) + F.tid; i < D * NE; i += F.G * NWAVES * 64) WR[i] = g2[i >> 5] * wr[i]; }
}

template <int MODE> __device__ __forceinline__ void normproj_unit(Frame& F, const Args& a, int tile) {
    const int w = F.wave, lane = F.lane, tid = F.tid, i = lane & 31, kk = lane >> 5, t0 = tile * 32;
    const float* X = MODE == 0 ? a.in[0] : (const float*)(F.ws + WS_H1); const float* g = MODE == 0 ? a.in[1] : a.in[13];
    const float* WR = (const float*)(F.ws + WS_WR); const float* br = a.in[15]; const float* w_in = a.in[2];
    LAS float* part = (LAS float*)F.lds;
    LAS float* ssq = part + 8192;
    LAS float* lg = ssq + 256;
    LAS float* rs = lg + 32 * 33;
    LAS unsigned* lcnt = (LAS unsigned*)(rs + 32); LAS unsigned* lbase = lcnt + 32; LAS unsigned* prec = lbase + 32;
    if (MODE == 1 && tid < NE) lcnt[tid] = 0u;
    f32x16 acc;
#pragma unroll
    for (int r = 0; r < 16; ++r) acc[r] = 0.f;
    float ss = 0.f;
    const int kbase = 256 * w + 128 * kk;
    const float* arow = X + (size_t)(t0 + i) * D + kbase;
    const float* bcol = MODE == 0 ? (w_in + (size_t)kbase * IN_COLS + C_GLR + (i & 15)) : (WR + (size_t)kbase * NE + i);
    const size_t bstr = MODE == 0 ? IN_COLS : NE;
#pragma unroll 1
    for (int c = 0; c < 4; ++c) {
        f32x4 av[8];
#pragma unroll
        for (int q = 0; q < 8; ++q) av[q] = *(const GAS f32x4*)(arow + 32 * c + 4 * q);
#pragma unroll
        for (int q = 0; q < 8; ++q)
#pragma unroll
            for (int j = 0; j < 4; ++j) { const int kq = 32 * c + 4 * q + j; float b = bcol[(size_t)kq * bstr];
                if (MODE == 0) b = (i < 16) ? b * g[kbase + kq] : 0.f;
                acc = __builtin_amdgcn_mfma_f32_32x32x2f32(av[q][j], b, acc, 0, 0, 0); ss = fmaf(av[q][j], av[q][j], ss); }
    }
    ss += __shfl_xor(ss, 32);
    if (kk == 0) ssq[w * 32 + i] = ss;
#pragma unroll
    for (int r = 0; r < 16; ++r) part[(w * 32 + (r & 3) + 8 * (r >> 2) + 4 * kk) * 32 + i] = acc[r];
    __syncthreads();
#pragma unroll
    for (int rep = 0; rep < 2; ++rep) { const int idx = tid + 512 * rep, tok = idx >> 5, e = idx & 31; float sum = 0.f, st = 0.f;
#pragma unroll
        for (int ww = 0; ww < 8; ++ww) { sum += part[(ww * 32 + tok) * 32 + e]; st += ssq[ww * 32 + tok]; }
        const float rstd = rsqrtf(st * (1.f / D) + 1e-6f);
        if (MODE == 0) { if (e < 16) ((float*)(F.ws + WS_GLR))[(size_t)(t0 + tok) * 16 + e] = sum * rstd; }
        else lg[tok * 33 + e] = sum * rstd + br[e];
        if (e == 0) rs[tok] = rstd; }
    __syncthreads();
    bf16* HN = (bf16*)(F.ws + (MODE == 0 ? WS_XN : WS_HN)); float* topw = (float*)(F.ws + WS_TOPW); int* tope = (int*)(F.ws + WS_TOPE); int* tops = (int*)(F.ws + WS_TOPS);
    unsigned* cnt = F.ctl + CW_CNT;
#pragma unroll 1
    for (int q = 0; q < 4; ++q) {
        const int tok = 4 * w + q, t = t0 + tok, e = lane & 31;
        const float rstd = rs[tok];
        {
            const GAS f32x4* x4 = (const GAS f32x4*)(X + (size_t)t * D) + lane; GAS u32x2* o8 = (GAS u32x2*)(HN + (size_t)t * D) + lane;
#pragma unroll
            for (int j = 0; j < 8; ++j) { const f32x4 gg = *((const GAS f32x4*)g + lane + 64 * j); const f32x4 y = x4[64 * j] * rstd * gg;
                if (MODE == 0) { u32x2 wv; wv.x = pk2(y.x, y.y); wv.y = pk2(y.z, y.w); o8[64 * j] = wv; }
                else { int w8 = 0; w8 = __builtin_amdgcn_cvt_pk_fp8_f32(y.x, y.y, w8, false); w8 = __builtin_amdgcn_cvt_pk_fp8_f32(y.z, y.w, w8, true); ((GAS int*)((unsigned char*)HN + (size_t)t * D))[lane + 64 * j] = w8; } }
        }
        if (MODE == 1) {
        float vals[4]; int idxs[4]; float cur = lg[tok * 33 + e];
#pragma unroll
        for (int r = 0; r < 4; ++r) {
            float bv = cur; int bi = e;
#pragma unroll
            for (int o = 1; o < 32; o <<= 1) { const float ov = __shfl_xor(bv, o); const int oi = __shfl_xor(bi, o); if (ov > bv || (ov == bv && oi < bi)) { bv = ov; bi = oi; } }
            vals[r] = bv; idxs[r] = bi;
            if (e == bi) cur = -3.0e38f;
        }
        float ex[4], sum = 0.f;
#pragma unroll
        for (int r = 0; r < 4; ++r) { ex[r] = __expf(vals[r] - vals[0]); sum += ex[r]; }
#pragma unroll
        for (int r = 0; r < 4; ++r) {
            if (lane == r) { const int ee = idxs[r]; const unsigned lr = __hip_atomic_fetch_add(&lcnt[ee], 1u, __ATOMIC_RELAXED, __HIP_MEMORY_SCOPE_WORKGROUP);
                topw[t * 4 + r] = ex[r] / sum; tope[t * 4 + r] = ee; prec[tok * 4 + r] = (ee << 16) | lr; }
        }
        }
    }
    if (MODE == 1) {
        __syncthreads();
        if (tid < NE) { const unsigned c = lcnt[tid]; lbase[tid] = c ? atomicAdd(&cnt[64 * tid], c) : 0u; }
        __syncthreads();
        if (tid < 128) { const unsigned pr = prec[tid]; tops[(t0 * 4) + tid] = (int)(lbase[pr >> 16] + (pr & 0xffffu)); }
        __syncthreads();
        if (tid < NE) lcnt[tid] = 0u;
    }
    __syncthreads();
}
__device__ __forceinline__ void moe_table(Frame& F) {
    volatile LAS int* ts = (volatile LAS int*)(F.lds + TAB_OFF); volatile LAS int* cn = (volatile LAS int*)(F.lds + TAB_OFF + 256);
    __syncthreads();
    if (F.tid == 0) { int s = 0; for (int e = 0; e < NE; ++e) { const int c = (int)__hip_atomic_load(F.ctl + CW_CNT + 64 * e, __ATOMIC_RELAXED, __HIP_MEMORY_SCOPE_AGENT); cn[e] = c; ts[e] = s; s += (c + 255) >> 8; } ts[NE] = s; }
    __syncthreads();
}
__device__ __forceinline__ void p7_gather(Frame& F) {
    const int gw = F.vcu * NWAVES + F.wave, NGW = F.G * NWAVES, lane = F.lane;
    volatile LAS int* ts = (volatile LAS int*)(F.lds + TAB_OFF);
    const bf16* HN = (const bf16*)(F.ws + WS_HN); bf16* HNG = (bf16*)(F.ws + WS_HNG);
    const float* topw = (const float*)(F.ws + WS_TOPW); const int* tope = (const int*)(F.ws + WS_TOPE); const int* tops = (const int*)(F.ws + WS_TOPS);
    int* rpair = (int*)(F.ws + WS_RPAIR); float* rw = (float*)(F.ws + WS_RW);
    { volatile LAS int* cn = (volatile LAS int*)(F.lds + TAB_OFF + 256);
      for (int e = gw; e < NE; e += NGW) { const int c = cn[e], base = ts[e] * 256, padn = ((c + 255) & ~255) - c;
          for (int r = lane; r < padn; r += 64) { rpair[base + c + r] = S * 4; rw[base + c + r] = 0.f; } } }
    for (int t = gw; t < S; t += NGW) {
        const GAS u32x4* src = (const GAS u32x4*)((const unsigned char*)HN + (size_t)t * D) + lane; u32x4 v[2];
#pragma unroll
        for (int j = 0; j < 2; ++j) v[j] = src[64 * j];
#pragma unroll
        for (int r = 0; r < 4; ++r) { const int p = t * 4 + r; const int dst = ts[tope[p]] * 256 + tops[p];
            GAS u32x4* d = (GAS u32x4*)((unsigned char*)HNG + (size_t)dst * D) + lane;
#pragma unroll
            for (int j = 0; j < 2; ++j) d[64 * j] = v[j];
            if (lane == 0) { rpair[dst] = p; rw[dst] = topw[p]; } }
    }
}
__device__ __forceinline__ void p10_combine(Frame& F, const Args& a) {
    const int gw = F.vcu * NWAVES + F.wave, NGW = F.G * NWAVES, lane = F.lane;
    const bf16* PY = (const bf16*)(F.ws + WS_PY); float* out = a.out; const float* H1 = (const float*)(F.ws + WS_H1);
    for (int t = gw; t < S; t += NGW) {
#pragma unroll
        for (int j = 0; j < 4; ++j) {
            float r[8]; { const f32x4 h0 = *(const GAS f32x4*)(H1 + (size_t)t * D + 512 * j + 8 * lane), h1v = *(const GAS f32x4*)(H1 + (size_t)t * D + 512 * j + 8 * lane + 4);
                r[0] = h0.x; r[1] = h0.y; r[2] = h0.z; r[3] = h0.w; r[4] = h1v.x; r[5] = h1v.y; r[6] = h1v.z; r[7] = h1v.w; }
#pragma unroll
            for (int k = 0; k < 4; ++k) { const u32x4 p = *(const GAS u32x4*)(PY + (size_t)(t * 4 + k) * D + 512 * j + 8 * lane);
#pragma unroll
                for (int q = 0; q < 4; ++q) { r[2 * q] += __uint_as_float(p[q] << 16); r[2 * q + 1] += __uint_as_float(p[q] & 0xffff0000u); } }
            *(GAS f32x4*)(out + (size_t)t * D + 512 * j + 8 * lane) = (f32x4){r[0], r[1], r[2], r[3]};
            *(GAS f32x4*)(out + (size_t)t * D + 512 * j + 8 * lane + 4) = (f32x4){r[4], r[5], r[6], r[7]};
        }
    }
}


constexpr float ATT_QSCALE = 0.08838834764831845f * 1.4426950408889634f;
__device__ __forceinline__ void attn_prep_unit(Frame& F, const Args& a, int n, int h) {
    const int wave = F.wave, lane = F.lane, tid = F.tid;
    LAS bf16* kst = (LAS bf16*)(F.lds);
    LAS bf16* vst = (LAS bf16*)(F.lds + 16384);
    const bf16* AQ = (const bf16*)(F.ws + WS_AQ); const bf16* AK = (const bf16*)(F.ws + WS_AK); const bf16* AV = (const bf16*)(F.ws + WS_AV);
    bf16* QH = (bf16*)(F.ws + WS_QH);
    const float* qg = a.in[6]; const float* kg = a.in[7];
    const float gq0 = qg[2 * lane], gq1 = qg[2 * lane + 1], gk0 = kg[2 * lane], gk1 = kg[2 * lane + 1];
#pragma unroll
    for (int i = 0; i < 8; ++i) {
        const int row = n * 64 + wave * 8 + i; const size_t off = (size_t)row * ATT_W + h * ATT_HD + 2 * lane;
        const unsigned qv = *(const unsigned*)(AQ + off), kv = *(const unsigned*)(AK + off), vv = *(const unsigned*)(AV + off);
        const float q0 = __uint_as_float(qv << 16), q1 = __uint_as_float(qv & 0xffff0000u), k0 = __uint_as_float(kv << 16), k1 = __uint_as_float(kv & 0xffff0000u);
        const float rq = rsqrtf(wave_sum(q0 * q0 + q1 * q1) * (1.f / 128.f) + 1e-6f) * ATT_QSCALE, rk = rsqrtf(wave_sum(k0 * k0 + k1 * k1) * (1.f / 128.f) + 1e-6f);
        *(unsigned*)(QH + off) = pk2(q0 * rq * gq0, q1 * rq * gq1);
        *(LAS unsigned*)(kst + (wave * 8 + i) * 128 + 2 * lane) = pk2(k0 * rk * gk0, k1 * rk * gk1);
        *(LAS unsigned*)(vst + (wave * 8 + i) * 128 + 2 * lane) = vv;
    }
    __syncthreads();
    bf16* KI = (bf16*)(F.ws + WS_KIMG) + (size_t)(n * ATT_H + h) * 8192; bf16* VI = (bf16*)(F.ws + WS_VIMG) + (size_t)(n * ATT_H + h) * 8192;
#pragma unroll
    for (int i = 0; i < 2; ++i) {
        const int g = tid + 512 * i;
        { const int c16 = g >> 6, key = g & 63; const u32x4 v = *(const LAS u32x4*)(kst + key * 128 + c16 * 8); *(u32x4*)(KI + (size_t)g * 8) = v; }
        { const int kg8 = g >> 7, d = g & 127; unsigned short e[8];
#pragma unroll
          for (int j = 0; j < 8; ++j) e[j] = vst[(kg8 * 8 + j) * 128 + d];
          u32x4 v; v.x = e[0] | ((unsigned)e[1] << 16); v.y = e[2] | ((unsigned)e[3] << 16); v.z = e[4] | ((unsigned)e[5] << 16); v.w = e[6] | ((unsigned)e[7] << 16);
          *(u32x4*)(VI + (size_t)g * 8) = v; }
    }
    __syncthreads();
}

__device__ __forceinline__ int crow(int r, int hi) { return (r & 3) + 8 * (r >> 2) + 4 * hi; }
__device__ __forceinline__ void attn_unit(Frame& F, const Args& a, int n4, int h) {
    const int w = F.wave, lane = F.lane, r32 = lane & 31, hi = lane >> 5, tid = F.tid;
    const int p = w >> 1, half = w & 1, c = 4 * n4 + p, qrow0 = c * 64 + 32 * half;
    LAS unsigned char* lds = F.lds;
    LAS float* btab = (LAS float*)(lds + 65536); LAS float* xch = (LAS float*)(lds + 67584 + 256 * w); LAS bf16* ost = (LAS bf16*)(lds + 8192 * w);
    const float* relb = a.in[8] + h * 257;
    if (tid < 257) btab[tid] = relb[tid] * 1.4426950408889634f;
    const bf16* QH = (const bf16*)(F.ws + WS_QH);
    LAS unsigned char* qimg = lds + 69632 + 8192 * w;
#pragma unroll
    for (int d0 = 0; d0 < 8; ++d0) { const bf16x8 qv = *(const bf16x8*)(QH + (size_t)(qrow0 + r32) * ATT_W + h * ATT_HD + d0 * 16 + hi * 8);
        *(LAS bf16x8*)(qimg + ((2 * d0 + hi) * 32 + r32) * 16) = qv; }
    const char* KIMG = (const char*)(F.ws + WS_KIMG); const char* VIMG = (const char*)(F.ws + WS_VIMG);
    f32x16 o[4];
#pragma unroll
    for (int dt = 0; dt < 4; ++dt)
#pragma unroll
        for (int r = 0; r < 16; ++r) o[dt][r] = 0.f;
    float m = -1.0e30f, l = 0.f;
    const int s0 = (4 * n4 - 8 < 0) ? (8 - 4 * n4) : 0;
#define ATT_STAGE(s_) do { const int kc_ = 4 * n4 - 8 + (s_); const size_t gb_ = (size_t)(kc_ * ATT_H + h) * 16384; const unsigned lb_ = ((s_) & 1) * 32768; \
        _Pragma("unroll") for (int i_ = 0; i_ < 2; ++i_) { const int pc_ = w + 8 * i_; \
            __builtin_amdgcn_global_load_lds((const unsigned*)(KIMG + gb_ + pc_ * 1024 + lane * 16), (LAS unsigned*)(lds + lb_ + pc_ * 1024), 16, 0, 0); \
            __builtin_amdgcn_global_load_lds((const unsigned*)(VIMG + gb_ + pc_ * 1024 + lane * 16), (LAS unsigned*)(lds + lb_ + 16384 + pc_ * 1024), 16, 0, 0); } } while (0)
    ATT_STAGE(s0);
    for (int s = s0; s < 12; ++s) {
        asm volatile("s_waitcnt vmcnt(0) lgkmcnt(0)" ::: "memory");
        __builtin_amdgcn_s_barrier();
        if (s + 1 < 12) ATT_STAGE(s + 1);
        if (s >= p && s <= p + 8) {
            const LAS unsigned char* kb = lds + (s & 1) * 32768; const LAS unsigned char* vb = kb + 16384;
            f32x16 p0, p1;
#pragma unroll
            for (int r = 0; r < 16; ++r) { p0[r] = 0.f; p1[r] = 0.f; }
#pragma unroll
            for (int d0 = 0; d0 < 8; ++d0) {
                const bf16x8 k0 = *(const LAS bf16x8*)(kb + (2 * d0 + hi) * 1024 + r32 * 16), k1 = *(const LAS bf16x8*)(kb + (2 * d0 + hi) * 1024 + (r32 + 32) * 16);
                const bf16x8 qv = *(const LAS bf16x8*)(qimg + ((2 * d0 + hi) * 32 + r32) * 16);
                p0 = __builtin_amdgcn_mfma_f32_32x32x16_bf16(k0, qv, p0, 0, 0, 0);
                p1 = __builtin_amdgcn_mfma_f32_32x32x16_bf16(k1, qv, p1, 0, 0, 0);
                if (d0 & 1) __builtin_amdgcn_sched_barrier(0);
            }
            const int wrel = p + 8 - s;
            if (wrel >= 3) { const float bc = btab[256];
#pragma unroll
                for (int r = 0; r < 16; ++r) { p0[r] += bc; p1[r] += bc; } }
            else { const int base = 64 * wrel + 32 * half + r32 + 128;
#pragma unroll
                for (int r = 0; r < 16; ++r) { int i0 = base - crow(r, hi), i1 = i0 - 32; i0 = i0 > 256 ? 256 : i0; i1 = i1 > 256 ? 256 : i1; i1 = i1 < 0 ? 0 : i1; i0 = i0 < 0 ? 0 : i0; p0[r] += btab[i0]; p1[r] += btab[i1]; } }
            float mx = p0[0];
#pragma unroll
            for (int r = 1; r < 16; ++r) mx = fmaxf(mx, p0[r]);
#pragma unroll
            for (int r = 0; r < 16; ++r) mx = fmaxf(mx, p1[r]);
            mx = fmaxf(mx, __shfl_xor(mx, 32));
            const float mn = fmaxf(m, mx), alpha = __builtin_amdgcn_exp2f(m - mn);
            float ps = 0.f;
#pragma unroll
            for (int r = 0; r < 16; ++r) { p0[r] = __builtin_amdgcn_exp2f(p0[r] - mn); p1[r] = __builtin_amdgcn_exp2f(p1[r] - mn); ps += p0[r] + p1[r]; }
            l = l * alpha + ps;
            if (__any(mn > m)) {
                if (hi == 0) xch[r32] = alpha;
                asm volatile("s_waitcnt lgkmcnt(0)" ::: "memory");
#pragma unroll
                for (int g = 0; g < 4; ++g) { const f32x4 av = *(const LAS f32x4*)(xch + 8 * g + 4 * hi);
#pragma unroll
                    for (int dt = 0; dt < 4; ++dt) { o[dt][4 * g] *= av[0]; o[dt][4 * g + 1] *= av[1]; o[dt][4 * g + 2] *= av[2]; o[dt][4 * g + 3] *= av[3]; } }
            }
            m = mn;
            bf16x8 pa[4];
#pragma unroll
            for (int ks = 0; ks < 4; ++ks) { const f32x16& src = (ks < 2) ? p0 : p1; const int b = (ks & 1) * 8; u32x4 t;
                t.x = cvt_pk_bf16(src[b], src[b + 1]); t.y = cvt_pk_bf16(src[b + 2], src[b + 3]); t.z = cvt_pk_bf16(src[b + 4], src[b + 5]); t.w = cvt_pk_bf16(src[b + 6], src[b + 7]);
                pa[ks] = __builtin_bit_cast(bf16x8, t); }
#pragma unroll
            for (int dt = 0; dt < 4; ++dt)
#pragma unroll
                for (int ks = 0; ks < 4; ++ks) {
                    const LAS unsigned char* vp = vb + (2 * ks) * 2048 + (32 * dt + r32) * 16 + 8 * hi;
                    const u32x2 lo = *(const LAS u32x2*)vp, hh = *(const LAS u32x2*)(vp + 2048);
                    const u32x4 bq = (u32x4){lo.x, lo.y, hh.x, hh.y};
                    o[dt] = __builtin_amdgcn_mfma_f32_32x32x16_bf16(pa[ks], __builtin_bit_cast(bf16x8, bq), o[dt], 0, 0, 0);
                    if (ks == 3) __builtin_amdgcn_sched_barrier(0);
                }
        }
    }
#undef ATT_STAGE
    asm volatile("s_waitcnt lgkmcnt(0)" ::: "memory");
    __builtin_amdgcn_s_barrier();
    l += __shfl_xor(l, 32);
    if (hi == 0) xch[32 + r32] = 1.f / l;
    asm volatile("s_waitcnt lgkmcnt(0)" ::: "memory");
#pragma unroll
    for (int g = 0; g < 4; ++g) { const f32x4 iv = *(const LAS f32x4*)(xch + 32 + 8 * g + 4 * hi);
#pragma unroll
        for (int dt = 0; dt < 4; ++dt)
#pragma unroll
            for (int j = 0; j < 4; ++j) ost[(8 * g + 4 * hi + j) * 128 + 32 * dt + r32] = (bf16)f2bf(o[dt][4 * g + j] * iv[j]); }
    asm volatile("s_waitcnt lgkmcnt(0)" ::: "memory");
    bf16* YA = (bf16*)(F.ws + WS_YA);
#pragma unroll
    for (int i = 0; i < 8; ++i) { const int g = i * 64 + lane, row = g >> 4, c16 = g & 15; const u32x4 v = *(const LAS u32x4*)(ost + row * 128 + c16 * 8);
        *(u32x4*)(YA + (size_t)(qrow0 + row) * ATT_W + h * ATT_HD + c16 * 8) = v; }
    asm volatile("s_waitcnt vmcnt(0) lgkmcnt(0)" ::: "memory");
    __builtin_amdgcn_s_barrier();
}


__device__ __forceinline__ void gla_prep_unit(Frame& F, const Args& a, int n, int cg) {
    const int tid = F.tid, cq = tid & 15, seg = tid >> 4;
    const int h = cg >> 2, dk0 = (cg & 3) * 64 + 4 * cq, col0 = h * GLA_DK + dk0, nh = n * GLA_H + h;
    const float* wgu = a.in[3]; const float* bgt = a.in[4]; const float* GLR = (const float*)(F.ws + WS_GLR);
    const bf16* GQ = (const bf16*)(F.ws + WS_GQ); const bf16* GK = (const bf16*)(F.ws + WS_GK);
    LAS float* tot = (LAS float*)F.lds;
    LAS float* wl = tot + 2048;
    if (seg < 16) *(LAS f32x4*)(wl + seg * 64 + 4 * cq) = *(const f32x4*)(wgu + seg * GLA_QK + col0);
    __syncthreads();
    const f32x4 bgv = *(const f32x4*)(bgt + col0);
    f32x4 cs[8]; f32x4 run = (f32x4){0.f, 0.f, 0.f, 0.f};
    const int t0 = n * 256 + seg * 8;
#pragma unroll
    for (int i = 0; i < 8; ++i) {
        const f32x4* gp = (const f32x4*)(GLR + (size_t)(t0 + i) * 16); f32x4 z = bgv;
#pragma unroll
        for (int q = 0; q < 4; ++q) { const f32x4 gv = gp[q]; const LAS f32x4* wp = (const LAS f32x4*)(wl + 4 * q * 64 + 4 * cq);
            z += wp[0] * gv.x; z += wp[16] * gv.y; z += wp[32] * gv.z; z += wp[48] * gv.w; }
#pragma unroll
        for (int j = 0; j < 4; ++j) run[j] += log_sigmoid(z[j]) * (1.f / 16.f);
        cs[i] = run;
    }
    *(LAS f32x4*)(tot + seg * 64 + 4 * cq) = run;
    __syncthreads();
    f32x4 off = (f32x4){0.f, 0.f, 0.f, 0.f}, total = (f32x4){0.f, 0.f, 0.f, 0.f};
    for (int sg = 0; sg < 32; ++sg) { const f32x4 tv = *(const LAS f32x4*)(tot + sg * 64 + 4 * cq); total += tv; if (sg < seg) off += tv; }
    unsigned kew[4][4];
    bf16* ACAT = (bf16*)(F.ws + WS_ACAT); bf16* KI = (bf16*)(F.ws + WS_KI); bf16* KET = (bf16*)(F.ws + WS_KET);
    float kprev[4];
#pragma unroll
    for (int i = 0; i < 8; ++i) {
        const size_t trow = (size_t)(t0 + i);
        const u32x2 qv = *(const u32x2*)(GQ + trow * GLA_QK + col0), kv = *(const u32x2*)(GK + trow * GLA_QK + col0);
        float q[4] = {__uint_as_float(qv.x << 16), __uint_as_float(qv.x & 0xffff0000u), __uint_as_float(qv.y << 16), __uint_as_float(qv.y & 0xffff0000u)};
        float k[4] = {__uint_as_float(kv.x << 16), __uint_as_float(kv.x & 0xffff0000u), __uint_as_float(kv.y << 16), __uint_as_float(kv.y & 0xffff0000u)};
        float qd[4], ki[4], ke[4];
#pragma unroll
        for (int j = 0; j < 4; ++j) { const float bc = cs[i][j] + off[j]; qd[j] = q[j] * 0.0625f * __expf(bc); ki[j] = k[j] * __expf(-bc); ke[j] = k[j] * __expf(total[j] - bc); }
        const size_t lrow = (size_t)nh * 256 + seg * 8 + i;
        u32x2 o; o.x = pk2(qd[0], qd[1]); o.y = pk2(qd[2], qd[3]); *(u32x2*)(ACAT + lrow * 512 + 256 + dk0) = o;
        o.x = pk2(ki[0], ki[1]); o.y = pk2(ki[2], ki[3]); *(u32x2*)(KI + lrow * 256 + dk0) = o;
        if (i & 1) {
#pragma unroll
            for (int j = 0; j < 4; ++j) kew[j][i >> 1] = pk2(kprev[j], ke[j]); }
        else {
#pragma unroll
            for (int j = 0; j < 4; ++j) kprev[j] = ke[j]; }
    }
#pragma unroll
    for (int j = 0; j < 4; ++j) *(u32x4*)(KET + ((size_t)nh * 256 + dk0 + j) * 256 + seg * 8) = (u32x4){kew[j][0], kew[j][1], kew[j][2], kew[j][3]};
    if (seg == 0) *(f32x4*)((float*)(F.ws + WS_DEC) + n * GLA_QK + col0) = (f32x4){__expf(total[0]), __expf(total[1]), __expf(total[2]), __expf(total[3])};
    __syncthreads();
}
__device__ __forceinline__ void gla_vt_unit(Frame& F, int n, int h, int g8) {
    const int tid = F.tid; const int nh = n * GLA_H + h;
    LAS bf16* tile = (LAS bf16*)F.lds;
    const bf16* GV = (const bf16*)(F.ws + WS_GV); bf16* BCAT = (bf16*)(F.ws + WS_BCAT);
#pragma unroll
    for (int ps = 0; ps < 4; ++ps) { const int row = (tid >> 3) + 64 * ps, ch = tid & 7;
        const u32x4 v = *(const u32x4*)(GV + (size_t)(n * 256 + row) * GLA_V + h * GLA_DV + g8 * 64 + ch * 8);
        *(LAS u32x2*)(tile + row * 72 + ch * 8) = (u32x2){v.x, v.y}; *(LAS u32x2*)(tile + row * 72 + ch * 8 + 4) = (u32x2){v.z, v.w}; }
    __syncthreads();
#pragma unroll
    for (int i = 0; i < 4; ++i) { const int g = tid + 512 * i, c = g & 63, tg = g >> 6; unsigned short e[8];
#pragma unroll
        for (int j = 0; j < 8; ++j) e[j] = tile[(tg * 8 + j) * 72 + c];
        u32x4 v; v.x = e[0] | ((unsigned)e[1] << 16); v.y = e[2] | ((unsigned)e[3] << 16); v.z = e[4] | ((unsigned)e[5] << 16); v.w = e[6] | ((unsigned)e[7] << 16);
        *(u32x4*)(BCAT + ((size_t)nh * 512 + g8 * 64 + c) * 512 + tg * 8) = v; }
    __syncthreads();
}
__device__ __forceinline__ void gla_scan(Frame& F) {
    const bf16* UT = (const bf16*)(F.ws + WS_UT); bf16* BCAT = (bf16*)(F.ws + WS_BCAT); const float* DEC = (const float*)(F.ws + WS_DEC);
    for (int idx = F.vcu * (NWAVES * 64) + F.tid; idx < GLA_H * GLA_DV * 64; idx += F.G * NWAVES * 64) {
        const int dk4 = (idx & 63) * 4, dv = (idx >> 6) & 511, h = idx >> 15;
        float s[4] = {0.f, 0.f, 0.f, 0.f};
#pragma unroll 8
        for (int n = 0; n < 32; ++n) {
            const size_t nh = (size_t)n * GLA_H + h;
            u32x2 o; o.x = pk2(s[0], s[1]); o.y = pk2(s[2], s[3]); *(u32x2*)(BCAT + (nh * 512 + dv) * 512 + 256 + dk4) = o;
            const u32x2 uv = *(const u32x2*)(UT + (nh * 512 + dv) * 256 + dk4); const f32x4 dc = *(const f32x4*)(DEC + n * GLA_QK + h * GLA_DK + dk4);
            s[0] = s[0] * dc.x + __uint_as_float(uv.x << 16); s[1] = s[1] * dc.y + __uint_as_float(uv.x & 0xffff0000u);
            s[2] = s[2] * dc.z + __uint_as_float(uv.y << 16); s[3] = s[3] * dc.w + __uint_as_float(uv.y & 0xffff0000u);
        }
    }
}
__device__ __forceinline__ void gla_norm(Frame& F, const Args& a) {
    const int gw = F.vcu * NWAVES + F.wave, NGW = F.G * NWAVES, lane = F.lane;
    const bf16* OB = (const bf16*)(F.ws + WS_OB); const bf16* GR = (const bf16*)(F.ws + WS_GR); bf16* YG = (bf16*)(F.ws + WS_YG); const float* g = a.in[5];
    const f32x4 g0 = *(const f32x4*)(g + 8 * lane), g1 = *(const f32x4*)(g + 8 * lane + 4);
    for (int wi = gw; wi < S * GLA_H; wi += NGW) {
        const size_t off = (size_t)(wi >> 2) * GLA_V + (wi & 3) * GLA_DV + 8 * lane;
        const u32x4 ov = *(const u32x4*)(OB + off), rv = *(const u32x4*)(GR + off);
        float o[8], r[8]; float ss = 0.f;
#pragma unroll
        for (int j = 0; j < 4; ++j) { o[2 * j] = __uint_as_float(ov[j] << 16); o[2 * j + 1] = __uint_as_float(ov[j] & 0xffff0000u); r[2 * j] = __uint_as_float(rv[j] << 16); r[2 * j + 1] = __uint_as_float(rv[j] & 0xffff0000u); }
#pragma unroll
        for (int j = 0; j < 8; ++j) ss += o[j] * o[j];
        const float rstd = rsqrtf(wave_sum(ss) * (1.f / GLA_DV) + 1e-6f);
        u32x4 w; w.x = pk2(o[0] * rstd * g0.x * r[0], o[1] * rstd * g0.y * r[1]); w.y = pk2(o[2] * rstd * g0.z * r[2], o[3] * rstd * g0.w * r[3]);
        w.z = pk2(o[4] * rstd * g1.x * r[4], o[5] * rstd * g1.y * r[5]); w.w = pk2(o[6] * rstd * g1.z * r[6], o[7] * rstd * g1.w * r[7]);
        *(u32x4*)(YG + off) = w;
    }
}

__global__ void __launch_bounds__(NWAVES * 64, 2) fwd(Args args) {
    extern __shared__ __attribute__((aligned(16))) unsigned char lds_raw[];
    Frame F;
    F.lds = (LAS unsigned char*)lds_raw; F.MISC = (volatile LAS unsigned*)(F.lds + MISC_OFF);
    F.tid = threadIdx.x; F.lane = F.tid & 63; F.wave = __builtin_amdgcn_readfirstlane(F.tid >> 6);
    F.G = gridDim.x; { const int bx = blockIdx.x; F.vcu = (F.G % 8 == 0) ? (bx % 8) * (F.G / 8) + bx / 8 : bx; }
    F.ws = args.ws; F.ctl = (unsigned*)(args.ws + WS_CTL);
    for (int u = F.tid; u < (LDS_BYTES - CTLZ_OFF) / 4; u += NWAVES * 64) ((LAS unsigned*)(F.lds + CTLZ_OFF))[u] = 0u;
    __syncthreads();
    XcdBarrier bar = xcd_barrier_post(F.ctl + CW_BAR + args.li * XCD_BAR_WORDS, F.MISC + 8);
    const int lo = args.ph_lo, hi = args.ph_hi;
#define IN(k) (lo <= (k) && (k) < hi)
#define SEAM(k) do { if (IN(k) && IN((k) + 1)) xcd_barrier(bar); } while (0)
    unsigned char* ws = args.ws;
#ifndef DUP_MASK
#define DUP_MASK 0
#endif
#define DUP(k) ((DUP_MASK >> (k)) & 1)
#define PHASE(k, ...) do { if (IN(k)) { __VA_ARGS__ if (DUP(k)) { xcd_barrier(bar); __VA_ARGS__ } } SEAM(k); } while (0)
#define PHASE_NB(k, ...) do { if (IN(k)) { __VA_ARGS__ if (DUP(k)) { xcd_barrier(bar); __VA_ARGS__ } } } while (0)
    const int gcus = (F.G == 256) ? GEMM_CUS : F.G;
    PHASE(0, { p0_convert(F, args, 0, gcus < F.G ? P0_I_IN : P0_NITEMS, F.vcu * NWAVES + F.wave, F.G * NWAVES); if (gcus == F.G) p0_convert8(F, args, F.vcu * NWAVES + F.wave, F.G * NWAVES); p0_rows(F, args);
        for (int u = F.vcu; u < S / 32; u += F.G) normproj_unit<0>(F, args, u); });
    PHASE(1, { if ((int)blockIdx.x < gcus) { pg8::DenseSched Sc; Sc.init(ws + WS_XN, ws + WS_WIN, S, NPROJ, D, gcus, (int)blockIdx.x); pg8::EpiProj E{ws, args.in[9]};
            pg8::gemm_phase<pg8::EpiProj, pg8::DenseSched>(F.lds, D, D, D, Sc, E); }
        else { p0_convert(F, args, P0_I_IN, P0_NITEMS, ((int)blockIdx.x - gcus) * NWAVES + F.wave, (F.G - gcus) * NWAVES); p0_convert8(F, args, ((int)blockIdx.x - gcus) * NWAVES + F.wave, (F.G - gcus) * NWAVES); } });
    PHASE(2, { for (int rp = 0; rp < 1 + DUP(16); ++rp) for (int u = F.vcu; u < NCH * ATT_H; u += F.G) attn_prep_unit(F, args, u >> 3, u & 7);
        for (int rp = 0; rp < 1 + DUP(17); ++rp) for (int u = F.vcu; u < 32 * 16; u += F.G) gla_prep_unit(F, args, u >> 4, u & 15);
        for (int rp = 0; rp < 1 + DUP(18); ++rp) for (int u = F.vcu; u < 32 * GLA_H * 8; u += F.G) gla_vt_unit(F, u >> 5, (u >> 3) & 3, u & 7); });
    PHASE(3, { for (int u = F.vcu; u < (NCH / 4) * ATT_H; u += F.G) attn_unit(F, args, u >> 3, u & 7);
        { pg8::GlaSched Sc{0, F.G, F.G - 1 - (int)blockIdx.x, ws}; pg8::EpiGla<0> E{ws}; pg8::gemm_phase<pg8::EpiGla<0>, pg8::GlaSched>(F.lds, 256, 512, 256, Sc, E); }
        { pg8::GlaSched Sc{1, F.G, (int)blockIdx.x, ws}; pg8::EpiGla<1> E{ws}; pg8::gemm_phase<pg8::EpiGla<1>, pg8::GlaSched>(F.lds, 256, 512, 256, Sc, E); } });
    PHASE(4, { gla_scan(F); });
    PHASE(5, { pg8::GlaSched Sc{2, F.G, (int)blockIdx.x, ws}; pg8::EpiGla<2> E{ws}; pg8::gemm_phase<pg8::EpiGla<2>, pg8::GlaSched>(F.lds, 512, 512, 512, Sc, E); });
    PHASE(6, { gla_norm(F, args); });
    PHASE_NB(7, { pg8::DenseSched Sc; Sc.init(ws + WS_YG, ws + WS_WBG, S, D, GLA_V, F.G, (int)blockIdx.x); pg8::EpiBranch<0> E{(const bf16*)(ws + WS_SG), nullptr, (bf16*)(ws + WS_T)};
        pg8::gemm_phase<pg8::EpiBranch<0>, pg8::DenseSched>(F.lds, GLA_V, GLA_V, GLA_V, Sc, E); });
    PHASE(8, { pg8::DenseSched Sc; Sc.init(ws + WS_YA, ws + WS_WBA, S, D, ATT_W, F.G, (int)blockIdx.x); pg8::EpiBranch<1> E{(const bf16*)(ws + WS_SA), (const bf16*)(ws + WS_T), (bf16*)(ws + WS_MG)};
        pg8::gemm_phase<pg8::EpiBranch<1>, pg8::DenseSched>(F.lds, ATT_W, ATT_W, ATT_W, Sc, E); });
    PHASE(9, { pg8::DenseSched Sc; Sc.init(ws + WS_MG, ws + WS_WOUT, S, D, D, F.G, (int)blockIdx.x); pg8::EpiResid E{args.in[0], (float*)(ws + WS_H1)};
        pg8::gemm_phase<pg8::EpiResid, pg8::DenseSched>(F.lds, D, D, D, Sc, E); });
    PHASE(10, { for (int u = F.vcu; u < S / 32; u += F.G) normproj_unit<1>(F, args, u); });
    PHASE(11, { moe_table(F); p7_gather(F); });
    PHASE(12, { moe_table(F); pg8::MoeSched Sc; Sc.init(ws + WS_HNG, ws + WS_GU, (volatile LAS int*)(F.lds + TAB_OFF), (volatile LAS int*)(F.lds + TAB_OFF + 256), 16, D, F.G, (int)blockIdx.x);
        pg8::EpiSwiglu E{args.in[17], args.in[19], ws + WS_HD};
        pg8::gemm_phase8<pg8::EpiSwiglu, pg8::MoeSched>(F.lds, D, D, D, Sc, E); });
    PHASE(13, { moe_table(F); pg8::MoeSched Sc; Sc.init(ws + WS_HD, ws + WS_DN, (volatile LAS int*)(F.lds + TAB_OFF), (volatile LAS int*)(F.lds + TAB_OFF + 256), 8, DFF, F.G, (int)blockIdx.x);
        pg8::EpiDown E{args.in[21], (const int*)(ws + WS_RPAIR), (const float*)(ws + WS_RW), (bf16*)(ws + WS_PY)};
        pg8::gemm_phase8<pg8::EpiDown, pg8::MoeSched>(F.lds, DFF, DFF, DFF, Sc, E); });
    PHASE(14, { p10_combine(F, args); });
#undef PHASE
#undef PHASE_NB
#undef IN
#undef SEAM
}

extern "C" void kernel_launch(void* const* d_in, const int* in_sizes, int n_in, void* d_out, int out_size, void* d_ws, size_t ws_size, hipStream_t stream) {
    static int grid = 0;
    if (grid == 0) {
        if (n_in != 22 || out_size != S * D || ws_size < WS_END) { fprintf(stderr, "kernel_launch: unexpected problem (n_in %d out %d ws %zu)\n", n_in, out_size, ws_size); grid = -1; return; }
        int dev = 0, cus = 0, per_cu = 0;
        if (hipGetDevice(&dev) != hipSuccess || hipDeviceGetAttribute(&cus, hipDeviceAttributeMultiprocessorCount, dev) != hipSuccess) { grid = -1; return; }
        if (hipFuncSetAttribute((const void*)fwd, hipFuncAttributeMaxDynamicSharedMemorySize, LDS_BYTES) != hipSuccess) { fprintf(stderr, "kernel_launch: hipFuncSetAttribute failed\n"); grid = -1; return; }
        if (hipOccupancyMaxActiveBlocksPerMultiprocessor(&per_cu, (const void*)fwd, NWAVES * 64, LDS_BYTES) != hipSuccess || per_cu < 1) fprintf(stderr, "kernel_launch: occupancy query says %d\n", per_cu);
        (void)hipGetLastError();
        grid = cus;
    }
    if (grid < 0) return;
    (void)hipMemsetAsync((char*)d_ws + WS_CTL, 0, CTL_ZERO_BYTES, stream);
    Args a{};
    for (int i = 0; i < 22; ++i) a.in[i] = (const float*)d_in[i];
    a.out = (float*)d_out; a.ws = (unsigned char*)d_ws;
    a.ph_lo = 0; a.ph_hi = 15; a.li = 0;
    hipLaunchKernelGGL(fwd, dim3(grid), dim3(NWAVES * 64), LDS_BYTES, stream, a);
}
```

```cpp
#include <hip/hip_runtime.h>
#include <stdint.h>
#include <cstdio>

constexpr int S = 8192, D = 2048;
constexpr int GLA_H = 4, GLA_DK = 256, GLA_DV = 512, GLA_QK = 1024, GLA_V = 2048;
constexpr int ATT_H = 8, ATT_HD = 128, ATT_W = 1024, NCH = S / 64;
constexpr int NE = 32, DFF = 2048;
constexpr int IN_COLS = 13328, C_GLR = 6144;
constexpr int NPROJ = 13312;
constexpr int MAXROWS = 32768 + NE * 256;

constexpr size_t MiB = 1u << 20;
constexpr size_t WS_CTL = 0, CTL_ZERO_BYTES = 1 * MiB;
constexpr size_t WS_TOPW = 1 * MiB, WS_TOPE = WS_TOPW + 128 * 1024, WS_TOPS = WS_TOPE + 128 * 1024, WS_RPAIR = WS_TOPS + 128 * 1024, WS_RW = WS_RPAIR + 256 * 1024;
constexpr size_t WS_GLR = 2 * MiB, WS_WR = 3 * MiB;
constexpr size_t WS_WIN = 8 * MiB, WS_WBG = 60 * MiB, WS_WBA = 68 * MiB, WS_WOUT = 72 * MiB, WS_GU = 80 * MiB, WS_DN = 592 * MiB;
constexpr size_t WS_XN = 848 * MiB, WS_GQ = 880 * MiB, WS_GK = 896 * MiB, WS_GV = 912 * MiB, WS_GR = 944 * MiB, WS_AQ = 976 * MiB, WS_AK = 992 * MiB, WS_AV = 1008 * MiB;
constexpr size_t WS_SG = 1024 * MiB, WS_SA = 1056 * MiB, WS_YG = 1088 * MiB, WS_YA = 1120 * MiB, WS_T = 1136 * MiB, WS_MG = 1168 * MiB, WS_HN = 1200 * MiB;
constexpr size_t WS_HNG = 1232 * MiB, WS_HD = 1392 * MiB, WS_PY = 1552 * MiB, WS_QH = 1681 * MiB, WS_KIMG = 1697 * MiB, WS_VIMG = 1713 * MiB;
constexpr size_t WS_ACAT = 1729 * MiB, WS_BCAT = 1761 * MiB, WS_KI = 1825 * MiB, WS_KET = 1841 * MiB, WS_UT = 1857 * MiB, WS_DEC = 1889 * MiB, WS_OB = 1890 * MiB, WS_H1 = 1922 * MiB, WS_END = 1986 * MiB;
constexpr int CW_CNT = 256;
constexpr int CW_BAR = 4096;

typedef unsigned short bf16;
typedef short bf16x8 __attribute__((ext_vector_type(8)));
typedef float f32x4 __attribute__((ext_vector_type(4)));
typedef float f32x16 __attribute__((ext_vector_type(16)));
typedef unsigned u32x4 __attribute__((ext_vector_type(4)));
typedef unsigned u32x2 __attribute__((ext_vector_type(2)));
typedef int v8i __attribute__((ext_vector_type(8)));
#define LAS __attribute__((address_space(3)))
#define GAS __attribute__((address_space(1)))
__device__ __forceinline__ float bf2f(bf16 v) { return __uint_as_float((unsigned)v << 16); }
__device__ __forceinline__ unsigned f2bf(float f) { unsigned u = __float_as_uint(f); return (u + 0x7fffu + ((u >> 16) & 1u)) >> 16; }
__device__ __forceinline__ unsigned pk2(float lo, float hi) { return f2bf(lo) | (f2bf(hi) << 16); }
__device__ __forceinline__ unsigned cvt_pk_bf16(float lo, float hi) { unsigned r; asm volatile("v_cvt_pk_bf16_f32 %0, %1, %2" : "=v"(r) : "v"(lo), "v"(hi)); return r; }
__device__ __forceinline__ float wave_sum(float v) {
#pragma unroll
    for (int o = 1; o < 64; o <<= 1) v += __shfl_xor(v, o);
    return v;
}
__device__ __forceinline__ float sigmoidf_(float x) { return __builtin_amdgcn_rcpf(1.f + __expf(-x)); }
__device__ __forceinline__ float log_sigmoid(float z) { return fminf(z, 0.f) - log1pf(__expf(-fabsf(z))); }
#define LDS_WAIT() asm volatile("s_waitcnt lgkmcnt(0)" ::: "memory")
#define VM_WAIT() asm volatile("s_waitcnt vmcnt(0)" ::: "memory")

#define XB_TMO      128
#define XB_XCNT(j)  (256  + 64 * (j))
#define XB_XSUB(j)  (1280 + 64 * (j))
#define XB_XGEN(j)  (2304 + 64 * (j))
#define XB_TOP      3328
#define XB_TOPGEN   3392
#define XCD_BAR_WORDS 3456
#define XB_SPIN_CAP (1u << 18)
__device__ __forceinline__ unsigned xb_ld(unsigned* p)              { return __hip_atomic_load(p, __ATOMIC_RELAXED, __HIP_MEMORY_SCOPE_AGENT); }
__device__ __forceinline__ unsigned xb_add(unsigned* p, unsigned v) { return __hip_atomic_fetch_add(p, v, __ATOMIC_RELAXED, __HIP_MEMORY_SCOPE_AGENT); }
__device__ __forceinline__ unsigned xb_xcc_id() { return (unsigned)__builtin_amdgcn_s_getreg((3 << 11) | 20) & 0xFu; }
#define XB_SPIN(cond, bar) do { unsigned _sp = 0; while (cond) { __builtin_amdgcn_s_sleep(1); \
    if ((++_sp & 255u) == 0u) { if (xb_ld(&(bar)[XB_TMO])) break; if (_sp > XB_SPIN_CAP) { atomicAdd(&(bar)[XB_TMO], 1u); break; } } } } while (0)
struct XcdBarrier { unsigned* bar; unsigned x; volatile LAS unsigned* st; };
__device__ __forceinline__ XcdBarrier xcd_barrier_post(unsigned* bar, volatile LAS unsigned* st) {
    XcdBarrier b; b.bar = bar; b.x = xb_xcc_id(); b.st = st;
    if (threadIdx.x == 0) (void)xb_add(&bar[XB_XCNT(b.x)], 1u);
    return b;
}
__device__ __forceinline__ void xcd_barrier_complete(unsigned* bar, unsigned x, unsigned& nloc, unsigned& nx) {
    const unsigned G = gridDim.x * gridDim.y * gridDim.z;
    unsigned sum, cnt, mine, sp = 0u;
    for (;;) {
        sum = 0u; cnt = 0u; mine = 0u;
#pragma unroll
        for (unsigned j = 0; j < 16; ++j) { const unsigned c = xb_ld(&bar[XB_XCNT(j)]); sum += c; cnt += (c > 0u) ? 1u : 0u; mine = (j == x) ? c : mine; }
        if (sum == G) break;
        __builtin_amdgcn_s_sleep(1);
        if ((++sp & 255u) == 0u) { if (xb_ld(&bar[XB_TMO])) break; if (sp > XB_SPIN_CAP) { atomicAdd(&bar[XB_TMO], 1u); break; } }
    }
    nloc = mine > 0u ? mine : 1u; nx = cnt > 0u ? cnt : 1u;
}
__device__ __forceinline__ void xcd_barrier(const XcdBarrier& b) {
    asm volatile("s_waitcnt vmcnt(0)" ::: "memory");
    __syncthreads();
    if (threadIdx.x == 0) {
        unsigned* bar = b.bar;
        __builtin_amdgcn_s_waitcnt(0);
        unsigned nloc = b.st[0], nx = b.st[1];
        if (nloc == 0u) { xcd_barrier_complete(bar, b.x, nloc, nx); b.st[0] = nloc; b.st[1] = nx; }
        const unsigned old = xb_add(&bar[XB_XSUB(b.x)], 1u);
        const unsigned gen = old / nloc;
        if (old + 1u == (gen + 1u) * nloc) {
            __builtin_amdgcn_fence(__ATOMIC_RELEASE, "agent");
            asm volatile("s_waitcnt vmcnt(0)" ::: "memory");
            const unsigned og = xb_add(&bar[XB_TOP], 1u);
            const unsigned tg = og / nx;
            if (og + 1u == (tg + 1u) * nx) xb_add(&bar[XB_TOPGEN], 1u);
            else XB_SPIN(xb_ld(&bar[XB_TOPGEN]) == tg, bar);
            __builtin_amdgcn_fence(__ATOMIC_ACQUIRE, "agent");
            xb_add(&bar[XB_XGEN(b.x)], 1u);
            asm volatile("s_waitcnt vmcnt(0)" ::: "memory");
        } else {
            XB_SPIN(xb_ld(&bar[XB_XGEN(b.x)]) == gen, bar);
            __builtin_amdgcn_fence(__ATOMIC_ACQUIRE, "agent");
            asm volatile("s_waitcnt vmcnt(0)" ::: "memory");
        }
    }
    __syncthreads();
}

namespace pg8 {
constexpr int BM = 256, BK = 64, HALF = 128, HTB = HALF * BK * 2, STAGE_BYTES = 8 * HTB, NXCD = 8, WGM = 8;
__host__ __device__ __forceinline__ int lds_byte(int r, int c) { const int st = (r >> 4) * 2 + (c >> 5), rr = r & 15, cc = c & 31, ob = rr * 64 + cc * 2; return st * 1024 + (ob ^ (((ob >> 9) & 1) << 5)); }
__host__ __device__ __forceinline__ void stage_rc(int b, int& R, int& C) { const int st = b / 1024, sb = b % 1024, swz = sb ^ (((sb >> 9) & 1) << 5); R = (st >> 1) * 16 + swz / 64; C = (st & 1) * 32 + (swz % 64) / 2; }
__host__ __device__ __forceinline__ int perm32(int rho) { const int n = rho >> 4, i = rho & 15; return 8 * (i >> 2) + 4 * n + (i & 3); }
__device__ __forceinline__ int xcd_remap(int wgid, int nwg) { const int q = nwg / NXCD, r = nwg % NXCD, xcd = wgid % NXCD, off = wgid / NXCD; return (xcd < r ? xcd * (q + 1) : r * (q + 1) + (xcd - r) * q) + off; }

struct Unit { const char* A; const char* B; int pm, pn, e, nrow; };

struct DenseSched {
    const char* A; const char* Bt; int nM, nN, nwg, G, c; size_t tstep;
    __device__ __forceinline__ void init(const void* A_, const void* Bt_, int M, int N, int K, int G_, int c_) { A = (const char*)A_; Bt = (const char*)Bt_; nM = M / BM; nN = N / BM; nwg = nM * nN; G = G_; c = c_; tstep = (size_t)BM * K * 2; }
    __device__ __forceinline__ bool next(int i, Unit& u) const {
        const long L = (long)i * G + c; if (L >= nwg) return false;
        const int wgid = xcd_remap((int)L, nwg);
        const int nig = WGM * nN, gid = wgid / nig, fm = gid * WGM, gsz = (nM - fm) < WGM ? (nM - fm) : WGM;
        u.pm = fm + ((wgid % nig) % gsz); u.pn = (wgid % nig) / gsz; u.e = 0; u.nrow = BM;
        u.A = A + (size_t)u.pm * tstep; u.B = Bt + (size_t)u.pn * tstep; return true;
    }
};
struct MoeSched {
    const char* A; const char* Bt; const volatile LAS int* tstart; const volatile LAS int* cnt; int NT, nwg, G, c; size_t tstep;
    __device__ __forceinline__ void init(const void* A_, const void* Bt_, const volatile LAS int* ts, const volatile LAS int* cn, int NT_, int Kbytes, int G_, int c_) {
        A = (const char*)A_; Bt = (const char*)Bt_; tstart = ts; cnt = cn; NT = NT_; nwg = ts[NE] * NT_; G = G_; c = c_; tstep = (size_t)BM * Kbytes; }
    __device__ __forceinline__ bool next(int i, Unit& u) const {
        const long L = (long)i * G + c; if (L >= nwg) return false;
        const int wgid = xcd_remap((int)L, nwg);
        int e = 0;
#pragma unroll 1
        for (int j = 1; j < NE; ++j) e = (wgid >= tstart[j] * NT) ? j : e;
        const int t0 = tstart[e], nte = tstart[e + 1] - t0, local = wgid - t0 * NT;
        const int pn = local / nte, mt = local - pn * nte;
        u.e = e; u.pn = pn; u.pm = t0 + mt; u.nrow = cnt[e] - mt * BM;
        u.A = A + (size_t)u.pm * tstep; u.B = Bt + (size_t)(e * NT + pn) * tstep; return true;
    }
};

template <class Epi, class Sched, bool BGRAN = false>
__device__ __forceinline__ void gemm_phase(LAS unsigned char* lds, const int K, const int lda, const int ldb, const Sched& S, const Epi& E) {
    const int tid = threadIdx.x, wid = __builtin_amdgcn_readfirstlane(tid >> 6), lane = tid & 63, wr = wid >> 2, wc = wid & 3, fr = lane & 15, fq = lane >> 4;
    int nt = K / BK; asm volatile("" : "+s"(nt));
    unsigned voffA[2], voffB[2];
#pragma unroll
    for (int i = 0; i < 2; ++i) { int R, C; stage_rc(tid * 16 + i * 8192, R, C); const int Rb = Epi::PERM ? ((R & ~31) + perm32(R & 31)) : R;
        voffA[i] = (unsigned)(R * lda + C) * 2u; voffB[i] = BGRAN ? (unsigned)((C >> 3) * ldb + Rb) * 16u : (unsigned)(Rb * ldb + C) * 2u; }
    const size_t kstep = (size_t)(BK * 2), kstepB = BGRAN ? (size_t)ldb * 128 : (size_t)(BK * 2);
    const size_t hstepA = (size_t)HALF * lda * 2, hstepB = BGRAN ? (size_t)2048 : (size_t)HALF * ldb * 2;
    const unsigned ldsw = (unsigned)wid * 1024u;
    const int aoff = lds_byte(wr * 64 + fr, fq * 8), boff = lds_byte(wc * 32 + fr, fq * 8);
#define PG8_SA(b, h) (((b) * 2 + (h)) * HTB)
#define PG8_SB(b, h) ((4 + (b) * 2 + (h)) * HTB)
#define PG8_STAGE(bufoff, gbase, voff) do { _Pragma("unroll") for (int _i = 0; _i < 2; ++_i) \
        __builtin_amdgcn_global_load_lds((const unsigned*)((const char*)(gbase) + (voff)[_i]), (LAS unsigned*)(lds + (bufoff) + ldsw + _i * 8192), 16, 0, 0); } while (0)
#define PG8_LDA(dst, b, h) do { _Pragma("unroll") for (int m = 0; m < 4; ++m) _Pragma("unroll") for (int k = 0; k < 2; ++k) dst[m][k] = *(const LAS bf16x8*)(lds + PG8_SA(b, h) + aoff + m * 2048 + k * 1024); } while (0)
#define PG8_LDB(dst, b, h) do { _Pragma("unroll") for (int n = 0; n < 2; ++n) _Pragma("unroll") for (int k = 0; k < 2; ++k) dst[n][k] = *(const LAS bf16x8*)(lds + PG8_SB(b, h) + boff + n * 2048 + k * 1024); } while (0)
#define PG8_MMA(ai, bj, At, Bt) do { __builtin_amdgcn_s_setprio(1); _Pragma("unroll") for (int m = 0; m < 4; ++m) _Pragma("unroll") for (int n = 0; n < 2; ++n) _Pragma("unroll") for (int k = 0; k < 2; ++k) \
        acc[ai][bj][m][n] = __builtin_amdgcn_mfma_f32_16x16x32_bf16(Bt[n][k], At[m][k], acc[ai][bj][m][n], 0, 0, 0); __builtin_amdgcn_s_setprio(0); } while (0)
#define PG8_WAIT_V(n) asm volatile("s_waitcnt vmcnt(" #n ")" ::: "memory")
#define PG8_WAIT_L(n) asm volatile("s_waitcnt lgkmcnt(" #n ")" ::: "memory")
#define PG8_BAR __builtin_amdgcn_s_barrier()
#define PG8_SCHED __builtin_amdgcn_sched_barrier(0)
    Unit cur, nxt; int ui = 0;
    if (!S.next(0, cur)) return;
    f32x4 acc[2][2][4][2];
#pragma unroll
    for (int a = 0; a < 2; ++a)
#pragma unroll
        for (int b = 0; b < 2; ++b)
#pragma unroll
            for (int m = 0; m < 4; ++m)
#pragma unroll
                for (int n = 0; n < 2; ++n) acc[a][b][m][n] = (f32x4){0.f, 0.f, 0.f, 0.f};
    bf16x8 At[4][2], B0[2][2], B1[2][2];
    const char* cA = cur.A; const char* cB = cur.B;
    PG8_STAGE(PG8_SB(0, 0), cB, voffB); PG8_STAGE(PG8_SB(0, 1), cB + hstepB, voffB); PG8_STAGE(PG8_SA(0, 0), cA, voffA); PG8_STAGE(PG8_SA(0, 1), cA + hstepA, voffA);
    if (wr == 1) PG8_BAR;
    PG8_WAIT_V(2); PG8_BAR;
    PG8_STAGE(PG8_SB(1, 0), cB + kstepB, voffB); PG8_STAGE(PG8_SA(1, 0), cA + kstep, voffA); PG8_STAGE(PG8_SB(1, 1), cB + hstepB + kstepB, voffB);
    PG8_WAIT_V(6); PG8_BAR;
    for (;;) {
        const bool has_next = S.next(ui + 1, nxt);
        const char* nA = has_next ? nxt.A : cA; const char* nB = has_next ? nxt.B : cB;
#pragma unroll 1
        for (int t = 0; t < nt; t += 2) {
            const bool last = (t == nt - 2);
            const char* a1 = cA + (size_t)(t + 1) * kstep;
            const char* a2 = last ? nA : cA + (size_t)(t + 2) * kstep; const char* b2 = last ? nB : cB + (size_t)(t + 2) * kstepB;
            const char* a3 = a2 + kstep; const char* b3 = b2 + kstepB;
            PG8_LDB(B0, 0, 0); PG8_LDB(B1, 0, 1); PG8_SCHED; PG8_LDA(At, 0, 0); PG8_STAGE(PG8_SA(1, 1), a1 + hstepA, voffA);
            PG8_WAIT_V(8); PG8_WAIT_L(0); PG8_BAR; PG8_MMA(0, 0, At, B0); PG8_MMA(0, 1, At, B1); PG8_BAR; PG8_SCHED;
            PG8_LDA(At, 0, 1); PG8_STAGE(PG8_SB(0, 0), b2, voffB); PG8_STAGE(PG8_SB(0, 1), b2 + hstepB, voffB); PG8_STAGE(PG8_SA(0, 0), a2, voffA);
            PG8_WAIT_V(8); PG8_WAIT_L(0); PG8_BAR; PG8_MMA(1, 0, At, B0); PG8_MMA(1, 1, At, B1); PG8_BAR; PG8_SCHED;
            PG8_LDB(B0, 1, 0); PG8_LDB(B1, 1, 1); PG8_SCHED; PG8_LDA(At, 1, 0); PG8_STAGE(PG8_SA(0, 1), a2 + hstepA, voffA);
            PG8_WAIT_V(8); PG8_WAIT_L(0); PG8_BAR; PG8_MMA(0, 0, At, B0); PG8_MMA(0, 1, At, B1); PG8_BAR; PG8_SCHED;
            PG8_LDA(At, 1, 1); PG8_STAGE(PG8_SB(1, 0), b3, voffB); PG8_STAGE(PG8_SB(1, 1), b3 + hstepB, voffB); PG8_STAGE(PG8_SA(1, 0), a3, voffA);
            PG8_WAIT_V(8); PG8_WAIT_L(0); PG8_BAR; PG8_MMA(1, 0, At, B0); PG8_MMA(1, 1, At, B1); PG8_BAR; PG8_SCHED;
        }
        if (wr == 0) PG8_BAR;
        { int fr_ = fr, fq_ = fq; asm volatile("" : "+v"(fr_), "+v"(fq_));
          E(acc, cur, wr, wc, fr_, fq_); }
        if (!has_next) break;
#pragma unroll
        for (int a = 0; a < 2; ++a)
#pragma unroll
            for (int b = 0; b < 2; ++b)
#pragma unroll
                for (int m = 0; m < 4; ++m)
#pragma unroll
                    for (int n = 0; n < 2; ++n) acc[a][b][m][n] = (f32x4){0.f, 0.f, 0.f, 0.f};
        cur = nxt; cA = nA; cB = nB; ++ui;
        if (wr == 1) PG8_BAR;
    }
    PG8_WAIT_V(0);
    PG8_BAR;
#undef PG8_SA
#undef PG8_SB
#undef PG8_STAGE
#undef PG8_LDA
#undef PG8_LDB
#undef PG8_MMA
#undef PG8_WAIT_V
#undef PG8_WAIT_L
#undef PG8_BAR
#undef PG8_SCHED
}

template <class Epi, class Sched>
__device__ __forceinline__ void gemm_phase8(LAS unsigned char* lds, const int K, const int lda, const int ldb, const Sched& S, const Epi& E) {
    const int tid = threadIdx.x, wid = __builtin_amdgcn_readfirstlane(tid >> 6), lane = tid & 63, wr = wid >> 2, wc = wid & 3, fr = lane & 15, fq = lane >> 4;
    int nt = K / 128; asm volatile("" : "+s"(nt));
    unsigned voffA[2], voffB[2];
#pragma unroll
    for (int i = 0; i < 2; ++i) { int R, C; stage_rc(tid * 16 + i * 8192, R, C); const int Rb = Epi::PERM ? ((R & ~31) + perm32(R & 31)) : R;
        voffA[i] = (unsigned)(R * lda + C * 2); voffB[i] = (unsigned)(Rb * ldb + C * 2); }
    const size_t kstep = 128, kstepB = 128;
    const size_t hstepA = (size_t)HALF * lda, hstepB = (size_t)HALF * ldb;
    const unsigned ldsw = (unsigned)wid * 1024u;
    const int aoff = lds_byte(wr * 64 + fr, fq * 8), boff = lds_byte(wc * 32 + fr, fq * 8);
#define PG8_SA(b, h) (((b) * 2 + (h)) * HTB)
#define PG8_SB(b, h) ((4 + (b) * 2 + (h)) * HTB)
#define PG8_STAGE(bufoff, gbase, voff) do { _Pragma("unroll") for (int _i = 0; _i < 2; ++_i) \
        __builtin_amdgcn_global_load_lds((const unsigned*)((const char*)(gbase) + (voff)[_i]), (LAS unsigned*)(lds + (bufoff) + ldsw + _i * 8192), 16, 0, 0); } while (0)
#define PG8_LDA(dst, b, h) do { _Pragma("unroll") for (int m = 0; m < 4; ++m) { dst[m][0] = *(const LAS u32x4*)(lds + PG8_SA(b, h) + aoff + m * 2048); dst[m][1] = *(const LAS u32x4*)(lds + PG8_SA(b, h) + aoff + m * 2048 + 1024); } } while (0)
#define PG8_LDB(dst, b, h) do { _Pragma("unroll") for (int n = 0; n < 2; ++n) { dst[n][0] = *(const LAS u32x4*)(lds + PG8_SB(b, h) + boff + n * 2048); dst[n][1] = *(const LAS u32x4*)(lds + PG8_SB(b, h) + boff + n * 2048 + 1024); } } while (0)
#define PG8_MMA(ai, bj, At, Bt) do { __builtin_amdgcn_s_setprio(1); _Pragma("unroll") for (int m = 0; m < 4; ++m) _Pragma("unroll") for (int n = 0; n < 2; ++n) { \
        const v8i b_ = __builtin_bit_cast(v8i, __builtin_shufflevector(Bt[n][0], Bt[n][1], 0, 1, 2, 3, 4, 5, 6, 7)), a_ = __builtin_bit_cast(v8i, __builtin_shufflevector(At[m][0], At[m][1], 0, 1, 2, 3, 4, 5, 6, 7)); \
        asm volatile("s_nop 1\n\tv_mfma_scale_f32_16x16x128_f8f6f4 %0, %1, %2, %0, %3, %4 op_sel_hi:[0,0,0]" : "+v"(acc[ai][bj][m][n]) : "v"(b_), "v"(a_), "v"(scw), "v"(scx)); } \
        __builtin_amdgcn_s_setprio(0); } while (0)
#define PG8_WAIT_V(n) asm volatile("s_waitcnt vmcnt(" #n ")" ::: "memory")
#define PG8_WAIT_L(n) asm volatile("s_waitcnt lgkmcnt(" #n ")" ::: "memory")
#define PG8_BAR __builtin_amdgcn_s_barrier()
#define PG8_SCHED __builtin_amdgcn_sched_barrier(0)
    Unit cur, nxt; int ui = 0;
    if (!S.next(0, cur)) return;
    f32x4 acc[2][2][4][2];
#pragma unroll
    for (int a = 0; a < 2; ++a)
#pragma unroll
        for (int b = 0; b < 2; ++b)
#pragma unroll
            for (int m = 0; m < 4; ++m)
#pragma unroll
                for (int n = 0; n < 2; ++n) acc[a][b][m][n] = (f32x4){0.f, 0.f, 0.f, 0.f};
    u32x4 At[4][2], B0[2][2], B1[2][2];
    int scw = 0x7a7a7a7a, scx = 0x7f7f7f7f; asm volatile("" : "+v"(scw), "+v"(scx));
    const char* cA = cur.A; const char* cB = cur.B;
    PG8_STAGE(PG8_SB(0, 0), cB, voffB); PG8_STAGE(PG8_SB(0, 1), cB + hstepB, voffB); PG8_STAGE(PG8_SA(0, 0), cA, voffA); PG8_STAGE(PG8_SA(0, 1), cA + hstepA, voffA);
    if (wr == 1) PG8_BAR;
    PG8_WAIT_V(2); PG8_BAR;
    PG8_STAGE(PG8_SB(1, 0), cB + kstepB, voffB); PG8_STAGE(PG8_SA(1, 0), cA + kstep, voffA); PG8_STAGE(PG8_SB(1, 1), cB + hstepB + kstepB, voffB);
    PG8_WAIT_V(6); PG8_BAR;
    for (;;) {
        const bool has_next = S.next(ui + 1, nxt);
        const char* nA = has_next ? nxt.A : cA; const char* nB = has_next ? nxt.B : cB;
#pragma unroll 1
        for (int t = 0; t < nt; t += 2) {
            const bool last = (t == nt - 2);
            const char* a1 = cA + (size_t)(t + 1) * kstep;
            const char* a2 = last ? nA : cA + (size_t)(t + 2) * kstep; const char* b2 = last ? nB : cB + (size_t)(t + 2) * kstepB;
            const char* a3 = a2 + kstep; const char* b3 = b2 + kstepB;
            PG8_LDB(B0, 0, 0); PG8_LDB(B1, 0, 1); PG8_SCHED; PG8_LDA(At, 0, 0); PG8_STAGE(PG8_SA(1, 1), a1 + hstepA, voffA);
            PG8_WAIT_V(8); PG8_WAIT_L(0); PG8_BAR; PG8_MMA(0, 0, At, B0); PG8_MMA(0, 1, At, B1); PG8_BAR; PG8_SCHED;
            PG8_LDA(At, 0, 1); PG8_STAGE(PG8_SB(0, 0), b2, voffB); PG8_STAGE(PG8_SB(0, 1), b2 + hstepB, voffB); PG8_STAGE(PG8_SA(0, 0), a2, voffA);
            PG8_WAIT_V(8); PG8_WAIT_L(0); PG8_BAR; PG8_MMA(1, 0, At, B0); PG8_MMA(1, 1, At, B1); PG8_BAR; PG8_SCHED;
            PG8_LDB(B0, 1, 0); PG8_LDB(B1, 1, 1); PG8_SCHED; PG8_LDA(At, 1, 0); PG8_STAGE(PG8_SA(0, 1), a2 + hstepA, voffA);
            PG8_WAIT_V(8); PG8_WAIT_L(0); PG8_BAR; PG8_MMA(0, 0, At, B0); PG8_MMA(0, 1, At, B1); PG8_BAR; PG8_SCHED;
            PG8_LDA(At, 1, 1); PG8_STAGE(PG8_SB(1, 0), b3, voffB); PG8_STAGE(PG8_SB(1, 1), b3 + hstepB, voffB); PG8_STAGE(PG8_SA(1, 0), a3, voffA);
            PG8_WAIT_V(8); PG8_WAIT_L(0); PG8_BAR; PG8_MMA(1, 0, At, B0); PG8_MMA(1, 1, At, B1); PG8_BAR; PG8_SCHED;
        }
        if (wr == 0) PG8_BAR;
        asm volatile("s_nop 15\n\ts_nop 7" ::: "memory");
        { int fr_ = fr, fq_ = fq; asm volatile("" : "+v"(fr_), "+v"(fq_));
          E(acc, cur, wr, wc, fr_, fq_); }
        if (!has_next) break;
#pragma unroll
        for (int a = 0; a < 2; ++a)
#pragma unroll
            for (int b = 0; b < 2; ++b)
#pragma unroll
                for (int m = 0; m < 4; ++m)
#pragma unroll
                    for (int n = 0; n < 2; ++n) acc[a][b][m][n] = (f32x4){0.f, 0.f, 0.f, 0.f};
        cur = nxt; cA = nA; cB = nB; ++ui;
        if (wr == 1) PG8_BAR;
    }
    PG8_WAIT_V(0);
    PG8_BAR;
#undef PG8_SA
#undef PG8_SB
#undef PG8_STAGE
#undef PG8_LDA
#undef PG8_LDB
#undef PG8_MMA
#undef PG8_WAIT_V
#undef PG8_WAIT_L
#undef PG8_BAR
#undef PG8_SCHED
}

struct EpiProj {
    static constexpr bool PERM = true;
    unsigned char* ws; const float* bbg;
    __device__ __forceinline__ void operator()(const f32x4 (&acc)[2][2][4][2], const Unit& u, int wr, int wc, int fr, int fq) const {
        const int pn = u.pn; size_t off; int ld, t0, act = 0;
        if (pn < 4) { off = WS_GQ; ld = 1024; t0 = 0; } else if (pn < 8) { off = WS_GK; ld = 1024; t0 = 4; } else if (pn < 16) { off = WS_GV; ld = 2048; t0 = 8; }
        else if (pn < 24) { off = WS_GR; ld = 2048; t0 = 16; act = 1; } else if (pn < 28) { off = WS_AQ; ld = 1024; t0 = 24; } else if (pn < 32) { off = WS_AK; ld = 1024; t0 = 28; }
        else if (pn < 36) { off = WS_AV; ld = 1024; t0 = 32; } else if (pn < 44) { off = WS_SG; ld = 2048; t0 = 36; act = 2; } else { off = WS_SA; ld = 2048; t0 = 44; act = 3; }
        bf16* base = (bf16*)(ws + off);
        const int colt = (pn - t0) * BM + wc * 32 + 8 * fq, row0 = u.pm * BM + wr * 64 + fr;
        f32x4 bv[2][2];
#pragma unroll
        for (int bj = 0; bj < 2; ++bj)
#pragma unroll
            for (int n = 0; n < 2; ++n) bv[bj][n] = act >= 2 ? *(const f32x4*)(bbg + (act - 2) * D + colt + bj * HALF + 4 * n) : (f32x4){0.f, 0.f, 0.f, 0.f};
#pragma unroll
        for (int ai = 0; ai < 2; ++ai)
#pragma unroll
            for (int m = 0; m < 4; ++m) { bf16* rowp = base + (size_t)(row0 + ai * HALF + m * 16) * ld + colt;
#pragma unroll
                for (int bj = 0; bj < 2; ++bj) { f32x4 v0 = acc[ai][bj][m][0] + bv[bj][0], v1 = acc[ai][bj][m][1] + bv[bj][1];
                    if (act == 1) {
#pragma unroll
                        for (int j = 0; j < 4; ++j) { v0[j] = v0[j] * sigmoidf_(v0[j]); v1[j] = v1[j] * sigmoidf_(v1[j]); } }
                    else if (act >= 2) {
#pragma unroll
                        for (int j = 0; j < 4; ++j) { v0[j] = sigmoidf_(v0[j]); v1[j] = sigmoidf_(v1[j]); } }
                    u32x4 w; w.x = cvt_pk_bf16(v0[0], v0[1]); w.y = cvt_pk_bf16(v0[2], v0[3]); w.z = cvt_pk_bf16(v1[0], v1[1]); w.w = cvt_pk_bf16(v1[2], v1[3]);
                    *(u32x4*)(rowp + bj * HALF) = w; } }
    }
};
template <int MODE> struct EpiBranch {
    static constexpr bool PERM = true;
    const bf16* gate; const bf16* tin; bf16* out;
    __device__ __forceinline__ void operator()(const f32x4 (&acc)[2][2][4][2], const Unit& u, int wr, int wc, int fr, int fq) const {
        const int colt = u.pn * BM + wc * 32 + 8 * fq, row0 = u.pm * BM + wr * 64 + fr;
#pragma unroll
        for (int ai = 0; ai < 2; ++ai)
#pragma unroll
            for (int m = 0; m < 4; ++m) { const size_t ro = (size_t)(row0 + ai * HALF + m * 16) * D + colt;
#pragma unroll
                for (int bj = 0; bj < 2; ++bj) {
                    const u32x4 gq = *(const u32x4*)(gate + ro + bj * HALF);
                    u32x4 tq = (u32x4){0u, 0u, 0u, 0u}; if (MODE == 1) tq = *(const u32x4*)(tin + ro + bj * HALF);
                    float r[8];
#pragma unroll
                    for (int j = 0; j < 4; ++j) { r[j] = acc[ai][bj][m][0][j]; r[4 + j] = acc[ai][bj][m][1][j]; }
#pragma unroll
                    for (int j = 0; j < 4; ++j) { const unsigned gw = gq[j], tw = tq[j];
                        r[2 * j] = r[2 * j] * __uint_as_float(gw << 16) + __uint_as_float(tw << 16);
                        r[2 * j + 1] = r[2 * j + 1] * __uint_as_float(gw & 0xffff0000u) + __uint_as_float(tw & 0xffff0000u); }
                    u32x4 w; w.x = cvt_pk_bf16(r[0], r[1]); w.y = cvt_pk_bf16(r[2], r[3]); w.z = cvt_pk_bf16(r[4], r[5]); w.w = cvt_pk_bf16(r[6], r[7]);
                    *(u32x4*)(out + ro + bj * HALF) = w; } }
    }
};
struct EpiResid {
    static constexpr bool PERM = false;
    const float* x; float* out;
    __device__ __forceinline__ void operator()(const f32x4 (&acc)[2][2][4][2], const Unit& u, int wr, int wc, int fr, int fq) const {
        const int col0 = u.pn * BM + wc * 32 + 4 * fq, row0 = u.pm * BM + wr * 64 + fr;
#pragma unroll
        for (int ai = 0; ai < 2; ++ai)
#pragma unroll
            for (int m = 0; m < 4; ++m) { const size_t ro = (size_t)(row0 + ai * HALF + m * 16) * D + col0;
#pragma unroll
                for (int bj = 0; bj < 2; ++bj)
#pragma unroll
                    for (int n = 0; n < 2; ++n) { const f32x4 xv = *(const f32x4*)(x + ro + bj * HALF + n * 16); *(f32x4*)(out + ro + bj * HALF + n * 16) = xv + acc[ai][bj][m][n]; } }
    }
};
struct EpiSwiglu {
    static constexpr bool PERM = true;
    const float* bgate; const float* bup; unsigned char* hd;
    __device__ __forceinline__ void operator()(const f32x4 (&acc)[2][2][4][2], const Unit& u, int wr, int wc, int fr, int fq) const {
        const int col = u.pn * HALF + wc * 32 + 8 * fq; const size_t row0 = (size_t)u.pm * BM + wr * 64 + fr;
        const float* bg = bgate + (size_t)u.e * DFF + col; const float* bu = bup + (size_t)u.e * DFF + col;
        const f32x4 g0 = *(const f32x4*)bg, g1 = *(const f32x4*)(bg + 4), u0 = *(const f32x4*)bu, u1 = *(const f32x4*)(bu + 4);
#pragma unroll
        for (int ai = 0; ai < 2; ++ai)
#pragma unroll
            for (int m = 0; m < 4; ++m) {
                float r[8];
#pragma unroll
                for (int j = 0; j < 4; ++j) {
                    const float ga = fminf(acc[ai][0][m][0][j] + g0[j], 7.f), ua = fminf(fmaxf(acc[ai][1][m][0][j] + u0[j], -7.f), 7.f);
                    const float gb = fminf(acc[ai][0][m][1][j] + g1[j], 7.f), ub = fminf(fmaxf(acc[ai][1][m][1][j] + u1[j], -7.f), 7.f);
                    r[j] = (ua + 1.f) * (ga * sigmoidf_(1.702f * ga)); r[4 + j] = (ub + 1.f) * (gb * sigmoidf_(1.702f * gb)); }
                int w0 = 0, w1 = 0;
                w0 = __builtin_amdgcn_cvt_pk_fp8_f32(r[0], r[1], w0, false); w0 = __builtin_amdgcn_cvt_pk_fp8_f32(r[2], r[3], w0, true);
                w1 = __builtin_amdgcn_cvt_pk_fp8_f32(r[4], r[5], w1, false); w1 = __builtin_amdgcn_cvt_pk_fp8_f32(r[6], r[7], w1, true);
                *(u32x2*)(hd + (row0 + ai * HALF + m * 16) * DFF + col) = (u32x2){(unsigned)w0, (unsigned)w1}; }
    }
};
struct EpiDown {
    static constexpr bool PERM = true;
    const float* bdown; const int* rpair; const float* rw; bf16* py;
    __device__ __forceinline__ void operator()(const f32x4 (&acc)[2][2][4][2], const Unit& u, int wr, int wc, int fr, int fq) const {
        const int colt = u.pn * BM + wc * 32 + 8 * fq; const size_t srow0 = (size_t)u.pm * BM + wr * 64 + fr;
        f32x4 bv[2][2];
#pragma unroll
        for (int bj = 0; bj < 2; ++bj)
#pragma unroll
            for (int n = 0; n < 2; ++n) bv[bj][n] = *(const f32x4*)(bdown + (size_t)u.e * D + colt + bj * HALF + 4 * n);
#pragma unroll
        for (int ai = 0; ai < 2; ++ai)
#pragma unroll
            for (int m = 0; m < 4; ++m) { const size_t srow = srow0 + ai * HALF + m * 16; const int pair = rpair[srow]; const float wgt = rw[srow];
                bf16* rowp = py + (size_t)pair * D + colt;
#pragma unroll
                for (int bj = 0; bj < 2; ++bj) { const f32x4 v0 = (acc[ai][bj][m][0] + bv[bj][0]) * wgt, v1 = (acc[ai][bj][m][1] + bv[bj][1]) * wgt;
                    u32x4 w; w.x = cvt_pk_bf16(v0[0], v0[1]); w.y = cvt_pk_bf16(v0[2], v0[3]); w.z = cvt_pk_bf16(v1[0], v1[1]); w.w = cvt_pk_bf16(v1[2], v1[3]);
                    *(u32x4*)(rowp + bj * HALF) = w; } }
    }
};

struct GlaSched {
    int mode, G, c; unsigned char* ws;
    __device__ __forceinline__ bool next(int i, Unit& u) const {
        const int L = i * G + c; const int nu = mode == 0 ? 128 : 256; if (L >= nu) return false;
        const int nh = mode == 0 ? L : (L >> 1), hv = mode == 0 ? 0 : (L & 1);
        u.pm = nh; u.pn = hv; u.e = 0; u.nrow = BM;
        if (mode == 0) { u.A = (const char*)(ws + WS_ACAT) + (size_t)nh * 256 * 512 * 2 + 512; u.B = (const char*)(ws + WS_KI) + (size_t)nh * 256 * 256 * 2; }
        else if (mode == 1) { u.A = (const char*)(ws + WS_BCAT) + (size_t)nh * 512 * 512 * 2 + (size_t)hv * 256 * 512 * 2; u.B = (const char*)(ws + WS_KET) + (size_t)nh * 256 * 256 * 2; }
        else { u.A = (const char*)(ws + WS_ACAT) + (size_t)nh * 256 * 512 * 2; u.B = (const char*)(ws + WS_BCAT) + (size_t)nh * 512 * 512 * 2 + (size_t)hv * 256 * 512 * 2; }
        return true;
    }
};
template <int MODE> struct EpiGla {
    static constexpr bool PERM = true;
    unsigned char* ws;
    __device__ __forceinline__ void operator()(const f32x4 (&acc)[2][2][4][2], const Unit& u, int wr, int wc, int fr, int fq) const {
        const int nh = u.pm, hv = u.pn; const int c8 = wc * 32 + 8 * fq, r0 = wr * 64 + fr;
        bf16* base; int ld;
        if (MODE == 0) { base = (bf16*)(ws + WS_ACAT) + (size_t)nh * 256 * 512; ld = 512; }
        else if (MODE == 1) { base = (bf16*)(ws + WS_UT) + (size_t)nh * 512 * 256 + (size_t)hv * 256 * 256; ld = 256; }
        else { base = (bf16*)(ws + WS_OB) + (size_t)(nh >> 2) * 256 * GLA_V + (nh & 3) * GLA_DV + hv * 256; ld = GLA_V; }
#pragma unroll
        for (int ai = 0; ai < 2; ++ai)
#pragma unroll
            for (int m = 0; m < 4; ++m) { const int row = r0 + ai * HALF + m * 16;
#pragma unroll
                for (int bj = 0; bj < 2; ++bj) { f32x4 v0 = acc[ai][bj][m][0], v1 = acc[ai][bj][m][1]; const int col = bj * HALF + c8;
                    if (MODE == 0) {
#pragma unroll
                        for (int j = 0; j < 4; ++j) { v0[j] = (col + j <= row) ? v0[j] : 0.f; v1[j] = (col + 4 + j <= row) ? v1[j] : 0.f; } }
                    u32x4 w; w.x = cvt_pk_bf16(v0[0], v0[1]); w.y = cvt_pk_bf16(v0[2], v0[3]); w.z = cvt_pk_bf16(v1[0], v1[1]); w.w = cvt_pk_bf16(v1[2], v1[3]);
                    *(u32x4*)(base + (size_t)row * ld + col) = w; } }
    }
};
}

constexpr int NWAVES = 8;
#ifndef GEMM_CUS
#define GEMM_CUS 152
#endif
constexpr int RING_BYTES = 131072, CTLZ_OFF = 139264, MISC_OFF = CTLZ_OFF + 320, LDS_BYTES = 147456;
constexpr int TAB_OFF = MISC_OFF + 128;

struct Frame {
    LAS unsigned char* lds; volatile LAS unsigned* MISC; unsigned* ctl; unsigned char* ws;
    int tid, lane, wave, vcu, G;
};
struct Args { const float* in[22]; float* out; unsigned char* ws; int ph_lo, ph_hi, li, pad; };

struct P0Item { const float* src; bf16* dst; int ldn, K; };
constexpr int P0_I_IN = 32 * (NPROJ / 32), P0_I_BG = 32 * 64, P0_I_BA = 16 * 64, P0_I_OUT = 32 * 64, P0_I_E = 32 * 64;
constexpr int P0_I_SMALL = P0_I_IN + P0_I_BG + P0_I_BA + P0_I_OUT, P0_NITEMS = P0_I_SMALL;
__device__ __forceinline__ P0Item p0_decode(Frame& F, const Args& a, int r) {
    constexpr int I_IN = P0_I_IN, I_BG = P0_I_BG, I_BA = P0_I_BA;
    P0Item it;
    if (r < I_IN) { const int nb = r % (NPROJ / 32), kb = r / (NPROJ / 32), d0 = nb * 32, s0 = d0 < C_GLR ? d0 : d0 + 16;
        it.src = a.in[2] + (size_t)kb * 64 * IN_COLS + s0; it.ldn = IN_COLS; it.dst = (bf16*)(F.ws + WS_WIN) + (size_t)d0 * D + kb * 64; it.K = D; return it; } r -= I_IN;
    if (r < I_BG) { const int nb = r % 64, kb = r / 64; it.src = a.in[10] + (size_t)kb * 64 * D + nb * 32; it.ldn = D; it.dst = (bf16*)(F.ws + WS_WBG) + (size_t)nb * 32 * GLA_V + kb * 64; it.K = GLA_V; return it; } r -= I_BG;
    if (r < I_BA) { const int nb = r % 64, kb = r / 64; it.src = a.in[11] + (size_t)kb * 64 * D + nb * 32; it.ldn = D; it.dst = (bf16*)(F.ws + WS_WBA) + (size_t)nb * 32 * ATT_W + kb * 64; it.K = ATT_W; return it; } r -= I_BA;
    { const int nb = r % 64, kb = r / 64; it.src = a.in[12] + (size_t)kb * 64 * D + nb * 32; it.ldn = D; it.dst = (bf16*)(F.ws + WS_WOUT) + (size_t)nb * 32 * D + kb * 64; it.K = D; }
    return it;
}
__device__ __forceinline__ void p0_load(const P0Item& it, int lane, f32x4 (&v)[8]) {
    const float* p = it.src + (size_t)(lane >> 3) * it.ldn + 4 * (lane & 7);
#pragma unroll
    for (int i = 0; i < 8; ++i) v[i] = __builtin_nontemporal_load((const GAS f32x4*)(p + (size_t)(8 * i) * it.ldn));
}
__device__ __forceinline__ void p0_convert(Frame& F, const Args& a, int it_lo, int it_hi, int gw, int NGW) {
    LAS float* scr = (LAS float*)(F.lds + F.wave * 16384);
    const int lane = F.lane;
    int itx = it_lo + gw;
    if (itx >= it_hi) return;
    P0Item cur = p0_decode(F, a, itx);
    f32x4 v[8]; p0_load(cur, lane, v);
    for (;;) {
        const int nx = itx + NGW; const bool more = nx < it_hi;
        P0Item nxt = cur; f32x4 vn[8];
        if (more) { nxt = p0_decode(F, a, nx); p0_load(nxt, lane, vn); }
#pragma unroll
        for (int i = 0; i < 8; ++i) { LAS float* q = scr + (8 * i + (lane >> 3)) * 33 + 4 * (lane & 7); q[0] = v[i].x; q[1] = v[i].y; q[2] = v[i].z; q[3] = v[i].w; }
        LDS_WAIT(); asm volatile("" ::: "memory");
        const int c = lane & 7;
#pragma unroll
        for (int j = 0; j < 4; ++j) { const int n = (lane >> 3) + 8 * j; const LAS float* sp = scr + (8 * c) * 33 + n;
            u32x4 o; o.x = pk2(sp[0 * 33], sp[1 * 33]); o.y = pk2(sp[2 * 33], sp[3 * 33]); o.z = pk2(sp[4 * 33], sp[5 * 33]); o.w = pk2(sp[6 * 33], sp[7 * 33]);
            __builtin_nontemporal_store(o, (GAS u32x4*)(cur.dst + (size_t)n * cur.K + 8 * c)); }
        LDS_WAIT(); asm volatile("" ::: "memory");
        if (!more) break;
        itx = nx; cur = nxt;
#pragma unroll
        for (int i = 0; i < 8; ++i) v[i] = vn[i];
    }
}
constexpr int P8_NITEMS = 3 * NE * 16 * 64;
__device__ __forceinline__ void p0_convert8(Frame& F, const Args& a, int gw, int NGW) {
    LAS unsigned char* tile = F.lds + F.wave * 16384;
    const int lane = F.lane, kq = lane >> 3, n4 = lane & 7;
    for (int it = gw; it < P8_NITEMS; it += NGW) {
        const int which = it / (NE * 1024), e = (it >> 10) & 31, kb = (it >> 6) & 15, nb = it & 63, k0 = kb * 128, n0 = nb * 32;
        const float* src; unsigned char* dst; int ldn;
        if (which < 2) { src = (which ? a.in[18] : a.in[16]) + (size_t)e * D * DFF + (size_t)k0 * DFF + n0; ldn = DFF;
            dst = F.ws + WS_GU + (size_t)e * 2 * DFF * D + (size_t)((n0 >> 7) * 256 + (n0 & 127) + which * 128) * D + k0; }
        else { src = a.in[20] + (size_t)e * DFF * D + (size_t)k0 * D + n0; ldn = D; dst = F.ws + WS_DN + (size_t)e * D * DFF + (size_t)n0 * DFF + k0; }
        const float* p = src + (size_t)(4 * kq) * ldn + 4 * n4;
        f32x4 v[4][4];
#pragma unroll
        for (int ps = 0; ps < 4; ++ps)
#pragma unroll
            for (int i = 0; i < 4; ++i) v[ps][i] = __builtin_nontemporal_load((const GAS f32x4*)(p + (size_t)(32 * ps + i) * ldn));
#pragma unroll
        for (int ps = 0; ps < 4; ++ps)
#pragma unroll
            for (int c = 0; c < 4; ++c) { int w = 0;
                w = __builtin_amdgcn_cvt_pk_fp8_f32(v[ps][0][c] * 32.f, v[ps][1][c] * 32.f, w, false); w = __builtin_amdgcn_cvt_pk_fp8_f32(v[ps][2][c] * 32.f, v[ps][3][c] * 32.f, w, true);
                *(LAS int*)(tile + (4 * n4 + c) * 144 + 32 * ps + 4 * kq) = w; }
        LDS_WAIT(); asm volatile("" ::: "memory");
#pragma unroll
        for (int j = 0; j < 4; ++j) { const int n = (lane >> 3) + 8 * j, c16 = lane & 7; const u32x4 g = *(const LAS u32x4*)(tile + n * 144 + 16 * c16);
            __builtin_nontemporal_store(g, (GAS u32x4*)(dst + (size_t)n * 2048 + 16 * c16)); }
        LDS_WAIT(); asm volatile("" ::: "memory");
    }
}
__device__ __forceinline__ void p0_rows(Frame& F, const Args& a) {
    { const float* g2 = a.in[13]; const float* wr = a.in[14]; float* WR = (float*)(F.ws + WS_WR);
      for (int i = (F.vcu * NWAVES * 64) + F.tid; i < D * NE; i += F.G * NWAVES * 64) WR[i] = g2[i >> 5] * wr[i]; }
}

template <int MODE> __device__ __forceinline__ void normproj_unit(Frame& F, const Args& a, int tile) {
    const int w = F.wave, lane = F.lane, tid = F.tid, i = lane & 31, kk = lane >> 5, t0 = tile * 32;
    const float* X = MODE == 0 ? a.in[0] : (const float*)(F.ws + WS_H1); const float* g = MODE == 0 ? a.in[1] : a.in[13];
    const float* WR = (const float*)(F.ws + WS_WR); const float* br = a.in[15]; const float* w_in = a.in[2];
    LAS float* part = (LAS float*)F.lds;
    LAS float* ssq = part + 8192;
    LAS float* lg = ssq + 256;
    LAS float* rs = lg + 32 * 33;
    LAS unsigned* lcnt = (LAS unsigned*)(rs + 32); LAS unsigned* lbase = lcnt + 32; LAS unsigned* prec = lbase + 32;
    if (MODE == 1 && tid < NE) lcnt[tid] = 0u;
    f32x16 acc;
#pragma unroll
    for (int r = 0; r < 16; ++r) acc[r] = 0.f;
    float ss = 0.f;
    const int kbase = 256 * w + 128 * kk;
    const float* arow = X + (size_t)(t0 + i) * D + kbase;
    const float* bcol = MODE == 0 ? (w_in + (size_t)kbase * IN_COLS + C_GLR + (i & 15)) : (WR + (size_t)kbase * NE + i);
    const size_t bstr = MODE == 0 ? IN_COLS : NE;
#pragma unroll 1
    for (int c = 0; c < 4; ++c) {
        f32x4 av[8];
#pragma unroll
        for (int q = 0; q < 8; ++q) av[q] = *(const GAS f32x4*)(arow + 32 * c + 4 * q);
#pragma unroll
        for (int q = 0; q < 8; ++q)
#pragma unroll
            for (int j = 0; j < 4; ++j) { const int kq = 32 * c + 4 * q + j; float b = bcol[(size_t)kq * bstr];
                if (MODE == 0) b = (i < 16) ? b * g[kbase + kq] : 0.f;
                acc = __builtin_amdgcn_mfma_f32_32x32x2f32(av[q][j], b, acc, 0, 0, 0); ss = fmaf(av[q][j], av[q][j], ss); }
    }
    ss += __shfl_xor(ss, 32);
    if (kk == 0) ssq[w * 32 + i] = ss;
#pragma unroll
    for (int r = 0; r < 16; ++r) part[(w * 32 + (r & 3) + 8 * (r >> 2) + 4 * kk) * 32 + i] = acc[r];
    __syncthreads();
#pragma unroll
    for (int rep = 0; rep < 2; ++rep) { const int idx = tid + 512 * rep, tok = idx >> 5, e = idx & 31; float sum = 0.f, st = 0.f;
#pragma unroll
        for (int ww = 0; ww < 8; ++ww) { sum += part[(ww * 32 + tok) * 32 + e]; st += ssq[ww * 32 + tok]; }
        const float rstd = rsqrtf(st * (1.f / D) + 1e-6f);
        if (MODE == 0) { if (e < 16) ((float*)(F.ws + WS_GLR))[(size_t)(t0 + tok) * 16 + e] = sum * rstd; }
        else lg[tok * 33 + e] = sum * rstd + br[e];
        if (e == 0) rs[tok] = rstd; }
    __syncthreads();
    bf16* HN = (bf16*)(F.ws + (MODE == 0 ? WS_XN : WS_HN)); float* topw = (float*)(F.ws + WS_TOPW); int* tope = (int*)(F.ws + WS_TOPE); int* tops = (int*)(F.ws + WS_TOPS);
    unsigned* cnt = F.ctl + CW_CNT;
#pragma unroll 1
    for (int q = 0; q < 4; ++q) {
        const int tok = 4 * w + q, t = t0 + tok, e = lane & 31;
        const float rstd = rs[tok];
        {
            const GAS f32x4* x4 = (const GAS f32x4*)(X + (size_t)t * D) + lane; GAS u32x2* o8 = (GAS u32x2*)(HN + (size_t)t * D) + lane;
#pragma unroll
            for (int j = 0; j < 8; ++j) { const f32x4 gg = *((const GAS f32x4*)g + lane + 64 * j); const f32x4 y = x4[64 * j] * rstd * gg;
                if (MODE == 0) { u32x2 wv; wv.x = pk2(y.x, y.y); wv.y = pk2(y.z, y.w); o8[64 * j] = wv; }
                else { int w8 = 0; w8 = __builtin_amdgcn_cvt_pk_fp8_f32(y.x, y.y, w8, false); w8 = __builtin_amdgcn_cvt_pk_fp8_f32(y.z, y.w, w8, true); ((GAS int*)((unsigned char*)HN + (size_t)t * D))[lane + 64 * j] = w8; } }
        }
        if (MODE == 1) {
        float vals[4]; int idxs[4]; float cur = lg[tok * 33 + e];
#pragma unroll
        for (int r = 0; r < 4; ++r) {
            float bv = cur; int bi = e;
#pragma unroll
            for (int o = 1; o < 32; o <<= 1) { const float ov = __shfl_xor(bv, o); const int oi = __shfl_xor(bi, o); if (ov > bv || (ov == bv && oi < bi)) { bv = ov; bi = oi; } }
            vals[r] = bv; idxs[r] = bi;
            if (e == bi) cur = -3.0e38f;
        }
        float ex[4], sum = 0.f;
#pragma unroll
        for (int r = 0; r < 4; ++r) { ex[r] = __expf(vals[r] - vals[0]); sum += ex[r]; }
#pragma unroll
        for (int r = 0; r < 4; ++r) {
            if (lane == r) { const int ee = idxs[r]; const unsigned lr = __hip_atomic_fetch_add(&lcnt[ee], 1u, __ATOMIC_RELAXED, __HIP_MEMORY_SCOPE_WORKGROUP);
                topw[t * 4 + r] = ex[r] / sum; tope[t * 4 + r] = ee; prec[tok * 4 + r] = (ee << 16) | lr; }
        }
        }
    }
    if (MODE == 1) {
        __syncthreads();
        if (tid < NE) { const unsigned c = lcnt[tid]; lbase[tid] = c ? atomicAdd(&cnt[64 * tid], c) : 0u; }
        __syncthreads();
        if (tid < 128) { const unsigned pr = prec[tid]; tops[(t0 * 4) + tid] = (int)(lbase[pr >> 16] + (pr & 0xffffu)); }
        __syncthreads();
        if (tid < NE) lcnt[tid] = 0u;
    }
    __syncthreads();
}
__device__ __forceinline__ void moe_table(Frame& F) {
    volatile LAS int* ts = (volatile LAS int*)(F.lds + TAB_OFF); volatile LAS int* cn = (volatile LAS int*)(F.lds + TAB_OFF + 256);
    __syncthreads();
    if (F.tid == 0) { int s = 0; for (int e = 0; e < NE; ++e) { const int c = (int)__hip_atomic_load(F.ctl + CW_CNT + 64 * e, __ATOMIC_RELAXED, __HIP_MEMORY_SCOPE_AGENT); cn[e] = c; ts[e] = s; s += (c + 255) >> 8; } ts[NE] = s; }
    __syncthreads();
}
__device__ __forceinline__ void p7_gather(Frame& F) {
    const int gw = F.vcu * NWAVES + F.wave, NGW = F.G * NWAVES, lane = F.lane;
    volatile LAS int* ts = (volatile LAS int*)(F.lds + TAB_OFF);
    const bf16* HN = (const bf16*)(F.ws + WS_HN); bf16* HNG = (bf16*)(F.ws + WS_HNG);
    const float* topw = (const float*)(F.ws + WS_TOPW); const int* tope = (const int*)(F.ws + WS_TOPE); const int* tops = (const int*)(F.ws + WS_TOPS);
    int* rpair = (int*)(F.ws + WS_RPAIR); float* rw = (float*)(F.ws + WS_RW);
    { volatile LAS int* cn = (volatile LAS int*)(F.lds + TAB_OFF + 256);
      for (int e = gw; e < NE; e += NGW) { const int c = cn[e], base = ts[e] * 256, padn = ((c + 255) & ~255) - c;
          for (int r = lane; r < padn; r += 64) { rpair[base + c + r] = S * 4; rw[base + c + r] = 0.f; } } }
    for (int t = gw; t < S; t += NGW) {
        const GAS u32x4* src = (const GAS u32x4*)((const unsigned char*)HN + (size_t)t * D) + lane; u32x4 v[2];
#pragma unroll
        for (int j = 0; j < 2; ++j) v[j] = src[64 * j];
#pragma unroll
        for (int r = 0; r < 4; ++r) { const int p = t * 4 + r; const int dst = ts[tope[p]] * 256 + tops[p];
            GAS u32x4* d = (GAS u32x4*)((unsigned char*)HNG + (size_t)dst * D) + lane;
#pragma unroll
            for (int j = 0; j < 2; ++j) d[64 * j] = v[j];
            if (lane == 0) { rpair[dst] = p; rw[dst] = topw[p]; } }
    }
}
__device__ __forceinline__ void p10_combine(Frame& F, const Args& a) {
    const int gw = F.vcu * NWAVES + F.wave, NGW = F.G * NWAVES, lane = F.lane;
    const bf16* PY = (const bf16*)(F.ws + WS_PY); float* out = a.out; const float* H1 = (const float*)(F.ws + WS_H1);
    for (int t = gw; t < S; t += NGW) {
#pragma unroll
        for (int j = 0; j < 4; ++j) {
            float r[8]; { const f32x4 h0 = *(const GAS f32x4*)(H1 + (size_t)t * D + 512 * j + 8 * lane), h1v = *(const GAS f32x4*)(H1 + (size_t)t * D + 512 * j + 8 * lane + 4);
                r[0] = h0.x; r[1] = h0.y; r[2] = h0.z; r[3] = h0.w; r[4] = h1v.x; r[5] = h1v.y; r[6] = h1v.z; r[7] = h1v.w; }
#pragma unroll
            for (int k = 0; k < 4; ++k) { const u32x4 p = *(const GAS u32x4*)(PY + (size_t)(t * 4 + k) * D + 512 * j + 8 * lane);
#pragma unroll
                for (int q = 0; q < 4; ++q) { r[2 * q] += __uint_as_float(p[q] << 16); r[2 * q + 1] += __uint_as_float(p[q] & 0xffff0000u); } }
            *(GAS f32x4*)(out + (size_t)t * D + 512 * j + 8 * lane) = (f32x4){r[0], r[1], r[2], r[3]};
            *(GAS f32x4*)(out + (size_t)t * D + 512 * j + 8 * lane + 4) = (f32x4){r[4], r[5], r[6], r[7]};
        }
    }
}


constexpr float ATT_QSCALE = 0.08838834764831845f * 1.4426950408889634f;
__device__ __forceinline__ void attn_prep_unit(Frame& F, const Args& a, int n, int h) {
    const int wave = F.wave, lane = F.lane, tid = F.tid;
    LAS bf16* kst = (LAS bf16*)(F.lds);
    LAS bf16* vst = (LAS bf16*)(F.lds + 16384);
    const bf16* AQ = (const bf16*)(F.ws + WS_AQ); const bf16* AK = (const bf16*)(F.ws + WS_AK); const bf16* AV = (const bf16*)(F.ws + WS_AV);
    bf16* QH = (bf16*)(F.ws + WS_QH);
    const float* qg = a.in[6]; const float* kg = a.in[7];
    const float gq0 = qg[2 * lane], gq1 = qg[2 * lane + 1], gk0 = kg[2 * lane], gk1 = kg[2 * lane + 1];
#pragma unroll
    for (int i = 0; i < 8; ++i) {
        const int row = n * 64 + wave * 8 + i; const size_t off = (size_t)row * ATT_W + h * ATT_HD + 2 * lane;
        const unsigned qv = *(const unsigned*)(AQ + off), kv = *(const unsigned*)(AK + off), vv = *(const unsigned*)(AV + off);
        const float q0 = __uint_as_float(qv << 16), q1 = __uint_as_float(qv & 0xffff0000u), k0 = __uint_as_float(kv << 16), k1 = __uint_as_float(kv & 0xffff0000u);
        const float rq = rsqrtf(wave_sum(q0 * q0 + q1 * q1) * (1.f / 128.f) + 1e-6f) * ATT_QSCALE, rk = rsqrtf(wave_sum(k0 * k0 + k1 * k1) * (1.f / 128.f) + 1e-6f);
        *(unsigned*)(QH + off) = pk2(q0 * rq * gq0, q1 * rq * gq1);
        *(LAS unsigned*)(kst + (wave * 8 + i) * 128 + 2 * lane) = pk2(k0 * rk * gk0, k1 * rk * gk1);
        *(LAS unsigned*)(vst + (wave * 8 + i) * 128 + 2 * lane) = vv;
    }
    __syncthreads();
    bf16* KI = (bf16*)(F.ws + WS_KIMG) + (size_t)(n * ATT_H + h) * 8192; bf16* VI = (bf16*)(F.ws + WS_VIMG) + (size_t)(n * ATT_H + h) * 8192;
#pragma unroll
    for (int i = 0; i < 2; ++i) {
        const int g = tid + 512 * i;
        { const int c16 = g >> 6, key = g & 63; const u32x4 v = *(const LAS u32x4*)(kst + key * 128 + c16 * 8); *(u32x4*)(KI + (size_t)g * 8) = v; }
        { const int kg8 = g >> 7, d = g & 127; unsigned short e[8];
#pragma unroll
          for (int j = 0; j < 8; ++j) e[j] = vst[(kg8 * 8 + j) * 128 + d];
          u32x4 v; v.x = e[0] | ((unsigned)e[1] << 16); v.y = e[2] | ((unsigned)e[3] << 16); v.z = e[4] | ((unsigned)e[5] << 16); v.w = e[6] | ((unsigned)e[7] << 16);
          *(u32x4*)(VI + (size_t)g * 8) = v; }
    }
    __syncthreads();
}

__device__ __forceinline__ int crow(int r, int hi) { return (r & 3) + 8 * (r >> 2) + 4 * hi; }
__device__ __forceinline__ void attn_unit(Frame& F, const Args& a, int n4, int h) {
    const int w = F.wave, lane = F.lane, r32 = lane & 31, hi = lane >> 5, tid = F.tid;
    const int p = w >> 1, half = w & 1, c = 4 * n4 + p, qrow0 = c * 64 + 32 * half;
    LAS unsigned char* lds = F.lds;
    LAS float* btab = (LAS float*)(lds + 65536); LAS float* xch = (LAS float*)(lds + 67584 + 256 * w); LAS bf16* ost = (LAS bf16*)(lds + 8192 * w);
    const float* relb = a.in[8] + h * 257;
    if (tid < 257) btab[tid] = relb[tid] * 1.4426950408889634f;
    const bf16* QH = (const bf16*)(F.ws + WS_QH);
    LAS unsigned char* qimg = lds + 69632 + 8192 * w;
#pragma unroll
    for (int d0 = 0; d0 < 8; ++d0) { const bf16x8 qv = *(const bf16x8*)(QH + (size_t)(qrow0 + r32) * ATT_W + h * ATT_HD + d0 * 16 + hi * 8);
        *(LAS bf16x8*)(qimg + ((2 * d0 + hi) * 32 + r32) * 16) = qv; }
    const char* KIMG = (const char*)(F.ws + WS_KIMG); const char* VIMG = (const char*)(F.ws + WS_VIMG);
    f32x16 o[4];
#pragma unroll
    for (int dt = 0; dt < 4; ++dt)
#pragma unroll
        for (int r = 0; r < 16; ++r) o[dt][r] = 0.f;
    float m = -1.0e30f, l = 0.f;
    const int s0 = (4 * n4 - 8 < 0) ? (8 - 4 * n4) : 0;
#define ATT_STAGE(s_) do { const int kc_ = 4 * n4 - 8 + (s_); const size_t gb_ = (size_t)(kc_ * ATT_H + h) * 16384; const unsigned lb_ = ((s_) & 1) * 32768; \
        _Pragma("unroll") for (int i_ = 0; i_ < 2; ++i_) { const int pc_ = w + 8 * i_; \
            __builtin_amdgcn_global_load_lds((const unsigned*)(KIMG + gb_ + pc_ * 1024 + lane * 16), (LAS unsigned*)(lds + lb_ + pc_ * 1024), 16, 0, 0); \
            __builtin_amdgcn_global_load_lds((const unsigned*)(VIMG + gb_ + pc_ * 1024 + lane * 16), (LAS unsigned*)(lds + lb_ + 16384 + pc_ * 1024), 16, 0, 0); } } while (0)
    ATT_STAGE(s0);
    for (int s = s0; s < 12; ++s) {
        asm volatile("s_waitcnt vmcnt(0) lgkmcnt(0)" ::: "memory");
        __builtin_amdgcn_s_barrier();
        if (s + 1 < 12) ATT_STAGE(s + 1);
        if (s >= p && s <= p + 8) {
            const LAS unsigned char* kb = lds + (s & 1) * 32768; const LAS unsigned char* vb = kb + 16384;
            f32x16 p0, p1;
#pragma unroll
            for (int r = 0; r < 16; ++r) { p0[r] = 0.f; p1[r] = 0.f; }
#pragma unroll
            for (int d0 = 0; d0 < 8; ++d0) {
                const bf16x8 k0 = *(const LAS bf16x8*)(kb + (2 * d0 + hi) * 1024 + r32 * 16), k1 = *(const LAS bf16x8*)(kb + (2 * d0 + hi) * 1024 + (r32 + 32) * 16);
                const bf16x8 qv = *(const LAS bf16x8*)(qimg + ((2 * d0 + hi) * 32 + r32) * 16);
                p0 = __builtin_amdgcn_mfma_f32_32x32x16_bf16(k0, qv, p0, 0, 0, 0);
                p1 = __builtin_amdgcn_mfma_f32_32x32x16_bf16(k1, qv, p1, 0, 0, 0);
                if (d0 & 1) __builtin_amdgcn_sched_barrier(0);
            }
            const int wrel = p + 8 - s;
            if (wrel >= 3) { const float bc = btab[256];
#pragma unroll
                for (int r = 0; r < 16; ++r) { p0[r] += bc; p1[r] += bc; } }
            else { const int base = 64 * wrel + 32 * half + r32 + 128;
#pragma unroll
                for (int r = 0; r < 16; ++r) { int i0 = base - crow(r, hi), i1 = i0 - 32; i0 = i0 > 256 ? 256 : i0; i1 = i1 > 256 ? 256 : i1; i1 = i1 < 0 ? 0 : i1; i0 = i0 < 0 ? 0 : i0; p0[r] += btab[i0]; p1[r] += btab[i1]; } }
            float mx = p0[0];
#pragma unroll
            for (int r = 1; r < 16; ++r) mx = fmaxf(mx, p0[r]);
#pragma unroll
            for (int r = 0; r < 16; ++r) mx = fmaxf(mx, p1[r]);
            mx = fmaxf(mx, __shfl_xor(mx, 32));
            const float mn = fmaxf(m, mx), alpha = __builtin_amdgcn_exp2f(m - mn);
            float ps = 0.f;
#pragma unroll
            for (int r = 0; r < 16; ++r) { p0[r] = __builtin_amdgcn_exp2f(p0[r] - mn); p1[r] = __builtin_amdgcn_exp2f(p1[r] - mn); ps += p0[r] + p1[r]; }
            l = l * alpha + ps;
            if (__any(mn > m)) {
                if (hi == 0) xch[r32] = alpha;
                asm volatile("s_waitcnt lgkmcnt(0)" ::: "memory");
#pragma unroll
                for (int g = 0; g < 4; ++g) { const f32x4 av = *(const LAS f32x4*)(xch + 8 * g + 4 * hi);
#pragma unroll
                    for (int dt = 0; dt < 4; ++dt) { o[dt][4 * g] *= av[0]; o[dt][4 * g + 1] *= av[1]; o[dt][4 * g + 2] *= av[2]; o[dt][4 * g + 3] *= av[3]; } }
            }
            m = mn;
            bf16x8 pa[4];
#pragma unroll
            for (int ks = 0; ks < 4; ++ks) { const f32x16& src = (ks < 2) ? p0 : p1; const int b = (ks & 1) * 8; u32x4 t;
                t.x = cvt_pk_bf16(src[b], src[b + 1]); t.y = cvt_pk_bf16(src[b + 2], src[b + 3]); t.z = cvt_pk_bf16(src[b + 4], src[b + 5]); t.w = cvt_pk_bf16(src[b + 6], src[b + 7]);
                pa[ks] = __builtin_bit_cast(bf16x8, t); }
#pragma unroll
            for (int dt = 0; dt < 4; ++dt)
#pragma unroll
                for (int ks = 0; ks < 4; ++ks) {
                    const LAS unsigned char* vp = vb + (2 * ks) * 2048 + (32 * dt + r32) * 16 + 8 * hi;
                    const u32x2 lo = *(const LAS u32x2*)vp, hh = *(const LAS u32x2*)(vp + 2048);
                    const u32x4 bq = (u32x4){lo.x, lo.y, hh.x, hh.y};
                    o[dt] = __builtin_amdgcn_mfma_f32_32x32x16_bf16(pa[ks], __builtin_bit_cast(bf16x8, bq), o[dt], 0, 0, 0);
                    if (ks == 3) __builtin_amdgcn_sched_barrier(0);
                }
        }
    }
#undef ATT_STAGE
    asm volatile("s_waitcnt lgkmcnt(0)" ::: "memory");
    __builtin_amdgcn_s_barrier();
    l += __shfl_xor(l, 32);
    if (hi == 0) xch[32 + r32] = 1.f / l;
    asm volatile("s_waitcnt lgkmcnt(0)" ::: "memory");
#pragma unroll
    for (int g = 0; g < 4; ++g) { const f32x4 iv = *(const LAS f32x4*)(xch + 32 + 8 * g + 4 * hi);
#pragma unroll
        for (int dt = 0; dt < 4; ++dt)
#pragma unroll
            for (int j = 0; j < 4; ++j) ost[(8 * g + 4 * hi + j) * 128 + 32 * dt + r32] = (bf16)f2bf(o[dt][4 * g + j] * iv[j]); }
    asm volatile("s_waitcnt lgkmcnt(0)" ::: "memory");
    bf16* YA = (bf16*)(F.ws + WS_YA);
#pragma unroll
    for (int i = 0; i < 8; ++i) { const int g = i * 64 + lane, row = g >> 4, c16 = g & 15; const u32x4 v = *(const LAS u32x4*)(ost + row * 128 + c16 * 8);
        *(u32x4*)(YA + (size_t)(qrow0 + row) * ATT_W + h * ATT_HD + c16 * 8) = v; }
    asm volatile("s_waitcnt vmcnt(0) lgkmcnt(0)" ::: "memory");
    __builtin_amdgcn_s_barrier();
}


__device__ __forceinline__ void gla_prep_unit(Frame& F, const Args& a, int n, int cg) {
    const int tid = F.tid, cq = tid & 15, seg = tid >> 4;
    const int h = cg >> 2, dk0 = (cg & 3) * 64 + 4 * cq, col0 = h * GLA_DK + dk0, nh = n * GLA_H + h;
    const float* wgu = a.in[3]; const float* bgt = a.in[4]; const float* GLR = (const float*)(F.ws + WS_GLR);
    const bf16* GQ = (const bf16*)(F.ws + WS_GQ); const bf16* GK = (const bf16*)(F.ws + WS_GK);
    LAS float* tot = (LAS float*)F.lds;
    LAS float* wl = tot + 2048;
    if (seg < 16) *(LAS f32x4*)(wl + seg * 64 + 4 * cq) = *(const f32x4*)(wgu + seg * GLA_QK + col0);
    __syncthreads();
    const f32x4 bgv = *(const f32x4*)(bgt + col0);
    f32x4 cs[8]; f32x4 run = (f32x4){0.f, 0.f, 0.f, 0.f};
    const int t0 = n * 256 + seg * 8;
#pragma unroll
    for (int i = 0; i < 8; ++i) {
        const f32x4* gp = (const f32x4*)(GLR + (size_t)(t0 + i) * 16); f32x4 z = bgv;
#pragma unroll
        for (int q = 0; q < 4; ++q) { const f32x4 gv = gp[q]; const LAS f32x4* wp = (const LAS f32x4*)(wl + 4 * q * 64 + 4 * cq);
            z += wp[0] * gv.x; z += wp[16] * gv.y; z += wp[32] * gv.z; z += wp[48] * gv.w; }
#pragma unroll
        for (int j = 0; j < 4; ++j) run[j] += log_sigmoid(z[j]) * (1.f / 16.f);
        cs[i] = run;
    }
    *(LAS f32x4*)(tot + seg * 64 + 4 * cq) = run;
    __syncthreads();
    f32x4 off = (f32x4){0.f, 0.f, 0.f, 0.f}, total = (f32x4){0.f, 0.f, 0.f, 0.f};
    for (int sg = 0; sg < 32; ++sg) { const f32x4 tv = *(const LAS f32x4*)(tot + sg * 64 + 4 * cq); total += tv; if (sg < seg) off += tv; }
    float etot[4];
#pragma unroll
    for (int j = 0; j < 4; ++j) etot[j] = __expf(total[j]);
    unsigned kew[4][4];
    bf16* ACAT = (bf16*)(F.ws + WS_ACAT); bf16* KI = (bf16*)(F.ws + WS_KI); bf16* KET = (bf16*)(F.ws + WS_KET);
    float kprev[4];
#pragma unroll
    for (int i = 0; i < 8; ++i) {
        const size_t trow = (size_t)(t0 + i);
        const u32x2 qv = *(const u32x2*)(GQ + trow * GLA_QK + col0), kv = *(const u32x2*)(GK + trow * GLA_QK + col0);
        float q[4] = {__uint_as_float(qv.x << 16), __uint_as_float(qv.x & 0xffff0000u), __uint_as_float(qv.y << 16), __uint_as_float(qv.y & 0xffff0000u)};
        float k[4] = {__uint_as_float(kv.x << 16), __uint_as_float(kv.x & 0xffff0000u), __uint_as_float(kv.y << 16), __uint_as_float(kv.y & 0xffff0000u)};
        float qd[4], ki[4], ke[4];
#pragma unroll
        for (int j = 0; j < 4; ++j) { const float bc = cs[i][j] + off[j]; const float eb = __expf(bc), ib = __builtin_amdgcn_rcpf(eb); qd[j] = q[j] * 0.0625f * eb; ki[j] = k[j] * ib; ke[j] = ki[j] * etot[j]; }
        const size_t lrow = (size_t)nh * 256 + seg * 8 + i;
        u32x2 o; o.x = pk2(qd[0], qd[1]); o.y = pk2(qd[2], qd[3]); *(u32x2*)(ACAT + lrow * 512 + 256 + dk0) = o;
        o.x = pk2(ki[0], ki[1]); o.y = pk2(ki[2], ki[3]); *(u32x2*)(KI + lrow * 256 + dk0) = o;
        if (i & 1) {
#pragma unroll
            for (int j = 0; j < 4; ++j) kew[j][i >> 1] = pk2(kprev[j], ke[j]); }
        else {
#pragma unroll
            for (int j = 0; j < 4; ++j) kprev[j] = ke[j]; }
    }
#pragma unroll
    for (int j = 0; j < 4; ++j) *(u32x4*)(KET + ((size_t)nh * 256 + dk0 + j) * 256 + seg * 8) = (u32x4){kew[j][0], kew[j][1], kew[j][2], kew[j][3]};
    if (seg == 0) *(f32x4*)((float*)(F.ws + WS_DEC) + n * GLA_QK + col0) = (f32x4){etot[0], etot[1], etot[2], etot[3]};
    __syncthreads();
}
__device__ __forceinline__ void gla_vt_unit(Frame& F, int n, int h, int g8) {
    const int tid = F.tid; const int nh = n * GLA_H + h;
    LAS bf16* tile = (LAS bf16*)F.lds;
    const bf16* GV = (const bf16*)(F.ws + WS_GV); bf16* BCAT = (bf16*)(F.ws + WS_BCAT);
#pragma unroll
    for (int ps = 0; ps < 4; ++ps) { const int row = (tid >> 3) + 64 * ps, ch = tid & 7;
        const u32x4 v = *(const u32x4*)(GV + (size_t)(n * 256 + row) * GLA_V + h * GLA_DV + g8 * 64 + ch * 8);
        *(LAS u32x2*)(tile + row * 72 + ch * 8) = (u32x2){v.x, v.y}; *(LAS u32x2*)(tile + row * 72 + ch * 8 + 4) = (u32x2){v.z, v.w}; }
    __syncthreads();
#pragma unroll
    for (int i = 0; i < 4; ++i) { const int g = tid + 512 * i, c = g & 63, tg = g >> 6; unsigned short e[8];
#pragma unroll
        for (int j = 0; j < 8; ++j) e[j] = tile[(tg * 8 + j) * 72 + c];
        u32x4 v; v.x = e[0] | ((unsigned)e[1] << 16); v.y = e[2] | ((unsigned)e[3] << 16); v.z = e[4] | ((unsigned)e[5] << 16); v.w = e[6] | ((unsigned)e[7] << 16);
        *(u32x4*)(BCAT + ((size_t)nh * 512 + g8 * 64 + c) * 512 + tg * 8) = v; }
    __syncthreads();
}
__device__ __forceinline__ void gla_scan(Frame& F) {
    const bf16* UT = (const bf16*)(F.ws + WS_UT); bf16* BCAT = (bf16*)(F.ws + WS_BCAT); const float* DEC = (const float*)(F.ws + WS_DEC);
    for (int idx = F.vcu * (NWAVES * 64) + F.tid; idx < GLA_H * GLA_DV * 64; idx += F.G * NWAVES * 64) {
        const int dk4 = (idx & 63) * 4, dv = (idx >> 6) & 511, h = idx >> 15;
        float s[4] = {0.f, 0.f, 0.f, 0.f};
#pragma unroll 8
        for (int n = 0; n < 32; ++n) {
            const size_t nh = (size_t)n * GLA_H + h;
            u32x2 o; o.x = pk2(s[0], s[1]); o.y = pk2(s[2], s[3]); *(u32x2*)(BCAT + (nh * 512 + dv) * 512 + 256 + dk4) = o;
            const u32x2 uv = *(const u32x2*)(UT + (nh * 512 + dv) * 256 + dk4); const f32x4 dc = *(const f32x4*)(DEC + n * GLA_QK + h * GLA_DK + dk4);
            s[0] = s[0] * dc.x + __uint_as_float(uv.x << 16); s[1] = s[1] * dc.y + __uint_as_float(uv.x & 0xffff0000u);
            s[2] = s[2] * dc.z + __uint_as_float(uv.y << 16); s[3] = s[3] * dc.w + __uint_as_float(uv.y & 0xffff0000u);
        }
    }
}
__device__ __forceinline__ void gla_norm(Frame& F, const Args& a) {
    const int gw = F.vcu * NWAVES + F.wave, NGW = F.G * NWAVES, lane = F.lane;
    const bf16* OB = (const bf16*)(F.ws + WS_OB); const bf16* GR = (const bf16*)(F.ws + WS_GR); bf16* YG = (bf16*)(F.ws + WS_YG); const float* g = a.in[5];
    const f32x4 g0 = *(const f32x4*)(g + 8 * lane), g1 = *(const f32x4*)(g + 8 * lane + 4);
    for (int wi = gw; wi < S * GLA_H; wi += NGW) {
        const size_t off = (size_t)(wi >> 2) * GLA_V + (wi & 3) * GLA_DV + 8 * lane;
        const u32x4 ov = *(const u32x4*)(OB + off), rv = *(const u32x4*)(GR + off);
        float o[8], r[8]; float ss = 0.f;
#pragma unroll
        for (int j = 0; j < 4; ++j) { o[2 * j] = __uint_as_float(ov[j] << 16); o[2 * j + 1] = __uint_as_float(ov[j] & 0xffff0000u); r[2 * j] = __uint_as_float(rv[j] << 16); r[2 * j + 1] = __uint_as_float(rv[j] & 0xffff0000u); }
#pragma unroll
        for (int j = 0; j < 8; ++j) ss += o[j] * o[j];
        const float rstd = rsqrtf(wave_sum(ss) * (1.f / GLA_DV) + 1e-6f);
        u32x4 w; w.x = pk2(o[0] * rstd * g0.x * r[0], o[1] * rstd * g0.y * r[1]); w.y = pk2(o[2] * rstd * g0.z * r[2], o[3] * rstd * g0.w * r[3]);
        w.z = pk2(o[4] * rstd * g1.x * r[4], o[5] * rstd * g1.y * r[5]); w.w = pk2(o[6] * rstd * g1.z * r[6], o[7] * rstd * g1.w * r[7]);
        *(u32x4*)(YG + off) = w;
    }
}

__global__ void __launch_bounds__(NWAVES * 64, 2) fwd(Args args) {
    extern __shared__ __attribute__((aligned(16))) unsigned char lds_raw[];
    Frame F;
    F.lds = (LAS unsigned char*)lds_raw; F.MISC = (volatile LAS unsigned*)(F.lds + MISC_OFF);
    F.tid = threadIdx.x; F.lane = F.tid & 63; F.wave = __builtin_amdgcn_readfirstlane(F.tid >> 6);
    F.G = gridDim.x; { const int bx = blockIdx.x; F.vcu = (F.G % 8 == 0) ? (bx % 8) * (F.G / 8) + bx / 8 : bx; }
    F.ws = args.ws; F.ctl = (unsigned*)(args.ws + WS_CTL);
    for (int u = F.tid; u < (LDS_BYTES - CTLZ_OFF) / 4; u += NWAVES * 64) ((LAS unsigned*)(F.lds + CTLZ_OFF))[u] = 0u;
    __syncthreads();
    XcdBarrier bar = xcd_barrier_post(F.ctl + CW_BAR + args.li * XCD_BAR_WORDS, F.MISC + 8);
    const int lo = args.ph_lo, hi = args.ph_hi;
#define IN(k) (lo <= (k) && (k) < hi)
#define SEAM(k) do { if (IN(k) && IN((k) + 1)) xcd_barrier(bar); } while (0)
    unsigned char* ws = args.ws;
#ifndef DUP_MASK
#define DUP_MASK 0
#endif
#define DUP(k) ((DUP_MASK >> (k)) & 1)
#define PHASE(k, ...) do { if (IN(k)) { __VA_ARGS__ if (DUP(k)) { xcd_barrier(bar); __VA_ARGS__ } } SEAM(k); } while (0)
#define PHASE_NB(k, ...) do { if (IN(k)) { __VA_ARGS__ if (DUP(k)) { xcd_barrier(bar); __VA_ARGS__ } } } while (0)
    const int gcus = (F.G == 256) ? GEMM_CUS : F.G;
    PHASE(0, { p0_convert(F, args, 0, gcus < F.G ? P0_I_IN : P0_NITEMS, F.vcu * NWAVES + F.wave, F.G * NWAVES); if (gcus == F.G) p0_convert8(F, args, F.vcu * NWAVES + F.wave, F.G * NWAVES); p0_rows(F, args);
        for (int u = F.vcu; u < S / 32; u += F.G) normproj_unit<0>(F, args, u); });
    PHASE(1, { if ((int)blockIdx.x < gcus) { pg8::DenseSched Sc; Sc.init(ws + WS_XN, ws + WS_WIN, S, NPROJ, D, gcus, (int)blockIdx.x); pg8::EpiProj E{ws, args.in[9]};
            pg8::gemm_phase<pg8::EpiProj, pg8::DenseSched>(F.lds, D, D, D, Sc, E); }
        else { p0_convert(F, args, P0_I_IN, P0_NITEMS, ((int)blockIdx.x - gcus) * NWAVES + F.wave, (F.G - gcus) * NWAVES); p0_convert8(F, args, ((int)blockIdx.x - gcus) * NWAVES + F.wave, (F.G - gcus) * NWAVES); } });
    PHASE(2, { for (int rp = 0; rp < 1 + DUP(16); ++rp) for (int u = F.vcu; u < NCH * ATT_H; u += F.G) attn_prep_unit(F, args, u >> 3, u & 7);
        for (int rp = 0; rp < 1 + DUP(17); ++rp) for (int u = F.vcu; u < 32 * 16; u += F.G) gla_prep_unit(F, args, u >> 4, u & 15);
        for (int rp = 0; rp < 1 + DUP(18); ++rp) for (int u = F.vcu; u < 32 * GLA_H * 8; u += F.G) gla_vt_unit(F, u >> 5, (u >> 3) & 3, u & 7); });
    PHASE(3, { for (int u = F.vcu; u < (NCH / 4) * ATT_H; u += F.G) attn_unit(F, args, u >> 3, u & 7);
        { pg8::GlaSched Sc{0, F.G, F.G - 1 - (int)blockIdx.x, ws}; pg8::EpiGla<0> E{ws}; pg8::gemm_phase<pg8::EpiGla<0>, pg8::GlaSched>(F.lds, 256, 512, 256, Sc, E); }
        { pg8::GlaSched Sc{1, F.G, (int)blockIdx.x, ws}; pg8::EpiGla<1> E{ws}; pg8::gemm_phase<pg8::EpiGla<1>, pg8::GlaSched>(F.lds, 256, 512, 256, Sc, E); } });
    PHASE(4, { gla_scan(F); });
    PHASE(5, { pg8::GlaSched Sc{2, F.G, (int)blockIdx.x, ws}; pg8::EpiGla<2> E{ws}; pg8::gemm_phase<pg8::EpiGla<2>, pg8::GlaSched>(F.lds, 512, 512, 512, Sc, E); });
    PHASE(6, { gla_norm(F, args); });
    PHASE_NB(7, { pg8::DenseSched Sc; Sc.init(ws + WS_YG, ws + WS_WBG, S, D, GLA_V, F.G, (int)blockIdx.x); pg8::EpiBranch<0> E{(const bf16*)(ws + WS_SG), nullptr, (bf16*)(ws + WS_T)};
        pg8::gemm_phase<pg8::EpiBranch<0>, pg8::DenseSched>(F.lds, GLA_V, GLA_V, GLA_V, Sc, E); });
    PHASE(8, { pg8::DenseSched Sc; Sc.init(ws + WS_YA, ws + WS_WBA, S, D, ATT_W, F.G, (int)blockIdx.x); pg8::EpiBranch<1> E{(const bf16*)(ws + WS_SA), (const bf16*)(ws + WS_T), (bf16*)(ws + WS_MG)};
        pg8::gemm_phase<pg8::EpiBranch<1>, pg8::DenseSched>(F.lds, ATT_W, ATT_W, ATT_W, Sc, E); });
    PHASE(9, { pg8::DenseSched Sc; Sc.init(ws + WS_MG, ws + WS_WOUT, S, D, D, F.G, (int)blockIdx.x); pg8::EpiResid E{args.in[0], (float*)(ws + WS_H1)};
        pg8::gemm_phase<pg8::EpiResid, pg8::DenseSched>(F.lds, D, D, D, Sc, E); });
    PHASE(10, { for (int u = F.vcu; u < S / 32; u += F.G) normproj_unit<1>(F, args, u); });
    PHASE(11, { moe_table(F); p7_gather(F); });
    PHASE(12, { moe_table(F); pg8::MoeSched Sc; Sc.init(ws + WS_HNG, ws + WS_GU, (volatile LAS int*)(F.lds + TAB_OFF), (volatile LAS int*)(F.lds + TAB_OFF + 256), 16, D, F.G, (int)blockIdx.x);
        pg8::EpiSwiglu E{args.in[17], args.in[19], ws + WS_HD};
        pg8::gemm_phase8<pg8::EpiSwiglu, pg8::MoeSched>(F.lds, D, D, D, Sc, E); });
    PHASE(13, { moe_table(F); pg8::MoeSched Sc; Sc.init(ws + WS_HD, ws + WS_DN, (volatile LAS int*)(F.lds + TAB_OFF), (volatile LAS int*)(F.lds + TAB_OFF + 256), 8, DFF, F.G, (int)blockIdx.x);
        pg8::EpiDown E{args.in[21], (const int*)(ws + WS_RPAIR), (const float*)(ws + WS_RW), (bf16*)(ws + WS_PY)};
        pg8::gemm_phase8<pg8::EpiDown, pg8::MoeSched>(F.lds, DFF, DFF, DFF, Sc, E); });
    PHASE(14, { p10_combine(F, args); });
#undef PHASE
#undef PHASE_NB
#undef IN
#undef SEAM
}

extern "C" void kernel_launch(void* const* d_in, const int* in_sizes, int n_in, void* d_out, int out_size, void* d_ws, size_t ws_size, hipStream_t stream) {
    static int grid = 0;
    if (grid == 0) {
        if (n_in != 22 || out_size != S * D || ws_size < WS_END) { fprintf(stderr, "kernel_launch: unexpected problem (n_in %d out %d ws %zu)\n", n_in, out_size, ws_size); grid = -1; return; }
        int dev = 0, cus = 0, per_cu = 0;
        if (hipGetDevice(&dev) != hipSuccess || hipDeviceGetAttribute(&cus, hipDeviceAttributeMultiprocessorCount, dev) != hipSuccess) { grid = -1; return; }
        if (hipFuncSetAttribute((const void*)fwd, hipFuncAttributeMaxDynamicSharedMemorySize, LDS_BYTES) != hipSuccess) { fprintf(stderr, "kernel_launch: hipFuncSetAttribute failed\n"); grid = -1; return; }
        if (hipOccupancyMaxActiveBlocksPerMultiprocessor(&per_cu, (const void*)fwd, NWAVES * 64, LDS_BYTES) != hipSuccess || per_cu < 1) fprintf(stderr, "kernel_launch: occupancy query says %d\n", per_cu);
        (void)hipGetLastError();
        grid = cus;
    }
    if (grid < 0) return;
    (void)hipMemsetAsync((char*)d_ws + WS_CTL, 0, CTL_ZERO_BYTES, stream);
    Args a{};
    for (int i = 0; i < 22; ++i) a.in[i] = (const float*)d_in[i];
    a.out = (float*)d_out; a.ws = (unsigned char*)d_ws;
    a.ph_lo = 0; a.ph_hi = 15; a.li = 0;
    hipLaunchKernelGGL(fwd, dim3(grid), dim3(NWAVES * 64), LDS_BYTES, stream, a);
}
```

```cpp
#include <hip/hip_runtime.h>
#include <stdint.h>
#include <cstdio>

constexpr int S = 8192, D = 2048;
constexpr int GLA_H = 4, GLA_DK = 256, GLA_DV = 512, GLA_QK = 1024, GLA_V = 2048;
constexpr int ATT_H = 8, ATT_HD = 128, ATT_W = 1024, NCH = S / 64;
constexpr int NE = 32, DFF = 2048;
constexpr int IN_COLS = 13328, C_GLR = 6144;
constexpr int NPROJ = 13312;
constexpr int MAXROWS = 32768 + NE * 256;

constexpr size_t MiB = 1u << 20;
constexpr size_t WS_CTL = 0, CTL_ZERO_BYTES = 64 * 1024;
constexpr size_t WS_TOPW = 1 * MiB, WS_TOPE = WS_TOPW + 128 * 1024, WS_TOPS = WS_TOPE + 128 * 1024, WS_RPAIR = WS_TOPS + 128 * 1024, WS_RW = WS_RPAIR + 256 * 1024;
constexpr size_t WS_GLR = 2 * MiB, WS_WR = 3 * MiB;
constexpr size_t WS_SMAP = 1232 * MiB, WS_WMAP = 1233 * MiB;
constexpr size_t WS_WIN = 8 * MiB, WS_WBG = 60 * MiB, WS_WBA = 68 * MiB, WS_WOUT = 72 * MiB, WS_GU = 80 * MiB, WS_DN = 592 * MiB;
constexpr size_t WS_XN = 848 * MiB, WS_GQ = 880 * MiB, WS_GK = 896 * MiB, WS_GV = 912 * MiB, WS_GR = 944 * MiB, WS_AQ = 976 * MiB, WS_AK = 992 * MiB, WS_AV = 1008 * MiB;
constexpr size_t WS_SG = 1024 * MiB, WS_SA = 1056 * MiB, WS_YG = 1088 * MiB, WS_YA = 1120 * MiB, WS_T = 1136 * MiB, WS_MG = 1168 * MiB, WS_HN = 1200 * MiB;
constexpr size_t WS_HNG = 1232 * MiB, WS_HD = 1392 * MiB, WS_PY = 1552 * MiB, WS_QH = 1681 * MiB, WS_KIMG = 1697 * MiB, WS_VIMG = 1713 * MiB;
constexpr size_t WS_PSLOT = 1889 * MiB + 512 * 1024;
constexpr size_t WS_ACAT = 1729 * MiB, WS_BCAT = 1761 * MiB, WS_KI = 1825 * MiB, WS_KET = 1841 * MiB, WS_UT = 1857 * MiB, WS_DEC = 1889 * MiB, WS_OB = 1890 * MiB, WS_H1 = 1922 * MiB, WS_XN8 = 1986 * MiB, WS_WIN8 = WS_WIN + 24 * MiB, WS_WBA8 = WS_WIN + 40 * MiB, WS_END = 2002 * MiB;
constexpr int CW_CNT = 256;
constexpr int CW_JIT = 2560;
constexpr int CW_BAR = 4096;
constexpr int CW_PS = 8192;

typedef unsigned short bf16;
typedef short bf16x8 __attribute__((ext_vector_type(8)));
typedef float f32x4 __attribute__((ext_vector_type(4)));
typedef float f32x16 __attribute__((ext_vector_type(16)));
typedef unsigned u32x4 __attribute__((ext_vector_type(4)));
typedef unsigned u32x2 __attribute__((ext_vector_type(2)));
typedef int v8i __attribute__((ext_vector_type(8)));
#define LAS __attribute__((address_space(3)))
#define GAS __attribute__((address_space(1)))
__device__ __forceinline__ float bf2f(bf16 v) { return __uint_as_float((unsigned)v << 16); }
typedef float f32x2_t __attribute__((ext_vector_type(2))); typedef __bf16 bf16x2_t __attribute__((ext_vector_type(2)));
__device__ __forceinline__ unsigned pk2(float lo, float hi) { const f32x2_t v = {lo, hi}; const bf16x2_t b = __builtin_convertvector(v, bf16x2_t); return __builtin_bit_cast(unsigned, b); }
__device__ __forceinline__ unsigned f2bf(float f) { return pk2(f, 0.f) & 0xffffu; }
__device__ __forceinline__ unsigned cvt_pk_bf16(float lo, float hi) { return pk2(lo, hi); }
__device__ __forceinline__ float wave_sum(float v) {
#pragma unroll
    for (int o = 1; o < 64; o <<= 1) v += __shfl_xor(v, o);
    return v;
}
__device__ __forceinline__ float sigmoidf_(float x) { return __builtin_amdgcn_rcpf(1.f + __expf(-x)); }
__device__ __forceinline__ float log_sigmoid(float z) { return fminf(z, 0.f) - __logf(1.f + __expf(-fabsf(z))); }
#define LDS_WAIT() asm volatile("s_waitcnt lgkmcnt(0)" ::: "memory")
#define VM_WAIT() asm volatile("s_waitcnt vmcnt(0)" ::: "memory")

#define XB_TMO      128
#define XB_XCNT(j)  (256  + 64 * (j))
#define XB_XSUB(j)  (1280 + 64 * (j))
#define XB_XGEN(j)  (2304 + 64 * (j))
#define XB_TOP      3328
#define XB_TOPGEN   3392
#define XCD_BAR_WORDS 3456
#define XB_SPIN_CAP (1u << 18)
__device__ __forceinline__ unsigned xb_ld(unsigned* p)              { return __hip_atomic_load(p, __ATOMIC_RELAXED, __HIP_MEMORY_SCOPE_AGENT); }
__device__ __forceinline__ unsigned xb_add(unsigned* p, unsigned v) { return __hip_atomic_fetch_add(p, v, __ATOMIC_RELAXED, __HIP_MEMORY_SCOPE_AGENT); }
__device__ __forceinline__ unsigned xb_xcc_id() { return (unsigned)__builtin_amdgcn_s_getreg((3 << 11) | 20) & 0xFu; }
#define XB_SPIN(cond, bar) do { unsigned _sp = 0; while (cond) { __builtin_amdgcn_s_sleep(1); \
    if ((++_sp & 255u) == 0u) { if (xb_ld(&(bar)[XB_TMO])) break; if (_sp > XB_SPIN_CAP) { atomicAdd(&(bar)[XB_TMO], 1u); break; } } } } while (0)
struct XcdBarrier { unsigned* bar; unsigned x; volatile LAS unsigned* st; };
__device__ __forceinline__ XcdBarrier xcd_barrier_post(unsigned* bar, volatile LAS unsigned* st) {
    XcdBarrier b; b.bar = bar; b.x = xb_xcc_id(); b.st = st;
    if (threadIdx.x == 0) (void)xb_add(&bar[XB_XCNT(b.x)], 1u);
    return b;
}
__device__ __forceinline__ void xcd_barrier_complete(unsigned* bar, unsigned x, unsigned& nloc, unsigned& nx) {
    const unsigned G = gridDim.x * gridDim.y * gridDim.z;
    unsigned sum, cnt, mine, sp = 0u;
    for (;;) {
        sum = 0u; cnt = 0u; mine = 0u;
#pragma unroll
        for (unsigned j = 0; j < 16; ++j) { const unsigned c = xb_ld(&bar[XB_XCNT(j)]); sum += c; cnt += (c > 0u) ? 1u : 0u; mine = (j == x) ? c : mine; }
        if (sum == G) break;
        __builtin_amdgcn_s_sleep(1);
        if ((++sp & 255u) == 0u) { if (xb_ld(&bar[XB_TMO])) break; if (sp > XB_SPIN_CAP) { atomicAdd(&bar[XB_TMO], 1u); break; } }
    }
    nloc = mine > 0u ? mine : 1u; nx = cnt > 0u ? cnt : 1u;
}
__device__ __forceinline__ void xcd_barrier(const XcdBarrier& b) {
    asm volatile("s_waitcnt vmcnt(0)" ::: "memory");
    __syncthreads();
    if (threadIdx.x == 0) {
        unsigned* bar = b.bar;
        __builtin_amdgcn_s_waitcnt(0);
        unsigned nloc = b.st[0], nx = b.st[1];
        if (nloc == 0u) { xcd_barrier_complete(bar, b.x, nloc, nx); b.st[0] = nloc; b.st[1] = nx; }
        const unsigned old = xb_add(&bar[XB_XSUB(b.x)], 1u);
        const unsigned gen = old / nloc;
        if (old + 1u == (gen + 1u) * nloc) {
            __builtin_amdgcn_fence(__ATOMIC_RELEASE, "agent");
            asm volatile("s_waitcnt vmcnt(0)" ::: "memory");
            const unsigned og = xb_add(&bar[XB_TOP], 1u);
            const unsigned tg = og / nx;
            if (og + 1u == (tg + 1u) * nx) xb_add(&bar[XB_TOPGEN], 1u);
            else XB_SPIN(xb_ld(&bar[XB_TOPGEN]) == tg, bar);
            __builtin_amdgcn_fence(__ATOMIC_ACQUIRE, "agent");
            xb_add(&bar[XB_XGEN(b.x)], 1u);
            asm volatile("s_waitcnt vmcnt(0)" ::: "memory");
        } else {
            XB_SPIN(xb_ld(&bar[XB_XGEN(b.x)]) == gen, bar);
            __builtin_amdgcn_fence(__ATOMIC_ACQUIRE, "agent");
            asm volatile("s_waitcnt vmcnt(0)" ::: "memory");
        }
    }
    __syncthreads();
}

namespace pg8 {
constexpr int JIT_EARLY = 5;
constexpr int BM = 256, BK = 64, HALF = 128, HTB = HALF * BK * 2, STAGE_BYTES = 8 * HTB, NXCD = 8, WGM = 8;
__host__ __device__ __forceinline__ int lds_byte(int r, int c) { const int st = (r >> 4) * 2 + (c >> 5), rr = r & 15, cc = c & 31, ob = rr * 64 + cc * 2; return st * 1024 + (ob ^ (((ob >> 9) & 1) << 5)); }
__host__ __device__ __forceinline__ void stage_rc(int b, int& R, int& C) { const int st = b / 1024, sb = b % 1024, swz = sb ^ (((sb >> 9) & 1) << 5); R = (st >> 1) * 16 + swz / 64; C = (st & 1) * 32 + (swz % 64) / 2; }
__host__ __device__ __forceinline__ int perm32(int rho) { const int n = rho >> 4, i = rho & 15; return 8 * (i >> 2) + 4 * n + (i & 3); }
__device__ __forceinline__ int xcd_remap(int wgid, int nwg) { const int q = nwg / NXCD, r = nwg % NXCD, xcd = wgid % NXCD, off = wgid / NXCD; return (xcd < r ? xcd * (q + 1) : r * (q + 1) + (xcd - r) * q) + off; }

struct Unit { const char* A; const char* B; int pm, pn, e, nrow, trow; };

struct DenseSched {
    const char* A; const char* Bt; int nM, nN, nwg, G, c; size_t tstep; int pn_split, pn_skip, pn_base, bcompact, jhalf;
    unsigned* jflag; unsigned jwant0, jwant1; volatile LAS unsigned* jseen; int jmode; mutable int seen;
    __device__ __forceinline__ void init(const void* A_, const void* Bt_, int M, int N, int K, int G_, int c_) { A = (const char*)A_; Bt = (const char*)Bt_; nM = M / BM; nN = N / BM; nwg = nM * nN; G = G_; c = c_; tstep = (size_t)BM * K * 2; pn_split = nN; pn_skip = 0; pn_base = 0; bcompact = 0; jhalf = 1 << 20; jflag = nullptr; seen = 0; jmode = 0; }
    __device__ __forceinline__ void init_split(const void* A_, const void* Bt_, int M, int ntiles, int Kbytes, int G_, int c_, int split, int skip) { A = (const char*)A_; Bt = (const char*)Bt_; nM = M / BM; nN = ntiles; nwg = nM * nN; G = G_; c = c_; tstep = (size_t)BM * Kbytes; pn_split = split; pn_skip = skip; pn_base = 0; bcompact = 0; jhalf = ntiles / 2; jflag = nullptr; seen = 0; jmode = 0; }
    __device__ __forceinline__ void jwait(int st) const {
        if (seen & (1 << st)) return;
        if (__builtin_amdgcn_readfirstlane((int)(threadIdx.x >> 6)) == 0) {
            const unsigned want = st ? jwant1 : jwant0; unsigned sp = 0u;
            while ((unsigned)__builtin_amdgcn_readfirstlane((int)__hip_atomic_load(jflag + 64 * st, __ATOMIC_RELAXED, __HIP_MEMORY_SCOPE_AGENT)) < want) { __builtin_amdgcn_s_sleep(8); if (++sp > (1u << 18)) break; }
            __builtin_amdgcn_fence(__ATOMIC_ACQUIRE, "agent");
            jseen[st] = 1u;
        } else { unsigned sp = 0u; while (jseen[st] == 0u) { __builtin_amdgcn_s_sleep(2); if (++sp > (1u << 22)) break; } }
        asm volatile("" ::: "memory");
        seen |= 1 << st;
    }
    __device__ __forceinline__ bool next(int i, Unit& u) const {
        const long L = (long)i * G + c; if (L >= nwg) return false;
        const int wgid = xcd_remap((int)L, nwg);
        const int nig = WGM * nN, gid = wgid / nig, fm = gid * WGM, gsz = (nM - fm) < WGM ? (nM - fm) : WGM;
        const int j = (wgid % nig) / gsz;
        if (jflag) jwait((jmode == 0 && (j % jhalf) < JIT_EARLY) ? 0 : 1);
        u.pm = fm + ((wgid % nig) % gsz); u.pn = j < pn_split ? j + pn_base : j + pn_skip; u.e = 0; u.nrow = BM;
        u.A = A + (size_t)u.pm * tstep; u.B = Bt + (ptrdiff_t)(bcompact ? j : u.pn) * (ptrdiff_t)tstep; return true;
    }
};
struct MoeSched {
    const char* A; const char* Bt; const volatile LAS int* tstart; const volatile LAS int* cnt; int NT, nwg, G, c; size_t tstep; int agather;
    __device__ __forceinline__ void init(const void* A_, const void* Bt_, const volatile LAS int* ts, const volatile LAS int* cn, int NT_, int Kbytes, int G_, int c_) {
        A = (const char*)A_; Bt = (const char*)Bt_; tstart = ts; cnt = cn; NT = NT_; nwg = ts[NE] * NT_; G = G_; c = c_; tstep = (size_t)BM * Kbytes; agather = 0; }
    __device__ __forceinline__ bool next(int i, Unit& u) const {
        const long L = (long)i * G + c; if (L >= nwg) return false;
        const int wgid = xcd_remap((int)L, nwg);
        const int lj = (int)(threadIdx.x & 31u); const int tj = tstart[lj];
        const unsigned long long hit = __ballot(wgid >= tj * NT);
        const int e = __builtin_amdgcn_readfirstlane(__builtin_popcount((unsigned)(hit & 0xffffffffull)) - 1);
        const int t0 = tstart[e], nte = tstart[e + 1] - t0, local = wgid - t0 * NT;
        const int pn = local / nte, mt = local - pn * nte;
        u.e = e; u.pn = pn; u.pm = t0 + mt; u.nrow = cnt[e] - mt * BM; u.trow = e * 8192 + mt * BM;
        u.A = agather ? A : A + (size_t)u.pm * tstep; u.B = Bt + (size_t)(e * NT + pn) * tstep; return true;
    }
};

template <class Epi, class Sched, bool BGRAN = false>
__device__ __forceinline__ void gemm_phase(LAS unsigned char* lds, const int K, const int lda, const int ldb, const Sched& S, const Epi& E) {
    const int tid = threadIdx.x, wid = __builtin_amdgcn_readfirstlane(tid >> 6), lane = tid & 63, wr = wid >> 2, wc = wid & 3, fr = lane & 15, fq = lane >> 4;
    int nt = K / BK; asm volatile("" : "+s"(nt));
    unsigned voffA[2], voffB[2];
#pragma unroll
    for (int i = 0; i < 2; ++i) { int R, C; stage_rc(tid * 16 + i * 8192, R, C); const int Rb = Epi::PERM ? ((R & ~31) + perm32(R & 31)) : R;
        voffA[i] = (unsigned)(R * lda + C) * 2u; voffB[i] = BGRAN ? (unsigned)((C >> 3) * ldb + Rb) * 16u : (unsigned)(Rb * ldb + C) * 2u; }
    const size_t kstep = (size_t)(BK * 2), kstepB = BGRAN ? (size_t)ldb * 128 : (size_t)(BK * 2);
    const size_t hstepA = (size_t)HALF * lda * 2, hstepB = BGRAN ? (size_t)2048 : (size_t)HALF * ldb * 2;
    const unsigned ldsw = (unsigned)wid * 1024u;
    const int aoff = lds_byte(wr * 64 + fr, fq * 8), boff = lds_byte(wc * 32 + fr, fq * 8);
#define PG8_SA(b, h) (((b) * 2 + (h)) * HTB)
#define PG8_SB(b, h) ((4 + (b) * 2 + (h)) * HTB)
#define PG8_STAGE(bufoff, gbase, voff) do { _Pragma("unroll") for (int _i = 0; _i < 2; ++_i) \
        __builtin_amdgcn_global_load_lds((const unsigned*)((const char*)(gbase) + (voff)[_i]), (LAS unsigned*)(lds + (bufoff) + ldsw + _i * 8192), 16, 0, 0); } while (0)
#define PG8_LDA(dst, b, h) do { _Pragma("unroll") for (int m = 0; m < 4; ++m) _Pragma("unroll") for (int k = 0; k < 2; ++k) dst[m][k] = *(const LAS bf16x8*)(lds + PG8_SA(b, h) + aoff + m * 2048 + k * 1024); } while (0)
#define PG8_LDB(dst, b, h) do { _Pragma("unroll") for (int n = 0; n < 2; ++n) _Pragma("unroll") for (int k = 0; k < 2; ++k) dst[n][k] = *(const LAS bf16x8*)(lds + PG8_SB(b, h) + boff + n * 2048 + k * 1024); } while (0)
#define PG8_MMA(ai, bj, At, Bt) do { __builtin_amdgcn_s_setprio(1); _Pragma("unroll") for (int m = 0; m < 4; ++m) _Pragma("unroll") for (int n = 0; n < 2; ++n) _Pragma("unroll") for (int k = 0; k < 2; ++k) \
        acc[ai][bj][m][n] = __builtin_amdgcn_mfma_f32_16x16x32_bf16(Bt[n][k], At[m][k], acc[ai][bj][m][n], 0, 0, 0); __builtin_amdgcn_s_setprio(0); } while (0)
#define PG8_WAIT_V(n) asm volatile("s_waitcnt vmcnt(" #n ")" ::: "memory")
#define PG8_WAIT_L(n) asm volatile("s_waitcnt lgkmcnt(" #n ")" ::: "memory")
#define PG8_BAR __builtin_amdgcn_s_barrier()
#define PG8_SCHED __builtin_amdgcn_sched_barrier(0)
    Unit cur, nxt; int ui = 0;
    if (!S.next(0, cur)) return;
    f32x4 acc[2][2][4][2];
#pragma unroll
    for (int a = 0; a < 2; ++a)
#pragma unroll
        for (int b = 0; b < 2; ++b)
#pragma unroll
            for (int m = 0; m < 4; ++m)
#pragma unroll
                for (int n = 0; n < 2; ++n) acc[a][b][m][n] = (f32x4){0.f, 0.f, 0.f, 0.f};
    bf16x8 At[4][2], B0[2][2], B1[2][2];
    const char* cA = cur.A; const char* cB = cur.B;
    PG8_STAGE(PG8_SB(0, 0), cB, voffB); PG8_STAGE(PG8_SB(0, 1), cB + hstepB, voffB); PG8_STAGE(PG8_SA(0, 0), cA, voffA); PG8_STAGE(PG8_SA(0, 1), cA + hstepA, voffA);
    if (wr == 1) PG8_BAR;
    PG8_WAIT_V(2); PG8_BAR;
    PG8_STAGE(PG8_SB(1, 0), cB + kstepB, voffB); PG8_STAGE(PG8_SA(1, 0), cA + kstep, voffA); PG8_STAGE(PG8_SB(1, 1), cB + hstepB + kstepB, voffB);
    PG8_WAIT_V(6); PG8_BAR;
    for (;;) {
        const bool has_next = S.next(ui + 1, nxt);
        const char* nA = has_next ? nxt.A : cA; const char* nB = has_next ? nxt.B : cB;
#pragma unroll 1
        for (int t = 0; t < nt; t += 2) {
            const bool last = (t == nt - 2);
            const char* a1 = cA + (size_t)(t + 1) * kstep;
            const char* a2 = last ? nA : cA + (size_t)(t + 2) * kstep; const char* b2 = last ? nB : cB + (size_t)(t + 2) * kstepB;
            const char* a3 = a2 + kstep; const char* b3 = b2 + kstepB;
            PG8_LDB(B0, 0, 0); PG8_LDB(B1, 0, 1); PG8_SCHED; PG8_LDA(At, 0, 0); PG8_STAGE(PG8_SA(1, 1), a1 + hstepA, voffA);
            PG8_WAIT_V(8); PG8_WAIT_L(0); PG8_BAR; PG8_MMA(0, 0, At, B0); PG8_MMA(0, 1, At, B1); PG8_BAR; PG8_SCHED;
            PG8_LDA(At, 0, 1); PG8_STAGE(PG8_SB(0, 0), b2, voffB); PG8_STAGE(PG8_SB(0, 1), b2 + hstepB, voffB); PG8_STAGE(PG8_SA(0, 0), a2, voffA);
            PG8_WAIT_V(8); PG8_WAIT_L(0); PG8_BAR; PG8_MMA(1, 0, At, B0); PG8_MMA(1, 1, At, B1); PG8_BAR; PG8_SCHED;
            PG8_LDB(B0, 1, 0); PG8_LDB(B1, 1, 1); PG8_SCHED; PG8_LDA(At, 1, 0); PG8_STAGE(PG8_SA(0, 1), a2 + hstepA, voffA);
            PG8_WAIT_V(8); PG8_WAIT_L(0); PG8_BAR; PG8_MMA(0, 0, At, B0); PG8_MMA(0, 1, At, B1); PG8_BAR; PG8_SCHED;
            PG8_LDA(At, 1, 1); PG8_STAGE(PG8_SB(1, 0), b3, voffB); PG8_STAGE(PG8_SB(1, 1), b3 + hstepB, voffB); PG8_STAGE(PG8_SA(1, 0), a3, voffA);
            PG8_WAIT_V(8); PG8_WAIT_L(0); PG8_BAR; PG8_MMA(1, 0, At, B0); PG8_MMA(1, 1, At, B1); PG8_BAR; PG8_SCHED;
        }
        if (wr == 0) PG8_BAR;
        { int fr_ = fr, fq_ = fq; asm volatile("" : "+v"(fr_), "+v"(fq_));
          E(acc, cur, wr, wc, fr_, fq_); }
        if (!has_next) break;
#pragma unroll
        for (int a = 0; a < 2; ++a)
#pragma unroll
            for (int b = 0; b < 2; ++b)
#pragma unroll
                for (int m = 0; m < 4; ++m)
#pragma unroll
                    for (int n = 0; n < 2; ++n) acc[a][b][m][n] = (f32x4){0.f, 0.f, 0.f, 0.f};
        cur = nxt; cA = nA; cB = nB; ++ui;
        if (wr == 1) PG8_BAR;
    }
    PG8_WAIT_V(0);
    PG8_BAR;
#undef PG8_SA
#undef PG8_SB
#undef PG8_STAGE
#undef PG8_LDA
#undef PG8_LDB
#undef PG8_MMA
#undef PG8_WAIT_V
#undef PG8_WAIT_L
#undef PG8_BAR
#undef PG8_SCHED
}

template <class Epi, class Sched, bool GATHER = false>
__device__ __forceinline__ void gemm_phase8(LAS unsigned char* lds, const int K, const int lda, const int ldb, const Sched& S, const Epi& E, const int scx_init = 0x7f7f7f7f, const int* rtab = nullptr, const int gmax = 0) {
    const int tid = threadIdx.x, wid = __builtin_amdgcn_readfirstlane(tid >> 6), lane = tid & 63, wr = wid >> 2, wc = wid & 3, fr = lane & 15, fq = lane >> 4;
    int nt = K / 128; asm volatile("" : "+s"(nt));
    unsigned voffA[2], voffB[2];
#pragma unroll
    for (int i = 0; i < 2; ++i) { int R, C; stage_rc(tid * 16 + i * 8192, R, C); const int Rb = Epi::PERM ? ((R & ~31) + perm32(R & 31)) : R;
        voffA[i] = (unsigned)(R * lda + C * 2); voffB[i] = (unsigned)(Rb * ldb + C * 2); }
    const size_t kstep = 128, kstepB = 128;
    const size_t hstepA = GATHER ? (size_t)0 : (size_t)HALF * lda, hstepB = (size_t)HALF * ldb;
    unsigned vgC[2][2], vgN[2][2];
#define PG8_GLOAD(dst, U_) do { if (GATHER) { _Pragma("unroll") for (int h_ = 0; h_ < 2; ++h_) _Pragma("unroll") for (int i_ = 0; i_ < 2; ++i_) { int R_, C_; stage_rc(tid * 16 + i_ * 8192, R_, C_); \
        int tk_ = rtab[(U_).trow + h_ * HALF + R_] >> 2; tk_ = (h_ * HALF + R_) < (U_).nrow ? tk_ : gmax; tk_ = tk_ < gmax ? tk_ : gmax; tk_ = tk_ > 0 ? tk_ : 0; dst[h_][i_] = (unsigned)(tk_ * lda + C_ * 2); } } } while (0)
#define PG8_VA(h_, nextu) (GATHER ? ((nextu) ? vgN[h_] : vgC[h_]) : voffA)
    const unsigned ldsw = (unsigned)wid * 1024u;
    const int aoff = lds_byte(wr * 64 + fr, fq * 8), boff = lds_byte(wc * 32 + fr, fq * 8);
#define PG8_SA(b, h) (((b) * 2 + (h)) * HTB)
#define PG8_SB(b, h) ((4 + (b) * 2 + (h)) * HTB)
#define PG8_STAGE(bufoff, gbase, voff) do { _Pragma("unroll") for (int _i = 0; _i < 2; ++_i) \
        __builtin_amdgcn_global_load_lds((const unsigned*)((const char*)(gbase) + (voff)[_i]), (LAS unsigned*)(lds + (bufoff) + ldsw + _i * 8192), 16, 0, 0); } while (0)
#define PG8_LDA(dst, b, h) do { _Pragma("unroll") for (int m = 0; m < 4; ++m) { dst[m][0] = *(const LAS u32x4*)(lds + PG8_SA(b, h) + aoff + m * 2048); dst[m][1] = *(const LAS u32x4*)(lds + PG8_SA(b, h) + aoff + m * 2048 + 1024); } } while (0)
#define PG8_LDB(dst, b, h) do { _Pragma("unroll") for (int n = 0; n < 2; ++n) { dst[n][0] = *(const LAS u32x4*)(lds + PG8_SB(b, h) + boff + n * 2048); dst[n][1] = *(const LAS u32x4*)(lds + PG8_SB(b, h) + boff + n * 2048 + 1024); } } while (0)
#define PG8_MMA(ai, bj, At, Bt) do { __builtin_amdgcn_s_setprio(1); _Pragma("unroll") for (int m = 0; m < 4; ++m) _Pragma("unroll") for (int n = 0; n < 2; ++n) { \
        const v8i b_ = __builtin_bit_cast(v8i, __builtin_shufflevector(Bt[n][0], Bt[n][1], 0, 1, 2, 3, 4, 5, 6, 7)), a_ = __builtin_bit_cast(v8i, __builtin_shufflevector(At[m][0], At[m][1], 0, 1, 2, 3, 4, 5, 6, 7)); \
        asm volatile("s_nop 1\n\tv_mfma_scale_f32_16x16x128_f8f6f4 %0, %1, %2, %0, %3, %4 op_sel_hi:[0,0,0]" : "+v"(acc[ai][bj][m][n]) : "v"(b_), "v"(a_), "v"(scw), "v"(scx)); } \
        __builtin_amdgcn_s_setprio(0); } while (0)
#define PG8_WAIT_V(n) asm volatile("s_waitcnt vmcnt(" #n ")" ::: "memory")
#define PG8_WAIT_L(n) asm volatile("s_waitcnt lgkmcnt(" #n ")" ::: "memory")
#define PG8_BAR __builtin_amdgcn_s_barrier()
#define PG8_SCHED __builtin_amdgcn_sched_barrier(0)
    Unit cur, nxt; int ui = 0;
    if (!S.next(0, cur)) return;
    f32x4 acc[2][2][4][2];
#pragma unroll
    for (int a = 0; a < 2; ++a)
#pragma unroll
        for (int b = 0; b < 2; ++b)
#pragma unroll
            for (int m = 0; m < 4; ++m)
#pragma unroll
                for (int n = 0; n < 2; ++n) acc[a][b][m][n] = (f32x4){0.f, 0.f, 0.f, 0.f};
    u32x4 At[4][2], B0[2][2], B1[2][2];
    int scw = 0x7a7a7a7a, scx = scx_init; asm volatile("" : "+v"(scw), "+v"(scx));
    const char* cA = cur.A; const char* cB = cur.B;
    PG8_GLOAD(vgC, cur);
    PG8_STAGE(PG8_SB(0, 0), cB, voffB); PG8_STAGE(PG8_SB(0, 1), cB + hstepB, voffB); PG8_STAGE(PG8_SA(0, 0), cA, PG8_VA(0, false)); PG8_STAGE(PG8_SA(0, 1), cA + hstepA, PG8_VA(1, false));
    if (wr == 1) PG8_BAR;
    PG8_WAIT_V(2); PG8_BAR;
    PG8_STAGE(PG8_SB(1, 0), cB + kstepB, voffB); PG8_STAGE(PG8_SA(1, 0), cA + kstep, PG8_VA(0, false)); PG8_STAGE(PG8_SB(1, 1), cB + hstepB + kstepB, voffB);
    PG8_WAIT_V(6); PG8_BAR;
    for (;;) {
        const bool has_next = S.next(ui + 1, nxt);
        const char* nA = has_next ? nxt.A : cA; const char* nB = has_next ? nxt.B : cB;
        if (has_next) PG8_GLOAD(vgN, nxt);
        const bool full = cur.nrow > HALF;
#pragma unroll 1
        for (int t = 0; t < nt; t += 2) {
            const bool last = (t == nt - 2);
            const char* a1 = cA + (size_t)(t + 1) * kstep;
            const char* a2 = last ? nA : cA + (size_t)(t + 2) * kstep; const char* b2 = last ? nB : cB + (size_t)(t + 2) * kstepB;
            const char* a3 = a2 + kstep; const char* b3 = b2 + kstepB;
            PG8_LDB(B0, 0, 0); PG8_LDB(B1, 0, 1); PG8_SCHED; PG8_LDA(At, 0, 0); PG8_STAGE(PG8_SA(1, 1), a1 + hstepA, PG8_VA(1, false));
            PG8_WAIT_V(8); PG8_WAIT_L(0); PG8_BAR; PG8_MMA(0, 0, At, B0); PG8_MMA(0, 1, At, B1); PG8_BAR; PG8_SCHED;
            if (full) PG8_LDA(At, 0, 1); PG8_STAGE(PG8_SB(0, 0), b2, voffB); PG8_STAGE(PG8_SB(0, 1), b2 + hstepB, voffB); PG8_STAGE(PG8_SA(0, 0), a2, PG8_VA(0, last && has_next));
            PG8_WAIT_V(8); PG8_WAIT_L(0); PG8_BAR; if (full) { PG8_MMA(1, 0, At, B0); PG8_MMA(1, 1, At, B1); } PG8_BAR; PG8_SCHED;
            PG8_LDB(B0, 1, 0); PG8_LDB(B1, 1, 1); PG8_SCHED; PG8_LDA(At, 1, 0); PG8_STAGE(PG8_SA(0, 1), a2 + hstepA, PG8_VA(1, last && has_next));
            PG8_WAIT_V(8); PG8_WAIT_L(0); PG8_BAR; PG8_MMA(0, 0, At, B0); PG8_MMA(0, 1, At, B1); PG8_BAR; PG8_SCHED;
            if (full) PG8_LDA(At, 1, 1); PG8_STAGE(PG8_SB(1, 0), b3, voffB); PG8_STAGE(PG8_SB(1, 1), b3 + hstepB, voffB); PG8_STAGE(PG8_SA(1, 0), a3, PG8_VA(0, last && has_next));
            PG8_WAIT_V(8); PG8_WAIT_L(0); PG8_BAR; if (full) { PG8_MMA(1, 0, At, B0); PG8_MMA(1, 1, At, B1); } PG8_BAR; PG8_SCHED;
        }
        if (wr == 0) PG8_BAR;
        asm volatile("s_nop 15\n\ts_nop 7" ::: "memory");
        { int fr_ = fr, fq_ = fq; asm volatile("" : "+v"(fr_), "+v"(fq_));
          E(acc, cur, wr, wc, fr_, fq_); }
        if (!has_next) break;
#pragma unroll
        for (int a = 0; a < 2; ++a)
#pragma unroll
            for (int b = 0; b < 2; ++b)
#pragma unroll
                for (int m = 0; m < 4; ++m)
#pragma unroll
                    for (int n = 0; n < 2; ++n) acc[a][b][m][n] = (f32x4){0.f, 0.f, 0.f, 0.f};
        cur = nxt; cA = nA; cB = nB; ++ui;
        if (GATHER) { _Pragma("unroll") for (int h_ = 0; h_ < 2; ++h_) _Pragma("unroll") for (int i_ = 0; i_ < 2; ++i_) vgC[h_][i_] = vgN[h_][i_]; }
        if (wr == 1) PG8_BAR;
    }
    PG8_WAIT_V(0);
    PG8_BAR;
#undef PG8_SA
#undef PG8_SB
#undef PG8_STAGE
#undef PG8_GLOAD
#undef PG8_VA
#undef PG8_LDA
#undef PG8_LDB
#undef PG8_MMA
#undef PG8_WAIT_V
#undef PG8_WAIT_L
#undef PG8_BAR
#undef PG8_SCHED
}

struct EpiProj {
    static constexpr bool PERM = true;
    unsigned char* ws; const float* bbg;
    __device__ __forceinline__ void operator()(const f32x4 (&acc)[2][2][4][2], const Unit& u, int wr, int wc, int fr, int fq) const {
        const int pn = u.pn; size_t off; int ld, t0, act = 0;
        if (pn < 4) { off = WS_GQ; ld = 1024; t0 = 0; } else if (pn < 8) { off = WS_GK; ld = 1024; t0 = 4; } else if (pn < 16) { off = WS_GV; ld = 2048; t0 = 8; }
        else if (pn < 24) { off = WS_GR; ld = 2048; t0 = 16; act = 1; } else if (pn < 28) { off = WS_AQ; ld = 1024; t0 = 24; } else if (pn < 32) { off = WS_AK; ld = 1024; t0 = 28; }
        else if (pn < 36) { off = WS_AV; ld = 1024; t0 = 32; } else if (pn < 44) { off = WS_SG; ld = 2048; t0 = 36; act = 2; } else { off = WS_SA; ld = 2048; t0 = 44; act = 3; }
        bf16* base = (bf16*)(ws + off);
        const int colt = (pn - t0) * BM + wc * 32 + 8 * fq, row0 = u.pm * BM + wr * 64 + fr;
        f32x4 bv[2][2];
#pragma unroll
        for (int bj = 0; bj < 2; ++bj)
#pragma unroll
            for (int n = 0; n < 2; ++n) bv[bj][n] = act >= 2 ? *(const f32x4*)(bbg + (act - 2) * D + colt + bj * HALF + 4 * n) : (f32x4){0.f, 0.f, 0.f, 0.f};
#pragma unroll
        for (int ai = 0; ai < 2; ++ai)
#pragma unroll
            for (int m = 0; m < 4; ++m) { bf16* rowp = base + (size_t)(row0 + ai * HALF + m * 16) * ld + colt;
#pragma unroll
                for (int bj = 0; bj < 2; ++bj) { f32x4 v0 = acc[ai][bj][m][0] + bv[bj][0], v1 = acc[ai][bj][m][1] + bv[bj][1];
                    if (act == 1) {
#pragma unroll
                        for (int j = 0; j < 4; ++j) { v0[j] = v0[j] * sigmoidf_(v0[j]); v1[j] = v1[j] * sigmoidf_(v1[j]); } }
                    else if (act >= 2) {
#pragma unroll
                        for (int j = 0; j < 4; ++j) { v0[j] = sigmoidf_(v0[j]); v1[j] = sigmoidf_(v1[j]); } }
                    if (act == 3 || (pn >= 24 && pn < 36)) {
                        int a8 = 0, b8 = 0; a8 = __builtin_amdgcn_cvt_pk_fp8_f32(v0[0], v0[1], a8, false); a8 = __builtin_amdgcn_cvt_pk_fp8_f32(v0[2], v0[3], a8, true);
                        b8 = __builtin_amdgcn_cvt_pk_fp8_f32(v1[0], v1[1], b8, false); b8 = __builtin_amdgcn_cvt_pk_fp8_f32(v1[2], v1[3], b8, true);
                        *(u32x2*)((unsigned char*)base + (size_t)(row0 + ai * HALF + m * 16) * ld + colt + bj * HALF) = (u32x2){(unsigned)a8, (unsigned)b8}; }
                    else {
                    u32x4 w; w.x = cvt_pk_bf16(v0[0], v0[1]); w.y = cvt_pk_bf16(v0[2], v0[3]); w.z = cvt_pk_bf16(v1[0], v1[1]); w.w = cvt_pk_bf16(v1[2], v1[3]);
                    *(u32x4*)(rowp + bj * HALF) = w; } } }
    }
};
template <int MODE> struct EpiBranch {
    static constexpr bool PERM = true;
    const void* gate; const unsigned char* tin; void* out;
    __device__ __forceinline__ void operator()(const f32x4 (&acc)[2][2][4][2], const Unit& u, int wr, int wc, int fr, int fq) const {
        const int colt = u.pn * BM + wc * 32 + 8 * fq, row0 = u.pm * BM + wr * 64 + fr;
#pragma unroll
        for (int ai = 0; ai < 2; ++ai) {
            u32x4 gq4[4][2]; u32x2 gq2[4][2], tq2[4][2];
#pragma unroll
            for (int m = 0; m < 4; ++m) { const size_t ro = (size_t)(row0 + ai * HALF + m * 16) * D + colt;
#pragma unroll
                for (int bj = 0; bj < 2; ++bj) {
                    if (MODE == 0) gq2[m][bj] = *(const u32x2*)((const unsigned char*)gate + ro + bj * HALF);
                    else { gq4[m][bj] = *(const u32x4*)((const bf16*)gate + ro + bj * HALF); tq2[m][bj] = *(const u32x2*)(tin + ro + bj * HALF); } } }
#pragma unroll
            for (int m = 0; m < 4; ++m) { const size_t ro = (size_t)(row0 + ai * HALF + m * 16) * D + colt;
#pragma unroll
                for (int bj = 0; bj < 2; ++bj) {
                    float r[8], gt[8], tt[8];
#pragma unroll
                    for (int j = 0; j < 4; ++j) { r[j] = acc[ai][bj][m][0][j]; r[4 + j] = acc[ai][bj][m][1][j]; }
                    if (MODE == 0) { const u32x2 gq = gq2[m][bj];
#pragma unroll
                        for (int q = 0; q < 2; ++q) { const f32x2_t lo = __builtin_amdgcn_cvt_pk_f32_fp8((int)gq[q], false), hi = __builtin_amdgcn_cvt_pk_f32_fp8((int)gq[q], true);
                            gt[4 * q] = lo.x; gt[4 * q + 1] = lo.y; gt[4 * q + 2] = hi.x; gt[4 * q + 3] = hi.y; }
                        int a8 = 0, b8 = 0;
                        a8 = __builtin_amdgcn_cvt_pk_fp8_f32(r[0] * gt[0] * 64.f, r[1] * gt[1] * 64.f, a8, false); a8 = __builtin_amdgcn_cvt_pk_fp8_f32(r[2] * gt[2] * 64.f, r[3] * gt[3] * 64.f, a8, true);
                        b8 = __builtin_amdgcn_cvt_pk_fp8_f32(r[4] * gt[4] * 64.f, r[5] * gt[5] * 64.f, b8, false); b8 = __builtin_amdgcn_cvt_pk_fp8_f32(r[6] * gt[6] * 64.f, r[7] * gt[7] * 64.f, b8, true);
                        *(u32x2*)((unsigned char*)out + ro + bj * HALF) = (u32x2){(unsigned)a8, (unsigned)b8}; }
                    else { const u32x4 gq = gq4[m][bj]; const u32x2 tq = tq2[m][bj];
#pragma unroll
                        for (int j = 0; j < 4; ++j) { gt[2 * j] = __uint_as_float(gq[j] << 16); gt[2 * j + 1] = __uint_as_float(gq[j] & 0xffff0000u); }
#pragma unroll
                        for (int q = 0; q < 2; ++q) { const f32x2_t lo = __builtin_amdgcn_cvt_pk_f32_fp8((int)tq[q], false), hi = __builtin_amdgcn_cvt_pk_f32_fp8((int)tq[q], true);
                            tt[4 * q] = lo.x; tt[4 * q + 1] = lo.y; tt[4 * q + 2] = hi.x; tt[4 * q + 3] = hi.y; }
#pragma unroll
                        for (int j = 0; j < 8; ++j) r[j] = fmaf(r[j], gt[j], tt[j] * 0.015625f);
                        u32x4 w; w.x = cvt_pk_bf16(r[0], r[1]); w.y = cvt_pk_bf16(r[2], r[3]); w.z = cvt_pk_bf16(r[4], r[5]); w.w = cvt_pk_bf16(r[6], r[7]);
                        *(u32x4*)((bf16*)out + ro + bj * HALF) = w; } } } }
    }
};
struct EpiResid {
    static constexpr bool PERM = true;
    const float* x; bf16* out;
    __device__ __forceinline__ void operator()(const f32x4 (&acc)[2][2][4][2], const Unit& u, int wr, int wc, int fr, int fq) const {
        const int colt = u.pn * BM + wc * 32 + 8 * fq, row0 = u.pm * BM + wr * 64 + fr;
#pragma unroll
        for (int ai = 0; ai < 2; ++ai)
#pragma unroll
          for (int mp = 0; mp < 4; mp += 2) {
            f32x4 xq[2][2][2];
#pragma unroll
            for (int mm = 0; mm < 2; ++mm) { const size_t ro = (size_t)(row0 + ai * HALF + (mp + mm) * 16) * D + colt;
#pragma unroll
                for (int bj = 0; bj < 2; ++bj) { xq[mm][bj][0] = *(const f32x4*)(x + ro + bj * HALF); xq[mm][bj][1] = *(const f32x4*)(x + ro + bj * HALF + 4); } }
#pragma unroll
            for (int mm = 0; mm < 2; ++mm) { const int m = mp + mm; const size_t ro = (size_t)(row0 + ai * HALF + m * 16) * D + colt;
#pragma unroll
                for (int bj = 0; bj < 2; ++bj) { const f32x4 v0 = xq[mm][bj][0] + acc[ai][bj][m][0], v1 = xq[mm][bj][1] + acc[ai][bj][m][1];
                    u32x4 w; w.x = cvt_pk_bf16(v0[0], v0[1]); w.y = cvt_pk_bf16(v0[2], v0[3]); w.z = cvt_pk_bf16(v1[0], v1[1]); w.w = cvt_pk_bf16(v1[2], v1[3]);
                    *(u32x4*)(out + ro + bj * HALF) = w; } } }
    }
};
struct EpiSwiglu {
    static constexpr bool PERM = true;
    const float* bgate; const float* bup; unsigned char* hd;
    __device__ __forceinline__ void operator()(const f32x4 (&acc)[2][2][4][2], const Unit& u, int wr, int wc, int fr, int fq) const {
        const int col = u.pn * HALF + wc * 32 + 8 * fq; const size_t row0 = (size_t)u.pm * BM + wr * 64 + fr;
        const float* bg = bgate + (size_t)u.e * DFF + col; const float* bu = bup + (size_t)u.e * DFF + col;
        const f32x4 g0 = *(const f32x4*)bg, g1 = *(const f32x4*)(bg + 4), u0 = *(const f32x4*)bu, u1 = *(const f32x4*)(bu + 4);
#pragma unroll
        for (int ai = 0; ai < 2; ++ai)
#pragma unroll
            for (int m = 0; m < 4; ++m) {
                float r[8];
#pragma unroll
                for (int j = 0; j < 4; ++j) {
                    const float ga = fminf(acc[ai][0][m][0][j] + g0[j], 7.f), ua = fminf(fmaxf(acc[ai][1][m][0][j] + u0[j], -7.f), 7.f);
                    const float gb = fminf(acc[ai][0][m][1][j] + g1[j], 7.f), ub = fminf(fmaxf(acc[ai][1][m][1][j] + u1[j], -7.f), 7.f);
                    r[j] = (ua + 1.f) * (ga * sigmoidf_(1.702f * ga)); r[4 + j] = (ub + 1.f) * (gb * sigmoidf_(1.702f * gb)); }
                int w0 = 0, w1 = 0;
                w0 = __builtin_amdgcn_cvt_pk_fp8_f32(r[0], r[1], w0, false); w0 = __builtin_amdgcn_cvt_pk_fp8_f32(r[2], r[3], w0, true);
                w1 = __builtin_amdgcn_cvt_pk_fp8_f32(r[4], r[5], w1, false); w1 = __builtin_amdgcn_cvt_pk_fp8_f32(r[6], r[7], w1, true);
                *(u32x2*)(hd + (row0 + ai * HALF + m * 16) * DFF + col) = (u32x2){(unsigned)w0, (unsigned)w1}; }
    }
};
struct EpiDown {
    static constexpr bool PERM = true;
    const float* bdown; const int* rpair; const float* rw; unsigned char* py;
    __device__ __forceinline__ void operator()(const f32x4 (&acc)[2][2][4][2], const Unit& u, int wr, int wc, int fr, int fq) const {
        const int colt = u.pn * BM + wc * 32 + 8 * fq; const size_t srow0 = (size_t)u.pm * BM + wr * 64 + fr;
        f32x4 bv[2][2];
#pragma unroll
        for (int bj = 0; bj < 2; ++bj)
#pragma unroll
            for (int n = 0; n < 2; ++n) bv[bj][n] = *(const f32x4*)(bdown + (size_t)u.e * D + colt + bj * HALF + 4 * n);
        int pairs[2][4]; float wgts[2][4];
#pragma unroll
        for (int ai = 0; ai < 2; ++ai)
#pragma unroll
            for (int m = 0; m < 4; ++m) { const int rl = wr * 64 + fr + ai * HALF + m * 16; const int pq = rpair[u.trow + rl]; const float wq = rw[u.trow + rl];
                pairs[ai][m] = rl < u.nrow ? pq : S * 4; wgts[ai][m] = rl < u.nrow ? wq : 0.f; }
#pragma unroll
        for (int ai = 0; ai < 2; ++ai)
#pragma unroll
            for (int m = 0; m < 4; ++m) { const int pair = pairs[ai][m]; const float wgt = wgts[ai][m];
                unsigned char* rowp = py + (size_t)pair * D + colt; const float w16 = wgt * 16.f;
#pragma unroll
                for (int bj = 0; bj < 2; ++bj) { const f32x4 v0 = (acc[ai][bj][m][0] + bv[bj][0]) * w16, v1 = (acc[ai][bj][m][1] + bv[bj][1]) * w16;
                    int w0 = 0, w1 = 0;
                    w0 = __builtin_amdgcn_cvt_pk_fp8_f32(v0[0], v0[1], w0, false); w0 = __builtin_amdgcn_cvt_pk_fp8_f32(v0[2], v0[3], w0, true);
                    w1 = __builtin_amdgcn_cvt_pk_fp8_f32(v1[0], v1[1], w1, false); w1 = __builtin_amdgcn_cvt_pk_fp8_f32(v1[2], v1[3], w1, true);
                    *(u32x2*)(rowp + bj * HALF) = (u32x2){(unsigned)w0, (unsigned)w1}; } }
    }
};

struct GlaSched {
    int mode, G, c; unsigned char* ws;
    __device__ __forceinline__ bool next(int i, Unit& u) const {
        if (mode == 3) {
            const int L = i * G + c; int md, l2;
            if (L < 256) { md = 1; l2 = L; } else { const int r = L - 256; const int rr = (r / G) * G + (G - 1 - r % G); if (rr >= 128) return false; md = 0; l2 = rr; }
            const int nh = md == 0 ? l2 : (l2 >> 1), hv = md == 0 ? 0 : (l2 & 1);
            u.pm = nh; u.pn = hv; u.e = md; u.nrow = BM;
            if (md == 0) { u.A = (const char*)(ws + WS_ACAT) + (size_t)nh * 256 * 512 * 2 + 512; u.B = (const char*)(ws + WS_KI) + (size_t)nh * 256 * 256 * 2; }
            else { u.A = (const char*)(ws + WS_BCAT) + (size_t)nh * 512 * 512 * 2 + (size_t)hv * 256 * 512 * 2; u.B = (const char*)(ws + WS_KET) + (size_t)nh * 256 * 256 * 2; }
            return true;
        }
        const int L = i * G + c; const int nu = mode == 0 ? 128 : 256; if (L >= nu) return false;
        const int nh = mode == 0 ? L : (L >> 1), hv = mode == 0 ? 0 : (L & 1);
        u.pm = nh; u.pn = hv; u.e = 0; u.nrow = BM;
        if (mode == 0) { u.A = (const char*)(ws + WS_ACAT) + (size_t)nh * 256 * 512 * 2 + 512; u.B = (const char*)(ws + WS_KI) + (size_t)nh * 256 * 256 * 2; }
        else if (mode == 1) { u.A = (const char*)(ws + WS_BCAT) + (size_t)nh * 512 * 512 * 2 + (size_t)hv * 256 * 512 * 2; u.B = (const char*)(ws + WS_KET) + (size_t)nh * 256 * 256 * 2; }
        else { u.A = (const char*)(ws + WS_ACAT) + (size_t)nh * 256 * 512 * 2; u.B = (const char*)(ws + WS_BCAT) + (size_t)nh * 512 * 512 * 2 + (size_t)hv * 256 * 512 * 2; }
        return true;
    }
};
struct EpiGlaNorm {
    static constexpr bool PERM = true;
    unsigned char* ws; const float* g; unsigned* ctl; LAS float* scr;
    __device__ __forceinline__ void operator()(const f32x4 (&acc)[2][2][4][2], const Unit& u, int wr, int wc, int fr, int fq) const {
        const int nh = u.pm, hv = u.pn, unit = nh * 2 + hv, tid = threadIdx.x;
        LAS float* rowpart = scr; LAS float* rstdv = scr + 1024;
#pragma unroll
        for (int ai = 0; ai < 2; ++ai)
#pragma unroll
            for (int m = 0; m < 4; ++m) { float sq = 0.f;
#pragma unroll
                for (int bj = 0; bj < 2; ++bj)
#pragma unroll
                    for (int n = 0; n < 2; ++n)
#pragma unroll
                        for (int j = 0; j < 4; ++j) sq = fmaf(acc[ai][bj][m][n][j], acc[ai][bj][m][n][j], sq);
                sq += __shfl_xor(sq, 16); sq += __shfl_xor(sq, 32);
                if (fq == 0) rowpart[wc * 256 + wr * 64 + ai * HALF + m * 16 + fr] = sq; }
        asm volatile("s_waitcnt lgkmcnt(0)" ::: "memory"); __builtin_amdgcn_s_barrier();
        float mine = 0.f; float* slot = (float*)(ws + WS_PSLOT);
        if (tid < 256) { mine = rowpart[tid] + rowpart[256 + tid] + rowpart[512 + tid] + rowpart[768 + tid]; __hip_atomic_store(slot + unit * 256 + tid, mine, __ATOMIC_RELAXED, __HIP_MEMORY_SCOPE_AGENT); }
        asm volatile("s_waitcnt vmcnt(0)" ::: "memory"); __builtin_amdgcn_s_barrier();
        if (tid == 0) { unsigned* ctr = ctl + CW_PS + 16 * nh; (void)__hip_atomic_fetch_add(ctr, 1u, __ATOMIC_RELAXED, __HIP_MEMORY_SCOPE_AGENT);
            unsigned sp = 0u; while (__hip_atomic_load(ctr, __ATOMIC_RELAXED, __HIP_MEMORY_SCOPE_AGENT) < 2u) { __builtin_amdgcn_s_sleep(1); if (++sp > (1u << 20)) break; }
            __builtin_amdgcn_fence(__ATOMIC_ACQUIRE, "agent"); asm volatile("s_waitcnt vmcnt(0)" ::: "memory"); }
        __builtin_amdgcn_s_barrier();
        if (tid < 256) { const float other = __hip_atomic_load(slot + (unit ^ 1) * 256 + tid, __ATOMIC_RELAXED, __HIP_MEMORY_SCOPE_AGENT); rstdv[tid] = rsqrtf((mine + other) * (1.f / GLA_DV) + 1e-6f); }
        asm volatile("s_waitcnt vmcnt(0) lgkmcnt(0)" ::: "memory"); __builtin_amdgcn_s_barrier();
        const int c8 = wc * 32 + 8 * fq, colh = hv * 256 + c8; const size_t tok0 = (size_t)(nh >> 2) * 256; const int colg = (nh & 3) * GLA_DV + colh;
        const bf16* GR = (const bf16*)(ws + WS_GR); bf16* YG = (bf16*)(ws + WS_YG);
        float gv[2][8];
#pragma unroll
        for (int bj = 0; bj < 2; ++bj) { const f32x4 a0 = *(const f32x4*)(g + colh + bj * HALF), a1 = *(const f32x4*)(g + colh + bj * HALF + 4);
#pragma unroll
            for (int j = 0; j < 4; ++j) { gv[bj][j] = a0[j]; gv[bj][4 + j] = a1[j]; } }
#pragma unroll
        for (int ai = 0; ai < 2; ++ai) {
            u32x4 rq[4][2];
#pragma unroll
            for (int m = 0; m < 4; ++m)
#pragma unroll
                for (int bj = 0; bj < 2; ++bj) rq[m][bj] = *(const u32x4*)(GR + (tok0 + wr * 64 + ai * HALF + m * 16 + fr) * GLA_V + colg + bj * HALF);
#pragma unroll
            for (int m = 0; m < 4; ++m) { const int row = wr * 64 + ai * HALF + m * 16 + fr; const float rs = rstdv[row];
#pragma unroll
                for (int bj = 0; bj < 2; ++bj) { float y[8];
#pragma unroll
                    for (int j = 0; j < 4; ++j) { y[j] = acc[ai][bj][m][0][j]; y[4 + j] = acc[ai][bj][m][1][j]; }
#pragma unroll
                    for (int j = 0; j < 4; ++j) { const unsigned rw_ = rq[m][bj][j];
                        y[2 * j] = y[2 * j] * rs * gv[bj][2 * j] * __uint_as_float(rw_ << 16); y[2 * j + 1] = y[2 * j + 1] * rs * gv[bj][2 * j + 1] * __uint_as_float(rw_ & 0xffff0000u); }
                    u32x4 w; w.x = cvt_pk_bf16(y[0], y[1]); w.y = cvt_pk_bf16(y[2], y[3]); w.z = cvt_pk_bf16(y[4], y[5]); w.w = cvt_pk_bf16(y[6], y[7]);
                    *(u32x4*)(YG + (tok0 + row) * GLA_V + colg + bj * HALF) = w; } } }
    }
};
template <int MODE> struct EpiGla {
    static constexpr bool PERM = true;
    unsigned char* ws;
    __device__ __forceinline__ void operator()(const f32x4 (&acc)[2][2][4][2], const Unit& u, int wr, int wc, int fr, int fq) const {
        const int nh = u.pm, hv = u.pn; const int c8 = wc * 32 + 8 * fq, r0 = wr * 64 + fr;
        bf16* base; int ld;
        const bool amask = MODE == 0 || (MODE == 3 && u.e == 0);
        if (MODE == 3) { if (u.e == 0) { base = (bf16*)(ws + WS_ACAT) + (size_t)nh * 256 * 512; ld = 512; } else { base = (bf16*)(ws + WS_UT) + (size_t)nh * 512 * 256 + (size_t)hv * 256 * 256; ld = 256; } }
        else if (MODE == 0) { base = (bf16*)(ws + WS_ACAT) + (size_t)nh * 256 * 512; ld = 512; }
        else if (MODE == 1) { base = (bf16*)(ws + WS_UT) + (size_t)nh * 512 * 256 + (size_t)hv * 256 * 256; ld = 256; }
        else { base = (bf16*)(ws + WS_OB) + (size_t)(nh >> 2) * 256 * GLA_V + (nh & 3) * GLA_DV + hv * 256; ld = GLA_V; }
#pragma unroll
        for (int ai = 0; ai < 2; ++ai)
#pragma unroll
            for (int m = 0; m < 4; ++m) { const int row = r0 + ai * HALF + m * 16;
#pragma unroll
                for (int bj = 0; bj < 2; ++bj) { f32x4 v0 = acc[ai][bj][m][0], v1 = acc[ai][bj][m][1]; const int col = bj * HALF + c8;
                    if (amask) {
#pragma unroll
                        for (int j = 0; j < 4; ++j) { v0[j] = (col + j <= row) ? v0[j] : 0.f; v1[j] = (col + 4 + j <= row) ? v1[j] : 0.f; } }
                    u32x4 w; w.x = cvt_pk_bf16(v0[0], v0[1]); w.y = cvt_pk_bf16(v0[2], v0[3]); w.z = cvt_pk_bf16(v1[0], v1[1]); w.w = cvt_pk_bf16(v1[2], v1[3]);
                    *(u32x4*)(base + (size_t)row * ld + col) = w; } }
    }
};
}

constexpr int NWAVES = 8;
#ifndef GEMM_CUS
#define GEMM_CUS 152
#endif
constexpr int RING_BYTES = 131072, CTLZ_OFF = 139264, MISC_OFF = CTLZ_OFF + 320, LDS_BYTES = 147456;
constexpr int TAB_OFF = MISC_OFF + 128;

struct Frame {
    LAS unsigned char* lds; volatile LAS unsigned* MISC; unsigned* ctl; unsigned char* ws;
    int tid, lane, wave, vcu, G;
};
struct Args { const float* in[22]; float* out; unsigned char* ws; int ph_lo, ph_hi, li, pad; };

struct P0Item { const float* src; bf16* dst; int ldn, K; };
constexpr int P0_I_IN = 24 * 256, P0_JIT_A = 2 * pg8::JIT_EARLY * 256, P0_I_BG = 32 * 64, P0_I_BA = 16 * 64, P0_I_OUT = 32 * 64, P0_I_E = 32 * 64;
constexpr int P0_I_SMALL = P0_I_IN + P0_I_BG + P0_I_BA + P0_I_OUT, P0_NITEMS = P0_I_SMALL;
__device__ __forceinline__ P0Item p0_decode(Frame& F, const Args& a, int r) {
    constexpr int I_IN = P0_I_IN, I_BG = P0_I_BG, I_BA = P0_I_BA;
    P0Item it;
    if (r < I_IN) {
        const int p = r >> 8, j = (p & 1) * 12 + (p >> 1), T = j, nb = 8 * T + (r & 7), kb = (r >> 3) & 31, d0 = nb * 32, s0 = d0 < C_GLR ? d0 : d0 + 16;
        it.src = a.in[2] + (size_t)kb * 64 * IN_COLS + s0; it.ldn = IN_COLS; it.dst = (bf16*)(F.ws + WS_WIN) + (size_t)d0 * D + kb * 64; it.K = D; return it; } r -= I_IN;
    if (r < I_BG) { const int nb = r % 64, kb = r / 64; it.src = a.in[10] + (size_t)kb * 64 * D + nb * 32; it.ldn = D; it.dst = (bf16*)(F.ws + WS_WBG) + (size_t)nb * 32 * GLA_V + kb * 64; it.K = GLA_V; return it; } r -= I_BG;
    if (r < I_BA) { const int nb = r % 64, kb = r / 64; it.src = a.in[11] + (size_t)kb * 64 * D + nb * 32; it.ldn = D; it.dst = (bf16*)(F.ws + WS_WBA) + (size_t)nb * 32 * ATT_W + kb * 64; it.K = ATT_W; return it; } r -= I_BA;
    { const int nb = r % 64, kb = r / 64; it.src = a.in[12] + (size_t)kb * 64 * D + nb * 32; it.ldn = D; it.dst = (bf16*)(F.ws + WS_WOUT) + (size_t)nb * 32 * D + kb * 64; it.K = D; }
    return it;
}
__device__ __forceinline__ void p0_load(const P0Item& it, int lane, f32x4 (&v)[8]) {
    const float* p = it.src + (size_t)(lane >> 3) * it.ldn + 4 * (lane & 7);
#pragma unroll
    for (int i = 0; i < 8; ++i) v[i] = __builtin_nontemporal_load((const GAS f32x4*)(p + (size_t)(8 * i) * it.ldn));
}
__device__ __forceinline__ void p0_convert(Frame& F, const Args& a, int it_lo, int it_hi, int gw, int NGW) {
    LAS float* scr = (LAS float*)(F.lds + F.wave * 16384);
    const int lane = F.lane;
    int itx = it_lo + gw;
    if (itx >= it_hi) return;
    P0Item cur = p0_decode(F, a, itx);
    f32x4 v[8]; p0_load(cur, lane, v);
    for (;;) {
        const int nx = itx + NGW; const bool more = nx < it_hi;
        P0Item nxt = cur; f32x4 vn[8];
        if (more) { nxt = p0_decode(F, a, nx); p0_load(nxt, lane, vn); }
#pragma unroll
        for (int i = 0; i < 8; ++i) { LAS float* q = scr + (8 * i + (lane >> 3)) * 33 + 4 * (lane & 7); q[0] = v[i].x; q[1] = v[i].y; q[2] = v[i].z; q[3] = v[i].w; }
        LDS_WAIT(); asm volatile("" ::: "memory");
        const int c = lane & 7;
#pragma unroll
        for (int j = 0; j < 4; ++j) { const int n = (lane >> 3) + 8 * j; const LAS float* sp = scr + (8 * c) * 33 + n;
            u32x4 o; o.x = pk2(sp[0 * 33], sp[1 * 33]); o.y = pk2(sp[2 * 33], sp[3 * 33]); o.z = pk2(sp[4 * 33], sp[5 * 33]); o.w = pk2(sp[6 * 33], sp[7 * 33]);
            __builtin_nontemporal_store(o, (GAS u32x4*)(cur.dst + (size_t)n * cur.K + 8 * c)); }
        LDS_WAIT(); asm volatile("" ::: "memory");
        if (!more) break;
        itx = nx; cur = nxt;
#pragma unroll
        for (int i = 0; i < 8; ++i) v[i] = vn[i];
    }
}
constexpr int P8_NITEMS = 3 * NE * 16 * 64, P8_ALL = P8_NITEMS + 16 * 224, P8_BA = 8 * 64, P8_END = P8_ALL + P8_BA;
__device__ __forceinline__ void p0_item8(Frame& F, const Args& a, const int it) {
    LAS unsigned char* tile = F.lds + F.wave * 16384;
    const int lane = F.lane, kq = lane >> 3, n4 = lane & 7;
    {
        const int which = it / (NE * 1024), e = (it >> 10) & 31, kb = (it >> 6) & 15, nb = it & 63, k0 = kb * 128, n0 = nb * 32;
        const float* src; unsigned char* dst; int ldn, dpitch = 2048;
        if (it >= P8_ALL) { const int r = it - P8_ALL, kb2 = r >> 6, nb2 = r & 63; src = a.in[11] + (size_t)(kb2 * 128) * D + nb2 * 32; ldn = D; dst = F.ws + WS_WBA8 + (size_t)(nb2 * 32) * ATT_W + kb2 * 128; dpitch = ATT_W; }
        else if (it >= P8_NITEMS) { const int r = it - P8_NITEMS, kb2 = r / 224, nb2 = r - kb2 * 224, d0 = 6144 + 32 * nb2; src = a.in[2] + (size_t)(kb2 * 128) * IN_COLS + d0 + 16; ldn = IN_COLS; dst = F.ws + WS_WIN8 + (size_t)(nb2 * 32) * D + kb2 * 128; }
        else if (which < 2) { src = (which ? a.in[18] : a.in[16]) + (size_t)e * D * DFF + (size_t)k0 * DFF + n0; ldn = DFF;
            dst = F.ws + WS_GU + (size_t)e * 2 * DFF * D + (size_t)((n0 >> 7) * 256 + (n0 & 127) + which * 128) * D + k0; }
        else { src = a.in[20] + (size_t)e * DFF * D + (size_t)k0 * D + n0; ldn = D; dst = F.ws + WS_DN + (size_t)e * D * DFF + (size_t)n0 * DFF + k0; }
        const float* p = src + (size_t)(4 * kq) * ldn + 4 * n4;
        f32x4 v[4][4];
#pragma unroll
        for (int ps = 0; ps < 4; ++ps)
#pragma unroll
            for (int i = 0; i < 4; ++i) v[ps][i] = __builtin_nontemporal_load((const GAS f32x4*)(p + (size_t)(32 * ps + i) * ldn));
#pragma unroll
        for (int ps = 0; ps < 4; ++ps)
#pragma unroll
            for (int c = 0; c < 4; ++c) { int w = 0;
                w = __builtin_amdgcn_cvt_pk_fp8_f32(v[ps][0][c] * 32.f, v[ps][1][c] * 32.f, w, false); w = __builtin_amdgcn_cvt_pk_fp8_f32(v[ps][2][c] * 32.f, v[ps][3][c] * 32.f, w, true);
                *(LAS int*)(tile + (4 * n4 + c) * 144 + 32 * ps + 4 * kq) = w; }
        LDS_WAIT(); asm volatile("" ::: "memory");
#pragma unroll
        for (int j = 0; j < 4; ++j) { const int n = (lane >> 3) + 8 * j, c16 = lane & 7; const u32x4 g = *(const LAS u32x4*)(tile + n * 144 + 16 * c16);
            __builtin_nontemporal_store(g, (GAS u32x4*)(dst + (size_t)n * dpitch + 16 * c16)); }
        LDS_WAIT(); asm volatile("" ::: "memory");
    }
}
__device__ __forceinline__ void p0_convert8(Frame& F, const Args& a, int it_lo, int it_hi, int gw, int NGW) {
    for (int it = it_lo + gw; it < it_hi; it += NGW) p0_item8(F, a, it);
}
__device__ __forceinline__ void p0_convert8_queue(Frame& F, const Args& a, unsigned* qbase, int nitems) {
    const int per = nitems / 8, x0 = (int)(xb_xcc_id() & 7u);
    for (int dq = 0; dq < 8; ++dq) {
        const int x = (x0 + dq) & 7, base = x * per; unsigned* q = qbase + 64 * x;
        unsigned tk = 0u; if (F.lane == 0) tk = __hip_atomic_fetch_add(q, 1u, __ATOMIC_RELAXED, __HIP_MEMORY_SCOPE_AGENT);
        int t = __builtin_amdgcn_readfirstlane((int)tk);
        while (2 * t < per) {
            tk = 0u; if (F.lane == 0) tk = __hip_atomic_fetch_add(q, 1u, __ATOMIC_RELAXED, __HIP_MEMORY_SCOPE_AGENT);
            p0_item8(F, a, base + 2 * t); p0_item8(F, a, base + 2 * t + 1);
            t = __builtin_amdgcn_readfirstlane((int)tk);
        }
    }
}
__device__ __forceinline__ void jit_publish(unsigned* flag, int wave, int lane) {
    asm volatile("s_waitcnt vmcnt(0)" ::: "memory");
    __syncthreads();
    if (wave == 0) {
        __builtin_amdgcn_fence(__ATOMIC_RELEASE, "agent");
        asm volatile("s_waitcnt vmcnt(0)" ::: "memory");
        if (lane == 0) (void)__hip_atomic_fetch_add(flag, 1u, __ATOMIC_RELAXED, __HIP_MEMORY_SCOPE_AGENT);
    }
}
__device__ __forceinline__ void p0_rows(Frame& F, const Args& a) {
    { const float* g2 = a.in[13]; const float* wr = a.in[14]; float* WR = (float*)(F.ws + WS_WR);
      for (int i = (F.vcu * NWAVES * 64) + F.tid; i < D * NE; i += F.G * NWAVES * 64) WR[i] = g2[i >> 5] * wr[i]; }
}

template <int MODE> __device__ __forceinline__ void normproj_unit(Frame& F, const Args& a, int tile) {
    const int w = F.wave, lane = F.lane, tid = F.tid, i = lane & 31, kk = lane >> 5, t0 = tile * 32;
    const float* X = MODE == 0 ? a.in[0] : (const float*)(F.ws + WS_H1); const float* g = MODE == 0 ? a.in[1] : a.in[13];
    const float* WR = (const float*)(F.ws + WS_WR); const float* br = a.in[15]; const float* w_in = a.in[2];
    LAS float* part = (LAS float*)F.lds;
    LAS float* ssq = part + 8192;
    LAS float* lg = ssq + 256;
    LAS float* rs = lg + 32 * 33;
    LAS unsigned* lcnt = (LAS unsigned*)(rs + 32); LAS unsigned* lbase = lcnt + 32; LAS unsigned* prec = lbase + 32; LAS float* pwgt = (LAS float*)(prec + 128);
    __syncthreads();
    if (MODE == 1 && tid < NE) lcnt[tid] = 0u;
    f32x16 acc;
#pragma unroll
    for (int r = 0; r < 16; ++r) acc[r] = 0.f;
    float ss = 0.f;
    const int kbase = 256 * w + 128 * kk;
    const float* arow = X + (size_t)(t0 + i) * D + kbase;
    const bf16* Xb = (const bf16*)(F.ws + WS_H1); const bf16* arowb = Xb + (size_t)(t0 + i) * D + kbase;
    LAS float* Bl = (LAS float*)(F.lds + 65536 + 8192 * w);
    constexpr int NB = MODE == 1 ? 8 : 4;
    if (MODE == 0) { for (int z = lane; z < 1024; z += 64) Bl[(z >> 4) * 32 + 16 + (z & 15)] = 0.f; }
    f32x4 av[8], bv[NB];
#define NP_LOADA(c_, d_) do { _Pragma("unroll") for (int q = 0; q < 8; ++q) d_[q] = *(const GAS f32x4*)(arow + 32 * (c_) + 4 * q); } while (0)
#define NP_LOADA_RAW(c_, d_) do { _Pragma("unroll") for (int q = 0; q < 4; ++q) d_[q] = *(const GAS u32x4*)(arowb + 32 * (c_) + 8 * q); } while (0)
#define NP_UNPACK(r_, d_) do { _Pragma("unroll") for (int q = 0; q < 4; ++q) { \
        d_[2 * q] = (f32x4){__uint_as_float(r_[q].x << 16), __uint_as_float(r_[q].x & 0xffff0000u), __uint_as_float(r_[q].y << 16), __uint_as_float(r_[q].y & 0xffff0000u)}; \
        d_[2 * q + 1] = (f32x4){__uint_as_float(r_[q].z << 16), __uint_as_float(r_[q].z & 0xffff0000u), __uint_as_float(r_[q].w << 16), __uint_as_float(r_[q].w & 0xffff0000u)}; } } while (0)
#define NP_LOADB(c_, d_) do { _Pragma("unroll") for (int r = 0; r < NB; ++r) { const int idx = lane + 64 * r; \
        if (MODE == 1) { const int kkr = idx >> 8, rem = idx & 255, s_ = rem >> 3, f4 = rem & 7; d_[r] = *(const GAS f32x4*)(WR + (size_t)(256 * w + 128 * kkr + 32 * (c_) + s_) * NE + 4 * f4); } \
        else { const int kkr = idx >> 7, rem = idx & 127, s_ = rem >> 2, f4 = rem & 3, k_ = 256 * w + 128 * kkr + 32 * (c_) + s_; d_[r] = *(const GAS f32x4*)(w_in + (size_t)k_ * IN_COLS + C_GLR + 4 * f4) * g[k_]; } } } while (0)
#define NP_STOREB(d_) do { _Pragma("unroll") for (int r = 0; r < NB; ++r) { const int idx = lane + 64 * r; \
        if (MODE == 1) { const int kkr = idx >> 8, rem = idx & 255, s_ = rem >> 3, f4 = rem & 7; *(LAS f32x4*)(Bl + (kkr * 32 + s_) * 32 + 4 * f4) = d_[r]; } \
        else { const int kkr = idx >> 7, rem = idx & 127, s_ = rem >> 2, f4 = rem & 3; *(LAS f32x4*)(Bl + (kkr * 32 + s_) * 32 + 4 * f4) = d_[r]; } } } while (0)
    if (MODE == 0) NP_LOADA(0, av); else { u32x4 ar0[4]; NP_LOADA_RAW(0, ar0); NP_UNPACK(ar0, av); }
    NP_LOADB(0, bv); NP_STOREB(bv);
#pragma unroll 1
    for (int c = 0; c < 4; ++c) {
        f32x4 avn[8], bvn[NB]; u32x4 arn[4];
        if (c < 3) { if (MODE == 0) NP_LOADA(c + 1, avn); else NP_LOADA_RAW(c + 1, arn); NP_LOADB(c + 1, bvn); }
        float bq[32];
#pragma unroll
        for (int s_ = 0; s_ < 32; ++s_) bq[s_] = Bl[(kk * 32 + s_) * 32 + i];
#pragma unroll
        for (int q = 0; q < 8; ++q)
#pragma unroll
            for (int j = 0; j < 4; ++j) { acc = __builtin_amdgcn_mfma_f32_32x32x2f32(av[q][j], bq[4 * q + j], acc, 0, 0, 0); ss = fmaf(av[q][j], av[q][j], ss); }
        if (c < 3) { NP_STOREB(bvn);
            if (MODE == 0) {
#pragma unroll
                for (int q = 0; q < 8; ++q) av[q] = avn[q]; }
            else NP_UNPACK(arn, av); }
    }
#undef NP_LOADA
#undef NP_LOADA_RAW
#undef NP_UNPACK
#undef NP_LOADB
#undef NP_STOREB
    ss += __shfl_xor(ss, 32);
    if (kk == 0) ssq[w * 32 + i] = ss;
#pragma unroll
    for (int r = 0; r < 16; ++r) part[(w * 32 + (r & 3) + 8 * (r >> 2) + 4 * kk) * 32 + i] = acc[r];
    __syncthreads();
#pragma unroll
    for (int rep = 0; rep < 2; ++rep) { const int idx = tid + 512 * rep, tok = idx >> 5, e = idx & 31; float sum = 0.f, st = 0.f;
#pragma unroll
        for (int ww = 0; ww < 8; ++ww) { sum += part[(ww * 32 + tok) * 32 + e]; st += ssq[ww * 32 + tok]; }
        const float rstd = rsqrtf(st * (1.f / D) + 1e-6f);
        if (MODE == 0) { if (e < 16) ((float*)(F.ws + WS_GLR))[(size_t)(t0 + tok) * 16 + e] = sum * rstd; }
        else lg[tok * 33 + e] = sum * rstd + br[e];
        if (e == 0) rs[tok] = rstd; }
    __syncthreads();
    bf16* HN = (bf16*)(F.ws + (MODE == 0 ? WS_XN : WS_HN)); float* topw = (float*)(F.ws + WS_TOPW); int* tope = (int*)(F.ws + WS_TOPE); int* tops = (int*)(F.ws + WS_TOPS);
    unsigned* cnt = F.ctl + CW_CNT;
    {
        constexpr int NBT = MODE == 0 ? 2 : 4;
        f32x4 gg[8];
#pragma unroll
        for (int j = 0; j < 8; ++j) gg[j] = *((const GAS f32x4*)g + lane + 64 * j);
#pragma unroll 1
        for (int qb = 0; qb < 4; qb += NBT) {
            f32x4 xr[MODE == 0 ? NBT : 1][8]; u32x2 xb[MODE == 1 ? NBT : 1][8];
#pragma unroll
            for (int k = 0; k < NBT; ++k) { const int t = t0 + 4 * w + qb + k;
#pragma unroll
                for (int j = 0; j < 8; ++j) { if (MODE == 0) xr[k][j] = ((const GAS f32x4*)(X + (size_t)t * D))[lane + 64 * j]; else xb[k][j] = ((const GAS u32x2*)(Xb + (size_t)t * D))[lane + 64 * j]; } }
#pragma unroll
            for (int k = 0; k < NBT; ++k) { const int tok = 4 * w + qb + k, t = t0 + tok; const float rstd = rs[tok];
                GAS u32x2* o8 = (GAS u32x2*)(HN + (size_t)t * D) + lane;
#pragma unroll
                for (int j = 0; j < 8; ++j) { f32x4 xv;
                    if (MODE == 0) xv = xr[k][j]; else { const u32x2 xw = xb[k][j]; xv = (f32x4){__uint_as_float(xw.x << 16), __uint_as_float(xw.x & 0xffff0000u), __uint_as_float(xw.y << 16), __uint_as_float(xw.y & 0xffff0000u)}; }
                    const f32x4 y = xv * rstd * gg[j];
                    if (MODE == 0) { u32x2 wv; wv.x = pk2(y.x, y.y); wv.y = pk2(y.z, y.w); o8[64 * j] = wv;
                        int w8 = 0; w8 = __builtin_amdgcn_cvt_pk_fp8_f32(y.x, y.y, w8, false); w8 = __builtin_amdgcn_cvt_pk_fp8_f32(y.z, y.w, w8, true); ((GAS int*)(F.ws + WS_XN8 + (size_t)t * D))[lane + 64 * j] = w8; }
                    else { int w8 = 0; w8 = __builtin_amdgcn_cvt_pk_fp8_f32(y.x, y.y, w8, false); w8 = __builtin_amdgcn_cvt_pk_fp8_f32(y.z, y.w, w8, true); ((GAS int*)((unsigned char*)HN + (size_t)t * D))[lane + 64 * j] = w8; } } }
        }
    }
#pragma unroll 1
    for (int q = 0; q < 4; ++q) {
        const int tok = 4 * w + q, t = t0 + tok, e = lane & 31;
        if (MODE == 1) {
        float vals[4]; int idxs[4]; float cur = lg[tok * 33 + e];
#pragma unroll
        for (int r = 0; r < 4; ++r) {
            float bv = cur; int bi = e;
#pragma unroll
            for (int o = 1; o < 32; o <<= 1) { const float ov = __shfl_xor(bv, o); const int oi = __shfl_xor(bi, o); if (ov > bv || (ov == bv && oi < bi)) { bv = ov; bi = oi; } }
            vals[r] = bv; idxs[r] = bi;
            if (e == bi) cur = -3.0e38f;
        }
        float ex[4], sum = 0.f;
#pragma unroll
        for (int r = 0; r < 4; ++r) { ex[r] = __expf(vals[r] - vals[0]); sum += ex[r]; }
#pragma unroll
        for (int r = 0; r < 4; ++r) {
            if (lane == r) { const int ee = idxs[r]; const unsigned lr = __hip_atomic_fetch_add(&lcnt[ee], 1u, __ATOMIC_RELAXED, __HIP_MEMORY_SCOPE_WORKGROUP);
                const float wv_ = ex[r] / sum; topw[t * 4 + r] = wv_; tope[t * 4 + r] = ee; prec[tok * 4 + r] = (ee << 16) | lr; pwgt[tok * 4 + r] = wv_; }
        }
        }
    }
    if (MODE == 1) {
        __syncthreads();
        if (tid < NE) { const unsigned c = lcnt[tid]; lbase[tid] = c ? atomicAdd(&cnt[64 * tid], c) : 0u; }
        __syncthreads();
        if (tid < 128) { const unsigned pr = prec[tid]; const int slot = (int)(lbase[pr >> 16] + (pr & 0xffffu)); tops[(t0 * 4) + tid] = slot;
            ((int*)(F.ws + WS_SMAP))[(pr >> 16) * 8192 + slot] = t0 * 4 + tid; ((float*)(F.ws + WS_WMAP))[(pr >> 16) * 8192 + slot] = pwgt[tid]; }
        __syncthreads();
        if (tid < NE) lcnt[tid] = 0u;
    }
    __syncthreads();
}
__device__ __forceinline__ void moe_table(Frame& F) {
    volatile LAS int* ts = (volatile LAS int*)(F.lds + TAB_OFF); volatile LAS int* cn = (volatile LAS int*)(F.lds + TAB_OFF + 256);
    __syncthreads();
    if (F.tid < 64) {
        const int e = F.tid & 31; const int c = (int)__hip_atomic_load(F.ctl + CW_CNT + 64 * e, __ATOMIC_RELAXED, __HIP_MEMORY_SCOPE_AGENT);
        int incl = (c + 255) >> 8; const int mine = incl;
#pragma unroll
        for (int o = 1; o < 32; o <<= 1) { const int up = __shfl_up(incl, o, 32); if (e >= o) incl += up; }
        if (F.tid < 32) { cn[e] = c; ts[e] = incl - mine; if (e == 31) ts[NE] = incl; } }
    __syncthreads();
}
__device__ __forceinline__ void p7_gather(Frame& F) {
    const int gw = F.vcu * NWAVES + F.wave, NGW = F.G * NWAVES, lane = F.lane;
    volatile LAS int* ts = (volatile LAS int*)(F.lds + TAB_OFF);
    const float* topw = (const float*)(F.ws + WS_TOPW); const int* tope = (const int*)(F.ws + WS_TOPE); const int* tops = (const int*)(F.ws + WS_TOPS);
    int* rpair = (int*)(F.ws + WS_RPAIR); float* rw = (float*)(F.ws + WS_RW);
    { volatile LAS int* cn = (volatile LAS int*)(F.lds + TAB_OFF + 256);
      for (int e = gw; e < NE; e += NGW) { const int c = cn[e], base = ts[e] * 256, padn = ((c + 255) & ~255) - c;
          for (int r = lane; r < padn; r += 64) { rpair[base + c + r] = S * 4; rw[base + c + r] = 0.f; } } }
    for (int p = F.vcu * (NWAVES * 64) + F.tid; p < S * 4; p += F.G * NWAVES * 64) { const int dst = ts[tope[p]] * 256 + tops[p]; rpair[dst] = p; rw[dst] = topw[p]; }
}
__device__ __forceinline__ void p10_combine(Frame& F, const Args& a) {
    const int gw = F.vcu * NWAVES + F.wave, NGW = F.G * NWAVES, lane = F.lane;
    const unsigned char* PY = F.ws + WS_PY; float* out = a.out; const bf16* H1 = (const bf16*)(F.ws + WS_H1);
    for (int t = gw; t < S; t += NGW) {
        u32x4 hv[4]; u32x2 pv[4][4];
#pragma unroll
        for (int j = 0; j < 4; ++j) { hv[j] = *(const GAS u32x4*)(H1 + (size_t)t * D + 512 * j + 8 * lane);
#pragma unroll
            for (int k = 0; k < 4; ++k) pv[j][k] = *(const GAS u32x2*)(PY + (size_t)(t * 4 + k) * D + 512 * j + 8 * lane); }
#pragma unroll
        for (int j = 0; j < 4; ++j) {
            float r[8];
#pragma unroll
            for (int q = 0; q < 4; ++q) { r[2 * q] = __uint_as_float(hv[j][q] << 16); r[2 * q + 1] = __uint_as_float(hv[j][q] & 0xffff0000u); }
            float ps[8] = {0.f, 0.f, 0.f, 0.f, 0.f, 0.f, 0.f, 0.f};
#pragma unroll
            for (int k = 0; k < 4; ++k) { const u32x2 p = pv[j][k];
#pragma unroll
                for (int q = 0; q < 2; ++q) { const f32x2_t lo = __builtin_amdgcn_cvt_pk_f32_fp8((int)p[q], false), hi = __builtin_amdgcn_cvt_pk_f32_fp8((int)p[q], true);
                    ps[4 * q] += lo.x; ps[4 * q + 1] += lo.y; ps[4 * q + 2] += hi.x; ps[4 * q + 3] += hi.y; } }
#pragma unroll
            for (int q = 0; q < 8; ++q) r[q] = fmaf(ps[q], 0.0625f, r[q]);
            *(GAS f32x4*)(out + (size_t)t * D + 512 * j + 8 * lane) = (f32x4){r[0], r[1], r[2], r[3]};
            *(GAS f32x4*)(out + (size_t)t * D + 512 * j + 8 * lane + 4) = (f32x4){r[4], r[5], r[6], r[7]};
        }
    }
}


constexpr float ATT_QSCALE = 0.08838834764831845f * 1.4426950408889634f;
__device__ __forceinline__ void attn_prep_unit(Frame& F, const Args& a, int n, int h) {
    const int wave = F.wave, lane = F.lane, tid = F.tid;
    LAS bf16* kst = (LAS bf16*)(F.lds);
    LAS bf16* vst = (LAS bf16*)(F.lds + 16384);
    const bf16* AQ = (const bf16*)(F.ws + WS_AQ); const bf16* AK = (const bf16*)(F.ws + WS_AK); const bf16* AV = (const bf16*)(F.ws + WS_AV);
    const float* kg = a.in[7];
    const float gk0 = kg[2 * lane], gk1 = kg[2 * lane + 1];
    unsigned kraw[8], vraw[8];
#pragma unroll
    for (int i = 0; i < 8; ++i) { const size_t off = (size_t)(n * 64 + wave * 8 + i) * ATT_W + h * ATT_HD + 2 * lane;
        kraw[i] = *(const unsigned short*)((const unsigned char*)AK + off); vraw[i] = *(const unsigned short*)((const unsigned char*)AV + off); }
#pragma unroll
    for (int i = 0; i < 8; ++i) {
        const int row = n * 64 + wave * 8 + i; const size_t off = (size_t)row * ATT_W + h * ATT_HD + 2 * lane;
        const unsigned kv = kraw[i], v8 = vraw[i];
        const f32x2_t kf = __builtin_amdgcn_cvt_pk_f32_fp8((int)kv, false), vf = __builtin_amdgcn_cvt_pk_f32_fp8((int)v8, false);
        const float k0 = kf.x, k1 = kf.y; const unsigned vv = pk2(vf.x, vf.y);
        const float rk = rsqrtf(wave_sum(k0 * k0 + k1 * k1) * (1.f / 128.f) + 1e-6f);
        *(LAS unsigned*)(kst + (wave * 8 + i) * 128 + 2 * lane) = pk2(k0 * rk * gk0, k1 * rk * gk1);
        *(LAS unsigned*)(vst + (wave * 8 + i) * 128 + 2 * lane) = vv;
    }
    __syncthreads();
    bf16* KI = (bf16*)(F.ws + WS_KIMG) + (size_t)(n * ATT_H + h) * 8192; bf16* VI = (bf16*)(F.ws + WS_VIMG) + (size_t)(n * ATT_H + h) * 8192;
#pragma unroll
    for (int i = 0; i < 2; ++i) {
        const int g = tid + 512 * i;
        { const int c16 = g >> 6, key = g & 63; const u32x4 v = *(const LAS u32x4*)(kst + key * 128 + c16 * 8); *(u32x4*)(KI + (size_t)g * 8) = v; }
        { const int kg8 = g >> 7, d = g & 127; unsigned short e[8];
#pragma unroll
          for (int j = 0; j < 8; ++j) e[j] = vst[(kg8 * 8 + j) * 128 + d];
          u32x4 v; v.x = e[0] | ((unsigned)e[1] << 16); v.y = e[2] | ((unsigned)e[3] << 16); v.z = e[4] | ((unsigned)e[5] << 16); v.w = e[6] | ((unsigned)e[7] << 16);
          *(u32x4*)(VI + (size_t)g * 8) = v; }
    }
    __syncthreads();
}

__device__ __forceinline__ int crow(int r, int hi) { return (r & 3) + 8 * (r >> 2) + 4 * hi; }
__device__ __forceinline__ void attn_unit(Frame& F, const Args& a, int n4, int h) {
    const int w = F.wave, lane = F.lane, r32 = lane & 31, hi = lane >> 5, tid = F.tid;
    const int p = w >> 1, half = w & 1, c = 4 * n4 + p, qrow0 = c * 64 + 32 * half;
    LAS unsigned char* lds = F.lds;
    LAS float* btab = (LAS float*)(lds + 65536); LAS float* xch = (LAS float*)(lds + 67584 + 256 * w); LAS bf16* ost = (LAS bf16*)(lds + 8192 * w);
    const float* relb = a.in[8] + h * 257;
    if (tid < 257) btab[tid] = relb[tid] * 1.4426950408889634f;
    LAS unsigned char* qimg = lds + 69632 + 8192 * w;
    {
        const unsigned char* AQ8 = F.ws + WS_AQ + (size_t)(qrow0 + r32) * ATT_W + h * ATT_HD + hi * 8; const float* qg = a.in[6] + hi * 8;
        u32x2 qr[8];
#pragma unroll
        for (int d0 = 0; d0 < 8; ++d0) qr[d0] = *(const u32x2*)(AQ8 + d0 * 16);
        float qf[8][8]; float ssq_ = 0.f;
#pragma unroll
        for (int d0 = 0; d0 < 8; ++d0)
#pragma unroll
            for (int q2 = 0; q2 < 2; ++q2) { const f32x2_t lo = __builtin_amdgcn_cvt_pk_f32_fp8((int)qr[d0][q2], false), hh = __builtin_amdgcn_cvt_pk_f32_fp8((int)qr[d0][q2], true);
                qf[d0][4 * q2] = lo.x; qf[d0][4 * q2 + 1] = lo.y; qf[d0][4 * q2 + 2] = hh.x; qf[d0][4 * q2 + 3] = hh.y;
                ssq_ += lo.x * lo.x + lo.y * lo.y + hh.x * hh.x + hh.y * hh.y; }
        ssq_ += __shfl_xor(ssq_, 32);
        const float rq = rsqrtf(ssq_ * (1.f / 128.f) + 1e-6f) * ATT_QSCALE;
#pragma unroll
        for (int d0 = 0; d0 < 8; ++d0) { const f32x4 g0 = *(const f32x4*)(qg + d0 * 16), g1 = *(const f32x4*)(qg + d0 * 16 + 4);
            u32x4 wq; wq.x = pk2(qf[d0][0] * rq * g0.x, qf[d0][1] * rq * g0.y); wq.y = pk2(qf[d0][2] * rq * g0.z, qf[d0][3] * rq * g0.w);
            wq.z = pk2(qf[d0][4] * rq * g1.x, qf[d0][5] * rq * g1.y); wq.w = pk2(qf[d0][6] * rq * g1.z, qf[d0][7] * rq * g1.w);
            *(LAS u32x4*)(qimg + ((2 * d0 + hi) * 32 + r32) * 16) = wq; }
    }
    const char* KIMG = (const char*)(F.ws + WS_KIMG); const char* VIMG = (const char*)(F.ws + WS_VIMG);
    f32x16 o[4];
#pragma unroll
    for (int dt = 0; dt < 4; ++dt)
#pragma unroll
        for (int r = 0; r < 16; ++r) o[dt][r] = 0.f;
    float m = -1.0e30f, l = 0.f;
    const int s0 = (4 * n4 - 8 < 0) ? (8 - 4 * n4) : 0;
#define ATT_STAGE(s_) do { const int kc_ = 4 * n4 - 8 + (s_); const size_t gb_ = (size_t)(kc_ * ATT_H + h) * 16384; const unsigned lb_ = ((s_) & 1) * 32768; \
        _Pragma("unroll") for (int i_ = 0; i_ < 2; ++i_) { const int pc_ = w + 8 * i_; \
            __builtin_amdgcn_global_load_lds((const unsigned*)(KIMG + gb_ + pc_ * 1024 + lane * 16), (LAS unsigned*)(lds + lb_ + pc_ * 1024), 16, 0, 0); \
            __builtin_amdgcn_global_load_lds((const unsigned*)(VIMG + gb_ + pc_ * 1024 + lane * 16), (LAS unsigned*)(lds + lb_ + 16384 + pc_ * 1024), 16, 0, 0); } } while (0)
    ATT_STAGE(s0);
    for (int s = s0; s < 12; ++s) {
        asm volatile("s_waitcnt vmcnt(0) lgkmcnt(0)" ::: "memory");
        __builtin_amdgcn_s_barrier();
        if (s + 1 < 12) ATT_STAGE(s + 1);
        if (s >= p && s <= p + 8) {
            const LAS unsigned char* kb = lds + (s & 1) * 32768; const LAS unsigned char* vb = kb + 16384;
            f32x16 p0, p1;
#pragma unroll
            for (int r = 0; r < 16; ++r) { p0[r] = 0.f; p1[r] = 0.f; }
#pragma unroll
            for (int d0 = 0; d0 < 8; ++d0) {
                const bf16x8 k0 = *(const LAS bf16x8*)(kb + (2 * d0 + hi) * 1024 + r32 * 16), k1 = *(const LAS bf16x8*)(kb + (2 * d0 + hi) * 1024 + (r32 + 32) * 16);
                const bf16x8 qv = *(const LAS bf16x8*)(qimg + ((2 * d0 + hi) * 32 + r32) * 16);
                p0 = __builtin_amdgcn_mfma_f32_32x32x16_bf16(k0, qv, p0, 0, 0, 0);
                p1 = __builtin_amdgcn_mfma_f32_32x32x16_bf16(k1, qv, p1, 0, 0, 0);
                if (d0 & 1) __builtin_amdgcn_sched_barrier(0);
            }
            const int wrel = p + 8 - s;
            if (wrel >= 3) { const float bc = btab[256];
#pragma unroll
                for (int r = 0; r < 16; ++r) { p0[r] += bc; p1[r] += bc; } }
            else { const int base = 64 * wrel + 32 * half + r32 + 128;
#pragma unroll
                for (int r = 0; r < 16; ++r) { int i0 = base - crow(r, hi), i1 = i0 - 32; i0 = i0 > 256 ? 256 : i0; i1 = i1 > 256 ? 256 : i1; i1 = i1 < 0 ? 0 : i1; i0 = i0 < 0 ? 0 : i0; p0[r] += btab[i0]; p1[r] += btab[i1]; } }
            float mx = p0[0];
#pragma unroll
            for (int r = 1; r < 16; ++r) mx = fmaxf(mx, p0[r]);
#pragma unroll
            for (int r = 0; r < 16; ++r) mx = fmaxf(mx, p1[r]);
            mx = fmaxf(mx, __shfl_xor(mx, 32));
            const float mn = fmaxf(m, mx), alpha = __builtin_amdgcn_exp2f(m - mn);
            float ps = 0.f;
#pragma unroll
            for (int r = 0; r < 16; ++r) { p0[r] = __builtin_amdgcn_exp2f(p0[r] - mn); p1[r] = __builtin_amdgcn_exp2f(p1[r] - mn); ps += p0[r] + p1[r]; }
            l = l * alpha + ps;
            if (__any(mn > m)) {
                if (hi == 0) xch[r32] = alpha;
                asm volatile("s_waitcnt lgkmcnt(0)" ::: "memory");
#pragma unroll
                for (int g = 0; g < 4; ++g) { const f32x4 av = *(const LAS f32x4*)(xch + 8 * g + 4 * hi);
#pragma unroll
                    for (int dt = 0; dt < 4; ++dt) { o[dt][4 * g] *= av[0]; o[dt][4 * g + 1] *= av[1]; o[dt][4 * g + 2] *= av[2]; o[dt][4 * g + 3] *= av[3]; } }
            }
            m = mn;
            bf16x8 pa[4];
#pragma unroll
            for (int ks = 0; ks < 4; ++ks) { const f32x16& src = (ks < 2) ? p0 : p1; const int b = (ks & 1) * 8; u32x4 t;
                t.x = cvt_pk_bf16(src[b], src[b + 1]); t.y = cvt_pk_bf16(src[b + 2], src[b + 3]); t.z = cvt_pk_bf16(src[b + 4], src[b + 5]); t.w = cvt_pk_bf16(src[b + 6], src[b + 7]);
                pa[ks] = __builtin_bit_cast(bf16x8, t); }
#pragma unroll
            for (int dt = 0; dt < 4; ++dt)
#pragma unroll
                for (int ks = 0; ks < 4; ++ks) {
                    const LAS unsigned char* vp = vb + (2 * ks) * 2048 + (32 * dt + r32) * 16 + 8 * hi;
                    const u32x2 lo = *(const LAS u32x2*)vp, hh = *(const LAS u32x2*)(vp + 2048);
                    const u32x4 bq = (u32x4){lo.x, lo.y, hh.x, hh.y};
                    o[dt] = __builtin_amdgcn_mfma_f32_32x32x16_bf16(pa[ks], __builtin_bit_cast(bf16x8, bq), o[dt], 0, 0, 0);
                    if (ks == 3) __builtin_amdgcn_sched_barrier(0);
                }
        }
    }
#undef ATT_STAGE
    asm volatile("s_waitcnt lgkmcnt(0)" ::: "memory");
    __builtin_amdgcn_s_barrier();
    l += __shfl_xor(l, 32);
    if (hi == 0) xch[32 + r32] = 1.f / l;
    asm volatile("s_waitcnt lgkmcnt(0)" ::: "memory");
#pragma unroll
    for (int g = 0; g < 4; ++g) { const f32x4 iv = *(const LAS f32x4*)(xch + 32 + 8 * g + 4 * hi);
#pragma unroll
        for (int dt = 0; dt < 4; ++dt)
#pragma unroll
            for (int j = 0; j < 4; ++j) ost[(8 * g + 4 * hi + j) * 128 + 32 * dt + r32] = (bf16)f2bf(o[dt][4 * g + j] * iv[j]); }
    asm volatile("s_waitcnt lgkmcnt(0)" ::: "memory");
    unsigned char* YA = F.ws + WS_YA;
#pragma unroll
    for (int i = 0; i < 8; ++i) { const int g = i * 64 + lane, row = g >> 4, c16 = g & 15; const u32x4 v = *(const LAS u32x4*)(ost + row * 128 + c16 * 8);
        u32x2 o8;
#pragma unroll
        for (int q = 0; q < 2; ++q) { int w8 = 0; const unsigned w0 = v[2 * q], w1 = v[2 * q + 1];
            w8 = __builtin_amdgcn_cvt_pk_fp8_f32(__uint_as_float(w0 << 16) * 32.f, __uint_as_float(w0 & 0xffff0000u) * 32.f, w8, false);
            w8 = __builtin_amdgcn_cvt_pk_fp8_f32(__uint_as_float(w1 << 16) * 32.f, __uint_as_float(w1 & 0xffff0000u) * 32.f, w8, true); o8[q] = (unsigned)w8; }
        *(u32x2*)(YA + (size_t)(qrow0 + row) * ATT_W + h * ATT_HD + c16 * 8) = o8; }
    asm volatile("s_waitcnt vmcnt(0) lgkmcnt(0)" ::: "memory");
    __builtin_amdgcn_s_barrier();
}


__device__ __forceinline__ void gla_prep_unit(Frame& F, const Args& a, int n, int cg) {
    const int tid = F.tid, cq = tid & 15, seg = tid >> 4;
    const int h = cg >> 2, dk0 = (cg & 3) * 64 + 4 * cq, col0 = h * GLA_DK + dk0, nh = n * GLA_H + h;
    const float* wgu = a.in[3]; const float* bgt = a.in[4]; const float* GLR = (const float*)(F.ws + WS_GLR);
    const bf16* GQ = (const bf16*)(F.ws + WS_GQ); const bf16* GK = (const bf16*)(F.ws + WS_GK);
    LAS float* tot = (LAS float*)F.lds;
    LAS float* wl = tot + 2048;
    const int t0 = n * 256 + seg * 8;
    u32x2 qraw[8], kraw[8];
#pragma unroll
    for (int i = 0; i < 8; ++i) { qraw[i] = *(const u32x2*)(GQ + (size_t)(t0 + i) * GLA_QK + col0); kraw[i] = *(const u32x2*)(GK + (size_t)(t0 + i) * GLA_QK + col0); }
    if (seg < 16) *(LAS f32x4*)(wl + seg * 64 + 4 * cq) = *(const f32x4*)(wgu + seg * GLA_QK + col0);
    __syncthreads();
    const f32x4 bgv = *(const f32x4*)(bgt + col0);
    f32x4 cs[8]; f32x4 run = (f32x4){0.f, 0.f, 0.f, 0.f};
#pragma unroll
    for (int i = 0; i < 8; ++i) {
        const f32x4* gp = (const f32x4*)(GLR + (size_t)(t0 + i) * 16); f32x4 z = bgv;
#pragma unroll
        for (int q = 0; q < 4; ++q) { const f32x4 gv = gp[q]; const LAS f32x4* wp = (const LAS f32x4*)(wl + 4 * q * 64 + 4 * cq);
            z += wp[0] * gv.x; z += wp[16] * gv.y; z += wp[32] * gv.z; z += wp[48] * gv.w; }
#pragma unroll
        for (int j = 0; j < 4; ++j) run[j] += log_sigmoid(z[j]) * (1.f / 16.f);
        cs[i] = run;
    }
    *(LAS f32x4*)(tot + seg * 64 + 4 * cq) = run;
    __syncthreads();
    f32x4 off = (f32x4){0.f, 0.f, 0.f, 0.f}, total = (f32x4){0.f, 0.f, 0.f, 0.f};
    for (int sg = 0; sg < 32; ++sg) { const f32x4 tv = *(const LAS f32x4*)(tot + sg * 64 + 4 * cq); total += tv; if (sg < seg) off += tv; }
    float etot[4];
#pragma unroll
    for (int j = 0; j < 4; ++j) etot[j] = __expf(total[j]);
    unsigned kew[4][4];
    bf16* ACAT = (bf16*)(F.ws + WS_ACAT); bf16* KI = (bf16*)(F.ws + WS_KI); bf16* KET = (bf16*)(F.ws + WS_KET);
    float kprev[4];
#pragma unroll
    for (int i = 0; i < 8; ++i) {
        const size_t trow = (size_t)(t0 + i);
        const u32x2 qv = qraw[i], kv = kraw[i];
        float q[4] = {__uint_as_float(qv.x << 16), __uint_as_float(qv.x & 0xffff0000u), __uint_as_float(qv.y << 16), __uint_as_float(qv.y & 0xffff0000u)};
        float k[4] = {__uint_as_float(kv.x << 16), __uint_as_float(kv.x & 0xffff0000u), __uint_as_float(kv.y << 16), __uint_as_float(kv.y & 0xffff0000u)};
        float qd[4], ki[4], ke[4];
#pragma unroll
        for (int j = 0; j < 4; ++j) { const float bc = cs[i][j] + off[j]; const float eb = __expf(bc), ib = __builtin_amdgcn_rcpf(eb); qd[j] = q[j] * 0.0625f * eb; ki[j] = k[j] * ib; ke[j] = ki[j] * etot[j]; }
        const size_t lrow = (size_t)nh * 256 + seg * 8 + i;
        u32x2 o; o.x = pk2(qd[0], qd[1]); o.y = pk2(qd[2], qd[3]); *(u32x2*)(ACAT + lrow * 512 + 256 + dk0) = o;
        o.x = pk2(ki[0], ki[1]); o.y = pk2(ki[2], ki[3]); *(u32x2*)(KI + lrow * 256 + dk0) = o;
        if (i & 1) {
#pragma unroll
            for (int j = 0; j < 4; ++j) kew[j][i >> 1] = pk2(kprev[j], ke[j]); }
        else {
#pragma unroll
            for (int j = 0; j < 4; ++j) kprev[j] = ke[j]; }
    }
#pragma unroll
    for (int j = 0; j < 4; ++j) *(u32x4*)(KET + ((size_t)nh * 256 + dk0 + j) * 256 + seg * 8) = (u32x4){kew[j][0], kew[j][1], kew[j][2], kew[j][3]};
    if (seg == 0) *(f32x4*)((float*)(F.ws + WS_DEC) + n * GLA_QK + col0) = (f32x4){etot[0], etot[1], etot[2], etot[3]};
    __syncthreads();
}
__device__ __forceinline__ void gla_vt_unit(Frame& F, int n, int h, int g8) {
    const int tid = F.tid; const int nh = n * GLA_H + h;
    LAS bf16* tile = (LAS bf16*)F.lds;
    const bf16* GV = (const bf16*)(F.ws + WS_GV); bf16* BCAT = (bf16*)(F.ws + WS_BCAT);
#pragma unroll
    for (int ps = 0; ps < 4; ++ps) { const int row = (tid >> 3) + 64 * ps, ch = tid & 7;
        const u32x4 v = *(const u32x4*)(GV + (size_t)(n * 256 + row) * GLA_V + h * GLA_DV + g8 * 64 + ch * 8);
        *(LAS u32x2*)(tile + row * 72 + ch * 8) = (u32x2){v.x, v.y}; *(LAS u32x2*)(tile + row * 72 + ch * 8 + 4) = (u32x2){v.z, v.w}; }
    __syncthreads();
#pragma unroll
    for (int i = 0; i < 4; ++i) { const int g = tid + 512 * i, c = g & 63, tg = g >> 6; unsigned short e[8];
#pragma unroll
        for (int j = 0; j < 8; ++j) e[j] = tile[(tg * 8 + j) * 72 + c];
        u32x4 v; v.x = e[0] | ((unsigned)e[1] << 16); v.y = e[2] | ((unsigned)e[3] << 16); v.z = e[4] | ((unsigned)e[5] << 16); v.w = e[6] | ((unsigned)e[7] << 16);
        *(u32x4*)(BCAT + ((size_t)nh * 512 + g8 * 64 + c) * 512 + tg * 8) = v; }
    __syncthreads();
}
__device__ __forceinline__ void gla_scan(Frame& F) {
    const bf16* UT = (const bf16*)(F.ws + WS_UT); bf16* BCAT = (bf16*)(F.ws + WS_BCAT); const float* DEC = (const float*)(F.ws + WS_DEC);
    for (int idx = F.vcu * (NWAVES * 64) + F.tid; idx < GLA_H * GLA_DV * 64; idx += F.G * NWAVES * 64) {
        const int dk4 = (idx & 63) * 4, dv = (idx >> 6) & 511, h = idx >> 15;
        float s[4] = {0.f, 0.f, 0.f, 0.f};
#pragma unroll 1
        for (int nb = 0; nb < 32; nb += 16) {
            u32x2 uvv[16]; f32x4 dcv[16];
#pragma unroll
            for (int k = 0; k < 16; ++k) { const size_t nh = (size_t)(nb + k) * GLA_H + h;
                uvv[k] = *(const u32x2*)(UT + (nh * 512 + dv) * 256 + dk4); dcv[k] = *(const f32x4*)(DEC + (nb + k) * GLA_QK + h * GLA_DK + dk4); }
#pragma unroll
            for (int k = 0; k < 16; ++k) { const size_t nh = (size_t)(nb + k) * GLA_H + h; const u32x2 uv = uvv[k]; const f32x4 dc = dcv[k];
                u32x2 o; o.x = pk2(s[0], s[1]); o.y = pk2(s[2], s[3]); *(u32x2*)(BCAT + (nh * 512 + dv) * 512 + 256 + dk4) = o;
                s[0] = s[0] * dc.x + __uint_as_float(uv.x << 16); s[1] = s[1] * dc.y + __uint_as_float(uv.x & 0xffff0000u);
                s[2] = s[2] * dc.z + __uint_as_float(uv.y << 16); s[3] = s[3] * dc.w + __uint_as_float(uv.y & 0xffff0000u); }
        }
    }
}
__device__ __forceinline__ void gla_norm(Frame& F, const Args& a) {
    const int gw = F.vcu * NWAVES + F.wave, NGW = F.G * NWAVES, lane = F.lane;
    const bf16* OB = (const bf16*)(F.ws + WS_OB); const bf16* GR = (const bf16*)(F.ws + WS_GR); bf16* YG = (bf16*)(F.ws + WS_YG); const float* g = a.in[5];
    const f32x4 g0 = *(const f32x4*)(g + 8 * lane), g1 = *(const f32x4*)(g + 8 * lane + 4);
    for (int wb = gw; wb < S * GLA_H; wb += 4 * NGW) {
        u32x4 ovv[4], rvv[4];
#pragma unroll
        for (int k = 0; k < 4; ++k) { const int wi = wb + k * NGW; if (wi < S * GLA_H) { const size_t off = (size_t)(wi >> 2) * GLA_V + (wi & 3) * GLA_DV + 8 * lane; ovv[k] = *(const u32x4*)(OB + off); rvv[k] = *(const u32x4*)(GR + off); } }
#pragma unroll
        for (int k = 0; k < 4; ++k) { const int wi = wb + k * NGW; if (wi < S * GLA_H) {
        const size_t off = (size_t)(wi >> 2) * GLA_V + (wi & 3) * GLA_DV + 8 * lane;
        const u32x4 ov = ovv[k], rv = rvv[k];
        float o[8], r[8]; float ss = 0.f;
#pragma unroll
        for (int j = 0; j < 4; ++j) { o[2 * j] = __uint_as_float(ov[j] << 16); o[2 * j + 1] = __uint_as_float(ov[j] & 0xffff0000u); r[2 * j] = __uint_as_float(rv[j] << 16); r[2 * j + 1] = __uint_as_float(rv[j] & 0xffff0000u); }
#pragma unroll
        for (int j = 0; j < 8; ++j) ss += o[j] * o[j];
        const float rstd = rsqrtf(wave_sum(ss) * (1.f / GLA_DV) + 1e-6f);
        u32x4 w; w.x = pk2(o[0] * rstd * g0.x * r[0], o[1] * rstd * g0.y * r[1]); w.y = pk2(o[2] * rstd * g0.z * r[2], o[3] * rstd * g0.w * r[3]);
        w.z = pk2(o[4] * rstd * g1.x * r[4], o[5] * rstd * g1.y * r[5]); w.w = pk2(o[6] * rstd * g1.z * r[6], o[7] * rstd * g1.w * r[7]);
        *(u32x4*)(YG + off) = w; } }
    }
}

__global__ void __launch_bounds__(NWAVES * 64, 2) fwd(Args args) {
    extern __shared__ __attribute__((aligned(16))) unsigned char lds_raw[];
    Frame F;
    F.lds = (LAS unsigned char*)lds_raw; F.MISC = (volatile LAS unsigned*)(F.lds + MISC_OFF);
    F.tid = threadIdx.x; F.lane = F.tid & 63; F.wave = __builtin_amdgcn_readfirstlane(F.tid >> 6);
    F.G = gridDim.x; { const int bx = blockIdx.x; F.vcu = (F.G % 8 == 0) ? (bx % 8) * (F.G / 8) + bx / 8 : bx; }
    F.ws = args.ws; F.ctl = (unsigned*)(args.ws + WS_CTL);
    for (int u = F.tid; u < (LDS_BYTES - CTLZ_OFF) / 4; u += NWAVES * 64) ((LAS unsigned*)(F.lds + CTLZ_OFF))[u] = 0u;
    __syncthreads();
    XcdBarrier bar = xcd_barrier_post(F.ctl + CW_BAR + args.li * XCD_BAR_WORDS, F.MISC + 8);
    const int lo = args.ph_lo, hi = args.ph_hi;
#define IN(k) (lo <= (k) && (k) < hi)
#define SEAM(k) do { if (IN(k) && IN((k) + 1)) xcd_barrier(bar); } while (0)
    unsigned char* ws = args.ws;
#ifndef DUP_MASK
#define DUP_MASK 0
#endif
#define DUP(k) ((DUP_MASK >> (k)) & 1)
#define PHASE(k, ...) do { if (IN(k)) { __VA_ARGS__ if (DUP(k)) { xcd_barrier(bar); __VA_ARGS__ } } SEAM(k); } while (0)
#define PHASE_NB(k, ...) do { if (IN(k)) { __VA_ARGS__ if (DUP(k)) { xcd_barrier(bar); __VA_ARGS__ } } } while (0)
    const int gcus = (F.G == 256) ? GEMM_CUS : F.G;
#ifndef JIT_WIN
#define JIT_WIN 0
#endif
    const bool split = gcus < F.G, jit = split && JIT_WIN;
    unsigned* const jf = F.ctl + CW_JIT;
    PHASE(0, { if (!jit) { p0_convert(F, args, 0, split ? P0_I_IN : P0_NITEMS, F.vcu * NWAVES + F.wave, F.G * NWAVES); p0_convert8(F, args, split ? P8_NITEMS : 0, split ? P8_ALL : P8_END, F.vcu * NWAVES + F.wave, F.G * NWAVES); } p0_rows(F, args);
        for (int u = F.vcu; u < S / 32; u += F.G) normproj_unit<0>(F, args, u); });
    PHASE(1, { if (jit) { p0_convert(F, args, 0, P0_JIT_A, F.vcu * NWAVES + F.wave, F.G * NWAVES); jit_publish(jf, F.wave, F.lane); }
        if ((int)blockIdx.x < gcus) {
            { pg8::DenseSched Sc; Sc.init_split(ws + WS_XN, ws + WS_WIN, S, 24, D * 2, gcus, (int)blockIdx.x, 24, 0); pg8::EpiProj E{ws, args.in[9]};
              if (jit) { Sc.jflag = jf; Sc.jwant0 = (unsigned)F.G; Sc.jwant1 = (unsigned)(F.G - gcus); Sc.jseen = F.MISC + 16; }
              pg8::gemm_phase<pg8::EpiProj, pg8::DenseSched>(F.lds, D, D, D, Sc, E); }
            { pg8::DenseSched Sc; Sc.init_split(ws + WS_XN8, ws + WS_WIN8, S, 28, D, gcus, gcus - 1 - (int)blockIdx.x, 28, 0); Sc.pn_base = 24; Sc.bcompact = 1; pg8::EpiProj E{ws, args.in[9]};
              if (jit) { Sc.jflag = jf; Sc.jwant0 = (unsigned)F.G; Sc.jwant1 = (unsigned)(F.G - gcus); Sc.jseen = F.MISC + 16; Sc.jmode = 1; }
              pg8::gemm_phase8<pg8::EpiProj, pg8::DenseSched>(F.lds, D, D, D, Sc, E); }
            if (split) { __syncthreads(); p0_convert8_queue(F, args, jf + 128, P8_NITEMS); } }
        else { const int cw = ((int)blockIdx.x - gcus) * NWAVES + F.wave, ncw = (F.G - gcus) * NWAVES;
            if (jit) { p0_convert(F, args, P0_JIT_A, P0_I_IN, cw, ncw); p0_convert8(F, args, P8_NITEMS, P8_ALL, cw, ncw); jit_publish(jf + 64, F.wave, F.lane); }
            p0_convert(F, args, P0_I_IN, P0_I_IN + P0_I_BG, cw, ncw); p0_convert(F, args, P0_I_IN + P0_I_BG + P0_I_BA, P0_NITEMS, cw, ncw); p0_convert8(F, args, P8_ALL, P8_END, cw, ncw); p0_convert8_queue(F, args, jf + 128, P8_NITEMS); } });
    PHASE(2, { for (int rp = 0; rp < 1 + DUP(16); ++rp) for (int u = F.vcu; u < NCH * ATT_H; u += F.G) attn_prep_unit(F, args, u >> 3, u & 7);
        for (int rp = 0; rp < 1 + DUP(17); ++rp) for (int u = F.vcu; u < 32 * 16; u += F.G) gla_prep_unit(F, args, u >> 4, u & 15);
        for (int rp = 0; rp < 1 + DUP(18); ++rp) for (int u = F.vcu; u < 32 * GLA_H * 8; u += F.G) gla_vt_unit(F, u >> 5, (u >> 3) & 3, u & 7); });
    PHASE(3, { for (int u = F.vcu; u < (NCH / 4) * ATT_H; u += F.G) attn_unit(F, args, u >> 3, u & 7);
        { pg8::GlaSched Sc{3, F.G, (int)blockIdx.x, ws}; pg8::EpiGla<3> E{ws}; pg8::gemm_phase<pg8::EpiGla<3>, pg8::GlaSched>(F.lds, 256, 512, 256, Sc, E); } });
    PHASE(4, { gla_scan(F);
        { pg8::DenseSched Sc; Sc.init_split(ws + WS_YA, ws + WS_WBA8, S, D / 256, ATT_W, F.G, (int)blockIdx.x, D / 256, 0); pg8::EpiBranch<0> E{ws + WS_SA, nullptr, ws + WS_T};
          pg8::gemm_phase8<pg8::EpiBranch<0>, pg8::DenseSched>(F.lds, ATT_W, ATT_W, ATT_W, Sc, E, 0x7a7a7a7a); } });
    const bool fuse56 = (F.G == 256);
    PHASE(5, { pg8::GlaSched Sc{2, F.G, (int)blockIdx.x, ws};
        if (fuse56) { pg8::EpiGlaNorm E{ws, args.in[5], F.ctl, (LAS float*)(F.lds + RING_BYTES)}; pg8::gemm_phase<pg8::EpiGlaNorm, pg8::GlaSched>(F.lds, 512, 512, 512, Sc, E); }
        else { pg8::EpiGla<2> E{ws}; pg8::gemm_phase<pg8::EpiGla<2>, pg8::GlaSched>(F.lds, 512, 512, 512, Sc, E); } });
    if (!fuse56) PHASE(6, { gla_norm(F, args); });
    PHASE(7, { pg8::DenseSched Sc; Sc.init(ws + WS_YG, ws + WS_WBG, S, D, GLA_V, F.G, (int)blockIdx.x); pg8::EpiBranch<1> E{ws + WS_SG, ws + WS_T, ws + WS_MG};
        pg8::gemm_phase<pg8::EpiBranch<1>, pg8::DenseSched>(F.lds, GLA_V, GLA_V, GLA_V, Sc, E); });
    PHASE(9, { pg8::DenseSched Sc; Sc.init(ws + WS_MG, ws + WS_WOUT, S, D, D, F.G, (int)blockIdx.x); pg8::EpiResid E{args.in[0], (bf16*)(ws + WS_H1)};
        pg8::gemm_phase<pg8::EpiResid, pg8::DenseSched>(F.lds, D, D, D, Sc, E); });
    PHASE(10, { for (int u = F.vcu; u < S / 32; u += F.G) normproj_unit<1>(F, args, u); });
    PHASE(12, { moe_table(F); pg8::MoeSched Sc;
        Sc.init(ws + WS_HN, ws + WS_GU, (volatile LAS int*)(F.lds + TAB_OFF), (volatile LAS int*)(F.lds + TAB_OFF + 256), 16, D, F.G, (int)blockIdx.x); Sc.agather = 1;
        pg8::EpiSwiglu E{args.in[17], args.in[19], ws + WS_HD};
        pg8::gemm_phase8<pg8::EpiSwiglu, pg8::MoeSched, true>(F.lds, D, D, D, Sc, E, 0x7f7f7f7f, (const int*)(ws + WS_SMAP), S - 1); });
    PHASE(13, { pg8::MoeSched Sc; Sc.init(ws + WS_HD, ws + WS_DN, (volatile LAS int*)(F.lds + TAB_OFF), (volatile LAS int*)(F.lds + TAB_OFF + 256), 8, DFF, F.G, (int)blockIdx.x);
        pg8::EpiDown E{args.in[21], (const int*)(ws + WS_SMAP), (const float*)(ws + WS_WMAP), ws + WS_PY};
        pg8::gemm_phase8<pg8::EpiDown, pg8::MoeSched>(F.lds, DFF, DFF, DFF, Sc, E); });
    PHASE(14, { p10_combine(F, args); });
#undef PHASE
#undef PHASE_NB
#undef IN
#undef SEAM
}

extern "C" void kernel_launch(void* const* d_in, const int* in_sizes, int n_in, void* d_out, int out_size, void* d_ws, size_t ws_size, hipStream_t stream) {
    static int grid = 0;
    if (grid == 0) {
        if (n_in != 22 || out_size != S * D || ws_size < WS_END) { fprintf(stderr, "kernel_launch: unexpected problem (n_in %d out %d ws %zu)\n", n_in, out_size, ws_size); grid = -1; return; }
        int dev = 0, cus = 0, per_cu = 0;
        if (hipGetDevice(&dev) != hipSuccess || hipDeviceGetAttribute(&cus, hipDeviceAttributeMultiprocessorCount, dev) != hipSuccess) { grid = -1; return; }
        if (hipFuncSetAttribute((const void*)fwd, hipFuncAttributeMaxDynamicSharedMemorySize, LDS_BYTES) != hipSuccess) { fprintf(stderr, "kernel_launch: hipFuncSetAttribute failed\n"); grid = -1; return; }
        if (hipOccupancyMaxActiveBlocksPerMultiprocessor(&per_cu, (const void*)fwd, NWAVES * 64, LDS_BYTES) != hipSuccess || per_cu < 1) fprintf(stderr, "kernel_launch: occupancy query says %d\n", per_cu);
        (void)hipGetLastError();
        grid = cus;
    }
    if (grid < 0) return;
    (void)hipMemsetAsync((char*)d_ws + WS_CTL, 0, CTL_ZERO_BYTES, stream);
    Args a{};
    for (int i = 0; i < 22; ++i) a.in[i] = (const float*)d_in[i];
    a.out = (float*)d_out; a.ws = (unsigned char*)d_ws;
    a.ph_lo = 0; a.ph_hi = 15; a.li = 0;
    hipLaunchKernelGGL(fwd, dim3(grid), dim3(NWAVES * 64), LDS_BYTES, stream, a);
}
```

```cpp
#include <hip/hip_runtime.h>
#include <stdint.h>
#include <cstdio>

constexpr int S = 8192, D = 2048;
constexpr int GLA_H = 4, GLA_DK = 256, GLA_DV = 512, GLA_QK = 1024, GLA_V = 2048;
constexpr int ATT_H = 8, ATT_HD = 128, ATT_W = 1024, NCH = S / 64;
constexpr int NE = 32, DFF = 2048;
constexpr int IN_COLS = 13328, C_GLR = 6144;
constexpr int NPROJ = 13312;
constexpr int MAXROWS = 32768 + NE * 256;

constexpr size_t MiB = 1u << 20;
constexpr size_t WS_CTL = 0, CTL_ZERO_BYTES = 64 * 1024;
constexpr size_t WS_TOPW = 1 * MiB, WS_TOPE = WS_TOPW + 128 * 1024, WS_TOPS = WS_TOPE + 128 * 1024, WS_RPAIR = WS_TOPS + 128 * 1024, WS_RW = WS_RPAIR + 256 * 1024;
constexpr size_t WS_GLR = 2 * MiB, WS_WR = 3 * MiB;
constexpr size_t WS_SMAP = 1232 * MiB, WS_WMAP = 1233 * MiB;
constexpr size_t WS_WIN = 8 * MiB, WS_WBG = 60 * MiB, WS_WBA = 68 * MiB, WS_WOUT = 72 * MiB, WS_GU = 80 * MiB, WS_DN = 592 * MiB;
constexpr size_t WS_XN = 848 * MiB, WS_GQ = 880 * MiB, WS_GK = 896 * MiB, WS_GV = 912 * MiB, WS_GR = 944 * MiB, WS_AQ = 976 * MiB, WS_AK = 992 * MiB, WS_AV = 1008 * MiB;
constexpr size_t WS_SG = 1024 * MiB, WS_SA = 1056 * MiB, WS_YG = 1088 * MiB, WS_YA = 1120 * MiB, WS_T = 1136 * MiB, WS_MG = 1168 * MiB, WS_HN = 1200 * MiB;
constexpr size_t WS_HNG = 1232 * MiB, WS_HD = 1392 * MiB, WS_PY = 1552 * MiB, WS_QH = 1681 * MiB, WS_KIMG = 1697 * MiB, WS_VIMG = 1713 * MiB;
constexpr size_t WS_PSLOT = 1889 * MiB + 512 * 1024;
constexpr size_t WS_ACAT = 1729 * MiB, WS_BCAT = 1761 * MiB, WS_KI = 1825 * MiB, WS_KET = 1841 * MiB, WS_UT = 1857 * MiB, WS_DEC = 1889 * MiB, WS_OB = 1890 * MiB, WS_H1 = 1922 * MiB, WS_XN8 = 1986 * MiB, WS_WIN8 = WS_WIN + 24 * MiB, WS_WBA8 = WS_WIN + 40 * MiB, WS_END = 2002 * MiB;
constexpr int CW_CNT = 256;
constexpr int CW_JIT = 2560;
constexpr int CW_BAR = 4096;
constexpr int CW_PS = 8192;

typedef unsigned short bf16;
typedef short bf16x8 __attribute__((ext_vector_type(8)));
typedef float f32x4 __attribute__((ext_vector_type(4)));
typedef float f32x16 __attribute__((ext_vector_type(16)));
typedef unsigned u32x4 __attribute__((ext_vector_type(4)));
typedef unsigned u32x2 __attribute__((ext_vector_type(2)));
typedef int v8i __attribute__((ext_vector_type(8)));
#define LAS __attribute__((address_space(3)))
#define GAS __attribute__((address_space(1)))
__device__ __forceinline__ float bf2f(bf16 v) { return __uint_as_float((unsigned)v << 16); }
typedef float f32x2_t __attribute__((ext_vector_type(2))); typedef __bf16 bf16x2_t __attribute__((ext_vector_type(2)));
__device__ __forceinline__ unsigned pk2(float lo, float hi) { const f32x2_t v = {lo, hi}; const bf16x2_t b = __builtin_convertvector(v, bf16x2_t); return __builtin_bit_cast(unsigned, b); }
__device__ __forceinline__ unsigned f2bf(float f) { return pk2(f, 0.f) & 0xffffu; }
__device__ __forceinline__ unsigned cvt_pk_bf16(float lo, float hi) { return pk2(lo, hi); }
__device__ __forceinline__ float wave_sum(float v) {
#pragma unroll
    for (int o = 1; o < 64; o <<= 1) v += __shfl_xor(v, o);
    return v;
}
__device__ __forceinline__ float sigmoidf_(float x) { return __builtin_amdgcn_rcpf(1.f + __expf(-x)); }
__device__ __forceinline__ float log_sigmoid(float z) { return fminf(z, 0.f) - __logf(1.f + __expf(-fabsf(z))); }
#define LDS_WAIT() asm volatile("s_waitcnt lgkmcnt(0)" ::: "memory")
#define VM_WAIT() asm volatile("s_waitcnt vmcnt(0)" ::: "memory")

#define XB_TMO      128
#define XB_XCNT(j)  (256  + 64 * (j))
#define XB_XSUB(j)  (1280 + 64 * (j))
#define XB_XGEN(j)  (2304 + 64 * (j))
#define XB_TOP      3328
#define XB_TOPGEN   3392
#define XCD_BAR_WORDS 3456
#define XB_SPIN_CAP (1u << 18)
__device__ __forceinline__ unsigned xb_ld(unsigned* p)              { return __hip_atomic_load(p, __ATOMIC_RELAXED, __HIP_MEMORY_SCOPE_AGENT); }
__device__ __forceinline__ unsigned xb_add(unsigned* p, unsigned v) { return __hip_atomic_fetch_add(p, v, __ATOMIC_RELAXED, __HIP_MEMORY_SCOPE_AGENT); }
__device__ __forceinline__ unsigned xb_xcc_id() { return (unsigned)__builtin_amdgcn_s_getreg((3 << 11) | 20) & 0xFu; }
#define XB_SPIN(cond, bar) do { unsigned _sp = 0; while (cond) { __builtin_amdgcn_s_sleep(1); \
    if ((++_sp & 255u) == 0u) { if (xb_ld(&(bar)[XB_TMO])) break; if (_sp > XB_SPIN_CAP) { atomicAdd(&(bar)[XB_TMO], 1u); break; } } } } while (0)
struct XcdBarrier { unsigned* bar; unsigned x; volatile LAS unsigned* st; };
__device__ __forceinline__ XcdBarrier xcd_barrier_post(unsigned* bar, volatile LAS unsigned* st) {
    XcdBarrier b; b.bar = bar; b.x = xb_xcc_id(); b.st = st;
    if (threadIdx.x == 0) (void)xb_add(&bar[XB_XCNT(b.x)], 1u);
    return b;
}
__device__ __forceinline__ void xcd_barrier_complete(unsigned* bar, unsigned x, unsigned& nloc, unsigned& nx) {
    const unsigned G = gridDim.x * gridDim.y * gridDim.z;
    unsigned sum, cnt, mine, sp = 0u;
    for (;;) {
        sum = 0u; cnt = 0u; mine = 0u;
#pragma unroll
        for (unsigned j = 0; j < 16; ++j) { const unsigned c = xb_ld(&bar[XB_XCNT(j)]); sum += c; cnt += (c > 0u) ? 1u : 0u; mine = (j == x) ? c : mine; }
        if (sum == G) break;
        __builtin_amdgcn_s_sleep(1);
        if ((++sp & 255u) == 0u) { if (xb_ld(&bar[XB_TMO])) break; if (sp > XB_SPIN_CAP) { atomicAdd(&bar[XB_TMO], 1u); break; } }
    }
    nloc = mine > 0u ? mine : 1u; nx = cnt > 0u ? cnt : 1u;
}
__device__ __forceinline__ void xcd_barrier(const XcdBarrier& b) {
    asm volatile("s_waitcnt vmcnt(0)" ::: "memory");
    __syncthreads();
    if (threadIdx.x == 0) {
        unsigned* bar = b.bar;
        __builtin_amdgcn_s_waitcnt(0);
        unsigned nloc = b.st[0], nx = b.st[1];
        if (nloc == 0u) { xcd_barrier_complete(bar, b.x, nloc, nx); b.st[0] = nloc; b.st[1] = nx; }
        const unsigned old = xb_add(&bar[XB_XSUB(b.x)], 1u);
        const unsigned gen = old / nloc;
        if (old + 1u == (gen + 1u) * nloc) {
            __builtin_amdgcn_fence(__ATOMIC_RELEASE, "agent");
            asm volatile("s_waitcnt vmcnt(0)" ::: "memory");
            const unsigned og = xb_add(&bar[XB_TOP], 1u);
            const unsigned tg = og / nx;
            if (og + 1u == (tg + 1u) * nx) xb_add(&bar[XB_TOPGEN], 1u);
            else XB_SPIN(xb_ld(&bar[XB_TOPGEN]) == tg, bar);
            __builtin_amdgcn_fence(__ATOMIC_ACQUIRE, "agent");
            xb_add(&bar[XB_XGEN(b.x)], 1u);
            asm volatile("s_waitcnt vmcnt(0)" ::: "memory");
        } else {
            XB_SPIN(xb_ld(&bar[XB_XGEN(b.x)]) == gen, bar);
            __builtin_amdgcn_fence(__ATOMIC_ACQUIRE, "agent");
            asm volatile("s_waitcnt vmcnt(0)" ::: "memory");
        }
    }
    __syncthreads();
}

namespace pg8 {
constexpr int JIT_EARLY = 5;
constexpr int BM = 256, BK = 64, HALF = 128, HTB = HALF * BK * 2, STAGE_BYTES = 8 * HTB, NXCD = 8, WGM = 8;
__host__ __device__ __forceinline__ int lds_byte(int r, int c) { const int st = (r >> 4) * 2 + (c >> 5), rr = r & 15, cc = c & 31, ob = rr * 64 + cc * 2; return st * 1024 + (ob ^ (((ob >> 9) & 1) << 5)); }
__host__ __device__ __forceinline__ void stage_rc(int b, int& R, int& C) { const int st = b / 1024, sb = b % 1024, swz = sb ^ (((sb >> 9) & 1) << 5); R = (st >> 1) * 16 + swz / 64; C = (st & 1) * 32 + (swz % 64) / 2; }
__host__ __device__ __forceinline__ int perm32(int rho) { const int n = rho >> 4, i = rho & 15; return 8 * (i >> 2) + 4 * n + (i & 3); }
__device__ __forceinline__ int xcd_remap(int wgid, int nwg) { const int q = nwg / NXCD, r = nwg % NXCD, xcd = wgid % NXCD, off = wgid / NXCD; return (xcd < r ? xcd * (q + 1) : r * (q + 1) + (xcd - r) * q) + off; }

struct Unit { const char* A; const char* B; int pm, pn, e, nrow, trow; };

struct DenseSched {
    const char* A; const char* Bt; int nM, nN, nwg, G, c; size_t tstep; int pn_split, pn_skip, pn_base, bcompact, jhalf;
    unsigned* jflag; unsigned jwant0, jwant1; volatile LAS unsigned* jseen; int jmode; mutable int seen;
    __device__ __forceinline__ void init(const void* A_, const void* Bt_, int M, int N, int K, int G_, int c_) { A = (const char*)A_; Bt = (const char*)Bt_; nM = M / BM; nN = N / BM; nwg = nM * nN; G = G_; c = c_; tstep = (size_t)BM * K * 2; pn_split = nN; pn_skip = 0; pn_base = 0; bcompact = 0; jhalf = 1 << 20; jflag = nullptr; seen = 0; jmode = 0; }
    __device__ __forceinline__ void init_split(const void* A_, const void* Bt_, int M, int ntiles, int Kbytes, int G_, int c_, int split, int skip) { A = (const char*)A_; Bt = (const char*)Bt_; nM = M / BM; nN = ntiles; nwg = nM * nN; G = G_; c = c_; tstep = (size_t)BM * Kbytes; pn_split = split; pn_skip = skip; pn_base = 0; bcompact = 0; jhalf = ntiles / 2; jflag = nullptr; seen = 0; jmode = 0; }
    __device__ __forceinline__ void jwait(int st) const {
        if (seen & (1 << st)) return;
        if (__builtin_amdgcn_readfirstlane((int)(threadIdx.x >> 6)) == 0) {
            const unsigned want = st ? jwant1 : jwant0; unsigned sp = 0u;
            while ((unsigned)__builtin_amdgcn_readfirstlane((int)__hip_atomic_load(jflag + 64 * st, __ATOMIC_RELAXED, __HIP_MEMORY_SCOPE_AGENT)) < want) { __builtin_amdgcn_s_sleep(8); if (++sp > (1u << 18)) break; }
            __builtin_amdgcn_fence(__ATOMIC_ACQUIRE, "agent");
            jseen[st] = 1u;
        } else { unsigned sp = 0u; while (jseen[st] == 0u) { __builtin_amdgcn_s_sleep(2); if (++sp > (1u << 22)) break; } }
        asm volatile("" ::: "memory");
        seen |= 1 << st;
    }
    __device__ __forceinline__ bool next(int i, Unit& u) const {
        const long L = (long)i * G + c; if (L >= nwg) return false;
        const int wgid = xcd_remap((int)L, nwg);
        const int nig = WGM * nN, gid = wgid / nig, fm = gid * WGM, gsz = (nM - fm) < WGM ? (nM - fm) : WGM;
        const int j = (wgid % nig) / gsz;
        if (jflag) jwait((jmode == 0 && (j % jhalf) < JIT_EARLY) ? 0 : 1);
        u.pm = fm + ((wgid % nig) % gsz); u.pn = j < pn_split ? j + pn_base : j + pn_skip; u.e = 0; u.nrow = BM;
        u.A = A + (size_t)u.pm * tstep; u.B = Bt + (ptrdiff_t)(bcompact ? j : u.pn) * (ptrdiff_t)tstep; return true;
    }
};
struct MoeSched {
    const char* A; const char* Bt; const volatile LAS int* tstart; const volatile LAS int* cnt; int NT, nwg, G, c; size_t tstep; int agather;
    __device__ __forceinline__ void init(const void* A_, const void* Bt_, const volatile LAS int* ts, const volatile LAS int* cn, int NT_, int Kbytes, int G_, int c_) {
        A = (const char*)A_; Bt = (const char*)Bt_; tstart = ts; cnt = cn; NT = NT_; nwg = ts[NE] * NT_; G = G_; c = c_; tstep = (size_t)BM * Kbytes; agather = 0; }
    __device__ __forceinline__ bool next(int i, Unit& u) const {
        const long L = (long)i * G + c; if (L >= nwg) return false;
        const int wgid = xcd_remap((int)L, nwg);
        const int lj = (int)(threadIdx.x & 31u); const int tj = tstart[lj];
        const unsigned long long hit = __ballot(wgid >= tj * NT);
        const int e = __builtin_amdgcn_readfirstlane(__builtin_popcount((unsigned)(hit & 0xffffffffull)) - 1);
        const int t0 = tstart[e], nte = tstart[e + 1] - t0, local = wgid - t0 * NT;
        const int pn = local / nte, mt = local - pn * nte;
        u.e = e; u.pn = pn; u.pm = t0 + mt; u.nrow = cnt[e] - mt * BM; u.trow = e * 8192 + mt * BM;
        u.A = agather ? A : A + (size_t)u.pm * tstep; u.B = Bt + (size_t)(e * NT + pn) * tstep; return true;
    }
};

template <class Epi, class Sched, bool BGRAN = false>
__device__ __forceinline__ void gemm_phase(LAS unsigned char* lds, const int K, const int lda, const int ldb, const Sched& S, const Epi& E) {
    const int tid = threadIdx.x, wid = __builtin_amdgcn_readfirstlane(tid >> 6), lane = tid & 63, wr = wid >> 2, wc = wid & 3, fr = lane & 15, fq = lane >> 4;
    int nt = K / BK; asm volatile("" : "+s"(nt));
    unsigned voffA[2], voffB[2];
#pragma unroll
    for (int i = 0; i < 2; ++i) { int R, C; stage_rc(tid * 16 + i * 8192, R, C); const int Rb = Epi::PERM ? ((R & ~31) + perm32(R & 31)) : R;
        voffA[i] = (unsigned)(R * lda + C) * 2u; voffB[i] = BGRAN ? (unsigned)((C >> 3) * ldb + Rb) * 16u : (unsigned)(Rb * ldb + C) * 2u; }
    const size_t kstep = (size_t)(BK * 2), kstepB = BGRAN ? (size_t)ldb * 128 : (size_t)(BK * 2);
    const size_t hstepA = (size_t)HALF * lda * 2, hstepB = BGRAN ? (size_t)2048 : (size_t)HALF * ldb * 2;
    const unsigned ldsw = (unsigned)wid * 1024u;
    const int aoff = lds_byte(wr * 64 + fr, fq * 8), boff = lds_byte(wc * 32 + fr, fq * 8);
#define PG8_SA(b, h) (((b) * 2 + (h)) * HTB)
#define PG8_SB(b, h) ((4 + (b) * 2 + (h)) * HTB)
#define PG8_STAGE(bufoff, gbase, voff) do { _Pragma("unroll") for (int _i = 0; _i < 2; ++_i) \
        __builtin_amdgcn_global_load_lds((const unsigned*)((const char*)(gbase) + (voff)[_i]), (LAS unsigned*)(lds + (bufoff) + ldsw + _i * 8192), 16, 0, 0); } while (0)
#define PG8_LDA(dst, b, h) do { _Pragma("unroll") for (int m = 0; m < 4; ++m) _Pragma("unroll") for (int k = 0; k < 2; ++k) dst[m][k] = *(const LAS bf16x8*)(lds + PG8_SA(b, h) + aoff + m * 2048 + k * 1024); } while (0)
#define PG8_LDB(dst, b, h) do { _Pragma("unroll") for (int n = 0; n < 2; ++n) _Pragma("unroll") for (int k = 0; k < 2; ++k) dst[n][k] = *(const LAS bf16x8*)(lds + PG8_SB(b, h) + boff + n * 2048 + k * 1024); } while (0)
#define PG8_MMA(ai, bj, At, Bt) do { __builtin_amdgcn_s_setprio(1); _Pragma("unroll") for (int m = 0; m < 4; ++m) _Pragma("unroll") for (int n = 0; n < 2; ++n) _Pragma("unroll") for (int k = 0; k < 2; ++k) \
        acc[ai][bj][m][n] = __builtin_amdgcn_mfma_f32_16x16x32_bf16(Bt[n][k], At[m][k], acc[ai][bj][m][n], 0, 0, 0); __builtin_amdgcn_s_setprio(0); } while (0)
#define PG8_WAIT_V(n) asm volatile("s_waitcnt vmcnt(" #n ")" ::: "memory")
#define PG8_WAIT_L(n) asm volatile("s_waitcnt lgkmcnt(" #n ")" ::: "memory")
#define PG8_BAR __builtin_amdgcn_s_barrier()
#define PG8_SCHED __builtin_amdgcn_sched_barrier(0)
    Unit cur, nxt; int ui = 0;
    if (!S.next(0, cur)) return;
    f32x4 acc[2][2][4][2];
#pragma unroll
    for (int a = 0; a < 2; ++a)
#pragma unroll
        for (int b = 0; b < 2; ++b)
#pragma unroll
            for (int m = 0; m < 4; ++m)
#pragma unroll
                for (int n = 0; n < 2; ++n) acc[a][b][m][n] = (f32x4){0.f, 0.f, 0.f, 0.f};
    bf16x8 At[4][2], B0[2][2], B1[2][2];
    const char* cA = cur.A; const char* cB = cur.B;
    PG8_STAGE(PG8_SB(0, 0), cB, voffB); PG8_STAGE(PG8_SB(0, 1), cB + hstepB, voffB); PG8_STAGE(PG8_SA(0, 0), cA, voffA); PG8_STAGE(PG8_SA(0, 1), cA + hstepA, voffA);
    if (wr == 1) PG8_BAR;
    PG8_WAIT_V(2); PG8_BAR;
    PG8_STAGE(PG8_SB(1, 0), cB + kstepB, voffB); PG8_STAGE(PG8_SA(1, 0), cA + kstep, voffA); PG8_STAGE(PG8_SB(1, 1), cB + hstepB + kstepB, voffB);
    PG8_WAIT_V(6); PG8_BAR;
    for (;;) {
        const bool has_next = S.next(ui + 1, nxt);
        const char* nA = has_next ? nxt.A : cA; const char* nB = has_next ? nxt.B : cB;
#pragma unroll 1
        for (int t = 0; t < nt; t += 2) {
            const bool last = (t == nt - 2);
            const char* a1 = cA + (size_t)(t + 1) * kstep;
            const char* a2 = last ? nA : cA + (size_t)(t + 2) * kstep; const char* b2 = last ? nB : cB + (size_t)(t + 2) * kstepB;
            const char* a3 = a2 + kstep; const char* b3 = b2 + kstepB;
            PG8_LDB(B0, 0, 0); PG8_LDB(B1, 0, 1); PG8_SCHED; PG8_LDA(At, 0, 0); PG8_STAGE(PG8_SA(1, 1), a1 + hstepA, voffA);
            PG8_WAIT_V(8); PG8_WAIT_L(0); PG8_BAR; PG8_MMA(0, 0, At, B0); PG8_MMA(0, 1, At, B1); PG8_BAR; PG8_SCHED;
            PG8_LDA(At, 0, 1); PG8_STAGE(PG8_SB(0, 0), b2, voffB); PG8_STAGE(PG8_SB(0, 1), b2 + hstepB, voffB); PG8_STAGE(PG8_SA(0, 0), a2, voffA);
            PG8_WAIT_V(8); PG8_WAIT_L(0); PG8_BAR; PG8_MMA(1, 0, At, B0); PG8_MMA(1, 1, At, B1); PG8_BAR; PG8_SCHED;
            PG8_LDB(B0, 1, 0); PG8_LDB(B1, 1, 1); PG8_SCHED; PG8_LDA(At, 1, 0); PG8_STAGE(PG8_SA(0, 1), a2 + hstepA, voffA);
            PG8_WAIT_V(8); PG8_WAIT_L(0); PG8_BAR; PG8_MMA(0, 0, At, B0); PG8_MMA(0, 1, At, B1); PG8_BAR; PG8_SCHED;
            PG8_LDA(At, 1, 1); PG8_STAGE(PG8_SB(1, 0), b3, voffB); PG8_STAGE(PG8_SB(1, 1), b3 + hstepB, voffB); PG8_STAGE(PG8_SA(1, 0), a3, voffA);
            PG8_WAIT_V(8); PG8_WAIT_L(0); PG8_BAR; PG8_MMA(1, 0, At, B0); PG8_MMA(1, 1, At, B1); PG8_BAR; PG8_SCHED;
        }
        if (wr == 0) PG8_BAR;
        { int fr_ = fr, fq_ = fq; asm volatile("" : "+v"(fr_), "+v"(fq_));
          E(acc, cur, wr, wc, fr_, fq_); }
        if (!has_next) break;
#pragma unroll
        for (int a = 0; a < 2; ++a)
#pragma unroll
            for (int b = 0; b < 2; ++b)
#pragma unroll
                for (int m = 0; m < 4; ++m)
#pragma unroll
                    for (int n = 0; n < 2; ++n) acc[a][b][m][n] = (f32x4){0.f, 0.f, 0.f, 0.f};
        cur = nxt; cA = nA; cB = nB; ++ui;
        if (wr == 1) PG8_BAR;
    }
    PG8_WAIT_V(0);
    PG8_BAR;
#undef PG8_SA
#undef PG8_SB
#undef PG8_STAGE
#undef PG8_LDA
#undef PG8_LDB
#undef PG8_MMA
#undef PG8_WAIT_V
#undef PG8_WAIT_L
#undef PG8_BAR
#undef PG8_SCHED
}

template <class Epi, class Sched, bool GATHER = false>
__device__ __forceinline__ void gemm_phase8(LAS unsigned char* lds, const int K, const int lda, const int ldb, const Sched& S, const Epi& E, const int scx_init = 0x7f7f7f7f, const int* rtab = nullptr, const int gmax = 0) {
    const int tid = threadIdx.x, wid = __builtin_amdgcn_readfirstlane(tid >> 6), lane = tid & 63, wr = wid >> 2, wc = wid & 3, fr = lane & 15, fq = lane >> 4;
    int nt = K / 128; asm volatile("" : "+s"(nt));
    unsigned voffA[2], voffB[2];
#pragma unroll
    for (int i = 0; i < 2; ++i) { int R, C; stage_rc(tid * 16 + i * 8192, R, C); const int Rb = Epi::PERM ? ((R & ~31) + perm32(R & 31)) : R;
        voffA[i] = (unsigned)(R * lda + C * 2); voffB[i] = (unsigned)(Rb * ldb + C * 2); }
    const size_t kstep = 128, kstepB = 128;
    const size_t hstepA = GATHER ? (size_t)0 : (size_t)HALF * lda, hstepB = (size_t)HALF * ldb;
    unsigned vgC[2][2], vgN[2][2];
#define PG8_GLOAD(dst, U_) do { if (GATHER) { _Pragma("unroll") for (int h_ = 0; h_ < 2; ++h_) _Pragma("unroll") for (int i_ = 0; i_ < 2; ++i_) { int R_, C_; stage_rc(tid * 16 + i_ * 8192, R_, C_); \
        int tk_ = rtab[(U_).trow + h_ * HALF + R_] >> 2; tk_ = (h_ * HALF + R_) < (U_).nrow ? tk_ : gmax; tk_ = tk_ < gmax ? tk_ : gmax; tk_ = tk_ > 0 ? tk_ : 0; dst[h_][i_] = (unsigned)(tk_ * lda + C_ * 2); } } } while (0)
#define PG8_VA(h_, nextu) (GATHER ? ((nextu) ? vgN[h_] : vgC[h_]) : voffA)
    const unsigned ldsw = (unsigned)wid * 1024u;
    const int aoff = lds_byte(wr * 64 + fr, fq * 8), boff = lds_byte(wc * 32 + fr, fq * 8);
#define PG8_SA(b, h) (((b) * 2 + (h)) * HTB)
#define PG8_SB(b, h) ((4 + (b) * 2 + (h)) * HTB)
#define PG8_STAGE(bufoff, gbase, voff) do { _Pragma("unroll") for (int _i = 0; _i < 2; ++_i) \
        __builtin_amdgcn_global_load_lds((const unsigned*)((const char*)(gbase) + (voff)[_i]), (LAS unsigned*)(lds + (bufoff) + ldsw + _i * 8192), 16, 0, 0); } while (0)
#define PG8_LDA(dst, b, h) do { _Pragma("unroll") for (int m = 0; m < 4; ++m) { dst[m][0] = *(const LAS u32x4*)(lds + PG8_SA(b, h) + aoff + m * 2048); dst[m][1] = *(const LAS u32x4*)(lds + PG8_SA(b, h) + aoff + m * 2048 + 1024); } } while (0)
#define PG8_LDB(dst, b, h) do { _Pragma("unroll") for (int n = 0; n < 2; ++n) { dst[n][0] = *(const LAS u32x4*)(lds + PG8_SB(b, h) + boff + n * 2048); dst[n][1] = *(const LAS u32x4*)(lds + PG8_SB(b, h) + boff + n * 2048 + 1024); } } while (0)
#define PG8_MMA(ai, bj, At, Bt) do { __builtin_amdgcn_s_setprio(1); _Pragma("unroll") for (int m = 0; m < 4; ++m) _Pragma("unroll") for (int n = 0; n < 2; ++n) { \
        const v8i b_ = __builtin_bit_cast(v8i, __builtin_shufflevector(Bt[n][0], Bt[n][1], 0, 1, 2, 3, 4, 5, 6, 7)), a_ = __builtin_bit_cast(v8i, __builtin_shufflevector(At[m][0], At[m][1], 0, 1, 2, 3, 4, 5, 6, 7)); \
        asm volatile("s_nop 1\n\tv_mfma_scale_f32_16x16x128_f8f6f4 %0, %1, %2, %0, %3, %4 op_sel_hi:[0,0,0]" : "+v"(acc[ai][bj][m][n]) : "v"(b_), "v"(a_), "v"(scw), "v"(scx)); } \
        __builtin_amdgcn_s_setprio(0); } while (0)
#define PG8_WAIT_V(n) asm volatile("s_waitcnt vmcnt(" #n ")" ::: "memory")
#define PG8_WAIT_L(n) asm volatile("s_waitcnt lgkmcnt(" #n ")" ::: "memory")
#define PG8_BAR __builtin_amdgcn_s_barrier()
#define PG8_SCHED __builtin_amdgcn_sched_barrier(0)
    Unit cur, nxt; int ui = 0;
    if (!S.next(0, cur)) return;
    f32x4 acc[2][2][4][2];
#pragma unroll
    for (int a = 0; a < 2; ++a)
#pragma unroll
        for (int b = 0; b < 2; ++b)
#pragma unroll
            for (int m = 0; m < 4; ++m)
#pragma unroll
                for (int n = 0; n < 2; ++n) acc[a][b][m][n] = (f32x4){0.f, 0.f, 0.f, 0.f};
    u32x4 At[4][2], B0[2][2], B1[2][2];
    int scw = 0x7a7a7a7a, scx = scx_init; asm volatile("" : "+v"(scw), "+v"(scx));
    const char* cA = cur.A; const char* cB = cur.B;
    PG8_GLOAD(vgC, cur);
    PG8_STAGE(PG8_SB(0, 0), cB, voffB); PG8_STAGE(PG8_SB(0, 1), cB + hstepB, voffB); PG8_STAGE(PG8_SA(0, 0), cA, PG8_VA(0, false)); PG8_STAGE(PG8_SA(0, 1), cA + hstepA, PG8_VA(1, false));
    if (wr == 1) PG8_BAR;
    PG8_WAIT_V(2); PG8_BAR;
    PG8_STAGE(PG8_SB(1, 0), cB + kstepB, voffB); PG8_STAGE(PG8_SA(1, 0), cA + kstep, PG8_VA(0, false)); PG8_STAGE(PG8_SB(1, 1), cB + hstepB + kstepB, voffB);
    PG8_WAIT_V(6); PG8_BAR;
    for (;;) {
        const bool has_next = S.next(ui + 1, nxt);
        const char* nA = has_next ? nxt.A : cA; const char* nB = has_next ? nxt.B : cB;
        if (has_next) PG8_GLOAD(vgN, nxt);
        const bool full = cur.nrow > HALF;
#pragma unroll 1
        for (int t = 0; t < nt; t += 2) {
            const bool last = (t == nt - 2);
            const char* a1 = cA + (size_t)(t + 1) * kstep;
            const char* a2 = last ? nA : cA + (size_t)(t + 2) * kstep; const char* b2 = last ? nB : cB + (size_t)(t + 2) * kstepB;
            const char* a3 = a2 + kstep; const char* b3 = b2 + kstepB;
            PG8_LDB(B0, 0, 0); PG8_LDB(B1, 0, 1); PG8_SCHED; PG8_LDA(At, 0, 0); PG8_STAGE(PG8_SA(1, 1), a1 + hstepA, PG8_VA(1, false));
            PG8_WAIT_V(8); PG8_WAIT_L(0); PG8_BAR; PG8_MMA(0, 0, At, B0); PG8_MMA(0, 1, At, B1); PG8_BAR; PG8_SCHED;
            if (full) PG8_LDA(At, 0, 1); PG8_STAGE(PG8_SB(0, 0), b2, voffB); PG8_STAGE(PG8_SB(0, 1), b2 + hstepB, voffB); PG8_STAGE(PG8_SA(0, 0), a2, PG8_VA(0, last && has_next));
            PG8_WAIT_V(8); PG8_WAIT_L(0); PG8_BAR; if (full) { PG8_MMA(1, 0, At, B0); PG8_MMA(1, 1, At, B1); } PG8_BAR; PG8_SCHED;
            PG8_LDB(B0, 1, 0); PG8_LDB(B1, 1, 1); PG8_SCHED; PG8_LDA(At, 1, 0); PG8_STAGE(PG8_SA(0, 1), a2 + hstepA, PG8_VA(1, last && has_next));
            PG8_WAIT_V(8); PG8_WAIT_L(0); PG8_BAR; PG8_MMA(0, 0, At, B0); PG8_MMA(0, 1, At, B1); PG8_BAR; PG8_SCHED;
            if (full) PG8_LDA(At, 1, 1); PG8_STAGE(PG8_SB(1, 0), b3, voffB); PG8_STAGE(PG8_SB(1, 1), b3 + hstepB, voffB); PG8_STAGE(PG8_SA(1, 0), a3, PG8_VA(0, last && has_next));
            PG8_WAIT_V(8); PG8_WAIT_L(0); PG8_BAR; if (full) { PG8_MMA(1, 0, At, B0); PG8_MMA(1, 1, At, B1); } PG8_BAR; PG8_SCHED;
        }
        if (wr == 0) PG8_BAR;
        asm volatile("s_nop 15\n\ts_nop 7" ::: "memory");
        { int fr_ = fr, fq_ = fq; asm volatile("" : "+v"(fr_), "+v"(fq_));
          E(acc, cur, wr, wc, fr_, fq_); }
        if (!has_next) break;
#pragma unroll
        for (int a = 0; a < 2; ++a)
#pragma unroll
            for (int b = 0; b < 2; ++b)
#pragma unroll
                for (int m = 0; m < 4; ++m)
#pragma unroll
                    for (int n = 0; n < 2; ++n) acc[a][b][m][n] = (f32x4){0.f, 0.f, 0.f, 0.f};
        cur = nxt; cA = nA; cB = nB; ++ui;
        if (GATHER) { _Pragma("unroll") for (int h_ = 0; h_ < 2; ++h_) _Pragma("unroll") for (int i_ = 0; i_ < 2; ++i_) vgC[h_][i_] = vgN[h_][i_]; }
        if (wr == 1) PG8_BAR;
    }
    PG8_WAIT_V(0);
    PG8_BAR;
#undef PG8_SA
#undef PG8_SB
#undef PG8_STAGE
#undef PG8_GLOAD
#undef PG8_VA
#undef PG8_LDA
#undef PG8_LDB
#undef PG8_MMA
#undef PG8_WAIT_V
#undef PG8_WAIT_L
#undef PG8_BAR
#undef PG8_SCHED
}

struct EpiProj {
    static constexpr bool PERM = true;
    unsigned char* ws; const float* bbg;
    __device__ __forceinline__ void operator()(const f32x4 (&acc)[2][2][4][2], const Unit& u, int wr, int wc, int fr, int fq) const {
        const int pn = u.pn; size_t off; int ld, t0, act = 0;
        if (pn < 4) { off = WS_GQ; ld = 1024; t0 = 0; } else if (pn < 8) { off = WS_GK; ld = 1024; t0 = 4; } else if (pn < 16) { off = WS_GV; ld = 2048; t0 = 8; }
        else if (pn < 24) { off = WS_GR; ld = 2048; t0 = 16; act = 1; } else if (pn < 28) { off = WS_AQ; ld = 1024; t0 = 24; } else if (pn < 32) { off = WS_AK; ld = 1024; t0 = 28; }
        else if (pn < 36) { off = WS_AV; ld = 1024; t0 = 32; } else if (pn < 44) { off = WS_SG; ld = 2048; t0 = 36; act = 2; } else { off = WS_SA; ld = 2048; t0 = 44; act = 3; }
        bf16* base = (bf16*)(ws + off);
        const int colt = (pn - t0) * BM + wc * 32 + 8 * fq, row0 = u.pm * BM + wr * 64 + fr;
        f32x4 bv[2][2];
#pragma unroll
        for (int bj = 0; bj < 2; ++bj)
#pragma unroll
            for (int n = 0; n < 2; ++n) bv[bj][n] = act >= 2 ? *(const f32x4*)(bbg + (act - 2) * D + colt + bj * HALF + 4 * n) : (f32x4){0.f, 0.f, 0.f, 0.f};
#pragma unroll
        for (int ai = 0; ai < 2; ++ai)
#pragma unroll
            for (int m = 0; m < 4; ++m) { bf16* rowp = base + (size_t)(row0 + ai * HALF + m * 16) * ld + colt;
#pragma unroll
                for (int bj = 0; bj < 2; ++bj) { f32x4 v0 = acc[ai][bj][m][0] + bv[bj][0], v1 = acc[ai][bj][m][1] + bv[bj][1];
                    if (act == 1) {
#pragma unroll
                        for (int j = 0; j < 4; ++j) { v0[j] = v0[j] * sigmoidf_(v0[j]); v1[j] = v1[j] * sigmoidf_(v1[j]); } }
                    else if (act >= 2) {
#pragma unroll
                        for (int j = 0; j < 4; ++j) { v0[j] = sigmoidf_(v0[j]); v1[j] = sigmoidf_(v1[j]); } }
                    if (act == 3 || (pn >= 24 && pn < 36)) {
                        int a8 = 0, b8 = 0; a8 = __builtin_amdgcn_cvt_pk_fp8_f32(v0[0], v0[1], a8, false); a8 = __builtin_amdgcn_cvt_pk_fp8_f32(v0[2], v0[3], a8, true);
                        b8 = __builtin_amdgcn_cvt_pk_fp8_f32(v1[0], v1[1], b8, false); b8 = __builtin_amdgcn_cvt_pk_fp8_f32(v1[2], v1[3], b8, true);
                        *(u32x2*)((unsigned char*)base + (size_t)(row0 + ai * HALF + m * 16) * ld + colt + bj * HALF) = (u32x2){(unsigned)a8, (unsigned)b8}; }
                    else {
                    u32x4 w; w.x = cvt_pk_bf16(v0[0], v0[1]); w.y = cvt_pk_bf16(v0[2], v0[3]); w.z = cvt_pk_bf16(v1[0], v1[1]); w.w = cvt_pk_bf16(v1[2], v1[3]);
                    *(u32x4*)(rowp + bj * HALF) = w; } } }
    }
};
template <int MODE> struct EpiBranch {
    static constexpr bool PERM = true;
    const void* gate; const unsigned char* tin; void* out;
    __device__ __forceinline__ void operator()(const f32x4 (&acc)[2][2][4][2], const Unit& u, int wr, int wc, int fr, int fq) const {
        const int colt = u.pn * BM + wc * 32 + 8 * fq, row0 = u.pm * BM + wr * 64 + fr;
#pragma unroll
        for (int ai = 0; ai < 2; ++ai) {
            u32x4 gq4[4][2]; u32x2 gq2[4][2], tq2[4][2];
#pragma unroll
            for (int m = 0; m < 4; ++m) { const size_t ro = (size_t)(row0 + ai * HALF + m * 16) * D + colt;
#pragma unroll
                for (int bj = 0; bj < 2; ++bj) {
                    if (MODE == 0) gq2[m][bj] = *(const u32x2*)((const unsigned char*)gate + ro + bj * HALF);
                    else { gq4[m][bj] = *(const u32x4*)((const bf16*)gate + ro + bj * HALF); tq2[m][bj] = *(const u32x2*)(tin + ro + bj * HALF); } } }
#pragma unroll
            for (int m = 0; m < 4; ++m) { const size_t ro = (size_t)(row0 + ai * HALF + m * 16) * D + colt;
#pragma unroll
                for (int bj = 0; bj < 2; ++bj) {
                    float r[8], gt[8], tt[8];
#pragma unroll
                    for (int j = 0; j < 4; ++j) { r[j] = acc[ai][bj][m][0][j]; r[4 + j] = acc[ai][bj][m][1][j]; }
                    if (MODE == 0) { const u32x2 gq = gq2[m][bj];
#pragma unroll
                        for (int q = 0; q < 2; ++q) { const f32x2_t lo = __builtin_amdgcn_cvt_pk_f32_fp8((int)gq[q], false), hi = __builtin_amdgcn_cvt_pk_f32_fp8((int)gq[q], true);
                            gt[4 * q] = lo.x; gt[4 * q + 1] = lo.y; gt[4 * q + 2] = hi.x; gt[4 * q + 3] = hi.y; }
                        int a8 = 0, b8 = 0;
                        a8 = __builtin_amdgcn_cvt_pk_fp8_f32(r[0] * gt[0] * 64.f, r[1] * gt[1] * 64.f, a8, false); a8 = __builtin_amdgcn_cvt_pk_fp8_f32(r[2] * gt[2] * 64.f, r[3] * gt[3] * 64.f, a8, true);
                        b8 = __builtin_amdgcn_cvt_pk_fp8_f32(r[4] * gt[4] * 64.f, r[5] * gt[5] * 64.f, b8, false); b8 = __builtin_amdgcn_cvt_pk_fp8_f32(r[6] * gt[6] * 64.f, r[7] * gt[7] * 64.f, b8, true);
                        *(u32x2*)((unsigned char*)out + ro + bj * HALF) = (u32x2){(unsigned)a8, (unsigned)b8}; }
                    else { const u32x4 gq = gq4[m][bj]; const u32x2 tq = tq2[m][bj];
#pragma unroll
                        for (int j = 0; j < 4; ++j) { gt[2 * j] = __uint_as_float(gq[j] << 16); gt[2 * j + 1] = __uint_as_float(gq[j] & 0xffff0000u); }
#pragma unroll
                        for (int q = 0; q < 2; ++q) { const f32x2_t lo = __builtin_amdgcn_cvt_pk_f32_fp8((int)tq[q], false), hi = __builtin_amdgcn_cvt_pk_f32_fp8((int)tq[q], true);
                            tt[4 * q] = lo.x; tt[4 * q + 1] = lo.y; tt[4 * q + 2] = hi.x; tt[4 * q + 3] = hi.y; }
#pragma unroll
                        for (int j = 0; j < 8; ++j) r[j] = fmaf(r[j], gt[j], tt[j] * 0.015625f);
                        u32x4 w; w.x = cvt_pk_bf16(r[0], r[1]); w.y = cvt_pk_bf16(r[2], r[3]); w.z = cvt_pk_bf16(r[4], r[5]); w.w = cvt_pk_bf16(r[6], r[7]);
                        *(u32x4*)((bf16*)out + ro + bj * HALF) = w; } } } }
    }
};
struct EpiResid {
    static constexpr bool PERM = true;
    const float* x; bf16* out;
    __device__ __forceinline__ void operator()(const f32x4 (&acc)[2][2][4][2], const Unit& u, int wr, int wc, int fr, int fq) const {
        const int colt = u.pn * BM + wc * 32 + 8 * fq, row0 = u.pm * BM + wr * 64 + fr;
#pragma unroll
        for (int ai = 0; ai < 2; ++ai)
#pragma unroll
          for (int mp = 0; mp < 4; mp += 2) {
            f32x4 xq[2][2][2];
#pragma unroll
            for (int mm = 0; mm < 2; ++mm) { const size_t ro = (size_t)(row0 + ai * HALF + (mp + mm) * 16) * D + colt;
#pragma unroll
                for (int bj = 0; bj < 2; ++bj) { xq[mm][bj][0] = *(const f32x4*)(x + ro + bj * HALF); xq[mm][bj][1] = *(const f32x4*)(x + ro + bj * HALF + 4); } }
#pragma unroll
            for (int mm = 0; mm < 2; ++mm) { const int m = mp + mm; const size_t ro = (size_t)(row0 + ai * HALF + m * 16) * D + colt;
#pragma unroll
                for (int bj = 0; bj < 2; ++bj) { const f32x4 v0 = xq[mm][bj][0] + acc[ai][bj][m][0], v1 = xq[mm][bj][1] + acc[ai][bj][m][1];
                    u32x4 w; w.x = cvt_pk_bf16(v0[0], v0[1]); w.y = cvt_pk_bf16(v0[2], v0[3]); w.z = cvt_pk_bf16(v1[0], v1[1]); w.w = cvt_pk_bf16(v1[2], v1[3]);
                    *(u32x4*)(out + ro + bj * HALF) = w; } } }
    }
};
struct EpiSwiglu {
    static constexpr bool PERM = true;
    const float* bgate; const float* bup; unsigned char* hd;
    __device__ __forceinline__ void operator()(const f32x4 (&acc)[2][2][4][2], const Unit& u, int wr, int wc, int fr, int fq) const {
        const int col = u.pn * HALF + wc * 32 + 8 * fq; const size_t row0 = (size_t)u.pm * BM + wr * 64 + fr;
        const float* bg = bgate + (size_t)u.e * DFF + col; const float* bu = bup + (size_t)u.e * DFF + col;
        const f32x4 g0 = *(const f32x4*)bg, g1 = *(const f32x4*)(bg + 4), u0 = *(const f32x4*)bu, u1 = *(const f32x4*)(bu + 4);
#pragma unroll
        for (int ai = 0; ai < 2; ++ai)
#pragma unroll
            for (int m = 0; m < 4; ++m) {
                float r[8];
#pragma unroll
                for (int j = 0; j < 4; ++j) {
                    const float ga = fminf(acc[ai][0][m][0][j] + g0[j], 7.f), ua = fminf(fmaxf(acc[ai][1][m][0][j] + u0[j], -7.f), 7.f);
                    const float gb = fminf(acc[ai][0][m][1][j] + g1[j], 7.f), ub = fminf(fmaxf(acc[ai][1][m][1][j] + u1[j], -7.f), 7.f);
                    r[j] = (ua + 1.f) * (ga * sigmoidf_(1.702f * ga)); r[4 + j] = (ub + 1.f) * (gb * sigmoidf_(1.702f * gb)); }
                int w0 = 0, w1 = 0;
                w0 = __builtin_amdgcn_cvt_pk_fp8_f32(r[0], r[1], w0, false); w0 = __builtin_amdgcn_cvt_pk_fp8_f32(r[2], r[3], w0, true);
                w1 = __builtin_amdgcn_cvt_pk_fp8_f32(r[4], r[5], w1, false); w1 = __builtin_amdgcn_cvt_pk_fp8_f32(r[6], r[7], w1, true);
                *(u32x2*)(hd + (row0 + ai * HALF + m * 16) * DFF + col) = (u32x2){(unsigned)w0, (unsigned)w1}; }
    }
};
struct EpiDown {
    static constexpr bool PERM = true;
    const float* bdown; const int* rpair; const float* rw; unsigned char* py;
    __device__ __forceinline__ void operator()(const f32x4 (&acc)[2][2][4][2], const Unit& u, int wr, int wc, int fr, int fq) const {
        const int colt = u.pn * BM + wc * 32 + 8 * fq; const size_t srow0 = (size_t)u.pm * BM + wr * 64 + fr;
        f32x4 bv[2][2];
#pragma unroll
        for (int bj = 0; bj < 2; ++bj)
#pragma unroll
            for (int n = 0; n < 2; ++n) bv[bj][n] = *(const f32x4*)(bdown + (size_t)u.e * D + colt + bj * HALF + 4 * n);
        int pairs[2][4]; float wgts[2][4];
#pragma unroll
        for (int ai = 0; ai < 2; ++ai)
#pragma unroll
            for (int m = 0; m < 4; ++m) { const int rl = wr * 64 + fr + ai * HALF + m * 16; const int pq = rpair[u.trow + rl]; const float wq = rw[u.trow + rl];
                pairs[ai][m] = rl < u.nrow ? pq : S * 4; wgts[ai][m] = rl < u.nrow ? wq : 0.f; }
#pragma unroll
        for (int ai = 0; ai < 2; ++ai)
#pragma unroll
            for (int m = 0; m < 4; ++m) { const int pair = pairs[ai][m]; const float wgt = wgts[ai][m];
                unsigned char* rowp = py + (size_t)pair * D + colt; const float w16 = wgt * 16.f;
#pragma unroll
                for (int bj = 0; bj < 2; ++bj) { const f32x4 v0 = (acc[ai][bj][m][0] + bv[bj][0]) * w16, v1 = (acc[ai][bj][m][1] + bv[bj][1]) * w16;
                    int w0 = 0, w1 = 0;
                    w0 = __builtin_amdgcn_cvt_pk_fp8_f32(v0[0], v0[1], w0, false); w0 = __builtin_amdgcn_cvt_pk_fp8_f32(v0[2], v0[3], w0, true);
                    w1 = __builtin_amdgcn_cvt_pk_fp8_f32(v1[0], v1[1], w1, false); w1 = __builtin_amdgcn_cvt_pk_fp8_f32(v1[2], v1[3], w1, true);
                    *(u32x2*)(rowp + bj * HALF) = (u32x2){(unsigned)w0, (unsigned)w1}; } }
    }
};

struct GlaSched {
    int mode, G, c; unsigned char* ws;
    __device__ __forceinline__ bool next(int i, Unit& u) const {
        const int L = i * G + c; const int nu = mode == 0 ? 128 : 256; if (L >= nu) return false;
        const int nh = mode == 0 ? L : (L >> 1), hv = mode == 0 ? 0 : (L & 1);
        u.pm = nh; u.pn = hv; u.e = 0; u.nrow = BM;
        if (mode == 0) { u.A = (const char*)(ws + WS_ACAT) + (size_t)nh * 256 * 512 * 2 + 512; u.B = (const char*)(ws + WS_KI) + (size_t)nh * 256 * 256 * 2; }
        else if (mode == 1) { u.A = (const char*)(ws + WS_BCAT) + (size_t)nh * 512 * 512 * 2 + (size_t)hv * 256 * 512 * 2; u.B = (const char*)(ws + WS_KET) + (size_t)nh * 256 * 256 * 2; }
        else { u.A = (const char*)(ws + WS_ACAT) + (size_t)nh * 256 * 512 * 2; u.B = (const char*)(ws + WS_BCAT) + (size_t)nh * 512 * 512 * 2 + (size_t)hv * 256 * 512 * 2; }
        return true;
    }
};
struct EpiGlaNorm {
    static constexpr bool PERM = true;
    unsigned char* ws; const float* g; unsigned* ctl; LAS float* scr;
    __device__ __forceinline__ void operator()(const f32x4 (&acc)[2][2][4][2], const Unit& u, int wr, int wc, int fr, int fq) const {
        const int nh = u.pm, hv = u.pn, unit = nh * 2 + hv, tid = threadIdx.x;
        LAS float* rowpart = scr; LAS float* rstdv = scr + 1024;
#pragma unroll
        for (int ai = 0; ai < 2; ++ai)
#pragma unroll
            for (int m = 0; m < 4; ++m) { float sq = 0.f;
#pragma unroll
                for (int bj = 0; bj < 2; ++bj)
#pragma unroll
                    for (int n = 0; n < 2; ++n)
#pragma unroll
                        for (int j = 0; j < 4; ++j) sq = fmaf(acc[ai][bj][m][n][j], acc[ai][bj][m][n][j], sq);
                sq += __shfl_xor(sq, 16); sq += __shfl_xor(sq, 32);
                if (fq == 0) rowpart[wc * 256 + wr * 64 + ai * HALF + m * 16 + fr] = sq; }
        asm volatile("s_waitcnt lgkmcnt(0)" ::: "memory"); __builtin_amdgcn_s_barrier();
        float mine = 0.f; float* slot = (float*)(ws + WS_PSLOT);
        if (tid < 256) { mine = rowpart[tid] + rowpart[256 + tid] + rowpart[512 + tid] + rowpart[768 + tid]; __hip_atomic_store(slot + unit * 256 + tid, mine, __ATOMIC_RELAXED, __HIP_MEMORY_SCOPE_AGENT); }
        asm volatile("s_waitcnt vmcnt(0)" ::: "memory"); __builtin_amdgcn_s_barrier();
        if (tid == 0) { unsigned* ctr = ctl + CW_PS + 16 * nh; (void)__hip_atomic_fetch_add(ctr, 1u, __ATOMIC_RELAXED, __HIP_MEMORY_SCOPE_AGENT);
            unsigned sp = 0u; while (__hip_atomic_load(ctr, __ATOMIC_RELAXED, __HIP_MEMORY_SCOPE_AGENT) < 2u) { __builtin_amdgcn_s_sleep(1); if (++sp > (1u << 20)) break; }
            __builtin_amdgcn_fence(__ATOMIC_ACQUIRE, "agent"); asm volatile("s_waitcnt vmcnt(0)" ::: "memory"); }
        __builtin_amdgcn_s_barrier();
        if (tid < 256) { const float other = __hip_atomic_load(slot + (unit ^ 1) * 256 + tid, __ATOMIC_RELAXED, __HIP_MEMORY_SCOPE_AGENT); rstdv[tid] = rsqrtf((mine + other) * (1.f / GLA_DV) + 1e-6f); }
        asm volatile("s_waitcnt vmcnt(0) lgkmcnt(0)" ::: "memory"); __builtin_amdgcn_s_barrier();
        const int c8 = wc * 32 + 8 * fq, colh = hv * 256 + c8; const size_t tok0 = (size_t)(nh >> 2) * 256; const int colg = (nh & 3) * GLA_DV + colh;
        const bf16* GR = (const bf16*)(ws + WS_GR); bf16* YG = (bf16*)(ws + WS_YG);
        float gv[2][8];
#pragma unroll
        for (int bj = 0; bj < 2; ++bj) { const f32x4 a0 = *(const f32x4*)(g + colh + bj * HALF), a1 = *(const f32x4*)(g + colh + bj * HALF + 4);
#pragma unroll
            for (int j = 0; j < 4; ++j) { gv[bj][j] = a0[j]; gv[bj][4 + j] = a1[j]; } }
#pragma unroll
        for (int ai = 0; ai < 2; ++ai) {
            u32x4 rq[4][2];
#pragma unroll
            for (int m = 0; m < 4; ++m)
#pragma unroll
                for (int bj = 0; bj < 2; ++bj) rq[m][bj] = *(const u32x4*)(GR + (tok0 + wr * 64 + ai * HALF + m * 16 + fr) * GLA_V + colg + bj * HALF);
#pragma unroll
            for (int m = 0; m < 4; ++m) { const int row = wr * 64 + ai * HALF + m * 16 + fr; const float rs = rstdv[row];
#pragma unroll
                for (int bj = 0; bj < 2; ++bj) { float y[8];
#pragma unroll
                    for (int j = 0; j < 4; ++j) { y[j] = acc[ai][bj][m][0][j]; y[4 + j] = acc[ai][bj][m][1][j]; }
#pragma unroll
                    for (int j = 0; j < 4; ++j) { const unsigned rw_ = rq[m][bj][j];
                        y[2 * j] = y[2 * j] * rs * gv[bj][2 * j] * __uint_as_float(rw_ << 16); y[2 * j + 1] = y[2 * j + 1] * rs * gv[bj][2 * j + 1] * __uint_as_float(rw_ & 0xffff0000u); }
                    u32x4 w; w.x = cvt_pk_bf16(y[0], y[1]); w.y = cvt_pk_bf16(y[2], y[3]); w.z = cvt_pk_bf16(y[4], y[5]); w.w = cvt_pk_bf16(y[6], y[7]);
                    *(u32x4*)(YG + (tok0 + row) * GLA_V + colg + bj * HALF) = w; } } }
    }
};
template <int MODE> struct EpiGla {
    static constexpr bool PERM = true;
    unsigned char* ws;
    __device__ __forceinline__ void operator()(const f32x4 (&acc)[2][2][4][2], const Unit& u, int wr, int wc, int fr, int fq) const {
        const int nh = u.pm, hv = u.pn; const int c8 = wc * 32 + 8 * fq, r0 = wr * 64 + fr;
        bf16* base; int ld;
        if (MODE == 0) { base = (bf16*)(ws + WS_ACAT) + (size_t)nh * 256 * 512; ld = 512; }
        else if (MODE == 1) { base = (bf16*)(ws + WS_UT) + (size_t)nh * 512 * 256 + (size_t)hv * 256 * 256; ld = 256; }
        else { base = (bf16*)(ws + WS_OB) + (size_t)(nh >> 2) * 256 * GLA_V + (nh & 3) * GLA_DV + hv * 256; ld = GLA_V; }
#pragma unroll
        for (int ai = 0; ai < 2; ++ai)
#pragma unroll
            for (int m = 0; m < 4; ++m) { const int row = r0 + ai * HALF + m * 16;
#pragma unroll
                for (int bj = 0; bj < 2; ++bj) { f32x4 v0 = acc[ai][bj][m][0], v1 = acc[ai][bj][m][1]; const int col = bj * HALF + c8;
                    if (MODE == 0) {
#pragma unroll
                        for (int j = 0; j < 4; ++j) { v0[j] = (col + j <= row) ? v0[j] : 0.f; v1[j] = (col + 4 + j <= row) ? v1[j] : 0.f; } }
                    u32x4 w; w.x = cvt_pk_bf16(v0[0], v0[1]); w.y = cvt_pk_bf16(v0[2], v0[3]); w.z = cvt_pk_bf16(v1[0], v1[1]); w.w = cvt_pk_bf16(v1[2], v1[3]);
                    *(u32x4*)(base + (size_t)row * ld + col) = w; } }
    }
};
}

constexpr int NWAVES = 8;
#ifndef GEMM_CUS
#define GEMM_CUS 156
#endif
constexpr int RING_BYTES = 131072, CTLZ_OFF = 139264, MISC_OFF = CTLZ_OFF + 320, LDS_BYTES = 147456;
constexpr int TAB_OFF = MISC_OFF + 128;

struct Frame {
    LAS unsigned char* lds; volatile LAS unsigned* MISC; unsigned* ctl; unsigned char* ws;
    int tid, lane, wave, vcu, G;
};
struct Args { const float* in[22]; float* out; unsigned char* ws; int ph_lo, ph_hi, li, pad; };

struct P0Item { const float* src; bf16* dst; int ldn, K; };
constexpr int P0_I_IN = 24 * 256, P0_JIT_A = 2 * pg8::JIT_EARLY * 256, P0_I_BG = 32 * 64, P0_I_BA = 16 * 64, P0_I_OUT = 32 * 64, P0_I_E = 32 * 64;
constexpr int P0_I_SMALL = P0_I_IN + P0_I_BG + P0_I_BA + P0_I_OUT, P0_NITEMS = P0_I_SMALL;
__device__ __forceinline__ P0Item p0_decode(Frame& F, const Args& a, int r) {
    constexpr int I_IN = P0_I_IN, I_BG = P0_I_BG, I_BA = P0_I_BA;
    P0Item it;
    if (r < I_IN) {
        const int p = r >> 8, j = (p & 1) * 12 + (p >> 1), T = j, nb = 8 * T + (r & 7), kb = (r >> 3) & 31, d0 = nb * 32, s0 = d0 < C_GLR ? d0 : d0 + 16;
        it.src = a.in[2] + (size_t)kb * 64 * IN_COLS + s0; it.ldn = IN_COLS; it.dst = (bf16*)(F.ws + WS_WIN) + (size_t)d0 * D + kb * 64; it.K = D; return it; } r -= I_IN;
    if (r < I_BG) { const int nb = r % 64, kb = r / 64; it.src = a.in[10] + (size_t)kb * 64 * D + nb * 32; it.ldn = D; it.dst = (bf16*)(F.ws + WS_WBG) + (size_t)nb * 32 * GLA_V + kb * 64; it.K = GLA_V; return it; } r -= I_BG;
    if (r < I_BA) { const int nb = r % 64, kb = r / 64; it.src = a.in[11] + (size_t)kb * 64 * D + nb * 32; it.ldn = D; it.dst = (bf16*)(F.ws + WS_WBA) + (size_t)nb * 32 * ATT_W + kb * 64; it.K = ATT_W; return it; } r -= I_BA;
    { const int nb = r % 64, kb = r / 64; it.src = a.in[12] + (size_t)kb * 64 * D + nb * 32; it.ldn = D; it.dst = (bf16*)(F.ws + WS_WOUT) + (size_t)nb * 32 * D + kb * 64; it.K = D; }
    return it;
}
__device__ __forceinline__ void p0_load(const P0Item& it, int lane, f32x4 (&v)[8]) {
    const float* p = it.src + (size_t)(lane >> 3) * it.ldn + 4 * (lane & 7);
#pragma unroll
    for (int i = 0; i < 8; ++i) v[i] = __builtin_nontemporal_load((const GAS f32x4*)(p + (size_t)(8 * i) * it.ldn));
}
__device__ __forceinline__ void p0_convert(Frame& F, const Args& a, int it_lo, int it_hi, int gw, int NGW) {
    LAS float* scr = (LAS float*)(F.lds + F.wave * 16384);
    const int lane = F.lane;
    int itx = it_lo + gw;
    if (itx >= it_hi) return;
    P0Item cur = p0_decode(F, a, itx);
    f32x4 v[8]; p0_load(cur, lane, v);
    for (;;) {
        const int nx = itx + NGW; const bool more = nx < it_hi;
        P0Item nxt = cur; f32x4 vn[8];
        if (more) { nxt = p0_decode(F, a, nx); p0_load(nxt, lane, vn); }
#pragma unroll
        for (int i = 0; i < 8; ++i) { LAS float* q = scr + (8 * i + (lane >> 3)) * 33 + 4 * (lane & 7); q[0] = v[i].x; q[1] = v[i].y; q[2] = v[i].z; q[3] = v[i].w; }
        LDS_WAIT(); asm volatile("" ::: "memory");
        const int c = lane & 7;
#pragma unroll
        for (int j = 0; j < 4; ++j) { const int n = (lane >> 3) + 8 * j; const LAS float* sp = scr + (8 * c) * 33 + n;
            u32x4 o; o.x = pk2(sp[0 * 33], sp[1 * 33]); o.y = pk2(sp[2 * 33], sp[3 * 33]); o.z = pk2(sp[4 * 33], sp[5 * 33]); o.w = pk2(sp[6 * 33], sp[7 * 33]);
            __builtin_nontemporal_store(o, (GAS u32x4*)(cur.dst + (size_t)n * cur.K + 8 * c)); }
        LDS_WAIT(); asm volatile("" ::: "memory");
        if (!more) break;
        itx = nx; cur = nxt;
#pragma unroll
        for (int i = 0; i < 8; ++i) v[i] = vn[i];
    }
}
constexpr int P8_NITEMS = 3 * NE * 16 * 64, P8_ALL = P8_NITEMS + 16 * 224, P8_BA = 8 * 64, P8_END = P8_ALL + P8_BA;
__device__ __forceinline__ void p0_item8(Frame& F, const Args& a, const int it) {
    LAS unsigned char* tile = F.lds + F.wave * 16384;
    const int lane = F.lane, kq = lane >> 3, n4 = lane & 7;
    {
        const int which = it / (NE * 1024), e = (it >> 10) & 31, kb = (it >> 6) & 15, nb = it & 63, k0 = kb * 128, n0 = nb * 32;
        const float* src; unsigned char* dst; int ldn, dpitch = 2048;
        if (it >= P8_ALL) { const int r = it - P8_ALL, kb2 = r >> 6, nb2 = r & 63; src = a.in[11] + (size_t)(kb2 * 128) * D + nb2 * 32; ldn = D; dst = F.ws + WS_WBA8 + (size_t)(nb2 * 32) * ATT_W + kb2 * 128; dpitch = ATT_W; }
        else if (it >= P8_NITEMS) { const int r = it - P8_NITEMS, kb2 = r / 224, nb2 = r - kb2 * 224, d0 = 6144 + 32 * nb2; src = a.in[2] + (size_t)(kb2 * 128) * IN_COLS + d0 + 16; ldn = IN_COLS; dst = F.ws + WS_WIN8 + (size_t)(nb2 * 32) * D + kb2 * 128; }
        else if (which < 2) { src = (which ? a.in[18] : a.in[16]) + (size_t)e * D * DFF + (size_t)k0 * DFF + n0; ldn = DFF;
            dst = F.ws + WS_GU + (size_t)e * 2 * DFF * D + (size_t)((n0 >> 7) * 256 + (n0 & 127) + which * 128) * D + k0; }
        else { src = a.in[20] + (size_t)e * DFF * D + (size_t)k0 * D + n0; ldn = D; dst = F.ws + WS_DN + (size_t)e * D * DFF + (size_t)n0 * DFF + k0; }
        const float* p = src + (size_t)(4 * kq) * ldn + 4 * n4;
        f32x4 v[4][4];
#pragma unroll
        for (int ps = 0; ps < 4; ++ps)
#pragma unroll
            for (int i = 0; i < 4; ++i) v[ps][i] = __builtin_nontemporal_load((const GAS f32x4*)(p + (size_t)(32 * ps + i) * ldn));
#pragma unroll
        for (int ps = 0; ps < 4; ++ps)
#pragma unroll
            for (int c = 0; c < 4; ++c) { int w = 0;
                w = __builtin_amdgcn_cvt_pk_fp8_f32(v[ps][0][c] * 32.f, v[ps][1][c] * 32.f, w, false); w = __builtin_amdgcn_cvt_pk_fp8_f32(v[ps][2][c] * 32.f, v[ps][3][c] * 32.f, w, true);
                *(LAS int*)(tile + (4 * n4 + c) * 144 + 32 * ps + 4 * kq) = w; }
        LDS_WAIT(); asm volatile("" ::: "memory");
#pragma unroll
        for (int j = 0; j < 4; ++j) { const int n = (lane >> 3) + 8 * j, c16 = lane & 7; const u32x4 g = *(const LAS u32x4*)(tile + n * 144 + 16 * c16);
            __builtin_nontemporal_store(g, (GAS u32x4*)(dst + (size_t)n * dpitch + 16 * c16)); }
        LDS_WAIT(); asm volatile("" ::: "memory");
    }
}
__device__ __forceinline__ void p0_convert8(Frame& F, const Args& a, int it_lo, int it_hi, int gw, int NGW) {
    for (int it = it_lo + gw; it < it_hi; it += NGW) p0_item8(F, a, it);
}
__device__ __forceinline__ void p0_convert8_queue(Frame& F, const Args& a, unsigned* qbase, int nitems) {
    const int per = nitems / 8, x0 = (int)(xb_xcc_id() & 7u);
    for (int dq = 0; dq < 8; ++dq) {
        const int x = (x0 + dq) & 7, base = x * per; unsigned* q = qbase + 64 * x;
        unsigned tk = 0u; if (F.lane == 0) tk = __hip_atomic_fetch_add(q, 1u, __ATOMIC_RELAXED, __HIP_MEMORY_SCOPE_AGENT);
        int t = __builtin_amdgcn_readfirstlane((int)tk);
        while (2 * t < per) {
            tk = 0u; if (F.lane == 0) tk = __hip_atomic_fetch_add(q, 1u, __ATOMIC_RELAXED, __HIP_MEMORY_SCOPE_AGENT);
            p0_item8(F, a, base + 2 * t); p0_item8(F, a, base + 2 * t + 1);
            t = __builtin_amdgcn_readfirstlane((int)tk);
        }
    }
}
__device__ __forceinline__ void jit_publish(unsigned* flag, int wave, int lane) {
    asm volatile("s_waitcnt vmcnt(0)" ::: "memory");
    __syncthreads();
    if (wave == 0) {
        __builtin_amdgcn_fence(__ATOMIC_RELEASE, "agent");
        asm volatile("s_waitcnt vmcnt(0)" ::: "memory");
        if (lane == 0) (void)__hip_atomic_fetch_add(flag, 1u, __ATOMIC_RELAXED, __HIP_MEMORY_SCOPE_AGENT);
    }
}
__device__ __forceinline__ void p0_rows(Frame& F, const Args& a) {
    { const float* g2 = a.in[13]; const float* wr = a.in[14]; float* WR = (float*)(F.ws + WS_WR);
      for (int i = (F.vcu * NWAVES * 64) + F.tid; i < D * NE; i += F.G * NWAVES * 64) WR[i] = g2[i >> 5] * wr[i]; }
}

template <int MODE> __device__ __forceinline__ void normproj_unit(Frame& F, const Args& a, int tile) {
    const int w = F.wave, lane = F.lane, tid = F.tid, i = lane & 31, kk = lane >> 5, t0 = tile * 32;
    const float* X = MODE == 0 ? a.in[0] : (const float*)(F.ws + WS_H1); const float* g = MODE == 0 ? a.in[1] : a.in[13];
    const float* WR = (const float*)(F.ws + WS_WR); const float* br = a.in[15]; const float* w_in = a.in[2];
    LAS float* part = (LAS float*)F.lds;
    LAS float* ssq = part + 8192;
    LAS float* lg = ssq + 256;
    LAS float* rs = lg + 32 * 33;
    LAS unsigned* lcnt = (LAS unsigned*)(rs + 32); LAS unsigned* lbase = lcnt + 32; LAS unsigned* prec = lbase + 32; LAS float* pwgt = (LAS float*)(prec + 128);
    __syncthreads();
    if (MODE == 1 && tid < NE) lcnt[tid] = 0u;
    f32x16 acc;
#pragma unroll
    for (int r = 0; r < 16; ++r) acc[r] = 0.f;
    float ss = 0.f;
    const int kbase = 256 * w + 128 * kk;
    const float* arow = X + (size_t)(t0 + i) * D + kbase;
    const bf16* Xb = (const bf16*)(F.ws + WS_H1); const bf16* arowb = Xb + (size_t)(t0 + i) * D + kbase;
    LAS float* Bl = (LAS float*)(F.lds + 65536 + 8192 * w);
    constexpr int NB = MODE == 1 ? 8 : 4;
    if (MODE == 0) { for (int z = lane; z < 1024; z += 64) Bl[(z >> 4) * 32 + 16 + (z & 15)] = 0.f; }
    f32x4 av[8], bv[NB];
#define NP_LOADA(c_, d_) do { _Pragma("unroll") for (int q = 0; q < 8; ++q) d_[q] = *(const GAS f32x4*)(arow + 32 * (c_) + 4 * q); } while (0)
#define NP_LOADA_RAW(c_, d_) do { _Pragma("unroll") for (int q = 0; q < 4; ++q) d_[q] = *(const GAS u32x4*)(arowb + 32 * (c_) + 8 * q); } while (0)
#define NP_UNPACK(r_, d_) do { _Pragma("unroll") for (int q = 0; q < 4; ++q) { \
        d_[2 * q] = (f32x4){__uint_as_float(r_[q].x << 16), __uint_as_float(r_[q].x & 0xffff0000u), __uint_as_float(r_[q].y << 16), __uint_as_float(r_[q].y & 0xffff0000u)}; \
        d_[2 * q + 1] = (f32x4){__uint_as_float(r_[q].z << 16), __uint_as_float(r_[q].z & 0xffff0000u), __uint_as_float(r_[q].w << 16), __uint_as_float(r_[q].w & 0xffff0000u)}; } } while (0)
#define NP_LOADB(c_, d_) do { _Pragma("unroll") for (int r = 0; r < NB; ++r) { const int idx = lane + 64 * r; \
        if (MODE == 1) { const int kkr = idx >> 8, rem = idx & 255, s_ = rem >> 3, f4 = rem & 7; d_[r] = *(const GAS f32x4*)(WR + (size_t)(256 * w + 128 * kkr + 32 * (c_) + s_) * NE + 4 * f4); } \
        else { const int kkr = idx >> 7, rem = idx & 127, s_ = rem >> 2, f4 = rem & 3, k_ = 256 * w + 128 * kkr + 32 * (c_) + s_; d_[r] = *(const GAS f32x4*)(w_in + (size_t)k_ * IN_COLS + C_GLR + 4 * f4) * g[k_]; } } } while (0)
#define NP_STOREB(d_) do { _Pragma("unroll") for (int r = 0; r < NB; ++r) { const int idx = lane + 64 * r; \
        if (MODE == 1) { const int kkr = idx >> 8, rem = idx & 255, s_ = rem >> 3, f4 = rem & 7; *(LAS f32x4*)(Bl + (kkr * 32 + s_) * 32 + 4 * f4) = d_[r]; } \
        else { const int kkr = idx >> 7, rem = idx & 127, s_ = rem >> 2, f4 = rem & 3; *(LAS f32x4*)(Bl + (kkr * 32 + s_) * 32 + 4 * f4) = d_[r]; } } } while (0)
    if (MODE == 0) NP_LOADA(0, av); else { u32x4 ar0[4]; NP_LOADA_RAW(0, ar0); NP_UNPACK(ar0, av); }
    NP_LOADB(0, bv); NP_STOREB(bv);
#pragma unroll 1
    for (int c = 0; c < 4; ++c) {
        f32x4 avn[8], bvn[NB]; u32x4 arn[4];
        if (c < 3) { if (MODE == 0) NP_LOADA(c + 1, avn); else NP_LOADA_RAW(c + 1, arn); NP_LOADB(c + 1, bvn); }
        float bq[32];
#pragma unroll
        for (int s_ = 0; s_ < 32; ++s_) bq[s_] = Bl[(kk * 32 + s_) * 32 + i];
#pragma unroll
        for (int q = 0; q < 8; ++q)
#pragma unroll
            for (int j = 0; j < 4; ++j) { acc = __builtin_amdgcn_mfma_f32_32x32x2f32(av[q][j], bq[4 * q + j], acc, 0, 0, 0); ss = fmaf(av[q][j], av[q][j], ss); }
        if (c < 3) { NP_STOREB(bvn);
            if (MODE == 0) {
#pragma unroll
                for (int q = 0; q < 8; ++q) av[q] = avn[q]; }
            else NP_UNPACK(arn, av); }
    }
#undef NP_LOADA
#undef NP_LOADA_RAW
#undef NP_UNPACK
#undef NP_LOADB
#undef NP_STOREB
    ss += __shfl_xor(ss, 32);
    if (kk == 0) ssq[w * 32 + i] = ss;
#pragma unroll
    for (int r = 0; r < 16; ++r) part[(w * 32 + (r & 3) + 8 * (r >> 2) + 4 * kk) * 32 + i] = acc[r];
    __syncthreads();
#pragma unroll
    for (int rep = 0; rep < 2; ++rep) { const int idx = tid + 512 * rep, tok = idx >> 5, e = idx & 31; float sum = 0.f, st = 0.f;
#pragma unroll
        for (int ww = 0; ww < 8; ++ww) { sum += part[(ww * 32 + tok) * 32 + e]; st += ssq[ww * 32 + tok]; }
        const float rstd = rsqrtf(st * (1.f / D) + 1e-6f);
        if (MODE == 0) { if (e < 16) ((float*)(F.ws + WS_GLR))[(size_t)(t0 + tok) * 16 + e] = sum * rstd; }
        else lg[tok * 33 + e] = sum * rstd + br[e];
        if (e == 0) rs[tok] = rstd; }
    __syncthreads();
    bf16* HN = (bf16*)(F.ws + (MODE == 0 ? WS_XN : WS_HN)); float* topw = (float*)(F.ws + WS_TOPW); int* tope = (int*)(F.ws + WS_TOPE); int* tops = (int*)(F.ws + WS_TOPS);
    unsigned* cnt = F.ctl + CW_CNT;
    {
        constexpr int NBT = MODE == 0 ? 2 : 4;
        f32x4 gg[8];
#pragma unroll
        for (int j = 0; j < 8; ++j) gg[j] = *((const GAS f32x4*)g + lane + 64 * j);
#pragma unroll 1
        for (int qb = 0; qb < 4; qb += NBT) {
            f32x4 xr[MODE == 0 ? NBT : 1][8]; u32x2 xb[MODE == 1 ? NBT : 1][8];
#pragma unroll
            for (int k = 0; k < NBT; ++k) { const int t = t0 + 4 * w + qb + k;
#pragma unroll
                for (int j = 0; j < 8; ++j) { if (MODE == 0) xr[k][j] = ((const GAS f32x4*)(X + (size_t)t * D))[lane + 64 * j]; else xb[k][j] = ((const GAS u32x2*)(Xb + (size_t)t * D))[lane + 64 * j]; } }
#pragma unroll
            for (int k = 0; k < NBT; ++k) { const int tok = 4 * w + qb + k, t = t0 + tok; const float rstd = rs[tok];
                GAS u32x2* o8 = (GAS u32x2*)(HN + (size_t)t * D) + lane;
#pragma unroll
                for (int j = 0; j < 8; ++j) { f32x4 xv;
                    if (MODE == 0) xv = xr[k][j]; else { const u32x2 xw = xb[k][j]; xv = (f32x4){__uint_as_float(xw.x << 16), __uint_as_float(xw.x & 0xffff0000u), __uint_as_float(xw.y << 16), __uint_as_float(xw.y & 0xffff0000u)}; }
                    const f32x4 y = xv * rstd * gg[j];
                    if (MODE == 0) { u32x2 wv; wv.x = pk2(y.x, y.y); wv.y = pk2(y.z, y.w); o8[64 * j] = wv;
                        int w8 = 0; w8 = __builtin_amdgcn_cvt_pk_fp8_f32(y.x, y.y, w8, false); w8 = __builtin_amdgcn_cvt_pk_fp8_f32(y.z, y.w, w8, true); ((GAS int*)(F.ws + WS_XN8 + (size_t)t * D))[lane + 64 * j] = w8; }
                    else { int w8 = 0; w8 = __builtin_amdgcn_cvt_pk_fp8_f32(y.x, y.y, w8, false); w8 = __builtin_amdgcn_cvt_pk_fp8_f32(y.z, y.w, w8, true); ((GAS int*)((unsigned char*)HN + (size_t)t * D))[lane + 64 * j] = w8; } } }
        }
    }
#pragma unroll 1
    for (int q = 0; q < 4; ++q) {
        const int tok = 4 * w + q, t = t0 + tok, e = lane & 31;
        if (MODE == 1) {
        float vals[4]; int idxs[4]; float cur = lg[tok * 33 + e];
#pragma unroll
        for (int r = 0; r < 4; ++r) {
            float bv = cur; int bi = e;
#pragma unroll
            for (int o = 1; o < 32; o <<= 1) { const float ov = __shfl_xor(bv, o); const int oi = __shfl_xor(bi, o); if (ov > bv || (ov == bv && oi < bi)) { bv = ov; bi = oi; } }
            vals[r] = bv; idxs[r] = bi;
            if (e == bi) cur = -3.0e38f;
        }
        float ex[4], sum = 0.f;
#pragma unroll
        for (int r = 0; r < 4; ++r) { ex[r] = __expf(vals[r] - vals[0]); sum += ex[r]; }
#pragma unroll
        for (int r = 0; r < 4; ++r) {
            if (lane == r) { const int ee = idxs[r]; const unsigned lr = __hip_atomic_fetch_add(&lcnt[ee], 1u, __ATOMIC_RELAXED, __HIP_MEMORY_SCOPE_WORKGROUP);
                const float wv_ = ex[r] / sum; topw[t * 4 + r] = wv_; tope[t * 4 + r] = ee; prec[tok * 4 + r] = (ee << 16) | lr; pwgt[tok * 4 + r] = wv_; }
        }
        }
    }
    if (MODE == 1) {
        __syncthreads();
        if (tid < NE) { const unsigned c = lcnt[tid]; lbase[tid] = c ? atomicAdd(&cnt[64 * tid], c) : 0u; }
        __syncthreads();
        if (tid < 128) { const unsigned pr = prec[tid]; const int slot = (int)(lbase[pr >> 16] + (pr & 0xffffu)); tops[(t0 * 4) + tid] = slot;
            ((int*)(F.ws + WS_SMAP))[(pr >> 16) * 8192 + slot] = t0 * 4 + tid; ((float*)(F.ws + WS_WMAP))[(pr >> 16) * 8192 + slot] = pwgt[tid]; }
        __syncthreads();
        if (tid < NE) lcnt[tid] = 0u;
    }
    __syncthreads();
}
__device__ __forceinline__ void moe_table(Frame& F) {
    volatile LAS int* ts = (volatile LAS int*)(F.lds + TAB_OFF); volatile LAS int* cn = (volatile LAS int*)(F.lds + TAB_OFF + 256);
    __syncthreads();
    if (F.tid < 64) {
        const int e = F.tid & 31; const int c = (int)__hip_atomic_load(F.ctl + CW_CNT + 64 * e, __ATOMIC_RELAXED, __HIP_MEMORY_SCOPE_AGENT);
        int incl = (c + 255) >> 8; const int mine = incl;
#pragma unroll
        for (int o = 1; o < 32; o <<= 1) { const int up = __shfl_up(incl, o, 32); if (e >= o) incl += up; }
        if (F.tid < 32) { cn[e] = c; ts[e] = incl - mine; if (e == 31) ts[NE] = incl; } }
    __syncthreads();
}
__device__ __forceinline__ void p7_gather(Frame& F) {
    const int gw = F.vcu * NWAVES + F.wave, NGW = F.G * NWAVES, lane = F.lane;
    volatile LAS int* ts = (volatile LAS int*)(F.lds + TAB_OFF);
    const float* topw = (const float*)(F.ws + WS_TOPW); const int* tope = (const int*)(F.ws + WS_TOPE); const int* tops = (const int*)(F.ws + WS_TOPS);
    int* rpair = (int*)(F.ws + WS_RPAIR); float* rw = (float*)(F.ws + WS_RW);
    { volatile LAS int* cn = (volatile LAS int*)(F.lds + TAB_OFF + 256);
      for (int e = gw; e < NE; e += NGW) { const int c = cn[e], base = ts[e] * 256, padn = ((c + 255) & ~255) - c;
          for (int r = lane; r < padn; r += 64) { rpair[base + c + r] = S * 4; rw[base + c + r] = 0.f; } } }
    for (int p = F.vcu * (NWAVES * 64) + F.tid; p < S * 4; p += F.G * NWAVES * 64) { const int dst = ts[tope[p]] * 256 + tops[p]; rpair[dst] = p; rw[dst] = topw[p]; }
}
__device__ __forceinline__ void p10_combine(Frame& F, const Args& a) {
    const int gw = F.vcu * NWAVES + F.wave, NGW = F.G * NWAVES, lane = F.lane;
    const unsigned char* PY = F.ws + WS_PY; float* out = a.out; const bf16* H1 = (const bf16*)(F.ws + WS_H1);
    for (int t = gw; t < S; t += NGW) {
        u32x4 hv[4]; u32x2 pv[4][4];
#pragma unroll
        for (int j = 0; j < 4; ++j) { hv[j] = *(const GAS u32x4*)(H1 + (size_t)t * D + 512 * j + 8 * lane);
#pragma unroll
            for (int k = 0; k < 4; ++k) pv[j][k] = *(const GAS u32x2*)(PY + (size_t)(t * 4 + k) * D + 512 * j + 8 * lane); }
#pragma unroll
        for (int j = 0; j < 4; ++j) {
            float r[8];
#pragma unroll
            for (int q = 0; q < 4; ++q) { r[2 * q] = __uint_as_float(hv[j][q] << 16); r[2 * q + 1] = __uint_as_float(hv[j][q] & 0xffff0000u); }
            float ps[8] = {0.f, 0.f, 0.f, 0.f, 0.f, 0.f, 0.f, 0.f};
#pragma unroll
            for (int k = 0; k < 4; ++k) { const u32x2 p = pv[j][k];
#pragma unroll
                for (int q = 0; q < 2; ++q) { const f32x2_t lo = __builtin_amdgcn_cvt_pk_f32_fp8((int)p[q], false), hi = __builtin_amdgcn_cvt_pk_f32_fp8((int)p[q], true);
                    ps[4 * q] += lo.x; ps[4 * q + 1] += lo.y; ps[4 * q + 2] += hi.x; ps[4 * q + 3] += hi.y; } }
#pragma unroll
            for (int q = 0; q < 8; ++q) r[q] = fmaf(ps[q], 0.0625f, r[q]);
            *(GAS f32x4*)(out + (size_t)t * D + 512 * j + 8 * lane) = (f32x4){r[0], r[1], r[2], r[3]};
            *(GAS f32x4*)(out + (size_t)t * D + 512 * j + 8 * lane + 4) = (f32x4){r[4], r[5], r[6], r[7]};
        }
    }
}


constexpr float ATT_QSCALE = 0.08838834764831845f * 1.4426950408889634f;
__device__ __forceinline__ void attn_prep_unit(Frame& F, const Args& a, int n, int h) {
    const int wave = F.wave, lane = F.lane, tid = F.tid;
    LAS bf16* kst = (LAS bf16*)(F.lds);
    LAS bf16* vst = (LAS bf16*)(F.lds + 16384);
    const bf16* AQ = (const bf16*)(F.ws + WS_AQ); const bf16* AK = (const bf16*)(F.ws + WS_AK); const bf16* AV = (const bf16*)(F.ws + WS_AV);
    const float* kg = a.in[7];
    const float gk0 = kg[2 * lane], gk1 = kg[2 * lane + 1];
    unsigned kraw[8], vraw[8];
#pragma unroll
    for (int i = 0; i < 8; ++i) { const size_t off = (size_t)(n * 64 + wave * 8 + i) * ATT_W + h * ATT_HD + 2 * lane;
        kraw[i] = *(const unsigned short*)((const unsigned char*)AK + off); vraw[i] = *(const unsigned short*)((const unsigned char*)AV + off); }
#pragma unroll
    for (int i = 0; i < 8; ++i) {
        const int row = n * 64 + wave * 8 + i; const size_t off = (size_t)row * ATT_W + h * ATT_HD + 2 * lane;
        const unsigned kv = kraw[i], v8 = vraw[i];
        const f32x2_t kf = __builtin_amdgcn_cvt_pk_f32_fp8((int)kv, false), vf = __builtin_amdgcn_cvt_pk_f32_fp8((int)v8, false);
        const float k0 = kf.x, k1 = kf.y; const unsigned vv = pk2(vf.x, vf.y);
        const float rk = rsqrtf(wave_sum(k0 * k0 + k1 * k1) * (1.f / 128.f) + 1e-6f);
        *(LAS unsigned*)(kst + (wave * 8 + i) * 128 + 2 * lane) = pk2(k0 * rk * gk0, k1 * rk * gk1);
        *(LAS unsigned*)(vst + (wave * 8 + i) * 128 + 2 * lane) = vv;
    }
    __syncthreads();
    bf16* KI = (bf16*)(F.ws + WS_KIMG) + (size_t)(n * ATT_H + h) * 8192; bf16* VI = (bf16*)(F.ws + WS_VIMG) + (size_t)(n * ATT_H + h) * 8192;
#pragma unroll
    for (int i = 0; i < 2; ++i) {
        const int g = tid + 512 * i;
        { const int c16 = g >> 6, key = g & 63; const u32x4 v = *(const LAS u32x4*)(kst + key * 128 + c16 * 8); *(u32x4*)(KI + (size_t)g * 8) = v; }
        { const int kg8 = g >> 7, d = g & 127; unsigned short e[8];
#pragma unroll
          for (int j = 0; j < 8; ++j) e[j] = vst[(kg8 * 8 + j) * 128 + d];
          u32x4 v; v.x = e[0] | ((unsigned)e[1] << 16); v.y = e[2] | ((unsigned)e[3] << 16); v.z = e[4] | ((unsigned)e[5] << 16); v.w = e[6] | ((unsigned)e[7] << 16);
          *(u32x4*)(VI + (size_t)g * 8) = v; }
    }
    __syncthreads();
}

__device__ __forceinline__ int crow(int r, int hi) { return (r & 3) + 8 * (r >> 2) + 4 * hi; }
__device__ __forceinline__ void attn_unit(Frame& F, const Args& a, int n4, int h) {
    const int w = F.wave, lane = F.lane, r32 = lane & 31, hi = lane >> 5, tid = F.tid;
    const int p = w >> 1, half = w & 1, c = 4 * n4 + p, qrow0 = c * 64 + 32 * half;
    LAS unsigned char* lds = F.lds;
    LAS float* btab = (LAS float*)(lds + 65536); LAS float* xch = (LAS float*)(lds + 67584 + 256 * w); LAS bf16* ost = (LAS bf16*)(lds + 8192 * w);
    const float* relb = a.in[8] + h * 257;
    if (tid < 257) btab[tid] = relb[tid] * 1.4426950408889634f;
    LAS unsigned char* qimg = lds + 69632 + 8192 * w;
    {
        const unsigned char* AQ8 = F.ws + WS_AQ + (size_t)(qrow0 + r32) * ATT_W + h * ATT_HD + hi * 8; const float* qg = a.in[6] + hi * 8;
        u32x2 qr[8];
#pragma unroll
        for (int d0 = 0; d0 < 8; ++d0) qr[d0] = *(const u32x2*)(AQ8 + d0 * 16);
        float qf[8][8]; float ssq_ = 0.f;
#pragma unroll
        for (int d0 = 0; d0 < 8; ++d0)
#pragma unroll
            for (int q2 = 0; q2 < 2; ++q2) { const f32x2_t lo = __builtin_amdgcn_cvt_pk_f32_fp8((int)qr[d0][q2], false), hh = __builtin_amdgcn_cvt_pk_f32_fp8((int)qr[d0][q2], true);
                qf[d0][4 * q2] = lo.x; qf[d0][4 * q2 + 1] = lo.y; qf[d0][4 * q2 + 2] = hh.x; qf[d0][4 * q2 + 3] = hh.y;
                ssq_ += lo.x * lo.x + lo.y * lo.y + hh.x * hh.x + hh.y * hh.y; }
        ssq_ += __shfl_xor(ssq_, 32);
        const float rq = rsqrtf(ssq_ * (1.f / 128.f) + 1e-6f) * ATT_QSCALE;
#pragma unroll
        for (int d0 = 0; d0 < 8; ++d0) { const f32x4 g0 = *(const f32x4*)(qg + d0 * 16), g1 = *(const f32x4*)(qg + d0 * 16 + 4);
            u32x4 wq; wq.x = pk2(qf[d0][0] * rq * g0.x, qf[d0][1] * rq * g0.y); wq.y = pk2(qf[d0][2] * rq * g0.z, qf[d0][3] * rq * g0.w);
            wq.z = pk2(qf[d0][4] * rq * g1.x, qf[d0][5] * rq * g1.y); wq.w = pk2(qf[d0][6] * rq * g1.z, qf[d0][7] * rq * g1.w);
            *(LAS u32x4*)(qimg + ((2 * d0 + hi) * 32 + r32) * 16) = wq; }
    }
    const char* KIMG = (const char*)(F.ws + WS_KIMG); const char* VIMG = (const char*)(F.ws + WS_VIMG);
    f32x16 o[4];
#pragma unroll
    for (int dt = 0; dt < 4; ++dt)
#pragma unroll
        for (int r = 0; r < 16; ++r) o[dt][r] = 0.f;
    float m = -1.0e30f, l = 0.f;
    const int s0 = (4 * n4 - 8 < 0) ? (8 - 4 * n4) : 0;
#define ATT_STAGE(s_) do { const int kc_ = 4 * n4 - 8 + (s_); const size_t gb_ = (size_t)(kc_ * ATT_H + h) * 16384; const unsigned lb_ = ((s_) & 1) * 32768; \
        _Pragma("unroll") for (int i_ = 0; i_ < 2; ++i_) { const int pc_ = w + 8 * i_; \
            __builtin_amdgcn_global_load_lds((const unsigned*)(KIMG + gb_ + pc_ * 1024 + lane * 16), (LAS unsigned*)(lds + lb_ + pc_ * 1024), 16, 0, 0); \
            __builtin_amdgcn_global_load_lds((const unsigned*)(VIMG + gb_ + pc_ * 1024 + lane * 16), (LAS unsigned*)(lds + lb_ + 16384 + pc_ * 1024), 16, 0, 0); } } while (0)
    ATT_STAGE(s0);
    for (int s = s0; s < 12; ++s) {
        asm volatile("s_waitcnt vmcnt(0) lgkmcnt(0)" ::: "memory");
        __builtin_amdgcn_s_barrier();
        if (s + 1 < 12) ATT_STAGE(s + 1);
        if (s >= p && s <= p + 8) {
            const LAS unsigned char* kb = lds + (s & 1) * 32768; const LAS unsigned char* vb = kb + 16384;
            f32x16 p0, p1;
#pragma unroll
            for (int r = 0; r < 16; ++r) { p0[r] = 0.f; p1[r] = 0.f; }
#pragma unroll
            for (int d0 = 0; d0 < 8; ++d0) {
                const bf16x8 k0 = *(const LAS bf16x8*)(kb + (2 * d0 + hi) * 1024 + r32 * 16), k1 = *(const LAS bf16x8*)(kb + (2 * d0 + hi) * 1024 + (r32 + 32) * 16);
                const bf16x8 qv = *(const LAS bf16x8*)(qimg + ((2 * d0 + hi) * 32 + r32) * 16);
                p0 = __builtin_amdgcn_mfma_f32_32x32x16_bf16(k0, qv, p0, 0, 0, 0);
                p1 = __builtin_amdgcn_mfma_f32_32x32x16_bf16(k1, qv, p1, 0, 0, 0);
                if (d0 & 1) __builtin_amdgcn_sched_barrier(0);
            }
            const int wrel = p + 8 - s;
            if (wrel >= 3) { const float bc = btab[256];
#pragma unroll
                for (int r = 0; r < 16; ++r) { p0[r] += bc; p1[r] += bc; } }
            else { const int base = 64 * wrel + 32 * half + r32 + 128;
#pragma unroll
                for (int r = 0; r < 16; ++r) { int i0 = base - crow(r, hi), i1 = i0 - 32; i0 = i0 > 256 ? 256 : i0; i1 = i1 > 256 ? 256 : i1; i1 = i1 < 0 ? 0 : i1; i0 = i0 < 0 ? 0 : i0; p0[r] += btab[i0]; p1[r] += btab[i1]; } }
            float mx = p0[0];
#pragma unroll
            for (int r = 1; r < 16; ++r) mx = fmaxf(mx, p0[r]);
#pragma unroll
            for (int r = 0; r < 16; ++r) mx = fmaxf(mx, p1[r]);
            mx = fmaxf(mx, __shfl_xor(mx, 32));
            const float mn = fmaxf(m, mx), alpha = __builtin_amdgcn_exp2f(m - mn);
            float ps = 0.f;
#pragma unroll
            for (int r = 0; r < 16; ++r) { p0[r] = __builtin_amdgcn_exp2f(p0[r] - mn); p1[r] = __builtin_amdgcn_exp2f(p1[r] - mn); ps += p0[r] + p1[r]; }
            l = l * alpha + ps;
            if (__any(mn > m)) {
                if (hi == 0) xch[r32] = alpha;
                asm volatile("s_waitcnt lgkmcnt(0)" ::: "memory");
#pragma unroll
                for (int g = 0; g < 4; ++g) { const f32x4 av = *(const LAS f32x4*)(xch + 8 * g + 4 * hi);
#pragma unroll
                    for (int dt = 0; dt < 4; ++dt) { o[dt][4 * g] *= av[0]; o[dt][4 * g + 1] *= av[1]; o[dt][4 * g + 2] *= av[2]; o[dt][4 * g + 3] *= av[3]; } }
            }
            m = mn;
            bf16x8 pa[4];
#pragma unroll
            for (int ks = 0; ks < 4; ++ks) { const f32x16& src = (ks < 2) ? p0 : p1; const int b = (ks & 1) * 8; u32x4 t;
                t.x = cvt_pk_bf16(src[b], src[b + 1]); t.y = cvt_pk_bf16(src[b + 2], src[b + 3]); t.z = cvt_pk_bf16(src[b + 4], src[b + 5]); t.w = cvt_pk_bf16(src[b + 6], src[b + 7]);
                pa[ks] = __builtin_bit_cast(bf16x8, t); }
#pragma unroll
            for (int dt = 0; dt < 4; ++dt)
#pragma unroll
                for (int ks = 0; ks < 4; ++ks) {
                    const LAS unsigned char* vp = vb + (2 * ks) * 2048 + (32 * dt + r32) * 16 + 8 * hi;
                    const u32x2 lo = *(const LAS u32x2*)vp, hh = *(const LAS u32x2*)(vp + 2048);
                    const u32x4 bq = (u32x4){lo.x, lo.y, hh.x, hh.y};
                    o[dt] = __builtin_amdgcn_mfma_f32_32x32x16_bf16(pa[ks], __builtin_bit_cast(bf16x8, bq), o[dt], 0, 0, 0);
                    if (ks == 3) __builtin_amdgcn_sched_barrier(0);
                }
        }
    }
#undef ATT_STAGE
    asm volatile("s_waitcnt lgkmcnt(0)" ::: "memory");
    __builtin_amdgcn_s_barrier();
    l += __shfl_xor(l, 32);
    if (hi == 0) xch[32 + r32] = 1.f / l;
    asm volatile("s_waitcnt lgkmcnt(0)" ::: "memory");
#pragma unroll
    for (int g = 0; g < 4; ++g) { const f32x4 iv = *(const LAS f32x4*)(xch + 32 + 8 * g + 4 * hi);
#pragma unroll
        for (int dt = 0; dt < 4; ++dt)
#pragma unroll
            for (int j = 0; j < 4; ++j) ost[(8 * g + 4 * hi + j) * 128 + 32 * dt + r32] = (bf16)f2bf(o[dt][4 * g + j] * iv[j]); }
    asm volatile("s_waitcnt lgkmcnt(0)" ::: "memory");
    unsigned char* YA = F.ws + WS_YA;
#pragma unroll
    for (int i = 0; i < 8; ++i) { const int g = i * 64 + lane, row = g >> 4, c16 = g & 15; const u32x4 v = *(const LAS u32x4*)(ost + row * 128 + c16 * 8);
        u32x2 o8;
#pragma unroll
        for (int q = 0; q < 2; ++q) { int w8 = 0; const unsigned w0 = v[2 * q], w1 = v[2 * q + 1];
            w8 = __builtin_amdgcn_cvt_pk_fp8_f32(__uint_as_float(w0 << 16) * 32.f, __uint_as_float(w0 & 0xffff0000u) * 32.f, w8, false);
            w8 = __builtin_amdgcn_cvt_pk_fp8_f32(__uint_as_float(w1 << 16) * 32.f, __uint_as_float(w1 & 0xffff0000u) * 32.f, w8, true); o8[q] = (unsigned)w8; }
        *(u32x2*)(YA + (size_t)(qrow0 + row) * ATT_W + h * ATT_HD + c16 * 8) = o8; }
    asm volatile("s_waitcnt vmcnt(0) lgkmcnt(0)" ::: "memory");
    __builtin_amdgcn_s_barrier();
}


__device__ __forceinline__ void gla_prep_unit(Frame& F, const Args& a, int n, int cg) {
    const int tid = F.tid, cq = tid & 15, seg = tid >> 4;
    const int h = cg >> 2, dk0 = (cg & 3) * 64 + 4 * cq, col0 = h * GLA_DK + dk0, nh = n * GLA_H + h;
    const float* wgu = a.in[3]; const float* bgt = a.in[4]; const float* GLR = (const float*)(F.ws + WS_GLR);
    const bf16* GQ = (const bf16*)(F.ws + WS_GQ); const bf16* GK = (const bf16*)(F.ws + WS_GK);
    LAS float* tot = (LAS float*)F.lds;
    LAS float* wl = tot + 2048;
    const int t0 = n * 256 + seg * 8;
    u32x2 qraw[8], kraw[8];
#pragma unroll
    for (int i = 0; i < 8; ++i) { qraw[i] = *(const u32x2*)(GQ + (size_t)(t0 + i) * GLA_QK + col0); kraw[i] = *(const u32x2*)(GK + (size_t)(t0 + i) * GLA_QK + col0); }
    if (seg < 16) *(LAS f32x4*)(wl + seg * 64 + 4 * cq) = *(const f32x4*)(wgu + seg * GLA_QK + col0);
    __syncthreads();
    const f32x4 bgv = *(const f32x4*)(bgt + col0);
    f32x4 cs[8]; f32x4 run = (f32x4){0.f, 0.f, 0.f, 0.f};
#pragma unroll
    for (int i = 0; i < 8; ++i) {
        const f32x4* gp = (const f32x4*)(GLR + (size_t)(t0 + i) * 16); f32x4 z = bgv;
#pragma unroll
        for (int q = 0; q < 4; ++q) { const f32x4 gv = gp[q]; const LAS f32x4* wp = (const LAS f32x4*)(wl + 4 * q * 64 + 4 * cq);
            z += wp[0] * gv.x; z += wp[16] * gv.y; z += wp[32] * gv.z; z += wp[48] * gv.w; }
#pragma unroll
        for (int j = 0; j < 4; ++j) run[j] += log_sigmoid(z[j]) * (1.f / 16.f);
        cs[i] = run;
    }
    *(LAS f32x4*)(tot + seg * 64 + 4 * cq) = run;
    __syncthreads();
    f32x4 off = (f32x4){0.f, 0.f, 0.f, 0.f}, total = (f32x4){0.f, 0.f, 0.f, 0.f};
    for (int sg = 0; sg < 32; ++sg) { const f32x4 tv = *(const LAS f32x4*)(tot + sg * 64 + 4 * cq); total += tv; if (sg < seg) off += tv; }
    float etot[4];
#pragma unroll
    for (int j = 0; j < 4; ++j) etot[j] = __expf(total[j]);
    unsigned kew[4][4];
    bf16* ACAT = (bf16*)(F.ws + WS_ACAT); bf16* KI = (bf16*)(F.ws + WS_KI); bf16* KET = (bf16*)(F.ws + WS_KET);
    float kprev[4];
#pragma unroll
    for (int i = 0; i < 8; ++i) {
        const size_t trow = (size_t)(t0 + i);
        const u32x2 qv = qraw[i], kv = kraw[i];
        float q[4] = {__uint_as_float(qv.x << 16), __uint_as_float(qv.x & 0xffff0000u), __uint_as_float(qv.y << 16), __uint_as_float(qv.y & 0xffff0000u)};
        float k[4] = {__uint_as_float(kv.x << 16), __uint_as_float(kv.x & 0xffff0000u), __uint_as_float(kv.y << 16), __uint_as_float(kv.y & 0xffff0000u)};
        float qd[4], ki[4], ke[4];
#pragma unroll
        for (int j = 0; j < 4; ++j) { const float bc = cs[i][j] + off[j]; const float eb = __expf(bc), ib = __builtin_amdgcn_rcpf(eb); qd[j] = q[j] * 0.0625f * eb; ki[j] = k[j] * ib; ke[j] = ki[j] * etot[j]; }
        const size_t lrow = (size_t)nh * 256 + seg * 8 + i;
        u32x2 o; o.x = pk2(qd[0], qd[1]); o.y = pk2(qd[2], qd[3]); *(u32x2*)(ACAT + lrow * 512 + 256 + dk0) = o;
        o.x = pk2(ki[0], ki[1]); o.y = pk2(ki[2], ki[3]); *(u32x2*)(KI + lrow * 256 + dk0) = o;
        if (i & 1) {
#pragma unroll
            for (int j = 0; j < 4; ++j) kew[j][i >> 1] = pk2(kprev[j], ke[j]); }
        else {
#pragma unroll
            for (int j = 0; j < 4; ++j) kprev[j] = ke[j]; }
    }
#pragma unroll
    for (int j = 0; j < 4; ++j) *(u32x4*)(KET + ((size_t)nh * 256 + dk0 + j) * 256 + seg * 8) = (u32x4){kew[j][0], kew[j][1], kew[j][2], kew[j][3]};
    if (seg == 0) *(f32x4*)((float*)(F.ws + WS_DEC) + n * GLA_QK + col0) = (f32x4){etot[0], etot[1], etot[2], etot[3]};
    __syncthreads();
}
__device__ __forceinline__ void gla_vt_unit(Frame& F, int n, int h, int g8) {
    const int tid = F.tid; const int nh = n * GLA_H + h;
    LAS bf16* tile = (LAS bf16*)F.lds;
    const bf16* GV = (const bf16*)(F.ws + WS_GV); bf16* BCAT = (bf16*)(F.ws + WS_BCAT);
#pragma unroll
    for (int ps = 0; ps < 4; ++ps) { const int row = (tid >> 3) + 64 * ps, ch = tid & 7;
        const u32x4 v = *(const u32x4*)(GV + (size_t)(n * 256 + row) * GLA_V + h * GLA_DV + g8 * 64 + ch * 8);
        *(LAS u32x2*)(tile + row * 72 + ch * 8) = (u32x2){v.x, v.y}; *(LAS u32x2*)(tile + row * 72 + ch * 8 + 4) = (u32x2){v.z, v.w}; }
    __syncthreads();
#pragma unroll
    for (int i = 0; i < 4; ++i) { const int g = tid + 512 * i, c = g & 63, tg = g >> 6; unsigned short e[8];
#pragma unroll
        for (int j = 0; j < 8; ++j) e[j] = tile[(tg * 8 + j) * 72 + c];
        u32x4 v; v.x = e[0] | ((unsigned)e[1] << 16); v.y = e[2] | ((unsigned)e[3] << 16); v.z = e[4] | ((unsigned)e[5] << 16); v.w = e[6] | ((unsigned)e[7] << 16);
        *(u32x4*)(BCAT + ((size_t)nh * 512 + g8 * 64 + c) * 512 + tg * 8) = v; }
    __syncthreads();
}
__device__ __forceinline__ void gla_scan(Frame& F) {
    const bf16* UT = (const bf16*)(F.ws + WS_UT); bf16* BCAT = (bf16*)(F.ws + WS_BCAT); const float* DEC = (const float*)(F.ws + WS_DEC);
    for (int idx = F.vcu * (NWAVES * 64) + F.tid; idx < GLA_H * GLA_DV * 64; idx += F.G * NWAVES * 64) {
        const int dk4 = (idx & 63) * 4, dv = (idx >> 6) & 511, h = idx >> 15;
        float s[4] = {0.f, 0.f, 0.f, 0.f};
#pragma unroll 1
        for (int nb = 0; nb < 32; nb += 16) {
            u32x2 uvv[16]; f32x4 dcv[16];
#pragma unroll
            for (int k = 0; k < 16; ++k) { const size_t nh = (size_t)(nb + k) * GLA_H + h;
                uvv[k] = *(const u32x2*)(UT + (nh * 512 + dv) * 256 + dk4); dcv[k] = *(const f32x4*)(DEC + (nb + k) * GLA_QK + h * GLA_DK + dk4); }
#pragma unroll
            for (int k = 0; k < 16; ++k) { const size_t nh = (size_t)(nb + k) * GLA_H + h; const u32x2 uv = uvv[k]; const f32x4 dc = dcv[k];
                u32x2 o; o.x = pk2(s[0], s[1]); o.y = pk2(s[2], s[3]); *(u32x2*)(BCAT + (nh * 512 + dv) * 512 + 256 + dk4) = o;
                s[0] = s[0] * dc.x + __uint_as_float(uv.x << 16); s[1] = s[1] * dc.y + __uint_as_float(uv.x & 0xffff0000u);
                s[2] = s[2] * dc.z + __uint_as_float(uv.y << 16); s[3] = s[3] * dc.w + __uint_as_float(uv.y & 0xffff0000u); }
        }
    }
}
__device__ __forceinline__ void gla_norm(Frame& F, const Args& a) {
    const int gw = F.vcu * NWAVES + F.wave, NGW = F.G * NWAVES, lane = F.lane;
    const bf16* OB = (const bf16*)(F.ws + WS_OB); const bf16* GR = (const bf16*)(F.ws + WS_GR); bf16* YG = (bf16*)(F.ws + WS_YG); const float* g = a.in[5];
    const f32x4 g0 = *(const f32x4*)(g + 8 * lane), g1 = *(const f32x4*)(g + 8 * lane + 4);
    for (int wb = gw; wb < S * GLA_H; wb += 4 * NGW) {
        u32x4 ovv[4], rvv[4];
#pragma unroll
        for (int k = 0; k < 4; ++k) { const int wi = wb + k * NGW; if (wi < S * GLA_H) { const size_t off = (size_t)(wi >> 2) * GLA_V + (wi & 3) * GLA_DV + 8 * lane; ovv[k] = *(const u32x4*)(OB + off); rvv[k] = *(const u32x4*)(GR + off); } }
#pragma unroll
        for (int k = 0; k < 4; ++k) { const int wi = wb + k * NGW; if (wi < S * GLA_H) {
        const size_t off = (size_t)(wi >> 2) * GLA_V + (wi & 3) * GLA_DV + 8 * lane;
        const u32x4 ov = ovv[k], rv = rvv[k];
        float o[8], r[8]; float ss = 0.f;
#pragma unroll
        for (int j = 0; j < 4; ++j) { o[2 * j] = __uint_as_float(ov[j] << 16); o[2 * j + 1] = __uint_as_float(ov[j] & 0xffff0000u); r[2 * j] = __uint_as_float(rv[j] << 16); r[2 * j + 1] = __uint_as_float(rv[j] & 0xffff0000u); }
#pragma unroll
        for (int j = 0; j < 8; ++j) ss += o[j] * o[j];
        const float rstd = rsqrtf(wave_sum(ss) * (1.f / GLA_DV) + 1e-6f);
        u32x4 w; w.x = pk2(o[0] * rstd * g0.x * r[0], o[1] * rstd * g0.y * r[1]); w.y = pk2(o[2] * rstd * g0.z * r[2], o[3] * rstd * g0.w * r[3]);
        w.z = pk2(o[4] * rstd * g1.x * r[4], o[5] * rstd * g1.y * r[5]); w.w = pk2(o[6] * rstd * g1.z * r[6], o[7] * rstd * g1.w * r[7]);
        *(u32x4*)(YG + off) = w; } }
    }
}

__global__ void __launch_bounds__(NWAVES * 64, 2) fwd(Args args) {
    extern __shared__ __attribute__((aligned(16))) unsigned char lds_raw[];
    Frame F;
    F.lds = (LAS unsigned char*)lds_raw; F.MISC = (volatile LAS unsigned*)(F.lds + MISC_OFF);
    F.tid = threadIdx.x; F.lane = F.tid & 63; F.wave = __builtin_amdgcn_readfirstlane(F.tid >> 6);
    F.G = gridDim.x; { const int bx = blockIdx.x; F.vcu = (F.G % 8 == 0) ? (bx % 8) * (F.G / 8) + bx / 8 : bx; }
    F.ws = args.ws; F.ctl = (unsigned*)(args.ws + WS_CTL);
    for (int u = F.tid; u < (LDS_BYTES - CTLZ_OFF) / 4; u += NWAVES * 64) ((LAS unsigned*)(F.lds + CTLZ_OFF))[u] = 0u;
    __syncthreads();
    XcdBarrier bar = xcd_barrier_post(F.ctl + CW_BAR + args.li * XCD_BAR_WORDS, F.MISC + 8);
    const int lo = args.ph_lo, hi = args.ph_hi;
#define IN(k) (lo <= (k) && (k) < hi)
#define SEAM(k) do { if (IN(k) && IN((k) + 1)) xcd_barrier(bar); } while (0)
    unsigned char* ws = args.ws;
#ifndef DUP_MASK
#define DUP_MASK 0
#endif
#define DUP(k) ((DUP_MASK >> (k)) & 1)
#define PHASE(k, ...) do { if (IN(k)) { __VA_ARGS__ if (DUP(k)) { xcd_barrier(bar); __VA_ARGS__ } } SEAM(k); } while (0)
#define PHASE_NB(k, ...) do { if (IN(k)) { __VA_ARGS__ if (DUP(k)) { xcd_barrier(bar); __VA_ARGS__ } } } while (0)
    const int gcus = (F.G == 256) ? GEMM_CUS : F.G;
#ifndef JIT_WIN
#define JIT_WIN 0
#endif
    const bool split = gcus < F.G, jit = split && JIT_WIN;
    unsigned* const jf = F.ctl + CW_JIT;
    PHASE(0, { if (!jit) { p0_convert(F, args, 0, split ? P0_I_IN : P0_NITEMS, F.vcu * NWAVES + F.wave, F.G * NWAVES); p0_convert8(F, args, split ? P8_NITEMS : 0, split ? P8_ALL : P8_END, F.vcu * NWAVES + F.wave, F.G * NWAVES); } p0_rows(F, args);
        for (int u = F.vcu; u < S / 32; u += F.G) normproj_unit<0>(F, args, u); });
    PHASE(1, { if (jit) { p0_convert(F, args, 0, P0_JIT_A, F.vcu * NWAVES + F.wave, F.G * NWAVES); jit_publish(jf, F.wave, F.lane); }
        if ((int)blockIdx.x < gcus) {
            { pg8::DenseSched Sc; Sc.init_split(ws + WS_XN, ws + WS_WIN, S, 24, D * 2, gcus, (int)blockIdx.x, 24, 0); pg8::EpiProj E{ws, args.in[9]};
              if (jit) { Sc.jflag = jf; Sc.jwant0 = (unsigned)F.G; Sc.jwant1 = (unsigned)(F.G - gcus); Sc.jseen = F.MISC + 16; }
              pg8::gemm_phase<pg8::EpiProj, pg8::DenseSched>(F.lds, D, D, D, Sc, E); }
            { pg8::DenseSched Sc; Sc.init_split(ws + WS_XN8, ws + WS_WIN8, S, 28, D, gcus, gcus - 1 - (int)blockIdx.x, 28, 0); Sc.pn_base = 24; Sc.bcompact = 1; pg8::EpiProj E{ws, args.in[9]};
              if (jit) { Sc.jflag = jf; Sc.jwant0 = (unsigned)F.G; Sc.jwant1 = (unsigned)(F.G - gcus); Sc.jseen = F.MISC + 16; Sc.jmode = 1; }
              pg8::gemm_phase8<pg8::EpiProj, pg8::DenseSched>(F.lds, D, D, D, Sc, E); }
            if (split) { __syncthreads(); p0_convert8_queue(F, args, jf + 128, P8_NITEMS); } }
        else { const int cw = ((int)blockIdx.x - gcus) * NWAVES + F.wave, ncw = (F.G - gcus) * NWAVES;
            if (jit) { p0_convert(F, args, P0_JIT_A, P0_I_IN, cw, ncw); p0_convert8(F, args, P8_NITEMS, P8_ALL, cw, ncw); jit_publish(jf + 64, F.wave, F.lane); }
            p0_convert(F, args, P0_I_IN, P0_I_IN + P0_I_BG, cw, ncw); p0_convert(F, args, P0_I_IN + P0_I_BG + P0_I_BA, P0_NITEMS, cw, ncw); p0_convert8(F, args, P8_ALL, P8_END, cw, ncw); p0_convert8_queue(F, args, jf + 128, P8_NITEMS); } });
    PHASE(2, { for (int rp = 0; rp < 1 + DUP(16); ++rp) for (int u = F.vcu; u < NCH * ATT_H; u += F.G) attn_prep_unit(F, args, u >> 3, u & 7);
        for (int rp = 0; rp < 1 + DUP(17); ++rp) for (int u = F.vcu; u < 32 * 16; u += F.G) gla_prep_unit(F, args, u >> 4, u & 15);
        for (int rp = 0; rp < 1 + DUP(18); ++rp) for (int u = F.vcu; u < 32 * GLA_H * 8; u += F.G) gla_vt_unit(F, u >> 5, (u >> 3) & 3, u & 7); });
    PHASE(3, { for (int u = F.vcu; u < (NCH / 4) * ATT_H; u += F.G) attn_unit(F, args, u >> 3, u & 7);
        { pg8::GlaSched Sc{0, F.G, F.G - 1 - (int)blockIdx.x, ws}; pg8::EpiGla<0> E{ws}; pg8::gemm_phase<pg8::EpiGla<0>, pg8::GlaSched>(F.lds, 256, 512, 256, Sc, E); }
        { pg8::GlaSched Sc{1, F.G, (int)blockIdx.x, ws}; pg8::EpiGla<1> E{ws}; pg8::gemm_phase<pg8::EpiGla<1>, pg8::GlaSched>(F.lds, 256, 512, 256, Sc, E); } });
    PHASE(4, { gla_scan(F);
        { pg8::DenseSched Sc; Sc.init_split(ws + WS_YA, ws + WS_WBA8, S, D / 256, ATT_W, F.G, (int)blockIdx.x, D / 256, 0); pg8::EpiBranch<0> E{ws + WS_SA, nullptr, ws + WS_T};
          pg8::gemm_phase8<pg8::EpiBranch<0>, pg8::DenseSched>(F.lds, ATT_W, ATT_W, ATT_W, Sc, E, 0x7a7a7a7a); } });
    const bool fuse56 = (F.G == 256);
    PHASE(5, { pg8::GlaSched Sc{2, F.G, (int)blockIdx.x, ws};
        if (fuse56) { pg8::EpiGlaNorm E{ws, args.in[5], F.ctl, (LAS float*)(F.lds + RING_BYTES)}; pg8::gemm_phase<pg8::EpiGlaNorm, pg8::GlaSched>(F.lds, 512, 512, 512, Sc, E); }
        else { pg8::EpiGla<2> E{ws}; pg8::gemm_phase<pg8::EpiGla<2>, pg8::GlaSched>(F.lds, 512, 512, 512, Sc, E); } });
    if (!fuse56) PHASE(6, { gla_norm(F, args); });
    PHASE(7, { pg8::DenseSched Sc; Sc.init(ws + WS_YG, ws + WS_WBG, S, D, GLA_V, F.G, (int)blockIdx.x); pg8::EpiBranch<1> E{ws + WS_SG, ws + WS_T, ws + WS_MG};
        pg8::gemm_phase<pg8::EpiBranch<1>, pg8::DenseSched>(F.lds, GLA_V, GLA_V, GLA_V, Sc, E); });
    PHASE(9, { pg8::DenseSched Sc; Sc.init(ws + WS_MG, ws + WS_WOUT, S, D, D, F.G, (int)blockIdx.x); pg8::EpiResid E{args.in[0], (bf16*)(ws + WS_H1)};
        pg8::gemm_phase<pg8::EpiResid, pg8::DenseSched>(F.lds, D, D, D, Sc, E); });
    PHASE(10, { for (int u = F.vcu; u < S / 32; u += F.G) normproj_unit<1>(F, args, u); });
    PHASE(12, { moe_table(F); pg8::MoeSched Sc;
        Sc.init(ws + WS_HN, ws + WS_GU, (volatile LAS int*)(F.lds + TAB_OFF), (volatile LAS int*)(F.lds + TAB_OFF + 256), 16, D, F.G, (int)blockIdx.x); Sc.agather = 1;
        pg8::EpiSwiglu E{args.in[17], args.in[19], ws + WS_HD};
        pg8::gemm_phase8<pg8::EpiSwiglu, pg8::MoeSched, true>(F.lds, D, D, D, Sc, E, 0x7f7f7f7f, (const int*)(ws + WS_SMAP), S - 1); });
    PHASE(13, { pg8::MoeSched Sc; Sc.init(ws + WS_HD, ws + WS_DN, (volatile LAS int*)(F.lds + TAB_OFF), (volatile LAS int*)(F.lds + TAB_OFF + 256), 8, DFF, F.G, (int)blockIdx.x);
        pg8::EpiDown E{args.in[21], (const int*)(ws + WS_SMAP), (const float*)(ws + WS_WMAP), ws + WS_PY};
        pg8::gemm_phase8<pg8::EpiDown, pg8::MoeSched>(F.lds, DFF, DFF, DFF, Sc, E); });
    PHASE(14, { p10_combine(F, args); });
#undef PHASE
#undef PHASE_NB
#undef IN
#undef SEAM
}

extern "C" void kernel_launch(void* const* d_in, const int* in_sizes, int n_in, void* d_out, int out_size, void* d_ws, size_t ws_size, hipStream_t stream) {
    static int grid = 0;
    if (grid == 0) {
        if (n_in != 22 || out_size != S * D || ws_size < WS_END) { fprintf(stderr, "kernel_launch: unexpected problem (n_in %d out %d ws %zu)\n", n_in, out_size, ws_size); grid = -1; return; }
        int dev = 0, cus = 0, per_cu = 0;
        if (hipGetDevice(&dev) != hipSuccess || hipDeviceGetAttribute(&cus, hipDeviceAttributeMultiprocessorCount, dev) != hipSuccess) { grid = -1; return; }
        if (hipFuncSetAttribute((const void*)fwd, hipFuncAttributeMaxDynamicSharedMemorySize, LDS_BYTES) != hipSuccess) { fprintf(stderr, "kernel_launch: hipFuncSetAttribute failed\n"); grid = -1; return; }
        if (hipOccupancyMaxActiveBlocksPerMultiprocessor(&per_cu, (const void*)fwd, NWAVES * 64, LDS_BYTES) != hipSuccess || per_cu < 1) fprintf(stderr, "kernel_launch: occupancy query says %d\n", per_cu);
        (void)hipGetLastError();
        grid = cus;
    }
    if (grid < 0) return;
    (void)hipMemsetAsync((char*)d_ws + WS_CTL, 0, CTL_ZERO_BYTES, stream);
    Args a{};
    for (int i = 0; i < 22; ++i) a.in[i] = (const float*)d_in[i];
    a.out = (float*)d_out; a.ws = (unsigned char*)d_ws;
    a.ph_lo = 0; a.ph_hi = 15; a.li = 0;
    hipLaunchKernelGGL(fwd, dim3(grid), dim3(NWAVES * 64), LDS_BYTES, stream, a);
}
```

```cpp
#include <hip/hip_runtime.h>
#include <stdint.h>
#include <cstdio>

constexpr int S = 8192, D = 2048;
constexpr int GLA_H = 4, GLA_DK = 256, GLA_DV = 512, GLA_QK = 1024, GLA_V = 2048;
constexpr int ATT_H = 8, ATT_HD = 128, ATT_W = 1024, NCH = S / 64;
constexpr int NE = 32, DFF = 2048;
constexpr int IN_COLS = 13328, C_GLR = 6144;
constexpr int NPROJ = 13312;
constexpr int MAXROWS = 32768 + NE * 256;

constexpr size_t MiB = 1u << 20;
constexpr size_t WS_CTL = 0, CTL_ZERO_BYTES = 64 * 1024;
constexpr size_t WS_TOPW = 1 * MiB, WS_TOPE = WS_TOPW + 128 * 1024, WS_TOPS = WS_TOPE + 128 * 1024, WS_RPAIR = WS_TOPS + 128 * 1024, WS_RW = WS_RPAIR + 256 * 1024;
constexpr size_t WS_GLR = 2 * MiB, WS_WR = 3 * MiB;
constexpr size_t WS_SMAP = 1232 * MiB, WS_WMAP = 1233 * MiB;
constexpr size_t WS_WIN = 8 * MiB, WS_WBG = 60 * MiB, WS_WBA = 68 * MiB, WS_WOUT = 72 * MiB, WS_GU = 80 * MiB, WS_DN = 592 * MiB;
constexpr size_t WS_XN = 848 * MiB, WS_GQ = 880 * MiB, WS_GK = 896 * MiB, WS_GV = 912 * MiB, WS_GR = 944 * MiB, WS_AQ = 976 * MiB, WS_AK = 992 * MiB, WS_AV = 1008 * MiB;
constexpr size_t WS_SG = 1024 * MiB, WS_SA = 1056 * MiB, WS_YG = 1088 * MiB, WS_YA = 1120 * MiB, WS_T = 1136 * MiB, WS_MG = 1168 * MiB, WS_HN = 1200 * MiB;
constexpr size_t WS_HNG = 1232 * MiB, WS_HD = 1392 * MiB, WS_PY = 1552 * MiB, WS_QH = 1681 * MiB, WS_KIMG = 1697 * MiB, WS_VIMG = 1713 * MiB;
constexpr size_t WS_PSLOT = 1889 * MiB + 512 * 1024;
constexpr size_t WS_ACAT = 1729 * MiB, WS_BCAT = 1761 * MiB, WS_KI = 1825 * MiB, WS_KET = 1841 * MiB, WS_UT = 1857 * MiB, WS_DEC = 1889 * MiB, WS_OB = 1890 * MiB, WS_H1 = 1922 * MiB, WS_XN8 = 1986 * MiB, WS_WIN8 = WS_WIN + 24 * MiB, WS_WBA8 = WS_WIN + 40 * MiB, WS_END = 2002 * MiB;
constexpr int CW_CNT = 256;
constexpr int CW_JIT = 2560;
constexpr int CW_BAR = 4096;
constexpr int CW_PS = 8192;

typedef unsigned short bf16;
typedef short bf16x8 __attribute__((ext_vector_type(8)));
typedef float f32x4 __attribute__((ext_vector_type(4)));
typedef float f32x16 __attribute__((ext_vector_type(16)));
typedef unsigned u32x4 __attribute__((ext_vector_type(4)));
typedef unsigned u32x2 __attribute__((ext_vector_type(2)));
typedef int v8i __attribute__((ext_vector_type(8)));
#define LAS __attribute__((address_space(3)))
#define GAS __attribute__((address_space(1)))
__device__ __forceinline__ float bf2f(bf16 v) { return __uint_as_float((unsigned)v << 16); }
typedef float f32x2_t __attribute__((ext_vector_type(2))); typedef __bf16 bf16x2_t __attribute__((ext_vector_type(2)));
__device__ __forceinline__ unsigned pk2(float lo, float hi) { const f32x2_t v = {lo, hi}; const bf16x2_t b = __builtin_convertvector(v, bf16x2_t); return __builtin_bit_cast(unsigned, b); }
__device__ __forceinline__ unsigned f2bf(float f) { return pk2(f, 0.f) & 0xffffu; }
__device__ __forceinline__ unsigned cvt_pk_bf16(float lo, float hi) { return pk2(lo, hi); }
__device__ __forceinline__ float wave_sum(float v) {
#pragma unroll
    for (int o = 1; o < 64; o <<= 1) v += __shfl_xor(v, o);
    return v;
}
__device__ __forceinline__ float sigmoidf_(float x) { return __builtin_amdgcn_rcpf(1.f + __expf(-x)); }
__device__ __forceinline__ float log_sigmoid(float z) { return fminf(z, 0.f) - __logf(1.f + __expf(-fabsf(z))); }
#define LDS_WAIT() asm volatile("s_waitcnt lgkmcnt(0)" ::: "memory")
#define VM_WAIT() asm volatile("s_waitcnt vmcnt(0)" ::: "memory")

#define XB_TMO      128
#define XB_XCNT(j)  (256  + 64 * (j))
#define XB_XSUB(j)  (1280 + 64 * (j))
#define XB_XGEN(j)  (2304 + 64 * (j))
#define XB_TOP      3328
#define XB_TOPGEN   3392
#define XCD_BAR_WORDS 3456
#define XB_SPIN_CAP (1u << 18)
__device__ __forceinline__ unsigned xb_ld(unsigned* p)              { return __hip_atomic_load(p, __ATOMIC_RELAXED, __HIP_MEMORY_SCOPE_AGENT); }
__device__ __forceinline__ unsigned xb_add(unsigned* p, unsigned v) { return __hip_atomic_fetch_add(p, v, __ATOMIC_RELAXED, __HIP_MEMORY_SCOPE_AGENT); }
__device__ __forceinline__ unsigned xb_xcc_id() { return (unsigned)__builtin_amdgcn_s_getreg((3 << 11) | 20) & 0xFu; }
#define XB_SPIN(cond, bar) do { unsigned _sp = 0; while (cond) { __builtin_amdgcn_s_sleep(1); \
    if ((++_sp & 255u) == 0u) { if (xb_ld(&(bar)[XB_TMO])) break; if (_sp > XB_SPIN_CAP) { atomicAdd(&(bar)[XB_TMO], 1u); break; } } } } while (0)
struct XcdBarrier { unsigned* bar; unsigned x; volatile LAS unsigned* st; };
__device__ __forceinline__ XcdBarrier xcd_barrier_post(unsigned* bar, volatile LAS unsigned* st) {
    XcdBarrier b; b.bar = bar; b.x = xb_xcc_id(); b.st = st;
    if (threadIdx.x == 0) (void)xb_add(&bar[XB_XCNT(b.x)], 1u);
    return b;
}
__device__ __forceinline__ void xcd_barrier_complete(unsigned* bar, unsigned x, unsigned& nloc, unsigned& nx) {
    const unsigned G = gridDim.x * gridDim.y * gridDim.z;
    unsigned sum, cnt, mine, sp = 0u;
    for (;;) {
        sum = 0u; cnt = 0u; mine = 0u;
#pragma unroll
        for (unsigned j = 0; j < 16; ++j) { const unsigned c = xb_ld(&bar[XB_XCNT(j)]); sum += c; cnt += (c > 0u) ? 1u : 0u; mine = (j == x) ? c : mine; }
        if (sum == G) break;
        __builtin_amdgcn_s_sleep(1);
        if ((++sp & 255u) == 0u) { if (xb_ld(&bar[XB_TMO])) break; if (sp > XB_SPIN_CAP) { atomicAdd(&bar[XB_TMO], 1u); break; } }
    }
    nloc = mine > 0u ? mine : 1u; nx = cnt > 0u ? cnt : 1u;
}
__device__ __forceinline__ void xcd_barrier(const XcdBarrier& b) {
    asm volatile("s_waitcnt vmcnt(0)" ::: "memory");
    __syncthreads();
    if (threadIdx.x == 0) {
        unsigned* bar = b.bar;
        __builtin_amdgcn_s_waitcnt(0);
        unsigned nloc = b.st[0], nx = b.st[1];
        if (nloc == 0u) { xcd_barrier_complete(bar, b.x, nloc, nx); b.st[0] = nloc; b.st[1] = nx; }
        const unsigned old = xb_add(&bar[XB_XSUB(b.x)], 1u);
        const unsigned gen = old / nloc;
        if (old + 1u == (gen + 1u) * nloc) {
            __builtin_amdgcn_fence(__ATOMIC_RELEASE, "agent");
            asm volatile("s_waitcnt vmcnt(0)" ::: "memory");
            const unsigned og = xb_add(&bar[XB_TOP], 1u);
            const unsigned tg = og / nx;
            if (og + 1u == (tg + 1u) * nx) xb_add(&bar[XB_TOPGEN], 1u);
            else XB_SPIN(xb_ld(&bar[XB_TOPGEN]) == tg, bar);
            __builtin_amdgcn_fence(__ATOMIC_ACQUIRE, "agent");
            xb_add(&bar[XB_XGEN(b.x)], 1u);
            asm volatile("s_waitcnt vmcnt(0)" ::: "memory");
        } else {
            XB_SPIN(xb_ld(&bar[XB_XGEN(b.x)]) == gen, bar);
            __builtin_amdgcn_fence(__ATOMIC_ACQUIRE, "agent");
            asm volatile("s_waitcnt vmcnt(0)" ::: "memory");
        }
    }
    __syncthreads();
}

namespace pg8 {
constexpr int JIT_EARLY = 5;
constexpr int BM = 256, BK = 64, HALF = 128, HTB = HALF * BK * 2, STAGE_BYTES = 8 * HTB, NXCD = 8, WGM = 8;
__host__ __device__ __forceinline__ int lds_byte(int r, int c) { const int st = (r >> 4) * 2 + (c >> 5), rr = r & 15, cc = c & 31, ob = rr * 64 + cc * 2; return st * 1024 + (ob ^ (((ob >> 9) & 1) << 5)); }
__host__ __device__ __forceinline__ void stage_rc(int b, int& R, int& C) { const int st = b / 1024, sb = b % 1024, swz = sb ^ (((sb >> 9) & 1) << 5); R = (st >> 1) * 16 + swz / 64; C = (st & 1) * 32 + (swz % 64) / 2; }
__host__ __device__ __forceinline__ int perm32(int rho) { const int n = rho >> 4, i = rho & 15; return 8 * (i >> 2) + 4 * n + (i & 3); }
__device__ __forceinline__ int xcd_remap(int wgid, int nwg) { const int q = nwg / NXCD, r = nwg % NXCD, xcd = wgid % NXCD, off = wgid / NXCD; return (xcd < r ? xcd * (q + 1) : r * (q + 1) + (xcd - r) * q) + off; }

struct Unit { const char* A; const char* B; int pm, pn, e, nrow, trow; };

struct DenseSched {
    const char* A; const char* Bt; int nM, nN, nwg, G, c; size_t tstep; int pn_split, pn_skip, pn_base, bcompact, jhalf, wgm;
    unsigned* jflag; unsigned jwant0, jwant1; volatile LAS unsigned* jseen; int jmode; mutable int seen;
    __device__ __forceinline__ void init(const void* A_, const void* Bt_, int M, int N, int K, int G_, int c_) { A = (const char*)A_; Bt = (const char*)Bt_; nM = M / BM; nN = N / BM; nwg = nM * nN; G = G_; c = c_; tstep = (size_t)BM * K * 2; pn_split = nN; pn_skip = 0; pn_base = 0; bcompact = 0; wgm = WGM; jhalf = 1 << 20; jflag = nullptr; seen = 0; jmode = 0; }
    __device__ __forceinline__ void init_split(const void* A_, const void* Bt_, int M, int ntiles, int Kbytes, int G_, int c_, int split, int skip) { A = (const char*)A_; Bt = (const char*)Bt_; nM = M / BM; nN = ntiles; nwg = nM * nN; G = G_; c = c_; tstep = (size_t)BM * Kbytes; pn_split = split; pn_skip = skip; pn_base = 0; bcompact = 0; wgm = WGM; jhalf = ntiles / 2; jflag = nullptr; seen = 0; jmode = 0; }
    __device__ __forceinline__ void jwait(int st) const {
        if (seen & (1 << st)) return;
        if (__builtin_amdgcn_readfirstlane((int)(threadIdx.x >> 6)) == 0) {
            const unsigned want = st ? jwant1 : jwant0; unsigned sp = 0u;
            while ((unsigned)__builtin_amdgcn_readfirstlane((int)__hip_atomic_load(jflag + 64 * st, __ATOMIC_RELAXED, __HIP_MEMORY_SCOPE_AGENT)) < want) { __builtin_amdgcn_s_sleep(8); if (++sp > (1u << 18)) break; }
            __builtin_amdgcn_fence(__ATOMIC_ACQUIRE, "agent");
            jseen[st] = 1u;
        } else { unsigned sp = 0u; while (jseen[st] == 0u) { __builtin_amdgcn_s_sleep(2); if (++sp > (1u << 22)) break; } }
        asm volatile("" ::: "memory");
        seen |= 1 << st;
    }
    __device__ __forceinline__ bool next(int i, Unit& u) const {
        const long L = (long)i * G + c; if (L >= nwg) return false;
        const int wgid = xcd_remap((int)L, nwg);
        const int nig = wgm * nN, gid = wgid / nig, fm = gid * wgm, gsz = (nM - fm) < wgm ? (nM - fm) : wgm;
        const int j = (wgid % nig) / gsz;
        if (jflag) jwait((jmode == 0 && (j % jhalf) < JIT_EARLY) ? 0 : 1);
        u.pm = fm + ((wgid % nig) % gsz); u.pn = j < pn_split ? j + pn_base : j + pn_skip; u.e = 0; u.nrow = BM;
        u.A = A + (size_t)u.pm * tstep; u.B = Bt + (ptrdiff_t)(bcompact ? j : u.pn) * (ptrdiff_t)tstep; return true;
    }
};
struct MoeSched {
    const char* A; const char* Bt; const volatile LAS int* tstart; const volatile LAS int* cnt; int NT, nwg, G, c; size_t tstep; int agather;
    __device__ __forceinline__ void init(const void* A_, const void* Bt_, const volatile LAS int* ts, const volatile LAS int* cn, int NT_, int Kbytes, int G_, int c_) {
        A = (const char*)A_; Bt = (const char*)Bt_; tstart = ts; cnt = cn; NT = NT_; nwg = ts[NE] * NT_; G = G_; c = c_; tstep = (size_t)BM * Kbytes; agather = 0; }
    __device__ __forceinline__ bool next(int i, Unit& u) const {
        const long L = (long)i * G + c; if (L >= nwg) return false;
        const int wgid = xcd_remap((int)L, nwg);
        const int lj = (int)(threadIdx.x & 31u); const int tj = tstart[lj];
        const unsigned long long hit = __ballot(wgid >= tj * NT);
        const int e = __builtin_amdgcn_readfirstlane(__builtin_popcount((unsigned)(hit & 0xffffffffull)) - 1);
        const int t0 = tstart[e], nte = tstart[e + 1] - t0, local = wgid - t0 * NT;
        const int pn = local / nte, mt = local - pn * nte;
        u.e = e; u.pn = pn; u.pm = t0 + mt; u.nrow = cnt[e] - mt * BM; u.trow = e * 8192 + mt * BM;
        u.A = agather ? A : A + (size_t)u.pm * tstep; u.B = Bt + (size_t)(e * NT + pn) * tstep; return true;
    }
};

template <class Epi, class Sched, bool BGRAN = false>
__device__ __forceinline__ void gemm_phase(LAS unsigned char* lds, const int K, const int lda, const int ldb, const Sched& S, const Epi& E) {
    const int tid = threadIdx.x, wid = __builtin_amdgcn_readfirstlane(tid >> 6), lane = tid & 63, wr = wid >> 2, wc = wid & 3, fr = lane & 15, fq = lane >> 4;
    int nt = K / BK; asm volatile("" : "+s"(nt));
    unsigned voffA[2], voffB[2];
#pragma unroll
    for (int i = 0; i < 2; ++i) { int R, C; stage_rc(tid * 16 + i * 8192, R, C); const int Rb = Epi::PERM ? ((R & ~31) + perm32(R & 31)) : R;
        voffA[i] = (unsigned)(R * lda + C) * 2u; voffB[i] = BGRAN ? (unsigned)((C >> 3) * ldb + Rb) * 16u : (unsigned)(Rb * ldb + C) * 2u; }
    const size_t kstep = (size_t)(BK * 2), kstepB = BGRAN ? (size_t)ldb * 128 : (size_t)(BK * 2);
    const size_t hstepA = (size_t)HALF * lda * 2, hstepB = BGRAN ? (size_t)2048 : (size_t)HALF * ldb * 2;
    const unsigned ldsw = (unsigned)wid * 1024u;
    const int aoff = lds_byte(wr * 64 + fr, fq * 8), boff = lds_byte(wc * 32 + fr, fq * 8);
#define PG8_SA(b, h) (((b) * 2 + (h)) * HTB)
#define PG8_SB(b, h) ((4 + (b) * 2 + (h)) * HTB)
#define PG8_STAGE(bufoff, gbase, voff) do { _Pragma("unroll") for (int _i = 0; _i < 2; ++_i) \
        __builtin_amdgcn_global_load_lds((const unsigned*)((const char*)(gbase) + (voff)[_i]), (LAS unsigned*)(lds + (bufoff) + ldsw + _i * 8192), 16, 0, 0); } while (0)
#define PG8_LDA(dst, b, h) do { _Pragma("unroll") for (int m = 0; m < 4; ++m) _Pragma("unroll") for (int k = 0; k < 2; ++k) dst[m][k] = *(const LAS bf16x8*)(lds + PG8_SA(b, h) + aoff + m * 2048 + k * 1024); } while (0)
#define PG8_LDB(dst, b, h) do { _Pragma("unroll") for (int n = 0; n < 2; ++n) _Pragma("unroll") for (int k = 0; k < 2; ++k) dst[n][k] = *(const LAS bf16x8*)(lds + PG8_SB(b, h) + boff + n * 2048 + k * 1024); } while (0)
#define PG8_MMA(ai, bj, At, Bt) do { __builtin_amdgcn_s_setprio(1); _Pragma("unroll") for (int m = 0; m < 4; ++m) _Pragma("unroll") for (int n = 0; n < 2; ++n) _Pragma("unroll") for (int k = 0; k < 2; ++k) \
        acc[ai][bj][m][n] = __builtin_amdgcn_mfma_f32_16x16x32_bf16(Bt[n][k], At[m][k], acc[ai][bj][m][n], 0, 0, 0); __builtin_amdgcn_s_setprio(0); } while (0)
#define PG8_WAIT_V(n) asm volatile("s_waitcnt vmcnt(" #n ")" ::: "memory")
#define PG8_WAIT_L(n) asm volatile("s_waitcnt lgkmcnt(" #n ")" ::: "memory")
#define PG8_BAR __builtin_amdgcn_s_barrier()
#define PG8_SCHED __builtin_amdgcn_sched_barrier(0)
    Unit cur, nxt; int ui = 0;
    if (!S.next(0, cur)) return;
    f32x4 acc[2][2][4][2];
#pragma unroll
    for (int a = 0; a < 2; ++a)
#pragma unroll
        for (int b = 0; b < 2; ++b)
#pragma unroll
            for (int m = 0; m < 4; ++m)
#pragma unroll
                for (int n = 0; n < 2; ++n) acc[a][b][m][n] = (f32x4){0.f, 0.f, 0.f, 0.f};
    bf16x8 At[4][2], B0[2][2], B1[2][2];
    const char* cA = cur.A; const char* cB = cur.B;
    PG8_STAGE(PG8_SB(0, 0), cB, voffB); PG8_STAGE(PG8_SB(0, 1), cB + hstepB, voffB); PG8_STAGE(PG8_SA(0, 0), cA, voffA); PG8_STAGE(PG8_SA(0, 1), cA + hstepA, voffA);
    if (wr == 1) PG8_BAR;
    PG8_WAIT_V(2); PG8_BAR;
    PG8_STAGE(PG8_SB(1, 0), cB + kstepB, voffB); PG8_STAGE(PG8_SA(1, 0), cA + kstep, voffA); PG8_STAGE(PG8_SB(1, 1), cB + hstepB + kstepB, voffB);
    PG8_WAIT_V(6); PG8_BAR;
    for (;;) {
        const bool has_next = S.next(ui + 1, nxt);
        const char* nA = has_next ? nxt.A : cA; const char* nB = has_next ? nxt.B : cB;
#pragma unroll 1
        for (int t = 0; t < nt; t += 2) {
            const bool last = (t == nt - 2);
            const char* a1 = cA + (size_t)(t + 1) * kstep;
            const char* a2 = last ? nA : cA + (size_t)(t + 2) * kstep; const char* b2 = last ? nB : cB + (size_t)(t + 2) * kstepB;
            const char* a3 = a2 + kstep; const char* b3 = b2 + kstepB;
            PG8_LDB(B0, 0, 0); PG8_LDB(B1, 0, 1); PG8_SCHED; PG8_LDA(At, 0, 0); PG8_STAGE(PG8_SA(1, 1), a1 + hstepA, voffA);
            PG8_WAIT_V(8); PG8_WAIT_L(0); PG8_BAR; PG8_MMA(0, 0, At, B0); PG8_MMA(0, 1, At, B1); PG8_BAR; PG8_SCHED;
            PG8_LDA(At, 0, 1); PG8_STAGE(PG8_SB(0, 0), b2, voffB); PG8_STAGE(PG8_SB(0, 1), b2 + hstepB, voffB); PG8_STAGE(PG8_SA(0, 0), a2, voffA);
            PG8_WAIT_V(8); PG8_WAIT_L(0); PG8_BAR; PG8_MMA(1, 0, At, B0); PG8_MMA(1, 1, At, B1); PG8_BAR; PG8_SCHED;
            PG8_LDB(B0, 1, 0); PG8_LDB(B1, 1, 1); PG8_SCHED; PG8_LDA(At, 1, 0); PG8_STAGE(PG8_SA(0, 1), a2 + hstepA, voffA);
            PG8_WAIT_V(8); PG8_WAIT_L(0); PG8_BAR; PG8_MMA(0, 0, At, B0); PG8_MMA(0, 1, At, B1); PG8_BAR; PG8_SCHED;
            PG8_LDA(At, 1, 1); PG8_STAGE(PG8_SB(1, 0), b3, voffB); PG8_STAGE(PG8_SB(1, 1), b3 + hstepB, voffB); PG8_STAGE(PG8_SA(1, 0), a3, voffA);
            PG8_WAIT_V(8); PG8_WAIT_L(0); PG8_BAR; PG8_MMA(1, 0, At, B0); PG8_MMA(1, 1, At, B1); PG8_BAR; PG8_SCHED;
        }
        if (wr == 0) PG8_BAR;
        { int fr_ = fr, fq_ = fq; asm volatile("" : "+v"(fr_), "+v"(fq_));
          E(acc, cur, wr, wc, fr_, fq_); }
        if (!has_next) break;
#pragma unroll
        for (int a = 0; a < 2; ++a)
#pragma unroll
            for (int b = 0; b < 2; ++b)
#pragma unroll
                for (int m = 0; m < 4; ++m)
#pragma unroll
                    for (int n = 0; n < 2; ++n) acc[a][b][m][n] = (f32x4){0.f, 0.f, 0.f, 0.f};
        cur = nxt; cA = nA; cB = nB; ++ui;
        if (wr == 1) PG8_BAR;
    }
    PG8_WAIT_V(0);
    PG8_BAR;
#undef PG8_SA
#undef PG8_SB
#undef PG8_STAGE
#undef PG8_LDA
#undef PG8_LDB
#undef PG8_MMA
#undef PG8_WAIT_V
#undef PG8_WAIT_L
#undef PG8_BAR
#undef PG8_SCHED
}

template <class Epi, class Sched, bool GATHER = false>
__device__ __forceinline__ void gemm_phase8(LAS unsigned char* lds, const int K, const int lda, const int ldb, const Sched& S, const Epi& E, const int scx_init = 0x7f7f7f7f, const int* rtab = nullptr, const int gmax = 0) {
    const int tid = threadIdx.x, wid = __builtin_amdgcn_readfirstlane(tid >> 6), lane = tid & 63, wr = wid >> 2, wc = wid & 3, fr = lane & 15, fq = lane >> 4;
    int nt = K / 128; asm volatile("" : "+s"(nt));
    unsigned voffA[2], voffB[2];
#pragma unroll
    for (int i = 0; i < 2; ++i) { int R, C; stage_rc(tid * 16 + i * 8192, R, C); const int Rb = Epi::PERM ? ((R & ~31) + perm32(R & 31)) : R;
        voffA[i] = (unsigned)(R * lda + C * 2); voffB[i] = (unsigned)(Rb * ldb + C * 2); }
    const size_t kstep = 128, kstepB = 128;
    const size_t hstepA = GATHER ? (size_t)0 : (size_t)HALF * lda, hstepB = (size_t)HALF * ldb;
    unsigned vgC[2][2], vgN[2][2];
#define PG8_GLOAD(dst, U_) do { if (GATHER) { _Pragma("unroll") for (int h_ = 0; h_ < 2; ++h_) _Pragma("unroll") for (int i_ = 0; i_ < 2; ++i_) { int R_, C_; stage_rc(tid * 16 + i_ * 8192, R_, C_); \
        int tk_ = rtab[(U_).trow + h_ * HALF + R_] >> 2; tk_ = (h_ * HALF + R_) < (U_).nrow ? tk_ : gmax; tk_ = tk_ < gmax ? tk_ : gmax; tk_ = tk_ > 0 ? tk_ : 0; dst[h_][i_] = (unsigned)(tk_ * lda + C_ * 2); } } } while (0)
#define PG8_VA(h_, nextu) (GATHER ? ((nextu) ? vgN[h_] : vgC[h_]) : voffA)
    const unsigned ldsw = (unsigned)wid * 1024u;
    const int aoff = lds_byte(wr * 64 + fr, fq * 8), boff = lds_byte(wc * 32 + fr, fq * 8);
#define PG8_SA(b, h) (((b) * 2 + (h)) * HTB)
#define PG8_SB(b, h) ((4 + (b) * 2 + (h)) * HTB)
#define PG8_STAGE(bufoff, gbase, voff) do { _Pragma("unroll") for (int _i = 0; _i < 2; ++_i) \
        __builtin_amdgcn_global_load_lds((const unsigned*)((const char*)(gbase) + (voff)[_i]), (LAS unsigned*)(lds + (bufoff) + ldsw + _i * 8192), 16, 0, 0); } while (0)
#define PG8_LDA(dst, b, h) do { _Pragma("unroll") for (int m = 0; m < 4; ++m) { dst[m][0] = *(const LAS u32x4*)(lds + PG8_SA(b, h) + aoff + m * 2048); dst[m][1] = *(const LAS u32x4*)(lds + PG8_SA(b, h) + aoff + m * 2048 + 1024); } } while (0)
#define PG8_LDB(dst, b, h) do { _Pragma("unroll") for (int n = 0; n < 2; ++n) { dst[n][0] = *(const LAS u32x4*)(lds + PG8_SB(b, h) + boff + n * 2048); dst[n][1] = *(const LAS u32x4*)(lds + PG8_SB(b, h) + boff + n * 2048 + 1024); } } while (0)
#define PG8_MMA(ai, bj, At, Bt) do { __builtin_amdgcn_s_setprio(1); _Pragma("unroll") for (int m = 0; m < 4; ++m) _Pragma("unroll") for (int n = 0; n < 2; ++n) { \
        const v8i b_ = __builtin_bit_cast(v8i, __builtin_shufflevector(Bt[n][0], Bt[n][1], 0, 1, 2, 3, 4, 5, 6, 7)), a_ = __builtin_bit_cast(v8i, __builtin_shufflevector(At[m][0], At[m][1], 0, 1, 2, 3, 4, 5, 6, 7)); \
        asm volatile("s_nop 1\n\tv_mfma_scale_f32_16x16x128_f8f6f4 %0, %1, %2, %0, %3, %4 op_sel_hi:[0,0,0]" : "+v"(acc[ai][bj][m][n]) : "v"(b_), "v"(a_), "v"(scw), "v"(scx)); } \
        __builtin_amdgcn_s_setprio(0); } while (0)
#define PG8_WAIT_V(n) asm volatile("s_waitcnt vmcnt(" #n ")" ::: "memory")
#define PG8_WAIT_L(n) asm volatile("s_waitcnt lgkmcnt(" #n ")" ::: "memory")
#define PG8_BAR __builtin_amdgcn_s_barrier()
#define PG8_SCHED __builtin_amdgcn_sched_barrier(0)
    Unit cur, nxt; int ui = 0;
    if (!S.next(0, cur)) return;
    f32x4 acc[2][2][4][2];
#pragma unroll
    for (int a = 0; a < 2; ++a)
#pragma unroll
        for (int b = 0; b < 2; ++b)
#pragma unroll
            for (int m = 0; m < 4; ++m)
#pragma unroll
                for (int n = 0; n < 2; ++n) acc[a][b][m][n] = (f32x4){0.f, 0.f, 0.f, 0.f};
    u32x4 At[4][2], B0[2][2], B1[2][2];
    int scw = 0x7a7a7a7a, scx = scx_init; asm volatile("" : "+v"(scw), "+v"(scx));
    const char* cA = cur.A; const char* cB = cur.B;
    PG8_GLOAD(vgC, cur);
    PG8_STAGE(PG8_SB(0, 0), cB, voffB); PG8_STAGE(PG8_SB(0, 1), cB + hstepB, voffB); PG8_STAGE(PG8_SA(0, 0), cA, PG8_VA(0, false)); PG8_STAGE(PG8_SA(0, 1), cA + hstepA, PG8_VA(1, false));
    if (wr == 1) PG8_BAR;
    PG8_WAIT_V(2); PG8_BAR;
    PG8_STAGE(PG8_SB(1, 0), cB + kstepB, voffB); PG8_STAGE(PG8_SA(1, 0), cA + kstep, PG8_VA(0, false)); PG8_STAGE(PG8_SB(1, 1), cB + hstepB + kstepB, voffB);
    PG8_WAIT_V(6); PG8_BAR;
    for (;;) {
        const bool has_next = S.next(ui + 1, nxt);
        const char* nA = has_next ? nxt.A : cA; const char* nB = has_next ? nxt.B : cB;
        if (has_next) PG8_GLOAD(vgN, nxt);
        const bool full = cur.nrow > HALF;
#pragma unroll 1
        for (int t = 0; t < nt; t += 2) {
            const bool last = (t == nt - 2);
            const char* a1 = cA + (size_t)(t + 1) * kstep;
            const char* a2 = last ? nA : cA + (size_t)(t + 2) * kstep; const char* b2 = last ? nB : cB + (size_t)(t + 2) * kstepB;
            const char* a3 = a2 + kstep; const char* b3 = b2 + kstepB;
            PG8_LDB(B0, 0, 0); PG8_LDB(B1, 0, 1); PG8_SCHED; PG8_LDA(At, 0, 0); PG8_STAGE(PG8_SA(1, 1), a1 + hstepA, PG8_VA(1, false));
            PG8_WAIT_V(8); PG8_WAIT_L(0); PG8_BAR; PG8_MMA(0, 0, At, B0); PG8_MMA(0, 1, At, B1); PG8_BAR; PG8_SCHED;
            if (full) PG8_LDA(At, 0, 1); PG8_STAGE(PG8_SB(0, 0), b2, voffB); PG8_STAGE(PG8_SB(0, 1), b2 + hstepB, voffB); PG8_STAGE(PG8_SA(0, 0), a2, PG8_VA(0, last && has_next));
            PG8_WAIT_V(8); PG8_WAIT_L(0); PG8_BAR; if (full) { PG8_MMA(1, 0, At, B0); PG8_MMA(1, 1, At, B1); } PG8_BAR; PG8_SCHED;
            PG8_LDB(B0, 1, 0); PG8_LDB(B1, 1, 1); PG8_SCHED; PG8_LDA(At, 1, 0); PG8_STAGE(PG8_SA(0, 1), a2 + hstepA, PG8_VA(1, last && has_next));
            PG8_WAIT_V(8); PG8_WAIT_L(0); PG8_BAR; PG8_MMA(0, 0, At, B0); PG8_MMA(0, 1, At, B1); PG8_BAR; PG8_SCHED;
            if (full) PG8_LDA(At, 1, 1); PG8_STAGE(PG8_SB(1, 0), b3, voffB); PG8_STAGE(PG8_SB(1, 1), b3 + hstepB, voffB); PG8_STAGE(PG8_SA(1, 0), a3, PG8_VA(0, last && has_next));
            PG8_WAIT_V(8); PG8_WAIT_L(0); PG8_BAR; if (full) { PG8_MMA(1, 0, At, B0); PG8_MMA(1, 1, At, B1); } PG8_BAR; PG8_SCHED;
        }
        if (wr == 0) PG8_BAR;
        asm volatile("s_nop 15\n\ts_nop 7" ::: "memory");
        { int fr_ = fr, fq_ = fq; asm volatile("" : "+v"(fr_), "+v"(fq_));
          E(acc, cur, wr, wc, fr_, fq_); }
        if (!has_next) break;
#pragma unroll
        for (int a = 0; a < 2; ++a)
#pragma unroll
            for (int b = 0; b < 2; ++b)
#pragma unroll
                for (int m = 0; m < 4; ++m)
#pragma unroll
                    for (int n = 0; n < 2; ++n) acc[a][b][m][n] = (f32x4){0.f, 0.f, 0.f, 0.f};
        cur = nxt; cA = nA; cB = nB; ++ui;
        if (GATHER) { _Pragma("unroll") for (int h_ = 0; h_ < 2; ++h_) _Pragma("unroll") for (int i_ = 0; i_ < 2; ++i_) vgC[h_][i_] = vgN[h_][i_]; }
        if (wr == 1) PG8_BAR;
    }
    PG8_WAIT_V(0);
    PG8_BAR;
#undef PG8_SA
#undef PG8_SB
#undef PG8_STAGE
#undef PG8_GLOAD
#undef PG8_VA
#undef PG8_LDA
#undef PG8_LDB
#undef PG8_MMA
#undef PG8_WAIT_V
#undef PG8_WAIT_L
#undef PG8_BAR
#undef PG8_SCHED
}

struct EpiProj {
    static constexpr bool PERM = true;
    unsigned char* ws; const float* bbg;
    __device__ __forceinline__ void operator()(const f32x4 (&acc)[2][2][4][2], const Unit& u, int wr, int wc, int fr, int fq) const {
        const int pn = u.pn; size_t off; int ld, t0, act = 0;
        if (pn < 4) { off = WS_GQ; ld = 1024; t0 = 0; } else if (pn < 8) { off = WS_GK; ld = 1024; t0 = 4; } else if (pn < 16) { off = WS_GV; ld = 2048; t0 = 8; }
        else if (pn < 24) { off = WS_GR; ld = 2048; t0 = 16; act = 1; } else if (pn < 28) { off = WS_AQ; ld = 1024; t0 = 24; } else if (pn < 32) { off = WS_AK; ld = 1024; t0 = 28; }
        else if (pn < 36) { off = WS_AV; ld = 1024; t0 = 32; } else if (pn < 44) { off = WS_SG; ld = 2048; t0 = 36; act = 2; } else { off = WS_SA; ld = 2048; t0 = 44; act = 3; }
        bf16* base = (bf16*)(ws + off);
        const int colt = (pn - t0) * BM + wc * 32 + 8 * fq, row0 = u.pm * BM + wr * 64 + fr;
        f32x4 bv[2][2];
#pragma unroll
        for (int bj = 0; bj < 2; ++bj)
#pragma unroll
            for (int n = 0; n < 2; ++n) bv[bj][n] = act >= 2 ? *(const f32x4*)(bbg + (act - 2) * D + colt + bj * HALF + 4 * n) : (f32x4){0.f, 0.f, 0.f, 0.f};
#pragma unroll
        for (int ai = 0; ai < 2; ++ai)
#pragma unroll
            for (int m = 0; m < 4; ++m) { bf16* rowp = base + (size_t)(row0 + ai * HALF + m * 16) * ld + colt;
#pragma unroll
                for (int bj = 0; bj < 2; ++bj) { f32x4 v0 = acc[ai][bj][m][0] + bv[bj][0], v1 = acc[ai][bj][m][1] + bv[bj][1];
                    if (act == 1) {
#pragma unroll
                        for (int j = 0; j < 4; ++j) { v0[j] = v0[j] * sigmoidf_(v0[j]); v1[j] = v1[j] * sigmoidf_(v1[j]); } }
                    else if (act >= 2) {
#pragma unroll
                        for (int j = 0; j < 4; ++j) { v0[j] = sigmoidf_(v0[j]); v1[j] = sigmoidf_(v1[j]); } }
                    if (act == 3 || (pn >= 24 && pn < 36)) {
                        int a8 = 0, b8 = 0; a8 = __builtin_amdgcn_cvt_pk_fp8_f32(v0[0], v0[1], a8, false); a8 = __builtin_amdgcn_cvt_pk_fp8_f32(v0[2], v0[3], a8, true);
                        b8 = __builtin_amdgcn_cvt_pk_fp8_f32(v1[0], v1[1], b8, false); b8 = __builtin_amdgcn_cvt_pk_fp8_f32(v1[2], v1[3], b8, true);
                        *(u32x2*)((unsigned char*)base + (size_t)(row0 + ai * HALF + m * 16) * ld + colt + bj * HALF) = (u32x2){(unsigned)a8, (unsigned)b8}; }
                    else {
                    u32x4 w; w.x = cvt_pk_bf16(v0[0], v0[1]); w.y = cvt_pk_bf16(v0[2], v0[3]); w.z = cvt_pk_bf16(v1[0], v1[1]); w.w = cvt_pk_bf16(v1[2], v1[3]);
                    *(u32x4*)(rowp + bj * HALF) = w; } } }
    }
};
template <int MODE> struct EpiBranch {
    static constexpr bool PERM = true;
    const void* gate; const unsigned char* tin; void* out;
    __device__ __forceinline__ void operator()(const f32x4 (&acc)[2][2][4][2], const Unit& u, int wr, int wc, int fr, int fq) const {
        const int colt = u.pn * BM + wc * 32 + 8 * fq, row0 = u.pm * BM + wr * 64 + fr;
#pragma unroll
        for (int ai = 0; ai < 2; ++ai) {
            u32x4 gq4[4][2]; u32x2 gq2[4][2], tq2[4][2];
#pragma unroll
            for (int m = 0; m < 4; ++m) { const size_t ro = (size_t)(row0 + ai * HALF + m * 16) * D + colt;
#pragma unroll
                for (int bj = 0; bj < 2; ++bj) {
                    if (MODE == 0) gq2[m][bj] = *(const u32x2*)((const unsigned char*)gate + ro + bj * HALF);
                    else { gq4[m][bj] = *(const u32x4*)((const bf16*)gate + ro + bj * HALF); tq2[m][bj] = *(const u32x2*)(tin + ro + bj * HALF); } } }
#pragma unroll
            for (int m = 0; m < 4; ++m) { const size_t ro = (size_t)(row0 + ai * HALF + m * 16) * D + colt;
#pragma unroll
                for (int bj = 0; bj < 2; ++bj) {
                    float r[8], gt[8], tt[8];
#pragma unroll
                    for (int j = 0; j < 4; ++j) { r[j] = acc[ai][bj][m][0][j]; r[4 + j] = acc[ai][bj][m][1][j]; }
                    if (MODE == 0) { const u32x2 gq = gq2[m][bj];
#pragma unroll
                        for (int q = 0; q < 2; ++q) { const f32x2_t lo = __builtin_amdgcn_cvt_pk_f32_fp8((int)gq[q], false), hi = __builtin_amdgcn_cvt_pk_f32_fp8((int)gq[q], true);
                            gt[4 * q] = lo.x; gt[4 * q + 1] = lo.y; gt[4 * q + 2] = hi.x; gt[4 * q + 3] = hi.y; }
                        int a8 = 0, b8 = 0;
                        a8 = __builtin_amdgcn_cvt_pk_fp8_f32(r[0] * gt[0] * 64.f, r[1] * gt[1] * 64.f, a8, false); a8 = __builtin_amdgcn_cvt_pk_fp8_f32(r[2] * gt[2] * 64.f, r[3] * gt[3] * 64.f, a8, true);
                        b8 = __builtin_amdgcn_cvt_pk_fp8_f32(r[4] * gt[4] * 64.f, r[5] * gt[5] * 64.f, b8, false); b8 = __builtin_amdgcn_cvt_pk_fp8_f32(r[6] * gt[6] * 64.f, r[7] * gt[7] * 64.f, b8, true);
                        *(u32x2*)((unsigned char*)out + ro + bj * HALF) = (u32x2){(unsigned)a8, (unsigned)b8}; }
                    else { const u32x4 gq = gq4[m][bj]; const u32x2 tq = tq2[m][bj];
#pragma unroll
                        for (int j = 0; j < 4; ++j) { gt[2 * j] = __uint_as_float(gq[j] << 16); gt[2 * j + 1] = __uint_as_float(gq[j] & 0xffff0000u); }
#pragma unroll
                        for (int q = 0; q < 2; ++q) { const f32x2_t lo = __builtin_amdgcn_cvt_pk_f32_fp8((int)tq[q], false), hi = __builtin_amdgcn_cvt_pk_f32_fp8((int)tq[q], true);
                            tt[4 * q] = lo.x; tt[4 * q + 1] = lo.y; tt[4 * q + 2] = hi.x; tt[4 * q + 3] = hi.y; }
#pragma unroll
                        for (int j = 0; j < 8; ++j) r[j] = fmaf(r[j], gt[j], tt[j] * 0.015625f);
                        u32x4 w; w.x = cvt_pk_bf16(r[0], r[1]); w.y = cvt_pk_bf16(r[2], r[3]); w.z = cvt_pk_bf16(r[4], r[5]); w.w = cvt_pk_bf16(r[6], r[7]);
                        *(u32x4*)((bf16*)out + ro + bj * HALF) = w; } } } }
    }
};
struct EpiResid {
    static constexpr bool PERM = true;
    const float* x; bf16* out;
    __device__ __forceinline__ void operator()(const f32x4 (&acc)[2][2][4][2], const Unit& u, int wr, int wc, int fr, int fq) const {
        const int colt = u.pn * BM + wc * 32 + 8 * fq, row0 = u.pm * BM + wr * 64 + fr;
#pragma unroll
        for (int ai = 0; ai < 2; ++ai)
#pragma unroll
          for (int mp = 0; mp < 4; mp += 2) {
            f32x4 xq[2][2][2];
#pragma unroll
            for (int mm = 0; mm < 2; ++mm) { const size_t ro = (size_t)(row0 + ai * HALF + (mp + mm) * 16) * D + colt;
#pragma unroll
                for (int bj = 0; bj < 2; ++bj) { xq[mm][bj][0] = *(const f32x4*)(x + ro + bj * HALF); xq[mm][bj][1] = *(const f32x4*)(x + ro + bj * HALF + 4); } }
#pragma unroll
            for (int mm = 0; mm < 2; ++mm) { const int m = mp + mm; const size_t ro = (size_t)(row0 + ai * HALF + m * 16) * D + colt;
#pragma unroll
                for (int bj = 0; bj < 2; ++bj) { const f32x4 v0 = xq[mm][bj][0] + acc[ai][bj][m][0], v1 = xq[mm][bj][1] + acc[ai][bj][m][1];
                    u32x4 w; w.x = cvt_pk_bf16(v0[0], v0[1]); w.y = cvt_pk_bf16(v0[2], v0[3]); w.z = cvt_pk_bf16(v1[0], v1[1]); w.w = cvt_pk_bf16(v1[2], v1[3]);
                    *(u32x4*)(out + ro + bj * HALF) = w; } } }
    }
};
struct EpiSwiglu {
    static constexpr bool PERM = true;
    const float* bgate; const float* bup; unsigned char* hd;
    __device__ __forceinline__ void operator()(const f32x4 (&acc)[2][2][4][2], const Unit& u, int wr, int wc, int fr, int fq) const {
        const int col = u.pn * HALF + wc * 32 + 8 * fq; const size_t row0 = (size_t)u.pm * BM + wr * 64 + fr;
        const float* bg = bgate + (size_t)u.e * DFF + col; const float* bu = bup + (size_t)u.e * DFF + col;
        const f32x4 g0 = *(const f32x4*)bg, g1 = *(const f32x4*)(bg + 4), u0 = *(const f32x4*)bu + 1.f, u1 = *(const f32x4*)(bu + 4) + 1.f;
        constexpr float KS = 1.702f * 1.4426950408889634f;
#pragma unroll
        for (int ai = 0; ai < 2; ++ai)
#pragma unroll
            for (int m = 0; m < 4; ++m) {
                float r[8];
#pragma unroll
                for (int j = 0; j < 4; ++j) {
                    const float ga = fminf(acc[ai][0][m][0][j] + g0[j], 7.f), ua = __builtin_amdgcn_fmed3f(acc[ai][1][m][0][j] + u0[j], -6.f, 8.f);
                    const float gb = fminf(acc[ai][0][m][1][j] + g1[j], 7.f), ub = __builtin_amdgcn_fmed3f(acc[ai][1][m][1][j] + u1[j], -6.f, 8.f);
                    r[j] = ua * (ga * __builtin_amdgcn_rcpf(1.f + __builtin_amdgcn_exp2f(-KS * ga))); r[4 + j] = ub * (gb * __builtin_amdgcn_rcpf(1.f + __builtin_amdgcn_exp2f(-KS * gb))); }
                int w0 = 0, w1 = 0;
                w0 = __builtin_amdgcn_cvt_pk_fp8_f32(r[0], r[1], w0, false); w0 = __builtin_amdgcn_cvt_pk_fp8_f32(r[2], r[3], w0, true);
                w1 = __builtin_amdgcn_cvt_pk_fp8_f32(r[4], r[5], w1, false); w1 = __builtin_amdgcn_cvt_pk_fp8_f32(r[6], r[7], w1, true);
                *(u32x2*)(hd + (row0 + ai * HALF + m * 16) * DFF + col) = (u32x2){(unsigned)w0, (unsigned)w1}; }
    }
};
struct EpiDown {
    static constexpr bool PERM = true;
    const float* bdown; const int* rpair; const float* rw; unsigned char* py;
    __device__ __forceinline__ void operator()(const f32x4 (&acc)[2][2][4][2], const Unit& u, int wr, int wc, int fr, int fq) const {
        const int colt = u.pn * BM + wc * 32 + 8 * fq; const size_t srow0 = (size_t)u.pm * BM + wr * 64 + fr;
        f32x4 bv[2][2];
#pragma unroll
        for (int bj = 0; bj < 2; ++bj)
#pragma unroll
            for (int n = 0; n < 2; ++n) bv[bj][n] = *(const f32x4*)(bdown + (size_t)u.e * D + colt + bj * HALF + 4 * n);
        int pairs[2][4]; float wgts[2][4];
#pragma unroll
        for (int ai = 0; ai < 2; ++ai)
#pragma unroll
            for (int m = 0; m < 4; ++m) { const int rl = wr * 64 + fr + ai * HALF + m * 16; const int pq = rpair[u.trow + rl]; const float wq = rw[u.trow + rl];
                pairs[ai][m] = rl < u.nrow ? pq : S * 4; wgts[ai][m] = rl < u.nrow ? wq : 0.f; }
#pragma unroll
        for (int ai = 0; ai < 2; ++ai)
#pragma unroll
            for (int m = 0; m < 4; ++m) { const int pair = pairs[ai][m]; const float wgt = wgts[ai][m];
                unsigned char* rowp = py + (size_t)pair * D + colt; const float w16 = wgt * 16.f;
#pragma unroll
                for (int bj = 0; bj < 2; ++bj) { const f32x4 v0 = (acc[ai][bj][m][0] + bv[bj][0]) * w16, v1 = (acc[ai][bj][m][1] + bv[bj][1]) * w16;
                    int w0 = 0, w1 = 0;
                    w0 = __builtin_amdgcn_cvt_pk_fp8_f32(v0[0], v0[1], w0, false); w0 = __builtin_amdgcn_cvt_pk_fp8_f32(v0[2], v0[3], w0, true);
                    w1 = __builtin_amdgcn_cvt_pk_fp8_f32(v1[0], v1[1], w1, false); w1 = __builtin_amdgcn_cvt_pk_fp8_f32(v1[2], v1[3], w1, true);
                    *(u32x2*)(rowp + bj * HALF) = (u32x2){(unsigned)w0, (unsigned)w1}; } }
    }
};

struct GlaSched {
    int mode, G, c; unsigned char* ws;
    __device__ __forceinline__ bool next(int i, Unit& u) const {
        const int L = i * G + c; const int nu = mode == 0 ? 128 : 256; if (L >= nu) return false;
        const int nh = mode == 0 ? L : (L >> 1), hv = mode == 0 ? 0 : (L & 1);
        u.pm = nh; u.pn = hv; u.e = 0; u.nrow = BM;
        if (mode == 0) { u.A = (const char*)(ws + WS_ACAT) + (size_t)nh * 256 * 512 * 2 + 512; u.B = (const char*)(ws + WS_KI) + (size_t)nh * 256 * 256 * 2; }
        else if (mode == 1) { u.A = (const char*)(ws + WS_BCAT) + (size_t)nh * 512 * 512 * 2 + (size_t)hv * 256 * 512 * 2; u.B = (const char*)(ws + WS_KET) + (size_t)nh * 256 * 256 * 2; }
        else { u.A = (const char*)(ws + WS_ACAT) + (size_t)nh * 256 * 512 * 2; u.B = (const char*)(ws + WS_BCAT) + (size_t)nh * 512 * 512 * 2 + (size_t)hv * 256 * 512 * 2; }
        return true;
    }
};
struct EpiGlaNorm {
    static constexpr bool PERM = true;
    unsigned char* ws; const float* g; unsigned* ctl; LAS float* scr;
    __device__ __forceinline__ void operator()(const f32x4 (&acc)[2][2][4][2], const Unit& u, int wr, int wc, int fr, int fq) const {
        const int nh = u.pm, hv = u.pn, unit = nh * 2 + hv, tid = threadIdx.x;
        LAS float* rowpart = scr; LAS float* rstdv = scr + 1024;
#pragma unroll
        for (int ai = 0; ai < 2; ++ai)
#pragma unroll
            for (int m = 0; m < 4; ++m) { float sq = 0.f;
#pragma unroll
                for (int bj = 0; bj < 2; ++bj)
#pragma unroll
                    for (int n = 0; n < 2; ++n)
#pragma unroll
                        for (int j = 0; j < 4; ++j) sq = fmaf(acc[ai][bj][m][n][j], acc[ai][bj][m][n][j], sq);
                sq += __shfl_xor(sq, 16); sq += __shfl_xor(sq, 32);
                if (fq == 0) rowpart[wc * 256 + wr * 64 + ai * HALF + m * 16 + fr] = sq; }
        asm volatile("s_waitcnt lgkmcnt(0)" ::: "memory"); __builtin_amdgcn_s_barrier();
        float mine = 0.f; float* slot = (float*)(ws + WS_PSLOT);
        if (tid < 256) { mine = rowpart[tid] + rowpart[256 + tid] + rowpart[512 + tid] + rowpart[768 + tid]; __hip_atomic_store(slot + unit * 256 + tid, mine, __ATOMIC_RELAXED, __HIP_MEMORY_SCOPE_AGENT); }
        asm volatile("s_waitcnt vmcnt(0)" ::: "memory"); __builtin_amdgcn_s_barrier();
        if (tid == 0) { unsigned* ctr = ctl + CW_PS + 16 * nh; (void)__hip_atomic_fetch_add(ctr, 1u, __ATOMIC_RELAXED, __HIP_MEMORY_SCOPE_AGENT);
            unsigned sp = 0u; while (__hip_atomic_load(ctr, __ATOMIC_RELAXED, __HIP_MEMORY_SCOPE_AGENT) < 2u) { __builtin_amdgcn_s_sleep(1); if (++sp > (1u << 20)) break; }
            __builtin_amdgcn_fence(__ATOMIC_ACQUIRE, "agent"); asm volatile("s_waitcnt vmcnt(0)" ::: "memory"); }
        __builtin_amdgcn_s_barrier();
        if (tid < 256) { const float other = __hip_atomic_load(slot + (unit ^ 1) * 256 + tid, __ATOMIC_RELAXED, __HIP_MEMORY_SCOPE_AGENT); rstdv[tid] = rsqrtf((mine + other) * (1.f / GLA_DV) + 1e-6f); }
        asm volatile("s_waitcnt vmcnt(0) lgkmcnt(0)" ::: "memory"); __builtin_amdgcn_s_barrier();
        const int c8 = wc * 32 + 8 * fq, colh = hv * 256 + c8; const size_t tok0 = (size_t)(nh >> 2) * 256; const int colg = (nh & 3) * GLA_DV + colh;
        const bf16* GR = (const bf16*)(ws + WS_GR); bf16* YG = (bf16*)(ws + WS_YG);
        float gv[2][8];
#pragma unroll
        for (int bj = 0; bj < 2; ++bj) { const f32x4 a0 = *(const f32x4*)(g + colh + bj * HALF), a1 = *(const f32x4*)(g + colh + bj * HALF + 4);
#pragma unroll
            for (int j = 0; j < 4; ++j) { gv[bj][j] = a0[j]; gv[bj][4 + j] = a1[j]; } }
#pragma unroll
        for (int ai = 0; ai < 2; ++ai) {
            u32x4 rq[4][2];
#pragma unroll
            for (int m = 0; m < 4; ++m)
#pragma unroll
                for (int bj = 0; bj < 2; ++bj) rq[m][bj] = *(const u32x4*)(GR + (tok0 + wr * 64 + ai * HALF + m * 16 + fr) * GLA_V + colg + bj * HALF);
#pragma unroll
            for (int m = 0; m < 4; ++m) { const int row = wr * 64 + ai * HALF + m * 16 + fr; const float rs = rstdv[row];
#pragma unroll
                for (int bj = 0; bj < 2; ++bj) { float y[8];
#pragma unroll
                    for (int j = 0; j < 4; ++j) { y[j] = acc[ai][bj][m][0][j]; y[4 + j] = acc[ai][bj][m][1][j]; }
#pragma unroll
                    for (int j = 0; j < 4; ++j) { const unsigned rw_ = rq[m][bj][j];
                        y[2 * j] = y[2 * j] * rs * gv[bj][2 * j] * __uint_as_float(rw_ << 16); y[2 * j + 1] = y[2 * j + 1] * rs * gv[bj][2 * j + 1] * __uint_as_float(rw_ & 0xffff0000u); }
                    u32x4 w; w.x = cvt_pk_bf16(y[0], y[1]); w.y = cvt_pk_bf16(y[2], y[3]); w.z = cvt_pk_bf16(y[4], y[5]); w.w = cvt_pk_bf16(y[6], y[7]);
                    *(u32x4*)(YG + (tok0 + row) * GLA_V + colg + bj * HALF) = w; } } }
    }
};
template <int MODE> struct EpiGla {
    static constexpr bool PERM = true;
    unsigned char* ws;
    __device__ __forceinline__ void operator()(const f32x4 (&acc)[2][2][4][2], const Unit& u, int wr, int wc, int fr, int fq) const {
        const int nh = u.pm, hv = u.pn; const int c8 = wc * 32 + 8 * fq, r0 = wr * 64 + fr;
        bf16* base; int ld;
        if (MODE == 0) { base = (bf16*)(ws + WS_ACAT) + (size_t)nh * 256 * 512; ld = 512; }
        else if (MODE == 1) { base = (bf16*)(ws + WS_UT) + (size_t)nh * 512 * 256 + (size_t)hv * 256 * 256; ld = 256; }
        else { base = (bf16*)(ws + WS_OB) + (size_t)(nh >> 2) * 256 * GLA_V + (nh & 3) * GLA_DV + hv * 256; ld = GLA_V; }
#pragma unroll
        for (int ai = 0; ai < 2; ++ai)
#pragma unroll
            for (int m = 0; m < 4; ++m) { const int row = r0 + ai * HALF + m * 16;
#pragma unroll
                for (int bj = 0; bj < 2; ++bj) { f32x4 v0 = acc[ai][bj][m][0], v1 = acc[ai][bj][m][1]; const int col = bj * HALF + c8;
                    if (MODE == 0) {
#pragma unroll
                        for (int j = 0; j < 4; ++j) { v0[j] = (col + j <= row) ? v0[j] : 0.f; v1[j] = (col + 4 + j <= row) ? v1[j] : 0.f; } }
                    u32x4 w; w.x = cvt_pk_bf16(v0[0], v0[1]); w.y = cvt_pk_bf16(v0[2], v0[3]); w.z = cvt_pk_bf16(v1[0], v1[1]); w.w = cvt_pk_bf16(v1[2], v1[3]);
                    *(u32x4*)(base + (size_t)row * ld + col) = w; } }
    }
};
}

constexpr int NWAVES = 8;
#ifndef GEMM_CUS
#define GEMM_CUS 152
#endif
constexpr int RING_BYTES = 131072, CTLZ_OFF = 139264, MISC_OFF = CTLZ_OFF + 320, LDS_BYTES = 147456;
constexpr int TAB_OFF = MISC_OFF + 128;

struct Frame {
    LAS unsigned char* lds; volatile LAS unsigned* MISC; unsigned* ctl; unsigned char* ws;
    int tid, lane, wave, vcu, G;
};
struct Args { const float* in[22]; float* out; unsigned char* ws; int ph_lo, ph_hi, li, pad; };

struct P0Item { const float* src; bf16* dst; int ldn, K; };
constexpr int P0_I_IN = 24 * 256, P0_JIT_A = 2 * pg8::JIT_EARLY * 256, P0_I_BG = 32 * 64, P0_I_BA = 16 * 64, P0_I_OUT = 32 * 64, P0_I_E = 32 * 64;
constexpr int P0_I_SMALL = P0_I_IN + P0_I_BG + P0_I_BA + P0_I_OUT, P0_NITEMS = P0_I_SMALL;
__device__ __forceinline__ P0Item p0_decode(Frame& F, const Args& a, int r) {
    constexpr int I_IN = P0_I_IN, I_BG = P0_I_BG, I_BA = P0_I_BA;
    P0Item it;
    if (r < I_IN) {
        const int p = r >> 8, j = (p & 1) * 12 + (p >> 1), T = j, nb = 8 * T + (r & 7), kb = (r >> 3) & 31, d0 = nb * 32, s0 = d0 < C_GLR ? d0 : d0 + 16;
        it.src = a.in[2] + (size_t)kb * 64 * IN_COLS + s0; it.ldn = IN_COLS; it.dst = (bf16*)(F.ws + WS_WIN) + (size_t)d0 * D + kb * 64; it.K = D; return it; } r -= I_IN;
    if (r < I_BG) { const int nb = r % 64, kb = r / 64; it.src = a.in[10] + (size_t)kb * 64 * D + nb * 32; it.ldn = D; it.dst = (bf16*)(F.ws + WS_WBG) + (size_t)nb * 32 * GLA_V + kb * 64; it.K = GLA_V; return it; } r -= I_BG;
    if (r < I_BA) { const int nb = r % 64, kb = r / 64; it.src = a.in[11] + (size_t)kb * 64 * D + nb * 32; it.ldn = D; it.dst = (bf16*)(F.ws + WS_WBA) + (size_t)nb * 32 * ATT_W + kb * 64; it.K = ATT_W; return it; } r -= I_BA;
    { const int nb = r % 64, kb = r / 64; it.src = a.in[12] + (size_t)kb * 64 * D + nb * 32; it.ldn = D; it.dst = (bf16*)(F.ws + WS_WOUT) + (size_t)nb * 32 * D + kb * 64; it.K = D; }
    return it;
}
__device__ __forceinline__ void p0_load(const P0Item& it, int lane, f32x4 (&v)[8]) {
    const float* p = it.src + (size_t)(lane >> 3) * it.ldn + 4 * (lane & 7);
#pragma unroll
    for (int i = 0; i < 8; ++i) v[i] = __builtin_nontemporal_load((const GAS f32x4*)(p + (size_t)(8 * i) * it.ldn));
}
__device__ __forceinline__ void p0_convert(Frame& F, const Args& a, int it_lo, int it_hi, int gw, int NGW) {
    LAS float* scr = (LAS float*)(F.lds + F.wave * 16384);
    const int lane = F.lane;
    int itx = it_lo + gw;
    if (itx >= it_hi) return;
    P0Item cur = p0_decode(F, a, itx);
    f32x4 v[8]; p0_load(cur, lane, v);
    for (;;) {
        const int nx = itx + NGW; const bool more = nx < it_hi;
        P0Item nxt = cur; f32x4 vn[8];
        if (more) { nxt = p0_decode(F, a, nx); p0_load(nxt, lane, vn); }
#pragma unroll
        for (int i = 0; i < 8; ++i) { LAS float* q = scr + (8 * i + (lane >> 3)) * 33 + 4 * (lane & 7); q[0] = v[i].x; q[1] = v[i].y; q[2] = v[i].z; q[3] = v[i].w; }
        LDS_WAIT(); asm volatile("" ::: "memory");
        const int c = lane & 7;
#pragma unroll
        for (int j = 0; j < 4; ++j) { const int n = (lane >> 3) + 8 * j; const LAS float* sp = scr + (8 * c) * 33 + n;
            u32x4 o; o.x = pk2(sp[0 * 33], sp[1 * 33]); o.y = pk2(sp[2 * 33], sp[3 * 33]); o.z = pk2(sp[4 * 33], sp[5 * 33]); o.w = pk2(sp[6 * 33], sp[7 * 33]);
            __builtin_nontemporal_store(o, (GAS u32x4*)(cur.dst + (size_t)n * cur.K + 8 * c)); }
        LDS_WAIT(); asm volatile("" ::: "memory");
        if (!more) break;
        itx = nx; cur = nxt;
#pragma unroll
        for (int i = 0; i < 8; ++i) v[i] = vn[i];
    }
}
constexpr int P8_NITEMS = 3 * NE * 16 * 64, P8_ALL = P8_NITEMS + 16 * 224, P8_BA = 8 * 64, P8_END = P8_ALL + P8_BA;
__device__ __forceinline__ void p0_item8(Frame& F, const Args& a, const int it) {
    LAS unsigned char* tile = F.lds + F.wave * 16384;
    const int lane = F.lane, kq = lane >> 3, n4 = lane & 7;
    {
        const int which = it / (NE * 1024), e = (it >> 10) & 31, kb = (it >> 6) & 15, nb = it & 63, k0 = kb * 128, n0 = nb * 32;
        const float* src; unsigned char* dst; int ldn, dpitch = 2048;
        if (it >= P8_ALL) { const int r = it - P8_ALL, kb2 = r >> 6, nb2 = r & 63; src = a.in[11] + (size_t)(kb2 * 128) * D + nb2 * 32; ldn = D; dst = F.ws + WS_WBA8 + (size_t)(nb2 * 32) * ATT_W + kb2 * 128; dpitch = ATT_W; }
        else if (it >= P8_NITEMS) { const int r = it - P8_NITEMS, kb2 = r / 224, nb2 = r - kb2 * 224, d0 = 6144 + 32 * nb2; src = a.in[2] + (size_t)(kb2 * 128) * IN_COLS + d0 + 16; ldn = IN_COLS; dst = F.ws + WS_WIN8 + (size_t)(nb2 * 32) * D + kb2 * 128; }
        else if (which < 2) { src = (which ? a.in[18] : a.in[16]) + (size_t)e * D * DFF + (size_t)k0 * DFF + n0; ldn = DFF;
            dst = F.ws + WS_GU + (size_t)e * 2 * DFF * D + (size_t)((n0 >> 7) * 256 + (n0 & 127) + which * 128) * D + k0; }
        else { src = a.in[20] + (size_t)e * DFF * D + (size_t)k0 * D + n0; ldn = D; dst = F.ws + WS_DN + (size_t)e * D * DFF + (size_t)n0 * DFF + k0; }
        const float* p = src + (size_t)(4 * kq) * ldn + 4 * n4;
        f32x4 v[4][4];
#pragma unroll
        for (int ps = 0; ps < 4; ++ps)
#pragma unroll
            for (int i = 0; i < 4; ++i) v[ps][i] = __builtin_nontemporal_load((const GAS f32x4*)(p + (size_t)(32 * ps + i) * ldn));
#pragma unroll
        for (int ps = 0; ps < 4; ++ps)
#pragma unroll
            for (int c = 0; c < 4; ++c) { int w = 0;
                w = __builtin_amdgcn_cvt_pk_fp8_f32(v[ps][0][c] * 32.f, v[ps][1][c] * 32.f, w, false); w = __builtin_amdgcn_cvt_pk_fp8_f32(v[ps][2][c] * 32.f, v[ps][3][c] * 32.f, w, true);
                *(LAS int*)(tile + (4 * n4 + c) * 144 + 32 * ps + 4 * kq) = w; }
        LDS_WAIT(); asm volatile("" ::: "memory");
#pragma unroll
        for (int j = 0; j < 4; ++j) { const int n = (lane >> 3) + 8 * j, c16 = lane & 7; const u32x4 g = *(const LAS u32x4*)(tile + n * 144 + 16 * c16);
            __builtin_nontemporal_store(g, (GAS u32x4*)(dst + (size_t)n * dpitch + 16 * c16)); }
        LDS_WAIT(); asm volatile("" ::: "memory");
    }
}
__device__ __forceinline__ void p0_convert8(Frame& F, const Args& a, int it_lo, int it_hi, int gw, int NGW) {
    for (int it = it_lo + gw; it < it_hi; it += NGW) p0_item8(F, a, it);
}
__device__ __forceinline__ void p0_convert8_queue(Frame& F, const Args& a, unsigned* qbase, int nitems) {
    const int per = nitems / 8, x0 = (int)(xb_xcc_id() & 7u);
    for (int dq = 0; dq < 8; ++dq) {
        const int x = (x0 + dq) & 7, base = x * per; unsigned* q = qbase + 64 * x;
        unsigned tk = 0u; if (F.lane == 0) tk = __hip_atomic_fetch_add(q, 1u, __ATOMIC_RELAXED, __HIP_MEMORY_SCOPE_AGENT);
        int t = __builtin_amdgcn_readfirstlane((int)tk);
        while (2 * t < per) {
            tk = 0u; if (F.lane == 0) tk = __hip_atomic_fetch_add(q, 1u, __ATOMIC_RELAXED, __HIP_MEMORY_SCOPE_AGENT);
            p0_item8(F, a, base + 2 * t); p0_item8(F, a, base + 2 * t + 1);
            t = __builtin_amdgcn_readfirstlane((int)tk);
        }
    }
}
__device__ __forceinline__ void jit_publish(unsigned* flag, int wave, int lane) {
    asm volatile("s_waitcnt vmcnt(0)" ::: "memory");
    __syncthreads();
    if (wave == 0) {
        __builtin_amdgcn_fence(__ATOMIC_RELEASE, "agent");
        asm volatile("s_waitcnt vmcnt(0)" ::: "memory");
        if (lane == 0) (void)__hip_atomic_fetch_add(flag, 1u, __ATOMIC_RELAXED, __HIP_MEMORY_SCOPE_AGENT);
    }
}
__device__ __forceinline__ void p0_rows(Frame& F, const Args& a) {
    { const float* g2 = a.in[13]; const float* wr = a.in[14]; float* WR = (float*)(F.ws + WS_WR);
      for (int i = (F.vcu * NWAVES * 64) + F.tid; i < D * NE; i += F.G * NWAVES * 64) WR[i] = g2[i >> 5] * wr[i]; }
}

template <int MODE> __device__ __forceinline__ void normproj_unit(Frame& F, const Args& a, int tile) {
    const int w = F.wave, lane = F.lane, tid = F.tid, i = lane & 31, kk = lane >> 5, t0 = tile * 32;
    const float* X = MODE == 0 ? a.in[0] : (const float*)(F.ws + WS_H1); const float* g = MODE == 0 ? a.in[1] : a.in[13];
    const float* WR = (const float*)(F.ws + WS_WR); const float* br = a.in[15]; const float* w_in = a.in[2];
    LAS float* part = (LAS float*)F.lds;
    LAS float* ssq = part + 8192;
    LAS float* lg = ssq + 256;
    LAS float* rs = lg + 32 * 33;
    LAS unsigned* lcnt = (LAS unsigned*)(rs + 32); LAS unsigned* lbase = lcnt + 32; LAS unsigned* prec = lbase + 32; LAS float* pwgt = (LAS float*)(prec + 128);
    __syncthreads();
    if (MODE == 1 && tid < NE) lcnt[tid] = 0u;
    f32x16 acc;
#pragma unroll
    for (int r = 0; r < 16; ++r) acc[r] = 0.f;
    float ss = 0.f;
    const int kbase = 256 * w + 128 * kk;
    const float* arow = X + (size_t)(t0 + i) * D + kbase;
    const bf16* Xb = (const bf16*)(F.ws + WS_H1); const bf16* arowb = Xb + (size_t)(t0 + i) * D + kbase;
    LAS float* Bl = (LAS float*)(F.lds + 65536 + 8192 * w);
    constexpr int NB = MODE == 1 ? 8 : 4;
    if (MODE == 0) { for (int z = lane; z < 1024; z += 64) Bl[(z >> 4) * 32 + 16 + (z & 15)] = 0.f; }
    f32x4 av[8], bv[NB];
#define NP_LOADA(c_, d_) do { _Pragma("unroll") for (int q = 0; q < 8; ++q) d_[q] = *(const GAS f32x4*)(arow + 32 * (c_) + 4 * q); } while (0)
#define NP_LOADA_RAW(c_, d_) do { _Pragma("unroll") for (int q = 0; q < 4; ++q) d_[q] = *(const GAS u32x4*)(arowb + 32 * (c_) + 8 * q); } while (0)
#define NP_UNPACK(r_, d_) do { _Pragma("unroll") for (int q = 0; q < 4; ++q) { \
        d_[2 * q] = (f32x4){__uint_as_float(r_[q].x << 16), __uint_as_float(r_[q].x & 0xffff0000u), __uint_as_float(r_[q].y << 16), __uint_as_float(r_[q].y & 0xffff0000u)}; \
        d_[2 * q + 1] = (f32x4){__uint_as_float(r_[q].z << 16), __uint_as_float(r_[q].z & 0xffff0000u), __uint_as_float(r_[q].w << 16), __uint_as_float(r_[q].w & 0xffff0000u)}; } } while (0)
#define NP_LOADB(c_, d_) do { _Pragma("unroll") for (int r = 0; r < NB; ++r) { const int idx = lane + 64 * r; \
        if (MODE == 1) { const int kkr = idx >> 8, rem = idx & 255, s_ = rem >> 3, f4 = rem & 7; d_[r] = *(const GAS f32x4*)(WR + (size_t)(256 * w + 128 * kkr + 32 * (c_) + s_) * NE + 4 * f4); } \
        else { const int kkr = idx >> 7, rem = idx & 127, s_ = rem >> 2, f4 = rem & 3, k_ = 256 * w + 128 * kkr + 32 * (c_) + s_; d_[r] = *(const GAS f32x4*)(w_in + (size_t)k_ * IN_COLS + C_GLR + 4 * f4) * g[k_]; } } } while (0)
#define NP_STOREB(d_) do { _Pragma("unroll") for (int r = 0; r < NB; ++r) { const int idx = lane + 64 * r; \
        if (MODE == 1) { const int kkr = idx >> 8, rem = idx & 255, s_ = rem >> 3, f4 = rem & 7; *(LAS f32x4*)(Bl + (kkr * 32 + s_) * 32 + 4 * f4) = d_[r]; } \
        else { const int kkr = idx >> 7, rem = idx & 127, s_ = rem >> 2, f4 = rem & 3; *(LAS f32x4*)(Bl + (kkr * 32 + s_) * 32 + 4 * f4) = d_[r]; } } } while (0)
    if (MODE == 0) NP_LOADA(0, av); else { u32x4 ar0[4]; NP_LOADA_RAW(0, ar0); NP_UNPACK(ar0, av); }
    NP_LOADB(0, bv); NP_STOREB(bv);
#pragma unroll 1
    for (int c = 0; c < 4; ++c) {
        f32x4 avn[8], bvn[NB]; u32x4 arn[4];
        if (c < 3) { if (MODE == 0) NP_LOADA(c + 1, avn); else NP_LOADA_RAW(c + 1, arn); NP_LOADB(c + 1, bvn); }
        float bq[32];
#pragma unroll
        for (int s_ = 0; s_ < 32; ++s_) bq[s_] = Bl[(kk * 32 + s_) * 32 + i];
#pragma unroll
        for (int q = 0; q < 8; ++q)
#pragma unroll
            for (int j = 0; j < 4; ++j) { acc = __builtin_amdgcn_mfma_f32_32x32x2f32(av[q][j], bq[4 * q + j], acc, 0, 0, 0); ss = fmaf(av[q][j], av[q][j], ss); }
        if (c < 3) { NP_STOREB(bvn);
            if (MODE == 0) {
#pragma unroll
                for (int q = 0; q < 8; ++q) av[q] = avn[q]; }
            else NP_UNPACK(arn, av); }
    }
#undef NP_LOADA
#undef NP_LOADA_RAW
#undef NP_UNPACK
#undef NP_LOADB
#undef NP_STOREB
    ss += __shfl_xor(ss, 32);
    if (kk == 0) ssq[w * 32 + i] = ss;
#pragma unroll
    for (int r = 0; r < 16; ++r) part[(w * 32 + (r & 3) + 8 * (r >> 2) + 4 * kk) * 32 + i] = acc[r];
    __syncthreads();
#pragma unroll
    for (int rep = 0; rep < 2; ++rep) { const int idx = tid + 512 * rep, tok = idx >> 5, e = idx & 31; float sum = 0.f, st = 0.f;
#pragma unroll
        for (int ww = 0; ww < 8; ++ww) { sum += part[(ww * 32 + tok) * 32 + e]; st += ssq[ww * 32 + tok]; }
        const float rstd = rsqrtf(st * (1.f / D) + 1e-6f);
        if (MODE == 0) { if (e < 16) ((float*)(F.ws + WS_GLR))[(size_t)(t0 + tok) * 16 + e] = sum * rstd; }
        else lg[tok * 33 + e] = sum * rstd + br[e];
        if (e == 0) rs[tok] = rstd; }
    __syncthreads();
    bf16* HN = (bf16*)(F.ws + (MODE == 0 ? WS_XN : WS_HN)); float* topw = (float*)(F.ws + WS_TOPW); int* tope = (int*)(F.ws + WS_TOPE); int* tops = (int*)(F.ws + WS_TOPS);
    unsigned* cnt = F.ctl + CW_CNT;
    {
        constexpr int NBT = MODE == 0 ? 2 : 4;
        f32x4 gg[8];
#pragma unroll
        for (int j = 0; j < 8; ++j) gg[j] = *((const GAS f32x4*)g + lane + 64 * j);
#pragma unroll 1
        for (int qb = 0; qb < 4; qb += NBT) {
            f32x4 xr[MODE == 0 ? NBT : 1][8]; u32x2 xb[MODE == 1 ? NBT : 1][8];
#pragma unroll
            for (int k = 0; k < NBT; ++k) { const int t = t0 + 4 * w + qb + k;
#pragma unroll
                for (int j = 0; j < 8; ++j) { if (MODE == 0) xr[k][j] = ((const GAS f32x4*)(X + (size_t)t * D))[lane + 64 * j]; else xb[k][j] = ((const GAS u32x2*)(Xb + (size_t)t * D))[lane + 64 * j]; } }
#pragma unroll
            for (int k = 0; k < NBT; ++k) { const int tok = 4 * w + qb + k, t = t0 + tok; const float rstd = rs[tok];
                GAS u32x2* o8 = (GAS u32x2*)(HN + (size_t)t * D) + lane;
#pragma unroll
                for (int j = 0; j < 8; ++j) { f32x4 xv;
                    if (MODE == 0) xv = xr[k][j]; else { const u32x2 xw = xb[k][j]; xv = (f32x4){__uint_as_float(xw.x << 16), __uint_as_float(xw.x & 0xffff0000u), __uint_as_float(xw.y << 16), __uint_as_float(xw.y & 0xffff0000u)}; }
                    const f32x4 y = xv * rstd * gg[j];
                    if (MODE == 0) { u32x2 wv; wv.x = pk2(y.x, y.y); wv.y = pk2(y.z, y.w); o8[64 * j] = wv;
                        int w8 = 0; w8 = __builtin_amdgcn_cvt_pk_fp8_f32(y.x, y.y, w8, false); w8 = __builtin_amdgcn_cvt_pk_fp8_f32(y.z, y.w, w8, true); ((GAS int*)(F.ws + WS_XN8 + (size_t)t * D))[lane + 64 * j] = w8; }
                    else { int w8 = 0; w8 = __builtin_amdgcn_cvt_pk_fp8_f32(y.x, y.y, w8, false); w8 = __builtin_amdgcn_cvt_pk_fp8_f32(y.z, y.w, w8, true); ((GAS int*)((unsigned char*)HN + (size_t)t * D))[lane + 64 * j] = w8; } } }
        }
    }
#pragma unroll 1
    for (int q = 0; q < 4; ++q) {
        const int tok = 4 * w + q, t = t0 + tok, e = lane & 31;
        if (MODE == 1) {
        float vals[4]; int idxs[4]; float cur = lg[tok * 33 + e];
#pragma unroll
        for (int r = 0; r < 4; ++r) {
            float bv = cur; int bi = e;
#pragma unroll
            for (int o = 1; o < 32; o <<= 1) { const float ov = __shfl_xor(bv, o); const int oi = __shfl_xor(bi, o); if (ov > bv || (ov == bv && oi < bi)) { bv = ov; bi = oi; } }
            vals[r] = bv; idxs[r] = bi;
            if (e == bi) cur = -3.0e38f;
        }
        float ex[4], sum = 0.f;
#pragma unroll
        for (int r = 0; r < 4; ++r) { ex[r] = __expf(vals[r] - vals[0]); sum += ex[r]; }
#pragma unroll
        for (int r = 0; r < 4; ++r) {
            if (lane == r) { const int ee = idxs[r]; const unsigned lr = __hip_atomic_fetch_add(&lcnt[ee], 1u, __ATOMIC_RELAXED, __HIP_MEMORY_SCOPE_WORKGROUP);
                const float wv_ = ex[r] / sum; topw[t * 4 + r] = wv_; tope[t * 4 + r] = ee; prec[tok * 4 + r] = (ee << 16) | lr; pwgt[tok * 4 + r] = wv_; }
        }
        }
    }
    if (MODE == 1) {
        __syncthreads();
        if (tid < NE) { const unsigned c = lcnt[tid]; lbase[tid] = c ? atomicAdd(&cnt[64 * tid], c) : 0u; }
        __syncthreads();
        if (tid < 128) { const unsigned pr = prec[tid]; const int slot = (int)(lbase[pr >> 16] + (pr & 0xffffu)); tops[(t0 * 4) + tid] = slot;
            ((int*)(F.ws + WS_SMAP))[(pr >> 16) * 8192 + slot] = t0 * 4 + tid; ((float*)(F.ws + WS_WMAP))[(pr >> 16) * 8192 + slot] = pwgt[tid]; }
        __syncthreads();
        if (tid < NE) lcnt[tid] = 0u;
    }
    __syncthreads();
}
__device__ __forceinline__ void moe_table(Frame& F) {
    volatile LAS int* ts = (volatile LAS int*)(F.lds + TAB_OFF); volatile LAS int* cn = (volatile LAS int*)(F.lds + TAB_OFF + 256);
    __syncthreads();
    if (F.tid < 64) {
        const int e = F.tid & 31; const int c = (int)__hip_atomic_load(F.ctl + CW_CNT + 64 * e, __ATOMIC_RELAXED, __HIP_MEMORY_SCOPE_AGENT);
        int incl = (c + 255) >> 8; const int mine = incl;
#pragma unroll
        for (int o = 1; o < 32; o <<= 1) { const int up = __shfl_up(incl, o, 32); if (e >= o) incl += up; }
        if (F.tid < 32) { cn[e] = c; ts[e] = incl - mine; if (e == 31) ts[NE] = incl; } }
    __syncthreads();
}
__device__ __forceinline__ void p7_gather(Frame& F) {
    const int gw = F.vcu * NWAVES + F.wave, NGW = F.G * NWAVES, lane = F.lane;
    volatile LAS int* ts = (volatile LAS int*)(F.lds + TAB_OFF);
    const float* topw = (const float*)(F.ws + WS_TOPW); const int* tope = (const int*)(F.ws + WS_TOPE); const int* tops = (const int*)(F.ws + WS_TOPS);
    int* rpair = (int*)(F.ws + WS_RPAIR); float* rw = (float*)(F.ws + WS_RW);
    { volatile LAS int* cn = (volatile LAS int*)(F.lds + TAB_OFF + 256);
      for (int e = gw; e < NE; e += NGW) { const int c = cn[e], base = ts[e] * 256, padn = ((c + 255) & ~255) - c;
          for (int r = lane; r < padn; r += 64) { rpair[base + c + r] = S * 4; rw[base + c + r] = 0.f; } } }
    for (int p = F.vcu * (NWAVES * 64) + F.tid; p < S * 4; p += F.G * NWAVES * 64) { const int dst = ts[tope[p]] * 256 + tops[p]; rpair[dst] = p; rw[dst] = topw[p]; }
}
__device__ __forceinline__ void p10_combine(Frame& F, const Args& a) {
    const int gw = F.vcu * NWAVES + F.wave, NGW = F.G * NWAVES, lane = F.lane;
    const unsigned char* PY = F.ws + WS_PY; float* out = a.out; const bf16* H1 = (const bf16*)(F.ws + WS_H1);
    for (int t = gw; t < S; t += NGW) {
        u32x4 hv[4]; u32x2 pv[4][4];
#pragma unroll
        for (int j = 0; j < 4; ++j) { hv[j] = *(const GAS u32x4*)(H1 + (size_t)t * D + 512 * j + 8 * lane);
#pragma unroll
            for (int k = 0; k < 4; ++k) pv[j][k] = *(const GAS u32x2*)(PY + (size_t)(t * 4 + k) * D + 512 * j + 8 * lane); }
#pragma unroll
        for (int j = 0; j < 4; ++j) {
            float r[8];
#pragma unroll
            for (int q = 0; q < 4; ++q) { r[2 * q] = __uint_as_float(hv[j][q] << 16); r[2 * q + 1] = __uint_as_float(hv[j][q] & 0xffff0000u); }
            float ps[8] = {0.f, 0.f, 0.f, 0.f, 0.f, 0.f, 0.f, 0.f};
#pragma unroll
            for (int k = 0; k < 4; ++k) { const u32x2 p = pv[j][k];
#pragma unroll
                for (int q = 0; q < 2; ++q) { const f32x2_t lo = __builtin_amdgcn_cvt_pk_f32_fp8((int)p[q], false), hi = __builtin_amdgcn_cvt_pk_f32_fp8((int)p[q], true);
                    ps[4 * q] += lo.x; ps[4 * q + 1] += lo.y; ps[4 * q + 2] += hi.x; ps[4 * q + 3] += hi.y; } }
#pragma unroll
            for (int q = 0; q < 8; ++q) r[q] = fmaf(ps[q], 0.0625f, r[q]);
            *(GAS f32x4*)(out + (size_t)t * D + 512 * j + 8 * lane) = (f32x4){r[0], r[1], r[2], r[3]};
            *(GAS f32x4*)(out + (size_t)t * D + 512 * j + 8 * lane + 4) = (f32x4){r[4], r[5], r[6], r[7]};
        }
    }
}


constexpr float ATT_QSCALE = 0.08838834764831845f * 1.4426950408889634f;
__device__ __forceinline__ void attn_prep_unit(Frame& F, const Args& a, int n, int h) {
    const int wave = F.wave, lane = F.lane, tid = F.tid;
    LAS bf16* kst = (LAS bf16*)(F.lds);
    LAS bf16* vst = (LAS bf16*)(F.lds + 16384);
    const bf16* AQ = (const bf16*)(F.ws + WS_AQ); const bf16* AK = (const bf16*)(F.ws + WS_AK); const bf16* AV = (const bf16*)(F.ws + WS_AV);
    const float* kg = a.in[7];
    const float gk0 = kg[2 * lane], gk1 = kg[2 * lane + 1];
    unsigned kraw[8], vraw[8];
#pragma unroll
    for (int i = 0; i < 8; ++i) { const size_t off = (size_t)(n * 64 + wave * 8 + i) * ATT_W + h * ATT_HD + 2 * lane;
        kraw[i] = *(const unsigned short*)((const unsigned char*)AK + off); vraw[i] = *(const unsigned short*)((const unsigned char*)AV + off); }
#pragma unroll
    for (int i = 0; i < 8; ++i) {
        const int row = n * 64 + wave * 8 + i; const size_t off = (size_t)row * ATT_W + h * ATT_HD + 2 * lane;
        const unsigned kv = kraw[i], v8 = vraw[i];
        const f32x2_t kf = __builtin_amdgcn_cvt_pk_f32_fp8((int)kv, false), vf = __builtin_amdgcn_cvt_pk_f32_fp8((int)v8, false);
        const float k0 = kf.x, k1 = kf.y; const unsigned vv = pk2(vf.x, vf.y);
        const float rk = rsqrtf(wave_sum(k0 * k0 + k1 * k1) * (1.f / 128.f) + 1e-6f);
        *(LAS unsigned*)(kst + (wave * 8 + i) * 128 + 2 * lane) = pk2(k0 * rk * gk0, k1 * rk * gk1);
        *(LAS unsigned*)(vst + (wave * 8 + i) * 128 + 2 * lane) = vv;
    }
    __syncthreads();
    bf16* KI = (bf16*)(F.ws + WS_KIMG) + (size_t)(n * ATT_H + h) * 8192; bf16* VI = (bf16*)(F.ws + WS_VIMG) + (size_t)(n * ATT_H + h) * 8192;
#pragma unroll
    for (int i = 0; i < 2; ++i) {
        const int g = tid + 512 * i;
        { const int c16 = g >> 6, key = g & 63; const u32x4 v = *(const LAS u32x4*)(kst + key * 128 + c16 * 8); *(u32x4*)(KI + (size_t)g * 8) = v; }
        { const int kg8 = g >> 7, d = g & 127; unsigned short e[8];
#pragma unroll
          for (int j = 0; j < 8; ++j) e[j] = vst[(kg8 * 8 + j) * 128 + d];
          u32x4 v; v.x = e[0] | ((unsigned)e[1] << 16); v.y = e[2] | ((unsigned)e[3] << 16); v.z = e[4] | ((unsigned)e[5] << 16); v.w = e[6] | ((unsigned)e[7] << 16);
          *(u32x4*)(VI + (size_t)g * 8) = v; }
    }
    __syncthreads();
}

__device__ __forceinline__ int crow(int r, int hi) { return (r & 3) + 8 * (r >> 2) + 4 * hi; }
__device__ __forceinline__ void attn_unit(Frame& F, const Args& a, int n4, int h) {
    const int w = F.wave, lane = F.lane, r32 = lane & 31, hi = lane >> 5, tid = F.tid;
    const int p = w >> 1, half = w & 1, c = 4 * n4 + p, qrow0 = c * 64 + 32 * half;
    LAS unsigned char* lds = F.lds;
    LAS float* btab = (LAS float*)(lds + 65536); LAS float* xch = (LAS float*)(lds + 67584 + 256 * w); LAS bf16* ost = (LAS bf16*)(lds + 8192 * w);
    const float* relb = a.in[8] + h * 257;
    if (tid < 257) btab[tid] = relb[tid] * 1.4426950408889634f;
    LAS unsigned char* qimg = lds + 69632 + 8192 * w;
    {
        const unsigned char* AQ8 = F.ws + WS_AQ + (size_t)(qrow0 + r32) * ATT_W + h * ATT_HD + hi * 8; const float* qg = a.in[6] + hi * 8;
        u32x2 qr[8];
#pragma unroll
        for (int d0 = 0; d0 < 8; ++d0) qr[d0] = *(const u32x2*)(AQ8 + d0 * 16);
        float qf[8][8]; float ssq_ = 0.f;
#pragma unroll
        for (int d0 = 0; d0 < 8; ++d0)
#pragma unroll
            for (int q2 = 0; q2 < 2; ++q2) { const f32x2_t lo = __builtin_amdgcn_cvt_pk_f32_fp8((int)qr[d0][q2], false), hh = __builtin_amdgcn_cvt_pk_f32_fp8((int)qr[d0][q2], true);
                qf[d0][4 * q2] = lo.x; qf[d0][4 * q2 + 1] = lo.y; qf[d0][4 * q2 + 2] = hh.x; qf[d0][4 * q2 + 3] = hh.y;
                ssq_ += lo.x * lo.x + lo.y * lo.y + hh.x * hh.x + hh.y * hh.y; }
        ssq_ += __shfl_xor(ssq_, 32);
        const float rq = rsqrtf(ssq_ * (1.f / 128.f) + 1e-6f) * ATT_QSCALE;
#pragma unroll
        for (int d0 = 0; d0 < 8; ++d0) { const f32x4 g0 = *(const f32x4*)(qg + d0 * 16), g1 = *(const f32x4*)(qg + d0 * 16 + 4);
            u32x4 wq; wq.x = pk2(qf[d0][0] * rq * g0.x, qf[d0][1] * rq * g0.y); wq.y = pk2(qf[d0][2] * rq * g0.z, qf[d0][3] * rq * g0.w);
            wq.z = pk2(qf[d0][4] * rq * g1.x, qf[d0][5] * rq * g1.y); wq.w = pk2(qf[d0][6] * rq * g1.z, qf[d0][7] * rq * g1.w);
            *(LAS u32x4*)(qimg + ((2 * d0 + hi) * 32 + r32) * 16) = wq; }
    }
    const char* KIMG = (const char*)(F.ws + WS_KIMG); const char* VIMG = (const char*)(F.ws + WS_VIMG);
    f32x16 o[4];
#pragma unroll
    for (int dt = 0; dt < 4; ++dt)
#pragma unroll
        for (int r = 0; r < 16; ++r) o[dt][r] = 0.f;
    float m = -1.0e30f, l = 0.f;
    const int s0 = (4 * n4 - 8 < 0) ? (8 - 4 * n4) : 0;
#define ATT_STAGE(s_) do { const int kc_ = 4 * n4 - 8 + (s_); const size_t gb_ = (size_t)(kc_ * ATT_H + h) * 16384; const unsigned lb_ = ((s_) & 1) * 32768; \
        _Pragma("unroll") for (int i_ = 0; i_ < 2; ++i_) { const int pc_ = w + 8 * i_; \
            __builtin_amdgcn_global_load_lds((const unsigned*)(KIMG + gb_ + pc_ * 1024 + lane * 16), (LAS unsigned*)(lds + lb_ + pc_ * 1024), 16, 0, 0); \
            __builtin_amdgcn_global_load_lds((const unsigned*)(VIMG + gb_ + pc_ * 1024 + lane * 16), (LAS unsigned*)(lds + lb_ + 16384 + pc_ * 1024), 16, 0, 0); } } while (0)
    ATT_STAGE(s0);
    for (int s = s0; s < 12; ++s) {
        asm volatile("s_waitcnt vmcnt(0) lgkmcnt(0)" ::: "memory");
        __builtin_amdgcn_s_barrier();
        if (s + 1 < 12) ATT_STAGE(s + 1);
        if (s >= p && s <= p + 8) {
            const LAS unsigned char* kb = lds + (s & 1) * 32768; const LAS unsigned char* vb = kb + 16384;
            f32x16 p0, p1;
#pragma unroll
            for (int r = 0; r < 16; ++r) { p0[r] = 0.f; p1[r] = 0.f; }
#pragma unroll
            for (int d0 = 0; d0 < 8; ++d0) {
                const bf16x8 k0 = *(const LAS bf16x8*)(kb + (2 * d0 + hi) * 1024 + r32 * 16), k1 = *(const LAS bf16x8*)(kb + (2 * d0 + hi) * 1024 + (r32 + 32) * 16);
                const bf16x8 qv = *(const LAS bf16x8*)(qimg + ((2 * d0 + hi) * 32 + r32) * 16);
                p0 = __builtin_amdgcn_mfma_f32_32x32x16_bf16(k0, qv, p0, 0, 0, 0);
                p1 = __builtin_amdgcn_mfma_f32_32x32x16_bf16(k1, qv, p1, 0, 0, 0);
                if (d0 & 1) __builtin_amdgcn_sched_barrier(0);
            }
            const int wrel = p + 8 - s;
            if (wrel >= 3) { const float bc = btab[256];
#pragma unroll
                for (int r = 0; r < 16; ++r) { p0[r] += bc; p1[r] += bc; } }
            else { const int base = 64 * wrel + 32 * half + r32 + 128;
#pragma unroll
                for (int r = 0; r < 16; ++r) { int i0 = base - crow(r, hi), i1 = i0 - 32; i0 = i0 > 256 ? 256 : i0; i1 = i1 > 256 ? 256 : i1; i1 = i1 < 0 ? 0 : i1; i0 = i0 < 0 ? 0 : i0; p0[r] += btab[i0]; p1[r] += btab[i1]; } }
            float mx = p0[0];
#pragma unroll
            for (int r = 1; r < 16; ++r) mx = fmaxf(mx, p0[r]);
#pragma unroll
            for (int r = 0; r < 16; ++r) mx = fmaxf(mx, p1[r]);
            mx = fmaxf(mx, __shfl_xor(mx, 32));
            const float mn = fmaxf(m, mx), alpha = __builtin_amdgcn_exp2f(m - mn);
            float ps = 0.f;
#pragma unroll
            for (int r = 0; r < 16; ++r) { p0[r] = __builtin_amdgcn_exp2f(p0[r] - mn); p1[r] = __builtin_amdgcn_exp2f(p1[r] - mn); ps += p0[r] + p1[r]; }
            l = l * alpha + ps;
            if (__any(mn > m)) {
                if (hi == 0) xch[r32] = alpha;
                asm volatile("s_waitcnt lgkmcnt(0)" ::: "memory");
#pragma unroll
                for (int g = 0; g < 4; ++g) { const f32x4 av = *(const LAS f32x4*)(xch + 8 * g + 4 * hi);
#pragma unroll
                    for (int dt = 0; dt < 4; ++dt) { o[dt][4 * g] *= av[0]; o[dt][4 * g + 1] *= av[1]; o[dt][4 * g + 2] *= av[2]; o[dt][4 * g + 3] *= av[3]; } }
            }
            m = mn;
            bf16x8 pa[4];
#pragma unroll
            for (int ks = 0; ks < 4; ++ks) { const f32x16& src = (ks < 2) ? p0 : p1; const int b = (ks & 1) * 8; u32x4 t;
                t.x = cvt_pk_bf16(src[b], src[b + 1]); t.y = cvt_pk_bf16(src[b + 2], src[b + 3]); t.z = cvt_pk_bf16(src[b + 4], src[b + 5]); t.w = cvt_pk_bf16(src[b + 6], src[b + 7]);
                pa[ks] = __builtin_bit_cast(bf16x8, t); }
#pragma unroll
            for (int dt = 0; dt < 4; ++dt)
#pragma unroll
                for (int ks = 0; ks < 4; ++ks) {
                    const LAS unsigned char* vp = vb + (2 * ks) * 2048 + (32 * dt + r32) * 16 + 8 * hi;
                    const u32x2 lo = *(const LAS u32x2*)vp, hh = *(const LAS u32x2*)(vp + 2048);
                    const u32x4 bq = (u32x4){lo.x, lo.y, hh.x, hh.y};
                    o[dt] = __builtin_amdgcn_mfma_f32_32x32x16_bf16(pa[ks], __builtin_bit_cast(bf16x8, bq), o[dt], 0, 0, 0);
                    if (ks == 3) __builtin_amdgcn_sched_barrier(0);
                }
        }
    }
#undef ATT_STAGE
    asm volatile("s_waitcnt lgkmcnt(0)" ::: "memory");
    __builtin_amdgcn_s_barrier();
    l += __shfl_xor(l, 32);
    if (hi == 0) xch[32 + r32] = 1.f / l;
    asm volatile("s_waitcnt lgkmcnt(0)" ::: "memory");
#pragma unroll
    for (int g = 0; g < 4; ++g) { const f32x4 iv = *(const LAS f32x4*)(xch + 32 + 8 * g + 4 * hi);
#pragma unroll
        for (int dt = 0; dt < 4; ++dt)
#pragma unroll
            for (int j = 0; j < 4; ++j) ost[(8 * g + 4 * hi + j) * 128 + 32 * dt + r32] = (bf16)f2bf(o[dt][4 * g + j] * iv[j]); }
    asm volatile("s_waitcnt lgkmcnt(0)" ::: "memory");
    unsigned char* YA = F.ws + WS_YA;
#pragma unroll
    for (int i = 0; i < 8; ++i) { const int g = i * 64 + lane, row = g >> 4, c16 = g & 15; const u32x4 v = *(const LAS u32x4*)(ost + row * 128 + c16 * 8);
        u32x2 o8;
#pragma unroll
        for (int q = 0; q < 2; ++q) { int w8 = 0; const unsigned w0 = v[2 * q], w1 = v[2 * q + 1];
            w8 = __builtin_amdgcn_cvt_pk_fp8_f32(__uint_as_float(w0 << 16) * 32.f, __uint_as_float(w0 & 0xffff0000u) * 32.f, w8, false);
            w8 = __builtin_amdgcn_cvt_pk_fp8_f32(__uint_as_float(w1 << 16) * 32.f, __uint_as_float(w1 & 0xffff0000u) * 32.f, w8, true); o8[q] = (unsigned)w8; }
        *(u32x2*)(YA + (size_t)(qrow0 + row) * ATT_W + h * ATT_HD + c16 * 8) = o8; }
    asm volatile("s_waitcnt vmcnt(0) lgkmcnt(0)" ::: "memory");
    __builtin_amdgcn_s_barrier();
}


__device__ __forceinline__ void gla_prep_unit(Frame& F, const Args& a, int n, int cg) {
    const int tid = F.tid, cq = tid & 15, seg = tid >> 4;
    const int h = cg >> 2, dk0 = (cg & 3) * 64 + 4 * cq, col0 = h * GLA_DK + dk0, nh = n * GLA_H + h;
    const float* wgu = a.in[3]; const float* bgt = a.in[4]; const float* GLR = (const float*)(F.ws + WS_GLR);
    const bf16* GQ = (const bf16*)(F.ws + WS_GQ); const bf16* GK = (const bf16*)(F.ws + WS_GK);
    LAS float* tot = (LAS float*)F.lds;
    LAS float* wl = tot + 2048;
    const int t0 = n * 256 + seg * 8;
    u32x2 qraw[8], kraw[8];
#pragma unroll
    for (int i = 0; i < 8; ++i) { qraw[i] = *(const u32x2*)(GQ + (size_t)(t0 + i) * GLA_QK + col0); kraw[i] = *(const u32x2*)(GK + (size_t)(t0 + i) * GLA_QK + col0); }
    if (seg < 16) *(LAS f32x4*)(wl + seg * 64 + 4 * cq) = *(const f32x4*)(wgu + seg * GLA_QK + col0);
    __syncthreads();
    const f32x4 bgv = *(const f32x4*)(bgt + col0);
    f32x4 cs[8]; f32x4 run = (f32x4){0.f, 0.f, 0.f, 0.f};
#pragma unroll
    for (int i = 0; i < 8; ++i) {
        const f32x4* gp = (const f32x4*)(GLR + (size_t)(t0 + i) * 16); f32x4 z = bgv;
#pragma unroll
        for (int q = 0; q < 4; ++q) { const f32x4 gv = gp[q]; const LAS f32x4* wp = (const LAS f32x4*)(wl + 4 * q * 64 + 4 * cq);
            z += wp[0] * gv.x; z += wp[16] * gv.y; z += wp[32] * gv.z; z += wp[48] * gv.w; }
#pragma unroll
        for (int j = 0; j < 4; ++j) run[j] += log_sigmoid(z[j]) * (1.f / 16.f);
        cs[i] = run;
    }
    *(LAS f32x4*)(tot + seg * 64 + 4 * cq) = run;
    __syncthreads();
    f32x4 off = (f32x4){0.f, 0.f, 0.f, 0.f}, total = (f32x4){0.f, 0.f, 0.f, 0.f};
    for (int sg = 0; sg < 32; ++sg) { const f32x4 tv = *(const LAS f32x4*)(tot + sg * 64 + 4 * cq); total += tv; if (sg < seg) off += tv; }
    float etot[4];
#pragma unroll
    for (int j = 0; j < 4; ++j) etot[j] = __expf(total[j]);
    unsigned kew[4][4];
    bf16* ACAT = (bf16*)(F.ws + WS_ACAT); bf16* KI = (bf16*)(F.ws + WS_KI); bf16* KET = (bf16*)(F.ws + WS_KET);
    float kprev[4];
#pragma unroll
    for (int i = 0; i < 8; ++i) {
        const size_t trow = (size_t)(t0 + i);
        const u32x2 qv = qraw[i], kv = kraw[i];
        float q[4] = {__uint_as_float(qv.x << 16), __uint_as_float(qv.x & 0xffff0000u), __uint_as_float(qv.y << 16), __uint_as_float(qv.y & 0xffff0000u)};
        float k[4] = {__uint_as_float(kv.x << 16), __uint_as_float(kv.x & 0xffff0000u), __uint_as_float(kv.y << 16), __uint_as_float(kv.y & 0xffff0000u)};
        float qd[4], ki[4], ke[4];
#pragma unroll
        for (int j = 0; j < 4; ++j) { const float bc = cs[i][j] + off[j]; const float eb = __expf(bc), ib = __builtin_amdgcn_rcpf(eb); qd[j] = q[j] * 0.0625f * eb; ki[j] = k[j] * ib; ke[j] = ki[j] * etot[j]; }
        const size_t lrow = (size_t)nh * 256 + seg * 8 + i;
        u32x2 o; o.x = pk2(qd[0], qd[1]); o.y = pk2(qd[2], qd[3]); *(u32x2*)(ACAT + lrow * 512 + 256 + dk0) = o;
        o.x = pk2(ki[0], ki[1]); o.y = pk2(ki[2], ki[3]); *(u32x2*)(KI + lrow * 256 + dk0) = o;
        if (i & 1) {
#pragma unroll
            for (int j = 0; j < 4; ++j) kew[j][i >> 1] = pk2(kprev[j], ke[j]); }
        else {
#pragma unroll
            for (int j = 0; j < 4; ++j) kprev[j] = ke[j]; }
    }
#pragma unroll
    for (int j = 0; j < 4; ++j) *(u32x4*)(KET + ((size_t)nh * 256 + dk0 + j) * 256 + seg * 8) = (u32x4){kew[j][0], kew[j][1], kew[j][2], kew[j][3]};
    if (seg == 0) *(f32x4*)((float*)(F.ws + WS_DEC) + n * GLA_QK + col0) = (f32x4){etot[0], etot[1], etot[2], etot[3]};
    __syncthreads();
}
__device__ __forceinline__ void gla_vt_unit(Frame& F, int n, int h, int g8) {
    const int tid = F.tid; const int nh = n * GLA_H + h;
    LAS bf16* tile = (LAS bf16*)F.lds;
    const bf16* GV = (const bf16*)(F.ws + WS_GV); bf16* BCAT = (bf16*)(F.ws + WS_BCAT);
#pragma unroll
    for (int ps = 0; ps < 4; ++ps) { const int row = (tid >> 3) + 64 * ps, ch = tid & 7;
        const u32x4 v = *(const u32x4*)(GV + (size_t)(n * 256 + row) * GLA_V + h * GLA_DV + g8 * 64 + ch * 8);
        *(LAS u32x2*)(tile + row * 72 + ch * 8) = (u32x2){v.x, v.y}; *(LAS u32x2*)(tile + row * 72 + ch * 8 + 4) = (u32x2){v.z, v.w}; }
    __syncthreads();
#pragma unroll
    for (int i = 0; i < 4; ++i) { const int g = tid + 512 * i, c = g & 63, tg = g >> 6; unsigned short e[8];
#pragma unroll
        for (int j = 0; j < 8; ++j) e[j] = tile[(tg * 8 + j) * 72 + c];
        u32x4 v; v.x = e[0] | ((unsigned)e[1] << 16); v.y = e[2] | ((unsigned)e[3] << 16); v.z = e[4] | ((unsigned)e[5] << 16); v.w = e[6] | ((unsigned)e[7] << 16);
        *(u32x4*)(BCAT + ((size_t)nh * 512 + g8 * 64 + c) * 512 + tg * 8) = v; }
    __syncthreads();
}
__device__ __forceinline__ void gla_scan(Frame& F) {
    const bf16* UT = (const bf16*)(F.ws + WS_UT); bf16* BCAT = (bf16*)(F.ws + WS_BCAT); const float* DEC = (const float*)(F.ws + WS_DEC);
    for (int idx = F.vcu * (NWAVES * 64) + F.tid; idx < GLA_H * GLA_DV * 64; idx += F.G * NWAVES * 64) {
        const int dk4 = (idx & 63) * 4, dv = (idx >> 6) & 511, h = idx >> 15;
        float s[4] = {0.f, 0.f, 0.f, 0.f};
#pragma unroll 1
        for (int nb = 0; nb < 32; nb += 16) {
            u32x2 uvv[16]; f32x4 dcv[16];
#pragma unroll
            for (int k = 0; k < 16; ++k) { const size_t nh = (size_t)(nb + k) * GLA_H + h;
                uvv[k] = *(const u32x2*)(UT + (nh * 512 + dv) * 256 + dk4); dcv[k] = *(const f32x4*)(DEC + (nb + k) * GLA_QK + h * GLA_DK + dk4); }
#pragma unroll
            for (int k = 0; k < 16; ++k) { const size_t nh = (size_t)(nb + k) * GLA_H + h; const u32x2 uv = uvv[k]; const f32x4 dc = dcv[k];
                u32x2 o; o.x = pk2(s[0], s[1]); o.y = pk2(s[2], s[3]); *(u32x2*)(BCAT + (nh * 512 + dv) * 512 + 256 + dk4) = o;
                s[0] = s[0] * dc.x + __uint_as_float(uv.x << 16); s[1] = s[1] * dc.y + __uint_as_float(uv.x & 0xffff0000u);
                s[2] = s[2] * dc.z + __uint_as_float(uv.y << 16); s[3] = s[3] * dc.w + __uint_as_float(uv.y & 0xffff0000u); }
        }
    }
}
__device__ __forceinline__ void gla_norm(Frame& F, const Args& a) {
    const int gw = F.vcu * NWAVES + F.wave, NGW = F.G * NWAVES, lane = F.lane;
    const bf16* OB = (const bf16*)(F.ws + WS_OB); const bf16* GR = (const bf16*)(F.ws + WS_GR); bf16* YG = (bf16*)(F.ws + WS_YG); const float* g = a.in[5];
    const f32x4 g0 = *(const f32x4*)(g + 8 * lane), g1 = *(const f32x4*)(g + 8 * lane + 4);
    for (int wb = gw; wb < S * GLA_H; wb += 4 * NGW) {
        u32x4 ovv[4], rvv[4];
#pragma unroll
        for (int k = 0; k < 4; ++k) { const int wi = wb + k * NGW; if (wi < S * GLA_H) { const size_t off = (size_t)(wi >> 2) * GLA_V + (wi & 3) * GLA_DV + 8 * lane; ovv[k] = *(const u32x4*)(OB + off); rvv[k] = *(const u32x4*)(GR + off); } }
#pragma unroll
        for (int k = 0; k < 4; ++k) { const int wi = wb + k * NGW; if (wi < S * GLA_H) {
        const size_t off = (size_t)(wi >> 2) * GLA_V + (wi & 3) * GLA_DV + 8 * lane;
        const u32x4 ov = ovv[k], rv = rvv[k];
        float o[8], r[8]; float ss = 0.f;
#pragma unroll
        for (int j = 0; j < 4; ++j) { o[2 * j] = __uint_as_float(ov[j] << 16); o[2 * j + 1] = __uint_as_float(ov[j] & 0xffff0000u); r[2 * j] = __uint_as_float(rv[j] << 16); r[2 * j + 1] = __uint_as_float(rv[j] & 0xffff0000u); }
#pragma unroll
        for (int j = 0; j < 8; ++j) ss += o[j] * o[j];
        const float rstd = rsqrtf(wave_sum(ss) * (1.f / GLA_DV) + 1e-6f);
        u32x4 w; w.x = pk2(o[0] * rstd * g0.x * r[0], o[1] * rstd * g0.y * r[1]); w.y = pk2(o[2] * rstd * g0.z * r[2], o[3] * rstd * g0.w * r[3]);
        w.z = pk2(o[4] * rstd * g1.x * r[4], o[5] * rstd * g1.y * r[5]); w.w = pk2(o[6] * rstd * g1.z * r[6], o[7] * rstd * g1.w * r[7]);
        *(u32x4*)(YG + off) = w; } }
    }
}

__global__ void __launch_bounds__(NWAVES * 64, 2) fwd(Args args) {
    extern __shared__ __attribute__((aligned(16))) unsigned char lds_raw[];
    Frame F;
    F.lds = (LAS unsigned char*)lds_raw; F.MISC = (volatile LAS unsigned*)(F.lds + MISC_OFF);
    F.tid = threadIdx.x; F.lane = F.tid & 63; F.wave = __builtin_amdgcn_readfirstlane(F.tid >> 6);
    F.G = gridDim.x; { const int bx = blockIdx.x; F.vcu = (F.G % 8 == 0) ? (bx % 8) * (F.G / 8) + bx / 8 : bx; }
    F.ws = args.ws; F.ctl = (unsigned*)(args.ws + WS_CTL);
    for (int u = F.tid; u < (LDS_BYTES - CTLZ_OFF) / 4; u += NWAVES * 64) ((LAS unsigned*)(F.lds + CTLZ_OFF))[u] = 0u;
    __syncthreads();
    XcdBarrier bar = xcd_barrier_post(F.ctl + CW_BAR + args.li * XCD_BAR_WORDS, F.MISC + 8);
    const int lo = args.ph_lo, hi = args.ph_hi;
#define IN(k) (lo <= (k) && (k) < hi)
#define SEAM(k) do { if (IN(k) && IN((k) + 1)) xcd_barrier(bar); } while (0)
    unsigned char* ws = args.ws;
#ifndef DUP_MASK
#define DUP_MASK 0
#endif
#define DUP(k) ((DUP_MASK >> (k)) & 1)
#define PHASE(k, ...) do { if (IN(k)) { __VA_ARGS__ if (DUP(k)) { xcd_barrier(bar); __VA_ARGS__ } } SEAM(k); } while (0)
#define PHASE_NB(k, ...) do { if (IN(k)) { __VA_ARGS__ if (DUP(k)) { xcd_barrier(bar); __VA_ARGS__ } } } while (0)
    const int gcus = (F.G == 256) ? GEMM_CUS : F.G;
#ifndef JIT_WIN
#define JIT_WIN 0
#endif
    const bool split = gcus < F.G, jit = split && JIT_WIN;
    unsigned* const jf = F.ctl + CW_JIT;
    PHASE(0, { if (!jit) { p0_convert(F, args, 0, split ? P0_I_IN : P0_NITEMS, F.vcu * NWAVES + F.wave, F.G * NWAVES); p0_convert8(F, args, split ? P8_NITEMS : 0, split ? P8_ALL : P8_END, F.vcu * NWAVES + F.wave, F.G * NWAVES); } p0_rows(F, args);
        for (int u = F.vcu; u < S / 32; u += F.G) normproj_unit<0>(F, args, u); });
    PHASE(1, { if (jit) { p0_convert(F, args, 0, P0_JIT_A, F.vcu * NWAVES + F.wave, F.G * NWAVES); jit_publish(jf, F.wave, F.lane); }
        if ((int)blockIdx.x < gcus) {
            { pg8::DenseSched Sc; Sc.init_split(ws + WS_XN, ws + WS_WIN, S, 24, D * 2, gcus, (int)blockIdx.x, 24, 0); Sc.wgm = 4; pg8::EpiProj E{ws, args.in[9]};
              if (jit) { Sc.jflag = jf; Sc.jwant0 = (unsigned)F.G; Sc.jwant1 = (unsigned)(F.G - gcus); Sc.jseen = F.MISC + 16; }
              pg8::gemm_phase<pg8::EpiProj, pg8::DenseSched>(F.lds, D, D, D, Sc, E); }
            { pg8::DenseSched Sc; Sc.init_split(ws + WS_XN8, ws + WS_WIN8, S, 28, D, gcus, gcus - 1 - (int)blockIdx.x, 28, 0); Sc.pn_base = 24; Sc.bcompact = 1; Sc.wgm = 4; pg8::EpiProj E{ws, args.in[9]};
              if (jit) { Sc.jflag = jf; Sc.jwant0 = (unsigned)F.G; Sc.jwant1 = (unsigned)(F.G - gcus); Sc.jseen = F.MISC + 16; Sc.jmode = 1; }
              pg8::gemm_phase8<pg8::EpiProj, pg8::DenseSched>(F.lds, D, D, D, Sc, E); }
            if (split) { __syncthreads(); p0_convert8_queue(F, args, jf + 128, P8_NITEMS); } }
        else { const int cw = ((int)blockIdx.x - gcus) * NWAVES + F.wave, ncw = (F.G - gcus) * NWAVES;
            if (jit) { p0_convert(F, args, P0_JIT_A, P0_I_IN, cw, ncw); p0_convert8(F, args, P8_NITEMS, P8_ALL, cw, ncw); jit_publish(jf + 64, F.wave, F.lane); }
            p0_convert(F, args, P0_I_IN, P0_I_IN + P0_I_BG, cw, ncw); p0_convert(F, args, P0_I_IN + P0_I_BG + P0_I_BA, P0_NITEMS, cw, ncw); p0_convert8(F, args, P8_ALL, P8_END, cw, ncw); p0_convert8_queue(F, args, jf + 128, P8_NITEMS); } });
    PHASE(2, { for (int rp = 0; rp < 1 + DUP(16); ++rp) for (int u = F.vcu; u < NCH * ATT_H; u += F.G) attn_prep_unit(F, args, u >> 3, u & 7);
        for (int rp = 0; rp < 1 + DUP(17); ++rp) for (int u = F.vcu; u < 32 * 16; u += F.G) gla_prep_unit(F, args, u >> 4, u & 15);
        for (int rp = 0; rp < 1 + DUP(18); ++rp) for (int u = F.vcu; u < 32 * GLA_H * 8; u += F.G) gla_vt_unit(F, u >> 5, (u >> 3) & 3, u & 7); });
    PHASE(3, { for (int u = F.vcu; u < (NCH / 4) * ATT_H; u += F.G) attn_unit(F, args, u >> 3, u & 7);
        { pg8::GlaSched Sc{0, F.G, F.G - 1 - (int)blockIdx.x, ws}; pg8::EpiGla<0> E{ws}; pg8::gemm_phase<pg8::EpiGla<0>, pg8::GlaSched>(F.lds, 256, 512, 256, Sc, E); }
        { pg8::GlaSched Sc{1, F.G, (int)blockIdx.x, ws}; pg8::EpiGla<1> E{ws}; pg8::gemm_phase<pg8::EpiGla<1>, pg8::GlaSched>(F.lds, 256, 512, 256, Sc, E); } });
    PHASE(4, { gla_scan(F);
        { pg8::DenseSched Sc; Sc.init_split(ws + WS_YA, ws + WS_WBA8, S, D / 256, ATT_W, F.G, (int)blockIdx.x, D / 256, 0); Sc.wgm = 4; pg8::EpiBranch<0> E{ws + WS_SA, nullptr, ws + WS_T};
          pg8::gemm_phase8<pg8::EpiBranch<0>, pg8::DenseSched>(F.lds, ATT_W, ATT_W, ATT_W, Sc, E, 0x7a7a7a7a); } });
    const bool fuse56 = (F.G == 256);
    PHASE(5, { pg8::GlaSched Sc{2, F.G, fuse56 ? ((int)blockIdx.x % 8) * 32 + (int)blockIdx.x / 8 : (int)blockIdx.x, ws};
        if (fuse56) { pg8::EpiGlaNorm E{ws, args.in[5], F.ctl, (LAS float*)(F.lds + RING_BYTES)}; pg8::gemm_phase<pg8::EpiGlaNorm, pg8::GlaSched>(F.lds, 512, 512, 512, Sc, E); }
        else { pg8::EpiGla<2> E{ws}; pg8::gemm_phase<pg8::EpiGla<2>, pg8::GlaSched>(F.lds, 512, 512, 512, Sc, E); } });
    if (!fuse56) PHASE(6, { gla_norm(F, args); });
    PHASE(7, { pg8::DenseSched Sc; Sc.init(ws + WS_YG, ws + WS_WBG, S, D, GLA_V, F.G, (int)blockIdx.x); Sc.wgm = 4; pg8::EpiBranch<1> E{ws + WS_SG, ws + WS_T, ws + WS_MG};
        pg8::gemm_phase<pg8::EpiBranch<1>, pg8::DenseSched>(F.lds, GLA_V, GLA_V, GLA_V, Sc, E); });
    PHASE(9, { pg8::DenseSched Sc; Sc.init(ws + WS_MG, ws + WS_WOUT, S, D, D, F.G, (int)blockIdx.x); Sc.wgm = 4; pg8::EpiResid E{args.in[0], (bf16*)(ws + WS_H1)};
        pg8::gemm_phase<pg8::EpiResid, pg8::DenseSched>(F.lds, D, D, D, Sc, E); });
    PHASE(10, { for (int u = F.vcu; u < S / 32; u += F.G) normproj_unit<1>(F, args, u); });
    PHASE(12, { moe_table(F); pg8::MoeSched Sc;
        Sc.init(ws + WS_HN, ws + WS_GU, (volatile LAS int*)(F.lds + TAB_OFF), (volatile LAS int*)(F.lds + TAB_OFF + 256), 16, D, F.G, (int)blockIdx.x); Sc.agather = 1;
        pg8::EpiSwiglu E{args.in[17], args.in[19], ws + WS_HD};
        pg8::gemm_phase8<pg8::EpiSwiglu, pg8::MoeSched, true>(F.lds, D, D, D, Sc, E, 0x7f7f7f7f, (const int*)(ws + WS_SMAP), S - 1); });
    PHASE(13, { pg8::MoeSched Sc; Sc.init(ws + WS_HD, ws + WS_DN, (volatile LAS int*)(F.lds + TAB_OFF), (volatile LAS int*)(F.lds + TAB_OFF + 256), 8, DFF, F.G, (int)blockIdx.x);
        pg8::EpiDown E{args.in[21], (const int*)(ws + WS_SMAP), (const float*)(ws + WS_WMAP), ws + WS_PY};
        pg8::gemm_phase8<pg8::EpiDown, pg8::MoeSched>(F.lds, DFF, DFF, DFF, Sc, E); });
    PHASE(14, { p10_combine(F, args); });
#undef PHASE
#undef PHASE_NB
#undef IN
#undef SEAM
}

extern "C" void kernel_launch(void* const* d_in, const int* in_sizes, int n_in, void* d_out, int out_size, void* d_ws, size_t ws_size, hipStream_t stream) {
    static int grid = 0;
    if (grid == 0) {
        if (n_in != 22 || out_size != S * D || ws_size < WS_END) { fprintf(stderr, "kernel_launch: unexpected problem (n_in %d out %d ws %zu)\n", n_in, out_size, ws_size); grid = -1; return; }
        int dev = 0, cus = 0, per_cu = 0;
        if (hipGetDevice(&dev) != hipSuccess || hipDeviceGetAttribute(&cus, hipDeviceAttributeMultiprocessorCount, dev) != hipSuccess) { grid = -1; return; }
        if (hipFuncSetAttribute((const void*)fwd, hipFuncAttributeMaxDynamicSharedMemorySize, LDS_BYTES) != hipSuccess) { fprintf(stderr, "kernel_launch: hipFuncSetAttribute failed\n"); grid = -1; return; }
        if (hipOccupancyMaxActiveBlocksPerMultiprocessor(&per_cu, (const void*)fwd, NWAVES * 64, LDS_BYTES) != hipSuccess || per_cu < 1) fprintf(stderr, "kernel_launch: occupancy query says %d\n", per_cu);
        (void)hipGetLastError();
        grid = cus;
    }
    if (grid < 0) return;
    (void)hipMemsetAsync((char*)d_ws + WS_CTL, 0, CTL_ZERO_BYTES, stream);
    Args a{};
    for (int i = 0; i < 22; ++i) a.in[i] = (const float*)d_in[i];
    a.out = (float*)d_out; a.ws = (unsigned char*)d_ws;
    a.ph_lo = 0; a.ph_hi = 15; a.li = 0;
    hipLaunchKernelGGL(fwd, dim3(grid), dim3(NWAVES * 64), LDS_BYTES, stream, a);
}
```
